# Optimizing an MI355X kernel written in HIP

```python
import math
import jax, jax.numpy as jnp
from jax import lax
import numpy as np

D_MODEL = 1024
BATCH = 16
SEQ = 256
DEPTH = 2
DEC_BATCH = 8
DEC_SEQ = 2048
PAST_LEN = 256

GRID_W = 64
HEAD_DIM = 64
H_RET = 8
H_Q = 8
H_KV = 2
N_REP = H_Q // H_KV
CHUNK = 128
Q_BLOCK = 128
CM_GROUPS = 4
RET_W = H_RET * HEAD_DIM
ATT_Q_W = H_Q * HEAD_DIM
ATT_KV_W = H_KV * HEAD_DIM
CM_W = 512
CM_GROUP_CH = CM_W // CM_GROUPS
D_FF = 4 * D_MODEL
ROPE_BASE = 10000.0
EPS = 1e-6
IN_SIZES = (RET_W, RET_W, RET_W, RET_W, ATT_Q_W, ATT_KV_W, ATT_KV_W, CM_W, CM_W, D_MODEL, D_MODEL, D_MODEL)
IN_W = 4 * RET_W + ATT_Q_W + 2 * ATT_KV_W + 2 * CM_W + 3 * D_MODEL

kernel_name = 'hybrid_diffusion_prefix_context_step'


def rms_norm(x, g):
    xf = x.astype(jnp.float32)
    y = xf * lax.rsqrt(jnp.mean(xf * xf, axis=-1, keepdims=True) + EPS)
    return (y * g.astype(jnp.float32)).astype(x.dtype)


def head_group_norm(o, g):
    B, L, H, d = o.shape
    mu = jnp.mean(o, axis=-1, keepdims=True)
    var = jnp.mean(jnp.square(o - mu), axis=-1, keepdims=True)
    y = (o - mu) * lax.rsqrt(var + EPS)
    return y.reshape(B, L, H * d) * g.astype(jnp.float32)


def split_proj(z):
    idx, acc = [], 0
    for s in IN_SIZES[:-1]:
        acc += s
        idx.append(acc)
    return jnp.split(z, idx, axis=-1)


def modulation(cond, w_mod, b_mod):
    m = jax.nn.silu(cond) @ w_mod + b_mod
    return [t[:, None, :] for t in jnp.split(m, 6, axis=-1)]


def axial_rope_tables(length):
    rows = length // GRID_W
    row = jnp.repeat(jnp.arange(rows, dtype=jnp.float32), GRID_W)
    col = jnp.tile(jnp.arange(GRID_W, dtype=jnp.float32), rows)
    half = HEAD_DIM // 2
    inv = 1.0 / (ROPE_BASE ** (jnp.arange(0, half, 2, dtype=jnp.float32) / half))
    ang = jnp.concatenate([row[:, None] * inv[None, :], col[:, None] * inv[None, :]], axis=-1)
    return jnp.cos(ang), jnp.sin(ang)


def apply_rope(x, cos, sin):
    xf = x.astype(jnp.float32)
    x1, x2 = xf[..., 0::2], xf[..., 1::2]
    c = cos[None, :, None, :]
    s = sin[None, :, None, :]
    out = jnp.stack([x1 * c - x2 * s, x1 * s + x2 * c], axis=-1).reshape(x.shape)
    return out.astype(x.dtype)


def retention_scan(q, k, v, log_decay, s0):
    B, L, H, d = q.shape
    nc = L // CHUNK
    qc = q.astype(jnp.float32).reshape(B, nc, CHUNK, H, d)
    kc = k.astype(jnp.float32).reshape(B, nc, CHUNK, H, d)
    vc = v.astype(jnp.float32).reshape(B, nc, CHUNK, H, d)
    ld = log_decay.astype(jnp.float32)
    pos = jnp.arange(CHUNK, dtype=jnp.float32)
    rel = pos[:, None] - pos[None, :]
    dmask = jnp.where(rel[None] >= 0, jnp.exp(ld[:, None, None] * jnp.maximum(rel, 0.0)[None]), 0.0)
    scores = jnp.einsum('bnihd,bnjhd->bnhij', qc, kc) * dmask[None, None]
    inner = jnp.einsum('bnhij,bnjhe->bnihe', scores, vc)
    zeta = jnp.exp(ld[None, :] * (CHUNK - 1.0 - pos)[:, None])
    upd = jnp.einsum('bnjhd,jh,bnjhe->nbhde', kc, zeta, vc)
    chunk_decay = jnp.exp(ld * CHUNK)[None, :, None, None]

    def step(s, u):
        return chunk_decay * s + u, s

    s_final, s_prev = lax.scan(step, s0.astype(jnp.float32), upd)
    xi = jnp.exp(ld[None, :] * (pos + 1.0)[:, None])
    cross = jnp.einsum('bnihd,ih,nbhde->bnihe', qc, xi, s_prev)
    return (inner + cross).reshape(B, L, H, d), s_final


def bidir_retention(q, k, v, decay_param, s0):
    ld = -jax.nn.softplus(decay_param.astype(jnp.float32))
    o_f, s_f = retention_scan(q, k, v, ld[0], s0[:, 0])
    o_b, s_b = retention_scan(q[:, ::-1], k[:, ::-1], v[:, ::-1], ld[1], s0[:, 1])
    return o_f + o_b[:, ::-1], jnp.stack([s_f, s_b], axis=1)


def block_attention(q, k, v):
    B, L, _, d = q.shape
    nb = L // Q_BLOCK
    qb = q.reshape(B, nb, Q_BLOCK, H_KV, N_REP, d).transpose(1, 0, 2, 3, 4, 5)
    kf = k.astype(jnp.float32)
    vf = v.astype(jnp.float32)
    scale = d ** -0.5

    def one_block(qi):
        s = jnp.einsum('bqgrd,bkgd->bgrqk', qi.astype(jnp.float32), kf) * scale
        p = jax.nn.softmax(s, axis=-1)
        return jnp.einsum('bgrqk,bkgd->bqgrd', p, vf)

    o = lax.map(one_block, qb)
    return o.transpose(1, 0, 2, 3, 4, 5).reshape(B, L, H_Q * d).astype(q.dtype)


def chunk_mlp(u, v, g_norm, ws, bs):
    B, L, _ = u.shape
    u = jax.nn.gelu(u)
    v = rms_norm(jax.nn.gelu(v), g_norm)
    vc = v.reshape(B, L // CHUNK, CHUNK, CM_GROUPS, CM_GROUP_CH)
    mixed = jnp.einsum('gpq,bnqgc->bnpgc', ws, vc) + bs.T[None, None, :, :, None]
    return u * mixed.reshape(B, L, CM_W)


def token_mixers(h, lp, is_latent, cos, sin, ctx_k, ctx_v, s0):
    B, L, _ = h.shape
    rq, rk, rv, rg, aq, ak, av, cu, cv, gr, ga, gc = split_proj(h @ lp['w_in'])

    def heads(t, n):
        return t.reshape(B, L, n, HEAD_DIM)

    rq, rk, rv = heads(rq, H_RET), heads(rk, H_RET) * (HEAD_DIM ** -0.5), heads(rv, H_RET)
    aq = rms_norm(heads(aq, H_Q), lp['g_q'])
    ak = rms_norm(heads(ak, H_KV), lp['g_k'])
    av = heads(av, H_KV)
    if is_latent:
        rq, rk = apply_rope(rq, cos, sin), apply_rope(rk, cos, sin)
        q_att = apply_rope(aq, cos, sin)
        keys = jnp.concatenate([ctx_k.astype(h.dtype), apply_rope(ak, cos, sin)], axis=1)
        vals = jnp.concatenate([ctx_v.astype(h.dtype), av], axis=1)
        state0 = s0
    else:
        q_att, keys, vals = aq, ak, av
        state0 = jnp.zeros((B, 2, H_RET, HEAD_DIM, HEAD_DIM), jnp.float32)
    ret_o, s_fin = bidir_retention(rq, rk, rv, lp['ret_decay'], state0)
    ret_o = (head_group_norm(ret_o, lp['ret_gn']) * jax.nn.silu(rg.astype(jnp.float32))).astype(h.dtype)
    att_o = block_attention(q_att, keys, vals)
    cm_o = chunk_mlp(cu, cv, lp['cm_norm'], lp['cm_ws'], lp['cm_bs'])
    merged = (jax.nn.sigmoid(gr) * (ret_o @ lp['w_br_ret'])
              + jax.nn.sigmoid(ga) * (att_o @ lp['w_br_att'])
              + jax.nn.sigmoid(gc) * (cm_o @ lp['w_br_cm']))
    return merged @ lp['w_out'], ak, av, s_fin


def trunk_layer(x, cond, lp, is_latent, cos, sin, ctx_k, ctx_v, s0):
    sh1, sc1, g1, sh2, sc2, g2 = modulation(cond, lp['w_mod'], lp['b_mod'])
    h = rms_norm(x, lp['g_norm1']) * (1.0 + sc1) + sh1
    y, k_ctx, v_ctx, s_ctx = token_mixers(h, lp, is_latent, cos, sin, ctx_k, ctx_v, s0)
    x = x + g1 * y
    h = rms_norm(x, lp['g_norm2']) * (1.0 + sc2) + sh2
    f = jnp.square(jax.nn.relu(h @ lp['w_ff1'])) @ lp['w_ff2']
    x = x + g2 * f
    return x, k_ctx, v_ctx, s_ctx


def setup_inputs(seed: int = 0) -> dict:
    key = jax.random.key(seed)
    ks = jax.random.split(key, 26)
    f32 = jnp.float32

    def nrm(k, shape, scale=1.0):
        return jax.random.normal(k, shape, f32) * scale

    gam = 1.0 - 2.0 ** (-5.0 - np.arange(H_RET, dtype=np.float32))
    decay_base = np.log(np.expm1(-np.log(gam))).astype(np.float32)
    return {
        'x_prompt': nrm(ks[0], (BATCH, SEQ, D_MODEL)),
        'x_sample': nrm(ks[1], (DEC_BATCH, DEC_SEQ, D_MODEL)),
        'cache_k': nrm(ks[2], (DEC_BATCH, DEPTH, PAST_LEN, H_KV, HEAD_DIM)),
        'cache_v': nrm(ks[3], (DEC_BATCH, DEPTH, PAST_LEN, H_KV, HEAD_DIM)),
        'state_ret': nrm(ks[4], (DEC_BATCH, DEPTH, 2, H_RET, HEAD_DIM, HEAD_DIM), 0.5),
        'c': nrm(ks[5], (DEC_BATCH, D_MODEL)),
        'c_ctx': nrm(ks[6], (D_MODEL,)),
        'w_mod': nrm(ks[7], (DEPTH, D_MODEL, 6 * D_MODEL), 0.5 * D_MODEL ** -0.5),
        'b_mod': nrm(ks[8], (DEPTH, 6 * D_MODEL), 0.02),
        'g_norm1': 1.0 + nrm(ks[9], (DEPTH, D_MODEL), 0.02),
        'g_norm2': 1.0 + nrm(ks[10], (DEPTH, D_MODEL), 0.02),
        'w_in': nrm(ks[11], (DEPTH, D_MODEL, IN_W), D_MODEL ** -0.5),
        'g_q': 1.0 + nrm(ks[12], (DEPTH, HEAD_DIM), 0.02),
        'g_k': 1.0 + nrm(ks[13], (DEPTH, HEAD_DIM), 0.02),
        'ret_decay': jnp.asarray(decay_base)[None, None, :] + nrm(ks[14], (DEPTH, 2, H_RET), 0.05),
        'ret_gn': 1.0 + nrm(ks[15], (DEPTH, RET_W), 0.02),
        'cm_norm': 1.0 + nrm(ks[16], (DEPTH, CM_W), 0.02),
        'cm_ws': nrm(ks[17], (DEPTH, CM_GROUPS, CHUNK, CHUNK), CHUNK ** -0.5),
        'cm_bs': 1.0 + nrm(ks[18], (DEPTH, CM_GROUPS, CHUNK), 0.02),
        'w_br_ret': nrm(ks[19], (DEPTH, RET_W, D_MODEL), RET_W ** -0.5),
        'w_br_att': nrm(ks[20], (DEPTH, ATT_Q_W, D_MODEL), ATT_Q_W ** -0.5),
        'w_br_cm': nrm(ks[21], (DEPTH, CM_W, D_MODEL), CM_W ** -0.5),
        'w_out': nrm(ks[22], (DEPTH, D_MODEL, D_MODEL), D_MODEL ** -0.5),
        'w_ff1': nrm(ks[23], (DEPTH, D_MODEL, D_FF), D_MODEL ** -0.5),
        'w_ff2': nrm(ks[24], (DEPTH, D_FF, D_MODEL), D_FF ** -0.5),
        'g_final': 1.0 + nrm(ks[25], (D_MODEL,), 0.02),
    }


def reference(x_prompt, x_sample, cache_k, cache_v, state_ret, c, c_ctx,
              w_mod, b_mod, g_norm1, g_norm2, w_in, g_q, g_k, ret_decay, ret_gn,
              cm_norm, cm_ws, cm_bs, w_br_ret, w_br_att, w_br_cm, w_out, w_ff1, w_ff2, g_final):
    cond_ctx = jnp.broadcast_to(c_ctx[None, :], (x_prompt.shape[0], D_MODEL))
    cos, sin = axial_rope_tables(x_sample.shape[1])
    xp, xs = x_prompt, x_sample
    ks_list, vs_list, ss_list = [], [], []
    for l in range(DEPTH):
        lp = {
            'w_mod': w_mod[l], 'b_mod': b_mod[l], 'g_norm1': g_norm1[l], 'g_norm2': g_norm2[l],
            'w_in': w_in[l], 'g_q': g_q[l], 'g_k': g_k[l], 'ret_decay': ret_decay[l], 'ret_gn': ret_gn[l],
            'cm_norm': cm_norm[l], 'cm_ws': cm_ws[l], 'cm_bs': cm_bs[l],
            'w_br_ret': w_br_ret[l], 'w_br_att': w_br_att[l], 'w_br_cm': w_br_cm[l], 'w_out': w_out[l],
            'w_ff1': w_ff1[l], 'w_ff2': w_ff2[l],
        }
        xp, k_l, v_l, s_l = trunk_layer(xp, cond_ctx, lp, False, None, None, None, None, None)
        ks_list.append(k_l)
        vs_list.append(v_l)
        ss_list.append(s_l.astype(x_prompt.dtype))
        xs, _, _, _ = trunk_layer(xs, c, lp, True, cos, sin, cache_k[:, l], cache_v[:, l], state_ret[:, l])
    y_prompt = rms_norm(xp, g_final)
    y_sample = rms_norm(xs, g_final)
    new_cache_k = jnp.stack(ks_list, axis=1)
    new_cache_v = jnp.stack(vs_list, axis=1)
    new_state_ret = jnp.stack(ss_list, axis=1)
    return (y_prompt, y_sample, new_cache_k, new_cache_v, new_state_ret)
```

```cpp
#include <hip/hip_runtime.h>
#include <cstdio>
#include <cstdint>

#ifndef N_LAUNCH_MODE
#define N_LAUNCH_MODE 0
#endif

#define GAS __attribute__((address_space(1)))
#define LAS __attribute__((address_space(3)))
#define RLX_AGENT __ATOMIC_RELAXED, __HIP_MEMORY_SCOPE_AGENT
typedef unsigned short bf16_t;
typedef short bf16x8 __attribute__((ext_vector_type(8)));
typedef float f32x4 __attribute__((ext_vector_type(4)));
typedef float f32x2 __attribute__((ext_vector_type(2)));
typedef unsigned u32x4 __attribute__((ext_vector_type(4)));
typedef unsigned u32x2 __attribute__((ext_vector_type(2)));

constexpr int DM = 1024, MP = 4096, MS = 16384, M = 20480, SEQ_P = 256, SEQ_S = 2048, NB_P = 16, NB_S = 8, PAST = 256;
constexpr int HD = 64, NH = 8, KVW = 128, DFF = 4096, INW = 6912, NMIX = 3840, NGATE = 3072, RW = 512;
constexpr int SKV_S = PAST + SEQ_S, SKV_P = SEQ_P;
constexpr int NCHUNK = M / 128;
constexpr float EPS = 1e-6f;
constexpr float C2 = 0.18033688011112042f;
constexpr size_t OUT_Y = 0, OUT_CK = (size_t)M * DM, OUT_CV = OUT_CK + (size_t)NB_P * 2 * SEQ_P * KVW, OUT_ST = OUT_CV + (size_t)NB_P * 2 * SEQ_P * KVW;

constexpr size_t MiB = 1u << 20;
constexpr size_t WS_CTL = 0;
constexpr size_t WS_MOD = 1 * MiB;
constexpr size_t WS_ROPE = 1 * MiB + 512 * 1024;
constexpr size_t WS_ZERO_BYTES = 1 * MiB + 512 * 1024;
constexpr size_t WS_W = 2 * MiB;
constexpr size_t W_IN = 0, W_BR = W_IN + (size_t)INW * DM * 2, W_OUT = W_BR + (size_t)3 * DM * RW * 2, W_FF1 = W_OUT + (size_t)DM * DM * 2, W_FF2 = W_FF1 + (size_t)DFF * DM * 2, W_END = W_FF2 + (size_t)DM * DFF * 2;
static_assert(W_END <= 35 * MiB, "weights");
constexpr size_t WS_XN = 37 * MiB;
constexpr size_t WS_Z = 77 * MiB;
constexpr size_t Z_RQ = WS_Z, Z_RK = WS_Z + 20 * MiB, Z_RV = WS_Z + 40 * MiB, Z_RG = WS_Z + 60 * MiB, Z_U = WS_Z + 80 * MiB;
constexpr size_t Z_AQ = WS_Z + 120 * MiB, Z_CU = WS_Z + 140 * MiB, Z_CV = WS_Z + 160 * MiB;
constexpr size_t Z_KS = WS_Z + 180 * MiB, Z_VS = Z_KS + (size_t)NB_S * SKV_S * KVW * 2, Z_KP = Z_VS + (size_t)NB_S * SKV_S * KVW * 2, Z_VP = Z_KP + (size_t)NB_P * SEQ_P * KVW * 2, Z_END = Z_VP + (size_t)NB_P * SEQ_P * KVW * 2;
constexpr size_t Z_GATE = WS_Z;
constexpr size_t Z_HB = WS_Z;
constexpr size_t WS_NEED = 268 * MiB;
static_assert(Z_END <= WS_NEED, "ws map");
constexpr int CW_BAR = 4096;

constexpr int LDS_BYTES = 147456;
constexpr int MISC_OFF = 131072 + 320;

__device__ __forceinline__ unsigned f2bf(float f) { unsigned u = __builtin_bit_cast(unsigned, f); return (u + 0x7fffu + ((u >> 16) & 1u)) >> 16; }
__device__ __forceinline__ unsigned pk2(float lo, float hi) { return f2bf(lo) | (f2bf(hi) << 16); }
__device__ __forceinline__ float bf2f(unsigned h) { return __builtin_bit_cast(float, h << 16); }
__device__ __forceinline__ float bflo(unsigned w) { return __builtin_bit_cast(float, w << 16); }
__device__ __forceinline__ float bfhi(unsigned w) { return __builtin_bit_cast(float, w & 0xffff0000u); }
__device__ __forceinline__ float sigmoidf_(float x) { return 1.f / (1.f + __expf(-x)); }
__device__ __forceinline__ float siluf_(float x) { return x / (1.f + __expf(-x)); }
__device__ __forceinline__ float gelu_tanh(float x) { const float u = 0.7978845608028654f * (x + 0.044715f * x * x * x); const float e = __expf(2.f * u); const float th = 1.f - 2.f / (e + 1.f); return 0.5f * x * (1.f + th); }
__device__ __forceinline__ float wave_sum(float v) {
#pragma unroll
    for (int o = 1; o < 64; o <<= 1) v += __shfl_xor(v, o);
    return v;
}

#define XB_TMO      128
#define XB_XCNT(j)  (256  + 64 * (j))
#define XB_XSUB(j)  (1280 + 64 * (j))
#define XB_XGEN(j)  (2304 + 64 * (j))
#define XB_TOP      3328
#define XB_TOPGEN   3392
#define XCD_BAR_WORDS 3456
#define XB_SPIN_CAP (1u << 18)
__device__ __forceinline__ unsigned xb_ld(unsigned* p)              { return __hip_atomic_load(p, __ATOMIC_RELAXED, __HIP_MEMORY_SCOPE_AGENT); }
__device__ __forceinline__ unsigned xb_add(unsigned* p, unsigned v) { return __hip_atomic_fetch_add(p, v, __ATOMIC_RELAXED, __HIP_MEMORY_SCOPE_AGENT); }
__device__ __forceinline__ unsigned xb_xcc_id() { return (unsigned)__builtin_amdgcn_s_getreg((3 << 11) | 20) & 0xFu; }
#define XB_SPIN(cond, bar) do { unsigned _sp = 0; while (cond) { __builtin_amdgcn_s_sleep(1); \
    if ((++_sp & 255u) == 0u) { if (xb_ld(&(bar)[XB_TMO])) break; if (_sp > XB_SPIN_CAP) { atomicAdd(&(bar)[XB_TMO], 1u); break; } } } } while (0)
struct XcdBarrier { unsigned* bar; unsigned x; volatile LAS unsigned* st; };
__device__ __forceinline__ XcdBarrier xcd_barrier_post(unsigned* bar, volatile LAS unsigned* st) {
    XcdBarrier b; b.bar = bar; b.x = xb_xcc_id(); b.st = st;
    if (threadIdx.x == 0) (void)xb_add(&bar[XB_XCNT(b.x)], 1u);
    return b;
}
__device__ __forceinline__ void xcd_barrier_complete(unsigned* bar, unsigned x, unsigned& nloc, unsigned& nx) {
    const unsigned G = gridDim.x * gridDim.y * gridDim.z;
    unsigned sum, cnt, mine, sp = 0u;
    for (;;) {
        sum = 0u; cnt = 0u; mine = 0u;
#pragma unroll
        for (unsigned j = 0; j < 16; ++j) { const unsigned c = xb_ld(&bar[XB_XCNT(j)]); sum += c; cnt += (c > 0u) ? 1u : 0u; mine = (j == x) ? c : mine; }
        if (sum == G) break;
        __builtin_amdgcn_s_sleep(1);
        if ((++sp & 255u) == 0u) { if (xb_ld(&bar[XB_TMO])) break; if (sp > XB_SPIN_CAP) { atomicAdd(&bar[XB_TMO], 1u); break; } }
    }
    nloc = mine > 0u ? mine : 1u; nx = cnt > 0u ? cnt : 1u;
}
__device__ __forceinline__ void xcd_barrier(const XcdBarrier& b) {
    asm volatile("s_waitcnt vmcnt(0)" ::: "memory");
    __syncthreads();
    if (threadIdx.x == 0) {
        unsigned* bar = b.bar;
        __builtin_amdgcn_s_waitcnt(0);
        unsigned nloc = b.st[0], nx = b.st[1];
        if (nloc == 0u) { xcd_barrier_complete(bar, b.x, nloc, nx); b.st[0] = nloc; b.st[1] = nx; }
        const unsigned old = xb_add(&bar[XB_XSUB(b.x)], 1u);
        const unsigned gen = old / nloc;
        if (old + 1u == (gen + 1u) * nloc) {
            __builtin_amdgcn_fence(__ATOMIC_RELEASE, "agent");
            asm volatile("s_waitcnt vmcnt(0)" ::: "memory");
            const unsigned og = xb_add(&bar[XB_TOP], 1u);
            const unsigned tg = og / nx;
            if (og + 1u == (tg + 1u) * nx) xb_add(&bar[XB_TOPGEN], 1u);
            else XB_SPIN(xb_ld(&bar[XB_TOPGEN]) == tg, bar);
            __builtin_amdgcn_fence(__ATOMIC_ACQUIRE, "agent");
            xb_add(&bar[XB_XGEN(b.x)], 1u);
            asm volatile("s_waitcnt vmcnt(0)" ::: "memory");
        } else {
            XB_SPIN(xb_ld(&bar[XB_XGEN(b.x)]) == gen, bar);
            __builtin_amdgcn_fence(__ATOMIC_ACQUIRE, "agent");
            asm volatile("s_waitcnt vmcnt(0)" ::: "memory");
        }
    }
    __syncthreads();
}

enum { I_XP = 0, I_XS, I_CK, I_CV, I_ST, I_C, I_CCTX, I_WMOD, I_BMOD, I_GN1, I_GN2, I_WIN, I_GQ, I_GK, I_DECAY, I_RETGN, I_CMNORM, I_CMWS, I_CMBS, I_WBRR, I_WBRA, I_WBRC, I_WOUT, I_WFF1, I_WFF2, I_GFIN, N_IN };
struct Params { const float* in[N_IN]; float* out; unsigned char* ws; int ph_lo, ph_hi; };
static_assert(sizeof(Params) == N_IN * 8 + 8 + 8 + 8, "no padding");

struct Ctx {
    int tid, lane, wave, G, bx;
    LAS unsigned char* lds;
};
__device__ __forceinline__ int row_ci(int R) { return R < MP ? 0 : 1 + ((R - MP) >> 11); }
__device__ __forceinline__ const float* mod_ptr(const Params& p, int l, int ci, int part) { return (const float*)(p.ws + WS_MOD) + ((size_t)(l * 9 + ci) * 6 + part) * DM; }

__device__ __forceinline__ void p0_modulation(const Params& p, const Ctx& c) {
    LAS float* sl = (LAS float*)c.lds;
    for (int i = c.tid; i < 9 * DM; i += 512) { const int ci = i >> 10, k = i & 1023; const float v = ci == 0 ? p.in[I_CCTX][k] : p.in[I_C][(ci - 1) * DM + k]; sl[i] = siluf_(v); }
    __syncthreads();
    float* mod = (float*)(p.ws + WS_MOD);
    const int gw = c.bx * 8 + c.wave, NGW = c.G * 8;
    constexpr int NITEM = 2 * 96 * 8;
    for (int it = gw; it < NITEM; it += NGW) {
        const int l = it / 768, r = it % 768, cb = r >> 3, ks = r & 7;
        const float* W = p.in[I_WMOD] + (size_t)l * DM * 6144 + (size_t)(ks * 128) * 6144 + cb * 64 + c.lane;
        float s[9];
#pragma unroll
        for (int ci = 0; ci < 9; ++ci) s[ci] = 0.f;
#pragma unroll 4
        for (int k = 0; k < 128; ++k) {
            const float w = W[(size_t)k * 6144];
#pragma unroll
            for (int ci = 0; ci < 9; ++ci) s[ci] += sl[ci * DM + ks * 128 + k] * w;
        }
        const float bias = ks == 0 ? p.in[I_BMOD][l * 6144 + cb * 64 + c.lane] : 0.f;
#pragma unroll
        for (int ci = 0; ci < 9; ++ci) atomicAdd(mod + (size_t)(l * 9 + ci) * 6144 + cb * 64 + c.lane, s[ci] + bias);
    }
    __syncthreads();
}
__device__ __forceinline__ void p0_rope_tables(const Params& p, const Ctx& c) {
    f32x2* tab = (f32x2*)(p.ws + WS_ROPE);
    const int g = c.bx * 512 + c.tid;
    if (g < 96 * 16) { const int pos = g >> 4, i = g & 15; const float inv = 1.0f / powf(10000.0f, (float)(2 * i) / 32.0f); const float posf = pos < 32 ? (float)pos : (float)(pos - 32);
        const float ang = posf * inv; f32x2 v; v.x = cosf(ang); v.y = sinf(ang); tab[g] = v; }
}
__device__ __forceinline__ int win_colmap(int n) {
    const int tile = n >> 8, pp = n & 255, bj = pp >> 7, wc = (pp >> 5) & 3;
    if (tile < 10) return (tile >> 1) * 512 + ((tile & 1) * 4 + wc) * 64 + 32 * bj;
    if (tile == 10) return (wc < 2 ? 2560 + wc * 64 : 2688 + (wc - 2) * 64) + 32 * bj;
    return n;
}
__device__ __forceinline__ void transpose_item(const float* W, int K, int ldn, int src_col0, bf16_t* WT, int dst_row0, int k0, LAS float* scr, int lane) {
#pragma unroll 8
    for (int i = 0; i < 32; ++i) { const int kk = 2 * i + (lane >> 5); scr[kk * 33 + (lane & 31)] = W[(size_t)(k0 + kk) * ldn + src_col0 + (lane & 31)]; }
    asm volatile("s_waitcnt lgkmcnt(0)" ::: "memory");
    const int ch = lane & 7;
#pragma unroll
    for (int j = 0; j < 4; ++j) { const int n = (lane >> 3) + 8 * j; const LAS float* s = scr + (8 * ch) * 33 + n;
        u32x4 o; o.x = pk2(s[0 * 33], s[1 * 33]); o.y = pk2(s[2 * 33], s[3 * 33]); o.z = pk2(s[4 * 33], s[5 * 33]); o.w = pk2(s[6 * 33], s[7 * 33]);
        *(u32x4*)(WT + (size_t)(dst_row0 + n) * K + k0 + 8 * ch) = o; }
    asm volatile("s_waitcnt lgkmcnt(0)" ::: "memory");
}
__device__ __forceinline__ void p_wconv(const Params& p, const Ctx& c, int l) {
    LAS float* scr = (LAS float*)(c.lds + 40960 + c.wave * 8448);
    const int gw = c.bx * 8 + c.wave, NGW = c.G * 8;
    unsigned char* wb = p.ws + WS_W;
    constexpr int I_IN = 16 * 216, I_BRX = 8 * 32, I_O = 16 * 32, I_F1 = 16 * 128, I_F2 = 64 * 32;
    constexpr int NITEMS = I_IN + 3 * I_BRX + I_O + I_F1 + I_F2;
    for (int it = gw; it < NITEMS; it += NGW) {
        int r = it;
        if (r < I_IN) { const int kb = r / 216, nb = r % 216; transpose_item(p.in[I_WIN] + (size_t)l * DM * INW, DM, INW, win_colmap(nb * 32), (bf16_t*)(wb + W_IN), nb * 32, kb * 64, scr, c.lane); continue; } r -= I_IN;
        if (r < 3 * I_BRX) { const int x = r / I_BRX, rr = r % I_BRX, kb = rr / 32, nb = rr % 32;
            const float* src = (x == 0 ? p.in[I_WBRA] : x == 1 ? p.in[I_WBRC] : p.in[I_WBRR]) + (size_t)l * RW * DM;
            transpose_item(src, RW, DM, nb * 32, (bf16_t*)(wb + W_BR) + (size_t)x * DM * RW, nb * 32, kb * 64, scr, c.lane); continue; } r -= 3 * I_BRX;
        if (r < I_O) { const int kb = r / 32, nb = r % 32; transpose_item(p.in[I_WOUT] + (size_t)l * DM * DM, DM, DM, nb * 32, (bf16_t*)(wb + W_OUT), nb * 32, kb * 64, scr, c.lane); continue; } r -= I_O;
        if (r < I_F1) { const int kb = r / 128, nb = r % 128; transpose_item(p.in[I_WFF1] + (size_t)l * DM * DFF, DM, DFF, nb * 32, (bf16_t*)(wb + W_FF1), nb * 32, kb * 64, scr, c.lane); continue; } r -= I_F1;
        { const int kb = r / 32, nb = r % 32; transpose_item(p.in[I_WFF2] + (size_t)l * DFF * DM, DFF, DM, nb * 32, (bf16_t*)(wb + W_FF2), nb * 32, kb * 64, scr, c.lane); }
    }
}
__device__ __forceinline__ void p_kvctx(const Params& p, const Ctx& c, int l) {
    const int g = c.bx * 512 + c.tid, NG = c.G * 512;
    for (int i = g; i < NB_S * PAST * KVW / 4; i += NG) {
        const int e = i * 4, b = e / (PAST * KVW), r = e % (PAST * KVW);
        const size_t src = ((size_t)(b * 2 + l) * PAST) * KVW + r;
        const f32x4 k = *(const f32x4*)(p.in[I_CK] + src), v = *(const f32x4*)(p.in[I_CV] + src);
        u32x2 ko, vo; ko.x = pk2(k.x, k.y); ko.y = pk2(k.z, k.w); vo.x = pk2(v.x, v.y); vo.y = pk2(v.z, v.w);
        *(u32x2*)((bf16_t*)(p.ws + Z_KS) + (size_t)b * SKV_S * KVW + r) = ko;
        *(u32x2*)((bf16_t*)(p.ws + Z_VS) + (size_t)b * SKV_S * KVW + r) = vo;
    }
}
__device__ __forceinline__ const float* x_row(const Params& p, int l, int R) { return l == 0 ? (R < MP ? p.in[I_XP] + (size_t)R * DM : p.in[I_XS] + (size_t)(R - MP) * DM) : p.out + (size_t)R * DM; }
__device__ __forceinline__ void p_norm(const Params& p, const Ctx& c, int l, int which) {
    const int gw = c.bx * 8 + c.wave, NGW = c.G * 8;
    const float* gvec = (which == 0 ? p.in[I_GN1] : p.in[I_GN2]) + l * DM;
    for (int R = gw; R < M; R += NGW) {
        const float* xr = which == 0 ? x_row(p, l, R) : p.out + (size_t)R * DM;
        const int ci = row_ci(R);
        const float* sh = mod_ptr(p, l, ci, which == 0 ? 0 : 3); const float* sc = mod_ptr(p, l, ci, which == 0 ? 1 : 4);
        f32x4 v[4]; float s = 0.f;
#pragma unroll
        for (int j = 0; j < 4; ++j) { v[j] = *(const f32x4*)(xr + 4 * c.lane + 256 * j); s += (v[j].x * v[j].x + v[j].y * v[j].y) + (v[j].z * v[j].z + v[j].w * v[j].w); }
        const float rstd = rsqrtf(wave_sum(s) * (1.f / DM) + EPS);
        bf16_t* orow = (bf16_t*)(p.ws + WS_XN) + (size_t)R * DM;
#pragma unroll
        for (int j = 0; j < 4; ++j) { const int col = 4 * c.lane + 256 * j; const f32x4 g = *(const f32x4*)(gvec + col), a = *(const f32x4*)(sc + col), b = *(const f32x4*)(sh + col);
            f32x4 o = v[j] * rstd * g * (a + 1.0f) + b; u32x2 w; w.x = pk2(o.x, o.y); w.y = pk2(o.z, o.w); *(u32x2*)(orow + col) = w; }
    }
}
__device__ __forceinline__ void p_final_norm(const Params& p, const Ctx& c) {
    const int gw = c.bx * 8 + c.wave, NGW = c.G * 8;
    for (int R = gw; R < M; R += NGW) {
        float* xr = p.out + (size_t)R * DM;
        f32x4 v[4]; float s = 0.f;
#pragma unroll
        for (int j = 0; j < 4; ++j) { v[j] = *(const f32x4*)(xr + 4 * c.lane + 256 * j); s += (v[j].x * v[j].x + v[j].y * v[j].y) + (v[j].z * v[j].z + v[j].w * v[j].w); }
        const float rstd = rsqrtf(wave_sum(s) * (1.f / DM) + EPS);
#pragma unroll
        for (int j = 0; j < 4; ++j) { const int col = 4 * c.lane + 256 * j; const f32x4 g = *(const f32x4*)(p.in[I_GFIN] + col); *(f32x4*)(xr + col) = v[j] * rstd * g; }
    }
}

struct Unit { int pm, pn; };
__host__ __device__ __forceinline__ int perm32(int rho) { const int n = rho >> 4, i = rho & 15; return 8 * (i >> 2) + 4 * n + (i & 3); }
struct StaticOrder {
    int nM, nN, nwg, G, c;
    __device__ void init(int Mr, int N, int G_, int c_) { nM = Mr / 256; nN = N / 256; nwg = nM * nN; G = G_; c = c_; }
    __device__ bool next(int i, Unit& u) const {
        const long L = (long)i * G + c; if (L >= nwg) return false;
        int wgid = (int)L; { const int q = nwg / 8, r = nwg % 8, xcd = wgid % 8, off = wgid / 8; wgid = (xcd < r ? xcd * (q + 1) : r * (q + 1) + (xcd - r) * q) + off; }
        const int nig = 8 * nN, gid = wgid / nig, fm = gid * 8, gsz = (nM - fm) < 8 ? (nM - fm) : 8;
        u.pm = fm + ((wgid % nig) % gsz); u.pn = (wgid % nig) / gsz; return true;
    }
};
struct MergeOrder {
    int G, c;
    __device__ bool next(int i, Unit& u) const {
        const int t = i / 3, x = i % 3; const long L = (long)t * G + c; if (L >= 320) return false;
        u.pm = x * 80 + (int)(L >> 2); u.pn = x * 4 + (int)(L & 3); return true;
    }
};
template <class Epi, class Sched>
__device__ __forceinline__ void gemm_simple(const bf16_t* A, const bf16_t* Bt, int K, const Sched& S, const Epi& E) {
    const int tid = threadIdx.x, wid = tid >> 6, lane = tid & 63, wr = wid >> 2, wc = wid & 3, fr = lane & 15, fq = lane >> 4;
    Unit u;
    for (int ui = 0; S.next(ui, u); ++ui) {
        f32x4 acc[2][2][4][2];
#pragma unroll
        for (int a = 0; a < 2; ++a)
#pragma unroll
            for (int b = 0; b < 2; ++b)
#pragma unroll
                for (int m = 0; m < 4; ++m)
#pragma unroll
                    for (int n = 0; n < 2; ++n) acc[a][b][m][n] = (f32x4){0.f, 0.f, 0.f, 0.f};
        const bf16_t* Ar = A + (size_t)(u.pm * 256 + wr * 64 + fr) * K + fq * 8;
        const bf16_t* Br[2];
#pragma unroll
        for (int n = 0; n < 2; ++n) Br[n] = Bt + (size_t)(u.pn * 256 + wc * 32 + (Epi::PERM ? perm32(16 * n + fr) : 16 * n + fr)) * K + fq * 8;
        for (int k0 = 0; k0 < K; k0 += 32) {
            bf16x8 tf[2][4], wf[2][2];
#pragma unroll
            for (int ai = 0; ai < 2; ++ai)
#pragma unroll
                for (int m = 0; m < 4; ++m) tf[ai][m] = *(const bf16x8*)(Ar + (size_t)(ai * 128 + m * 16) * K + k0);
#pragma unroll
            for (int bj = 0; bj < 2; ++bj)
#pragma unroll
                for (int n = 0; n < 2; ++n) wf[bj][n] = *(const bf16x8*)(Br[n] + (size_t)(bj * 128) * K + k0);
#pragma unroll
            for (int ai = 0; ai < 2; ++ai)
#pragma unroll
                for (int bj = 0; bj < 2; ++bj)
#pragma unroll
                    for (int m = 0; m < 4; ++m)
#pragma unroll
                        for (int n = 0; n < 2; ++n) acc[ai][bj][m][n] = __builtin_amdgcn_mfma_f32_16x16x32_bf16(wf[bj][n], tf[ai][m], acc[ai][bj][m][n], 0, 0, 0);
        }
        E(acc, u, wr, wc, fr, fq);
    }
}

__device__ __forceinline__ u32x4 pack8(const f32x4& a, const f32x4& b) { u32x4 w; w.x = pk2(a.x, a.y); w.y = pk2(a.z, a.w); w.z = pk2(b.x, b.y); w.w = pk2(b.z, b.w); return w; }
__device__ __forceinline__ void rope4(f32x4& v, const f32x2 cs0, const f32x2 cs1) {
    const float a0 = v.x * cs0.x - v.y * cs0.y, a1 = v.x * cs0.y + v.y * cs0.x, a2 = v.z * cs1.x - v.w * cs1.y, a3 = v.z * cs1.y + v.w * cs1.x;
    v.x = a0; v.y = a1; v.z = a2; v.w = a3;
}
struct EpiMix {
    static constexpr bool PERM = true;
    const Params* pp; int l;
    __device__ __forceinline__ void operator()(const f32x4 (&acc)[2][2][4][2], const Unit& u, int wr, int wc, int fr, int fq) const {
        const Params& p = *pp;
        const int pn = u.pn, R0 = u.pm * 256; const bool smp = R0 >= MP;
        const int b = smp ? (R0 - MP) >> 11 : R0 >> 8, t0 = smp ? (R0 - MP) & 2047 : 0;
        const f32x2* cs_row = (const f32x2*)(p.ws + WS_ROPE); const f32x2* cs_col = cs_row + 32 * 16;
        if (pn >= 11) {
            bf16_t* dst = (bf16_t*)(p.ws + (pn < 13 ? Z_CU : Z_CV)) + ((pn - 11) & 1) * 256 + wc * 32 + 8 * fq;
#pragma unroll
            for (int ai = 0; ai < 2; ++ai)
#pragma unroll
                for (int m = 0; m < 4; ++m) { const int R = R0 + ai * 128 + wr * 64 + m * 16 + fr;
#pragma unroll
                    for (int bj = 0; bj < 2; ++bj) { f32x4 v0 = acc[ai][bj][m][0], v1 = acc[ai][bj][m][1];
#pragma unroll
                        for (int r = 0; r < 4; ++r) { v0[r] = gelu_tanh(v0[r]); v1[r] = gelu_tanh(v1[r]); }
                        *(u32x4*)(dst + (size_t)R * RW + bj * 128) = pack8(v0, v1); } }
            return;
        }
        const int kind = pn >> 1;
        float gq[2][2][4];
        const bool is_k = (pn == 10 && wc < 2), is_v = (pn == 10 && wc >= 2);
        if (kind == 4 || is_k) { const float* g = (kind == 4 ? p.in[I_GQ] : p.in[I_GK]) + l * HD;
#pragma unroll
            for (int bj = 0; bj < 2; ++bj)
#pragma unroll
                for (int n = 0; n < 2; ++n)
#pragma unroll
                    for (int r = 0; r < 4; ++r) gq[bj][n][r] = g[32 * bj + 8 * fq + 4 * n + r]; }
        const int head = (pn & 1) * 4 + wc;
#pragma unroll
        for (int ai = 0; ai < 2; ++ai)
#pragma unroll
            for (int m = 0; m < 4; ++m) {
                const int rr = ai * 128 + wr * 64 + m * 16 + fr, R = R0 + rr, t = t0 + rr;
                f32x4 v[2][2];
#pragma unroll
                for (int bj = 0; bj < 2; ++bj)
#pragma unroll
                    for (int n = 0; n < 2; ++n) v[bj][n] = acc[ai][bj][m][n];
                if (kind == 4 || is_k) {
                    float ss = 0.f;
#pragma unroll
                    for (int bj = 0; bj < 2; ++bj)
#pragma unroll
                        for (int n = 0; n < 2; ++n) ss += (v[bj][n].x * v[bj][n].x + v[bj][n].y * v[bj][n].y) + (v[bj][n].z * v[bj][n].z + v[bj][n].w * v[bj][n].w);
                    ss += __shfl_xor(ss, 16); ss += __shfl_xor(ss, 32);
                    const float rs = rsqrtf(ss * (1.f / HD) + EPS);
#pragma unroll
                    for (int bj = 0; bj < 2; ++bj)
#pragma unroll
                        for (int n = 0; n < 2; ++n)
#pragma unroll
                            for (int r = 0; r < 4; ++r) v[bj][n][r] = v[bj][n][r] * rs * gq[bj][n][r];
                }
                if (is_k && !smp) {
                    float* o = p.out + OUT_CK + ((size_t)((b * 2 + l) * SEQ_P + t) * 2 + wc) * HD + 8 * fq;
#pragma unroll
                    for (int bj = 0; bj < 2; ++bj) { *(f32x4*)(o + 32 * bj) = v[bj][0]; *(f32x4*)(o + 32 * bj + 4) = v[bj][1]; }
                }
                if (is_v && !smp) {
                    float* o = p.out + OUT_CV + ((size_t)((b * 2 + l) * SEQ_P + t) * 2 + (wc - 2)) * HD + 8 * fq;
#pragma unroll
                    for (int bj = 0; bj < 2; ++bj) { *(f32x4*)(o + 32 * bj) = v[bj][0]; *(f32x4*)(o + 32 * bj + 4) = v[bj][1]; }
                }
                if (kind == 1) {
#pragma unroll
                    for (int bj = 0; bj < 2; ++bj)
#pragma unroll
                        for (int n = 0; n < 2; ++n) v[bj][n] = v[bj][n] * 0.125f;
                }
                if (kind == 3) {
#pragma unroll
                    for (int bj = 0; bj < 2; ++bj)
#pragma unroll
                        for (int n = 0; n < 2; ++n)
#pragma unroll
                            for (int r = 0; r < 4; ++r) v[bj][n][r] = siluf_(v[bj][n][r]);
                }
                if (smp && (kind == 0 || kind == 1 || kind == 4 || is_k)) {
                    const f32x2* tr = cs_row + (t >> 6) * 16 + 4 * fq; const f32x2* tc = cs_col + (t & 63) * 16 + 4 * fq;
#pragma unroll
                    for (int n = 0; n < 2; ++n) { rope4(v[0][n], tr[2 * n], tr[2 * n + 1]); rope4(v[1][n], tc[2 * n], tc[2 * n + 1]); }
                }
                if (kind == 4) {
#pragma unroll
                    for (int bj = 0; bj < 2; ++bj)
#pragma unroll
                        for (int n = 0; n < 2; ++n) v[bj][n] = v[bj][n] * C2;
                }
                bf16_t* dst;
                if (kind < 5) dst = (bf16_t*)(p.ws + (kind == 0 ? Z_RQ : kind == 1 ? Z_RK : kind == 2 ? Z_RV : kind == 3 ? Z_RG : Z_AQ)) + (size_t)R * RW + head * HD + 8 * fq;
                else { const int hk = wc & 1;
                    if (smp) dst = (bf16_t*)(p.ws + (is_k ? Z_KS : Z_VS)) + ((size_t)b * SKV_S + PAST + t) * KVW + hk * HD + 8 * fq;
                    else dst = (bf16_t*)(p.ws + (is_k ? Z_KP : Z_VP)) + ((size_t)b * SEQ_P + t) * KVW + hk * HD + 8 * fq; }
#pragma unroll
                for (int bj = 0; bj < 2; ++bj) *(u32x4*)(dst + 32 * bj) = pack8(v[bj][0], v[bj][1]);
            }
    }
};
struct EpiGate {
    static constexpr bool PERM = true;
    const Params* pp;
    __device__ __forceinline__ void operator()(const f32x4 (&acc)[2][2][4][2], const Unit& u, int wr, int wc, int fr, int fq) const {
        const int x = u.pn >> 2; bf16_t* dst = (bf16_t*)(pp->ws + Z_GATE) + (size_t)x * M * DM + (u.pn & 3) * 256 + wc * 32 + 8 * fq;
#pragma unroll
        for (int ai = 0; ai < 2; ++ai)
#pragma unroll
            for (int m = 0; m < 4; ++m) { const int R = u.pm * 256 + ai * 128 + wr * 64 + m * 16 + fr;
#pragma unroll
                for (int bj = 0; bj < 2; ++bj) { f32x4 v0 = acc[ai][bj][m][0], v1 = acc[ai][bj][m][1];
#pragma unroll
                    for (int r = 0; r < 4; ++r) { v0[r] = sigmoidf_(v0[r]); v1[r] = sigmoidf_(v1[r]); }
                    *(u32x4*)(dst + (size_t)R * DM + bj * 128) = pack8(v0, v1); } }
    }
};
struct EpiMerge {
    static constexpr bool PERM = true;
    const Params* pp;
    __device__ __forceinline__ void operator()(const f32x4 (&acc)[2][2][4][2], const Unit& u, int wr, int wc, int fr, int fq) const {
        const int x = u.pn >> 2, pm = u.pm - 80 * x, gi = x == 0 ? 1 : x == 1 ? 2 : 0;
        const int col0 = (u.pn & 3) * 256 + wc * 32 + 8 * fq;
        const bf16_t* gate = (const bf16_t*)(pp->ws + Z_GATE) + (size_t)gi * M * DM + col0; bf16_t* dst = (bf16_t*)(pp->ws + WS_XN) + col0;
#pragma unroll
        for (int ai = 0; ai < 2; ++ai)
#pragma unroll
            for (int m = 0; m < 4; ++m) { const int R = pm * 256 + ai * 128 + wr * 64 + m * 16 + fr;
#pragma unroll
                for (int bj = 0; bj < 2; ++bj) { f32x4 v0 = acc[ai][bj][m][0], v1 = acc[ai][bj][m][1];
                    const u32x4 g = *(const u32x4*)(gate + (size_t)R * DM + bj * 128);
                    v0.x *= bflo(g.x); v0.y *= bfhi(g.x); v0.z *= bflo(g.y); v0.w *= bfhi(g.y); v1.x *= bflo(g.z); v1.y *= bfhi(g.z); v1.z *= bflo(g.w); v1.w *= bfhi(g.w);
                    if (x != 0) { const u32x4 o = *(const u32x4*)(dst + (size_t)R * DM + bj * 128);
                        v0.x += bflo(o.x); v0.y += bfhi(o.x); v0.z += bflo(o.y); v0.w += bfhi(o.y); v1.x += bflo(o.z); v1.y += bfhi(o.z); v1.z += bflo(o.w); v1.w += bfhi(o.w); }
                    *(u32x4*)(dst + (size_t)R * DM + bj * 128) = pack8(v0, v1); } }
    }
};
struct EpiRes {
    static constexpr bool PERM = false;
    const Params* pp; int l, part; bool from_inputs;
    __device__ __forceinline__ void operator()(const f32x4 (&acc)[2][2][4][2], const Unit& u, int wr, int wc, int fr, int fq) const {
        const Params& p = *pp; const int R0 = u.pm * 256; const int ci = row_ci(R0);
        const float* gv = mod_ptr(p, l, ci, part) + u.pn * 256 + wc * 32 + 4 * fq;
        f32x4 g[2][2];
#pragma unroll
        for (int bj = 0; bj < 2; ++bj)
#pragma unroll
            for (int n = 0; n < 2; ++n) g[bj][n] = *(const f32x4*)(gv + bj * 128 + n * 16);
#pragma unroll
        for (int ai = 0; ai < 2; ++ai)
#pragma unroll
            for (int m = 0; m < 4; ++m) { const int R = R0 + ai * 128 + wr * 64 + m * 16 + fr;
                const float* xs = (from_inputs ? x_row(p, 0, R) : p.out + (size_t)R * DM) + u.pn * 256 + wc * 32 + 4 * fq;
                float* xo = p.out + (size_t)R * DM + u.pn * 256 + wc * 32 + 4 * fq;
#pragma unroll
                for (int bj = 0; bj < 2; ++bj)
#pragma unroll
                    for (int n = 0; n < 2; ++n) { const f32x4 xv = *(const f32x4*)(xs + bj * 128 + n * 16); *(f32x4*)(xo + bj * 128 + n * 16) = xv + g[bj][n] * acc[ai][bj][m][n]; } }
    }
};
struct EpiFF1 {
    static constexpr bool PERM = true;
    const Params* pp;
    __device__ __forceinline__ void operator()(const f32x4 (&acc)[2][2][4][2], const Unit& u, int wr, int wc, int fr, int fq) const {
        bf16_t* dst = (bf16_t*)(pp->ws + Z_HB) + u.pn * 256 + wc * 32 + 8 * fq;
#pragma unroll
        for (int ai = 0; ai < 2; ++ai)
#pragma unroll
            for (int m = 0; m < 4; ++m) { const int R = u.pm * 256 + ai * 128 + wr * 64 + m * 16 + fr;
#pragma unroll
                for (int bj = 0; bj < 2; ++bj) { f32x4 v0 = acc[ai][bj][m][0], v1 = acc[ai][bj][m][1];
#pragma unroll
                    for (int r = 0; r < 4; ++r) { const float a = fmaxf(v0[r], 0.f), b = fmaxf(v1[r], 0.f); v0[r] = a * a; v1[r] = b * b; }
                    *(u32x4*)(dst + (size_t)R * DFF + bj * 128) = pack8(v0, v1); } }
    }
};

__device__ __forceinline__ void attn_simple(const Params& p, const Ctx& c) {
    LAS float* Kt = (LAS float*)c.lds; LAS float* Vt = Kt + 32 * 64; LAS float* Sc = Vt + 32 * 64;
    constexpr int NU_S = NB_S * NH * 4, NU_P = NB_P * NH;
    for (int u = c.bx; u < NU_S + NU_P; u += c.G) {
        const bool smp = u < NU_S; int b, h, q0, nq, skv; const bf16_t *Kb, *Vb; size_t rowbase;
        if (smp) { b = u / 32; h = (u / 4) & 7; q0 = (u & 3) * 512; nq = 512; skv = SKV_S; Kb = (const bf16_t*)(p.ws + Z_KS) + (size_t)b * SKV_S * KVW; Vb = (const bf16_t*)(p.ws + Z_VS) + (size_t)b * SKV_S * KVW; rowbase = MP + (size_t)b * SEQ_S + q0; }
        else { const int v = u - NU_S; b = v / 8; h = v & 7; q0 = 0; nq = 256; skv = SKV_P; Kb = (const bf16_t*)(p.ws + Z_KP) + (size_t)b * SEQ_P * KVW; Vb = (const bf16_t*)(p.ws + Z_VP) + (size_t)b * SEQ_P * KVW; rowbase = (size_t)b * SEQ_P; }
        const int hk = h >> 2; const bool act = c.tid < nq;
        bf16_t* qrow = (bf16_t*)(p.ws + Z_AQ) + (rowbase + (act ? c.tid : 0)) * RW + h * HD;
        float q[64], o[64]; float mx = -1e30f, lsum = 0.f;
#pragma unroll
        for (int i = 0; i < 8; ++i) { const u32x4 w = *(const u32x4*)(qrow + 8 * i); q[8 * i] = bflo(w.x); q[8 * i + 1] = bfhi(w.x); q[8 * i + 2] = bflo(w.y); q[8 * i + 3] = bfhi(w.y); q[8 * i + 4] = bflo(w.z); q[8 * i + 5] = bfhi(w.z); q[8 * i + 6] = bflo(w.w); q[8 * i + 7] = bfhi(w.w); }
#pragma unroll
        for (int i = 0; i < 64; ++i) o[i] = 0.f;
        for (int k0 = 0; k0 < skv; k0 += 32) {
            __syncthreads();
            { const int e = c.tid * 4, j = e >> 6, d = e & 63;
                const u32x2 kw = *(const u32x2*)(Kb + (size_t)(k0 + j) * KVW + hk * HD + d), vw = *(const u32x2*)(Vb + (size_t)(k0 + j) * KVW + hk * HD + d);
                *(LAS f32x4*)(Kt + e) = (f32x4){bflo(kw.x), bfhi(kw.x), bflo(kw.y), bfhi(kw.y)}; *(LAS f32x4*)(Vt + e) = (f32x4){bflo(vw.x), bfhi(vw.x), bflo(vw.y), bfhi(vw.y)}; }
            __syncthreads();
            float tm = mx;
#pragma unroll 1
            for (int j = 0; j < 32; ++j) { float a = 0.f;
#pragma unroll
                for (int d4 = 0; d4 < 16; ++d4) { const f32x4 kv = *(const LAS f32x4*)(Kt + j * 64 + 4 * d4); a += q[4 * d4] * kv.x + q[4 * d4 + 1] * kv.y + q[4 * d4 + 2] * kv.z + q[4 * d4 + 3] * kv.w; }
                Sc[j * 512 + c.tid] = a; tm = fmaxf(tm, a); }
            const float corr = exp2f(mx - tm); mx = tm; lsum *= corr;
#pragma unroll
            for (int i = 0; i < 64; ++i) o[i] *= corr;
#pragma unroll 1
            for (int j = 0; j < 32; ++j) { const float pj = exp2f(Sc[j * 512 + c.tid] - mx); lsum += pj;
#pragma unroll
                for (int d4 = 0; d4 < 16; ++d4) { const f32x4 vv = *(const LAS f32x4*)(Vt + j * 64 + 4 * d4); o[4 * d4] += pj * vv.x; o[4 * d4 + 1] += pj * vv.y; o[4 * d4 + 2] += pj * vv.z; o[4 * d4 + 3] += pj * vv.w; } }
        }
        if (act) { const float il = 1.f / lsum;
#pragma unroll
            for (int i = 0; i < 8; ++i) { u32x4 w; w.x = pk2(o[8 * i] * il, o[8 * i + 1] * il); w.y = pk2(o[8 * i + 2] * il, o[8 * i + 3] * il); w.z = pk2(o[8 * i + 4] * il, o[8 * i + 5] * il); w.w = pk2(o[8 * i + 6] * il, o[8 * i + 7] * il); *(u32x4*)(qrow + 8 * i) = w; } }
    }
    __syncthreads();
}
__device__ __forceinline__ void cmlp_simple(const Params& p, const Ctx& c, int l) {
    LAS float* Vt = (LAS float*)c.lds;
    LAS float* rs = Vt + 128 * 128;
    const bf16_t* cv = (const bf16_t*)(p.ws + Z_CV); bf16_t* cu = (bf16_t*)(p.ws + Z_CU);
    for (int u = c.bx; u < NCHUNK * 4; u += c.G) {
        const int ch = u >> 2, g = u & 3; const size_t R0 = (size_t)ch * 128;
        __syncthreads();
        { const int q = c.tid >> 2, part = c.tid & 3; float ss = 0.f;
            const bf16_t* r = cv + (R0 + q) * RW + part * 128;
#pragma unroll
            for (int i = 0; i < 16; ++i) { const u32x4 w = *(const u32x4*)(r + 8 * i); const float a0 = bflo(w.x), a1 = bfhi(w.x), a2 = bflo(w.y), a3 = bfhi(w.y), a4 = bflo(w.z), a5 = bfhi(w.z), a6 = bflo(w.w), a7 = bfhi(w.w);
                ss += (a0 * a0 + a1 * a1) + (a2 * a2 + a3 * a3) + (a4 * a4 + a5 * a5) + (a6 * a6 + a7 * a7); }
            ss += __shfl_xor(ss, 1); ss += __shfl_xor(ss, 2);
            if (part == 0) rs[q] = rsqrtf(ss * (1.f / RW) + EPS); }
        __syncthreads();
        for (int e = c.tid; e < 128 * 128 / 8; e += 512) { const int q = e >> 4, c8 = (e & 15) * 8; const float r = rs[q];
            const u32x4 w = *(const u32x4*)(cv + (R0 + q) * RW + g * 128 + c8);
            *(LAS f32x4*)(Vt + q * 128 + c8) = (f32x4){bflo(w.x) * r, bfhi(w.x) * r, bflo(w.y) * r, bfhi(w.y) * r};
            *(LAS f32x4*)(Vt + q * 128 + c8 + 4) = (f32x4){bflo(w.z) * r, bfhi(w.z) * r, bflo(w.w) * r, bfhi(w.w) * r}; }
        __syncthreads();
        const int cc = c.tid & 127, pg = __builtin_amdgcn_readfirstlane(c.tid >> 7);
        const float* Ws = p.in[I_CMWS] + ((size_t)(l * 4 + g) * 128) * 128; const float* bs = p.in[I_CMBS] + (l * 4 + g) * 128;
        const float gn = p.in[I_CMNORM][l * RW + g * 128 + cc];
        for (int pi = 0; pi < 32; ++pi) { const int pr = pg * 32 + pi; const float* wrow = Ws + pr * 128; float a = 0.f;
#pragma unroll 8
            for (int q = 0; q < 128; ++q) a += wrow[q] * Vt[q * 128 + cc];
            bf16_t* up = cu + (R0 + pr) * RW + g * 128 + cc;
            const float uu = bf2f(*up);
            *up = (bf16_t)f2bf(uu * (gn * a + bs[pr])); }
    }
    __syncthreads();
}
__device__ __forceinline__ float ret_ld(const Params& p, int l, int dir, int h) { const float x = p.in[I_DECAY][(l * 2 + dir) * NH + h]; return -log1pf(__expf(x)); }
__device__ __forceinline__ void retU_simple(const Params& p, const Ctx& c, int l) {
    LAS float* Kt = (LAS float*)c.lds; LAS float* Vt = Kt + 128 * 64; LAS float* wf = Vt + 128 * 64; LAS float* wb = wf + 128;
    float* U = (float*)(p.ws + Z_U);
    for (int u = c.bx; u < NCHUNK * NH; u += c.G) {
        const int ch = u >> 3, h = u & 7; const size_t R0 = (size_t)ch * 128;
        const float ldf = ret_ld(p, l, 0, h), ldb = ret_ld(p, l, 1, h);
        __syncthreads();
        if (c.tid < 128) { wf[c.tid] = __expf(ldf * (float)(127 - c.tid)); wb[c.tid] = __expf(ldb * (float)c.tid); }
        for (int e = c.tid; e < 128 * 64 / 8; e += 512) { const int j = e >> 3, d8 = (e & 7) * 8;
            const u32x4 kw = *(const u32x4*)((const bf16_t*)(p.ws + Z_RK) + (R0 + j) * RW + h * HD + d8), vw = *(const u32x4*)((const bf16_t*)(p.ws + Z_RV) + (R0 + j) * RW + h * HD + d8);
            *(LAS f32x4*)(Kt + j * 64 + d8) = (f32x4){bflo(kw.x), bfhi(kw.x), bflo(kw.y), bfhi(kw.y)}; *(LAS f32x4*)(Kt + j * 64 + d8 + 4) = (f32x4){bflo(kw.z), bfhi(kw.z), bflo(kw.w), bfhi(kw.w)};
            *(LAS f32x4*)(Vt + j * 64 + d8) = (f32x4){bflo(vw.x), bfhi(vw.x), bflo(vw.y), bfhi(vw.y)}; *(LAS f32x4*)(Vt + j * 64 + d8 + 4) = (f32x4){bflo(vw.z), bfhi(vw.z), bflo(vw.w), bfhi(vw.w)}; }
        __syncthreads();
        const int e = c.tid & 63, d0 = __builtin_amdgcn_readfirstlane(c.tid >> 6) * 8;
        float uf[8], ub[8];
#pragma unroll
        for (int i = 0; i < 8; ++i) { uf[i] = 0.f; ub[i] = 0.f; }
        for (int j = 0; j < 128; ++j) { const float v = Vt[j * 64 + e], vf = v * wf[j], vb = v * wb[j];
            const f32x4 k0 = *(const LAS f32x4*)(Kt + j * 64 + d0), k1 = *(const LAS f32x4*)(Kt + j * 64 + d0 + 4);
            uf[0] += k0.x * vf; uf[1] += k0.y * vf; uf[2] += k0.z * vf; uf[3] += k0.w * vf; uf[4] += k1.x * vf; uf[5] += k1.y * vf; uf[6] += k1.z * vf; uf[7] += k1.w * vf;
            ub[0] += k0.x * vb; ub[1] += k0.y * vb; ub[2] += k0.z * vb; ub[3] += k0.w * vb; ub[4] += k1.x * vb; ub[5] += k1.y * vb; ub[6] += k1.z * vb; ub[7] += k1.w * vb; }
        float* Uf = U + ((size_t)(0 * NCHUNK + ch) * NH + h) * 4096, *Ub = U + ((size_t)(1 * NCHUNK + ch) * NH + h) * 4096;
#pragma unroll
        for (int i = 0; i < 8; ++i) { Uf[(d0 + i) * 64 + e] = uf[i]; Ub[(d0 + i) * 64 + e] = ub[i]; }
    }
    __syncthreads();
}
__device__ __forceinline__ void retO_simple(const Params& p, const Ctx& c, int l) {
    LAS float* Kt = (LAS float*)c.lds; LAS float* Vt = Kt + 128 * 64; LAS float* Sf = Vt + 128 * 64; LAS float* Sb = Sf + 4096; LAS float* pf = Sb + 4096; LAS float* pb = pf + 132;
    const float* U = (const float*)(p.ws + Z_U);
    for (int u = c.bx; u < NCHUNK * NH; u += c.G) {
        const int ch = u >> 3, h = u & 7; const size_t R0 = (size_t)ch * 128; const bool smp = ch >= MP / 128;
        const int nc = smp ? 16 : 2, ch0 = smp ? (MP / 128 + ((ch - MP / 128) & ~15)) : (ch & ~1), cidx = ch - ch0, b = smp ? (ch - MP / 128) >> 4 : ch >> 1;
        const float ldf = ret_ld(p, l, 0, h), ldb = ret_ld(p, l, 1, h); const float Gf = __expf(128.f * ldf), Gb = __expf(128.f * ldb);
        __syncthreads();
        if (c.tid <= 128) { pf[c.tid] = __expf(ldf * (float)c.tid); pb[c.tid] = __expf(ldb * (float)c.tid); }
        for (int e = c.tid; e < 128 * 64 / 8; e += 512) { const int j = e >> 3, d8 = (e & 7) * 8;
            const u32x4 kw = *(const u32x4*)((const bf16_t*)(p.ws + Z_RK) + (R0 + j) * RW + h * HD + d8), vw = *(const u32x4*)((const bf16_t*)(p.ws + Z_RV) + (R0 + j) * RW + h * HD + d8);
            *(LAS f32x4*)(Kt + j * 64 + d8) = (f32x4){bflo(kw.x), bfhi(kw.x), bflo(kw.y), bfhi(kw.y)}; *(LAS f32x4*)(Kt + j * 64 + d8 + 4) = (f32x4){bflo(kw.z), bfhi(kw.z), bflo(kw.w), bfhi(kw.w)};
            *(LAS f32x4*)(Vt + j * 64 + d8) = (f32x4){bflo(vw.x), bfhi(vw.x), bflo(vw.y), bfhi(vw.y)}; *(LAS f32x4*)(Vt + j * 64 + d8 + 4) = (f32x4){bflo(vw.z), bfhi(vw.z), bflo(vw.w), bfhi(vw.w)}; }
        {
            float sf[8], sb[8]; const int e0 = c.tid * 8;
            if (smp) { const float* s0 = p.in[I_ST] + ((size_t)((b * 2 + l) * 2 + 0) * NH + h) * 4096 + e0; const float* s1 = p.in[I_ST] + ((size_t)((b * 2 + l) * 2 + 1) * NH + h) * 4096 + e0;
#pragma unroll
                for (int i = 0; i < 8; ++i) { sf[i] = s0[i]; sb[i] = s1[i]; } }
            else {
#pragma unroll
                for (int i = 0; i < 8; ++i) { sf[i] = 0.f; sb[i] = 0.f; } }
            for (int cc = 0; cc < cidx; ++cc) { const float* uf = U + ((size_t)(0 * NCHUNK + ch0 + cc) * NH + h) * 4096 + e0;
#pragma unroll
                for (int i = 0; i < 8; ++i) sf[i] = Gf * sf[i] + uf[i]; }
            for (int cc = nc - 1; cc > cidx; --cc) { const float* ub = U + ((size_t)(1 * NCHUNK + ch0 + cc) * NH + h) * 4096 + e0;
#pragma unroll
                for (int i = 0; i < 8; ++i) sb[i] = Gb * sb[i] + ub[i]; }
#pragma unroll
            for (int i = 0; i < 8; ++i) { Sf[e0 + i] = sf[i]; Sb[e0 + i] = sb[i]; }
            if (!smp && cidx == nc - 1) { const float* uf = U + ((size_t)(0 * NCHUNK + ch) * NH + h) * 4096 + e0; float* o = p.out + OUT_ST + ((size_t)((b * 2 + l) * 2 + 0) * NH + h) * 4096 + e0;
#pragma unroll
                for (int i = 0; i < 8; ++i) o[i] = Gf * sf[i] + uf[i]; }
            if (!smp && cidx == 0) { const float* ub = U + ((size_t)(1 * NCHUNK + ch) * NH + h) * 4096 + e0; float* o = p.out + OUT_ST + ((size_t)((b * 2 + l) * 2 + 1) * NH + h) * 4096 + e0;
#pragma unroll
                for (int i = 0; i < 8; ++i) o[i] = Gb * sb[i] + ub[i]; }
        }
        __syncthreads();
        const int i = c.tid >> 2, part = c.tid & 3;
        float qp[16], o[16];
        { const bf16_t* qr = (const bf16_t*)(p.ws + Z_RQ) + (R0 + i) * RW + h * HD + part * 16; const u32x4 w0 = *(const u32x4*)qr, w1 = *(const u32x4*)(qr + 8);
            qp[0] = bflo(w0.x); qp[1] = bfhi(w0.x); qp[2] = bflo(w0.y); qp[3] = bfhi(w0.y); qp[4] = bflo(w0.z); qp[5] = bfhi(w0.z); qp[6] = bflo(w0.w); qp[7] = bfhi(w0.w);
            qp[8] = bflo(w1.x); qp[9] = bfhi(w1.x); qp[10] = bflo(w1.y); qp[11] = bfhi(w1.y); qp[12] = bflo(w1.z); qp[13] = bfhi(w1.z); qp[14] = bflo(w1.w); qp[15] = bfhi(w1.w); }
#pragma unroll
        for (int e = 0; e < 16; ++e) o[e] = 0.f;
#pragma unroll 1
        for (int j = 0; j < 128; ++j) { float s = 0.f;
#pragma unroll
            for (int d4 = 0; d4 < 4; ++d4) { const f32x4 kv = *(const LAS f32x4*)(Kt + j * 64 + part * 16 + 4 * d4); s += qp[4 * d4] * kv.x + qp[4 * d4 + 1] * kv.y + qp[4 * d4 + 2] * kv.z + qp[4 * d4 + 3] * kv.w; }
            s += __shfl_xor(s, 1); s += __shfl_xor(s, 2);
            const float w = j < i ? pf[i - j] : (j > i ? pb[j - i] : 2.0f);
            s *= w;
#pragma unroll
            for (int e4 = 0; e4 < 4; ++e4) { const f32x4 vv = *(const LAS f32x4*)(Vt + j * 64 + part * 16 + 4 * e4); o[4 * e4] += s * vv.x; o[4 * e4 + 1] += s * vv.y; o[4 * e4 + 2] += s * vv.z; o[4 * e4 + 3] += s * vv.w; } }
        { const float xf = pf[i + 1], xb = pb[128 - i]; const bf16_t* qfull = (const bf16_t*)(p.ws + Z_RQ) + (R0 + i) * RW + h * HD;
#pragma unroll 2
            for (int d = 0; d < 64; ++d) { const float qd = bf2f(qfull[d]); const float af = qd * xf, ab = qd * xb;
#pragma unroll
                for (int e4 = 0; e4 < 4; ++e4) { const f32x4 a = *(const LAS f32x4*)(Sf + d * 64 + part * 16 + 4 * e4), bb = *(const LAS f32x4*)(Sb + d * 64 + part * 16 + 4 * e4);
                    o[4 * e4] += af * a.x + ab * bb.x; o[4 * e4 + 1] += af * a.y + ab * bb.y; o[4 * e4 + 2] += af * a.z + ab * bb.z; o[4 * e4 + 3] += af * a.w + ab * bb.w; } } }
        float s1 = 0.f;
#pragma unroll
        for (int e = 0; e < 16; ++e) s1 += o[e];
        s1 += __shfl_xor(s1, 1); s1 += __shfl_xor(s1, 2); const float mu = s1 * (1.f / 64.f);
        float s2 = 0.f;
#pragma unroll
        for (int e = 0; e < 16; ++e) { const float d = o[e] - mu; s2 += d * d; }
        s2 += __shfl_xor(s2, 1); s2 += __shfl_xor(s2, 2); const float rstd = rsqrtf(s2 * (1.f / 64.f) + EPS);
        const float* gn = p.in[I_RETGN] + l * RW + h * HD + part * 16;
        const bf16_t* rg = (const bf16_t*)(p.ws + Z_RG) + (R0 + i) * RW + h * HD + part * 16; const u32x4 g0 = *(const u32x4*)rg, g1 = *(const u32x4*)(rg + 8);
        float gs[16] = {bflo(g0.x), bfhi(g0.x), bflo(g0.y), bfhi(g0.y), bflo(g0.z), bfhi(g0.z), bflo(g0.w), bfhi(g0.w), bflo(g1.x), bfhi(g1.x), bflo(g1.y), bfhi(g1.y), bflo(g1.z), bfhi(g1.z), bflo(g1.w), bfhi(g1.w)};
        float y[16];
#pragma unroll
        for (int e = 0; e < 16; ++e) y[e] = (o[e] - mu) * rstd * gn[e] * gs[e];
        bf16_t* dst = (bf16_t*)(p.ws + Z_CV) + (R0 + i) * RW + h * HD + part * 16;
        u32x4 w0, w1; w0.x = pk2(y[0], y[1]); w0.y = pk2(y[2], y[3]); w0.z = pk2(y[4], y[5]); w0.w = pk2(y[6], y[7]); w1.x = pk2(y[8], y[9]); w1.y = pk2(y[10], y[11]); w1.z = pk2(y[12], y[13]); w1.w = pk2(y[14], y[15]);
        *(u32x4*)dst = w0; *(u32x4*)(dst + 8) = w1;
    }
    __syncthreads();
}

constexpr int NPHASE = 22;
template <int KIND> __device__ __forceinline__ void run_kind(const Params& p, const Ctx& c, int l) {
    const unsigned char* wb = p.ws + WS_W;
    if constexpr (KIND == 0) { p0_modulation(p, c); p0_rope_tables(p, c); p_wconv(p, c, 0); p_kvctx(p, c, 0); }
    else if constexpr (KIND == 1) { p_norm(p, c, 0, 0); }
    else if constexpr (KIND == 2) { StaticOrder S; S.init(M, NMIX, c.G, c.bx); EpiMix E{&p, l}; gemm_simple((const bf16_t*)(p.ws + WS_XN), (const bf16_t*)(wb + W_IN), DM, S, E); }
    else if constexpr (KIND == 3) { attn_simple(p, c); cmlp_simple(p, c, l); retU_simple(p, c, l); }
    else if constexpr (KIND == 4) { retO_simple(p, c, l); }
    else if constexpr (KIND == 5) { StaticOrder S; S.init(M, NGATE, c.G, c.bx); EpiGate E{&p}; gemm_simple((const bf16_t*)(p.ws + WS_XN), (const bf16_t*)(wb + W_IN) + (size_t)NMIX * DM, DM, S, E); }
    else if constexpr (KIND == 6) { MergeOrder S{c.G, c.bx}; EpiMerge E{&p}; gemm_simple((const bf16_t*)(p.ws + Z_AQ), (const bf16_t*)(wb + W_BR), RW, S, E); }
    else if constexpr (KIND == 7) { StaticOrder S; S.init(M, DM, c.G, c.bx); EpiRes E{&p, l, 2, l == 0}; gemm_simple((const bf16_t*)(p.ws + WS_XN), (const bf16_t*)(wb + W_OUT), DM, S, E); }
    else if constexpr (KIND == 8) { p_norm(p, c, l, 1); }
    else if constexpr (KIND == 9) { StaticOrder S; S.init(M, DFF, c.G, c.bx); EpiFF1 E{&p}; gemm_simple((const bf16_t*)(p.ws + WS_XN), (const bf16_t*)(wb + W_FF1), DM, S, E); }
    else if constexpr (KIND == 10) { StaticOrder S; S.init(M, DM, c.G, c.bx); EpiRes E{&p, l, 5, false}; gemm_simple((const bf16_t*)(p.ws + Z_HB), (const bf16_t*)(wb + W_FF2), DFF, S, E); }
    else { if (l == 0) { p_wconv(p, c, 1); p_kvctx(p, c, 1); p_norm(p, c, 1, 0); } else p_final_norm(p, c); }
}
__device__ __forceinline__ void run_phase(const Params& p, const Ctx& c, int ph) {
    if (ph == 0) { run_kind<0>(p, c, 0); return; }
    if (ph == 1) { run_kind<1>(p, c, 0); return; }
    const int l = (ph - 2) / 10, s = (ph - 2) % 10;
    switch (s) {
    case 0: run_kind<2>(p, c, l); break;
    case 1: run_kind<3>(p, c, l); break;
    case 2: run_kind<4>(p, c, l); break;
    case 3: run_kind<5>(p, c, l); break;
    case 4: run_kind<6>(p, c, l); break;
    case 5: run_kind<7>(p, c, l); break;
    case 6: run_kind<8>(p, c, l); break;
    case 7: run_kind<9>(p, c, l); break;
    case 8: run_kind<10>(p, c, l); break;
    default: run_kind<11>(p, c, l); break;
    }
}

#if N_LAUNCH_MODE == 1
__global__ void __launch_bounds__(512, 2) fwd_kernel(Params p) {
    extern __shared__ __attribute__((aligned(16))) unsigned char lds[];
    Ctx c; c.tid = threadIdx.x; c.lane = c.tid & 63; c.wave = __builtin_amdgcn_readfirstlane(c.tid >> 6); c.G = gridDim.x; c.bx = blockIdx.x; c.lds = (LAS unsigned char*)lds;
    volatile LAS unsigned* MISC = (volatile LAS unsigned*)(c.lds + MISC_OFF);
    if (c.tid < 32) MISC[c.tid] = 0u;
    __syncthreads();
    XcdBarrier bar = xcd_barrier_post((unsigned*)(p.ws + WS_CTL) + CW_BAR, MISC + 8);
    for (int ph = p.ph_lo; ph < p.ph_hi; ++ph) { run_phase(p, c, ph); if (ph + 1 < p.ph_hi) xcd_barrier(bar); }
}
#endif
template <int KIND> __global__ void __launch_bounds__(512, 2) phase_kernel(Params p) {
    extern __shared__ __attribute__((aligned(16))) unsigned char lds[];
    Ctx c; c.tid = threadIdx.x; c.lane = c.tid & 63; c.wave = __builtin_amdgcn_readfirstlane(c.tid >> 6); c.G = gridDim.x; c.bx = blockIdx.x; c.lds = (LAS unsigned char*)lds;
    run_kind<KIND>(p, c, p.ph_hi);
}
template <int KIND> static void launch_kind(Params p, int l, int grid, hipStream_t stream) {
    static bool attr = false;
    if (!attr) { (void)hipFuncSetAttribute((const void*)phase_kernel<KIND>, hipFuncAttributeMaxDynamicSharedMemorySize, LDS_BYTES); attr = true; }
    p.ph_lo = 0; p.ph_hi = l;
    hipLaunchKernelGGL(phase_kernel<KIND>, dim3(grid), dim3(512), LDS_BYTES, stream, p);
}

extern "C" void kernel_launch(void* const* d_in, const int* in_sizes, int n_in, void* d_out, int out_size, void* d_ws, size_t ws_size, hipStream_t stream) {
    static int grid = 0;
    if (grid == 0) {
        int dev = 0, cus = 0;
        if (n_in != N_IN || ws_size < WS_NEED) { grid = -1; return; }
        if (hipGetDevice(&dev) != hipSuccess || hipDeviceGetAttribute(&cus, hipDeviceAttributeMultiprocessorCount, dev) != hipSuccess) { grid = -1; return; }
#if N_LAUNCH_MODE == 1
        if (hipFuncSetAttribute((const void*)fwd_kernel, hipFuncAttributeMaxDynamicSharedMemorySize, LDS_BYTES) != hipSuccess) { grid = -1; return; }
#endif
        grid = cus;
    }
    if (grid < 0) return;
    (void)hipMemsetAsync((char*)d_ws + WS_CTL, 0, WS_ZERO_BYTES, stream);
    Params p{};
    for (int i = 0; i < N_IN; ++i) p.in[i] = (const float*)d_in[i];
    p.out = (float*)d_out; p.ws = (unsigned char*)d_ws;
#if N_LAUNCH_MODE == 1
    p.ph_lo = 0; p.ph_hi = NPHASE;
    hipLaunchKernelGGL(fwd_kernel, dim3(grid), dim3(512), LDS_BYTES, stream, p);
#else
    launch_kind<0>(p, 0, grid, stream); launch_kind<1>(p, 0, grid, stream);
    for (int l = 0; l < 2; ++l) {
        launch_kind<2>(p, l, grid, stream); launch_kind<3>(p, l, grid, stream); launch_kind<4>(p, l, grid, stream); launch_kind<5>(p, l, grid, stream); launch_kind<6>(p, l, grid, stream);
        launch_kind<7>(p, l, grid, stream); launch_kind<8>(p, l, grid, stream); launch_kind<9>(p, l, grid, stream); launch_kind<10>(p, l, grid, stream); launch_kind<11>(p, l, grid, stream);
    }
#endif
}
```

```cpp
#include <hip/hip_runtime.h>
#include <cstdio>
#include <cstdint>

#ifndef N_LAUNCH_MODE
#define N_LAUNCH_MODE 1
#endif

#define GAS __attribute__((address_space(1)))
#define LAS __attribute__((address_space(3)))
#define RLX_AGENT __ATOMIC_RELAXED, __HIP_MEMORY_SCOPE_AGENT
typedef unsigned short bf16_t;
typedef short bf16x8 __attribute__((ext_vector_type(8)));
typedef float f32x4 __attribute__((ext_vector_type(4)));
typedef float f32x2 __attribute__((ext_vector_type(2)));
typedef unsigned u32x4 __attribute__((ext_vector_type(4)));
typedef unsigned u32x2 __attribute__((ext_vector_type(2)));

constexpr int DM = 1024, MP = 4096, MS = 16384, M = 20480, SEQ_P = 256, SEQ_S = 2048, NB_P = 16, NB_S = 8, PAST = 256;
constexpr int HD = 64, NH = 8, KVW = 128, DFF = 4096, INW = 6912, NMIX = 3840, NGATE = 3072, RW = 512;
constexpr int SKV_S = PAST + SEQ_S, SKV_P = SEQ_P;
constexpr int NCHUNK = M / 128;
constexpr float EPS = 1e-6f;
constexpr float C2 = 0.18033688011112042f;
constexpr size_t OUT_Y = 0, OUT_CK = (size_t)M * DM, OUT_CV = OUT_CK + (size_t)NB_P * 2 * SEQ_P * KVW, OUT_ST = OUT_CV + (size_t)NB_P * 2 * SEQ_P * KVW;

constexpr size_t MiB = 1u << 20;
constexpr size_t WS_CTL = 0;
constexpr size_t WS_MOD = 1 * MiB;
constexpr size_t WS_ROPE = 1 * MiB + 512 * 1024;
constexpr size_t WS_ZERO_BYTES = 1 * MiB + 512 * 1024;
constexpr size_t WS_W = 2 * MiB;
constexpr size_t W_IN = 0, W_BR = W_IN + (size_t)INW * DM * 2, W_OUT = W_BR + (size_t)3 * DM * RW * 2, W_FF1 = W_OUT + (size_t)DM * DM * 2, W_FF2 = W_FF1 + (size_t)DFF * DM * 2, W_END = W_FF2 + (size_t)DM * DFF * 2;
static_assert(W_END <= 35 * MiB, "weights");
constexpr size_t WS_XN = 37 * MiB;
constexpr size_t WS_Z = 77 * MiB;
constexpr size_t Z_RQ = WS_Z, Z_RK = WS_Z + 20 * MiB, Z_RV = WS_Z + 40 * MiB, Z_RG = WS_Z + 60 * MiB, Z_U = WS_Z + 80 * MiB;
constexpr size_t Z_AQ = WS_Z + 120 * MiB, Z_CU = WS_Z + 140 * MiB, Z_CV = WS_Z + 160 * MiB;
constexpr size_t Z_KS = WS_Z + 180 * MiB, Z_VS = Z_KS + (size_t)NB_S * SKV_S * KVW * 2, Z_KP = Z_VS + (size_t)NB_S * SKV_S * KVW * 2, Z_VP = Z_KP + (size_t)NB_P * SEQ_P * KVW * 2, Z_END = Z_VP + (size_t)NB_P * SEQ_P * KVW * 2;
constexpr size_t Z_GATE = WS_Z;
constexpr size_t Z_HB = WS_Z;
constexpr size_t WS_NEED = 268 * MiB;
static_assert(Z_END <= WS_NEED, "ws map");
constexpr int CW_BAR = 4096;

constexpr int LDS_BYTES = 147456;
constexpr int MISC_OFF = 131072 + 320;

__device__ __forceinline__ unsigned f2bf(float f) { unsigned u = __builtin_bit_cast(unsigned, f); return (u + 0x7fffu + ((u >> 16) & 1u)) >> 16; }
__device__ __forceinline__ unsigned pk2(float lo, float hi) { return f2bf(lo) | (f2bf(hi) << 16); }
__device__ __forceinline__ float bf2f(unsigned h) { return __builtin_bit_cast(float, h << 16); }
__device__ __forceinline__ float bflo(unsigned w) { return __builtin_bit_cast(float, w << 16); }
__device__ __forceinline__ float bfhi(unsigned w) { return __builtin_bit_cast(float, w & 0xffff0000u); }
__device__ __forceinline__ float sigmoidf_(float x) { return 1.f / (1.f + __expf(-x)); }
__device__ __forceinline__ float siluf_(float x) { return x / (1.f + __expf(-x)); }
__device__ __forceinline__ float gelu_tanh(float x) { const float u = 0.7978845608028654f * (x + 0.044715f * x * x * x); const float e = __expf(2.f * u); const float th = 1.f - 2.f / (e + 1.f); return 0.5f * x * (1.f + th); }
__device__ __forceinline__ float wave_sum(float v) {
#pragma unroll
    for (int o = 1; o < 64; o <<= 1) v += __shfl_xor(v, o);
    return v;
}

#define XB_TMO      128
#define XB_XCNT(j)  (256  + 64 * (j))
#define XB_XSUB(j)  (1280 + 64 * (j))
#define XB_XGEN(j)  (2304 + 64 * (j))
#define XB_TOP      3328
#define XB_TOPGEN   3392
#define XCD_BAR_WORDS 3456
#define XB_SPIN_CAP (1u << 18)
__device__ __forceinline__ unsigned xb_ld(unsigned* p)              { return __hip_atomic_load(p, __ATOMIC_RELAXED, __HIP_MEMORY_SCOPE_AGENT); }
__device__ __forceinline__ unsigned xb_add(unsigned* p, unsigned v) { return __hip_atomic_fetch_add(p, v, __ATOMIC_RELAXED, __HIP_MEMORY_SCOPE_AGENT); }
__device__ __forceinline__ unsigned xb_xcc_id() { return (unsigned)__builtin_amdgcn_s_getreg((3 << 11) | 20) & 0xFu; }
#define XB_SPIN(cond, bar) do { unsigned _sp = 0; while (cond) { __builtin_amdgcn_s_sleep(1); \
    if ((++_sp & 255u) == 0u) { if (xb_ld(&(bar)[XB_TMO])) break; if (_sp > XB_SPIN_CAP) { atomicAdd(&(bar)[XB_TMO], 1u); break; } } } } while (0)
struct XcdBarrier { unsigned* bar; unsigned x; volatile LAS unsigned* st; };
__device__ __forceinline__ XcdBarrier xcd_barrier_post(unsigned* bar, volatile LAS unsigned* st) {
    XcdBarrier b; b.bar = bar; b.x = xb_xcc_id(); b.st = st;
    if (threadIdx.x == 0) (void)xb_add(&bar[XB_XCNT(b.x)], 1u);
    return b;
}
__device__ __forceinline__ void xcd_barrier_complete(unsigned* bar, unsigned x, unsigned& nloc, unsigned& nx) {
    const unsigned G = gridDim.x * gridDim.y * gridDim.z;
    unsigned sum, cnt, mine, sp = 0u;
    for (;;) {
        sum = 0u; cnt = 0u; mine = 0u;
#pragma unroll
        for (unsigned j = 0; j < 16; ++j) { const unsigned c = xb_ld(&bar[XB_XCNT(j)]); sum += c; cnt += (c > 0u) ? 1u : 0u; mine = (j == x) ? c : mine; }
        if (sum == G) break;
        __builtin_amdgcn_s_sleep(1);
        if ((++sp & 255u) == 0u) { if (xb_ld(&bar[XB_TMO])) break; if (sp > XB_SPIN_CAP) { atomicAdd(&bar[XB_TMO], 1u); break; } }
    }
    nloc = mine > 0u ? mine : 1u; nx = cnt > 0u ? cnt : 1u;
}
__device__ __forceinline__ void xcd_barrier(const XcdBarrier& b) {
    asm volatile("s_waitcnt vmcnt(0)" ::: "memory");
    __syncthreads();
    if (threadIdx.x == 0) {
        unsigned* bar = b.bar;
        __builtin_amdgcn_s_waitcnt(0);
        unsigned nloc = b.st[0], nx = b.st[1];
        if (nloc == 0u) { xcd_barrier_complete(bar, b.x, nloc, nx); b.st[0] = nloc; b.st[1] = nx; }
        const unsigned old = xb_add(&bar[XB_XSUB(b.x)], 1u);
        const unsigned gen = old / nloc;
        if (old + 1u == (gen + 1u) * nloc) {
            __builtin_amdgcn_fence(__ATOMIC_RELEASE, "agent");
            asm volatile("s_waitcnt vmcnt(0)" ::: "memory");
            const unsigned og = xb_add(&bar[XB_TOP], 1u);
            const unsigned tg = og / nx;
            if (og + 1u == (tg + 1u) * nx) xb_add(&bar[XB_TOPGEN], 1u);
            else XB_SPIN(xb_ld(&bar[XB_TOPGEN]) == tg, bar);
            __builtin_amdgcn_fence(__ATOMIC_ACQUIRE, "agent");
            xb_add(&bar[XB_XGEN(b.x)], 1u);
            asm volatile("s_waitcnt vmcnt(0)" ::: "memory");
        } else {
            XB_SPIN(xb_ld(&bar[XB_XGEN(b.x)]) == gen, bar);
            __builtin_amdgcn_fence(__ATOMIC_ACQUIRE, "agent");
            asm volatile("s_waitcnt vmcnt(0)" ::: "memory");
        }
    }
    __syncthreads();
}

enum { I_XP = 0, I_XS, I_CK, I_CV, I_ST, I_C, I_CCTX, I_WMOD, I_BMOD, I_GN1, I_GN2, I_WIN, I_GQ, I_GK, I_DECAY, I_RETGN, I_CMNORM, I_CMWS, I_CMBS, I_WBRR, I_WBRA, I_WBRC, I_WOUT, I_WFF1, I_WFF2, I_GFIN, N_IN };
struct Params { const float* in[N_IN]; float* out; unsigned char* ws; int ph_lo, ph_hi; };
static_assert(sizeof(Params) == N_IN * 8 + 8 + 8 + 8, "no padding");

struct Ctx {
    int tid, lane, wave, G, bx;
    LAS unsigned char* lds;
};
__device__ __forceinline__ int row_ci(int R) { return R < MP ? 0 : 1 + ((R - MP) >> 11); }
__device__ __forceinline__ const float* mod_ptr(const Params& p, int l, int ci, int part) { return (const float*)(p.ws + WS_MOD) + ((size_t)(l * 9 + ci) * 6 + part) * DM; }

__device__ __forceinline__ void p0_modulation(const Params& p, const Ctx& c) {
    LAS float* sl = (LAS float*)c.lds;
    for (int i = c.tid; i < 9 * DM; i += 512) { const int ci = i >> 10, k = i & 1023; const float v = ci == 0 ? p.in[I_CCTX][k] : p.in[I_C][(ci - 1) * DM + k]; sl[i] = siluf_(v); }
    __syncthreads();
    float* mod = (float*)(p.ws + WS_MOD);
    const int gw = c.bx * 8 + c.wave, NGW = c.G * 8;
    constexpr int NITEM = 2 * 96 * 8;
    for (int it = gw; it < NITEM; it += NGW) {
        const int l = it / 768, r = it % 768, cb = r >> 3, ks = r & 7;
        const float* W = p.in[I_WMOD] + (size_t)l * DM * 6144 + (size_t)(ks * 128) * 6144 + cb * 64 + c.lane;
        float s[9];
#pragma unroll
        for (int ci = 0; ci < 9; ++ci) s[ci] = 0.f;
#pragma unroll 4
        for (int k = 0; k < 128; ++k) {
            const float w = W[(size_t)k * 6144];
#pragma unroll
            for (int ci = 0; ci < 9; ++ci) s[ci] += sl[ci * DM + ks * 128 + k] * w;
        }
        const float bias = ks == 0 ? p.in[I_BMOD][l * 6144 + cb * 64 + c.lane] : 0.f;
#pragma unroll
        for (int ci = 0; ci < 9; ++ci) atomicAdd(mod + (size_t)(l * 9 + ci) * 6144 + cb * 64 + c.lane, s[ci] + bias);
    }
    __syncthreads();
}
__device__ __forceinline__ void p0_rope_tables(const Params& p, const Ctx& c) {
    f32x2* tab = (f32x2*)(p.ws + WS_ROPE);
    const int g = c.bx * 512 + c.tid;
    if (g < 96 * 16) { const int pos = g >> 4, i = g & 15; const float inv = 1.0f / powf(10000.0f, (float)(2 * i) / 32.0f); const float posf = pos < 32 ? (float)pos : (float)(pos - 32);
        const float ang = posf * inv; f32x2 v; v.x = cosf(ang); v.y = sinf(ang); tab[g] = v; }
}
__device__ __forceinline__ int win_colmap(int n) {
    const int tile = n >> 8, pp = n & 255, bj = pp >> 7, wc = (pp >> 5) & 3;
    if (tile < 10) return (tile >> 1) * 512 + ((tile & 1) * 4 + wc) * 64 + 32 * bj;
    if (tile == 10) return (wc < 2 ? 2560 + wc * 64 : 2688 + (wc - 2) * 64) + 32 * bj;
    return n;
}
__device__ __forceinline__ void transpose_item(const float* W, int K, int ldn, int src_col0, bf16_t* WT, int dst_row0, int k0, LAS float* scr, int lane) {
#pragma unroll 8
    for (int i = 0; i < 32; ++i) { const int kk = 2 * i + (lane >> 5); scr[kk * 33 + (lane & 31)] = W[(size_t)(k0 + kk) * ldn + src_col0 + (lane & 31)]; }
    asm volatile("s_waitcnt lgkmcnt(0)" ::: "memory");
    const int ch = lane & 7;
#pragma unroll
    for (int j = 0; j < 4; ++j) { const int n = (lane >> 3) + 8 * j; const LAS float* s = scr + (8 * ch) * 33 + n;
        u32x4 o; o.x = pk2(s[0 * 33], s[1 * 33]); o.y = pk2(s[2 * 33], s[3 * 33]); o.z = pk2(s[4 * 33], s[5 * 33]); o.w = pk2(s[6 * 33], s[7 * 33]);
        *(u32x4*)(WT + (size_t)(dst_row0 + n) * K + k0 + 8 * ch) = o; }
    asm volatile("s_waitcnt lgkmcnt(0)" ::: "memory");
}
__device__ __forceinline__ void p_wconv(const Params& p, const Ctx& c, int l) {
    LAS float* scr = (LAS float*)(c.lds + 40960 + c.wave * 8448);
    const int gw = c.bx * 8 + c.wave, NGW = c.G * 8;
    unsigned char* wb = p.ws + WS_W;
    constexpr int I_IN = 16 * 216, I_BRX = 8 * 32, I_O = 16 * 32, I_F1 = 16 * 128, I_F2 = 64 * 32;
    constexpr int NITEMS = I_IN + 3 * I_BRX + I_O + I_F1 + I_F2;
    for (int it = gw; it < NITEMS; it += NGW) {
        int r = it;
        if (r < I_IN) { const int kb = r / 216, nb = r % 216; transpose_item(p.in[I_WIN] + (size_t)l * DM * INW, DM, INW, win_colmap(nb * 32), (bf16_t*)(wb + W_IN), nb * 32, kb * 64, scr, c.lane); continue; } r -= I_IN;
        if (r < 3 * I_BRX) { const int x = r / I_BRX, rr = r % I_BRX, kb = rr / 32, nb = rr % 32;
            const float* src = (x == 0 ? p.in[I_WBRA] : x == 1 ? p.in[I_WBRC] : p.in[I_WBRR]) + (size_t)l * RW * DM;
            transpose_item(src, RW, DM, nb * 32, (bf16_t*)(wb + W_BR) + (size_t)x * DM * RW, nb * 32, kb * 64, scr, c.lane); continue; } r -= 3 * I_BRX;
        if (r < I_O) { const int kb = r / 32, nb = r % 32; transpose_item(p.in[I_WOUT] + (size_t)l * DM * DM, DM, DM, nb * 32, (bf16_t*)(wb + W_OUT), nb * 32, kb * 64, scr, c.lane); continue; } r -= I_O;
        if (r < I_F1) { const int kb = r / 128, nb = r % 128; transpose_item(p.in[I_WFF1] + (size_t)l * DM * DFF, DM, DFF, nb * 32, (bf16_t*)(wb + W_FF1), nb * 32, kb * 64, scr, c.lane); continue; } r -= I_F1;
        { const int kb = r / 32, nb = r % 32; transpose_item(p.in[I_WFF2] + (size_t)l * DFF * DM, DFF, DM, nb * 32, (bf16_t*)(wb + W_FF2), nb * 32, kb * 64, scr, c.lane); }
    }
}
__device__ __forceinline__ void p_kvctx(const Params& p, const Ctx& c, int l) {
    const int g = c.bx * 512 + c.tid, NG = c.G * 512;
    for (int i = g; i < NB_S * PAST * KVW / 4; i += NG) {
        const int e = i * 4, b = e / (PAST * KVW), r = e % (PAST * KVW);
        const size_t src = ((size_t)(b * 2 + l) * PAST) * KVW + r;
        const f32x4 k = *(const f32x4*)(p.in[I_CK] + src), v = *(const f32x4*)(p.in[I_CV] + src);
        u32x2 ko, vo; ko.x = pk2(k.x, k.y); ko.y = pk2(k.z, k.w); vo.x = pk2(v.x, v.y); vo.y = pk2(v.z, v.w);
        *(u32x2*)((bf16_t*)(p.ws + Z_KS) + (size_t)b * SKV_S * KVW + r) = ko;
        *(u32x2*)((bf16_t*)(p.ws + Z_VS) + (size_t)b * SKV_S * KVW + r) = vo;
    }
}
__device__ __forceinline__ const float* x_row(const Params& p, int l, int R) { return l == 0 ? (R < MP ? p.in[I_XP] + (size_t)R * DM : p.in[I_XS] + (size_t)(R - MP) * DM) : p.out + (size_t)R * DM; }
__device__ __forceinline__ void p_norm(const Params& p, const Ctx& c, int l, int which) {
    const int gw = c.bx * 8 + c.wave, NGW = c.G * 8;
    const float* gvec = (which == 0 ? p.in[I_GN1] : p.in[I_GN2]) + l * DM;
    for (int R = gw; R < M; R += NGW) {
        const float* xr = which == 0 ? x_row(p, l, R) : p.out + (size_t)R * DM;
        const int ci = row_ci(R);
        const float* sh = mod_ptr(p, l, ci, which == 0 ? 0 : 3); const float* sc = mod_ptr(p, l, ci, which == 0 ? 1 : 4);
        f32x4 v[4]; float s = 0.f;
#pragma unroll
        for (int j = 0; j < 4; ++j) { v[j] = *(const f32x4*)(xr + 4 * c.lane + 256 * j); s += (v[j].x * v[j].x + v[j].y * v[j].y) + (v[j].z * v[j].z + v[j].w * v[j].w); }
        const float rstd = rsqrtf(wave_sum(s) * (1.f / DM) + EPS);
        bf16_t* orow = (bf16_t*)(p.ws + WS_XN) + (size_t)R * DM;
#pragma unroll
        for (int j = 0; j < 4; ++j) { const int col = 4 * c.lane + 256 * j; const f32x4 g = *(const f32x4*)(gvec + col), a = *(const f32x4*)(sc + col), b = *(const f32x4*)(sh + col);
            f32x4 o = v[j] * rstd * g * (a + 1.0f) + b; u32x2 w; w.x = pk2(o.x, o.y); w.y = pk2(o.z, o.w); *(u32x2*)(orow + col) = w; }
    }
}
__device__ __forceinline__ void p_final_norm(const Params& p, const Ctx& c) {
    const int gw = c.bx * 8 + c.wave, NGW = c.G * 8;
    for (int R = gw; R < M; R += NGW) {
        float* xr = p.out + (size_t)R * DM;
        f32x4 v[4]; float s = 0.f;
#pragma unroll
        for (int j = 0; j < 4; ++j) { v[j] = *(const f32x4*)(xr + 4 * c.lane + 256 * j); s += (v[j].x * v[j].x + v[j].y * v[j].y) + (v[j].z * v[j].z + v[j].w * v[j].w); }
        const float rstd = rsqrtf(wave_sum(s) * (1.f / DM) + EPS);
#pragma unroll
        for (int j = 0; j < 4; ++j) { const int col = 4 * c.lane + 256 * j; const f32x4 g = *(const f32x4*)(p.in[I_GFIN] + col); *(f32x4*)(xr + col) = v[j] * rstd * g; }
    }
}

struct Unit { int pm, pn; };
__host__ __device__ __forceinline__ int perm32(int rho) { const int n = rho >> 4, i = rho & 15; return 8 * (i >> 2) + 4 * n + (i & 3); }
struct StaticOrder {
    int nM, nN, nwg, G, c;
    __device__ void init(int Mr, int N, int G_, int c_) { nM = Mr / 256; nN = N / 256; nwg = nM * nN; G = G_; c = c_; }
    __device__ bool next(int i, Unit& u) const {
        const long L = (long)i * G + c; if (L >= nwg) return false;
        int wgid = (int)L; { const int q = nwg / 8, r = nwg % 8, xcd = wgid % 8, off = wgid / 8; wgid = (xcd < r ? xcd * (q + 1) : r * (q + 1) + (xcd - r) * q) + off; }
        const int nig = 8 * nN, gid = wgid / nig, fm = gid * 8, gsz = (nM - fm) < 8 ? (nM - fm) : 8;
        u.pm = fm + ((wgid % nig) % gsz); u.pn = (wgid % nig) / gsz; return true;
    }
};
struct MergeOrder {
    int G, c;
    __device__ bool next(int i, Unit& u) const {
        const int t = i / 3, x = i % 3; const long L = (long)t * G + c; if (L >= 320) return false;
        u.pm = x * 80 + (int)(L >> 2); u.pn = x * 4 + (int)(L & 3); return true;
    }
};
template <class Epi, class Sched>
__device__ __forceinline__ void gemm_simple(const Ctx& c, const bf16_t* A, const bf16_t* Bt, int K, const Sched& S, const Epi& E) {
    const int tid = c.tid, wid = c.wave, lane = tid & 63, wr = wid >> 2, wc = wid & 3, fr = lane & 15, fq = lane >> 4;
    Unit u;
    for (int ui = 0; S.next(ui, u); ++ui) {
        f32x4 acc[2][2][4][2];
#pragma unroll
        for (int a = 0; a < 2; ++a)
#pragma unroll
            for (int b = 0; b < 2; ++b)
#pragma unroll
                for (int m = 0; m < 4; ++m)
#pragma unroll
                    for (int n = 0; n < 2; ++n) acc[a][b][m][n] = (f32x4){0.f, 0.f, 0.f, 0.f};
        const bf16_t* Ar = A + (size_t)(u.pm * 256 + wr * 64 + fr) * K + fq * 8;
        const bf16_t* Br[2];
#pragma unroll
        for (int n = 0; n < 2; ++n) Br[n] = Bt + (size_t)(u.pn * 256 + wc * 32 + (Epi::PERM ? perm32(16 * n + fr) : 16 * n + fr)) * K + fq * 8;
#pragma unroll 1
        for (int k0 = 0; k0 < K; k0 += 32) {
            bf16x8 tf[2][4], wf[2][2];
#pragma unroll
            for (int ai = 0; ai < 2; ++ai)
#pragma unroll
                for (int m = 0; m < 4; ++m) tf[ai][m] = *(const bf16x8*)(Ar + (size_t)(ai * 128 + m * 16) * K + k0);
#pragma unroll
            for (int bj = 0; bj < 2; ++bj)
#pragma unroll
                for (int n = 0; n < 2; ++n) wf[bj][n] = *(const bf16x8*)(Br[n] + (size_t)(bj * 128) * K + k0);
#pragma unroll
            for (int ai = 0; ai < 2; ++ai)
#pragma unroll
                for (int bj = 0; bj < 2; ++bj)
#pragma unroll
                    for (int m = 0; m < 4; ++m)
#pragma unroll
                        for (int n = 0; n < 2; ++n) acc[ai][bj][m][n] = __builtin_amdgcn_mfma_f32_16x16x32_bf16(wf[bj][n], tf[ai][m], acc[ai][bj][m][n], 0, 0, 0);
        }
        E(acc, u, wr, wc, fr, fq);
    }
}

__device__ __forceinline__ u32x4 pack8(const f32x4& a, const f32x4& b) { u32x4 w; w.x = pk2(a.x, a.y); w.y = pk2(a.z, a.w); w.z = pk2(b.x, b.y); w.w = pk2(b.z, b.w); return w; }
__device__ __forceinline__ void rope4(f32x4& v, const f32x2 cs0, const f32x2 cs1) {
    const float a0 = v.x * cs0.x - v.y * cs0.y, a1 = v.x * cs0.y + v.y * cs0.x, a2 = v.z * cs1.x - v.w * cs1.y, a3 = v.z * cs1.y + v.w * cs1.x;
    v.x = a0; v.y = a1; v.z = a2; v.w = a3;
}
struct EpiMix {
    static constexpr bool PERM = true;
    const Params* pp; int l;
    __device__ __forceinline__ void operator()(const f32x4 (&acc)[2][2][4][2], const Unit& u, int wr, int wc, int fr, int fq) const {
        const Params& p = *pp;
        const int pn = u.pn, R0 = u.pm * 256; const bool smp = R0 >= MP;
        const int b = smp ? (R0 - MP) >> 11 : R0 >> 8, t0 = smp ? (R0 - MP) & 2047 : 0;
        const f32x2* cs_row = (const f32x2*)(p.ws + WS_ROPE); const f32x2* cs_col = cs_row + 32 * 16;
        if (pn >= 11) {
            bf16_t* dst = (bf16_t*)(p.ws + (pn < 13 ? Z_CU : Z_CV)) + ((pn - 11) & 1) * 256 + wc * 32 + 8 * fq;
#pragma unroll
            for (int ai = 0; ai < 2; ++ai)
#pragma unroll
                for (int m = 0; m < 4; ++m) { const int R = R0 + ai * 128 + wr * 64 + m * 16 + fr;
#pragma unroll
                    for (int bj = 0; bj < 2; ++bj) { f32x4 v0 = acc[ai][bj][m][0], v1 = acc[ai][bj][m][1];
#pragma unroll
                        for (int r = 0; r < 4; ++r) { v0[r] = gelu_tanh(v0[r]); v1[r] = gelu_tanh(v1[r]); }
                        *(u32x4*)(dst + (size_t)R * RW + bj * 128) = pack8(v0, v1); } }
            return;
        }
        const int kind = pn >> 1;
        float gq[2][2][4];
        const bool is_k = (pn == 10 && wc < 2), is_v = (pn == 10 && wc >= 2);
        if (kind == 4 || is_k) { const float* g = (kind == 4 ? p.in[I_GQ] : p.in[I_GK]) + l * HD;
#pragma unroll
            for (int bj = 0; bj < 2; ++bj)
#pragma unroll
                for (int n = 0; n < 2; ++n)
#pragma unroll
                    for (int r = 0; r < 4; ++r) gq[bj][n][r] = g[32 * bj + 8 * fq + 4 * n + r]; }
        const int head = (pn & 1) * 4 + wc;
#pragma unroll
        for (int ai = 0; ai < 2; ++ai)
#pragma unroll
            for (int m = 0; m < 4; ++m) {
                const int rr = ai * 128 + wr * 64 + m * 16 + fr, R = R0 + rr, t = t0 + rr;
                f32x4 v[2][2];
#pragma unroll
                for (int bj = 0; bj < 2; ++bj)
#pragma unroll
                    for (int n = 0; n < 2; ++n) v[bj][n] = acc[ai][bj][m][n];
                if (kind == 4 || is_k) {
                    float ss = 0.f;
#pragma unroll
                    for (int bj = 0; bj < 2; ++bj)
#pragma unroll
                        for (int n = 0; n < 2; ++n) ss += (v[bj][n].x * v[bj][n].x + v[bj][n].y * v[bj][n].y) + (v[bj][n].z * v[bj][n].z + v[bj][n].w * v[bj][n].w);
                    ss += __shfl_xor(ss, 16); ss += __shfl_xor(ss, 32);
                    const float rs = rsqrtf(ss * (1.f / HD) + EPS);
#pragma unroll
                    for (int bj = 0; bj < 2; ++bj)
#pragma unroll
                        for (int n = 0; n < 2; ++n)
#pragma unroll
                            for (int r = 0; r < 4; ++r) v[bj][n][r] = v[bj][n][r] * rs * gq[bj][n][r];
                }
                if (is_k && !smp) {
                    float* o = p.out + OUT_CK + ((size_t)((b * 2 + l) * SEQ_P + t) * 2 + wc) * HD + 8 * fq;
#pragma unroll
                    for (int bj = 0; bj < 2; ++bj) { *(f32x4*)(o + 32 * bj) = v[bj][0]; *(f32x4*)(o + 32 * bj + 4) = v[bj][1]; }
                }
                if (is_v && !smp) {
                    float* o = p.out + OUT_CV + ((size_t)((b * 2 + l) * SEQ_P + t) * 2 + (wc - 2)) * HD + 8 * fq;
#pragma unroll
                    for (int bj = 0; bj < 2; ++bj) { *(f32x4*)(o + 32 * bj) = v[bj][0]; *(f32x4*)(o + 32 * bj + 4) = v[bj][1]; }
                }
                if (kind == 1) {
#pragma unroll
                    for (int bj = 0; bj < 2; ++bj)
#pragma unroll
                        for (int n = 0; n < 2; ++n) v[bj][n] = v[bj][n] * 0.125f;
                }
                if (kind == 3) {
#pragma unroll
                    for (int bj = 0; bj < 2; ++bj)
#pragma unroll
                        for (int n = 0; n < 2; ++n)
#pragma unroll
                            for (int r = 0; r < 4; ++r) v[bj][n][r] = siluf_(v[bj][n][r]);
                }
                if (smp && (kind == 0 || kind == 1 || kind == 4 || is_k)) {
                    const f32x2* tr = cs_row + (t >> 6) * 16 + 4 * fq; const f32x2* tc = cs_col + (t & 63) * 16 + 4 * fq;
#pragma unroll
                    for (int n = 0; n < 2; ++n) { rope4(v[0][n], tr[2 * n], tr[2 * n + 1]); rope4(v[1][n], tc[2 * n], tc[2 * n + 1]); }
                }
                if (kind == 4) {
#pragma unroll
                    for (int bj = 0; bj < 2; ++bj)
#pragma unroll
                        for (int n = 0; n < 2; ++n) v[bj][n] = v[bj][n] * C2;
                }
                bf16_t* dst;
                if (kind < 5) dst = (bf16_t*)(p.ws + (kind == 0 ? Z_RQ : kind == 1 ? Z_RK : kind == 2 ? Z_RV : kind == 3 ? Z_RG : Z_AQ)) + (size_t)R * RW + head * HD + 8 * fq;
                else { const int hk = wc & 1;
                    if (smp) dst = (bf16_t*)(p.ws + (is_k ? Z_KS : Z_VS)) + ((size_t)b * SKV_S + PAST + t) * KVW + hk * HD + 8 * fq;
                    else dst = (bf16_t*)(p.ws + (is_k ? Z_KP : Z_VP)) + ((size_t)b * SEQ_P + t) * KVW + hk * HD + 8 * fq; }
#pragma unroll
                for (int bj = 0; bj < 2; ++bj) *(u32x4*)(dst + 32 * bj) = pack8(v[bj][0], v[bj][1]);
            }
    }
};
struct EpiGate {
    static constexpr bool PERM = true;
    const Params* pp;
    __device__ __forceinline__ void operator()(const f32x4 (&acc)[2][2][4][2], const Unit& u, int wr, int wc, int fr, int fq) const {
        const int x = u.pn >> 2; bf16_t* dst = (bf16_t*)(pp->ws + Z_GATE) + (size_t)x * M * DM + (u.pn & 3) * 256 + wc * 32 + 8 * fq;
#pragma unroll
        for (int ai = 0; ai < 2; ++ai)
#pragma unroll
            for (int m = 0; m < 4; ++m) { const int R = u.pm * 256 + ai * 128 + wr * 64 + m * 16 + fr;
#pragma unroll
                for (int bj = 0; bj < 2; ++bj) { f32x4 v0 = acc[ai][bj][m][0], v1 = acc[ai][bj][m][1];
#pragma unroll
                    for (int r = 0; r < 4; ++r) { v0[r] = sigmoidf_(v0[r]); v1[r] = sigmoidf_(v1[r]); }
                    *(u32x4*)(dst + (size_t)R * DM + bj * 128) = pack8(v0, v1); } }
    }
};
struct EpiMerge {
    static constexpr bool PERM = true;
    const Params* pp;
    __device__ __forceinline__ void operator()(const f32x4 (&acc)[2][2][4][2], const Unit& u, int wr, int wc, int fr, int fq) const {
        const int x = u.pn >> 2, pm = u.pm - 80 * x, gi = x == 0 ? 1 : x == 1 ? 2 : 0;
        const int col0 = (u.pn & 3) * 256 + wc * 32 + 8 * fq;
        const bf16_t* gate = (const bf16_t*)(pp->ws + Z_GATE) + (size_t)gi * M * DM + col0; bf16_t* dst = (bf16_t*)(pp->ws + WS_XN) + col0;
#pragma unroll
        for (int ai = 0; ai < 2; ++ai)
#pragma unroll
            for (int m = 0; m < 4; ++m) { const int R = pm * 256 + ai * 128 + wr * 64 + m * 16 + fr;
#pragma unroll
                for (int bj = 0; bj < 2; ++bj) { f32x4 v0 = acc[ai][bj][m][0], v1 = acc[ai][bj][m][1];
                    const u32x4 g = *(const u32x4*)(gate + (size_t)R * DM + bj * 128);
                    v0.x *= bflo(g.x); v0.y *= bfhi(g.x); v0.z *= bflo(g.y); v0.w *= bfhi(g.y); v1.x *= bflo(g.z); v1.y *= bfhi(g.z); v1.z *= bflo(g.w); v1.w *= bfhi(g.w);
                    if (x != 0) { const u32x4 o = *(const u32x4*)(dst + (size_t)R * DM + bj * 128);
                        v0.x += bflo(o.x); v0.y += bfhi(o.x); v0.z += bflo(o.y); v0.w += bfhi(o.y); v1.x += bflo(o.z); v1.y += bfhi(o.z); v1.z += bflo(o.w); v1.w += bfhi(o.w); }
                    *(u32x4*)(dst + (size_t)R * DM + bj * 128) = pack8(v0, v1); } }
    }
};
struct EpiRes {
    static constexpr bool PERM = false;
    const Params* pp; int l, part; bool from_inputs;
    __device__ __forceinline__ void operator()(const f32x4 (&acc)[2][2][4][2], const Unit& u, int wr, int wc, int fr, int fq) const {
        const Params& p = *pp; const int R0 = u.pm * 256; const int ci = row_ci(R0);
        const float* gv = mod_ptr(p, l, ci, part) + u.pn * 256 + wc * 32 + 4 * fq;
        f32x4 g[2][2];
#pragma unroll
        for (int bj = 0; bj < 2; ++bj)
#pragma unroll
            for (int n = 0; n < 2; ++n) g[bj][n] = *(const f32x4*)(gv + bj * 128 + n * 16);
#pragma unroll
        for (int ai = 0; ai < 2; ++ai)
#pragma unroll
            for (int m = 0; m < 4; ++m) { const int R = R0 + ai * 128 + wr * 64 + m * 16 + fr;
                const float* xs = (from_inputs ? x_row(p, 0, R) : p.out + (size_t)R * DM) + u.pn * 256 + wc * 32 + 4 * fq;
                float* xo = p.out + (size_t)R * DM + u.pn * 256 + wc * 32 + 4 * fq;
#pragma unroll
                for (int bj = 0; bj < 2; ++bj)
#pragma unroll
                    for (int n = 0; n < 2; ++n) { const f32x4 xv = *(const f32x4*)(xs + bj * 128 + n * 16); *(f32x4*)(xo + bj * 128 + n * 16) = xv + g[bj][n] * acc[ai][bj][m][n]; } }
    }
};
struct EpiFF1 {
    static constexpr bool PERM = true;
    const Params* pp;
    __device__ __forceinline__ void operator()(const f32x4 (&acc)[2][2][4][2], const Unit& u, int wr, int wc, int fr, int fq) const {
        bf16_t* dst = (bf16_t*)(pp->ws + Z_HB) + u.pn * 256 + wc * 32 + 8 * fq;
#pragma unroll
        for (int ai = 0; ai < 2; ++ai)
#pragma unroll
            for (int m = 0; m < 4; ++m) { const int R = u.pm * 256 + ai * 128 + wr * 64 + m * 16 + fr;
#pragma unroll
                for (int bj = 0; bj < 2; ++bj) { f32x4 v0 = acc[ai][bj][m][0], v1 = acc[ai][bj][m][1];
#pragma unroll
                    for (int r = 0; r < 4; ++r) { const float a = fmaxf(v0[r], 0.f), b = fmaxf(v1[r], 0.f); v0[r] = a * a; v1[r] = b * b; }
                    *(u32x4*)(dst + (size_t)R * DFF + bj * 128) = pack8(v0, v1); } }
    }
};

__device__ __forceinline__ void attn_simple(const Params& p, const Ctx& c) {
    LAS float* Kt = (LAS float*)c.lds; LAS float* Vt = Kt + 32 * 64; LAS float* Sc = Vt + 32 * 64;
    constexpr int NU_S = NB_S * NH * 4, NU_P = NB_P * NH;
    for (int u = c.bx; u < NU_S + NU_P; u += c.G) {
        const bool smp = u < NU_S; int b, h, q0, nq, skv; const bf16_t *Kb, *Vb; size_t rowbase;
        if (smp) { b = u / 32; h = (u / 4) & 7; q0 = (u & 3) * 512; nq = 512; skv = SKV_S; Kb = (const bf16_t*)(p.ws + Z_KS) + (size_t)b * SKV_S * KVW; Vb = (const bf16_t*)(p.ws + Z_VS) + (size_t)b * SKV_S * KVW; rowbase = MP + (size_t)b * SEQ_S + q0; }
        else { const int v = u - NU_S; b = v / 8; h = v & 7; q0 = 0; nq = 256; skv = SKV_P; Kb = (const bf16_t*)(p.ws + Z_KP) + (size_t)b * SEQ_P * KVW; Vb = (const bf16_t*)(p.ws + Z_VP) + (size_t)b * SEQ_P * KVW; rowbase = (size_t)b * SEQ_P; }
        const int hk = h >> 2; const bool act = c.tid < nq;
        bf16_t* qrow = (bf16_t*)(p.ws + Z_AQ) + (rowbase + (act ? c.tid : 0)) * RW + h * HD;
        float q[64], o[64]; float mx = -1e30f, lsum = 0.f;
#pragma unroll
        for (int i = 0; i < 8; ++i) { const u32x4 w = *(const u32x4*)(qrow + 8 * i); q[8 * i] = bflo(w.x); q[8 * i + 1] = bfhi(w.x); q[8 * i + 2] = bflo(w.y); q[8 * i + 3] = bfhi(w.y); q[8 * i + 4] = bflo(w.z); q[8 * i + 5] = bfhi(w.z); q[8 * i + 6] = bflo(w.w); q[8 * i + 7] = bfhi(w.w); }
#pragma unroll
        for (int i = 0; i < 64; ++i) o[i] = 0.f;
        for (int k0 = 0; k0 < skv; k0 += 32) {
            __syncthreads();
            { const int e = c.tid * 4, j = e >> 6, d = e & 63;
                const u32x2 kw = *(const u32x2*)(Kb + (size_t)(k0 + j) * KVW + hk * HD + d), vw = *(const u32x2*)(Vb + (size_t)(k0 + j) * KVW + hk * HD + d);
                *(LAS f32x4*)(Kt + e) = (f32x4){bflo(kw.x), bfhi(kw.x), bflo(kw.y), bfhi(kw.y)}; *(LAS f32x4*)(Vt + e) = (f32x4){bflo(vw.x), bfhi(vw.x), bflo(vw.y), bfhi(vw.y)}; }
            __syncthreads();
            float tm = mx;
#pragma unroll 1
            for (int j = 0; j < 32; ++j) { float a = 0.f;
#pragma unroll
                for (int d4 = 0; d4 < 16; ++d4) { const f32x4 kv = *(const LAS f32x4*)(Kt + j * 64 + 4 * d4); a += q[4 * d4] * kv.x + q[4 * d4 + 1] * kv.y + q[4 * d4 + 2] * kv.z + q[4 * d4 + 3] * kv.w; }
                Sc[j * 512 + c.tid] = a; tm = fmaxf(tm, a); }
            const float corr = exp2f(mx - tm); mx = tm; lsum *= corr;
#pragma unroll
            for (int i = 0; i < 64; ++i) o[i] *= corr;
#pragma unroll 1
            for (int j = 0; j < 32; ++j) { const float pj = exp2f(Sc[j * 512 + c.tid] - mx); lsum += pj;
#pragma unroll
                for (int d4 = 0; d4 < 16; ++d4) { const f32x4 vv = *(const LAS f32x4*)(Vt + j * 64 + 4 * d4); o[4 * d4] += pj * vv.x; o[4 * d4 + 1] += pj * vv.y; o[4 * d4 + 2] += pj * vv.z; o[4 * d4 + 3] += pj * vv.w; } }
        }
        if (act) { const float il = 1.f / lsum;
#pragma unroll
            for (int i = 0; i < 8; ++i) { u32x4 w; w.x = pk2(o[8 * i] * il, o[8 * i + 1] * il); w.y = pk2(o[8 * i + 2] * il, o[8 * i + 3] * il); w.z = pk2(o[8 * i + 4] * il, o[8 * i + 5] * il); w.w = pk2(o[8 * i + 6] * il, o[8 * i + 7] * il); *(u32x4*)(qrow + 8 * i) = w; } }
    }
    __syncthreads();
}
__device__ __forceinline__ void cmlp_simple(const Params& p, const Ctx& c, int l) {
    LAS float* Vt = (LAS float*)c.lds;
    LAS float* rs = Vt + 128 * 128;
    const bf16_t* cv = (const bf16_t*)(p.ws + Z_CV); bf16_t* cu = (bf16_t*)(p.ws + Z_CU);
    for (int u = c.bx; u < NCHUNK * 4; u += c.G) {
        const int ch = u >> 2, g = u & 3; const size_t R0 = (size_t)ch * 128;
        __syncthreads();
        { const int q = c.tid >> 2, part = c.tid & 3; float ss = 0.f;
            const bf16_t* r = cv + (R0 + q) * RW + part * 128;
#pragma unroll
            for (int i = 0; i < 16; ++i) { const u32x4 w = *(const u32x4*)(r + 8 * i); const float a0 = bflo(w.x), a1 = bfhi(w.x), a2 = bflo(w.y), a3 = bfhi(w.y), a4 = bflo(w.z), a5 = bfhi(w.z), a6 = bflo(w.w), a7 = bfhi(w.w);
                ss += (a0 * a0 + a1 * a1) + (a2 * a2 + a3 * a3) + (a4 * a4 + a5 * a5) + (a6 * a6 + a7 * a7); }
            ss += __shfl_xor(ss, 1); ss += __shfl_xor(ss, 2);
            if (part == 0) rs[q] = rsqrtf(ss * (1.f / RW) + EPS); }
        __syncthreads();
        for (int e = c.tid; e < 128 * 128 / 8; e += 512) { const int q = e >> 4, c8 = (e & 15) * 8; const float r = rs[q];
            const u32x4 w = *(const u32x4*)(cv + (R0 + q) * RW + g * 128 + c8);
            *(LAS f32x4*)(Vt + q * 128 + c8) = (f32x4){bflo(w.x) * r, bfhi(w.x) * r, bflo(w.y) * r, bfhi(w.y) * r};
            *(LAS f32x4*)(Vt + q * 128 + c8 + 4) = (f32x4){bflo(w.z) * r, bfhi(w.z) * r, bflo(w.w) * r, bfhi(w.w) * r}; }
        __syncthreads();
        const int cc = c.tid & 127, pg = __builtin_amdgcn_readfirstlane(c.tid >> 7);
        const float* Ws = p.in[I_CMWS] + ((size_t)(l * 4 + g) * 128) * 128; const float* bs = p.in[I_CMBS] + (l * 4 + g) * 128;
        const float gn = p.in[I_CMNORM][l * RW + g * 128 + cc];
        for (int pi = 0; pi < 32; ++pi) { const int pr = pg * 32 + pi; const float* wrow = Ws + pr * 128; float a = 0.f;
#pragma unroll 8
            for (int q = 0; q < 128; ++q) a += wrow[q] * Vt[q * 128 + cc];
            bf16_t* up = cu + (R0 + pr) * RW + g * 128 + cc;
            const float uu = bf2f(*up);
            *up = (bf16_t)f2bf(uu * (gn * a + bs[pr])); }
    }
    __syncthreads();
}
__device__ __forceinline__ float ret_ld(const Params& p, int l, int dir, int h) { const float x = p.in[I_DECAY][(l * 2 + dir) * NH + h]; return -log1pf(__expf(x)); }
__device__ __forceinline__ void retU_simple(const Params& p, const Ctx& c, int l) {
    LAS float* Kt = (LAS float*)c.lds; LAS float* Vt = Kt + 128 * 64; LAS float* wf = Vt + 128 * 64; LAS float* wb = wf + 128;
    float* U = (float*)(p.ws + Z_U);
    for (int u = c.bx; u < NCHUNK * NH; u += c.G) {
        const int ch = u >> 3, h = u & 7; const size_t R0 = (size_t)ch * 128;
        const float ldf = ret_ld(p, l, 0, h), ldb = ret_ld(p, l, 1, h);
        __syncthreads();
        if (c.tid < 128) { wf[c.tid] = __expf(ldf * (float)(127 - c.tid)); wb[c.tid] = __expf(ldb * (float)c.tid); }
        for (int e = c.tid; e < 128 * 64 / 8; e += 512) { const int j = e >> 3, d8 = (e & 7) * 8;
            const u32x4 kw = *(const u32x4*)((const bf16_t*)(p.ws + Z_RK) + (R0 + j) * RW + h * HD + d8), vw = *(const u32x4*)((const bf16_t*)(p.ws + Z_RV) + (R0 + j) * RW + h * HD + d8);
            *(LAS f32x4*)(Kt + j * 64 + d8) = (f32x4){bflo(kw.x), bfhi(kw.x), bflo(kw.y), bfhi(kw.y)}; *(LAS f32x4*)(Kt + j * 64 + d8 + 4) = (f32x4){bflo(kw.z), bfhi(kw.z), bflo(kw.w), bfhi(kw.w)};
            *(LAS f32x4*)(Vt + j * 64 + d8) = (f32x4){bflo(vw.x), bfhi(vw.x), bflo(vw.y), bfhi(vw.y)}; *(LAS f32x4*)(Vt + j * 64 + d8 + 4) = (f32x4){bflo(vw.z), bfhi(vw.z), bflo(vw.w), bfhi(vw.w)}; }
        __syncthreads();
        const int e = c.tid & 63, d0 = __builtin_amdgcn_readfirstlane(c.tid >> 6) * 8;
        float uf[8], ub[8];
#pragma unroll
        for (int i = 0; i < 8; ++i) { uf[i] = 0.f; ub[i] = 0.f; }
        for (int j = 0; j < 128; ++j) { const float v = Vt[j * 64 + e], vf = v * wf[j], vb = v * wb[j];
            const f32x4 k0 = *(const LAS f32x4*)(Kt + j * 64 + d0), k1 = *(const LAS f32x4*)(Kt + j * 64 + d0 + 4);
            uf[0] += k0.x * vf; uf[1] += k0.y * vf; uf[2] += k0.z * vf; uf[3] += k0.w * vf; uf[4] += k1.x * vf; uf[5] += k1.y * vf; uf[6] += k1.z * vf; uf[7] += k1.w * vf;
            ub[0] += k0.x * vb; ub[1] += k0.y * vb; ub[2] += k0.z * vb; ub[3] += k0.w * vb; ub[4] += k1.x * vb; ub[5] += k1.y * vb; ub[6] += k1.z * vb; ub[7] += k1.w * vb; }
        float* Uf = U + ((size_t)(0 * NCHUNK + ch) * NH + h) * 4096, *Ub = U + ((size_t)(1 * NCHUNK + ch) * NH + h) * 4096;
#pragma unroll
        for (int i = 0; i < 8; ++i) { Uf[(d0 + i) * 64 + e] = uf[i]; Ub[(d0 + i) * 64 + e] = ub[i]; }
    }
    __syncthreads();
}
__device__ __forceinline__ void retO_simple(const Params& p, const Ctx& c, int l) {
    LAS float* Kt = (LAS float*)c.lds; LAS float* Vt = Kt + 128 * 64; LAS float* Sf = Vt + 128 * 64; LAS float* Sb = Sf + 4096; LAS float* pf = Sb + 4096; LAS float* pb = pf + 132;
    const float* U = (const float*)(p.ws + Z_U);
    for (int u = c.bx; u < NCHUNK * NH; u += c.G) {
        const int ch = u >> 3, h = u & 7; const size_t R0 = (size_t)ch * 128; const bool smp = ch >= MP / 128;
        const int nc = smp ? 16 : 2, ch0 = smp ? (MP / 128 + ((ch - MP / 128) & ~15)) : (ch & ~1), cidx = ch - ch0, b = smp ? (ch - MP / 128) >> 4 : ch >> 1;
        const float ldf = ret_ld(p, l, 0, h), ldb = ret_ld(p, l, 1, h); const float Gf = __expf(128.f * ldf), Gb = __expf(128.f * ldb);
        __syncthreads();
        if (c.tid <= 128) { pf[c.tid] = __expf(ldf * (float)c.tid); pb[c.tid] = __expf(ldb * (float)c.tid); }
        for (int e = c.tid; e < 128 * 64 / 8; e += 512) { const int j = e >> 3, d8 = (e & 7) * 8;
            const u32x4 kw = *(const u32x4*)((const bf16_t*)(p.ws + Z_RK) + (R0 + j) * RW + h * HD + d8), vw = *(const u32x4*)((const bf16_t*)(p.ws + Z_RV) + (R0 + j) * RW + h * HD + d8);
            *(LAS f32x4*)(Kt + j * 64 + d8) = (f32x4){bflo(kw.x), bfhi(kw.x), bflo(kw.y), bfhi(kw.y)}; *(LAS f32x4*)(Kt + j * 64 + d8 + 4) = (f32x4){bflo(kw.z), bfhi(kw.z), bflo(kw.w), bfhi(kw.w)};
            *(LAS f32x4*)(Vt + j * 64 + d8) = (f32x4){bflo(vw.x), bfhi(vw.x), bflo(vw.y), bfhi(vw.y)}; *(LAS f32x4*)(Vt + j * 64 + d8 + 4) = (f32x4){bflo(vw.z), bfhi(vw.z), bflo(vw.w), bfhi(vw.w)}; }
        {
            float sf[8], sb[8]; const int e0 = c.tid * 8;
            if (smp) { const float* s0 = p.in[I_ST] + ((size_t)((b * 2 + l) * 2 + 0) * NH + h) * 4096 + e0; const float* s1 = p.in[I_ST] + ((size_t)((b * 2 + l) * 2 + 1) * NH + h) * 4096 + e0;
#pragma unroll
                for (int i = 0; i < 8; ++i) { sf[i] = s0[i]; sb[i] = s1[i]; } }
            else {
#pragma unroll
                for (int i = 0; i < 8; ++i) { sf[i] = 0.f; sb[i] = 0.f; } }
            for (int cc = 0; cc < cidx; ++cc) { const float* uf = U + ((size_t)(0 * NCHUNK + ch0 + cc) * NH + h) * 4096 + e0;
#pragma unroll
                for (int i = 0; i < 8; ++i) sf[i] = Gf * sf[i] + uf[i]; }
            for (int cc = nc - 1; cc > cidx; --cc) { const float* ub = U + ((size_t)(1 * NCHUNK + ch0 + cc) * NH + h) * 4096 + e0;
#pragma unroll
                for (int i = 0; i < 8; ++i) sb[i] = Gb * sb[i] + ub[i]; }
#pragma unroll
            for (int i = 0; i < 8; ++i) { Sf[e0 + i] = sf[i]; Sb[e0 + i] = sb[i]; }
            if (!smp && cidx == nc - 1) { const float* uf = U + ((size_t)(0 * NCHUNK + ch) * NH + h) * 4096 + e0; float* o = p.out + OUT_ST + ((size_t)((b * 2 + l) * 2 + 0) * NH + h) * 4096 + e0;
#pragma unroll
                for (int i = 0; i < 8; ++i) o[i] = Gf * sf[i] + uf[i]; }
            if (!smp && cidx == 0) { const float* ub = U + ((size_t)(1 * NCHUNK + ch) * NH + h) * 4096 + e0; float* o = p.out + OUT_ST + ((size_t)((b * 2 + l) * 2 + 1) * NH + h) * 4096 + e0;
#pragma unroll
                for (int i = 0; i < 8; ++i) o[i] = Gb * sb[i] + ub[i]; }
        }
        __syncthreads();
        const int i = c.tid >> 2, part = c.tid & 3;
        float qp[16], o[16];
        { const bf16_t* qr = (const bf16_t*)(p.ws + Z_RQ) + (R0 + i) * RW + h * HD + part * 16; const u32x4 w0 = *(const u32x4*)qr, w1 = *(const u32x4*)(qr + 8);
            qp[0] = bflo(w0.x); qp[1] = bfhi(w0.x); qp[2] = bflo(w0.y); qp[3] = bfhi(w0.y); qp[4] = bflo(w0.z); qp[5] = bfhi(w0.z); qp[6] = bflo(w0.w); qp[7] = bfhi(w0.w);
            qp[8] = bflo(w1.x); qp[9] = bfhi(w1.x); qp[10] = bflo(w1.y); qp[11] = bfhi(w1.y); qp[12] = bflo(w1.z); qp[13] = bfhi(w1.z); qp[14] = bflo(w1.w); qp[15] = bfhi(w1.w); }
#pragma unroll
        for (int e = 0; e < 16; ++e) o[e] = 0.f;
#pragma unroll 1
        for (int j = 0; j < 128; ++j) { float s = 0.f;
#pragma unroll
            for (int d4 = 0; d4 < 4; ++d4) { const f32x4 kv = *(const LAS f32x4*)(Kt + j * 64 + part * 16 + 4 * d4); s += qp[4 * d4] * kv.x + qp[4 * d4 + 1] * kv.y + qp[4 * d4 + 2] * kv.z + qp[4 * d4 + 3] * kv.w; }
            s += __shfl_xor(s, 1); s += __shfl_xor(s, 2);
            const float w = j < i ? pf[i - j] : (j > i ? pb[j - i] : 2.0f);
            s *= w;
#pragma unroll
            for (int e4 = 0; e4 < 4; ++e4) { const f32x4 vv = *(const LAS f32x4*)(Vt + j * 64 + part * 16 + 4 * e4); o[4 * e4] += s * vv.x; o[4 * e4 + 1] += s * vv.y; o[4 * e4 + 2] += s * vv.z; o[4 * e4 + 3] += s * vv.w; } }
        { const float xf = pf[i + 1], xb = pb[128 - i]; const bf16_t* qfull = (const bf16_t*)(p.ws + Z_RQ) + (R0 + i) * RW + h * HD;
#pragma unroll 2
            for (int d = 0; d < 64; ++d) { const float qd = bf2f(qfull[d]); const float af = qd * xf, ab = qd * xb;
#pragma unroll
                for (int e4 = 0; e4 < 4; ++e4) { const f32x4 a = *(const LAS f32x4*)(Sf + d * 64 + part * 16 + 4 * e4), bb = *(const LAS f32x4*)(Sb + d * 64 + part * 16 + 4 * e4);
                    o[4 * e4] += af * a.x + ab * bb.x; o[4 * e4 + 1] += af * a.y + ab * bb.y; o[4 * e4 + 2] += af * a.z + ab * bb.z; o[4 * e4 + 3] += af * a.w + ab * bb.w; } } }
        float s1 = 0.f;
#pragma unroll
        for (int e = 0; e < 16; ++e) s1 += o[e];
        s1 += __shfl_xor(s1, 1); s1 += __shfl_xor(s1, 2); const float mu = s1 * (1.f / 64.f);
        float s2 = 0.f;
#pragma unroll
        for (int e = 0; e < 16; ++e) { const float d = o[e] - mu; s2 += d * d; }
        s2 += __shfl_xor(s2, 1); s2 += __shfl_xor(s2, 2); const float rstd = rsqrtf(s2 * (1.f / 64.f) + EPS);
        const float* gn = p.in[I_RETGN] + l * RW + h * HD + part * 16;
        const bf16_t* rg = (const bf16_t*)(p.ws + Z_RG) + (R0 + i) * RW + h * HD + part * 16; const u32x4 g0 = *(const u32x4*)rg, g1 = *(const u32x4*)(rg + 8);
        float gs[16] = {bflo(g0.x), bfhi(g0.x), bflo(g0.y), bfhi(g0.y), bflo(g0.z), bfhi(g0.z), bflo(g0.w), bfhi(g0.w), bflo(g1.x), bfhi(g1.x), bflo(g1.y), bfhi(g1.y), bflo(g1.z), bfhi(g1.z), bflo(g1.w), bfhi(g1.w)};
        float y[16];
#pragma unroll
        for (int e = 0; e < 16; ++e) y[e] = (o[e] - mu) * rstd * gn[e] * gs[e];
        bf16_t* dst = (bf16_t*)(p.ws + Z_CV) + (R0 + i) * RW + h * HD + part * 16;
        u32x4 w0, w1; w0.x = pk2(y[0], y[1]); w0.y = pk2(y[2], y[3]); w0.z = pk2(y[4], y[5]); w0.w = pk2(y[6], y[7]); w1.x = pk2(y[8], y[9]); w1.y = pk2(y[10], y[11]); w1.z = pk2(y[12], y[13]); w1.w = pk2(y[14], y[15]);
        *(u32x4*)dst = w0; *(u32x4*)(dst + 8) = w1;
    }
    __syncthreads();
}

#ifndef KMASK
#define KMASK 0xFFF
#endif
constexpr int NPHASE = 22;
template <int KIND> __device__ __forceinline__ void run_kind(const Params& p, const Ctx& c, int l) {
    const unsigned char* wb = p.ws + WS_W;
    if constexpr (KIND == 0) { p0_modulation(p, c); p0_rope_tables(p, c); p_wconv(p, c, 0); p_kvctx(p, c, 0); }
    else if constexpr (KIND == 1) { p_norm(p, c, 0, 0); }
    else if constexpr (KIND == 2) { StaticOrder S; S.init(M, NMIX, c.G, c.bx); EpiMix E{&p, l}; gemm_simple(c, (const bf16_t*)(p.ws + WS_XN), (const bf16_t*)(wb + W_IN), DM, S, E); }
    else if constexpr (KIND == 3) { attn_simple(p, c); cmlp_simple(p, c, l); retU_simple(p, c, l); }
    else if constexpr (KIND == 4) { retO_simple(p, c, l); }
    else if constexpr (KIND == 5) { StaticOrder S; S.init(M, NGATE, c.G, c.bx); EpiGate E{&p}; gemm_simple(c, (const bf16_t*)(p.ws + WS_XN), (const bf16_t*)(wb + W_IN) + (size_t)NMIX * DM, DM, S, E); }
    else if constexpr (KIND == 6) { MergeOrder S{c.G, c.bx}; EpiMerge E{&p}; gemm_simple(c, (const bf16_t*)(p.ws + Z_AQ), (const bf16_t*)(wb + W_BR), RW, S, E); }
    else if constexpr (KIND == 7) { StaticOrder S; S.init(M, DM, c.G, c.bx); EpiRes E{&p, l, 2, l == 0}; gemm_simple(c, (const bf16_t*)(p.ws + WS_XN), (const bf16_t*)(wb + W_OUT), DM, S, E); }
    else if constexpr (KIND == 8) { p_norm(p, c, l, 1); }
    else if constexpr (KIND == 9) { StaticOrder S; S.init(M, DFF, c.G, c.bx); EpiFF1 E{&p}; gemm_simple(c, (const bf16_t*)(p.ws + WS_XN), (const bf16_t*)(wb + W_FF1), DM, S, E); }
    else if constexpr (KIND == 10) { StaticOrder S; S.init(M, DM, c.G, c.bx); EpiRes E{&p, l, 5, false}; gemm_simple(c, (const bf16_t*)(p.ws + Z_HB), (const bf16_t*)(wb + W_FF2), DFF, S, E); }
    else { if (l == 0) { p_wconv(p, c, 1); p_kvctx(p, c, 1); p_norm(p, c, 1, 0); } else p_final_norm(p, c); }
}
__device__ __forceinline__ void run_phase(const Params& p, const Ctx& c0, int ph) {
    Ctx c = c0; asm volatile("" : "+v"(c.tid));
    c.lane = c.tid & 63; c.wave = __builtin_amdgcn_readfirstlane(c.tid >> 6);
    if (ph == 0) { if (KMASK & 1) run_kind<0>(p, c, 0); return; }
    if (ph == 1) { if (KMASK & 2) run_kind<1>(p, c, 0); return; }
    const int l = (ph - 2) / 10, s = (ph - 2) % 10;
    switch (s) {
    case 0: if (KMASK & (1 << 2)) run_kind<2>(p, c, l); break;
    case 1: if (KMASK & (1 << 3)) run_kind<3>(p, c, l); break;
    case 2: if (KMASK & (1 << 4)) run_kind<4>(p, c, l); break;
    case 3: if (KMASK & (1 << 5)) run_kind<5>(p, c, l); break;
    case 4: if (KMASK & (1 << 6)) run_kind<6>(p, c, l); break;
    case 5: if (KMASK & (1 << 7)) run_kind<7>(p, c, l); break;
    case 6: if (KMASK & (1 << 8)) run_kind<8>(p, c, l); break;
    case 7: if (KMASK & (1 << 9)) run_kind<9>(p, c, l); break;
    case 8: if (KMASK & (1 << 10)) run_kind<10>(p, c, l); break;
    default: if (KMASK & (1 << 11)) run_kind<11>(p, c, l); break;
    }
}

#if N_LAUNCH_MODE == 1
__global__ void __launch_bounds__(512, 2) fwd_kernel(Params p) {
    extern __shared__ __attribute__((aligned(16))) unsigned char lds[];
    Ctx c; c.tid = threadIdx.x; c.lane = c.tid & 63; c.wave = __builtin_amdgcn_readfirstlane(c.tid >> 6); c.G = gridDim.x; c.bx = blockIdx.x; c.lds = (LAS unsigned char*)lds;
    volatile LAS unsigned* MISC = (volatile LAS unsigned*)(c.lds + MISC_OFF);
    if (c.tid < 32) MISC[c.tid] = 0u;
    __syncthreads();
    XcdBarrier bar = xcd_barrier_post((unsigned*)(p.ws + WS_CTL) + CW_BAR, MISC + 8);
    for (int ph = p.ph_lo; ph < p.ph_hi; ++ph) { run_phase(p, c, ph); if (ph + 1 < p.ph_hi) xcd_barrier(bar); }
}
#endif
template <int KIND> __global__ void __launch_bounds__(512, 2) phase_kernel(Params p) {
    extern __shared__ __attribute__((aligned(16))) unsigned char lds[];
    Ctx c; c.tid = threadIdx.x; c.lane = c.tid & 63; c.wave = __builtin_amdgcn_readfirstlane(c.tid >> 6); c.G = gridDim.x; c.bx = blockIdx.x; c.lds = (LAS unsigned char*)lds;
    run_kind<KIND>(p, c, p.ph_hi);
}
template <int KIND> static void launch_kind(Params p, int l, int grid, hipStream_t stream) {
    static bool attr = false;
    if (!attr) { (void)hipFuncSetAttribute((const void*)phase_kernel<KIND>, hipFuncAttributeMaxDynamicSharedMemorySize, LDS_BYTES); attr = true; }
    p.ph_lo = 0; p.ph_hi = l;
    hipLaunchKernelGGL(phase_kernel<KIND>, dim3(grid), dim3(512), LDS_BYTES, stream, p);
}

extern "C" void kernel_launch(void* const* d_in, const int* in_sizes, int n_in, void* d_out, int out_size, void* d_ws, size_t ws_size, hipStream_t stream) {
    static int grid = 0;
    if (grid == 0) {
        int dev = 0, cus = 0;
        if (n_in != N_IN || ws_size < WS_NEED) { grid = -1; return; }
        if (hipGetDevice(&dev) != hipSuccess || hipDeviceGetAttribute(&cus, hipDeviceAttributeMultiprocessorCount, dev) != hipSuccess) { grid = -1; return; }
#if N_LAUNCH_MODE == 1
        if (hipFuncSetAttribute((const void*)fwd_kernel, hipFuncAttributeMaxDynamicSharedMemorySize, LDS_BYTES) != hipSuccess) { grid = -1; return; }
#endif
        grid = cus;
    }
    if (grid < 0) return;
    (void)hipMemsetAsync((char*)d_ws + WS_CTL, 0, WS_ZERO_BYTES, stream);
    Params p{};
    for (int i = 0; i < N_IN; ++i) p.in[i] = (const float*)d_in[i];
    p.out = (float*)d_out; p.ws = (unsigned char*)d_ws;
#if N_LAUNCH_MODE == 1
    p.ph_lo = 0; p.ph_hi = NPHASE;
    hipLaunchKernelGGL(fwd_kernel, dim3(grid), dim3(512), LDS_BYTES, stream, p);
#else
    launch_kind<0>(p, 0, grid, stream); launch_kind<1>(p, 0, grid, stream);
    for (int l = 0; l < 2; ++l) {
        launch_kind<2>(p, l, grid, stream); launch_kind<3>(p, l, grid, stream); launch_kind<4>(p, l, grid, stream); launch_kind<5>(p, l, grid, stream); launch_kind<6>(p, l, grid, stream);
        launch_kind<7>(p, l, grid, stream); launch_kind<8>(p, l, grid, stream); launch_kind<9>(p, l, grid, stream); launch_kind<10>(p, l, grid, stream); launch_kind<11>(p, l, grid, stream);
    }
#endif
}
```

```cpp
#include <hip/hip_runtime.h>
#include <cstdio>
#include <cstdint>

#ifndef N_LAUNCH_MODE
#define N_LAUNCH_MODE 1
#endif

#define GAS __attribute__((address_space(1)))
#define LAS __attribute__((address_space(3)))
#define RLX_AGENT __ATOMIC_RELAXED, __HIP_MEMORY_SCOPE_AGENT
typedef unsigned short bf16_t;
typedef short bf16x8 __attribute__((ext_vector_type(8)));
typedef float f32x4 __attribute__((ext_vector_type(4)));
typedef float f32x2 __attribute__((ext_vector_type(2)));
typedef unsigned u32x4 __attribute__((ext_vector_type(4)));
typedef unsigned u32x2 __attribute__((ext_vector_type(2)));

constexpr int DM = 1024, MP = 4096, MS = 16384, M = 20480, SEQ_P = 256, SEQ_S = 2048, NB_P = 16, NB_S = 8, PAST = 256;
constexpr int HD = 64, NH = 8, KVW = 128, DFF = 4096, INW = 6912, NMIX = 3840, NGATE = 3072, RW = 512;
constexpr int SKV_S = PAST + SEQ_S, SKV_P = SEQ_P;
constexpr int NCHUNK = M / 128;
constexpr float EPS = 1e-6f;
constexpr float C2 = 0.18033688011112042f;
constexpr size_t OUT_Y = 0, OUT_CK = (size_t)M * DM, OUT_CV = OUT_CK + (size_t)NB_P * 2 * SEQ_P * KVW, OUT_ST = OUT_CV + (size_t)NB_P * 2 * SEQ_P * KVW;

constexpr size_t MiB = 1u << 20;
constexpr size_t WS_CTL = 0;
constexpr size_t WS_MOD = 1 * MiB;
constexpr size_t WS_ROPE = 1 * MiB + 512 * 1024;
constexpr size_t WS_ZERO_BYTES = 1 * MiB + 512 * 1024;
constexpr size_t WS_W = 2 * MiB;
constexpr size_t W_IN = 0, W_BR = W_IN + (size_t)INW * DM * 2, W_OUT = W_BR + (size_t)3 * DM * RW * 2, W_FF1 = W_OUT + (size_t)DM * DM * 2, W_FF2 = W_FF1 + (size_t)DFF * DM * 2, W_END = W_FF2 + (size_t)DM * DFF * 2;
static_assert(W_END <= 35 * MiB, "weights");
constexpr size_t WS_XN = 37 * MiB;
constexpr size_t WS_Z = 77 * MiB;
constexpr size_t Z_RQ = WS_Z, Z_RK = WS_Z + 20 * MiB, Z_RV = WS_Z + 40 * MiB, Z_RG = WS_Z + 60 * MiB, Z_U = WS_Z + 80 * MiB;
constexpr size_t Z_AQ = WS_Z + 120 * MiB, Z_CU = WS_Z + 140 * MiB, Z_CV = WS_Z + 160 * MiB;
constexpr size_t Z_KS = WS_Z + 180 * MiB, Z_VS = Z_KS + (size_t)NB_S * SKV_S * KVW * 2, Z_KP = Z_VS + (size_t)NB_S * SKV_S * KVW * 2, Z_VP = Z_KP + (size_t)NB_P * SEQ_P * KVW * 2, Z_END = Z_VP + (size_t)NB_P * SEQ_P * KVW * 2;
constexpr size_t Z_GATE = WS_Z;
constexpr size_t Z_HB = WS_Z;
constexpr size_t WS_NEED = 268 * MiB;
static_assert(Z_END <= WS_NEED, "ws map");
constexpr int CW_BAR = 4096;

constexpr int LDS_BYTES = 147456;
constexpr int MISC_OFF = 131072 + 320;

__device__ __forceinline__ unsigned f2bf(float f) { unsigned u = __builtin_bit_cast(unsigned, f); return (u + 0x7fffu + ((u >> 16) & 1u)) >> 16; }
__device__ __forceinline__ unsigned pk2(float lo, float hi) { return f2bf(lo) | (f2bf(hi) << 16); }
__device__ __forceinline__ float bf2f(unsigned h) { return __builtin_bit_cast(float, h << 16); }
__device__ __forceinline__ float bflo(unsigned w) { return __builtin_bit_cast(float, w << 16); }
__device__ __forceinline__ float bfhi(unsigned w) { return __builtin_bit_cast(float, w & 0xffff0000u); }
__device__ __forceinline__ float sigmoidf_(float x) { return 1.f / (1.f + __expf(-x)); }
__device__ __forceinline__ float siluf_(float x) { return x / (1.f + __expf(-x)); }
__device__ __forceinline__ float gelu_tanh(float x) { const float u = 0.7978845608028654f * (x + 0.044715f * x * x * x); const float e = __expf(2.f * u); const float th = 1.f - 2.f / (e + 1.f); return 0.5f * x * (1.f + th); }
__device__ __forceinline__ float wave_sum(float v) {
#pragma unroll
    for (int o = 1; o < 64; o <<= 1) v += __shfl_xor(v, o);
    return v;
}

#define XB_TMO      128
#define XB_XCNT(j)  (256  + 64 * (j))
#define XB_XSUB(j)  (1280 + 64 * (j))
#define XB_XGEN(j)  (2304 + 64 * (j))
#define XB_TOP      3328
#define XB_TOPGEN   3392
#define XCD_BAR_WORDS 3456
#define XB_SPIN_CAP (1u << 18)
__device__ __forceinline__ unsigned xb_ld(unsigned* p)              { return __hip_atomic_load(p, __ATOMIC_RELAXED, __HIP_MEMORY_SCOPE_AGENT); }
__device__ __forceinline__ unsigned xb_add(unsigned* p, unsigned v) { return __hip_atomic_fetch_add(p, v, __ATOMIC_RELAXED, __HIP_MEMORY_SCOPE_AGENT); }
__device__ __forceinline__ unsigned xb_xcc_id() { return (unsigned)__builtin_amdgcn_s_getreg((3 << 11) | 20) & 0xFu; }
#define XB_SPIN(cond, bar) do { unsigned _sp = 0; while (cond) { __builtin_amdgcn_s_sleep(1); \
    if ((++_sp & 255u) == 0u) { if (xb_ld(&(bar)[XB_TMO])) break; if (_sp > XB_SPIN_CAP) { atomicAdd(&(bar)[XB_TMO], 1u); break; } } } } while (0)
struct XcdBarrier { unsigned* bar; unsigned x; volatile LAS unsigned* st; };
__device__ __forceinline__ XcdBarrier xcd_barrier_post(unsigned* bar, volatile LAS unsigned* st) {
    XcdBarrier b; b.bar = bar; b.x = xb_xcc_id(); b.st = st;
    if (threadIdx.x == 0) (void)xb_add(&bar[XB_XCNT(b.x)], 1u);
    return b;
}
__device__ __forceinline__ void xcd_barrier_complete(unsigned* bar, unsigned x, unsigned& nloc, unsigned& nx) {
    const unsigned G = gridDim.x * gridDim.y * gridDim.z;
    unsigned sum, cnt, mine, sp = 0u;
    for (;;) {
        sum = 0u; cnt = 0u; mine = 0u;
#pragma unroll
        for (unsigned j = 0; j < 16; ++j) { const unsigned c = xb_ld(&bar[XB_XCNT(j)]); sum += c; cnt += (c > 0u) ? 1u : 0u; mine = (j == x) ? c : mine; }
        if (sum == G) break;
        __builtin_amdgcn_s_sleep(1);
        if ((++sp & 255u) == 0u) { if (xb_ld(&bar[XB_TMO])) break; if (sp > XB_SPIN_CAP) { atomicAdd(&bar[XB_TMO], 1u); break; } }
    }
    nloc = mine > 0u ? mine : 1u; nx = cnt > 0u ? cnt : 1u;
}
__device__ __forceinline__ void xcd_barrier(const XcdBarrier& b) {
    asm volatile("s_waitcnt vmcnt(0)" ::: "memory");
    __syncthreads();
    if (threadIdx.x == 0) {
        unsigned* bar = b.bar;
        __builtin_amdgcn_s_waitcnt(0);
        unsigned nloc = b.st[0], nx = b.st[1];
        if (nloc == 0u) { xcd_barrier_complete(bar, b.x, nloc, nx); b.st[0] = nloc; b.st[1] = nx; }
        const unsigned old = xb_add(&bar[XB_XSUB(b.x)], 1u);
        const unsigned gen = old / nloc;
        if (old + 1u == (gen + 1u) * nloc) {
            __builtin_amdgcn_fence(__ATOMIC_RELEASE, "agent");
            asm volatile("s_waitcnt vmcnt(0)" ::: "memory");
            const unsigned og = xb_add(&bar[XB_TOP], 1u);
            const unsigned tg = og / nx;
            if (og + 1u == (tg + 1u) * nx) xb_add(&bar[XB_TOPGEN], 1u);
            else XB_SPIN(xb_ld(&bar[XB_TOPGEN]) == tg, bar);
            __builtin_amdgcn_fence(__ATOMIC_ACQUIRE, "agent");
            xb_add(&bar[XB_XGEN(b.x)], 1u);
            asm volatile("s_waitcnt vmcnt(0)" ::: "memory");
        } else {
            XB_SPIN(xb_ld(&bar[XB_XGEN(b.x)]) == gen, bar);
            __builtin_amdgcn_fence(__ATOMIC_ACQUIRE, "agent");
            asm volatile("s_waitcnt vmcnt(0)" ::: "memory");
        }
    }
    __syncthreads();
}

enum { I_XP = 0, I_XS, I_CK, I_CV, I_ST, I_C, I_CCTX, I_WMOD, I_BMOD, I_GN1, I_GN2, I_WIN, I_GQ, I_GK, I_DECAY, I_RETGN, I_CMNORM, I_CMWS, I_CMBS, I_WBRR, I_WBRA, I_WBRC, I_WOUT, I_WFF1, I_WFF2, I_GFIN, N_IN };
struct Params { const float* in[N_IN]; float* out; unsigned char* ws; int ph_lo, ph_hi; };
static_assert(sizeof(Params) == N_IN * 8 + 8 + 8 + 8, "no padding");

struct Ctx {
    int tid, lane, wave, G, bx;
    LAS unsigned char* lds;
};
__device__ __forceinline__ int row_ci(int R) { return R < MP ? 0 : 1 + ((R - MP) >> 11); }
__device__ __forceinline__ const float* mod_ptr(const Params& p, int l, int ci, int part) { return (const float*)(p.ws + WS_MOD) + ((size_t)(l * 9 + ci) * 6 + part) * DM; }

__device__ __forceinline__ void p0_modulation(const Params& p, const Ctx& c) {
    LAS float* sl = (LAS float*)c.lds;
    for (int i = c.tid; i < 9 * DM; i += 512) { const int ci = i >> 10, k = i & 1023; const float v = ci == 0 ? p.in[I_CCTX][k] : p.in[I_C][(ci - 1) * DM + k]; sl[i] = siluf_(v); }
    __syncthreads();
    float* mod = (float*)(p.ws + WS_MOD);
    const int gw = c.bx * 8 + c.wave, NGW = c.G * 8;
    constexpr int NITEM = 2 * 96 * 8;
    for (int it = gw; it < NITEM; it += NGW) {
        const int l = it / 768, r = it % 768, cb = r >> 3, ks = r & 7;
        const float* W = p.in[I_WMOD] + (size_t)l * DM * 6144 + (size_t)(ks * 128) * 6144 + cb * 64 + c.lane;
        float s[9];
#pragma unroll
        for (int ci = 0; ci < 9; ++ci) s[ci] = 0.f;
#pragma unroll 4
        for (int k = 0; k < 128; ++k) {
            const float w = W[(size_t)k * 6144];
#pragma unroll
            for (int ci = 0; ci < 9; ++ci) s[ci] += sl[ci * DM + ks * 128 + k] * w;
        }
        const float bias = ks == 0 ? p.in[I_BMOD][l * 6144 + cb * 64 + c.lane] : 0.f;
#pragma unroll
        for (int ci = 0; ci < 9; ++ci) atomicAdd(mod + (size_t)(l * 9 + ci) * 6144 + cb * 64 + c.lane, s[ci] + bias);
    }
    __syncthreads();
}
__device__ __forceinline__ void p0_rope_tables(const Params& p, const Ctx& c) {
    f32x2* tab = (f32x2*)(p.ws + WS_ROPE);
    const int g = c.bx * 512 + c.tid;
    if (g < 96 * 16) { const int pos = g >> 4, i = g & 15; const float inv = 1.0f / powf(10000.0f, (float)(2 * i) / 32.0f); const float posf = pos < 32 ? (float)pos : (float)(pos - 32);
        const float ang = posf * inv; f32x2 v; v.x = cosf(ang); v.y = sinf(ang); tab[g] = v; }
}
__device__ __forceinline__ int win_colmap(int n) {
    const int tile = n >> 8, pp = n & 255, bj = pp >> 7, wc = (pp >> 5) & 3;
    if (tile < 10) return (tile >> 1) * 512 + ((tile & 1) * 4 + wc) * 64 + 32 * bj;
    if (tile == 10) return (wc < 2 ? 2560 + wc * 64 : 2688 + (wc - 2) * 64) + 32 * bj;
    return n;
}
__device__ __forceinline__ void transpose_item(const float* W, int K, int ldn, int src_col0, bf16_t* WT, int dst_row0, int k0, LAS float* scr, int lane) {
#pragma unroll 8
    for (int i = 0; i < 32; ++i) { const int kk = 2 * i + (lane >> 5); scr[kk * 33 + (lane & 31)] = W[(size_t)(k0 + kk) * ldn + src_col0 + (lane & 31)]; }
    asm volatile("s_waitcnt lgkmcnt(0)" ::: "memory");
    const int ch = lane & 7;
#pragma unroll
    for (int j = 0; j < 4; ++j) { const int n = (lane >> 3) + 8 * j; const LAS float* s = scr + (8 * ch) * 33 + n;
        u32x4 o; o.x = pk2(s[0 * 33], s[1 * 33]); o.y = pk2(s[2 * 33], s[3 * 33]); o.z = pk2(s[4 * 33], s[5 * 33]); o.w = pk2(s[6 * 33], s[7 * 33]);
        *(u32x4*)(WT + (size_t)(dst_row0 + n) * K + k0 + 8 * ch) = o; }
    asm volatile("s_waitcnt lgkmcnt(0)" ::: "memory");
}
__device__ __forceinline__ void p_wconv(const Params& p, const Ctx& c, int l) {
    LAS float* scr = (LAS float*)(c.lds + 40960 + c.wave * 8448);
    const int gw = c.bx * 8 + c.wave, NGW = c.G * 8;
    unsigned char* wb = p.ws + WS_W;
    constexpr int I_IN = 16 * 216, I_BRX = 8 * 32, I_O = 16 * 32, I_F1 = 16 * 128, I_F2 = 64 * 32;
    constexpr int NITEMS = I_IN + 3 * I_BRX + I_O + I_F1 + I_F2;
    for (int it = gw; it < NITEMS; it += NGW) {
        int r = it;
        if (r < I_IN) { const int kb = r / 216, nb = r % 216; transpose_item(p.in[I_WIN] + (size_t)l * DM * INW, DM, INW, win_colmap(nb * 32), (bf16_t*)(wb + W_IN), nb * 32, kb * 64, scr, c.lane); continue; } r -= I_IN;
        if (r < 3 * I_BRX) { const int x = r / I_BRX, rr = r % I_BRX, kb = rr / 32, nb = rr % 32;
            const float* src = (x == 0 ? p.in[I_WBRA] : x == 1 ? p.in[I_WBRC] : p.in[I_WBRR]) + (size_t)l * RW * DM;
            transpose_item(src, RW, DM, nb * 32, (bf16_t*)(wb + W_BR) + (size_t)x * DM * RW, nb * 32, kb * 64, scr, c.lane); continue; } r -= 3 * I_BRX;
        if (r < I_O) { const int kb = r / 32, nb = r % 32; transpose_item(p.in[I_WOUT] + (size_t)l * DM * DM, DM, DM, nb * 32, (bf16_t*)(wb + W_OUT), nb * 32, kb * 64, scr, c.lane); continue; } r -= I_O;
        if (r < I_F1) { const int kb = r / 128, nb = r % 128; transpose_item(p.in[I_WFF1] + (size_t)l * DM * DFF, DM, DFF, nb * 32, (bf16_t*)(wb + W_FF1), nb * 32, kb * 64, scr, c.lane); continue; } r -= I_F1;
        { const int kb = r / 32, nb = r % 32; transpose_item(p.in[I_WFF2] + (size_t)l * DFF * DM, DFF, DM, nb * 32, (bf16_t*)(wb + W_FF2), nb * 32, kb * 64, scr, c.lane); }
    }
}
__device__ __forceinline__ void p_kvctx(const Params& p, const Ctx& c, int l) {
    const int g = c.bx * 512 + c.tid, NG = c.G * 512;
    for (int i = g; i < NB_S * PAST * KVW / 4; i += NG) {
        const int e = i * 4, b = e / (PAST * KVW), r = e % (PAST * KVW);
        const size_t src = ((size_t)(b * 2 + l) * PAST) * KVW + r;
        const f32x4 k = *(const f32x4*)(p.in[I_CK] + src), v = *(const f32x4*)(p.in[I_CV] + src);
        u32x2 ko, vo; ko.x = pk2(k.x, k.y); ko.y = pk2(k.z, k.w); vo.x = pk2(v.x, v.y); vo.y = pk2(v.z, v.w);
        *(u32x2*)((bf16_t*)(p.ws + Z_KS) + (size_t)b * SKV_S * KVW + r) = ko;
        *(u32x2*)((bf16_t*)(p.ws + Z_VS) + (size_t)b * SKV_S * KVW + r) = vo;
    }
}
__device__ __forceinline__ const float* x_row(const Params& p, int l, int R) { return l == 0 ? (R < MP ? p.in[I_XP] + (size_t)R * DM : p.in[I_XS] + (size_t)(R - MP) * DM) : p.out + (size_t)R * DM; }
__device__ __forceinline__ void p_norm(const Params& p, const Ctx& c, int l, int which) {
    const int gw = c.bx * 8 + c.wave, NGW = c.G * 8;
    const float* gvec = (which == 0 ? p.in[I_GN1] : p.in[I_GN2]) + l * DM;
    for (int R = gw; R < M; R += NGW) {
        const float* xr = which == 0 ? x_row(p, l, R) : p.out + (size_t)R * DM;
        const int ci = row_ci(R);
        const float* sh = mod_ptr(p, l, ci, which == 0 ? 0 : 3); const float* sc = mod_ptr(p, l, ci, which == 0 ? 1 : 4);
        f32x4 v[4]; float s = 0.f;
#pragma unroll
        for (int j = 0; j < 4; ++j) { v[j] = *(const f32x4*)(xr + 4 * c.lane + 256 * j); s += (v[j].x * v[j].x + v[j].y * v[j].y) + (v[j].z * v[j].z + v[j].w * v[j].w); }
        const float rstd = rsqrtf(wave_sum(s) * (1.f / DM) + EPS);
        bf16_t* orow = (bf16_t*)(p.ws + WS_XN) + (size_t)R * DM;
#pragma unroll
        for (int j = 0; j < 4; ++j) { const int col = 4 * c.lane + 256 * j; const f32x4 g = *(const f32x4*)(gvec + col), a = *(const f32x4*)(sc + col), b = *(const f32x4*)(sh + col);
            f32x4 o = v[j] * rstd * g * (a + 1.0f) + b; u32x2 w; w.x = pk2(o.x, o.y); w.y = pk2(o.z, o.w); *(u32x2*)(orow + col) = w; }
    }
}
__device__ __forceinline__ void p_final_norm(const Params& p, const Ctx& c) {
    const int gw = c.bx * 8 + c.wave, NGW = c.G * 8;
    for (int R = gw; R < M; R += NGW) {
        float* xr = p.out + (size_t)R * DM;
        f32x4 v[4]; float s = 0.f;
#pragma unroll
        for (int j = 0; j < 4; ++j) { v[j] = *(const f32x4*)(xr + 4 * c.lane + 256 * j); s += (v[j].x * v[j].x + v[j].y * v[j].y) + (v[j].z * v[j].z + v[j].w * v[j].w); }
        const float rstd = rsqrtf(wave_sum(s) * (1.f / DM) + EPS);
#pragma unroll
        for (int j = 0; j < 4; ++j) { const int col = 4 * c.lane + 256 * j; const f32x4 g = *(const f32x4*)(p.in[I_GFIN] + col); *(f32x4*)(xr + col) = v[j] * rstd * g; }
    }
}

struct Unit { int pm, pn; };
__host__ __device__ __forceinline__ int perm32(int rho) { const int n = rho >> 4, i = rho & 15; return 8 * (i >> 2) + 4 * n + (i & 3); }
struct StaticOrder {
    int nM, nN, nwg, G, c;
    __device__ void init(int Mr, int N, int G_, int c_) { nM = Mr / 256; nN = N / 256; nwg = nM * nN; G = G_; c = c_; }
    __device__ bool next(int i, Unit& u) const {
        const long L = (long)i * G + c; if (L >= nwg) return false;
        int wgid = (int)L; { const int q = nwg / 8, r = nwg % 8, xcd = wgid % 8, off = wgid / 8; wgid = (xcd < r ? xcd * (q + 1) : r * (q + 1) + (xcd - r) * q) + off; }
        const int nig = 8 * nN, gid = wgid / nig, fm = gid * 8, gsz = (nM - fm) < 8 ? (nM - fm) : 8;
        u.pm = fm + ((wgid % nig) % gsz); u.pn = (wgid % nig) / gsz; return true;
    }
    __device__ __forceinline__ void a_ready(const Unit&) const {}
    __device__ __forceinline__ void done(const Unit&) const {}
};
struct MergeOrder {
    int G, c;
    __device__ bool next(int i, Unit& u) const {
        const int t = i / 3, x = i % 3; const long L = (long)t * G + c; if (L >= 320) return false;
        u.pm = x * 80 + (int)(L >> 2); u.pn = x * 4 + (int)(L & 3); return true;
    }
    __device__ __forceinline__ void a_ready(const Unit&) const {}
    __device__ __forceinline__ void done(const Unit&) const {}
};
template <class Epi, class Sched>
__device__ __forceinline__ void gemm_simple(const Ctx& c, const bf16_t* A, const bf16_t* Bt, int K, const Sched& S, const Epi& E) {
    const int tid = c.tid, wid = c.wave, lane = tid & 63, wr = wid >> 2, wc = wid & 3, fr = lane & 15, fq = lane >> 4;
    Unit u;
    for (int ui = 0; S.next(ui, u); ++ui) {
        f32x4 acc[2][2][4][2];
#pragma unroll
        for (int a = 0; a < 2; ++a)
#pragma unroll
            for (int b = 0; b < 2; ++b)
#pragma unroll
                for (int m = 0; m < 4; ++m)
#pragma unroll
                    for (int n = 0; n < 2; ++n) acc[a][b][m][n] = (f32x4){0.f, 0.f, 0.f, 0.f};
        const bf16_t* Ar = A + (size_t)(u.pm * 256 + wr * 64 + fr) * K + fq * 8;
        const bf16_t* Br[2];
#pragma unroll
        for (int n = 0; n < 2; ++n) Br[n] = Bt + (size_t)(u.pn * 256 + wc * 32 + (Epi::PERM ? perm32(16 * n + fr) : 16 * n + fr)) * K + fq * 8;
#pragma unroll 1
        for (int k0 = 0; k0 < K; k0 += 32) {
            bf16x8 tf[2][4], wf[2][2];
#pragma unroll
            for (int ai = 0; ai < 2; ++ai)
#pragma unroll
                for (int m = 0; m < 4; ++m) tf[ai][m] = *(const bf16x8*)(Ar + (size_t)(ai * 128 + m * 16) * K + k0);
#pragma unroll
            for (int bj = 0; bj < 2; ++bj)
#pragma unroll
                for (int n = 0; n < 2; ++n) wf[bj][n] = *(const bf16x8*)(Br[n] + (size_t)(bj * 128) * K + k0);
#pragma unroll
            for (int ai = 0; ai < 2; ++ai)
#pragma unroll
                for (int bj = 0; bj < 2; ++bj)
#pragma unroll
                    for (int m = 0; m < 4; ++m)
#pragma unroll
                        for (int n = 0; n < 2; ++n) acc[ai][bj][m][n] = __builtin_amdgcn_mfma_f32_16x16x32_bf16(wf[bj][n], tf[ai][m], acc[ai][bj][m][n], 0, 0, 0);
        }
        E(acc, u, wr, wc, fr, fq);
    }
}

namespace pg8 {
#define PG8_LAS __attribute__((address_space(3)))
constexpr int BM = 256, BK = 64, HALF = 128, HTB = HALF * BK * 2  , STAGE_BYTES = 8 * HTB, NXCD = 8, WGM = 8;

__host__ __device__ __forceinline__ int lds_byte(int r, int c) { const int st = (r >> 4) * 2 + (c >> 5), rr = r & 15, cc = c & 31, ob = rr * 64 + cc * 2; return st * 1024 + (ob ^ (((ob >> 9) & 1) << 5)); }
__host__ __device__ __forceinline__ void stage_rc(int b, int& R, int& C) { const int st = b / 1024, sb = b % 1024, swz = sb ^ (((sb >> 9) & 1) << 5); R = (st >> 1) * 16 + swz / 64; C = (st & 1) * 32 + (swz % 64) / 2; }
struct Gemm { const bf16_t* A; const bf16_t* Bt; int M, N, K; };
template <class Epi, class Sched, bool ALIGN_EPI = false, bool SP2 = false>
__device__ __forceinline__ void gemm_phase(int tid_in, PG8_LAS unsigned char* lds, const Gemm g, const Sched& S, const Epi& E) {
    const int tid = tid_in, wid = __builtin_amdgcn_readfirstlane(tid >> 6), lane = tid & 63, wr = wid >> 2, wc = wid & 3, fr = lane & 15, fq = lane >> 4;
    const int K = g.K, nt = K / BK;
    unsigned voffA[2], voffB[2];
#pragma unroll
    for (int i = 0; i < 2; ++i) { int R, C; stage_rc(tid * 16 + i * 8192, R, C); const int Rb = Epi::PERM ? ((R & ~31) + perm32(R & 31)) : R;
        voffA[i] = (unsigned)(R * K + C) * 2u; voffB[i] = (unsigned)(Rb * K + C) * 2u; }
    const size_t kstep = (size_t)(BK * 2);
    const size_t hstep = (size_t)HALF * K * 2;
    const size_t tstep = 2 * hstep;
    const unsigned ldsw = (unsigned)wid * 1024u;
    const int aoff = lds_byte(wr * 64 + fr, fq * 8), boff = lds_byte(wc * 32 + fr, fq * 8);
#define PG8_SA(b, h) (((b) * 2 + (h)) * HTB)
#define PG8_SB(b, h) ((4 + (b) * 2 + (h)) * HTB)
#define PG8_STAGE(bufoff, gbase, voff) do { _Pragma("unroll") for (int _i = 0; _i < 2; ++_i) \
        __builtin_amdgcn_global_load_lds((const unsigned*)((const char*)(gbase) + (voff)[_i]), (PG8_LAS unsigned*)(lds + (bufoff) + ldsw + _i * 8192), 16, 0, 0); } while (0)
#define PG8_LDA(dst, b, h) do { _Pragma("unroll") for (int m = 0; m < 4; ++m) _Pragma("unroll") for (int k = 0; k < 2; ++k) dst[m][k] = *(const PG8_LAS bf16x8*)(lds + PG8_SA(b, h) + aoff + m * 2048 + k * 1024); } while (0)
#define PG8_LDB(dst, b, h) do { _Pragma("unroll") for (int n = 0; n < 2; ++n) _Pragma("unroll") for (int k = 0; k < 2; ++k) dst[n][k] = *(const PG8_LAS bf16x8*)(lds + PG8_SB(b, h) + boff + n * 2048 + k * 1024); } while (0)
#define PG8_MMA(ai, bj, At, Bt) do { __builtin_amdgcn_s_setprio(1); _Pragma("unroll") for (int m = 0; m < 4; ++m) _Pragma("unroll") for (int n = 0; n < 2; ++n) _Pragma("unroll") for (int k = 0; k < 2; ++k) \
        acc[ai][bj][m][n] = __builtin_amdgcn_mfma_f32_16x16x32_bf16(Bt[n][k], At[m][k], acc[ai][bj][m][n], 0, 0, 0); __builtin_amdgcn_s_setprio(0); } while (0)
#define PG8_WAIT_V(n) asm volatile("s_waitcnt vmcnt(" #n ")" ::: "memory")
#define PG8_WAIT_L(n) asm volatile("s_waitcnt lgkmcnt(" #n ")" ::: "memory")
#define PG8_BAR __builtin_amdgcn_s_barrier()
#define PG8_SCHED __builtin_amdgcn_sched_barrier(0)
    Unit cur, nxt; int ui = 0;
    if (!S.next(0, cur)) return;
    f32x4 acc[2][2][4][2];
#pragma unroll
    for (int a = 0; a < 2; ++a)
#pragma unroll
        for (int b = 0; b < 2; ++b)
#pragma unroll
            for (int m = 0; m < 4; ++m)
#pragma unroll
                for (int n = 0; n < 2; ++n) acc[a][b][m][n] = (f32x4){0.f, 0.f, 0.f, 0.f};
    bf16x8 At[4][2], B0[2][2], B1[2][2];
    const char* cA = (const char*)g.A + (size_t)cur.pm * tstep; const char* cB = (const char*)g.Bt + (size_t)cur.pn * tstep;
    S.a_ready(cur);
    if constexpr (SP2) {
        PG8_STAGE(PG8_SB(0, 0), cB, voffB); PG8_STAGE(PG8_SB(0, 1), cB + hstep, voffB); PG8_STAGE(PG8_SA(0, 0), cA, voffA); PG8_STAGE(PG8_SA(0, 1), cA + hstep, voffA);
        if (wr == 1) PG8_BAR;
        PG8_WAIT_V(2); PG8_BAR;
        PG8_STAGE(PG8_SB(1, 0), cB + kstep, voffB); PG8_STAGE(PG8_SA(1, 0), cA + kstep, voffA); PG8_STAGE(PG8_SB(1, 1), cB + hstep + kstep, voffB);
        PG8_WAIT_V(6); PG8_BAR;
    } else {
        PG8_STAGE(PG8_SB(0, 0), cB, voffB); PG8_STAGE(PG8_SA(0, 0), cA, voffA); PG8_STAGE(PG8_SB(0, 1), cB + hstep, voffB); PG8_STAGE(PG8_SA(0, 1), cA + hstep, voffA);
        if (wr == 1) PG8_BAR;
        PG8_WAIT_V(4); PG8_BAR;
        PG8_STAGE(PG8_SB(1, 0), cB + kstep, voffB); PG8_STAGE(PG8_SA(1, 0), cA + kstep, voffA); PG8_STAGE(PG8_SB(1, 1), cB + hstep + kstep, voffB);
        PG8_WAIT_V(6); PG8_BAR;
    }
    for (;;) {
        const bool has_next = S.next(ui + 1, nxt);
        const char* nA = has_next ? (const char*)g.A + (size_t)nxt.pm * tstep : cA; const char* nB = has_next ? (const char*)g.Bt + (size_t)nxt.pn * tstep : cB;
        for (int t = 0; t < nt; t += 2) {
            const bool last = (t == nt - 2);
            const char* a1 = cA + (size_t)(t + 1) * kstep;
            const char* a2 = last ? nA : cA + (size_t)(t + 2) * kstep; const char* b2 = last ? nB : cB + (size_t)(t + 2) * kstep;
            const char* a3 = a2 + kstep; const char* b3 = b2 + kstep;
            if (last && has_next) S.a_ready(nxt);
            if constexpr (SP2) {
            PG8_LDB(B0, 0, 0); PG8_LDB(B1, 0, 1); PG8_SCHED; PG8_LDA(At, 0, 0); PG8_STAGE(PG8_SA(1, 1), a1 + hstep, voffA);
            PG8_WAIT_V(8); PG8_WAIT_L(0); PG8_BAR; PG8_MMA(0, 0, At, B0); PG8_MMA(0, 1, At, B1); PG8_BAR; PG8_SCHED;
            PG8_LDA(At, 0, 1); PG8_STAGE(PG8_SB(0, 0), b2, voffB); PG8_STAGE(PG8_SB(0, 1), b2 + hstep, voffB); PG8_STAGE(PG8_SA(0, 0), a2, voffA);
            PG8_WAIT_V(8); PG8_WAIT_L(0); PG8_BAR; PG8_MMA(1, 0, At, B0); PG8_MMA(1, 1, At, B1); PG8_BAR; PG8_SCHED;
            PG8_LDB(B0, 1, 0); PG8_LDB(B1, 1, 1); PG8_SCHED; PG8_LDA(At, 1, 0); PG8_STAGE(PG8_SA(0, 1), a2 + hstep, voffA);
            PG8_WAIT_V(8); PG8_WAIT_L(0); PG8_BAR; PG8_MMA(0, 0, At, B0); PG8_MMA(0, 1, At, B1); PG8_BAR; PG8_SCHED;
            PG8_LDA(At, 1, 1); PG8_STAGE(PG8_SB(1, 0), b3, voffB); PG8_STAGE(PG8_SB(1, 1), b3 + hstep, voffB); PG8_STAGE(PG8_SA(1, 0), a3, voffA);
            PG8_WAIT_V(8); PG8_WAIT_L(0); PG8_BAR; PG8_MMA(1, 0, At, B0); PG8_MMA(1, 1, At, B1); PG8_BAR; PG8_SCHED;
            } else {
            PG8_LDB(B0, 0, 0); PG8_SCHED; PG8_LDA(At, 0, 0); PG8_STAGE(PG8_SA(1, 1), a1 + hstep, voffA);
            PG8_WAIT_L(8); PG8_BAR; PG8_WAIT_L(0); PG8_MMA(0, 0, At, B0); PG8_BAR; PG8_SCHED;
            PG8_LDB(B1, 0, 1); PG8_STAGE(PG8_SB(0, 0), b2, voffB);
            PG8_BAR; PG8_WAIT_L(0); PG8_MMA(0, 1, At, B1); PG8_BAR;
            PG8_LDA(At, 0, 1); PG8_STAGE(PG8_SA(0, 0), a2, voffA);
            PG8_BAR; PG8_WAIT_L(0); PG8_MMA(1, 0, At, B0); PG8_BAR; PG8_SCHED;
            PG8_STAGE(PG8_SB(0, 1), b2 + hstep, voffB);
            PG8_WAIT_V(6); PG8_BAR; PG8_MMA(1, 1, At, B1); PG8_BAR;
            PG8_LDB(B0, 1, 0); PG8_SCHED; PG8_LDA(At, 1, 0); PG8_STAGE(PG8_SA(0, 1), a2 + hstep, voffA);
            PG8_WAIT_L(8); PG8_BAR; PG8_WAIT_L(0); PG8_MMA(0, 0, At, B0); PG8_BAR; PG8_SCHED;
            PG8_LDB(B1, 1, 1); PG8_STAGE(PG8_SB(1, 0), b3, voffB);
            PG8_BAR; PG8_WAIT_L(0); PG8_MMA(0, 1, At, B1); PG8_BAR;
            PG8_LDA(At, 1, 1); PG8_STAGE(PG8_SA(1, 0), a3, voffA);
            PG8_BAR; PG8_WAIT_L(0); PG8_MMA(1, 0, At, B0); PG8_BAR; PG8_SCHED;
            PG8_STAGE(PG8_SB(1, 1), b3 + hstep, voffB);
            PG8_WAIT_V(6); PG8_BAR; PG8_MMA(1, 1, At, B1); PG8_BAR;
            }
        }
        if constexpr (ALIGN_EPI) { if (wr == 0) PG8_BAR; }
        if constexpr (!Epi::AFTER_DRAIN) { E(acc, cur, wr, wc, fr, fq); S.done(cur); }
        if (!has_next) break;
#pragma unroll
        for (int a = 0; a < 2; ++a)
#pragma unroll
            for (int b = 0; b < 2; ++b)
#pragma unroll
                for (int m = 0; m < 4; ++m)
#pragma unroll
                    for (int n = 0; n < 2; ++n) acc[a][b][m][n] = (f32x4){0.f, 0.f, 0.f, 0.f};
        cur = nxt; cA = nA; cB = nB; ++ui;
        if constexpr (ALIGN_EPI) { if (wr == 1) PG8_BAR; }
    }
    PG8_WAIT_V(0);
    if constexpr (!ALIGN_EPI) { if (wr == 0) PG8_BAR; }
    PG8_BAR;
    if constexpr (Epi::AFTER_DRAIN) { E.fused(acc, cur, wr, wc, fr, fq, lds, wid, lane); S.done(cur); }
#undef PG8_SA
#undef PG8_SB
#undef PG8_STAGE
#undef PG8_LDA
#undef PG8_LDB
#undef PG8_MMA
#undef PG8_WAIT_V
#undef PG8_WAIT_L
#undef PG8_BAR
#undef PG8_SCHED
}
}

__device__ __forceinline__ u32x4 pack8(const f32x4& a, const f32x4& b) { u32x4 w; w.x = pk2(a.x, a.y); w.y = pk2(a.z, a.w); w.z = pk2(b.x, b.y); w.w = pk2(b.z, b.w); return w; }
__device__ __forceinline__ void rope4(f32x4& v, const f32x2 cs0, const f32x2 cs1) {
    const float a0 = v.x * cs0.x - v.y * cs0.y, a1 = v.x * cs0.y + v.y * cs0.x, a2 = v.z * cs1.x - v.w * cs1.y, a3 = v.z * cs1.y + v.w * cs1.x;
    v.x = a0; v.y = a1; v.z = a2; v.w = a3;
}
struct EpiMix {
    static constexpr bool PERM = true, AFTER_DRAIN = false;
    const Params* pp; int l;
    __device__ __forceinline__ void operator()(const f32x4 (&acc)[2][2][4][2], const Unit& u, int wr, int wc, int fr, int fq) const {
        const Params& p = *pp;
        const int pn = u.pn, R0 = u.pm * 256; const bool smp = R0 >= MP;
        const int b = smp ? (R0 - MP) >> 11 : R0 >> 8, t0 = smp ? (R0 - MP) & 2047 : 0;
        const f32x2* cs_row = (const f32x2*)(p.ws + WS_ROPE); const f32x2* cs_col = cs_row + 32 * 16;
        if (pn >= 11) {
            bf16_t* dst = (bf16_t*)(p.ws + (pn < 13 ? Z_CU : Z_CV)) + ((pn - 11) & 1) * 256 + wc * 32 + 8 * fq;
#pragma unroll
            for (int ai = 0; ai < 2; ++ai)
#pragma unroll
                for (int m = 0; m < 4; ++m) { const int R = R0 + ai * 128 + wr * 64 + m * 16 + fr;
#pragma unroll
                    for (int bj = 0; bj < 2; ++bj) { f32x4 v0 = acc[ai][bj][m][0], v1 = acc[ai][bj][m][1];
#pragma unroll
                        for (int r = 0; r < 4; ++r) { v0[r] = gelu_tanh(v0[r]); v1[r] = gelu_tanh(v1[r]); }
                        *(u32x4*)(dst + (size_t)R * RW + bj * 128) = pack8(v0, v1); } }
            return;
        }
        const int kind = pn >> 1;
        const bool is_k = (pn == 10 && wc < 2), is_v = (pn == 10 && wc >= 2);
        const float* gqk = (kind == 4 ? p.in[I_GQ] : p.in[I_GK]) + l * HD + 8 * fq;
        const int head = (pn & 1) * 4 + wc;
        const bool norm = (kind == 4 || is_k), rope = smp && (kind == 0 || kind == 1 || kind == 4 || is_k);
        const float post = kind == 1 ? 0.125f : (kind == 4 ? C2 : 1.0f);
#pragma unroll
        for (int ai = 0; ai < 2; ++ai)
#pragma unroll
            for (int m = 0; m < 4; ++m) {
                const int rr = ai * 128 + wr * 64 + m * 16 + fr, R = R0 + rr, t = t0 + rr;
                float rs = 1.0f;
                if (norm) {
                    float ss = 0.f;
#pragma unroll
                    for (int bj = 0; bj < 2; ++bj)
#pragma unroll
                        for (int n = 0; n < 2; ++n) { const f32x4 x = acc[ai][bj][m][n]; ss += (x.x * x.x + x.y * x.y) + (x.z * x.z + x.w * x.w); }
                    ss += __shfl_xor(ss, 16); ss += __shfl_xor(ss, 32);
                    rs = rsqrtf(ss * (1.f / HD) + EPS);
                }
                bf16_t* dst;
                if (kind < 5) dst = (bf16_t*)(p.ws + (kind == 0 ? Z_RQ : kind == 1 ? Z_RK : kind == 2 ? Z_RV : kind == 3 ? Z_RG : Z_AQ)) + (size_t)R * RW + head * HD + 8 * fq;
                else { const int hk = wc & 1;
                    if (smp) dst = (bf16_t*)(p.ws + (is_k ? Z_KS : Z_VS)) + ((size_t)b * SKV_S + PAST + t) * KVW + hk * HD + 8 * fq;
                    else dst = (bf16_t*)(p.ws + (is_k ? Z_KP : Z_VP)) + ((size_t)b * SEQ_P + t) * KVW + hk * HD + 8 * fq; }
                float* cdst = p.out + (is_k ? OUT_CK : OUT_CV) + ((size_t)((b * 2 + l) * SEQ_P + t) * 2 + (wc & 1)) * HD + 8 * fq;
#pragma unroll
                for (int bj = 0; bj < 2; ++bj) {
                    f32x4 v0 = acc[ai][bj][m][0], v1 = acc[ai][bj][m][1];
                    if (norm) { const f32x4 g0 = *(const f32x4*)(gqk + 32 * bj), g1 = *(const f32x4*)(gqk + 32 * bj + 4); v0 = v0 * rs * g0; v1 = v1 * rs * g1; }
                    if (pn == 10 && !smp) { *(f32x4*)(cdst + 32 * bj) = v0; *(f32x4*)(cdst + 32 * bj + 4) = v1; }
                    if (kind == 3) {
#pragma unroll
                        for (int r = 0; r < 4; ++r) { v0[r] = siluf_(v0[r]); v1[r] = siluf_(v1[r]); } }
                    if (rope) {
                        const f32x2* tab = (bj == 0 ? cs_row + (t >> 6) * 16 : cs_col + (t & 63) * 16) + 4 * fq;
                        rope4(v0, tab[0], tab[1]); rope4(v1, tab[2], tab[3]); }
                    v0 = v0 * post; v1 = v1 * post;
                    *(u32x4*)(dst + 32 * bj) = pack8(v0, v1);
                    asm volatile("" ::: "memory");
                }
            }
    }
};
struct EpiGate {
    static constexpr bool PERM = true, AFTER_DRAIN = false;
    const Params* pp;
    __device__ __forceinline__ void operator()(const f32x4 (&acc)[2][2][4][2], const Unit& u, int wr, int wc, int fr, int fq) const {
        const int x = u.pn >> 2; bf16_t* dst = (bf16_t*)(pp->ws + Z_GATE) + (size_t)x * M * DM + (u.pn & 3) * 256 + wc * 32 + 8 * fq;
#pragma unroll
        for (int ai = 0; ai < 2; ++ai)
#pragma unroll
            for (int m = 0; m < 4; ++m) { const int R = u.pm * 256 + ai * 128 + wr * 64 + m * 16 + fr;
#pragma unroll
                for (int bj = 0; bj < 2; ++bj) { f32x4 v0 = acc[ai][bj][m][0], v1 = acc[ai][bj][m][1];
#pragma unroll
                    for (int r = 0; r < 4; ++r) { v0[r] = sigmoidf_(v0[r]); v1[r] = sigmoidf_(v1[r]); }
                    *(u32x4*)(dst + (size_t)R * DM + bj * 128) = pack8(v0, v1); } }
    }
};
struct EpiMerge {
    static constexpr bool PERM = true, AFTER_DRAIN = false;
    const Params* pp;
    __device__ __forceinline__ void operator()(const f32x4 (&acc)[2][2][4][2], const Unit& u, int wr, int wc, int fr, int fq) const {
        const int x = u.pn >> 2, pm = u.pm - 80 * x, gi = x == 0 ? 1 : x == 1 ? 2 : 0;
        const int col0 = (u.pn & 3) * 256 + wc * 32 + 8 * fq;
        const bf16_t* gate = (const bf16_t*)(pp->ws + Z_GATE) + (size_t)gi * M * DM + col0; bf16_t* dst = (bf16_t*)(pp->ws + WS_XN) + col0;
#pragma unroll
        for (int ai = 0; ai < 2; ++ai)
#pragma unroll
            for (int m = 0; m < 4; ++m) { const int R = pm * 256 + ai * 128 + wr * 64 + m * 16 + fr;
#pragma unroll
                for (int bj = 0; bj < 2; ++bj) { f32x4 v0 = acc[ai][bj][m][0], v1 = acc[ai][bj][m][1];
                    const u32x4 g = *(const u32x4*)(gate + (size_t)R * DM + bj * 128);
                    v0.x *= bflo(g.x); v0.y *= bfhi(g.x); v0.z *= bflo(g.y); v0.w *= bfhi(g.y); v1.x *= bflo(g.z); v1.y *= bfhi(g.z); v1.z *= bflo(g.w); v1.w *= bfhi(g.w);
                    if (x != 0) { const u32x4 o = *(const u32x4*)(dst + (size_t)R * DM + bj * 128);
                        v0.x += bflo(o.x); v0.y += bfhi(o.x); v0.z += bflo(o.y); v0.w += bfhi(o.y); v1.x += bflo(o.z); v1.y += bfhi(o.z); v1.z += bflo(o.w); v1.w += bfhi(o.w); }
                    *(u32x4*)(dst + (size_t)R * DM + bj * 128) = pack8(v0, v1); } }
    }
};
struct EpiRes {
    static constexpr bool PERM = false, AFTER_DRAIN = false;
    const Params* pp; int l, part; bool from_inputs;
    __device__ __forceinline__ void operator()(const f32x4 (&acc)[2][2][4][2], const Unit& u, int wr, int wc, int fr, int fq) const {
        const Params& p = *pp; const int R0 = u.pm * 256; const int ci = row_ci(R0);
        const float* gv = mod_ptr(p, l, ci, part) + u.pn * 256 + wc * 32 + 4 * fq;
        f32x4 g[2][2];
#pragma unroll
        for (int bj = 0; bj < 2; ++bj)
#pragma unroll
            for (int n = 0; n < 2; ++n) g[bj][n] = *(const f32x4*)(gv + bj * 128 + n * 16);
#pragma unroll
        for (int ai = 0; ai < 2; ++ai)
#pragma unroll
            for (int m = 0; m < 4; ++m) { const int R = R0 + ai * 128 + wr * 64 + m * 16 + fr;
                const float* xs = (from_inputs ? x_row(p, 0, R) : p.out + (size_t)R * DM) + u.pn * 256 + wc * 32 + 4 * fq;
                float* xo = p.out + (size_t)R * DM + u.pn * 256 + wc * 32 + 4 * fq;
#pragma unroll
                for (int bj = 0; bj < 2; ++bj)
#pragma unroll
                    for (int n = 0; n < 2; ++n) { const f32x4 xv = *(const f32x4*)(xs + bj * 128 + n * 16); *(f32x4*)(xo + bj * 128 + n * 16) = xv + g[bj][n] * acc[ai][bj][m][n]; } }
    }
};
struct EpiFF1 {
    static constexpr bool PERM = true, AFTER_DRAIN = false;
    const Params* pp;
    __device__ __forceinline__ void operator()(const f32x4 (&acc)[2][2][4][2], const Unit& u, int wr, int wc, int fr, int fq) const {
        bf16_t* dst = (bf16_t*)(pp->ws + Z_HB) + u.pn * 256 + wc * 32 + 8 * fq;
#pragma unroll
        for (int ai = 0; ai < 2; ++ai)
#pragma unroll
            for (int m = 0; m < 4; ++m) { const int R = u.pm * 256 + ai * 128 + wr * 64 + m * 16 + fr;
#pragma unroll
                for (int bj = 0; bj < 2; ++bj) { f32x4 v0 = acc[ai][bj][m][0], v1 = acc[ai][bj][m][1];
#pragma unroll
                    for (int r = 0; r < 4; ++r) { const float a = fmaxf(v0[r], 0.f), b = fmaxf(v1[r], 0.f); v0[r] = a * a; v1[r] = b * b; }
                    *(u32x4*)(dst + (size_t)R * DFF + bj * 128) = pack8(v0, v1); } }
    }
};

__device__ __forceinline__ void attn_simple(const Params& p, const Ctx& c) {
    LAS float* Kt = (LAS float*)c.lds; LAS float* Vt = Kt + 32 * 64; LAS float* Sc = Vt + 32 * 64;
    constexpr int NU_S = NB_S * NH * 4, NU_P = NB_P * NH;
    for (int u = c.bx; u < NU_S + NU_P; u += c.G) {
        const bool smp = u < NU_S; int b, h, q0, nq, skv; const bf16_t *Kb, *Vb; size_t rowbase;
        if (smp) { b = u / 32; h = (u / 4) & 7; q0 = (u & 3) * 512; nq = 512; skv = SKV_S; Kb = (const bf16_t*)(p.ws + Z_KS) + (size_t)b * SKV_S * KVW; Vb = (const bf16_t*)(p.ws + Z_VS) + (size_t)b * SKV_S * KVW; rowbase = MP + (size_t)b * SEQ_S + q0; }
        else { const int v = u - NU_S; b = v / 8; h = v & 7; q0 = 0; nq = 256; skv = SKV_P; Kb = (const bf16_t*)(p.ws + Z_KP) + (size_t)b * SEQ_P * KVW; Vb = (const bf16_t*)(p.ws + Z_VP) + (size_t)b * SEQ_P * KVW; rowbase = (size_t)b * SEQ_P; }
        const int hk = h >> 2; const bool act = c.tid < nq;
        bf16_t* qrow = (bf16_t*)(p.ws + Z_AQ) + (rowbase + (act ? c.tid : 0)) * RW + h * HD;
        float q[64], o[64]; float mx = -1e30f, lsum = 0.f;
#pragma unroll
        for (int i = 0; i < 8; ++i) { const u32x4 w = *(const u32x4*)(qrow + 8 * i); q[8 * i] = bflo(w.x); q[8 * i + 1] = bfhi(w.x); q[8 * i + 2] = bflo(w.y); q[8 * i + 3] = bfhi(w.y); q[8 * i + 4] = bflo(w.z); q[8 * i + 5] = bfhi(w.z); q[8 * i + 6] = bflo(w.w); q[8 * i + 7] = bfhi(w.w); }
#pragma unroll
        for (int i = 0; i < 64; ++i) o[i] = 0.f;
        for (int k0 = 0; k0 < skv; k0 += 32) {
            __syncthreads();
            { const int e = c.tid * 4, j = e >> 6, d = e & 63;
                const u32x2 kw = *(const u32x2*)(Kb + (size_t)(k0 + j) * KVW + hk * HD + d), vw = *(const u32x2*)(Vb + (size_t)(k0 + j) * KVW + hk * HD + d);
                *(LAS f32x4*)(Kt + e) = (f32x4){bflo(kw.x), bfhi(kw.x), bflo(kw.y), bfhi(kw.y)}; *(LAS f32x4*)(Vt + e) = (f32x4){bflo(vw.x), bfhi(vw.x), bflo(vw.y), bfhi(vw.y)}; }
            __syncthreads();
            float tm = mx;
#pragma unroll 1
            for (int j = 0; j < 32; ++j) { float a = 0.f;
#pragma unroll
                for (int d4 = 0; d4 < 16; ++d4) { const f32x4 kv = *(const LAS f32x4*)(Kt + j * 64 + 4 * d4); a += q[4 * d4] * kv.x + q[4 * d4 + 1] * kv.y + q[4 * d4 + 2] * kv.z + q[4 * d4 + 3] * kv.w; }
                Sc[j * 512 + c.tid] = a; tm = fmaxf(tm, a); }
            const float corr = exp2f(mx - tm); mx = tm; lsum *= corr;
#pragma unroll
            for (int i = 0; i < 64; ++i) o[i] *= corr;
#pragma unroll 1
            for (int j = 0; j < 32; ++j) { const float pj = exp2f(Sc[j * 512 + c.tid] - mx); lsum += pj;
#pragma unroll
                for (int d4 = 0; d4 < 16; ++d4) { const f32x4 vv = *(const LAS f32x4*)(Vt + j * 64 + 4 * d4); o[4 * d4] += pj * vv.x; o[4 * d4 + 1] += pj * vv.y; o[4 * d4 + 2] += pj * vv.z; o[4 * d4 + 3] += pj * vv.w; } }
        }
        if (act) { const float il = 1.f / lsum;
#pragma unroll
            for (int i = 0; i < 8; ++i) { u32x4 w; w.x = pk2(o[8 * i] * il, o[8 * i + 1] * il); w.y = pk2(o[8 * i + 2] * il, o[8 * i + 3] * il); w.z = pk2(o[8 * i + 4] * il, o[8 * i + 5] * il); w.w = pk2(o[8 * i + 6] * il, o[8 * i + 7] * il); *(u32x4*)(qrow + 8 * i) = w; } }
    }
    __syncthreads();
}
__device__ __forceinline__ void cmlp_simple(const Params& p, const Ctx& c, int l) {
    LAS float* Vt = (LAS float*)c.lds;
    LAS float* rs = Vt + 128 * 128;
    const bf16_t* cv = (const bf16_t*)(p.ws + Z_CV); bf16_t* cu = (bf16_t*)(p.ws + Z_CU);
    for (int u = c.bx; u < NCHUNK * 4; u += c.G) {
        const int ch = u >> 2, g = u & 3; const size_t R0 = (size_t)ch * 128;
        __syncthreads();
        { const int q = c.tid >> 2, part = c.tid & 3; float ss = 0.f;
            const bf16_t* r = cv + (R0 + q) * RW + part * 128;
#pragma unroll
            for (int i = 0; i < 16; ++i) { const u32x4 w = *(const u32x4*)(r + 8 * i); const float a0 = bflo(w.x), a1 = bfhi(w.x), a2 = bflo(w.y), a3 = bfhi(w.y), a4 = bflo(w.z), a5 = bfhi(w.z), a6 = bflo(w.w), a7 = bfhi(w.w);
                ss += (a0 * a0 + a1 * a1) + (a2 * a2 + a3 * a3) + (a4 * a4 + a5 * a5) + (a6 * a6 + a7 * a7); }
            ss += __shfl_xor(ss, 1); ss += __shfl_xor(ss, 2);
            if (part == 0) rs[q] = rsqrtf(ss * (1.f / RW) + EPS); }
        __syncthreads();
        for (int e = c.tid; e < 128 * 128 / 8; e += 512) { const int q = e >> 4, c8 = (e & 15) * 8; const float r = rs[q];
            const u32x4 w = *(const u32x4*)(cv + (R0 + q) * RW + g * 128 + c8);
            *(LAS f32x4*)(Vt + q * 128 + c8) = (f32x4){bflo(w.x) * r, bfhi(w.x) * r, bflo(w.y) * r, bfhi(w.y) * r};
            *(LAS f32x4*)(Vt + q * 128 + c8 + 4) = (f32x4){bflo(w.z) * r, bfhi(w.z) * r, bflo(w.w) * r, bfhi(w.w) * r}; }
        __syncthreads();
        const int cc = c.tid & 127, pg = __builtin_amdgcn_readfirstlane(c.tid >> 7);
        const float* Ws = p.in[I_CMWS] + ((size_t)(l * 4 + g) * 128) * 128; const float* bs = p.in[I_CMBS] + (l * 4 + g) * 128;
        const float gn = p.in[I_CMNORM][l * RW + g * 128 + cc];
        for (int pi = 0; pi < 32; ++pi) { const int pr = pg * 32 + pi; const float* wrow = Ws + pr * 128; float a = 0.f;
#pragma unroll 8
            for (int q = 0; q < 128; ++q) a += wrow[q] * Vt[q * 128 + cc];
            bf16_t* up = cu + (R0 + pr) * RW + g * 128 + cc;
            const float uu = bf2f(*up);
            *up = (bf16_t)f2bf(uu * (gn * a + bs[pr])); }
    }
    __syncthreads();
}
__device__ __forceinline__ float ret_ld(const Params& p, int l, int dir, int h) { const float x = p.in[I_DECAY][(l * 2 + dir) * NH + h]; return -log1pf(__expf(x)); }
__device__ __forceinline__ void retU_simple(const Params& p, const Ctx& c, int l) {
    LAS float* Kt = (LAS float*)c.lds; LAS float* Vt = Kt + 128 * 64; LAS float* wf = Vt + 128 * 64; LAS float* wb = wf + 128;
    float* U = (float*)(p.ws + Z_U);
    for (int u = c.bx; u < NCHUNK * NH; u += c.G) {
        const int ch = u >> 3, h = u & 7; const size_t R0 = (size_t)ch * 128;
        const float ldf = ret_ld(p, l, 0, h), ldb = ret_ld(p, l, 1, h);
        __syncthreads();
        if (c.tid < 128) { wf[c.tid] = __expf(ldf * (float)(127 - c.tid)); wb[c.tid] = __expf(ldb * (float)c.tid); }
        for (int e = c.tid; e < 128 * 64 / 8; e += 512) { const int j = e >> 3, d8 = (e & 7) * 8;
            const u32x4 kw = *(const u32x4*)((const bf16_t*)(p.ws + Z_RK) + (R0 + j) * RW + h * HD + d8), vw = *(const u32x4*)((const bf16_t*)(p.ws + Z_RV) + (R0 + j) * RW + h * HD + d8);
            *(LAS f32x4*)(Kt + j * 64 + d8) = (f32x4){bflo(kw.x), bfhi(kw.x), bflo(kw.y), bfhi(kw.y)}; *(LAS f32x4*)(Kt + j * 64 + d8 + 4) = (f32x4){bflo(kw.z), bfhi(kw.z), bflo(kw.w), bfhi(kw.w)};
            *(LAS f32x4*)(Vt + j * 64 + d8) = (f32x4){bflo(vw.x), bfhi(vw.x), bflo(vw.y), bfhi(vw.y)}; *(LAS f32x4*)(Vt + j * 64 + d8 + 4) = (f32x4){bflo(vw.z), bfhi(vw.z), bflo(vw.w), bfhi(vw.w)}; }
        __syncthreads();
        const int e = c.tid & 63, d0 = __builtin_amdgcn_readfirstlane(c.tid >> 6) * 8;
        float uf[8], ub[8];
#pragma unroll
        for (int i = 0; i < 8; ++i) { uf[i] = 0.f; ub[i] = 0.f; }
        for (int j = 0; j < 128; ++j) { const float v = Vt[j * 64 + e], vf = v * wf[j], vb = v * wb[j];
            const f32x4 k0 = *(const LAS f32x4*)(Kt + j * 64 + d0), k1 = *(const LAS f32x4*)(Kt + j * 64 + d0 + 4);
            uf[0] += k0.x * vf; uf[1] += k0.y * vf; uf[2] += k0.z * vf; uf[3] += k0.w * vf; uf[4] += k1.x * vf; uf[5] += k1.y * vf; uf[6] += k1.z * vf; uf[7] += k1.w * vf;
            ub[0] += k0.x * vb; ub[1] += k0.y * vb; ub[2] += k0.z * vb; ub[3] += k0.w * vb; ub[4] += k1.x * vb; ub[5] += k1.y * vb; ub[6] += k1.z * vb; ub[7] += k1.w * vb; }
        float* Uf = U + ((size_t)(0 * NCHUNK + ch) * NH + h) * 4096, *Ub = U + ((size_t)(1 * NCHUNK + ch) * NH + h) * 4096;
#pragma unroll
        for (int i = 0; i < 8; ++i) { Uf[(d0 + i) * 64 + e] = uf[i]; Ub[(d0 + i) * 64 + e] = ub[i]; }
    }
    __syncthreads();
}
__device__ __forceinline__ void retO_simple(const Params& p, const Ctx& c, int l) {
    LAS float* Kt = (LAS float*)c.lds; LAS float* Vt = Kt + 128 * 64; LAS float* Sf = Vt + 128 * 64; LAS float* Sb = Sf + 4096; LAS float* pf = Sb + 4096; LAS float* pb = pf + 132;
    const float* U = (const float*)(p.ws + Z_U);
    for (int u = c.bx; u < NCHUNK * NH; u += c.G) {
        const int ch = u >> 3, h = u & 7; const size_t R0 = (size_t)ch * 128; const bool smp = ch >= MP / 128;
        const int nc = smp ? 16 : 2, ch0 = smp ? (MP / 128 + ((ch - MP / 128) & ~15)) : (ch & ~1), cidx = ch - ch0, b = smp ? (ch - MP / 128) >> 4 : ch >> 1;
        const float ldf = ret_ld(p, l, 0, h), ldb = ret_ld(p, l, 1, h); const float Gf = __expf(128.f * ldf), Gb = __expf(128.f * ldb);
        __syncthreads();
        if (c.tid <= 128) { pf[c.tid] = __expf(ldf * (float)c.tid); pb[c.tid] = __expf(ldb * (float)c.tid); }
        for (int e = c.tid; e < 128 * 64 / 8; e += 512) { const int j = e >> 3, d8 = (e & 7) * 8;
            const u32x4 kw = *(const u32x4*)((const bf16_t*)(p.ws + Z_RK) + (R0 + j) * RW + h * HD + d8), vw = *(const u32x4*)((const bf16_t*)(p.ws + Z_RV) + (R0 + j) * RW + h * HD + d8);
            *(LAS f32x4*)(Kt + j * 64 + d8) = (f32x4){bflo(kw.x), bfhi(kw.x), bflo(kw.y), bfhi(kw.y)}; *(LAS f32x4*)(Kt + j * 64 + d8 + 4) = (f32x4){bflo(kw.z), bfhi(kw.z), bflo(kw.w), bfhi(kw.w)};
            *(LAS f32x4*)(Vt + j * 64 + d8) = (f32x4){bflo(vw.x), bfhi(vw.x), bflo(vw.y), bfhi(vw.y)}; *(LAS f32x4*)(Vt + j * 64 + d8 + 4) = (f32x4){bflo(vw.z), bfhi(vw.z), bflo(vw.w), bfhi(vw.w)}; }
        {
            float sf[8], sb[8]; const int e0 = c.tid * 8;
            if (smp) { const float* s0 = p.in[I_ST] + ((size_t)((b * 2 + l) * 2 + 0) * NH + h) * 4096 + e0; const float* s1 = p.in[I_ST] + ((size_t)((b * 2 + l) * 2 + 1) * NH + h) * 4096 + e0;
#pragma unroll
                for (int i = 0; i < 8; ++i) { sf[i] = s0[i]; sb[i] = s1[i]; } }
            else {
#pragma unroll
                for (int i = 0; i < 8; ++i) { sf[i] = 0.f; sb[i] = 0.f; } }
            for (int cc = 0; cc < cidx; ++cc) { const float* uf = U + ((size_t)(0 * NCHUNK + ch0 + cc) * NH + h) * 4096 + e0;
#pragma unroll
                for (int i = 0; i < 8; ++i) sf[i] = Gf * sf[i] + uf[i]; }
            for (int cc = nc - 1; cc > cidx; --cc) { const float* ub = U + ((size_t)(1 * NCHUNK + ch0 + cc) * NH + h) * 4096 + e0;
#pragma unroll
                for (int i = 0; i < 8; ++i) sb[i] = Gb * sb[i] + ub[i]; }
#pragma unroll
            for (int i = 0; i < 8; ++i) { Sf[e0 + i] = sf[i]; Sb[e0 + i] = sb[i]; }
            if (!smp && cidx == nc - 1) { const float* uf = U + ((size_t)(0 * NCHUNK + ch) * NH + h) * 4096 + e0; float* o = p.out + OUT_ST + ((size_t)((b * 2 + l) * 2 + 0) * NH + h) * 4096 + e0;
#pragma unroll
                for (int i = 0; i < 8; ++i) o[i] = Gf * sf[i] + uf[i]; }
            if (!smp && cidx == 0) { const float* ub = U + ((size_t)(1 * NCHUNK + ch) * NH + h) * 4096 + e0; float* o = p.out + OUT_ST + ((size_t)((b * 2 + l) * 2 + 1) * NH + h) * 4096 + e0;
#pragma unroll
                for (int i = 0; i < 8; ++i) o[i] = Gb * sb[i] + ub[i]; }
        }
        __syncthreads();
        const int i = c.tid >> 2, part = c.tid & 3;
        float qp[16], o[16];
        { const bf16_t* qr = (const bf16_t*)(p.ws + Z_RQ) + (R0 + i) * RW + h * HD + part * 16; const u32x4 w0 = *(const u32x4*)qr, w1 = *(const u32x4*)(qr + 8);
            qp[0] = bflo(w0.x); qp[1] = bfhi(w0.x); qp[2] = bflo(w0.y); qp[3] = bfhi(w0.y); qp[4] = bflo(w0.z); qp[5] = bfhi(w0.z); qp[6] = bflo(w0.w); qp[7] = bfhi(w0.w);
            qp[8] = bflo(w1.x); qp[9] = bfhi(w1.x); qp[10] = bflo(w1.y); qp[11] = bfhi(w1.y); qp[12] = bflo(w1.z); qp[13] = bfhi(w1.z); qp[14] = bflo(w1.w); qp[15] = bfhi(w1.w); }
#pragma unroll
        for (int e = 0; e < 16; ++e) o[e] = 0.f;
#pragma unroll 1
        for (int j = 0; j < 128; ++j) { float s = 0.f;
#pragma unroll
            for (int d4 = 0; d4 < 4; ++d4) { const f32x4 kv = *(const LAS f32x4*)(Kt + j * 64 + part * 16 + 4 * d4); s += qp[4 * d4] * kv.x + qp[4 * d4 + 1] * kv.y + qp[4 * d4 + 2] * kv.z + qp[4 * d4 + 3] * kv.w; }
            s += __shfl_xor(s, 1); s += __shfl_xor(s, 2);
            const float w = j < i ? pf[i - j] : (j > i ? pb[j - i] : 2.0f);
            s *= w;
#pragma unroll
            for (int e4 = 0; e4 < 4; ++e4) { const f32x4 vv = *(const LAS f32x4*)(Vt + j * 64 + part * 16 + 4 * e4); o[4 * e4] += s * vv.x; o[4 * e4 + 1] += s * vv.y; o[4 * e4 + 2] += s * vv.z; o[4 * e4 + 3] += s * vv.w; } }
        { const float xf = pf[i + 1], xb = pb[128 - i]; const bf16_t* qfull = (const bf16_t*)(p.ws + Z_RQ) + (R0 + i) * RW + h * HD;
#pragma unroll 2
            for (int d = 0; d < 64; ++d) { const float qd = bf2f(qfull[d]); const float af = qd * xf, ab = qd * xb;
#pragma unroll
                for (int e4 = 0; e4 < 4; ++e4) { const f32x4 a = *(const LAS f32x4*)(Sf + d * 64 + part * 16 + 4 * e4), bb = *(const LAS f32x4*)(Sb + d * 64 + part * 16 + 4 * e4);
                    o[4 * e4] += af * a.x + ab * bb.x; o[4 * e4 + 1] += af * a.y + ab * bb.y; o[4 * e4 + 2] += af * a.z + ab * bb.z; o[4 * e4 + 3] += af * a.w + ab * bb.w; } } }
        float s1 = 0.f;
#pragma unroll
        for (int e = 0; e < 16; ++e) s1 += o[e];
        s1 += __shfl_xor(s1, 1); s1 += __shfl_xor(s1, 2); const float mu = s1 * (1.f / 64.f);
        float s2 = 0.f;
#pragma unroll
        for (int e = 0; e < 16; ++e) { const float d = o[e] - mu; s2 += d * d; }
        s2 += __shfl_xor(s2, 1); s2 += __shfl_xor(s2, 2); const float rstd = rsqrtf(s2 * (1.f / 64.f) + EPS);
        const float* gn = p.in[I_RETGN] + l * RW + h * HD + part * 16;
        const bf16_t* rg = (const bf16_t*)(p.ws + Z_RG) + (R0 + i) * RW + h * HD + part * 16; const u32x4 g0 = *(const u32x4*)rg, g1 = *(const u32x4*)(rg + 8);
        float gs[16] = {bflo(g0.x), bfhi(g0.x), bflo(g0.y), bfhi(g0.y), bflo(g0.z), bfhi(g0.z), bflo(g0.w), bfhi(g0.w), bflo(g1.x), bfhi(g1.x), bflo(g1.y), bfhi(g1.y), bflo(g1.z), bfhi(g1.z), bflo(g1.w), bfhi(g1.w)};
        float y[16];
#pragma unroll
        for (int e = 0; e < 16; ++e) y[e] = (o[e] - mu) * rstd * gn[e] * gs[e];
        bf16_t* dst = (bf16_t*)(p.ws + Z_CV) + (R0 + i) * RW + h * HD + part * 16;
        u32x4 w0, w1; w0.x = pk2(y[0], y[1]); w0.y = pk2(y[2], y[3]); w0.z = pk2(y[4], y[5]); w0.w = pk2(y[6], y[7]); w1.x = pk2(y[8], y[9]); w1.y = pk2(y[10], y[11]); w1.z = pk2(y[12], y[13]); w1.w = pk2(y[14], y[15]);
        *(u32x4*)dst = w0; *(u32x4*)(dst + 8) = w1;
    }
    __syncthreads();
}

#ifndef PG8_MASK
#define PG8_MASK 0xFFF
#endif
template <int KIND, class Epi, class Sched>
__device__ __forceinline__ void gemm_any(const Ctx& c, const bf16_t* A, const bf16_t* Bt, int K, const Sched& S, const Epi& E) {
    if constexpr ((PG8_MASK >> KIND) & 1) { pg8::Gemm g{A, Bt, 0, 0, K}; pg8::gemm_phase<Epi, Sched, true, true>(c.tid, c.lds, g, S, E); }
    else gemm_simple(c, A, Bt, K, S, E);
}
#ifndef KMASK
#define KMASK 0xFFF
#endif
constexpr int NPHASE = 22;
template <int KIND> __device__ __forceinline__ void run_kind(const Params& p, const Ctx& c, int l) {
    const unsigned char* wb = p.ws + WS_W;
    if constexpr (KIND == 0) { p0_modulation(p, c); p0_rope_tables(p, c); p_wconv(p, c, 0); p_kvctx(p, c, 0); }
    else if constexpr (KIND == 1) { p_norm(p, c, 0, 0); }
    else if constexpr (KIND == 2) { StaticOrder S; S.init(M, NMIX, c.G, c.bx); EpiMix E{&p, l}; gemm_any<2>(c, (const bf16_t*)(p.ws + WS_XN), (const bf16_t*)(wb + W_IN), DM, S, E); }
    else if constexpr (KIND == 3) { attn_simple(p, c); cmlp_simple(p, c, l); retU_simple(p, c, l); }
    else if constexpr (KIND == 4) { retO_simple(p, c, l); }
    else if constexpr (KIND == 5) { StaticOrder S; S.init(M, NGATE, c.G, c.bx); EpiGate E{&p}; gemm_any<5>(c, (const bf16_t*)(p.ws + WS_XN), (const bf16_t*)(wb + W_IN) + (size_t)NMIX * DM, DM, S, E); }
    else if constexpr (KIND == 6) { MergeOrder S{c.G, c.bx}; EpiMerge E{&p}; gemm_any<6>(c, (const bf16_t*)(p.ws + Z_AQ), (const bf16_t*)(wb + W_BR), RW, S, E); }
    else if constexpr (KIND == 7) { StaticOrder S; S.init(M, DM, c.G, c.bx); EpiRes E{&p, l, 2, l == 0}; gemm_any<7>(c, (const bf16_t*)(p.ws + WS_XN), (const bf16_t*)(wb + W_OUT), DM, S, E); }
    else if constexpr (KIND == 8) { p_norm(p, c, l, 1); }
    else if constexpr (KIND == 9) { StaticOrder S; S.init(M, DFF, c.G, c.bx); EpiFF1 E{&p}; gemm_any<9>(c, (const bf16_t*)(p.ws + WS_XN), (const bf16_t*)(wb + W_FF1), DM, S, E); }
    else if constexpr (KIND == 10) { StaticOrder S; S.init(M, DM, c.G, c.bx); EpiRes E{&p, l, 5, false}; gemm_any<10>(c, (const bf16_t*)(p.ws + Z_HB), (const bf16_t*)(wb + W_FF2), DFF, S, E); }
    else { if (l == 0) { p_wconv(p, c, 1); p_kvctx(p, c, 1); p_norm(p, c, 1, 0); } else p_final_norm(p, c); }
}
__device__ __forceinline__ void run_phase(const Params& p, const Ctx& c0, int ph) {
    Ctx c = c0; asm volatile("" : "+v"(c.tid));
    c.lane = c.tid & 63; c.wave = __builtin_amdgcn_readfirstlane(c.tid >> 6);
    if (ph == 0) { if (KMASK & 1) run_kind<0>(p, c, 0); return; }
    if (ph == 1) { if (KMASK & 2) run_kind<1>(p, c, 0); return; }
    const int l = (ph - 2) / 10, s = (ph - 2) % 10;
    switch (s) {
    case 0: if (KMASK & (1 << 2)) run_kind<2>(p, c, l); break;
    case 1: if (KMASK & (1 << 3)) run_kind<3>(p, c, l); break;
    case 2: if (KMASK & (1 << 4)) run_kind<4>(p, c, l); break;
    case 3: if (KMASK & (1 << 5)) run_kind<5>(p, c, l); break;
    case 4: if (KMASK & (1 << 6)) run_kind<6>(p, c, l); break;
    case 5: if (KMASK & (1 << 7)) run_kind<7>(p, c, l); break;
    case 6: if (KMASK & (1 << 8)) run_kind<8>(p, c, l); break;
    case 7: if (KMASK & (1 << 9)) run_kind<9>(p, c, l); break;
    case 8: if (KMASK & (1 << 10)) run_kind<10>(p, c, l); break;
    default: if (KMASK & (1 << 11)) run_kind<11>(p, c, l); break;
    }
}

#if N_LAUNCH_MODE == 1
__global__ void __launch_bounds__(512, 2) fwd_kernel(Params p) {
    extern __shared__ __attribute__((aligned(16))) unsigned char lds[];
    Ctx c; c.tid = threadIdx.x; c.lane = c.tid & 63; c.wave = __builtin_amdgcn_readfirstlane(c.tid >> 6); c.G = gridDim.x; c.bx = blockIdx.x; c.lds = (LAS unsigned char*)lds;
    volatile LAS unsigned* MISC = (volatile LAS unsigned*)(c.lds + MISC_OFF);
    if (c.tid < 32) MISC[c.tid] = 0u;
    __syncthreads();
    XcdBarrier bar = xcd_barrier_post((unsigned*)(p.ws + WS_CTL) + CW_BAR, MISC + 8);
    for (int ph = p.ph_lo; ph < p.ph_hi; ++ph) { run_phase(p, c, ph); if (ph + 1 < p.ph_hi) xcd_barrier(bar); }
}
#endif
template <int KIND> __global__ void __launch_bounds__(512, 2) phase_kernel(Params p) {
    extern __shared__ __attribute__((aligned(16))) unsigned char lds[];
    Ctx c; c.tid = threadIdx.x; c.lane = c.tid & 63; c.wave = __builtin_amdgcn_readfirstlane(c.tid >> 6); c.G = gridDim.x; c.bx = blockIdx.x; c.lds = (LAS unsigned char*)lds;
    run_kind<KIND>(p, c, p.ph_hi);
}
template <int KIND> static void launch_kind(Params p, int l, int grid, hipStream_t stream) {
    static bool attr = false;
    if (!attr) { (void)hipFuncSetAttribute((const void*)phase_kernel<KIND>, hipFuncAttributeMaxDynamicSharedMemorySize, LDS_BYTES); attr = true; }
    p.ph_lo = 0; p.ph_hi = l;
    hipLaunchKernelGGL(phase_kernel<KIND>, dim3(grid), dim3(512), LDS_BYTES, stream, p);
}

extern "C" void kernel_launch(void* const* d_in, const int* in_sizes, int n_in, void* d_out, int out_size, void* d_ws, size_t ws_size, hipStream_t stream) {
    static int grid = 0;
    if (grid == 0) {
        int dev = 0, cus = 0;
        if (n_in != N_IN || ws_size < WS_NEED) { grid = -1; return; }
        if (hipGetDevice(&dev) != hipSuccess || hipDeviceGetAttribute(&cus, hipDeviceAttributeMultiprocessorCount, dev) != hipSuccess) { grid = -1; return; }
#if N_LAUNCH_MODE == 1
        if (hipFuncSetAttribute((const void*)fwd_kernel, hipFuncAttributeMaxDynamicSharedMemorySize, LDS_BYTES) != hipSuccess) { grid = -1; return; }
#endif
        grid = cus;
    }
    if (grid < 0) return;
    (void)hipMemsetAsync((char*)d_ws + WS_CTL, 0, WS_ZERO_BYTES, stream);
    Params p{};
    for (int i = 0; i < N_IN; ++i) p.in[i] = (const float*)d_in[i];
    p.out = (float*)d_out; p.ws = (unsigned char*)d_ws;
#if N_LAUNCH_MODE == 1
    p.ph_lo = 0; p.ph_hi = NPHASE;
    hipLaunchKernelGGL(fwd_kernel, dim3(grid), dim3(512), LDS_BYTES, stream, p);
#else
    launch_kind<0>(p, 0, grid, stream); launch_kind<1>(p, 0, grid, stream);
    for (int l = 0; l < 2; ++l) {
        launch_kind<2>(p, l, grid, stream); launch_kind<3>(p, l, grid, stream); launch_kind<4>(p, l, grid, stream); launch_kind<5>(p, l, grid, stream); launch_kind<6>(p, l, grid, stream);
        launch_kind<7>(p, l, grid, stream); launch_kind<8>(p, l, grid, stream); launch_kind<9>(p, l, grid, stream); launch_kind<10>(p, l, grid, stream); launch_kind<11>(p, l, grid, stream);
    }
#endif
}
```

```cpp
#include <hip/hip_runtime.h>
#include <hip/hip_bf16.h>
#include <cstdio>
#include <cstdint>

#ifndef N_LAUNCH_MODE
#define N_LAUNCH_MODE 1
#endif

#define GAS __attribute__((address_space(1)))
#define LAS __attribute__((address_space(3)))
#define RLX_AGENT __ATOMIC_RELAXED, __HIP_MEMORY_SCOPE_AGENT
typedef unsigned short bf16_t;
typedef short bf16x8 __attribute__((ext_vector_type(8)));
typedef float f32x4 __attribute__((ext_vector_type(4)));
typedef float f32x2 __attribute__((ext_vector_type(2)));
typedef unsigned u32x4 __attribute__((ext_vector_type(4)));
typedef unsigned u32x2 __attribute__((ext_vector_type(2)));

constexpr int DM = 1024, MP = 4096, MS = 16384, M = 20480, SEQ_P = 256, SEQ_S = 2048, NB_P = 16, NB_S = 8, PAST = 256;
constexpr int HD = 64, NH = 8, KVW = 128, DFF = 4096, INW = 6912, NMIX = 3840, NGATE = 3072, RW = 512;
constexpr int SKV_S = PAST + SEQ_S, SKV_P = SEQ_P;
constexpr int NCHUNK = M / 128;
constexpr float EPS = 1e-6f;
constexpr float C2 = 0.18033688011112042f;
constexpr size_t OUT_Y = 0, OUT_CK = (size_t)M * DM, OUT_CV = OUT_CK + (size_t)NB_P * 2 * SEQ_P * KVW, OUT_ST = OUT_CV + (size_t)NB_P * 2 * SEQ_P * KVW;

constexpr size_t MiB = 1u << 20;
constexpr size_t WS_CTL = 0;
constexpr size_t WS_MOD = 1 * MiB;
constexpr size_t WS_ROPE = 1 * MiB + 512 * 1024;
constexpr size_t WS_ZERO_BYTES = 1 * MiB + 512 * 1024;
constexpr size_t WS_W = 2 * MiB;
constexpr size_t W_IN = 0, W_BR = W_IN + (size_t)INW * DM * 2, W_OUT = W_BR + (size_t)3 * DM * RW * 2, W_FF1 = W_OUT + (size_t)DM * DM * 2, W_FF2 = W_FF1 + (size_t)DFF * DM * 2, W_END = W_FF2 + (size_t)DM * DFF * 2;
static_assert(W_END <= 35 * MiB, "weights");
constexpr size_t WS_XN = 37 * MiB;
constexpr size_t WS_Z = 77 * MiB;
constexpr size_t Z_RQ = WS_Z, Z_RK = WS_Z + 20 * MiB, Z_RV = WS_Z + 40 * MiB, Z_RG = WS_Z + 60 * MiB, Z_U = WS_Z + 80 * MiB;
constexpr size_t Z_AQ = WS_Z + 120 * MiB, Z_CU = WS_Z + 140 * MiB, Z_CV = WS_Z + 160 * MiB;
constexpr size_t Z_KS = WS_Z + 180 * MiB, Z_VS = Z_KS + (size_t)NB_S * SKV_S * KVW * 2, Z_KP = Z_VS + (size_t)NB_S * SKV_S * KVW * 2, Z_VP = Z_KP + (size_t)NB_P * SEQ_P * KVW * 2, Z_END = Z_VP + (size_t)NB_P * SEQ_P * KVW * 2;
constexpr size_t Z_GATE = WS_Z;
constexpr size_t Z_HB = WS_Z;
constexpr size_t WS_NEED = 268 * MiB;
static_assert(Z_END <= WS_NEED, "ws map");
constexpr int CW_BAR = 4096;

constexpr int LDS_BYTES = 147456;
constexpr int MISC_OFF = 131072 + 320;

__device__ __forceinline__ unsigned f2bf(float f) { unsigned u = __builtin_bit_cast(unsigned, f); return (u + 0x7fffu + ((u >> 16) & 1u)) >> 16; }
__device__ __forceinline__ unsigned pk2(float lo, float hi) { return f2bf(lo) | (f2bf(hi) << 16); }
__device__ __forceinline__ float bf2f(unsigned h) { return __builtin_bit_cast(float, h << 16); }
__device__ __forceinline__ float bflo(unsigned w) { return __builtin_bit_cast(float, w << 16); }
__device__ __forceinline__ float bfhi(unsigned w) { return __builtin_bit_cast(float, w & 0xffff0000u); }
__device__ __forceinline__ float sigmoidf_(float x) { return 1.f / (1.f + __expf(-x)); }
__device__ __forceinline__ float siluf_(float x) { return x / (1.f + __expf(-x)); }
__device__ __forceinline__ float gelu_tanh(float x) { const float u = 0.7978845608028654f * (x + 0.044715f * x * x * x); const float e = __expf(2.f * u); const float th = 1.f - 2.f / (e + 1.f); return 0.5f * x * (1.f + th); }
__device__ __forceinline__ float wave_sum(float v) {
#pragma unroll
    for (int o = 1; o < 64; o <<= 1) v += __shfl_xor(v, o);
    return v;
}

#define XB_TMO      128
#define XB_XCNT(j)  (256  + 64 * (j))
#define XB_XSUB(j)  (1280 + 64 * (j))
#define XB_XGEN(j)  (2304 + 64 * (j))
#define XB_TOP      3328
#define XB_TOPGEN   3392
#define XCD_BAR_WORDS 3456
#define XB_SPIN_CAP (1u << 18)
__device__ __forceinline__ unsigned xb_ld(unsigned* p)              { return __hip_atomic_load(p, __ATOMIC_RELAXED, __HIP_MEMORY_SCOPE_AGENT); }
__device__ __forceinline__ unsigned xb_add(unsigned* p, unsigned v) { return __hip_atomic_fetch_add(p, v, __ATOMIC_RELAXED, __HIP_MEMORY_SCOPE_AGENT); }
__device__ __forceinline__ unsigned xb_xcc_id() { return (unsigned)__builtin_amdgcn_s_getreg((3 << 11) | 20) & 0xFu; }
#define XB_SPIN(cond, bar) do { unsigned _sp = 0; while (cond) { __builtin_amdgcn_s_sleep(1); \
    if ((++_sp & 255u) == 0u) { if (xb_ld(&(bar)[XB_TMO])) break; if (_sp > XB_SPIN_CAP) { atomicAdd(&(bar)[XB_TMO], 1u); break; } } } } while (0)
struct XcdBarrier { unsigned* bar; unsigned x; volatile LAS unsigned* st; };
__device__ __forceinline__ XcdBarrier xcd_barrier_post(unsigned* bar, volatile LAS unsigned* st) {
    XcdBarrier b; b.bar = bar; b.x = xb_xcc_id(); b.st = st;
    if (threadIdx.x == 0) (void)xb_add(&bar[XB_XCNT(b.x)], 1u);
    return b;
}
__device__ __forceinline__ void xcd_barrier_complete(unsigned* bar, unsigned x, unsigned& nloc, unsigned& nx) {
    const unsigned G = gridDim.x * gridDim.y * gridDim.z;
    unsigned sum, cnt, mine, sp = 0u;
    for (;;) {
        sum = 0u; cnt = 0u; mine = 0u;
#pragma unroll
        for (unsigned j = 0; j < 16; ++j) { const unsigned c = xb_ld(&bar[XB_XCNT(j)]); sum += c; cnt += (c > 0u) ? 1u : 0u; mine = (j == x) ? c : mine; }
        if (sum == G) break;
        __builtin_amdgcn_s_sleep(1);
        if ((++sp & 255u) == 0u) { if (xb_ld(&bar[XB_TMO])) break; if (sp > XB_SPIN_CAP) { atomicAdd(&bar[XB_TMO], 1u); break; } }
    }
    nloc = mine > 0u ? mine : 1u; nx = cnt > 0u ? cnt : 1u;
}
__device__ __forceinline__ void xcd_barrier(const XcdBarrier& b) {
    asm volatile("s_waitcnt vmcnt(0)" ::: "memory");
    __syncthreads();
    if (threadIdx.x == 0) {
        unsigned* bar = b.bar;
        __builtin_amdgcn_s_waitcnt(0);
        unsigned nloc = b.st[0], nx = b.st[1];
        if (nloc == 0u) { xcd_barrier_complete(bar, b.x, nloc, nx); b.st[0] = nloc; b.st[1] = nx; }
        const unsigned old = xb_add(&bar[XB_XSUB(b.x)], 1u);
        const unsigned gen = old / nloc;
        if (old + 1u == (gen + 1u) * nloc) {
            __builtin_amdgcn_fence(__ATOMIC_RELEASE, "agent");
            asm volatile("s_waitcnt vmcnt(0)" ::: "memory");
            const unsigned og = xb_add(&bar[XB_TOP], 1u);
            const unsigned tg = og / nx;
            if (og + 1u == (tg + 1u) * nx) xb_add(&bar[XB_TOPGEN], 1u);
            else XB_SPIN(xb_ld(&bar[XB_TOPGEN]) == tg, bar);
            __builtin_amdgcn_fence(__ATOMIC_ACQUIRE, "agent");
            xb_add(&bar[XB_XGEN(b.x)], 1u);
            asm volatile("s_waitcnt vmcnt(0)" ::: "memory");
        } else {
            XB_SPIN(xb_ld(&bar[XB_XGEN(b.x)]) == gen, bar);
            __builtin_amdgcn_fence(__ATOMIC_ACQUIRE, "agent");
            asm volatile("s_waitcnt vmcnt(0)" ::: "memory");
        }
    }
    __syncthreads();
}

enum { I_XP = 0, I_XS, I_CK, I_CV, I_ST, I_C, I_CCTX, I_WMOD, I_BMOD, I_GN1, I_GN2, I_WIN, I_GQ, I_GK, I_DECAY, I_RETGN, I_CMNORM, I_CMWS, I_CMBS, I_WBRR, I_WBRA, I_WBRC, I_WOUT, I_WFF1, I_WFF2, I_GFIN, N_IN };
struct Params { const float* in[N_IN]; float* out; unsigned char* ws; int ph_lo, ph_hi; };
static_assert(sizeof(Params) == N_IN * 8 + 8 + 8 + 8, "no padding");

struct Ctx {
    int tid, lane, wave, G, bx;
    LAS unsigned char* lds;
};
__device__ __forceinline__ int row_ci(int R) { return R < MP ? 0 : 1 + ((R - MP) >> 11); }
__device__ __forceinline__ const float* mod_ptr(const Params& p, int l, int ci, int part) { return (const float*)(p.ws + WS_MOD) + ((size_t)(l * 9 + ci) * 6 + part) * DM; }

__device__ __forceinline__ void p0_modulation(const Params& p, const Ctx& c) {
    LAS float* sl = (LAS float*)c.lds;
    for (int i = c.tid; i < 9 * DM; i += 512) { const int ci = i >> 10, k = i & 1023; const float v = ci == 0 ? p.in[I_CCTX][k] : p.in[I_C][(ci - 1) * DM + k]; sl[i] = siluf_(v); }
    __syncthreads();
    float* mod = (float*)(p.ws + WS_MOD);
    const int gw = c.bx * 8 + c.wave, NGW = c.G * 8;
    constexpr int NITEM = 2 * 96 * 8;
    for (int it = gw; it < NITEM; it += NGW) {
        const int l = it / 768, r = it % 768, cb = r >> 3, ks = r & 7;
        const float* W = p.in[I_WMOD] + (size_t)l * DM * 6144 + (size_t)(ks * 128) * 6144 + cb * 64 + c.lane;
        float s[9];
#pragma unroll
        for (int ci = 0; ci < 9; ++ci) s[ci] = 0.f;
#pragma unroll 4
        for (int k = 0; k < 128; ++k) {
            const float w = W[(size_t)k * 6144];
#pragma unroll
            for (int ci = 0; ci < 9; ++ci) s[ci] += sl[ci * DM + ks * 128 + k] * w;
        }
        const float bias = ks == 0 ? p.in[I_BMOD][l * 6144 + cb * 64 + c.lane] : 0.f;
#pragma unroll
        for (int ci = 0; ci < 9; ++ci) atomicAdd(mod + (size_t)(l * 9 + ci) * 6144 + cb * 64 + c.lane, s[ci] + bias);
    }
    __syncthreads();
}
__device__ __forceinline__ void p0_rope_tables(const Params& p, const Ctx& c) {
    f32x2* tab = (f32x2*)(p.ws + WS_ROPE);
    const int g = c.bx * 512 + c.tid;
    if (g < 96 * 16) { const int pos = g >> 4, i = g & 15; const float inv = 1.0f / powf(10000.0f, (float)(2 * i) / 32.0f); const float posf = pos < 32 ? (float)pos : (float)(pos - 32);
        const float ang = posf * inv; f32x2 v; v.x = cosf(ang); v.y = sinf(ang); tab[g] = v; }
}
__device__ __forceinline__ int win_colmap(int n) {
    const int tile = n >> 8, pp = n & 255, bj = pp >> 7, wc = (pp >> 5) & 3;
    if (tile < 10) return (tile >> 1) * 512 + ((tile & 1) * 4 + wc) * 64 + 32 * bj;
    if (tile == 10) return (wc < 2 ? 2560 + wc * 64 : 2688 + (wc - 2) * 64) + 32 * bj;
    return n;
}
__device__ __forceinline__ void transpose_item(const float* W, int K, int ldn, int src_col0, bf16_t* WT, int dst_row0, int k0, LAS float* scr, int lane) {
#pragma unroll 8
    for (int i = 0; i < 32; ++i) { const int kk = 2 * i + (lane >> 5); scr[kk * 33 + (lane & 31)] = W[(size_t)(k0 + kk) * ldn + src_col0 + (lane & 31)]; }
    asm volatile("s_waitcnt lgkmcnt(0)" ::: "memory");
    const int ch = lane & 7;
#pragma unroll
    for (int j = 0; j < 4; ++j) { const int n = (lane >> 3) + 8 * j; const LAS float* s = scr + (8 * ch) * 33 + n;
        u32x4 o; o.x = pk2(s[0 * 33], s[1 * 33]); o.y = pk2(s[2 * 33], s[3 * 33]); o.z = pk2(s[4 * 33], s[5 * 33]); o.w = pk2(s[6 * 33], s[7 * 33]);
        *(u32x4*)(WT + (size_t)(dst_row0 + n) * K + k0 + 8 * ch) = o; }
    asm volatile("s_waitcnt lgkmcnt(0)" ::: "memory");
}
__device__ __forceinline__ void p_wconv(const Params& p, const Ctx& c, int l) {
    LAS float* scr = (LAS float*)(c.lds + 40960 + c.wave * 8448);
    const int gw = c.bx * 8 + c.wave, NGW = c.G * 8;
    unsigned char* wb = p.ws + WS_W;
    constexpr int I_IN = 16 * 216, I_BRX = 8 * 32, I_O = 16 * 32, I_F1 = 16 * 128, I_F2 = 64 * 32;
    constexpr int NITEMS = I_IN + 3 * I_BRX + I_O + I_F1 + I_F2;
    for (int it = gw; it < NITEMS; it += NGW) {
        int r = it;
        if (r < I_IN) { const int kb = r / 216, nb = r % 216; transpose_item(p.in[I_WIN] + (size_t)l * DM * INW, DM, INW, win_colmap(nb * 32), (bf16_t*)(wb + W_IN), nb * 32, kb * 64, scr, c.lane); continue; } r -= I_IN;
        if (r < 3 * I_BRX) { const int x = r / I_BRX, rr = r % I_BRX, kb = rr / 32, nb = rr % 32;
            const float* src = (x == 0 ? p.in[I_WBRA] : x == 1 ? p.in[I_WBRC] : p.in[I_WBRR]) + (size_t)l * RW * DM;
            transpose_item(src, RW, DM, nb * 32, (bf16_t*)(wb + W_BR) + (size_t)x * DM * RW, nb * 32, kb * 64, scr, c.lane); continue; } r -= 3 * I_BRX;
        if (r < I_O) { const int kb = r / 32, nb = r % 32; transpose_item(p.in[I_WOUT] + (size_t)l * DM * DM, DM, DM, nb * 32, (bf16_t*)(wb + W_OUT), nb * 32, kb * 64, scr, c.lane); continue; } r -= I_O;
        if (r < I_F1) { const int kb = r / 128, nb = r % 128; transpose_item(p.in[I_WFF1] + (size_t)l * DM * DFF, DM, DFF, nb * 32, (bf16_t*)(wb + W_FF1), nb * 32, kb * 64, scr, c.lane); continue; } r -= I_F1;
        { const int kb = r / 32, nb = r % 32; transpose_item(p.in[I_WFF2] + (size_t)l * DFF * DM, DFF, DM, nb * 32, (bf16_t*)(wb + W_FF2), nb * 32, kb * 64, scr, c.lane); }
    }
}
__device__ __forceinline__ void p_kvctx(const Params& p, const Ctx& c, int l) {
    const int g = c.bx * 512 + c.tid, NG = c.G * 512;
    for (int i = g; i < NB_S * PAST * KVW / 4; i += NG) {
        const int e = i * 4, b = e / (PAST * KVW), r = e % (PAST * KVW);
        const size_t src = ((size_t)(b * 2 + l) * PAST) * KVW + r;
        const f32x4 k = *(const f32x4*)(p.in[I_CK] + src), v = *(const f32x4*)(p.in[I_CV] + src);
        u32x2 ko, vo; ko.x = pk2(k.x, k.y); ko.y = pk2(k.z, k.w); vo.x = pk2(v.x, v.y); vo.y = pk2(v.z, v.w);
        *(u32x2*)((bf16_t*)(p.ws + Z_KS) + (size_t)b * SKV_S * KVW + r) = ko;
        *(u32x2*)((bf16_t*)(p.ws + Z_VS) + (size_t)b * SKV_S * KVW + r) = vo;
    }
}
__device__ __forceinline__ const float* x_row(const Params& p, int l, int R) { return l == 0 ? (R < MP ? p.in[I_XP] + (size_t)R * DM : p.in[I_XS] + (size_t)(R - MP) * DM) : p.out + (size_t)R * DM; }
__device__ __forceinline__ void p_norm(const Params& p, const Ctx& c, int l, int which) {
    const int gw = c.bx * 8 + c.wave, NGW = c.G * 8;
    const float* gvec = (which == 0 ? p.in[I_GN1] : p.in[I_GN2]) + l * DM;
    for (int R = gw; R < M; R += NGW) {
        const float* xr = which == 0 ? x_row(p, l, R) : p.out + (size_t)R * DM;
        const int ci = row_ci(R);
        const float* sh = mod_ptr(p, l, ci, which == 0 ? 0 : 3); const float* sc = mod_ptr(p, l, ci, which == 0 ? 1 : 4);
        f32x4 v[4]; float s = 0.f;
#pragma unroll
        for (int j = 0; j < 4; ++j) { v[j] = *(const f32x4*)(xr + 4 * c.lane + 256 * j); s += (v[j].x * v[j].x + v[j].y * v[j].y) + (v[j].z * v[j].z + v[j].w * v[j].w); }
        const float rstd = rsqrtf(wave_sum(s) * (1.f / DM) + EPS);
        bf16_t* orow = (bf16_t*)(p.ws + WS_XN) + (size_t)R * DM;
#pragma unroll
        for (int j = 0; j < 4; ++j) { const int col = 4 * c.lane + 256 * j; const f32x4 g = *(const f32x4*)(gvec + col), a = *(const f32x4*)(sc + col), b = *(const f32x4*)(sh + col);
            f32x4 o = v[j] * rstd * g * (a + 1.0f) + b; u32x2 w; w.x = pk2(o.x, o.y); w.y = pk2(o.z, o.w); *(u32x2*)(orow + col) = w; }
    }
}
__device__ __forceinline__ void p_final_norm(const Params& p, const Ctx& c) {
    const int gw = c.bx * 8 + c.wave, NGW = c.G * 8;
    for (int R = gw; R < M; R += NGW) {
        float* xr = p.out + (size_t)R * DM;
        f32x4 v[4]; float s = 0.f;
#pragma unroll
        for (int j = 0; j < 4; ++j) { v[j] = *(const f32x4*)(xr + 4 * c.lane + 256 * j); s += (v[j].x * v[j].x + v[j].y * v[j].y) + (v[j].z * v[j].z + v[j].w * v[j].w); }
        const float rstd = rsqrtf(wave_sum(s) * (1.f / DM) + EPS);
#pragma unroll
        for (int j = 0; j < 4; ++j) { const int col = 4 * c.lane + 256 * j; const f32x4 g = *(const f32x4*)(p.in[I_GFIN] + col); *(f32x4*)(xr + col) = v[j] * rstd * g; }
    }
}

struct Unit { int pm, pn; };
__host__ __device__ __forceinline__ int perm32(int rho) { const int n = rho >> 4, i = rho & 15; return 8 * (i >> 2) + 4 * n + (i & 3); }
struct StaticOrder {
    int nM, nN, nwg, G, c;
    __device__ void init(int Mr, int N, int G_, int c_) { nM = Mr / 256; nN = N / 256; nwg = nM * nN; G = G_; c = c_; }
    __device__ bool next(int i, Unit& u) const {
        const long L = (long)i * G + c; if (L >= nwg) return false;
        int wgid = (int)L; { const int q = nwg / 8, r = nwg % 8, xcd = wgid % 8, off = wgid / 8; wgid = (xcd < r ? xcd * (q + 1) : r * (q + 1) + (xcd - r) * q) + off; }
        const int nig = 8 * nN, gid = wgid / nig, fm = gid * 8, gsz = (nM - fm) < 8 ? (nM - fm) : 8;
        u.pm = fm + ((wgid % nig) % gsz); u.pn = (wgid % nig) / gsz; return true;
    }
    __device__ __forceinline__ void a_ready(const Unit&) const {}
    __device__ __forceinline__ void done(const Unit&) const {}
};
struct MergeOrder {
    int G, c;
    __device__ bool next(int i, Unit& u) const {
        const int t = i / 3, x = i % 3; const long L = (long)t * G + c; if (L >= 320) return false;
        u.pm = x * 80 + (int)(L >> 2); u.pn = x * 4 + (int)(L & 3); return true;
    }
    __device__ __forceinline__ void a_ready(const Unit&) const {}
    __device__ __forceinline__ void done(const Unit&) const {}
};
template <class Epi, class Sched>
__device__ __forceinline__ void gemm_simple(const Ctx& c, const bf16_t* A, const bf16_t* Bt, int K, const Sched& S, const Epi& E) {
    const int tid = c.tid, wid = c.wave, lane = tid & 63, wr = wid >> 2, wc = wid & 3, fr = lane & 15, fq = lane >> 4;
    Unit u;
    for (int ui = 0; S.next(ui, u); ++ui) {
        f32x4 acc[2][2][4][2];
#pragma unroll
        for (int a = 0; a < 2; ++a)
#pragma unroll
            for (int b = 0; b < 2; ++b)
#pragma unroll
                for (int m = 0; m < 4; ++m)
#pragma unroll
                    for (int n = 0; n < 2; ++n) acc[a][b][m][n] = (f32x4){0.f, 0.f, 0.f, 0.f};
        const bf16_t* Ar = A + (size_t)(u.pm * 256 + wr * 64 + fr) * K + fq * 8;
        const bf16_t* Br[2];
#pragma unroll
        for (int n = 0; n < 2; ++n) Br[n] = Bt + (size_t)(u.pn * 256 + wc * 32 + (Epi::PERM ? perm32(16 * n + fr) : 16 * n + fr)) * K + fq * 8;
#pragma unroll 1
        for (int k0 = 0; k0 < K; k0 += 32) {
            bf16x8 tf[2][4], wf[2][2];
#pragma unroll
            for (int ai = 0; ai < 2; ++ai)
#pragma unroll
                for (int m = 0; m < 4; ++m) tf[ai][m] = *(const bf16x8*)(Ar + (size_t)(ai * 128 + m * 16) * K + k0);
#pragma unroll
            for (int bj = 0; bj < 2; ++bj)
#pragma unroll
                for (int n = 0; n < 2; ++n) wf[bj][n] = *(const bf16x8*)(Br[n] + (size_t)(bj * 128) * K + k0);
#pragma unroll
            for (int ai = 0; ai < 2; ++ai)
#pragma unroll
                for (int bj = 0; bj < 2; ++bj)
#pragma unroll
                    for (int m = 0; m < 4; ++m)
#pragma unroll
                        for (int n = 0; n < 2; ++n) acc[ai][bj][m][n] = __builtin_amdgcn_mfma_f32_16x16x32_bf16(wf[bj][n], tf[ai][m], acc[ai][bj][m][n], 0, 0, 0);
        }
        E(acc, u, wr, wc, fr, fq);
    }
}

namespace pg8 {
#define PG8_LAS __attribute__((address_space(3)))
constexpr int BM = 256, BK = 64, HALF = 128, HTB = HALF * BK * 2  , STAGE_BYTES = 8 * HTB, NXCD = 8, WGM = 8;

__host__ __device__ __forceinline__ int lds_byte(int r, int c) { const int st = (r >> 4) * 2 + (c >> 5), rr = r & 15, cc = c & 31, ob = rr * 64 + cc * 2; return st * 1024 + (ob ^ (((ob >> 9) & 1) << 5)); }
__host__ __device__ __forceinline__ void stage_rc(int b, int& R, int& C) { const int st = b / 1024, sb = b % 1024, swz = sb ^ (((sb >> 9) & 1) << 5); R = (st >> 1) * 16 + swz / 64; C = (st & 1) * 32 + (swz % 64) / 2; }
struct Gemm { const bf16_t* A; const bf16_t* Bt; int M, N, K; };
template <class Epi, class Sched, bool ALIGN_EPI = false, bool SP2 = false>
__device__ __forceinline__ void gemm_phase(int tid_in, PG8_LAS unsigned char* lds, const Gemm g, const Sched& S, const Epi& E) {
    const int tid = tid_in, wid = __builtin_amdgcn_readfirstlane(tid >> 6), lane = tid & 63, wr = wid >> 2, wc = wid & 3, fr = lane & 15, fq = lane >> 4;
    const int K = g.K, nt = K / BK;
    unsigned voffA[2], voffB[2];
#pragma unroll
    for (int i = 0; i < 2; ++i) { int R, C; stage_rc(tid * 16 + i * 8192, R, C); const int Rb = Epi::PERM ? ((R & ~31) + perm32(R & 31)) : R;
        voffA[i] = (unsigned)(R * K + C) * 2u; voffB[i] = (unsigned)(Rb * K + C) * 2u; }
    const size_t kstep = (size_t)(BK * 2);
    const size_t hstep = (size_t)HALF * K * 2;
    const size_t tstep = 2 * hstep;
    const unsigned ldsw = (unsigned)wid * 1024u;
    const int aoff = lds_byte(wr * 64 + fr, fq * 8), boff = lds_byte(wc * 32 + fr, fq * 8);
#define PG8_SA(b, h) (((b) * 2 + (h)) * HTB)
#define PG8_SB(b, h) ((4 + (b) * 2 + (h)) * HTB)
#define PG8_STAGE(bufoff, gbase, voff) do { _Pragma("unroll") for (int _i = 0; _i < 2; ++_i) \
        __builtin_amdgcn_global_load_lds((const unsigned*)((const char*)(gbase) + (voff)[_i]), (PG8_LAS unsigned*)(lds + (bufoff) + ldsw + _i * 8192), 16, 0, 0); } while (0)
#define PG8_LDA(dst, b, h) do { _Pragma("unroll") for (int m = 0; m < 4; ++m) _Pragma("unroll") for (int k = 0; k < 2; ++k) dst[m][k] = *(const PG8_LAS bf16x8*)(lds + PG8_SA(b, h) + aoff + m * 2048 + k * 1024); } while (0)
#define PG8_LDB(dst, b, h) do { _Pragma("unroll") for (int n = 0; n < 2; ++n) _Pragma("unroll") for (int k = 0; k < 2; ++k) dst[n][k] = *(const PG8_LAS bf16x8*)(lds + PG8_SB(b, h) + boff + n * 2048 + k * 1024); } while (0)
#define PG8_MMA(ai, bj, At, Bt) do { __builtin_amdgcn_s_setprio(1); _Pragma("unroll") for (int m = 0; m < 4; ++m) _Pragma("unroll") for (int n = 0; n < 2; ++n) _Pragma("unroll") for (int k = 0; k < 2; ++k) \
        acc[ai][bj][m][n] = __builtin_amdgcn_mfma_f32_16x16x32_bf16(Bt[n][k], At[m][k], acc[ai][bj][m][n], 0, 0, 0); __builtin_amdgcn_s_setprio(0); } while (0)
#define PG8_WAIT_V(n) asm volatile("s_waitcnt vmcnt(" #n ")" ::: "memory")
#define PG8_WAIT_L(n) asm volatile("s_waitcnt lgkmcnt(" #n ")" ::: "memory")
#define PG8_BAR __builtin_amdgcn_s_barrier()
#define PG8_SCHED __builtin_amdgcn_sched_barrier(0)
    Unit cur, nxt; int ui = 0;
    if (!S.next(0, cur)) return;
    f32x4 acc[2][2][4][2];
#pragma unroll
    for (int a = 0; a < 2; ++a)
#pragma unroll
        for (int b = 0; b < 2; ++b)
#pragma unroll
            for (int m = 0; m < 4; ++m)
#pragma unroll
                for (int n = 0; n < 2; ++n) acc[a][b][m][n] = (f32x4){0.f, 0.f, 0.f, 0.f};
    bf16x8 At[4][2], B0[2][2], B1[2][2];
    const char* cA = (const char*)g.A + (size_t)cur.pm * tstep; const char* cB = (const char*)g.Bt + (size_t)cur.pn * tstep;
    S.a_ready(cur);
    if constexpr (SP2) {
        PG8_STAGE(PG8_SB(0, 0), cB, voffB); PG8_STAGE(PG8_SB(0, 1), cB + hstep, voffB); PG8_STAGE(PG8_SA(0, 0), cA, voffA); PG8_STAGE(PG8_SA(0, 1), cA + hstep, voffA);
        if (wr == 1) PG8_BAR;
        PG8_WAIT_V(2); PG8_BAR;
        PG8_STAGE(PG8_SB(1, 0), cB + kstep, voffB); PG8_STAGE(PG8_SA(1, 0), cA + kstep, voffA); PG8_STAGE(PG8_SB(1, 1), cB + hstep + kstep, voffB);
        PG8_WAIT_V(6); PG8_BAR;
    } else {
        PG8_STAGE(PG8_SB(0, 0), cB, voffB); PG8_STAGE(PG8_SA(0, 0), cA, voffA); PG8_STAGE(PG8_SB(0, 1), cB + hstep, voffB); PG8_STAGE(PG8_SA(0, 1), cA + hstep, voffA);
        if (wr == 1) PG8_BAR;
        PG8_WAIT_V(4); PG8_BAR;
        PG8_STAGE(PG8_SB(1, 0), cB + kstep, voffB); PG8_STAGE(PG8_SA(1, 0), cA + kstep, voffA); PG8_STAGE(PG8_SB(1, 1), cB + hstep + kstep, voffB);
        PG8_WAIT_V(6); PG8_BAR;
    }
    for (;;) {
        const bool has_next = S.next(ui + 1, nxt);
        const char* nA = has_next ? (const char*)g.A + (size_t)nxt.pm * tstep : cA; const char* nB = has_next ? (const char*)g.Bt + (size_t)nxt.pn * tstep : cB;
        for (int t = 0; t < nt; t += 2) {
            const bool last = (t == nt - 2);
            const char* a1 = cA + (size_t)(t + 1) * kstep;
            const char* a2 = last ? nA : cA + (size_t)(t + 2) * kstep; const char* b2 = last ? nB : cB + (size_t)(t + 2) * kstep;
            const char* a3 = a2 + kstep; const char* b3 = b2 + kstep;
            if (last && has_next) S.a_ready(nxt);
            if constexpr (SP2) {
            PG8_LDB(B0, 0, 0); PG8_LDB(B1, 0, 1); PG8_SCHED; PG8_LDA(At, 0, 0); PG8_STAGE(PG8_SA(1, 1), a1 + hstep, voffA);
            PG8_WAIT_V(8); PG8_WAIT_L(0); PG8_BAR; PG8_MMA(0, 0, At, B0); PG8_MMA(0, 1, At, B1); PG8_BAR; PG8_SCHED;
            PG8_LDA(At, 0, 1); PG8_STAGE(PG8_SB(0, 0), b2, voffB); PG8_STAGE(PG8_SB(0, 1), b2 + hstep, voffB); PG8_STAGE(PG8_SA(0, 0), a2, voffA);
            PG8_WAIT_V(8); PG8_WAIT_L(0); PG8_BAR; PG8_MMA(1, 0, At, B0); PG8_MMA(1, 1, At, B1); PG8_BAR; PG8_SCHED;
            PG8_LDB(B0, 1, 0); PG8_LDB(B1, 1, 1); PG8_SCHED; PG8_LDA(At, 1, 0); PG8_STAGE(PG8_SA(0, 1), a2 + hstep, voffA);
            PG8_WAIT_V(8); PG8_WAIT_L(0); PG8_BAR; PG8_MMA(0, 0, At, B0); PG8_MMA(0, 1, At, B1); PG8_BAR; PG8_SCHED;
            PG8_LDA(At, 1, 1); PG8_STAGE(PG8_SB(1, 0), b3, voffB); PG8_STAGE(PG8_SB(1, 1), b3 + hstep, voffB); PG8_STAGE(PG8_SA(1, 0), a3, voffA);
            PG8_WAIT_V(8); PG8_WAIT_L(0); PG8_BAR; PG8_MMA(1, 0, At, B0); PG8_MMA(1, 1, At, B1); PG8_BAR; PG8_SCHED;
            } else {
            PG8_LDB(B0, 0, 0); PG8_SCHED; PG8_LDA(At, 0, 0); PG8_STAGE(PG8_SA(1, 1), a1 + hstep, voffA);
            PG8_WAIT_L(8); PG8_BAR; PG8_WAIT_L(0); PG8_MMA(0, 0, At, B0); PG8_BAR; PG8_SCHED;
            PG8_LDB(B1, 0, 1); PG8_STAGE(PG8_SB(0, 0), b2, voffB);
            PG8_BAR; PG8_WAIT_L(0); PG8_MMA(0, 1, At, B1); PG8_BAR;
            PG8_LDA(At, 0, 1); PG8_STAGE(PG8_SA(0, 0), a2, voffA);
            PG8_BAR; PG8_WAIT_L(0); PG8_MMA(1, 0, At, B0); PG8_BAR; PG8_SCHED;
            PG8_STAGE(PG8_SB(0, 1), b2 + hstep, voffB);
            PG8_WAIT_V(6); PG8_BAR; PG8_MMA(1, 1, At, B1); PG8_BAR;
            PG8_LDB(B0, 1, 0); PG8_SCHED; PG8_LDA(At, 1, 0); PG8_STAGE(PG8_SA(0, 1), a2 + hstep, voffA);
            PG8_WAIT_L(8); PG8_BAR; PG8_WAIT_L(0); PG8_MMA(0, 0, At, B0); PG8_BAR; PG8_SCHED;
            PG8_LDB(B1, 1, 1); PG8_STAGE(PG8_SB(1, 0), b3, voffB);
            PG8_BAR; PG8_WAIT_L(0); PG8_MMA(0, 1, At, B1); PG8_BAR;
            PG8_LDA(At, 1, 1); PG8_STAGE(PG8_SA(1, 0), a3, voffA);
            PG8_BAR; PG8_WAIT_L(0); PG8_MMA(1, 0, At, B0); PG8_BAR; PG8_SCHED;
            PG8_STAGE(PG8_SB(1, 1), b3 + hstep, voffB);
            PG8_WAIT_V(6); PG8_BAR; PG8_MMA(1, 1, At, B1); PG8_BAR;
            }
        }
        if constexpr (ALIGN_EPI) { if (wr == 0) PG8_BAR; }
        if constexpr (!Epi::AFTER_DRAIN) { E(acc, cur, wr, wc, fr, fq); S.done(cur); }
        if (!has_next) break;
#pragma unroll
        for (int a = 0; a < 2; ++a)
#pragma unroll
            for (int b = 0; b < 2; ++b)
#pragma unroll
                for (int m = 0; m < 4; ++m)
#pragma unroll
                    for (int n = 0; n < 2; ++n) acc[a][b][m][n] = (f32x4){0.f, 0.f, 0.f, 0.f};
        cur = nxt; cA = nA; cB = nB; ++ui;
        if constexpr (ALIGN_EPI) { if (wr == 1) PG8_BAR; }
    }
    PG8_WAIT_V(0);
    if constexpr (!ALIGN_EPI) { if (wr == 0) PG8_BAR; }
    PG8_BAR;
    if constexpr (Epi::AFTER_DRAIN) { E.fused(acc, cur, wr, wc, fr, fq, lds, wid, lane); S.done(cur); }
#undef PG8_SA
#undef PG8_SB
#undef PG8_STAGE
#undef PG8_LDA
#undef PG8_LDB
#undef PG8_MMA
#undef PG8_WAIT_V
#undef PG8_WAIT_L
#undef PG8_BAR
#undef PG8_SCHED
}
}

__device__ __forceinline__ u32x4 pack8(const f32x4& a, const f32x4& b) { u32x4 w; w.x = pk2(a.x, a.y); w.y = pk2(a.z, a.w); w.z = pk2(b.x, b.y); w.w = pk2(b.z, b.w); return w; }
__device__ __forceinline__ void rope4(f32x4& v, const f32x2 cs0, const f32x2 cs1) {
    const float a0 = v.x * cs0.x - v.y * cs0.y, a1 = v.x * cs0.y + v.y * cs0.x, a2 = v.z * cs1.x - v.w * cs1.y, a3 = v.z * cs1.y + v.w * cs1.x;
    v.x = a0; v.y = a1; v.z = a2; v.w = a3;
}
struct EpiMix {
    static constexpr bool PERM = true, AFTER_DRAIN = false;
    const Params* pp; int l;
    __device__ __forceinline__ void operator()(const f32x4 (&acc)[2][2][4][2], const Unit& u, int wr, int wc, int fr, int fq) const {
        const Params& p = *pp;
        const int pn = u.pn, R0 = u.pm * 256; const bool smp = R0 >= MP;
        const int b = smp ? (R0 - MP) >> 11 : R0 >> 8, t0 = smp ? (R0 - MP) & 2047 : 0;
        const f32x2* cs_row = (const f32x2*)(p.ws + WS_ROPE); const f32x2* cs_col = cs_row + 32 * 16;
        if (pn >= 11) {
            bf16_t* dst = (bf16_t*)(p.ws + (pn < 13 ? Z_CU : Z_CV)) + ((pn - 11) & 1) * 256 + wc * 32 + 8 * fq;
#pragma unroll
            for (int ai = 0; ai < 2; ++ai)
#pragma unroll
                for (int m = 0; m < 4; ++m) { const int R = R0 + ai * 128 + wr * 64 + m * 16 + fr;
#pragma unroll
                    for (int bj = 0; bj < 2; ++bj) { f32x4 v0 = acc[ai][bj][m][0], v1 = acc[ai][bj][m][1];
#pragma unroll
                        for (int r = 0; r < 4; ++r) { v0[r] = gelu_tanh(v0[r]); v1[r] = gelu_tanh(v1[r]); }
                        *(u32x4*)(dst + (size_t)R * RW + bj * 128) = pack8(v0, v1); } }
            return;
        }
        const int kind = pn >> 1;
        const bool is_k = (pn == 10 && wc < 2), is_v = (pn == 10 && wc >= 2);
        const float* gqk = (kind == 4 ? p.in[I_GQ] : p.in[I_GK]) + l * HD + 8 * fq;
        const int head = (pn & 1) * 4 + wc;
        const bool norm = (kind == 4 || is_k), rope = smp && (kind == 0 || kind == 1 || kind == 4 || is_k);
        const float post = kind == 1 ? 0.125f : (kind == 4 ? C2 : 1.0f);
#pragma unroll
        for (int ai = 0; ai < 2; ++ai)
#pragma unroll
            for (int m = 0; m < 4; ++m) {
                const int rr = ai * 128 + wr * 64 + m * 16 + fr, R = R0 + rr, t = t0 + rr;
                float rs = 1.0f;
                if (norm) {
                    float ss = 0.f;
#pragma unroll
                    for (int bj = 0; bj < 2; ++bj)
#pragma unroll
                        for (int n = 0; n < 2; ++n) { const f32x4 x = acc[ai][bj][m][n]; ss += (x.x * x.x + x.y * x.y) + (x.z * x.z + x.w * x.w); }
                    ss += __shfl_xor(ss, 16); ss += __shfl_xor(ss, 32);
                    rs = rsqrtf(ss * (1.f / HD) + EPS);
                }
                bf16_t* dst;
                if (kind < 5) dst = (bf16_t*)(p.ws + (kind == 0 ? Z_RQ : kind == 1 ? Z_RK : kind == 2 ? Z_RV : kind == 3 ? Z_RG : Z_AQ)) + (size_t)R * RW + head * HD + 8 * fq;
                else { const int hk = wc & 1;
                    if (smp) dst = (bf16_t*)(p.ws + (is_k ? Z_KS : Z_VS)) + ((size_t)b * SKV_S + PAST + t) * KVW + hk * HD + 8 * fq;
                    else dst = (bf16_t*)(p.ws + (is_k ? Z_KP : Z_VP)) + ((size_t)b * SEQ_P + t) * KVW + hk * HD + 8 * fq; }
                float* cdst = p.out + (is_k ? OUT_CK : OUT_CV) + ((size_t)((b * 2 + l) * SEQ_P + t) * 2 + (wc & 1)) * HD + 8 * fq;
#pragma unroll
                for (int bj = 0; bj < 2; ++bj) {
                    f32x4 v0 = acc[ai][bj][m][0], v1 = acc[ai][bj][m][1];
                    if (norm) { const f32x4 g0 = *(const f32x4*)(gqk + 32 * bj), g1 = *(const f32x4*)(gqk + 32 * bj + 4); v0 = v0 * rs * g0; v1 = v1 * rs * g1; }
                    if (pn == 10 && !smp) { *(f32x4*)(cdst + 32 * bj) = v0; *(f32x4*)(cdst + 32 * bj + 4) = v1; }
                    if (kind == 3) {
#pragma unroll
                        for (int r = 0; r < 4; ++r) { v0[r] = siluf_(v0[r]); v1[r] = siluf_(v1[r]); } }
                    if (rope) {
                        const f32x2* tab = (bj == 0 ? cs_row + (t >> 6) * 16 : cs_col + (t & 63) * 16) + 4 * fq;
                        rope4(v0, tab[0], tab[1]); rope4(v1, tab[2], tab[3]); }
                    v0 = v0 * post; v1 = v1 * post;
                    *(u32x4*)(dst + 32 * bj) = pack8(v0, v1);
                    asm volatile("" ::: "memory");
                }
            }
    }
};
struct EpiGate {
    static constexpr bool PERM = true, AFTER_DRAIN = false;
    const Params* pp;
    __device__ __forceinline__ void operator()(const f32x4 (&acc)[2][2][4][2], const Unit& u, int wr, int wc, int fr, int fq) const {
        const int x = u.pn >> 2; bf16_t* dst = (bf16_t*)(pp->ws + Z_GATE) + (size_t)x * M * DM + (u.pn & 3) * 256 + wc * 32 + 8 * fq;
#pragma unroll
        for (int ai = 0; ai < 2; ++ai)
#pragma unroll
            for (int m = 0; m < 4; ++m) { const int R = u.pm * 256 + ai * 128 + wr * 64 + m * 16 + fr;
#pragma unroll
                for (int bj = 0; bj < 2; ++bj) { f32x4 v0 = acc[ai][bj][m][0], v1 = acc[ai][bj][m][1];
#pragma unroll
                    for (int r = 0; r < 4; ++r) { v0[r] = sigmoidf_(v0[r]); v1[r] = sigmoidf_(v1[r]); }
                    *(u32x4*)(dst + (size_t)R * DM + bj * 128) = pack8(v0, v1); } }
    }
};
struct EpiMerge {
    static constexpr bool PERM = true, AFTER_DRAIN = false;
    const Params* pp;
    __device__ __forceinline__ void operator()(const f32x4 (&acc)[2][2][4][2], const Unit& u, int wr, int wc, int fr, int fq) const {
        const int x = u.pn >> 2, pm = u.pm - 80 * x, gi = x == 0 ? 1 : x == 1 ? 2 : 0;
        const int col0 = (u.pn & 3) * 256 + wc * 32 + 8 * fq;
        const bf16_t* gate = (const bf16_t*)(pp->ws + Z_GATE) + (size_t)gi * M * DM + col0; bf16_t* dst = (bf16_t*)(pp->ws + WS_XN) + col0;
#pragma unroll
        for (int ai = 0; ai < 2; ++ai)
#pragma unroll
            for (int m = 0; m < 4; ++m) { const int R = pm * 256 + ai * 128 + wr * 64 + m * 16 + fr;
#pragma unroll
                for (int bj = 0; bj < 2; ++bj) { f32x4 v0 = acc[ai][bj][m][0], v1 = acc[ai][bj][m][1];
                    const u32x4 g = *(const u32x4*)(gate + (size_t)R * DM + bj * 128);
                    v0.x *= bflo(g.x); v0.y *= bfhi(g.x); v0.z *= bflo(g.y); v0.w *= bfhi(g.y); v1.x *= bflo(g.z); v1.y *= bfhi(g.z); v1.z *= bflo(g.w); v1.w *= bfhi(g.w);
                    if (x != 0) { const u32x4 o = *(const u32x4*)(dst + (size_t)R * DM + bj * 128);
                        v0.x += bflo(o.x); v0.y += bfhi(o.x); v0.z += bflo(o.y); v0.w += bfhi(o.y); v1.x += bflo(o.z); v1.y += bfhi(o.z); v1.z += bflo(o.w); v1.w += bfhi(o.w); }
                    *(u32x4*)(dst + (size_t)R * DM + bj * 128) = pack8(v0, v1); } }
    }
};
struct EpiRes {
    static constexpr bool PERM = false, AFTER_DRAIN = false;
    const Params* pp; int l, part; bool from_inputs;
    __device__ __forceinline__ void operator()(const f32x4 (&acc)[2][2][4][2], const Unit& u, int wr, int wc, int fr, int fq) const {
        const Params& p = *pp; const int R0 = u.pm * 256; const int ci = row_ci(R0);
        const float* gv = mod_ptr(p, l, ci, part) + u.pn * 256 + wc * 32 + 4 * fq;
        f32x4 g[2][2];
#pragma unroll
        for (int bj = 0; bj < 2; ++bj)
#pragma unroll
            for (int n = 0; n < 2; ++n) g[bj][n] = *(const f32x4*)(gv + bj * 128 + n * 16);
#pragma unroll
        for (int ai = 0; ai < 2; ++ai)
#pragma unroll
            for (int m = 0; m < 4; ++m) { const int R = R0 + ai * 128 + wr * 64 + m * 16 + fr;
                const float* xs = (from_inputs ? x_row(p, 0, R) : p.out + (size_t)R * DM) + u.pn * 256 + wc * 32 + 4 * fq;
                float* xo = p.out + (size_t)R * DM + u.pn * 256 + wc * 32 + 4 * fq;
#pragma unroll
                for (int bj = 0; bj < 2; ++bj)
#pragma unroll
                    for (int n = 0; n < 2; ++n) { const f32x4 xv = *(const f32x4*)(xs + bj * 128 + n * 16); *(f32x4*)(xo + bj * 128 + n * 16) = xv + g[bj][n] * acc[ai][bj][m][n]; } }
    }
};
struct EpiFF1 {
    static constexpr bool PERM = true, AFTER_DRAIN = false;
    const Params* pp;
    __device__ __forceinline__ void operator()(const f32x4 (&acc)[2][2][4][2], const Unit& u, int wr, int wc, int fr, int fq) const {
        bf16_t* dst = (bf16_t*)(pp->ws + Z_HB) + u.pn * 256 + wc * 32 + 8 * fq;
#pragma unroll
        for (int ai = 0; ai < 2; ++ai)
#pragma unroll
            for (int m = 0; m < 4; ++m) { const int R = u.pm * 256 + ai * 128 + wr * 64 + m * 16 + fr;
#pragma unroll
                for (int bj = 0; bj < 2; ++bj) { f32x4 v0 = acc[ai][bj][m][0], v1 = acc[ai][bj][m][1];
#pragma unroll
                    for (int r = 0; r < 4; ++r) { const float a = fmaxf(v0[r], 0.f), b = fmaxf(v1[r], 0.f); v0[r] = a * a; v1[r] = b * b; }
                    *(u32x4*)(dst + (size_t)R * DFF + bj * 128) = pack8(v0, v1); } }
    }
};

namespace attn_body {
using bf16=__hip_bfloat16;
using bf16x8=__attribute__((ext_vector_type(8)))short;
using s16x4=__attribute__((ext_vector_type(4)))short;
using f32x16=__attribute__((ext_vector_type(16)))float;
using u32x4=__attribute__((ext_vector_type(4)))unsigned;
constexpr int D=64,QP=512,KP=128;
constexpr int NW=8,QBLK=32,QB=QBLK*NW,KVBLK=64;
__device__ __forceinline__ int crow(int r,int hi){return (r&3)+8*(r>>2)+4*hi;}
#define SBAR() __builtin_amdgcn_sched_barrier(0)
constexpr int NSLOT=3, SLOTB=8192;
constexpr int LDS_K=0, LDS_V=NSLOT*SLOTB, LDS_WS=2*NSLOT*SLOTB, LDS_OST=LDS_WS+NW*64*4, LDS_BYTES=LDS_OST+NW*4096;
constexpr float C2=0.125f*1.4426950408889634f;
__device__ __forceinline__ void glds16(const void*gsrc,unsigned lds_dst){unsigned keep;
  asm volatile("s_mov_b32 %0, m0\n\ts_mov_b32 m0, %2\n\ts_nop 0\n\tglobal_load_lds_dwordx4 %1, off\n\ts_mov_b32 m0, %0":"=&s"(keep):"v"(gsrc),"s"(lds_dst):"memory");}
__device__ __forceinline__ float max3f(float a,float b,float c){float r;asm("v_max3_f32 %0, %1, %2, %3":"=v"(r):"v"(a),"v"(b),"v"(c));return r;}
__device__ __forceinline__ float max2f(float a,float b){float r;asm("v_max_f32_e32 %0, %1, %2":"=v"(r):"v"(a),"v"(b));return r;}
__device__ __forceinline__ float fadd_s(float a,float b){float r;asm("v_add_f32_e32 %0, %1, %2":"=v"(r):"v"(a),"v"(b));return r;}
__device__ __forceinline__ float fsub_s(float a,float b){float r;asm("v_sub_f32_e32 %0, %1, %2":"=v"(r):"v"(a),"v"(b));return r;}
typedef float f32x2_t __attribute__((ext_vector_type(2))); typedef __bf16 bf16x2_t __attribute__((ext_vector_type(2)));
__device__ __forceinline__ unsigned cvtpk_s(float lo,float hi){f32x2_t v={lo,hi};bf16x2_t b=__builtin_convertvector(v,bf16x2_t);return __builtin_bit_cast(unsigned,b);}
#define WAIT_BAR(N) asm volatile("s_waitcnt vmcnt(" #N ") lgkmcnt(0)\n\ts_barrier":::"memory")

__device__ __forceinline__ void qkt(f32x16&p0,f32x16&p1,const char*Kslot,const bf16x8*qr,const f32x16&negm,int r32,int hi){
  const char*kb=Kslot+hi*1024+r32*16;
  #pragma unroll
  for(int d0=0;d0<4;++d0){
    const bf16x8 b0=*reinterpret_cast<const bf16x8*>(kb+d0*2048);
    const bf16x8 b1=*reinterpret_cast<const bf16x8*>(kb+d0*2048+512);
    if(d0==0){p0=__builtin_amdgcn_mfma_f32_32x32x16_bf16(b0,qr[0],negm,0,0,0);p1=__builtin_amdgcn_mfma_f32_32x32x16_bf16(b1,qr[0],negm,0,0,0);}
    else{p0=__builtin_amdgcn_mfma_f32_32x32x16_bf16(b0,qr[d0],p0,0,0,0);p1=__builtin_amdgcn_mfma_f32_32x32x16_bf16(b1,qr[d0],p1,0,0,0);}}
}
typedef __attribute__((address_space(3))) const char* lds_cptr;
typedef short v4i16_t __attribute__((ext_vector_type(4)));
__device__ __forceinline__ void kload8(bf16x8*kf,lds_cptr kp){
  kf[0]=*(const __attribute__((address_space(3))) bf16x8*)(kp);      kf[1]=*(const __attribute__((address_space(3))) bf16x8*)(kp+512);
  kf[2]=*(const __attribute__((address_space(3))) bf16x8*)(kp+2048); kf[3]=*(const __attribute__((address_space(3))) bf16x8*)(kp+2560);
  kf[4]=*(const __attribute__((address_space(3))) bf16x8*)(kp+4096); kf[5]=*(const __attribute__((address_space(3))) bf16x8*)(kp+4608);
  kf[6]=*(const __attribute__((address_space(3))) bf16x8*)(kp+6144); kf[7]=*(const __attribute__((address_space(3))) bf16x8*)(kp+6656);
}
__device__ __forceinline__ void kload2(bf16x8*kf,lds_cptr kp,int j){ kf[2*j]=*(const __attribute__((address_space(3))) bf16x8*)(kp+j*2048); kf[2*j+1]=*(const __attribute__((address_space(3))) bf16x8*)(kp+j*2048+512); }
__device__ __forceinline__ s16x4 vtr(lds_cptr p){ return __builtin_bit_cast(s16x4,__builtin_amdgcn_ds_read_tr16_b64_v4i16((__attribute__((address_space(3))) v4i16_t*)p)); }
__device__ __forceinline__ float rowmax(const f32x16&p0,const f32x16&p1){
  float a=max3f(p0[0],p0[1],p1[0]),b=max3f(p0[2],p0[3],p1[1]);a=max3f(a,p1[2],p1[3]);
  #pragma unroll
  for(int r=4;r<16;r+=4){a=max3f(a,p0[r],p0[r+1]);b=max3f(b,p0[r+2],p0[r+3]);a=max3f(a,p1[r],p1[r+1]);b=max3f(b,p1[r+2],p1[r+3]);}
  const float m=max2f(a,b);
  auto rr=__builtin_amdgcn_permlane32_swap(__float_as_uint(m),__float_as_uint(m),false,false);
  return max2f(__uint_as_float(rr[0]),__uint_as_float(rr[1]));
}
__device__ __forceinline__ void pv(f32x16*o,int vb,bf16x8 pa0,bf16x8 pa1,bf16x8 pa2,bf16x8 pa3){
  #pragma unroll
  for(int d0=0;d0<2;++d0){s16x4 lo[4],hi[4];
    #pragma unroll
    for(int ks=0;ks<4;++ks){
      asm volatile("ds_read_b64_tr_b16 %0,%1 offset:%c2":"=&v"(lo[ks]):"v"(vb),"i"(d0*4096+ks*1024):"memory");
      asm volatile("ds_read_b64_tr_b16 %0,%1 offset:%c2":"=&v"(hi[ks]):"v"(vb),"i"(d0*4096+ks*1024+512):"memory");}
    asm volatile("s_waitcnt lgkmcnt(0)":::"memory");SBAR();
    #define PK(k) (bf16x8){lo[k][0],lo[k][1],lo[k][2],lo[k][3],hi[k][0],hi[k][1],hi[k][2],hi[k][3]}
    o[d0]=__builtin_amdgcn_mfma_f32_32x32x16_bf16(pa0,PK(0),o[d0],0,0,0);
    o[d0]=__builtin_amdgcn_mfma_f32_32x32x16_bf16(pa1,PK(1),o[d0],0,0,0);
    o[d0]=__builtin_amdgcn_mfma_f32_32x32x16_bf16(pa2,PK(2),o[d0],0,0,0);
    o[d0]=__builtin_amdgcn_mfma_f32_32x32x16_bf16(pa3,PK(3),o[d0],0,0,0);
    #undef PK
  }
}

#ifndef ATTN_STORE16
#define ATTN_STORE16(p,v) (*(u32x4*)(p)=(v))
#endif
template<int THRL> __device__ __forceinline__ void attn_unit(int tid,const bf16*Qu,const bf16*__restrict__ Kh,const bf16*__restrict__ Vh,bf16*Ou,const int NT,char*shm){
  const int lane=tid&63,r32=lane&31,hi=lane>>5; const int wid=__builtin_amdgcn_readfirstlane(tid>>6);
  const bf16*Qw=Qu+(long)(wid*QBLK)*QP;
  const unsigned lds0=(unsigned)(uintptr_t)shm;
  float*wsf=(float*)(shm+LDS_WS)+wid*64;
  const bf16*ksrc=Kh+(long)lane*KP+wid*8;
  const bf16*vsrc=Vh+(long)(16*(wid&3)+(lane>>2))*KP+(wid>>2)*32+(lane&3)*8;
  const unsigned kdst=lds0+LDS_K+wid*1024, vdst=lds0+LDS_V+wid*1024;
  #define DMA_K(t,slot) glds16(ksrc+(long)(t)*KVBLK*KP,(unsigned)__builtin_amdgcn_readfirstlane(kdst+(slot)))
  #define DMA_V(t,slot) glds16(vsrc+(long)(t)*KVBLK*KP,(unsigned)__builtin_amdgcn_readfirstlane(vdst+(slot)))
  const int vb0=(int)(lds0+LDS_V)+((lane>>4)&1)*32+(lane&3)*8+(4*hi+((lane&15)>>2))*64;
  const char*Kbase=shm+LDS_K; bf16x8 kf[8];
  const lds_cptr shm3=(lds_cptr)shm; const lds_cptr kp0=shm3+LDS_K+hi*1024+r32*16; const lds_cptr vp0=shm3+LDS_V+((lane>>4)&1)*32+(lane&3)*8+(4*hi+((lane&15)>>2))*64;
  DMA_K(0,0);DMA_V(0,0);DMA_K(1,SLOTB);
  bf16x8 qr[4];
  #pragma unroll
  for(int d0=0;d0<4;++d0)qr[d0]=*reinterpret_cast<const bf16x8*>(&Qw[(long)r32*QP+d0*16+hi*8]);
  float zf_=0.f;asm volatile("":"+v"(zf_));
  float mhat=zf_,l_reg=zf_;f32x16 o[2],negm;
  #pragma unroll
  for(int r=0;r<16;++r){o[0][r]=zf_;o[1][r]=zf_;negm[r]=zf_;}
  asm volatile("":"+v"(negm));
  #define CMASK(P0,P1,t) do{}while(0)
  bool resc=false;
  #define START(P0,P1) do{ const float rm=rowmax(P0,P1); resc=false; \
    { const float dl=rm; mhat=fadd_s(mhat,dl); \
      _Pragma("unroll") for(int r=0;r<16;++r){P0[r]=fsub_s(P0[r],dl);P1[r]=fsub_s(P1[r],dl);} \
      _Pragma("unroll") for(int r=0;r<16;++r)negm[r]=-mhat; asm volatile("":"+v"(negm)); } \
    _Pragma("unroll") for(int r=0;r<16;++r)P0[r]=__builtin_amdgcn_exp2f(P0[r]); }while(0)
  #define RESC() do{ if(resc){ asm volatile("s_waitcnt lgkmcnt(0)":::"memory"); \
      _Pragma("unroll") for(int d_=0;d_<2;++d_) _Pragma("unroll") for(int r=0;r<16;++r)o[d_][r]*=wsf[crow(r,hi)]; } }while(0)
  f32x16 pA0,pA1,pB0,pB1;
  int sl_prev=0,sl_cur=0,sl_next=SLOTB;
  #define ROT() do{sl_prev=sl_cur;sl_cur=sl_next;sl_next=(sl_next==(NSLOT-1)*SLOTB)?0:sl_next+SLOTB;}while(0)
  DMA_K(2,2*SLOTB);
  WAIT_BAR(3);
  qkt(pA0,pA1,Kbase,qr,negm,r32,hi);asm volatile("s_nop 15\n\ts_nop 7":"+v"(pA0),"+v"(pA1));CMASK(pA0,pA1,0);
  START(pA0,pA1);
  _Pragma("unroll") for(int r=0;r<16;++r)pA1[r]=__builtin_amdgcn_exp2f(pA1[r]);
  WAIT_BAR(0);
  DMA_K(3,0);DMA_V(1,SLOTB);
  ROT();
  kload8(kf,kp0+sl_cur);
  WAIT_BAR(2);
  s16x4 vlo[8],vhi[8]; u32x4 pw0,pw1,pw2,pw3;
  #define PKW(P,B) cvtpk_s(P[B],P[B+1])
  #define PAF(k) __builtin_bit_cast(bf16x8,pw##k)
  #define VFR(i) (bf16x8){vlo[i][0],vlo[i][1],vlo[i][2],vlo[i][3],vhi[i][0],vhi[i][1],vhi[i][2],vhi[i][3]}
  #define PIN(x) asm volatile("":"+v"(x))
  #define MX3(a,b,c) __builtin_fmaxf(__builtin_fmaxf((a),(b)),(c))
  #define GAPA(MF,A0,A1,A2,A3,W0,W1,PW) do{ MF; sacc+=A0; sacc+=A1; sacc+=A2; sacc+=A3; PIN(sacc); W0; W1; PIN(PW); SBAR(); }while(0)
  #define EX(v) __builtin_amdgcn_exp2f(v)
  #define GAPB(MF,X,B) do{ MF; X[B]=EX(X[B]); X[B+1]=EX(X[B+1]); X[B+2]=EX(X[B+2]); X[B+3]=EX(X[B+3]); PIN(X); SBAR(); }while(0)
  #define VRD(i) do{ vlo[i]=vtr(vp_+(((i)>>2)*4096+((i)&3)*1024)); vhi[i]=vtr(vp_+(((i)>>2)*4096+((i)&3)*1024+512)); }while(0)
  #define KRD(G,j) do{ if(G){ kload2(kf,kp0+sl_next,j); SBAR(); } }while(0)
  #define STEP(C0,C1,P0,P1,t,GK,GV,GL) do{ SBAR(); \
    const lds_cptr vp_=vp0+sl_prev; \
    VRD(0); SBAR(); float sacc=(P0[0]+P0[1]); \
    GAPA(C0=__builtin_amdgcn_mfma_f32_32x32x16_bf16(kf[0],qr[0],negm,0,0,0), P0[2],P0[3],P0[4],P0[5],     pw0[0]=PKW(P0,0), pw0[1]=PKW(P0,2), pw0); \
    VRD(4); SBAR(); GAPA(C1=__builtin_amdgcn_mfma_f32_32x32x16_bf16(kf[1],qr[0],negm,0,0,0), P0[6],P0[7],P0[8],P0[9],     pw0[2]=PKW(P0,4), pw0[3]=PKW(P0,6), pw0); \
    VRD(1); SBAR(); GAPA(C0=__builtin_amdgcn_mfma_f32_32x32x16_bf16(kf[2],qr[1],C0,0,0,0),   P0[10],P0[11],P0[12],P0[13], pw1[0]=PKW(P0,8), pw1[1]=PKW(P0,10), pw1); \
    VRD(5); SBAR(); GAPA(C1=__builtin_amdgcn_mfma_f32_32x32x16_bf16(kf[3],qr[1],C1,0,0,0),   P0[14],P0[15],P1[0],P1[1],   pw1[2]=PKW(P0,12),pw1[3]=PKW(P0,14), pw1); \
    VRD(2); SBAR(); GAPA(C0=__builtin_amdgcn_mfma_f32_32x32x16_bf16(kf[4],qr[2],C0,0,0,0),   P1[2],P1[3],P1[4],P1[5],     pw2[0]=PKW(P1,0), pw2[1]=PKW(P1,2), pw2); \
    VRD(6); SBAR(); GAPA(C1=__builtin_amdgcn_mfma_f32_32x32x16_bf16(kf[5],qr[2],C1,0,0,0),   P1[6],P1[7],P1[8],P1[9],     pw2[2]=PKW(P1,4), pw2[3]=PKW(P1,6), pw2); \
    VRD(3); SBAR(); GAPA(C0=__builtin_amdgcn_mfma_f32_32x32x16_bf16(kf[6],qr[3],C0,0,0,0),   P1[10],P1[11],P1[12],P1[13], pw3[0]=PKW(P1,8), pw3[1]=PKW(P1,10), pw3); \
    VRD(7); SBAR(); GAPA(C1=__builtin_amdgcn_mfma_f32_32x32x16_bf16(kf[7],qr[3],C1,0,0,0),   P1[14],P1[15],0.f,0.f,       pw3[2]=PKW(P1,12),pw3[3]=PKW(P1,14), pw3); \
    l_reg+=sacc; \
    if(GK){DMA_K((t)+3,sl_cur);} if(GV){DMA_V((t)+1,sl_next);} \
    CMASK(C0,C1,t); \
    { float a=MX3(C0[0],C0[1],C1[0]),b=MX3(C0[2],C0[3],C1[1]); a=MX3(a,C1[2],C1[3]); \
      _Pragma("unroll") for(int r=4;r<16;r+=4){a=MX3(a,C0[r],C0[r+1]);b=MX3(b,C0[r+2],C0[r+3]);a=MX3(a,C1[r],C1[r+1]);b=MX3(b,C1[r+2],C1[r+3]);} \
      float rm=__builtin_fmaxf(a,b); { auto rr=__builtin_amdgcn_permlane32_swap(__float_as_uint(rm),__float_as_uint(rm),false,false); rm=__builtin_fmaxf(__uint_as_float(rr[0]),__uint_as_float(rr[1])); } \
      resc=false; \
      if(__builtin_expect(__any(rm>(float)THRL),0)){ const float dl=__builtin_fmaxf(rm,0.f); mhat+=dl; \
        _Pragma("unroll") for(int r=0;r<16;++r){C0[r]-=dl;C1[r]-=dl;} \
        _Pragma("unroll") for(int r=0;r<16;++r)negm[r]=-mhat; asm volatile("":"+v"(negm)); \
        const float f=__builtin_amdgcn_exp2f(-dl); l_reg*=f; if(hi==0)wsf[r32]=f; resc=true; } } \
    SBAR(); \
    GAPB(o[0]=__builtin_amdgcn_mfma_f32_32x32x16_bf16(PAF(0),VFR(0),o[0],0,0,0), C0,0); \
    GAPB(o[1]=__builtin_amdgcn_mfma_f32_32x32x16_bf16(PAF(0),VFR(4),o[1],0,0,0), C0,4); \
    KRD(GL,0); GAPB(o[0]=__builtin_amdgcn_mfma_f32_32x32x16_bf16(PAF(1),VFR(1),o[0],0,0,0), C0,8); \
    KRD(GL,1); GAPB(o[1]=__builtin_amdgcn_mfma_f32_32x32x16_bf16(PAF(1),VFR(5),o[1],0,0,0), C0,12); \
    KRD(GL,2); GAPB(o[0]=__builtin_amdgcn_mfma_f32_32x32x16_bf16(PAF(2),VFR(2),o[0],0,0,0), C1,0); \
    KRD(GL,3); GAPB(o[1]=__builtin_amdgcn_mfma_f32_32x32x16_bf16(PAF(2),VFR(6),o[1],0,0,0), C1,4); \
    GAPB(o[0]=__builtin_amdgcn_mfma_f32_32x32x16_bf16(PAF(3),VFR(3),o[0],0,0,0), C1,8); \
    GAPB(o[1]=__builtin_amdgcn_mfma_f32_32x32x16_bf16(PAF(3),VFR(7),o[1],0,0,0), C1,12); \
    }while(0)
  int t=1;
  for(;t+5<NT;t+=2){
    STEP(pB0,pB1,pA0,pA1,t,true,true,true);     WAIT_BAR(2); RESC(); ROT();
    STEP(pA0,pA1,pB0,pB1,t+1,true,true,true);   WAIT_BAR(2); RESC(); ROT();
  }
  #define ENDW(tt) do{ if((tt)+3<NT){WAIT_BAR(2);} else if((tt)+2<NT){WAIT_BAR(1);} else {WAIT_BAR(0);} }while(0)
  for(;t+1<NT;t+=2){
    STEP(pB0,pB1,pA0,pA1,t,(t+3<NT),(t+1<NT),(t+1<NT));       ENDW(t);   RESC(); ROT();
    STEP(pA0,pA1,pB0,pB1,t+1,(t+4<NT),(t+2<NT),(t+2<NT));     ENDW(t+1); RESC(); ROT();
  }
  STEP(pB0,pB1,pA0,pA1,NT-1,false,false,false); RESC();
  { float sacc=pB0[0]+pB0[1]; _Pragma("unroll") for(int r=2;r<16;++r)sacc+=pB0[r]; _Pragma("unroll") for(int r=0;r<16;++r)sacc+=pB1[r]; l_reg+=sacc;
    pw0=(u32x4){PKW(pB0,0),PKW(pB0,2),PKW(pB0,4),PKW(pB0,6)};pw1=(u32x4){PKW(pB0,8),PKW(pB0,10),PKW(pB0,12),PKW(pB0,14)};pw2=(u32x4){PKW(pB1,0),PKW(pB1,2),PKW(pB1,4),PKW(pB1,6)};pw3=(u32x4){PKW(pB1,8),PKW(pB1,10),PKW(pB1,12),PKW(pB1,14)};
    SBAR(); pv(o,vb0+sl_cur,PAF(0),PAF(1),PAF(2),PAF(3)); }
  #undef PKW
  #undef PAF
  #undef VFR
  #undef PIN
  #undef MX3
  #undef GAPA
  #undef GAPB
  #undef EX
  #undef VRD
  #undef KRD
  #undef STEP
  #undef ENDW
  {auto rr=__builtin_amdgcn_permlane32_swap(__float_as_uint(l_reg),__float_as_uint(l_reg),false,false);l_reg=__uint_as_float(rr[0])+__uint_as_float(rr[1]);}
  if(hi==0)wsf[32+r32]=l_reg;asm volatile("s_waitcnt lgkmcnt(0)":::"memory");
  float rli[16];
  #pragma unroll
  for(int r=0;r<16;++r)rli[r]=__builtin_amdgcn_rcpf(wsf[32+crow(r,hi)]);
  bf16*Ow=Ou+(long)(wid*QBLK)*QP;
  { bf16*stg=(bf16*)(shm+LDS_OST)+wid*2048;
    #pragma unroll
    for(int r=0;r<16;++r){const int orow=crow(r,hi);
      #pragma unroll
      for(int d0=0;d0<2;++d0)stg[orow*64+d0*32+r32]=__float2bfloat16(o[d0][r]*rli[r]);}
    asm volatile("s_waitcnt lgkmcnt(0)":::"memory");
    #pragma unroll
    for(int i=0;i<4;++i){const int row=i*8+(lane>>3),ch=lane&7; const u32x4 v=*(const u32x4*)(stg+row*64+ch*8); ATTN_STORE16(Ow+(long)row*QP+ch*8,v);} }
  asm volatile("s_waitcnt lgkmcnt(0)\n\ts_barrier":::"memory");
  #undef DMA_K
  #undef DMA_V
  #undef CMASK
  #undef START
  #undef RESC
  #undef ROT
}
constexpr int ATTN_LDS_BYTES=LDS_BYTES;
#undef SBAR
#undef WAIT_BAR
}
#ifndef ATTN_FAST
#define ATTN_FAST 1
#endif
__device__ __forceinline__ void attn_fast(const Params& p, const Ctx& c) {
    typedef attn_body::bf16 abf;
    const int vcu = (c.G % 8 == 0) ? (c.bx % 8) * (c.G / 8) + c.bx / 8 : c.bx;
    for (int u = vcu; u < 512 + 128; u += c.G) {
        const abf *Qu, *Kh, *Vh; int NT;
        if (u < 512) { const int qb = u & 7, hq = (u >> 3) & 3, hk = (u >> 5) & 1, b = u >> 6, h = hk * 4 + hq;
            Qu = (const abf*)(p.ws + Z_AQ) + ((size_t)MP + (size_t)b * SEQ_S + qb * 256) * RW + h * HD;
            Kh = (const abf*)(p.ws + Z_KS) + (size_t)b * SKV_S * KVW + hk * HD; Vh = (const abf*)(p.ws + Z_VS) + (size_t)b * SKV_S * KVW + hk * HD; NT = SKV_S / 64; }
        else { const int v = u - 512, hq = v & 3, hk = (v >> 2) & 1, b = v >> 3, h = hk * 4 + hq;
            Qu = (const abf*)(p.ws + Z_AQ) + ((size_t)b * SEQ_P) * RW + h * HD;
            Kh = (const abf*)(p.ws + Z_KP) + (size_t)b * SEQ_P * KVW + hk * HD; Vh = (const abf*)(p.ws + Z_VP) + (size_t)b * SEQ_P * KVW + hk * HD; NT = SKV_P / 64; }
        attn_body::attn_unit<8>(c.tid, Qu, Kh, Vh, (abf*)Qu, NT, (char*)c.lds);
    }
    __syncthreads();
}

__device__ __forceinline__ void attn_simple(const Params& p, const Ctx& c) {
    LAS float* Kt = (LAS float*)c.lds; LAS float* Vt = Kt + 32 * 64; LAS float* Sc = Vt + 32 * 64;
    constexpr int NU_S = NB_S * NH * 4, NU_P = NB_P * NH;
    for (int u = c.bx; u < NU_S + NU_P; u += c.G) {
        const bool smp = u < NU_S; int b, h, q0, nq, skv; const bf16_t *Kb, *Vb; size_t rowbase;
        if (smp) { b = u / 32; h = (u / 4) & 7; q0 = (u & 3) * 512; nq = 512; skv = SKV_S; Kb = (const bf16_t*)(p.ws + Z_KS) + (size_t)b * SKV_S * KVW; Vb = (const bf16_t*)(p.ws + Z_VS) + (size_t)b * SKV_S * KVW; rowbase = MP + (size_t)b * SEQ_S + q0; }
        else { const int v = u - NU_S; b = v / 8; h = v & 7; q0 = 0; nq = 256; skv = SKV_P; Kb = (const bf16_t*)(p.ws + Z_KP) + (size_t)b * SEQ_P * KVW; Vb = (const bf16_t*)(p.ws + Z_VP) + (size_t)b * SEQ_P * KVW; rowbase = (size_t)b * SEQ_P; }
        const int hk = h >> 2; const bool act = c.tid < nq;
        bf16_t* qrow = (bf16_t*)(p.ws + Z_AQ) + (rowbase + (act ? c.tid : 0)) * RW + h * HD;
        float q[64], o[64]; float mx = -1e30f, lsum = 0.f;
#pragma unroll
        for (int i = 0; i < 8; ++i) { const u32x4 w = *(const u32x4*)(qrow + 8 * i); q[8 * i] = bflo(w.x); q[8 * i + 1] = bfhi(w.x); q[8 * i + 2] = bflo(w.y); q[8 * i + 3] = bfhi(w.y); q[8 * i + 4] = bflo(w.z); q[8 * i + 5] = bfhi(w.z); q[8 * i + 6] = bflo(w.w); q[8 * i + 7] = bfhi(w.w); }
#pragma unroll
        for (int i = 0; i < 64; ++i) o[i] = 0.f;
        for (int k0 = 0; k0 < skv; k0 += 32) {
            __syncthreads();
            { const int e = c.tid * 4, j = e >> 6, d = e & 63;
                const u32x2 kw = *(const u32x2*)(Kb + (size_t)(k0 + j) * KVW + hk * HD + d), vw = *(const u32x2*)(Vb + (size_t)(k0 + j) * KVW + hk * HD + d);
                *(LAS f32x4*)(Kt + e) = (f32x4){bflo(kw.x), bfhi(kw.x), bflo(kw.y), bfhi(kw.y)}; *(LAS f32x4*)(Vt + e) = (f32x4){bflo(vw.x), bfhi(vw.x), bflo(vw.y), bfhi(vw.y)}; }
            __syncthreads();
            float tm = mx;
#pragma unroll 1
            for (int j = 0; j < 32; ++j) { float a = 0.f;
#pragma unroll
                for (int d4 = 0; d4 < 16; ++d4) { const f32x4 kv = *(const LAS f32x4*)(Kt + j * 64 + 4 * d4); a += q[4 * d4] * kv.x + q[4 * d4 + 1] * kv.y + q[4 * d4 + 2] * kv.z + q[4 * d4 + 3] * kv.w; }
                Sc[j * 512 + c.tid] = a; tm = fmaxf(tm, a); }
            const float corr = exp2f(mx - tm); mx = tm; lsum *= corr;
#pragma unroll
            for (int i = 0; i < 64; ++i) o[i] *= corr;
#pragma unroll 1
            for (int j = 0; j < 32; ++j) { const float pj = exp2f(Sc[j * 512 + c.tid] - mx); lsum += pj;
#pragma unroll
                for (int d4 = 0; d4 < 16; ++d4) { const f32x4 vv = *(const LAS f32x4*)(Vt + j * 64 + 4 * d4); o[4 * d4] += pj * vv.x; o[4 * d4 + 1] += pj * vv.y; o[4 * d4 + 2] += pj * vv.z; o[4 * d4 + 3] += pj * vv.w; } }
        }
        if (act) { const float il = 1.f / lsum;
#pragma unroll
            for (int i = 0; i < 8; ++i) { u32x4 w; w.x = pk2(o[8 * i] * il, o[8 * i + 1] * il); w.y = pk2(o[8 * i + 2] * il, o[8 * i + 3] * il); w.z = pk2(o[8 * i + 4] * il, o[8 * i + 5] * il); w.w = pk2(o[8 * i + 6] * il, o[8 * i + 7] * il); *(u32x4*)(qrow + 8 * i) = w; } }
    }
    __syncthreads();
}
__device__ __forceinline__ void cmlp_simple(const Params& p, const Ctx& c, int l) {
    LAS float* Vt = (LAS float*)c.lds;
    LAS float* rs = Vt + 128 * 128;
    const bf16_t* cv = (const bf16_t*)(p.ws + Z_CV); bf16_t* cu = (bf16_t*)(p.ws + Z_CU);
    for (int u = c.bx; u < NCHUNK * 4; u += c.G) {
        const int ch = u >> 2, g = u & 3; const size_t R0 = (size_t)ch * 128;
        __syncthreads();
        { const int q = c.tid >> 2, part = c.tid & 3; float ss = 0.f;
            const bf16_t* r = cv + (R0 + q) * RW + part * 128;
#pragma unroll
            for (int i = 0; i < 16; ++i) { const u32x4 w = *(const u32x4*)(r + 8 * i); const float a0 = bflo(w.x), a1 = bfhi(w.x), a2 = bflo(w.y), a3 = bfhi(w.y), a4 = bflo(w.z), a5 = bfhi(w.z), a6 = bflo(w.w), a7 = bfhi(w.w);
                ss += (a0 * a0 + a1 * a1) + (a2 * a2 + a3 * a3) + (a4 * a4 + a5 * a5) + (a6 * a6 + a7 * a7); }
            ss += __shfl_xor(ss, 1); ss += __shfl_xor(ss, 2);
            if (part == 0) rs[q] = rsqrtf(ss * (1.f / RW) + EPS); }
        __syncthreads();
        for (int e = c.tid; e < 128 * 128 / 8; e += 512) { const int q = e >> 4, c8 = (e & 15) * 8; const float r = rs[q];
            const u32x4 w = *(const u32x4*)(cv + (R0 + q) * RW + g * 128 + c8);
            *(LAS f32x4*)(Vt + q * 128 + c8) = (f32x4){bflo(w.x) * r, bfhi(w.x) * r, bflo(w.y) * r, bfhi(w.y) * r};
            *(LAS f32x4*)(Vt + q * 128 + c8 + 4) = (f32x4){bflo(w.z) * r, bfhi(w.z) * r, bflo(w.w) * r, bfhi(w.w) * r}; }
        __syncthreads();
        const int cc = c.tid & 127, pg = __builtin_amdgcn_readfirstlane(c.tid >> 7);
        const float* Ws = p.in[I_CMWS] + ((size_t)(l * 4 + g) * 128) * 128; const float* bs = p.in[I_CMBS] + (l * 4 + g) * 128;
        const float gn = p.in[I_CMNORM][l * RW + g * 128 + cc];
        for (int pi = 0; pi < 32; ++pi) { const int pr = pg * 32 + pi; const float* wrow = Ws + pr * 128; float a = 0.f;
#pragma unroll 8
            for (int q = 0; q < 128; ++q) a += wrow[q] * Vt[q * 128 + cc];
            bf16_t* up = cu + (R0 + pr) * RW + g * 128 + cc;
            const float uu = bf2f(*up);
            *up = (bf16_t)f2bf(uu * (gn * a + bs[pr])); }
    }
    __syncthreads();
}
__device__ __forceinline__ float ret_ld(const Params& p, int l, int dir, int h) { const float x = p.in[I_DECAY][(l * 2 + dir) * NH + h]; return -log1pf(__expf(x)); }
__device__ __forceinline__ void retU_simple(const Params& p, const Ctx& c, int l) {
    LAS float* Kt = (LAS float*)c.lds; LAS float* Vt = Kt + 128 * 64; LAS float* wf = Vt + 128 * 64; LAS float* wb = wf + 128;
    float* U = (float*)(p.ws + Z_U);
    for (int u = c.bx; u < NCHUNK * NH; u += c.G) {
        const int ch = u >> 3, h = u & 7; const size_t R0 = (size_t)ch * 128;
        const float ldf = ret_ld(p, l, 0, h), ldb = ret_ld(p, l, 1, h);
        __syncthreads();
        if (c.tid < 128) { wf[c.tid] = __expf(ldf * (float)(127 - c.tid)); wb[c.tid] = __expf(ldb * (float)c.tid); }
        for (int e = c.tid; e < 128 * 64 / 8; e += 512) { const int j = e >> 3, d8 = (e & 7) * 8;
            const u32x4 kw = *(const u32x4*)((const bf16_t*)(p.ws + Z_RK) + (R0 + j) * RW + h * HD + d8), vw = *(const u32x4*)((const bf16_t*)(p.ws + Z_RV) + (R0 + j) * RW + h * HD + d8);
            *(LAS f32x4*)(Kt + j * 64 + d8) = (f32x4){bflo(kw.x), bfhi(kw.x), bflo(kw.y), bfhi(kw.y)}; *(LAS f32x4*)(Kt + j * 64 + d8 + 4) = (f32x4){bflo(kw.z), bfhi(kw.z), bflo(kw.w), bfhi(kw.w)};
            *(LAS f32x4*)(Vt + j * 64 + d8) = (f32x4){bflo(vw.x), bfhi(vw.x), bflo(vw.y), bfhi(vw.y)}; *(LAS f32x4*)(Vt + j * 64 + d8 + 4) = (f32x4){bflo(vw.z), bfhi(vw.z), bflo(vw.w), bfhi(vw.w)}; }
        __syncthreads();
        const int e = c.tid & 63, d0 = __builtin_amdgcn_readfirstlane(c.tid >> 6) * 8;
        float uf[8], ub[8];
#pragma unroll
        for (int i = 0; i < 8; ++i) { uf[i] = 0.f; ub[i] = 0.f; }
        for (int j = 0; j < 128; ++j) { const float v = Vt[j * 64 + e], vf = v * wf[j], vb = v * wb[j];
            const f32x4 k0 = *(const LAS f32x4*)(Kt + j * 64 + d0), k1 = *(const LAS f32x4*)(Kt + j * 64 + d0 + 4);
            uf[0] += k0.x * vf; uf[1] += k0.y * vf; uf[2] += k0.z * vf; uf[3] += k0.w * vf; uf[4] += k1.x * vf; uf[5] += k1.y * vf; uf[6] += k1.z * vf; uf[7] += k1.w * vf;
            ub[0] += k0.x * vb; ub[1] += k0.y * vb; ub[2] += k0.z * vb; ub[3] += k0.w * vb; ub[4] += k1.x * vb; ub[5] += k1.y * vb; ub[6] += k1.z * vb; ub[7] += k1.w * vb; }
        float* Uf = U + ((size_t)(0 * NCHUNK + ch) * NH + h) * 4096, *Ub = U + ((size_t)(1 * NCHUNK + ch) * NH + h) * 4096;
#pragma unroll
        for (int i = 0; i < 8; ++i) { Uf[(d0 + i) * 64 + e] = uf[i]; Ub[(d0 + i) * 64 + e] = ub[i]; }
    }
    __syncthreads();
}
__device__ __forceinline__ void retO_simple(const Params& p, const Ctx& c, int l) {
    LAS float* Kt = (LAS float*)c.lds; LAS float* Vt = Kt + 128 * 64; LAS float* Sf = Vt + 128 * 64; LAS float* Sb = Sf + 4096; LAS float* pf = Sb + 4096; LAS float* pb = pf + 132;
    const float* U = (const float*)(p.ws + Z_U);
    for (int u = c.bx; u < NCHUNK * NH; u += c.G) {
        const int ch = u >> 3, h = u & 7; const size_t R0 = (size_t)ch * 128; const bool smp = ch >= MP / 128;
        const int nc = smp ? 16 : 2, ch0 = smp ? (MP / 128 + ((ch - MP / 128) & ~15)) : (ch & ~1), cidx = ch - ch0, b = smp ? (ch - MP / 128) >> 4 : ch >> 1;
        const float ldf = ret_ld(p, l, 0, h), ldb = ret_ld(p, l, 1, h); const float Gf = __expf(128.f * ldf), Gb = __expf(128.f * ldb);
        __syncthreads();
        if (c.tid <= 128) { pf[c.tid] = __expf(ldf * (float)c.tid); pb[c.tid] = __expf(ldb * (float)c.tid); }
        for (int e = c.tid; e < 128 * 64 / 8; e += 512) { const int j = e >> 3, d8 = (e & 7) * 8;
            const u32x4 kw = *(const u32x4*)((const bf16_t*)(p.ws + Z_RK) + (R0 + j) * RW + h * HD + d8), vw = *(const u32x4*)((const bf16_t*)(p.ws + Z_RV) + (R0 + j) * RW + h * HD + d8);
            *(LAS f32x4*)(Kt + j * 64 + d8) = (f32x4){bflo(kw.x), bfhi(kw.x), bflo(kw.y), bfhi(kw.y)}; *(LAS f32x4*)(Kt + j * 64 + d8 + 4) = (f32x4){bflo(kw.z), bfhi(kw.z), bflo(kw.w), bfhi(kw.w)};
            *(LAS f32x4*)(Vt + j * 64 + d8) = (f32x4){bflo(vw.x), bfhi(vw.x), bflo(vw.y), bfhi(vw.y)}; *(LAS f32x4*)(Vt + j * 64 + d8 + 4) = (f32x4){bflo(vw.z), bfhi(vw.z), bflo(vw.w), bfhi(vw.w)}; }
        {
            float sf[8], sb[8]; const int e0 = c.tid * 8;
            if (smp) { const float* s0 = p.in[I_ST] + ((size_t)((b * 2 + l) * 2 + 0) * NH + h) * 4096 + e0; const float* s1 = p.in[I_ST] + ((size_t)((b * 2 + l) * 2 + 1) * NH + h) * 4096 + e0;
#pragma unroll
                for (int i = 0; i < 8; ++i) { sf[i] = s0[i]; sb[i] = s1[i]; } }
            else {
#pragma unroll
                for (int i = 0; i < 8; ++i) { sf[i] = 0.f; sb[i] = 0.f; } }
            for (int cc = 0; cc < cidx; ++cc) { const float* uf = U + ((size_t)(0 * NCHUNK + ch0 + cc) * NH + h) * 4096 + e0;
#pragma unroll
                for (int i = 0; i < 8; ++i) sf[i] = Gf * sf[i] + uf[i]; }
            for (int cc = nc - 1; cc > cidx; --cc) { const float* ub = U + ((size_t)(1 * NCHUNK + ch0 + cc) * NH + h) * 4096 + e0;
#pragma unroll
                for (int i = 0; i < 8; ++i) sb[i] = Gb * sb[i] + ub[i]; }
#pragma unroll
            for (int i = 0; i < 8; ++i) { Sf[e0 + i] = sf[i]; Sb[e0 + i] = sb[i]; }
            if (!smp && cidx == nc - 1) { const float* uf = U + ((size_t)(0 * NCHUNK + ch) * NH + h) * 4096 + e0; float* o = p.out + OUT_ST + ((size_t)((b * 2 + l) * 2 + 0) * NH + h) * 4096 + e0;
#pragma unroll
                for (int i = 0; i < 8; ++i) o[i] = Gf * sf[i] + uf[i]; }
            if (!smp && cidx == 0) { const float* ub = U + ((size_t)(1 * NCHUNK + ch) * NH + h) * 4096 + e0; float* o = p.out + OUT_ST + ((size_t)((b * 2 + l) * 2 + 1) * NH + h) * 4096 + e0;
#pragma unroll
                for (int i = 0; i < 8; ++i) o[i] = Gb * sb[i] + ub[i]; }
        }
        __syncthreads();
        const int i = c.tid >> 2, part = c.tid & 3;
        float qp[16], o[16];
        { const bf16_t* qr = (const bf16_t*)(p.ws + Z_RQ) + (R0 + i) * RW + h * HD + part * 16; const u32x4 w0 = *(const u32x4*)qr, w1 = *(const u32x4*)(qr + 8);
            qp[0] = bflo(w0.x); qp[1] = bfhi(w0.x); qp[2] = bflo(w0.y); qp[3] = bfhi(w0.y); qp[4] = bflo(w0.z); qp[5] = bfhi(w0.z); qp[6] = bflo(w0.w); qp[7] = bfhi(w0.w);
            qp[8] = bflo(w1.x); qp[9] = bfhi(w1.x); qp[10] = bflo(w1.y); qp[11] = bfhi(w1.y); qp[12] = bflo(w1.z); qp[13] = bfhi(w1.z); qp[14] = bflo(w1.w); qp[15] = bfhi(w1.w); }
#pragma unroll
        for (int e = 0; e < 16; ++e) o[e] = 0.f;
#pragma unroll 1
        for (int j = 0; j < 128; ++j) { float s = 0.f;
#pragma unroll
            for (int d4 = 0; d4 < 4; ++d4) { const f32x4 kv = *(const LAS f32x4*)(Kt + j * 64 + part * 16 + 4 * d4); s += qp[4 * d4] * kv.x + qp[4 * d4 + 1] * kv.y + qp[4 * d4 + 2] * kv.z + qp[4 * d4 + 3] * kv.w; }
            s += __shfl_xor(s, 1); s += __shfl_xor(s, 2);
            const float w = j < i ? pf[i - j] : (j > i ? pb[j - i] : 2.0f);
            s *= w;
#pragma unroll
            for (int e4 = 0; e4 < 4; ++e4) { const f32x4 vv = *(const LAS f32x4*)(Vt + j * 64 + part * 16 + 4 * e4); o[4 * e4] += s * vv.x; o[4 * e4 + 1] += s * vv.y; o[4 * e4 + 2] += s * vv.z; o[4 * e4 + 3] += s * vv.w; } }
        { const float xf = pf[i + 1], xb = pb[128 - i]; const bf16_t* qfull = (const bf16_t*)(p.ws + Z_RQ) + (R0 + i) * RW + h * HD;
#pragma unroll 2
            for (int d = 0; d < 64; ++d) { const float qd = bf2f(qfull[d]); const float af = qd * xf, ab = qd * xb;
#pragma unroll
                for (int e4 = 0; e4 < 4; ++e4) { const f32x4 a = *(const LAS f32x4*)(Sf + d * 64 + part * 16 + 4 * e4), bb = *(const LAS f32x4*)(Sb + d * 64 + part * 16 + 4 * e4);
                    o[4 * e4] += af * a.x + ab * bb.x; o[4 * e4 + 1] += af * a.y + ab * bb.y; o[4 * e4 + 2] += af * a.z + ab * bb.z; o[4 * e4 + 3] += af * a.w + ab * bb.w; } } }
        float s1 = 0.f;
#pragma unroll
        for (int e = 0; e < 16; ++e) s1 += o[e];
        s1 += __shfl_xor(s1, 1); s1 += __shfl_xor(s1, 2); const float mu = s1 * (1.f / 64.f);
        float s2 = 0.f;
#pragma unroll
        for (int e = 0; e < 16; ++e) { const float d = o[e] - mu; s2 += d * d; }
        s2 += __shfl_xor(s2, 1); s2 += __shfl_xor(s2, 2); const float rstd = rsqrtf(s2 * (1.f / 64.f) + EPS);
        const float* gn = p.in[I_RETGN] + l * RW + h * HD + part * 16;
        const bf16_t* rg = (const bf16_t*)(p.ws + Z_RG) + (R0 + i) * RW + h * HD + part * 16; const u32x4 g0 = *(const u32x4*)rg, g1 = *(const u32x4*)(rg + 8);
        float gs[16] = {bflo(g0.x), bfhi(g0.x), bflo(g0.y), bfhi(g0.y), bflo(g0.z), bfhi(g0.z), bflo(g0.w), bfhi(g0.w), bflo(g1.x), bfhi(g1.x), bflo(g1.y), bfhi(g1.y), bflo(g1.z), bfhi(g1.z), bflo(g1.w), bfhi(g1.w)};
        float y[16];
#pragma unroll
        for (int e = 0; e < 16; ++e) y[e] = (o[e] - mu) * rstd * gn[e] * gs[e];
        bf16_t* dst = (bf16_t*)(p.ws + Z_CV) + (R0 + i) * RW + h * HD + part * 16;
        u32x4 w0, w1; w0.x = pk2(y[0], y[1]); w0.y = pk2(y[2], y[3]); w0.z = pk2(y[4], y[5]); w0.w = pk2(y[6], y[7]); w1.x = pk2(y[8], y[9]); w1.y = pk2(y[10], y[11]); w1.z = pk2(y[12], y[13]); w1.w = pk2(y[14], y[15]);
        *(u32x4*)dst = w0; *(u32x4*)(dst + 8) = w1;
    }
    __syncthreads();
}

#ifndef PG8_MASK
#define PG8_MASK 0xFFF
#endif
template <int KIND, class Epi, class Sched>
__device__ __forceinline__ void gemm_any(const Ctx& c, const bf16_t* A, const bf16_t* Bt, int K, const Sched& S, const Epi& E) {
    if constexpr ((PG8_MASK >> KIND) & 1) { pg8::Gemm g{A, Bt, 0, 0, K}; pg8::gemm_phase<Epi, Sched, true, true>(c.tid, c.lds, g, S, E); }
    else gemm_simple(c, A, Bt, K, S, E);
}
#ifndef KMASK
#define KMASK 0xFFF
#endif
constexpr int NPHASE = 22;
template <int KIND> __device__ __forceinline__ void run_kind(const Params& p, const Ctx& c, int l) {
    const unsigned char* wb = p.ws + WS_W;
    if constexpr (KIND == 0) { p0_modulation(p, c); p0_rope_tables(p, c); p_wconv(p, c, 0); p_kvctx(p, c, 0); }
    else if constexpr (KIND == 1) { p_norm(p, c, 0, 0); }
    else if constexpr (KIND == 2) { StaticOrder S; S.init(M, NMIX, c.G, c.bx); EpiMix E{&p, l}; gemm_any<2>(c, (const bf16_t*)(p.ws + WS_XN), (const bf16_t*)(wb + W_IN), DM, S, E); }
    else if constexpr (KIND == 3) { if (ATTN_FAST) attn_fast(p, c); else attn_simple(p, c); cmlp_simple(p, c, l); retU_simple(p, c, l); }
    else if constexpr (KIND == 4) { retO_simple(p, c, l); }
    else if constexpr (KIND == 5) { StaticOrder S; S.init(M, NGATE, c.G, c.bx); EpiGate E{&p}; gemm_any<5>(c, (const bf16_t*)(p.ws + WS_XN), (const bf16_t*)(wb + W_IN) + (size_t)NMIX * DM, DM, S, E); }
    else if constexpr (KIND == 6) { MergeOrder S{c.G, c.bx}; EpiMerge E{&p}; gemm_any<6>(c, (const bf16_t*)(p.ws + Z_AQ), (const bf16_t*)(wb + W_BR), RW, S, E); }
    else if constexpr (KIND == 7) { StaticOrder S; S.init(M, DM, c.G, c.bx); EpiRes E{&p, l, 2, l == 0}; gemm_any<7>(c, (const bf16_t*)(p.ws + WS_XN), (const bf16_t*)(wb + W_OUT), DM, S, E); }
    else if constexpr (KIND == 8) { p_norm(p, c, l, 1); }
    else if constexpr (KIND == 9) { StaticOrder S; S.init(M, DFF, c.G, c.bx); EpiFF1 E{&p}; gemm_any<9>(c, (const bf16_t*)(p.ws + WS_XN), (const bf16_t*)(wb + W_FF1), DM, S, E); }
    else if constexpr (KIND == 10) { StaticOrder S; S.init(M, DM, c.G, c.bx); EpiRes E{&p, l, 5, false}; gemm_any<10>(c, (const bf16_t*)(p.ws + Z_HB), (const bf16_t*)(wb + W_FF2), DFF, S, E); }
    else { if (l == 0) { p_wconv(p, c, 1); p_kvctx(p, c, 1); p_norm(p, c, 1, 0); } else p_final_norm(p, c); }
}
__device__ __forceinline__ void run_phase(const Params& p, const Ctx& c0, int ph) {
    Ctx c = c0; asm volatile("" : "+v"(c.tid));
    c.lane = c.tid & 63; c.wave = __builtin_amdgcn_readfirstlane(c.tid >> 6);
    if (ph == 0) { if (KMASK & 1) run_kind<0>(p, c, 0); return; }
    if (ph == 1) { if (KMASK & 2) run_kind<1>(p, c, 0); return; }
    const int l = (ph - 2) / 10, s = (ph - 2) % 10;
    switch (s) {
    case 0: if (KMASK & (1 << 2)) run_kind<2>(p, c, l); break;
    case 1: if (KMASK & (1 << 3)) run_kind<3>(p, c, l); break;
    case 2: if (KMASK & (1 << 4)) run_kind<4>(p, c, l); break;
    case 3: if (KMASK & (1 << 5)) run_kind<5>(p, c, l); break;
    case 4: if (KMASK & (1 << 6)) run_kind<6>(p, c, l); break;
    case 5: if (KMASK & (1 << 7)) run_kind<7>(p, c, l); break;
    case 6: if (KMASK & (1 << 8)) run_kind<8>(p, c, l); break;
    case 7: if (KMASK & (1 << 9)) run_kind<9>(p, c, l); break;
    case 8: if (KMASK & (1 << 10)) run_kind<10>(p, c, l); break;
    default: if (KMASK & (1 << 11)) run_kind<11>(p, c, l); break;
    }
}

#if N_LAUNCH_MODE == 1
__global__ void __launch_bounds__(512, 2) fwd_kernel(Params p) {
    extern __shared__ __attribute__((aligned(16))) unsigned char lds[];
    Ctx c; c.tid = threadIdx.x; c.lane = c.tid & 63; c.wave = __builtin_amdgcn_readfirstlane(c.tid >> 6); c.G = gridDim.x; c.bx = blockIdx.x; c.lds = (LAS unsigned char*)lds;
    volatile LAS unsigned* MISC = (volatile LAS unsigned*)(c.lds + MISC_OFF);
    if (c.tid < 32) MISC[c.tid] = 0u;
    __syncthreads();
    XcdBarrier bar = xcd_barrier_post((unsigned*)(p.ws + WS_CTL) + CW_BAR, MISC + 8);
    for (int ph = p.ph_lo; ph < p.ph_hi; ++ph) { run_phase(p, c, ph); if (ph + 1 < p.ph_hi) xcd_barrier(bar); }
}
#endif
template <int KIND> __global__ void __launch_bounds__(512, 2) phase_kernel(Params p) {
    extern __shared__ __attribute__((aligned(16))) unsigned char lds[];
    Ctx c; c.tid = threadIdx.x; c.lane = c.tid & 63; c.wave = __builtin_amdgcn_readfirstlane(c.tid >> 6); c.G = gridDim.x; c.bx = blockIdx.x; c.lds = (LAS unsigned char*)lds;
    run_kind<KIND>(p, c, p.ph_hi);
}
template <int KIND> static void launch_kind(Params p, int l, int grid, hipStream_t stream) {
    static bool attr = false;
    if (!attr) { (void)hipFuncSetAttribute((const void*)phase_kernel<KIND>, hipFuncAttributeMaxDynamicSharedMemorySize, LDS_BYTES); attr = true; }
    p.ph_lo = 0; p.ph_hi = l;
    hipLaunchKernelGGL(phase_kernel<KIND>, dim3(grid), dim3(512), LDS_BYTES, stream, p);
}

extern "C" void kernel_launch(void* const* d_in, const int* in_sizes, int n_in, void* d_out, int out_size, void* d_ws, size_t ws_size, hipStream_t stream) {
    static int grid = 0;
    if (grid == 0) {
        int dev = 0, cus = 0;
        if (n_in != N_IN || ws_size < WS_NEED) { grid = -1; return; }
        if (hipGetDevice(&dev) != hipSuccess || hipDeviceGetAttribute(&cus, hipDeviceAttributeMultiprocessorCount, dev) != hipSuccess) { grid = -1; return; }
#if N_LAUNCH_MODE == 1
        if (hipFuncSetAttribute((const void*)fwd_kernel, hipFuncAttributeMaxDynamicSharedMemorySize, LDS_BYTES) != hipSuccess) { grid = -1; return; }
#endif
        grid = cus;
    }
    if (grid < 0) return;
    (void)hipMemsetAsync((char*)d_ws + WS_CTL, 0, WS_ZERO_BYTES, stream);
    Params p{};
    for (int i = 0; i < N_IN; ++i) p.in[i] = (const float*)d_in[i];
    p.out = (float*)d_out; p.ws = (unsigned char*)d_ws;
#if N_LAUNCH_MODE == 1
    p.ph_lo = 0; p.ph_hi = NPHASE;
    hipLaunchKernelGGL(fwd_kernel, dim3(grid), dim3(512), LDS_BYTES, stream, p);
#else
    launch_kind<0>(p, 0, grid, stream); launch_kind<1>(p, 0, grid, stream);
    for (int l = 0; l < 2; ++l) {
        launch_kind<2>(p, l, grid, stream); launch_kind<3>(p, l, grid, stream); launch_kind<4>(p, l, grid, stream); launch_kind<5>(p, l, grid, stream); launch_kind<6>(p, l, grid, stream);
        launch_kind<7>(p, l, grid, stream); launch_kind<8>(p, l, grid, stream); launch_kind<9>(p, l, grid, stream); launch_kind<10>(p, l, grid, stream); launch_kind<11>(p, l, grid, stream);
    }
#endif
}
```

```cpp
#include <hip/hip_runtime.h>
#include <hip/hip_bf16.h>
#include <cstdio>
#include <cstdint>

#ifndef N_LAUNCH_MODE
#define N_LAUNCH_MODE 1
#endif

#define GAS __attribute__((address_space(1)))
#define LAS __attribute__((address_space(3)))
#define RLX_AGENT __ATOMIC_RELAXED, __HIP_MEMORY_SCOPE_AGENT
typedef unsigned short bf16_t;
typedef short bf16x8 __attribute__((ext_vector_type(8)));
typedef float f32x4 __attribute__((ext_vector_type(4)));
typedef float f32x2 __attribute__((ext_vector_type(2)));
typedef unsigned u32x4 __attribute__((ext_vector_type(4)));
typedef unsigned u32x2 __attribute__((ext_vector_type(2)));

constexpr int DM = 1024, MP = 4096, MS = 16384, M = 20480, SEQ_P = 256, SEQ_S = 2048, NB_P = 16, NB_S = 8, PAST = 256;
constexpr int HD = 64, NH = 8, KVW = 128, DFF = 4096, INW = 6912, NMIX = 3840, NGATE = 3072, RW = 512;
constexpr int SKV_S = PAST + SEQ_S, SKV_P = SEQ_P;
constexpr int NCHUNK = M / 128;
constexpr float EPS = 1e-6f;
constexpr float C2 = 0.18033688011112042f;
constexpr size_t OUT_Y = 0, OUT_CK = (size_t)M * DM, OUT_CV = OUT_CK + (size_t)NB_P * 2 * SEQ_P * KVW, OUT_ST = OUT_CV + (size_t)NB_P * 2 * SEQ_P * KVW;

constexpr size_t MiB = 1u << 20;
constexpr size_t WS_CTL = 0;
constexpr size_t WS_MOD = 1 * MiB;
constexpr size_t WS_ROPE = 1 * MiB + 512 * 1024;
constexpr size_t WS_ZERO_BYTES = 1 * MiB + 512 * 1024;
constexpr size_t WS_W = 2 * MiB;
constexpr size_t W_IN = 0, W_BR = W_IN + (size_t)INW * DM * 2, W_OUT = W_BR + (size_t)3 * DM * RW * 2, W_FF1 = W_OUT + (size_t)DM * DM * 2, W_FF2 = W_FF1 + (size_t)DFF * DM * 2, W_END = W_FF2 + (size_t)DM * DFF * 2;
static_assert(W_END <= 35 * MiB, "weights");
constexpr size_t WS_XN = 37 * MiB;
constexpr size_t WS_Z = 77 * MiB;
constexpr size_t Z_RQ = WS_Z, Z_RK = WS_Z + 20 * MiB, Z_RV = WS_Z + 40 * MiB, Z_RG = WS_Z + 60 * MiB, Z_U = WS_Z + 80 * MiB;
constexpr size_t Z_AQ = WS_Z + 120 * MiB, Z_CU = WS_Z + 140 * MiB, Z_CV = WS_Z + 160 * MiB;
constexpr size_t Z_KS = WS_Z + 180 * MiB, Z_VS = Z_KS + (size_t)NB_S * SKV_S * KVW * 2, Z_KP = Z_VS + (size_t)NB_S * SKV_S * KVW * 2, Z_VP = Z_KP + (size_t)NB_P * SEQ_P * KVW * 2, Z_END = Z_VP + (size_t)NB_P * SEQ_P * KVW * 2;
constexpr size_t Z_GATE = WS_Z;
constexpr size_t Z_HB = WS_Z;
constexpr size_t WS_NEED = 268 * MiB;
static_assert(Z_END <= WS_NEED, "ws map");
constexpr int CW_BAR = 4096;

constexpr int LDS_BYTES = 147456;
constexpr int MISC_OFF = 131072 + 320;

__device__ __forceinline__ unsigned f2bf(float f) { unsigned u = __builtin_bit_cast(unsigned, f); return (u + 0x7fffu + ((u >> 16) & 1u)) >> 16; }
__device__ __forceinline__ unsigned pk2(float lo, float hi) { return f2bf(lo) | (f2bf(hi) << 16); }
__device__ __forceinline__ float bf2f(unsigned h) { return __builtin_bit_cast(float, h << 16); }
__device__ __forceinline__ float bflo(unsigned w) { return __builtin_bit_cast(float, w << 16); }
__device__ __forceinline__ float bfhi(unsigned w) { return __builtin_bit_cast(float, w & 0xffff0000u); }
__device__ __forceinline__ float sigmoidf_(float x) { return 1.f / (1.f + __expf(-x)); }
__device__ __forceinline__ float siluf_(float x) { return x / (1.f + __expf(-x)); }
__device__ __forceinline__ float gelu_tanh(float x) { const float u = 0.7978845608028654f * (x + 0.044715f * x * x * x); const float e = __expf(2.f * u); const float th = 1.f - 2.f / (e + 1.f); return 0.5f * x * (1.f + th); }
__device__ __forceinline__ float wave_sum(float v) {
#pragma unroll
    for (int o = 1; o < 64; o <<= 1) v += __shfl_xor(v, o);
    return v;
}

#define XB_TMO      128
#define XB_XCNT(j)  (256  + 64 * (j))
#define XB_XSUB(j)  (1280 + 64 * (j))
#define XB_XGEN(j)  (2304 + 64 * (j))
#define XB_TOP      3328
#define XB_TOPGEN   3392
#define XCD_BAR_WORDS 3456
#define XB_SPIN_CAP (1u << 18)
__device__ __forceinline__ unsigned xb_ld(unsigned* p)              { return __hip_atomic_load(p, __ATOMIC_RELAXED, __HIP_MEMORY_SCOPE_AGENT); }
__device__ __forceinline__ unsigned xb_add(unsigned* p, unsigned v) { return __hip_atomic_fetch_add(p, v, __ATOMIC_RELAXED, __HIP_MEMORY_SCOPE_AGENT); }
__device__ __forceinline__ unsigned xb_xcc_id() { return (unsigned)__builtin_amdgcn_s_getreg((3 << 11) | 20) & 0xFu; }
#define XB_SPIN(cond, bar) do { unsigned _sp = 0; while (cond) { __builtin_amdgcn_s_sleep(1); \
    if ((++_sp & 255u) == 0u) { if (xb_ld(&(bar)[XB_TMO])) break; if (_sp > XB_SPIN_CAP) { atomicAdd(&(bar)[XB_TMO], 1u); break; } } } } while (0)
struct XcdBarrier { unsigned* bar; unsigned x; volatile LAS unsigned* st; };
__device__ __forceinline__ XcdBarrier xcd_barrier_post(unsigned* bar, volatile LAS unsigned* st) {
    XcdBarrier b; b.bar = bar; b.x = xb_xcc_id(); b.st = st;
    if (threadIdx.x == 0) (void)xb_add(&bar[XB_XCNT(b.x)], 1u);
    return b;
}
__device__ __forceinline__ void xcd_barrier_complete(unsigned* bar, unsigned x, unsigned& nloc, unsigned& nx) {
    const unsigned G = gridDim.x * gridDim.y * gridDim.z;
    unsigned sum, cnt, mine, sp = 0u;
    for (;;) {
        sum = 0u; cnt = 0u; mine = 0u;
#pragma unroll
        for (unsigned j = 0; j < 16; ++j) { const unsigned c = xb_ld(&bar[XB_XCNT(j)]); sum += c; cnt += (c > 0u) ? 1u : 0u; mine = (j == x) ? c : mine; }
        if (sum == G) break;
        __builtin_amdgcn_s_sleep(1);
        if ((++sp & 255u) == 0u) { if (xb_ld(&bar[XB_TMO])) break; if (sp > XB_SPIN_CAP) { atomicAdd(&bar[XB_TMO], 1u); break; } }
    }
    nloc = mine > 0u ? mine : 1u; nx = cnt > 0u ? cnt : 1u;
}
__device__ __forceinline__ void xcd_barrier(const XcdBarrier& b) {
    asm volatile("s_waitcnt vmcnt(0)" ::: "memory");
    __syncthreads();
    if (threadIdx.x == 0) {
        unsigned* bar = b.bar;
        __builtin_amdgcn_s_waitcnt(0);
        unsigned nloc = b.st[0], nx = b.st[1];
        if (nloc == 0u) { xcd_barrier_complete(bar, b.x, nloc, nx); b.st[0] = nloc; b.st[1] = nx; }
        const unsigned old = xb_add(&bar[XB_XSUB(b.x)], 1u);
        const unsigned gen = old / nloc;
        if (old + 1u == (gen + 1u) * nloc) {
            __builtin_amdgcn_fence(__ATOMIC_RELEASE, "agent");
            asm volatile("s_waitcnt vmcnt(0)" ::: "memory");
            const unsigned og = xb_add(&bar[XB_TOP], 1u);
            const unsigned tg = og / nx;
            if (og + 1u == (tg + 1u) * nx) xb_add(&bar[XB_TOPGEN], 1u);
            else XB_SPIN(xb_ld(&bar[XB_TOPGEN]) == tg, bar);
            __builtin_amdgcn_fence(__ATOMIC_ACQUIRE, "agent");
            xb_add(&bar[XB_XGEN(b.x)], 1u);
            asm volatile("s_waitcnt vmcnt(0)" ::: "memory");
        } else {
            XB_SPIN(xb_ld(&bar[XB_XGEN(b.x)]) == gen, bar);
            __builtin_amdgcn_fence(__ATOMIC_ACQUIRE, "agent");
            asm volatile("s_waitcnt vmcnt(0)" ::: "memory");
        }
    }
    __syncthreads();
}

enum { I_XP = 0, I_XS, I_CK, I_CV, I_ST, I_C, I_CCTX, I_WMOD, I_BMOD, I_GN1, I_GN2, I_WIN, I_GQ, I_GK, I_DECAY, I_RETGN, I_CMNORM, I_CMWS, I_CMBS, I_WBRR, I_WBRA, I_WBRC, I_WOUT, I_WFF1, I_WFF2, I_GFIN, N_IN };
struct Params { const float* in[N_IN]; float* out; unsigned char* ws; int ph_lo, ph_hi; };
static_assert(sizeof(Params) == N_IN * 8 + 8 + 8 + 8, "no padding");

struct Ctx {
    int tid, lane, wave, G, bx;
    LAS unsigned char* lds;
};
__device__ __forceinline__ int row_ci(int R) { return R < MP ? 0 : 1 + ((R - MP) >> 11); }
__device__ __forceinline__ const float* mod_ptr(const Params& p, int l, int ci, int part) { return (const float*)(p.ws + WS_MOD) + ((size_t)(l * 9 + ci) * 6 + part) * DM; }

__device__ __forceinline__ void p0_modulation(const Params& p, const Ctx& c) {
    LAS float* sl = (LAS float*)c.lds;
    for (int i = c.tid; i < 9 * DM; i += 512) { const int ci = i >> 10, k = i & 1023; const float v = ci == 0 ? p.in[I_CCTX][k] : p.in[I_C][(ci - 1) * DM + k]; sl[i] = siluf_(v); }
    __syncthreads();
    float* mod = (float*)(p.ws + WS_MOD);
    const int gw = c.bx * 8 + c.wave, NGW = c.G * 8;
    constexpr int NITEM = 2 * 96 * 8;
    for (int it = gw; it < NITEM; it += NGW) {
        const int l = it / 768, r = it % 768, cb = r >> 3, ks = r & 7;
        const float* W = p.in[I_WMOD] + (size_t)l * DM * 6144 + (size_t)(ks * 128) * 6144 + cb * 64 + c.lane;
        float s[9];
#pragma unroll
        for (int ci = 0; ci < 9; ++ci) s[ci] = 0.f;
#pragma unroll 4
        for (int k = 0; k < 128; ++k) {
            const float w = W[(size_t)k * 6144];
#pragma unroll
            for (int ci = 0; ci < 9; ++ci) s[ci] += sl[ci * DM + ks * 128 + k] * w;
        }
        const float bias = ks == 0 ? p.in[I_BMOD][l * 6144 + cb * 64 + c.lane] : 0.f;
#pragma unroll
        for (int ci = 0; ci < 9; ++ci) atomicAdd(mod + (size_t)(l * 9 + ci) * 6144 + cb * 64 + c.lane, s[ci] + bias);
    }
    __syncthreads();
}
__device__ __forceinline__ void p0_rope_tables(const Params& p, const Ctx& c) {
    f32x2* tab = (f32x2*)(p.ws + WS_ROPE);
    const int g = c.bx * 512 + c.tid;
    if (g < 96 * 16) { const int pos = g >> 4, i = g & 15; const float inv = 1.0f / powf(10000.0f, (float)(2 * i) / 32.0f); const float posf = pos < 32 ? (float)pos : (float)(pos - 32);
        const float ang = posf * inv; f32x2 v; v.x = cosf(ang); v.y = sinf(ang); tab[g] = v; }
}
__device__ __forceinline__ int win_colmap(int n) {
    const int tile = n >> 8, pp = n & 255, bj = pp >> 7, wc = (pp >> 5) & 3;
    if (tile < 10) return (tile >> 1) * 512 + ((tile & 1) * 4 + wc) * 64 + 32 * bj;
    if (tile == 10) return (wc < 2 ? 2560 + wc * 64 : 2688 + (wc - 2) * 64) + 32 * bj;
    return n;
}
__device__ __forceinline__ void transpose_item(const float* W, int K, int ldn, int src_col0, bf16_t* WT, int dst_row0, int k0, LAS float* scr, int lane) {
#pragma unroll 8
    for (int i = 0; i < 32; ++i) { const int kk = 2 * i + (lane >> 5); scr[kk * 33 + (lane & 31)] = W[(size_t)(k0 + kk) * ldn + src_col0 + (lane & 31)]; }
    asm volatile("s_waitcnt lgkmcnt(0)" ::: "memory");
    const int ch = lane & 7;
#pragma unroll
    for (int j = 0; j < 4; ++j) { const int n = (lane >> 3) + 8 * j; const LAS float* s = scr + (8 * ch) * 33 + n;
        u32x4 o; o.x = pk2(s[0 * 33], s[1 * 33]); o.y = pk2(s[2 * 33], s[3 * 33]); o.z = pk2(s[4 * 33], s[5 * 33]); o.w = pk2(s[6 * 33], s[7 * 33]);
        *(u32x4*)(WT + (size_t)(dst_row0 + n) * K + k0 + 8 * ch) = o; }
    asm volatile("s_waitcnt lgkmcnt(0)" ::: "memory");
}
__device__ __forceinline__ void p_wconv(const Params& p, const Ctx& c, int l) {
    LAS float* scr = (LAS float*)(c.lds + 40960 + c.wave * 8448);
    const int gw = c.bx * 8 + c.wave, NGW = c.G * 8;
    unsigned char* wb = p.ws + WS_W;
    constexpr int I_IN = 16 * 216, I_BRX = 8 * 32, I_O = 16 * 32, I_F1 = 16 * 128, I_F2 = 64 * 32;
    constexpr int NITEMS = I_IN + 3 * I_BRX + I_O + I_F1 + I_F2;
    for (int it = gw; it < NITEMS; it += NGW) {
        int r = it;
        if (r < I_IN) { const int kb = r / 216, nb = r % 216; transpose_item(p.in[I_WIN] + (size_t)l * DM * INW, DM, INW, win_colmap(nb * 32), (bf16_t*)(wb + W_IN), nb * 32, kb * 64, scr, c.lane); continue; } r -= I_IN;
        if (r < 3 * I_BRX) { const int x = r / I_BRX, rr = r % I_BRX, kb = rr / 32, nb = rr % 32;
            const float* src = (x == 0 ? p.in[I_WBRA] : x == 1 ? p.in[I_WBRC] : p.in[I_WBRR]) + (size_t)l * RW * DM;
            transpose_item(src, RW, DM, nb * 32, (bf16_t*)(wb + W_BR) + (size_t)x * DM * RW, nb * 32, kb * 64, scr, c.lane); continue; } r -= 3 * I_BRX;
        if (r < I_O) { const int kb = r / 32, nb = r % 32; transpose_item(p.in[I_WOUT] + (size_t)l * DM * DM, DM, DM, nb * 32, (bf16_t*)(wb + W_OUT), nb * 32, kb * 64, scr, c.lane); continue; } r -= I_O;
        if (r < I_F1) { const int kb = r / 128, nb = r % 128; transpose_item(p.in[I_WFF1] + (size_t)l * DM * DFF, DM, DFF, nb * 32, (bf16_t*)(wb + W_FF1), nb * 32, kb * 64, scr, c.lane); continue; } r -= I_F1;
        { const int kb = r / 32, nb = r % 32; transpose_item(p.in[I_WFF2] + (size_t)l * DFF * DM, DFF, DM, nb * 32, (bf16_t*)(wb + W_FF2), nb * 32, kb * 64, scr, c.lane); }
    }
}
__device__ __forceinline__ void p_kvctx(const Params& p, const Ctx& c, int l) {
    const int g = c.bx * 512 + c.tid, NG = c.G * 512;
    for (int i = g; i < NB_S * PAST * KVW / 4; i += NG) {
        const int e = i * 4, b = e / (PAST * KVW), r = e % (PAST * KVW);
        const size_t src = ((size_t)(b * 2 + l) * PAST) * KVW + r;
        const f32x4 k = *(const f32x4*)(p.in[I_CK] + src), v = *(const f32x4*)(p.in[I_CV] + src);
        u32x2 ko, vo; ko.x = pk2(k.x, k.y); ko.y = pk2(k.z, k.w); vo.x = pk2(v.x, v.y); vo.y = pk2(v.z, v.w);
        *(u32x2*)((bf16_t*)(p.ws + Z_KS) + (size_t)b * SKV_S * KVW + r) = ko;
        *(u32x2*)((bf16_t*)(p.ws + Z_VS) + (size_t)b * SKV_S * KVW + r) = vo;
    }
}
__device__ __forceinline__ const float* x_row(const Params& p, int l, int R) { return l == 0 ? (R < MP ? p.in[I_XP] + (size_t)R * DM : p.in[I_XS] + (size_t)(R - MP) * DM) : p.out + (size_t)R * DM; }
__device__ __forceinline__ void p_norm(const Params& p, const Ctx& c, int l, int which) {
    const int gw = c.bx * 8 + c.wave, NGW = c.G * 8;
    const float* gvec = (which == 0 ? p.in[I_GN1] : p.in[I_GN2]) + l * DM;
    for (int R = gw; R < M; R += NGW) {
        const float* xr = which == 0 ? x_row(p, l, R) : p.out + (size_t)R * DM;
        const int ci = row_ci(R);
        const float* sh = mod_ptr(p, l, ci, which == 0 ? 0 : 3); const float* sc = mod_ptr(p, l, ci, which == 0 ? 1 : 4);
        f32x4 v[4]; float s = 0.f;
#pragma unroll
        for (int j = 0; j < 4; ++j) { v[j] = *(const f32x4*)(xr + 4 * c.lane + 256 * j); s += (v[j].x * v[j].x + v[j].y * v[j].y) + (v[j].z * v[j].z + v[j].w * v[j].w); }
        const float rstd = rsqrtf(wave_sum(s) * (1.f / DM) + EPS);
        bf16_t* orow = (bf16_t*)(p.ws + WS_XN) + (size_t)R * DM;
#pragma unroll
        for (int j = 0; j < 4; ++j) { const int col = 4 * c.lane + 256 * j; const f32x4 g = *(const f32x4*)(gvec + col), a = *(const f32x4*)(sc + col), b = *(const f32x4*)(sh + col);
            f32x4 o = v[j] * rstd * g * (a + 1.0f) + b; u32x2 w; w.x = pk2(o.x, o.y); w.y = pk2(o.z, o.w); *(u32x2*)(orow + col) = w; }
    }
}
__device__ __forceinline__ void p_final_norm(const Params& p, const Ctx& c) {
    const int gw = c.bx * 8 + c.wave, NGW = c.G * 8;
    for (int R = gw; R < M; R += NGW) {
        float* xr = p.out + (size_t)R * DM;
        f32x4 v[4]; float s = 0.f;
#pragma unroll
        for (int j = 0; j < 4; ++j) { v[j] = *(const f32x4*)(xr + 4 * c.lane + 256 * j); s += (v[j].x * v[j].x + v[j].y * v[j].y) + (v[j].z * v[j].z + v[j].w * v[j].w); }
        const float rstd = rsqrtf(wave_sum(s) * (1.f / DM) + EPS);
#pragma unroll
        for (int j = 0; j < 4; ++j) { const int col = 4 * c.lane + 256 * j; const f32x4 g = *(const f32x4*)(p.in[I_GFIN] + col); *(f32x4*)(xr + col) = v[j] * rstd * g; }
    }
}

struct Unit { int pm, pn; };
__host__ __device__ __forceinline__ int perm32(int rho) { const int n = rho >> 4, i = rho & 15; return 8 * (i >> 2) + 4 * n + (i & 3); }
struct StaticOrder {
    int nM, nN, nwg, G, c;
    __device__ void init(int Mr, int N, int G_, int c_) { nM = Mr / 256; nN = N / 256; nwg = nM * nN; G = G_; c = c_; }
    __device__ bool next(int i, Unit& u) const {
        const long L = (long)i * G + c; if (L >= nwg) return false;
        int wgid = (int)L; { const int q = nwg / 8, r = nwg % 8, xcd = wgid % 8, off = wgid / 8; wgid = (xcd < r ? xcd * (q + 1) : r * (q + 1) + (xcd - r) * q) + off; }
        const int nig = 8 * nN, gid = wgid / nig, fm = gid * 8, gsz = (nM - fm) < 8 ? (nM - fm) : 8;
        u.pm = fm + ((wgid % nig) % gsz); u.pn = (wgid % nig) / gsz; return true;
    }
    __device__ __forceinline__ void a_ready(const Unit&) const {}
    __device__ __forceinline__ void done(const Unit&) const {}
};
struct MergeOrder {
    int G, c;
    __device__ bool next(int i, Unit& u) const {
        const int t = i / 3, x = i % 3; const long L = (long)t * G + c; if (L >= 320) return false;
        u.pm = x * 80 + (int)(L >> 2); u.pn = x * 4 + (int)(L & 3); return true;
    }
    __device__ __forceinline__ void a_ready(const Unit&) const {}
    __device__ __forceinline__ void done(const Unit&) const {}
};
template <class Epi, class Sched>
__device__ __forceinline__ void gemm_simple(const Ctx& c, const bf16_t* A, const bf16_t* Bt, int K, const Sched& S, const Epi& E) {
    const int tid = c.tid, wid = c.wave, lane = tid & 63, wr = wid >> 2, wc = wid & 3, fr = lane & 15, fq = lane >> 4;
    Unit u;
    for (int ui = 0; S.next(ui, u); ++ui) {
        f32x4 acc[2][2][4][2];
#pragma unroll
        for (int a = 0; a < 2; ++a)
#pragma unroll
            for (int b = 0; b < 2; ++b)
#pragma unroll
                for (int m = 0; m < 4; ++m)
#pragma unroll
                    for (int n = 0; n < 2; ++n) acc[a][b][m][n] = (f32x4){0.f, 0.f, 0.f, 0.f};
        const bf16_t* Ar = A + (size_t)(u.pm * 256 + wr * 64 + fr) * K + fq * 8;
        const bf16_t* Br[2];
#pragma unroll
        for (int n = 0; n < 2; ++n) Br[n] = Bt + (size_t)(u.pn * 256 + wc * 32 + (Epi::PERM ? perm32(16 * n + fr) : 16 * n + fr)) * K + fq * 8;
#pragma unroll 1
        for (int k0 = 0; k0 < K; k0 += 32) {
            bf16x8 tf[2][4], wf[2][2];
#pragma unroll
            for (int ai = 0; ai < 2; ++ai)
#pragma unroll
                for (int m = 0; m < 4; ++m) tf[ai][m] = *(const bf16x8*)(Ar + (size_t)(ai * 128 + m * 16) * K + k0);
#pragma unroll
            for (int bj = 0; bj < 2; ++bj)
#pragma unroll
                for (int n = 0; n < 2; ++n) wf[bj][n] = *(const bf16x8*)(Br[n] + (size_t)(bj * 128) * K + k0);
#pragma unroll
            for (int ai = 0; ai < 2; ++ai)
#pragma unroll
                for (int bj = 0; bj < 2; ++bj)
#pragma unroll
                    for (int m = 0; m < 4; ++m)
#pragma unroll
                        for (int n = 0; n < 2; ++n) acc[ai][bj][m][n] = __builtin_amdgcn_mfma_f32_16x16x32_bf16(wf[bj][n], tf[ai][m], acc[ai][bj][m][n], 0, 0, 0);
        }
        E(acc, u, wr, wc, fr, fq);
    }
}

namespace pg8 {
#define PG8_LAS __attribute__((address_space(3)))
constexpr int BM = 256, BK = 64, HALF = 128, HTB = HALF * BK * 2  , STAGE_BYTES = 8 * HTB, NXCD = 8, WGM = 8;

__host__ __device__ __forceinline__ int lds_byte(int r, int c) { const int st = (r >> 4) * 2 + (c >> 5), rr = r & 15, cc = c & 31, ob = rr * 64 + cc * 2; return st * 1024 + (ob ^ (((ob >> 9) & 1) << 5)); }
__host__ __device__ __forceinline__ void stage_rc(int b, int& R, int& C) { const int st = b / 1024, sb = b % 1024, swz = sb ^ (((sb >> 9) & 1) << 5); R = (st >> 1) * 16 + swz / 64; C = (st & 1) * 32 + (swz % 64) / 2; }
struct Gemm { const bf16_t* A; const bf16_t* Bt; int M, N, K; };
template <class Epi, class Sched, bool ALIGN_EPI = false, bool SP2 = false>
__device__ __forceinline__ void gemm_phase(int tid_in, PG8_LAS unsigned char* lds, const Gemm g, const Sched& S, const Epi& E) {
    const int tid = tid_in, wid = __builtin_amdgcn_readfirstlane(tid >> 6), lane = tid & 63, wr = wid >> 2, wc = wid & 3, fr = lane & 15, fq = lane >> 4;
    const int K = g.K, nt = K / BK;
    unsigned voffA[2], voffB[2];
#pragma unroll
    for (int i = 0; i < 2; ++i) { int R, C; stage_rc(tid * 16 + i * 8192, R, C); const int Rb = Epi::PERM ? ((R & ~31) + perm32(R & 31)) : R;
        voffA[i] = (unsigned)(R * K + C) * 2u; voffB[i] = (unsigned)(Rb * K + C) * 2u; }
    const size_t kstep = (size_t)(BK * 2);
    const size_t hstep = (size_t)HALF * K * 2;
    const size_t tstep = 2 * hstep;
    const unsigned ldsw = (unsigned)wid * 1024u;
    const int aoff = lds_byte(wr * 64 + fr, fq * 8), boff = lds_byte(wc * 32 + fr, fq * 8);
#define PG8_SA(b, h) (((b) * 2 + (h)) * HTB)
#define PG8_SB(b, h) ((4 + (b) * 2 + (h)) * HTB)
#define PG8_STAGE(bufoff, gbase, voff) do { _Pragma("unroll") for (int _i = 0; _i < 2; ++_i) \
        __builtin_amdgcn_global_load_lds((const unsigned*)((const char*)(gbase) + (voff)[_i]), (PG8_LAS unsigned*)(lds + (bufoff) + ldsw + _i * 8192), 16, 0, 0); } while (0)
#define PG8_LDA(dst, b, h) do { _Pragma("unroll") for (int m = 0; m < 4; ++m) _Pragma("unroll") for (int k = 0; k < 2; ++k) dst[m][k] = *(const PG8_LAS bf16x8*)(lds + PG8_SA(b, h) + aoff + m * 2048 + k * 1024); } while (0)
#define PG8_LDB(dst, b, h) do { _Pragma("unroll") for (int n = 0; n < 2; ++n) _Pragma("unroll") for (int k = 0; k < 2; ++k) dst[n][k] = *(const PG8_LAS bf16x8*)(lds + PG8_SB(b, h) + boff + n * 2048 + k * 1024); } while (0)
#define PG8_MMA(ai, bj, At, Bt) do { __builtin_amdgcn_s_setprio(1); _Pragma("unroll") for (int m = 0; m < 4; ++m) _Pragma("unroll") for (int n = 0; n < 2; ++n) _Pragma("unroll") for (int k = 0; k < 2; ++k) \
        acc[ai][bj][m][n] = __builtin_amdgcn_mfma_f32_16x16x32_bf16(Bt[n][k], At[m][k], acc[ai][bj][m][n], 0, 0, 0); __builtin_amdgcn_s_setprio(0); } while (0)
#define PG8_WAIT_V(n) asm volatile("s_waitcnt vmcnt(" #n ")" ::: "memory")
#define PG8_WAIT_L(n) asm volatile("s_waitcnt lgkmcnt(" #n ")" ::: "memory")
#define PG8_BAR __builtin_amdgcn_s_barrier()
#define PG8_SCHED __builtin_amdgcn_sched_barrier(0)
    Unit cur, nxt; int ui = 0;
    if (!S.next(0, cur)) return;
    f32x4 acc[2][2][4][2];
#pragma unroll
    for (int a = 0; a < 2; ++a)
#pragma unroll
        for (int b = 0; b < 2; ++b)
#pragma unroll
            for (int m = 0; m < 4; ++m)
#pragma unroll
                for (int n = 0; n < 2; ++n) acc[a][b][m][n] = (f32x4){0.f, 0.f, 0.f, 0.f};
    bf16x8 At[4][2], B0[2][2], B1[2][2];
    const char* cA = (const char*)g.A + (size_t)cur.pm * tstep; const char* cB = (const char*)g.Bt + (size_t)cur.pn * tstep;
    S.a_ready(cur);
    if constexpr (SP2) {
        PG8_STAGE(PG8_SB(0, 0), cB, voffB); PG8_STAGE(PG8_SB(0, 1), cB + hstep, voffB); PG8_STAGE(PG8_SA(0, 0), cA, voffA); PG8_STAGE(PG8_SA(0, 1), cA + hstep, voffA);
        if (wr == 1) PG8_BAR;
        PG8_WAIT_V(2); PG8_BAR;
        PG8_STAGE(PG8_SB(1, 0), cB + kstep, voffB); PG8_STAGE(PG8_SA(1, 0), cA + kstep, voffA); PG8_STAGE(PG8_SB(1, 1), cB + hstep + kstep, voffB);
        PG8_WAIT_V(6); PG8_BAR;
    } else {
        PG8_STAGE(PG8_SB(0, 0), cB, voffB); PG8_STAGE(PG8_SA(0, 0), cA, voffA); PG8_STAGE(PG8_SB(0, 1), cB + hstep, voffB); PG8_STAGE(PG8_SA(0, 1), cA + hstep, voffA);
        if (wr == 1) PG8_BAR;
        PG8_WAIT_V(4); PG8_BAR;
        PG8_STAGE(PG8_SB(1, 0), cB + kstep, voffB); PG8_STAGE(PG8_SA(1, 0), cA + kstep, voffA); PG8_STAGE(PG8_SB(1, 1), cB + hstep + kstep, voffB);
        PG8_WAIT_V(6); PG8_BAR;
    }
    for (;;) {
        const bool has_next = S.next(ui + 1, nxt);
        const char* nA = has_next ? (const char*)g.A + (size_t)nxt.pm * tstep : cA; const char* nB = has_next ? (const char*)g.Bt + (size_t)nxt.pn * tstep : cB;
        for (int t = 0; t < nt; t += 2) {
            const bool last = (t == nt - 2);
            const char* a1 = cA + (size_t)(t + 1) * kstep;
            const char* a2 = last ? nA : cA + (size_t)(t + 2) * kstep; const char* b2 = last ? nB : cB + (size_t)(t + 2) * kstep;
            const char* a3 = a2 + kstep; const char* b3 = b2 + kstep;
            if (last && has_next) S.a_ready(nxt);
            if constexpr (SP2) {
            PG8_LDB(B0, 0, 0); PG8_LDB(B1, 0, 1); PG8_SCHED; PG8_LDA(At, 0, 0); PG8_STAGE(PG8_SA(1, 1), a1 + hstep, voffA);
            PG8_WAIT_V(8); PG8_WAIT_L(0); PG8_BAR; PG8_MMA(0, 0, At, B0); PG8_MMA(0, 1, At, B1); PG8_BAR; PG8_SCHED;
            PG8_LDA(At, 0, 1); PG8_STAGE(PG8_SB(0, 0), b2, voffB); PG8_STAGE(PG8_SB(0, 1), b2 + hstep, voffB); PG8_STAGE(PG8_SA(0, 0), a2, voffA);
            PG8_WAIT_V(8); PG8_WAIT_L(0); PG8_BAR; PG8_MMA(1, 0, At, B0); PG8_MMA(1, 1, At, B1); PG8_BAR; PG8_SCHED;
            PG8_LDB(B0, 1, 0); PG8_LDB(B1, 1, 1); PG8_SCHED; PG8_LDA(At, 1, 0); PG8_STAGE(PG8_SA(0, 1), a2 + hstep, voffA);
            PG8_WAIT_V(8); PG8_WAIT_L(0); PG8_BAR; PG8_MMA(0, 0, At, B0); PG8_MMA(0, 1, At, B1); PG8_BAR; PG8_SCHED;
            PG8_LDA(At, 1, 1); PG8_STAGE(PG8_SB(1, 0), b3, voffB); PG8_STAGE(PG8_SB(1, 1), b3 + hstep, voffB); PG8_STAGE(PG8_SA(1, 0), a3, voffA);
            PG8_WAIT_V(8); PG8_WAIT_L(0); PG8_BAR; PG8_MMA(1, 0, At, B0); PG8_MMA(1, 1, At, B1); PG8_BAR; PG8_SCHED;
            } else {
            PG8_LDB(B0, 0, 0); PG8_SCHED; PG8_LDA(At, 0, 0); PG8_STAGE(PG8_SA(1, 1), a1 + hstep, voffA);
            PG8_WAIT_L(8); PG8_BAR; PG8_WAIT_L(0); PG8_MMA(0, 0, At, B0); PG8_BAR; PG8_SCHED;
            PG8_LDB(B1, 0, 1); PG8_STAGE(PG8_SB(0, 0), b2, voffB);
            PG8_BAR; PG8_WAIT_L(0); PG8_MMA(0, 1, At, B1); PG8_BAR;
            PG8_LDA(At, 0, 1); PG8_STAGE(PG8_SA(0, 0), a2, voffA);
            PG8_BAR; PG8_WAIT_L(0); PG8_MMA(1, 0, At, B0); PG8_BAR; PG8_SCHED;
            PG8_STAGE(PG8_SB(0, 1), b2 + hstep, voffB);
            PG8_WAIT_V(6); PG8_BAR; PG8_MMA(1, 1, At, B1); PG8_BAR;
            PG8_LDB(B0, 1, 0); PG8_SCHED; PG8_LDA(At, 1, 0); PG8_STAGE(PG8_SA(0, 1), a2 + hstep, voffA);
            PG8_WAIT_L(8); PG8_BAR; PG8_WAIT_L(0); PG8_MMA(0, 0, At, B0); PG8_BAR; PG8_SCHED;
            PG8_LDB(B1, 1, 1); PG8_STAGE(PG8_SB(1, 0), b3, voffB);
            PG8_BAR; PG8_WAIT_L(0); PG8_MMA(0, 1, At, B1); PG8_BAR;
            PG8_LDA(At, 1, 1); PG8_STAGE(PG8_SA(1, 0), a3, voffA);
            PG8_BAR; PG8_WAIT_L(0); PG8_MMA(1, 0, At, B0); PG8_BAR; PG8_SCHED;
            PG8_STAGE(PG8_SB(1, 1), b3 + hstep, voffB);
            PG8_WAIT_V(6); PG8_BAR; PG8_MMA(1, 1, At, B1); PG8_BAR;
            }
        }
        if constexpr (ALIGN_EPI) { if (wr == 0) PG8_BAR; }
        if constexpr (!Epi::AFTER_DRAIN) { E(acc, cur, wr, wc, fr, fq); S.done(cur); }
        if (!has_next) break;
#pragma unroll
        for (int a = 0; a < 2; ++a)
#pragma unroll
            for (int b = 0; b < 2; ++b)
#pragma unroll
                for (int m = 0; m < 4; ++m)
#pragma unroll
                    for (int n = 0; n < 2; ++n) acc[a][b][m][n] = (f32x4){0.f, 0.f, 0.f, 0.f};
        cur = nxt; cA = nA; cB = nB; ++ui;
        if constexpr (ALIGN_EPI) { if (wr == 1) PG8_BAR; }
    }
    PG8_WAIT_V(0);
    if constexpr (!ALIGN_EPI) { if (wr == 0) PG8_BAR; }
    PG8_BAR;
    if constexpr (Epi::AFTER_DRAIN) { E.fused(acc, cur, wr, wc, fr, fq, lds, wid, lane); S.done(cur); }
#undef PG8_SA
#undef PG8_SB
#undef PG8_STAGE
#undef PG8_LDA
#undef PG8_LDB
#undef PG8_MMA
#undef PG8_WAIT_V
#undef PG8_WAIT_L
#undef PG8_BAR
#undef PG8_SCHED
}
}

__device__ __forceinline__ u32x4 pack8(const f32x4& a, const f32x4& b) { u32x4 w; w.x = pk2(a.x, a.y); w.y = pk2(a.z, a.w); w.z = pk2(b.x, b.y); w.w = pk2(b.z, b.w); return w; }
__device__ __forceinline__ void rope4(f32x4& v, const f32x2 cs0, const f32x2 cs1) {
    const float a0 = v.x * cs0.x - v.y * cs0.y, a1 = v.x * cs0.y + v.y * cs0.x, a2 = v.z * cs1.x - v.w * cs1.y, a3 = v.z * cs1.y + v.w * cs1.x;
    v.x = a0; v.y = a1; v.z = a2; v.w = a3;
}
struct EpiMix {
    static constexpr bool PERM = true, AFTER_DRAIN = false;
    const Params* pp; int l;
    __device__ __forceinline__ void operator()(const f32x4 (&acc)[2][2][4][2], const Unit& u, int wr, int wc, int fr, int fq) const {
        const Params& p = *pp;
        const int pn = u.pn, R0 = u.pm * 256; const bool smp = R0 >= MP;
        const int b = smp ? (R0 - MP) >> 11 : R0 >> 8, t0 = smp ? (R0 - MP) & 2047 : 0;
        const f32x2* cs_row = (const f32x2*)(p.ws + WS_ROPE); const f32x2* cs_col = cs_row + 32 * 16;
        if (pn >= 11) {
            bf16_t* dst = (bf16_t*)(p.ws + (pn < 13 ? Z_CU : Z_CV)) + ((pn - 11) & 1) * 256 + wc * 32 + 8 * fq;
#pragma unroll
            for (int ai = 0; ai < 2; ++ai)
#pragma unroll
                for (int m = 0; m < 4; ++m) { const int R = R0 + ai * 128 + wr * 64 + m * 16 + fr;
#pragma unroll
                    for (int bj = 0; bj < 2; ++bj) { f32x4 v0 = acc[ai][bj][m][0], v1 = acc[ai][bj][m][1];
#pragma unroll
                        for (int r = 0; r < 4; ++r) { v0[r] = gelu_tanh(v0[r]); v1[r] = gelu_tanh(v1[r]); }
                        *(u32x4*)(dst + (size_t)R * RW + bj * 128) = pack8(v0, v1); } }
            return;
        }
        const int kind = pn >> 1;
        const bool is_k = (pn == 10 && wc < 2), is_v = (pn == 10 && wc >= 2);
        const float* gqk = (kind == 4 ? p.in[I_GQ] : p.in[I_GK]) + l * HD + 8 * fq;
        const int head = (pn & 1) * 4 + wc;
        const bool norm = (kind == 4 || is_k), rope = smp && (kind == 0 || kind == 1 || kind == 4 || is_k);
        const float post = kind == 1 ? 0.125f : (kind == 4 ? C2 : 1.0f);
#pragma unroll
        for (int ai = 0; ai < 2; ++ai)
#pragma unroll
            for (int m = 0; m < 4; ++m) {
                const int rr = ai * 128 + wr * 64 + m * 16 + fr, R = R0 + rr, t = t0 + rr;
                float rs = 1.0f;
                if (norm) {
                    float ss = 0.f;
#pragma unroll
                    for (int bj = 0; bj < 2; ++bj)
#pragma unroll
                        for (int n = 0; n < 2; ++n) { const f32x4 x = acc[ai][bj][m][n]; ss += (x.x * x.x + x.y * x.y) + (x.z * x.z + x.w * x.w); }
                    ss += __shfl_xor(ss, 16); ss += __shfl_xor(ss, 32);
                    rs = rsqrtf(ss * (1.f / HD) + EPS);
                }
                bf16_t* dst;
                if (kind < 5) dst = (bf16_t*)(p.ws + (kind == 0 ? Z_RQ : kind == 1 ? Z_RK : kind == 2 ? Z_RV : kind == 3 ? Z_RG : Z_AQ)) + (size_t)R * RW + head * HD + 8 * fq;
                else { const int hk = wc & 1;
                    if (smp) dst = (bf16_t*)(p.ws + (is_k ? Z_KS : Z_VS)) + ((size_t)b * SKV_S + PAST + t) * KVW + hk * HD + 8 * fq;
                    else dst = (bf16_t*)(p.ws + (is_k ? Z_KP : Z_VP)) + ((size_t)b * SEQ_P + t) * KVW + hk * HD + 8 * fq; }
                float* cdst = p.out + (is_k ? OUT_CK : OUT_CV) + ((size_t)((b * 2 + l) * SEQ_P + t) * 2 + (wc & 1)) * HD + 8 * fq;
#pragma unroll
                for (int bj = 0; bj < 2; ++bj) {
                    f32x4 v0 = acc[ai][bj][m][0], v1 = acc[ai][bj][m][1];
                    if (norm) { const f32x4 g0 = *(const f32x4*)(gqk + 32 * bj), g1 = *(const f32x4*)(gqk + 32 * bj + 4); v0 = v0 * rs * g0; v1 = v1 * rs * g1; }
                    if (pn == 10 && !smp) { *(f32x4*)(cdst + 32 * bj) = v0; *(f32x4*)(cdst + 32 * bj + 4) = v1; }
                    if (kind == 3) {
#pragma unroll
                        for (int r = 0; r < 4; ++r) { v0[r] = siluf_(v0[r]); v1[r] = siluf_(v1[r]); } }
                    if (rope) {
                        const f32x2* tab = (bj == 0 ? cs_row + (t >> 6) * 16 : cs_col + (t & 63) * 16) + 4 * fq;
                        rope4(v0, tab[0], tab[1]); rope4(v1, tab[2], tab[3]); }
                    v0 = v0 * post; v1 = v1 * post;
                    *(u32x4*)(dst + 32 * bj) = pack8(v0, v1);
                    asm volatile("" ::: "memory");
                }
            }
    }
};
struct EpiGate {
    static constexpr bool PERM = true, AFTER_DRAIN = false;
    const Params* pp;
    __device__ __forceinline__ void operator()(const f32x4 (&acc)[2][2][4][2], const Unit& u, int wr, int wc, int fr, int fq) const {
        const int x = u.pn >> 2; bf16_t* dst = (bf16_t*)(pp->ws + Z_GATE) + (size_t)x * M * DM + (u.pn & 3) * 256 + wc * 32 + 8 * fq;
#pragma unroll
        for (int ai = 0; ai < 2; ++ai)
#pragma unroll
            for (int m = 0; m < 4; ++m) { const int R = u.pm * 256 + ai * 128 + wr * 64 + m * 16 + fr;
#pragma unroll
                for (int bj = 0; bj < 2; ++bj) { f32x4 v0 = acc[ai][bj][m][0], v1 = acc[ai][bj][m][1];
#pragma unroll
                    for (int r = 0; r < 4; ++r) { v0[r] = sigmoidf_(v0[r]); v1[r] = sigmoidf_(v1[r]); }
                    *(u32x4*)(dst + (size_t)R * DM + bj * 128) = pack8(v0, v1); } }
    }
};
struct EpiMerge {
    static constexpr bool PERM = true, AFTER_DRAIN = false;
    const Params* pp;
    __device__ __forceinline__ void operator()(const f32x4 (&acc)[2][2][4][2], const Unit& u, int wr, int wc, int fr, int fq) const {
        const int x = u.pn >> 2, pm = u.pm - 80 * x, gi = x == 0 ? 1 : x == 1 ? 2 : 0;
        const int col0 = (u.pn & 3) * 256 + wc * 32 + 8 * fq;
        const bf16_t* gate = (const bf16_t*)(pp->ws + Z_GATE) + (size_t)gi * M * DM + col0; bf16_t* dst = (bf16_t*)(pp->ws + WS_XN) + col0;
#pragma unroll
        for (int ai = 0; ai < 2; ++ai)
#pragma unroll
            for (int m = 0; m < 4; ++m) { const int R = pm * 256 + ai * 128 + wr * 64 + m * 16 + fr;
#pragma unroll
                for (int bj = 0; bj < 2; ++bj) { f32x4 v0 = acc[ai][bj][m][0], v1 = acc[ai][bj][m][1];
                    const u32x4 g = *(const u32x4*)(gate + (size_t)R * DM + bj * 128);
                    v0.x *= bflo(g.x); v0.y *= bfhi(g.x); v0.z *= bflo(g.y); v0.w *= bfhi(g.y); v1.x *= bflo(g.z); v1.y *= bfhi(g.z); v1.z *= bflo(g.w); v1.w *= bfhi(g.w);
                    if (x != 0) { const u32x4 o = *(const u32x4*)(dst + (size_t)R * DM + bj * 128);
                        v0.x += bflo(o.x); v0.y += bfhi(o.x); v0.z += bflo(o.y); v0.w += bfhi(o.y); v1.x += bflo(o.z); v1.y += bfhi(o.z); v1.z += bflo(o.w); v1.w += bfhi(o.w); }
                    *(u32x4*)(dst + (size_t)R * DM + bj * 128) = pack8(v0, v1); } }
    }
};
struct EpiRes {
    static constexpr bool PERM = false, AFTER_DRAIN = false;
    const Params* pp; int l, part; bool from_inputs;
    __device__ __forceinline__ void operator()(const f32x4 (&acc)[2][2][4][2], const Unit& u, int wr, int wc, int fr, int fq) const {
        const Params& p = *pp; const int R0 = u.pm * 256; const int ci = row_ci(R0);
        const float* gv = mod_ptr(p, l, ci, part) + u.pn * 256 + wc * 32 + 4 * fq;
        f32x4 g[2][2];
#pragma unroll
        for (int bj = 0; bj < 2; ++bj)
#pragma unroll
            for (int n = 0; n < 2; ++n) g[bj][n] = *(const f32x4*)(gv + bj * 128 + n * 16);
#pragma unroll
        for (int ai = 0; ai < 2; ++ai)
#pragma unroll
            for (int m = 0; m < 4; ++m) { const int R = R0 + ai * 128 + wr * 64 + m * 16 + fr;
                const float* xs = (from_inputs ? x_row(p, 0, R) : p.out + (size_t)R * DM) + u.pn * 256 + wc * 32 + 4 * fq;
                float* xo = p.out + (size_t)R * DM + u.pn * 256 + wc * 32 + 4 * fq;
#pragma unroll
                for (int bj = 0; bj < 2; ++bj)
#pragma unroll
                    for (int n = 0; n < 2; ++n) { const f32x4 xv = *(const f32x4*)(xs + bj * 128 + n * 16); *(f32x4*)(xo + bj * 128 + n * 16) = xv + g[bj][n] * acc[ai][bj][m][n]; } }
    }
};
struct EpiFF1 {
    static constexpr bool PERM = true, AFTER_DRAIN = false;
    const Params* pp;
    __device__ __forceinline__ void operator()(const f32x4 (&acc)[2][2][4][2], const Unit& u, int wr, int wc, int fr, int fq) const {
        bf16_t* dst = (bf16_t*)(pp->ws + Z_HB) + u.pn * 256 + wc * 32 + 8 * fq;
#pragma unroll
        for (int ai = 0; ai < 2; ++ai)
#pragma unroll
            for (int m = 0; m < 4; ++m) { const int R = u.pm * 256 + ai * 128 + wr * 64 + m * 16 + fr;
#pragma unroll
                for (int bj = 0; bj < 2; ++bj) { f32x4 v0 = acc[ai][bj][m][0], v1 = acc[ai][bj][m][1];
#pragma unroll
                    for (int r = 0; r < 4; ++r) { const float a = fmaxf(v0[r], 0.f), b = fmaxf(v1[r], 0.f); v0[r] = a * a; v1[r] = b * b; }
                    *(u32x4*)(dst + (size_t)R * DFF + bj * 128) = pack8(v0, v1); } }
    }
};

namespace attn_body {
using bf16=__hip_bfloat16;
using bf16x8=__attribute__((ext_vector_type(8)))short;
using s16x4=__attribute__((ext_vector_type(4)))short;
using f32x16=__attribute__((ext_vector_type(16)))float;
using u32x4=__attribute__((ext_vector_type(4)))unsigned;
constexpr int D=64,QP=512,KP=128;
constexpr int NW=8,QBLK=32,QB=QBLK*NW,KVBLK=64;
__device__ __forceinline__ int crow(int r,int hi){return (r&3)+8*(r>>2)+4*hi;}
#define SBAR() __builtin_amdgcn_sched_barrier(0)
constexpr int NSLOT=3, SLOTB=8192;
constexpr int LDS_K=0, LDS_V=NSLOT*SLOTB, LDS_WS=2*NSLOT*SLOTB, LDS_OST=LDS_WS+NW*64*4, LDS_BYTES=LDS_OST+NW*4096;
constexpr float C2=0.125f*1.4426950408889634f;
__device__ __forceinline__ void glds16(const void*gsrc,unsigned lds_dst){unsigned keep;
  asm volatile("s_mov_b32 %0, m0\n\ts_mov_b32 m0, %2\n\ts_nop 0\n\tglobal_load_lds_dwordx4 %1, off\n\ts_mov_b32 m0, %0":"=&s"(keep):"v"(gsrc),"s"(lds_dst):"memory");}
__device__ __forceinline__ float max3f(float a,float b,float c){float r;asm("v_max3_f32 %0, %1, %2, %3":"=v"(r):"v"(a),"v"(b),"v"(c));return r;}
__device__ __forceinline__ float max2f(float a,float b){float r;asm("v_max_f32_e32 %0, %1, %2":"=v"(r):"v"(a),"v"(b));return r;}
__device__ __forceinline__ float fadd_s(float a,float b){float r;asm("v_add_f32_e32 %0, %1, %2":"=v"(r):"v"(a),"v"(b));return r;}
__device__ __forceinline__ float fsub_s(float a,float b){float r;asm("v_sub_f32_e32 %0, %1, %2":"=v"(r):"v"(a),"v"(b));return r;}
typedef float f32x2_t __attribute__((ext_vector_type(2))); typedef __bf16 bf16x2_t __attribute__((ext_vector_type(2)));
__device__ __forceinline__ unsigned cvtpk_s(float lo,float hi){f32x2_t v={lo,hi};bf16x2_t b=__builtin_convertvector(v,bf16x2_t);return __builtin_bit_cast(unsigned,b);}
#define WAIT_BAR(N) asm volatile("s_waitcnt vmcnt(" #N ") lgkmcnt(0)\n\ts_barrier":::"memory")

__device__ __forceinline__ void qkt(f32x16&p0,f32x16&p1,const char*Kslot,const bf16x8*qr,const f32x16&negm,int r32,int hi){
  const char*kb=Kslot+hi*1024+r32*16;
  #pragma unroll
  for(int d0=0;d0<4;++d0){
    const bf16x8 b0=*reinterpret_cast<const bf16x8*>(kb+d0*2048);
    const bf16x8 b1=*reinterpret_cast<const bf16x8*>(kb+d0*2048+512);
    if(d0==0){p0=__builtin_amdgcn_mfma_f32_32x32x16_bf16(b0,qr[0],negm,0,0,0);p1=__builtin_amdgcn_mfma_f32_32x32x16_bf16(b1,qr[0],negm,0,0,0);}
    else{p0=__builtin_amdgcn_mfma_f32_32x32x16_bf16(b0,qr[d0],p0,0,0,0);p1=__builtin_amdgcn_mfma_f32_32x32x16_bf16(b1,qr[d0],p1,0,0,0);}}
}
typedef __attribute__((address_space(3))) const char* lds_cptr;
typedef short v4i16_t __attribute__((ext_vector_type(4)));
__device__ __forceinline__ void kload8(bf16x8*kf,lds_cptr kp){
  kf[0]=*(const __attribute__((address_space(3))) bf16x8*)(kp);      kf[1]=*(const __attribute__((address_space(3))) bf16x8*)(kp+512);
  kf[2]=*(const __attribute__((address_space(3))) bf16x8*)(kp+2048); kf[3]=*(const __attribute__((address_space(3))) bf16x8*)(kp+2560);
  kf[4]=*(const __attribute__((address_space(3))) bf16x8*)(kp+4096); kf[5]=*(const __attribute__((address_space(3))) bf16x8*)(kp+4608);
  kf[6]=*(const __attribute__((address_space(3))) bf16x8*)(kp+6144); kf[7]=*(const __attribute__((address_space(3))) bf16x8*)(kp+6656);
}
__device__ __forceinline__ void kload2(bf16x8*kf,lds_cptr kp,int j){ kf[2*j]=*(const __attribute__((address_space(3))) bf16x8*)(kp+j*2048); kf[2*j+1]=*(const __attribute__((address_space(3))) bf16x8*)(kp+j*2048+512); }
__device__ __forceinline__ s16x4 vtr(lds_cptr p){ return __builtin_bit_cast(s16x4,__builtin_amdgcn_ds_read_tr16_b64_v4i16((__attribute__((address_space(3))) v4i16_t*)p)); }
__device__ __forceinline__ float rowmax(const f32x16&p0,const f32x16&p1){
  float a=max3f(p0[0],p0[1],p1[0]),b=max3f(p0[2],p0[3],p1[1]);a=max3f(a,p1[2],p1[3]);
  #pragma unroll
  for(int r=4;r<16;r+=4){a=max3f(a,p0[r],p0[r+1]);b=max3f(b,p0[r+2],p0[r+3]);a=max3f(a,p1[r],p1[r+1]);b=max3f(b,p1[r+2],p1[r+3]);}
  const float m=max2f(a,b);
  auto rr=__builtin_amdgcn_permlane32_swap(__float_as_uint(m),__float_as_uint(m),false,false);
  return max2f(__uint_as_float(rr[0]),__uint_as_float(rr[1]));
}
__device__ __forceinline__ void pv(f32x16*o,int vb,bf16x8 pa0,bf16x8 pa1,bf16x8 pa2,bf16x8 pa3){
  #pragma unroll
  for(int d0=0;d0<2;++d0){s16x4 lo[4],hi[4];
    #pragma unroll
    for(int ks=0;ks<4;++ks){
      asm volatile("ds_read_b64_tr_b16 %0,%1 offset:%c2":"=&v"(lo[ks]):"v"(vb),"i"(d0*4096+ks*1024):"memory");
      asm volatile("ds_read_b64_tr_b16 %0,%1 offset:%c2":"=&v"(hi[ks]):"v"(vb),"i"(d0*4096+ks*1024+512):"memory");}
    asm volatile("s_waitcnt lgkmcnt(0)":::"memory");SBAR();
    #define PK(k) (bf16x8){lo[k][0],lo[k][1],lo[k][2],lo[k][3],hi[k][0],hi[k][1],hi[k][2],hi[k][3]}
    o[d0]=__builtin_amdgcn_mfma_f32_32x32x16_bf16(pa0,PK(0),o[d0],0,0,0);
    o[d0]=__builtin_amdgcn_mfma_f32_32x32x16_bf16(pa1,PK(1),o[d0],0,0,0);
    o[d0]=__builtin_amdgcn_mfma_f32_32x32x16_bf16(pa2,PK(2),o[d0],0,0,0);
    o[d0]=__builtin_amdgcn_mfma_f32_32x32x16_bf16(pa3,PK(3),o[d0],0,0,0);
    #undef PK
  }
}

#ifndef ATTN_STORE16
#define ATTN_STORE16(p,v) (*(u32x4*)(p)=(v))
#endif
template<int THRL> __device__ __forceinline__ void attn_unit(int tid,const bf16*Qu,const bf16*__restrict__ Kh,const bf16*__restrict__ Vh,bf16*Ou,const int NT,char*shm){
  const int lane=tid&63,r32=lane&31,hi=lane>>5; const int wid=__builtin_amdgcn_readfirstlane(tid>>6);
  const bf16*Qw=Qu+(long)(wid*QBLK)*QP;
  const unsigned lds0=(unsigned)(uintptr_t)shm;
  float*wsf=(float*)(shm+LDS_WS)+wid*64;
  const bf16*ksrc=Kh+(long)lane*KP+wid*8;
  const bf16*vsrc=Vh+(long)(16*(wid&3)+(lane>>2))*KP+(wid>>2)*32+(lane&3)*8;
  const unsigned kdst=lds0+LDS_K+wid*1024, vdst=lds0+LDS_V+wid*1024;
  #define DMA_K(t,slot) glds16(ksrc+(long)(t)*KVBLK*KP,(unsigned)__builtin_amdgcn_readfirstlane(kdst+(slot)))
  #define DMA_V(t,slot) glds16(vsrc+(long)(t)*KVBLK*KP,(unsigned)__builtin_amdgcn_readfirstlane(vdst+(slot)))
  const int vb0=(int)(lds0+LDS_V)+((lane>>4)&1)*32+(lane&3)*8+(4*hi+((lane&15)>>2))*64;
  const char*Kbase=shm+LDS_K; bf16x8 kf[8];
  const lds_cptr shm3=(lds_cptr)shm; const lds_cptr kp0=shm3+LDS_K+hi*1024+r32*16; const lds_cptr vp0=shm3+LDS_V+((lane>>4)&1)*32+(lane&3)*8+(4*hi+((lane&15)>>2))*64;
  DMA_K(0,0);DMA_V(0,0);DMA_K(1,SLOTB);
  bf16x8 qr[4];
  #pragma unroll
  for(int d0=0;d0<4;++d0)qr[d0]=*reinterpret_cast<const bf16x8*>(&Qw[(long)r32*QP+d0*16+hi*8]);
  float zf_=0.f;asm volatile("":"+v"(zf_));
  float mhat=zf_,l_reg=zf_;f32x16 o[2],negm;
  #pragma unroll
  for(int r=0;r<16;++r){o[0][r]=zf_;o[1][r]=zf_;negm[r]=zf_;}
  asm volatile("":"+v"(negm));
  #define CMASK(P0,P1,t) do{}while(0)
  bool resc=false;
  #define START(P0,P1) do{ const float rm=rowmax(P0,P1); resc=false; \
    { const float dl=rm; mhat=fadd_s(mhat,dl); \
      _Pragma("unroll") for(int r=0;r<16;++r){P0[r]=fsub_s(P0[r],dl);P1[r]=fsub_s(P1[r],dl);} \
      _Pragma("unroll") for(int r=0;r<16;++r)negm[r]=-mhat; asm volatile("":"+v"(negm)); } \
    _Pragma("unroll") for(int r=0;r<16;++r)P0[r]=__builtin_amdgcn_exp2f(P0[r]); }while(0)
  #define RESC() do{ if(resc){ asm volatile("s_waitcnt lgkmcnt(0)":::"memory"); \
      _Pragma("unroll") for(int d_=0;d_<2;++d_) _Pragma("unroll") for(int r=0;r<16;++r)o[d_][r]*=wsf[crow(r,hi)]; } }while(0)
  f32x16 pA0,pA1,pB0,pB1;
  int sl_prev=0,sl_cur=0,sl_next=SLOTB;
  #define ROT() do{sl_prev=sl_cur;sl_cur=sl_next;sl_next=(sl_next==(NSLOT-1)*SLOTB)?0:sl_next+SLOTB;}while(0)
  DMA_K(2,2*SLOTB);
  WAIT_BAR(3);
  qkt(pA0,pA1,Kbase,qr,negm,r32,hi);asm volatile("s_nop 15\n\ts_nop 7":"+v"(pA0),"+v"(pA1));CMASK(pA0,pA1,0);
  START(pA0,pA1);
  _Pragma("unroll") for(int r=0;r<16;++r)pA1[r]=__builtin_amdgcn_exp2f(pA1[r]);
  WAIT_BAR(0);
  DMA_K(3,0);DMA_V(1,SLOTB);
  ROT();
  kload8(kf,kp0+sl_cur);
  WAIT_BAR(2);
  s16x4 vlo[8],vhi[8]; u32x4 pw0,pw1,pw2,pw3;
  #define PKW(P,B) cvtpk_s(P[B],P[B+1])
  #define PAF(k) __builtin_bit_cast(bf16x8,pw##k)
  #define VFR(i) (bf16x8){vlo[i][0],vlo[i][1],vlo[i][2],vlo[i][3],vhi[i][0],vhi[i][1],vhi[i][2],vhi[i][3]}
  #define PIN(x) asm volatile("":"+v"(x))
  #define MX3(a,b,c) __builtin_fmaxf(__builtin_fmaxf((a),(b)),(c))
  #define GAPA(MF,A0,A1,A2,A3,W0,W1,PW) do{ MF; sacc+=A0; sacc+=A1; sacc+=A2; sacc+=A3; PIN(sacc); W0; W1; PIN(PW); SBAR(); }while(0)
  #define EX(v) __builtin_amdgcn_exp2f(v)
  #define GAPB(MF,X,B) do{ MF; X[B]=EX(X[B]); X[B+1]=EX(X[B+1]); X[B+2]=EX(X[B+2]); X[B+3]=EX(X[B+3]); PIN(X); SBAR(); }while(0)
  #define VRD(i) do{ vlo[i]=vtr(vp_+(((i)>>2)*4096+((i)&3)*1024)); vhi[i]=vtr(vp_+(((i)>>2)*4096+((i)&3)*1024+512)); }while(0)
  #define KRD(G,j) do{ if(G){ kload2(kf,kp0+sl_next,j); SBAR(); } }while(0)
  #define STEP(C0,C1,P0,P1,t,GK,GV,GL) do{ SBAR(); \
    const lds_cptr vp_=vp0+sl_prev; \
    VRD(0); SBAR(); float sacc=(P0[0]+P0[1]); \
    GAPA(C0=__builtin_amdgcn_mfma_f32_32x32x16_bf16(kf[0],qr[0],negm,0,0,0), P0[2],P0[3],P0[4],P0[5],     pw0[0]=PKW(P0,0), pw0[1]=PKW(P0,2), pw0); \
    VRD(4); SBAR(); GAPA(C1=__builtin_amdgcn_mfma_f32_32x32x16_bf16(kf[1],qr[0],negm,0,0,0), P0[6],P0[7],P0[8],P0[9],     pw0[2]=PKW(P0,4), pw0[3]=PKW(P0,6), pw0); \
    VRD(1); SBAR(); GAPA(C0=__builtin_amdgcn_mfma_f32_32x32x16_bf16(kf[2],qr[1],C0,0,0,0),   P0[10],P0[11],P0[12],P0[13], pw1[0]=PKW(P0,8), pw1[1]=PKW(P0,10), pw1); \
    VRD(5); SBAR(); GAPA(C1=__builtin_amdgcn_mfma_f32_32x32x16_bf16(kf[3],qr[1],C1,0,0,0),   P0[14],P0[15],P1[0],P1[1],   pw1[2]=PKW(P0,12),pw1[3]=PKW(P0,14), pw1); \
    VRD(2); SBAR(); GAPA(C0=__builtin_amdgcn_mfma_f32_32x32x16_bf16(kf[4],qr[2],C0,0,0,0),   P1[2],P1[3],P1[4],P1[5],     pw2[0]=PKW(P1,0), pw2[1]=PKW(P1,2), pw2); \
    VRD(6); SBAR(); GAPA(C1=__builtin_amdgcn_mfma_f32_32x32x16_bf16(kf[5],qr[2],C1,0,0,0),   P1[6],P1[7],P1[8],P1[9],     pw2[2]=PKW(P1,4), pw2[3]=PKW(P1,6), pw2); \
    VRD(3); SBAR(); GAPA(C0=__builtin_amdgcn_mfma_f32_32x32x16_bf16(kf[6],qr[3],C0,0,0,0),   P1[10],P1[11],P1[12],P1[13], pw3[0]=PKW(P1,8), pw3[1]=PKW(P1,10), pw3); \
    VRD(7); SBAR(); GAPA(C1=__builtin_amdgcn_mfma_f32_32x32x16_bf16(kf[7],qr[3],C1,0,0,0),   P1[14],P1[15],0.f,0.f,       pw3[2]=PKW(P1,12),pw3[3]=PKW(P1,14), pw3); \
    l_reg+=sacc; \
    if(GK){DMA_K((t)+3,sl_cur);} if(GV){DMA_V((t)+1,sl_next);} \
    CMASK(C0,C1,t); \
    { float a=MX3(C0[0],C0[1],C1[0]),b=MX3(C0[2],C0[3],C1[1]); a=MX3(a,C1[2],C1[3]); \
      _Pragma("unroll") for(int r=4;r<16;r+=4){a=MX3(a,C0[r],C0[r+1]);b=MX3(b,C0[r+2],C0[r+3]);a=MX3(a,C1[r],C1[r+1]);b=MX3(b,C1[r+2],C1[r+3]);} \
      float rm=__builtin_fmaxf(a,b); { auto rr=__builtin_amdgcn_permlane32_swap(__float_as_uint(rm),__float_as_uint(rm),false,false); rm=__builtin_fmaxf(__uint_as_float(rr[0]),__uint_as_float(rr[1])); } \
      resc=false; \
      if(__builtin_expect(__any(rm>(float)THRL),0)){ const float dl=__builtin_fmaxf(rm,0.f); mhat+=dl; \
        _Pragma("unroll") for(int r=0;r<16;++r){C0[r]-=dl;C1[r]-=dl;} \
        _Pragma("unroll") for(int r=0;r<16;++r)negm[r]=-mhat; asm volatile("":"+v"(negm)); \
        const float f=__builtin_amdgcn_exp2f(-dl); l_reg*=f; if(hi==0)wsf[r32]=f; resc=true; } } \
    SBAR(); \
    GAPB(o[0]=__builtin_amdgcn_mfma_f32_32x32x16_bf16(PAF(0),VFR(0),o[0],0,0,0), C0,0); \
    GAPB(o[1]=__builtin_amdgcn_mfma_f32_32x32x16_bf16(PAF(0),VFR(4),o[1],0,0,0), C0,4); \
    KRD(GL,0); GAPB(o[0]=__builtin_amdgcn_mfma_f32_32x32x16_bf16(PAF(1),VFR(1),o[0],0,0,0), C0,8); \
    KRD(GL,1); GAPB(o[1]=__builtin_amdgcn_mfma_f32_32x32x16_bf16(PAF(1),VFR(5),o[1],0,0,0), C0,12); \
    KRD(GL,2); GAPB(o[0]=__builtin_amdgcn_mfma_f32_32x32x16_bf16(PAF(2),VFR(2),o[0],0,0,0), C1,0); \
    KRD(GL,3); GAPB(o[1]=__builtin_amdgcn_mfma_f32_32x32x16_bf16(PAF(2),VFR(6),o[1],0,0,0), C1,4); \
    GAPB(o[0]=__builtin_amdgcn_mfma_f32_32x32x16_bf16(PAF(3),VFR(3),o[0],0,0,0), C1,8); \
    GAPB(o[1]=__builtin_amdgcn_mfma_f32_32x32x16_bf16(PAF(3),VFR(7),o[1],0,0,0), C1,12); \
    }while(0)
  int t=1;
  for(;t+5<NT;t+=2){
    STEP(pB0,pB1,pA0,pA1,t,true,true,true);     WAIT_BAR(2); RESC(); ROT();
    STEP(pA0,pA1,pB0,pB1,t+1,true,true,true);   WAIT_BAR(2); RESC(); ROT();
  }
  #define ENDW(tt) do{ if((tt)+3<NT){WAIT_BAR(2);} else if((tt)+2<NT){WAIT_BAR(1);} else {WAIT_BAR(0);} }while(0)
  for(;t+1<NT;t+=2){
    STEP(pB0,pB1,pA0,pA1,t,(t+3<NT),(t+1<NT),(t+1<NT));       ENDW(t);   RESC(); ROT();
    STEP(pA0,pA1,pB0,pB1,t+1,(t+4<NT),(t+2<NT),(t+2<NT));     ENDW(t+1); RESC(); ROT();
  }
  STEP(pB0,pB1,pA0,pA1,NT-1,false,false,false); RESC();
  { float sacc=pB0[0]+pB0[1]; _Pragma("unroll") for(int r=2;r<16;++r)sacc+=pB0[r]; _Pragma("unroll") for(int r=0;r<16;++r)sacc+=pB1[r]; l_reg+=sacc;
    pw0=(u32x4){PKW(pB0,0),PKW(pB0,2),PKW(pB0,4),PKW(pB0,6)};pw1=(u32x4){PKW(pB0,8),PKW(pB0,10),PKW(pB0,12),PKW(pB0,14)};pw2=(u32x4){PKW(pB1,0),PKW(pB1,2),PKW(pB1,4),PKW(pB1,6)};pw3=(u32x4){PKW(pB1,8),PKW(pB1,10),PKW(pB1,12),PKW(pB1,14)};
    SBAR(); pv(o,vb0+sl_cur,PAF(0),PAF(1),PAF(2),PAF(3)); }
  #undef PKW
  #undef PAF
  #undef VFR
  #undef PIN
  #undef MX3
  #undef GAPA
  #undef GAPB
  #undef EX
  #undef VRD
  #undef KRD
  #undef STEP
  #undef ENDW
  {auto rr=__builtin_amdgcn_permlane32_swap(__float_as_uint(l_reg),__float_as_uint(l_reg),false,false);l_reg=__uint_as_float(rr[0])+__uint_as_float(rr[1]);}
  if(hi==0)wsf[32+r32]=l_reg;asm volatile("s_waitcnt lgkmcnt(0)":::"memory");
  float rli[16];
  #pragma unroll
  for(int r=0;r<16;++r)rli[r]=__builtin_amdgcn_rcpf(wsf[32+crow(r,hi)]);
  bf16*Ow=Ou+(long)(wid*QBLK)*QP;
  { bf16*stg=(bf16*)(shm+LDS_OST)+wid*2048;
    #pragma unroll
    for(int r=0;r<16;++r){const int orow=crow(r,hi);
      #pragma unroll
      for(int d0=0;d0<2;++d0)stg[orow*64+d0*32+r32]=__float2bfloat16(o[d0][r]*rli[r]);}
    asm volatile("s_waitcnt lgkmcnt(0)":::"memory");
    #pragma unroll
    for(int i=0;i<4;++i){const int row=i*8+(lane>>3),ch=lane&7; const u32x4 v=*(const u32x4*)(stg+row*64+ch*8); ATTN_STORE16(Ow+(long)row*QP+ch*8,v);} }
  asm volatile("s_waitcnt lgkmcnt(0)\n\ts_barrier":::"memory");
  #undef DMA_K
  #undef DMA_V
  #undef CMASK
  #undef START
  #undef RESC
  #undef ROT
}
constexpr int ATTN_LDS_BYTES=LDS_BYTES;
#undef SBAR
#undef WAIT_BAR
}
#ifndef ATTN_FAST
#define ATTN_FAST 1
#endif
__device__ __forceinline__ void attn_fast(const Params& p, const Ctx& c) {
    typedef attn_body::bf16 abf;
    const int vcu = (c.G % 8 == 0) ? (c.bx % 8) * (c.G / 8) + c.bx / 8 : c.bx;
    for (int u = vcu; u < 512 + 128; u += c.G) {
        const abf *Qu, *Kh, *Vh; int NT;
        if (u < 512) { const int qb = u & 7, hq = (u >> 3) & 3, hk = (u >> 5) & 1, b = u >> 6, h = hk * 4 + hq;
            Qu = (const abf*)(p.ws + Z_AQ) + ((size_t)MP + (size_t)b * SEQ_S + qb * 256) * RW + h * HD;
            Kh = (const abf*)(p.ws + Z_KS) + (size_t)b * SKV_S * KVW + hk * HD; Vh = (const abf*)(p.ws + Z_VS) + (size_t)b * SKV_S * KVW + hk * HD; NT = SKV_S / 64; }
        else { const int v = u - 512, hq = v & 3, hk = (v >> 2) & 1, b = v >> 3, h = hk * 4 + hq;
            Qu = (const abf*)(p.ws + Z_AQ) + ((size_t)b * SEQ_P) * RW + h * HD;
            Kh = (const abf*)(p.ws + Z_KP) + (size_t)b * SEQ_P * KVW + hk * HD; Vh = (const abf*)(p.ws + Z_VP) + (size_t)b * SEQ_P * KVW + hk * HD; NT = SKV_P / 64; }
        attn_body::attn_unit<8>(c.tid, Qu, Kh, Vh, (abf*)Qu, NT, (char*)c.lds);
    }
    __syncthreads();
}

__device__ __forceinline__ void attn_simple(const Params& p, const Ctx& c) {
    LAS float* Kt = (LAS float*)c.lds; LAS float* Vt = Kt + 32 * 64; LAS float* Sc = Vt + 32 * 64;
    constexpr int NU_S = NB_S * NH * 4, NU_P = NB_P * NH;
    for (int u = c.bx; u < NU_S + NU_P; u += c.G) {
        const bool smp = u < NU_S; int b, h, q0, nq, skv; const bf16_t *Kb, *Vb; size_t rowbase;
        if (smp) { b = u / 32; h = (u / 4) & 7; q0 = (u & 3) * 512; nq = 512; skv = SKV_S; Kb = (const bf16_t*)(p.ws + Z_KS) + (size_t)b * SKV_S * KVW; Vb = (const bf16_t*)(p.ws + Z_VS) + (size_t)b * SKV_S * KVW; rowbase = MP + (size_t)b * SEQ_S + q0; }
        else { const int v = u - NU_S; b = v / 8; h = v & 7; q0 = 0; nq = 256; skv = SKV_P; Kb = (const bf16_t*)(p.ws + Z_KP) + (size_t)b * SEQ_P * KVW; Vb = (const bf16_t*)(p.ws + Z_VP) + (size_t)b * SEQ_P * KVW; rowbase = (size_t)b * SEQ_P; }
        const int hk = h >> 2; const bool act = c.tid < nq;
        bf16_t* qrow = (bf16_t*)(p.ws + Z_AQ) + (rowbase + (act ? c.tid : 0)) * RW + h * HD;
        float q[64], o[64]; float mx = -1e30f, lsum = 0.f;
#pragma unroll
        for (int i = 0; i < 8; ++i) { const u32x4 w = *(const u32x4*)(qrow + 8 * i); q[8 * i] = bflo(w.x); q[8 * i + 1] = bfhi(w.x); q[8 * i + 2] = bflo(w.y); q[8 * i + 3] = bfhi(w.y); q[8 * i + 4] = bflo(w.z); q[8 * i + 5] = bfhi(w.z); q[8 * i + 6] = bflo(w.w); q[8 * i + 7] = bfhi(w.w); }
#pragma unroll
        for (int i = 0; i < 64; ++i) o[i] = 0.f;
        for (int k0 = 0; k0 < skv; k0 += 32) {
            __syncthreads();
            { const int e = c.tid * 4, j = e >> 6, d = e & 63;
                const u32x2 kw = *(const u32x2*)(Kb + (size_t)(k0 + j) * KVW + hk * HD + d), vw = *(const u32x2*)(Vb + (size_t)(k0 + j) * KVW + hk * HD + d);
                *(LAS f32x4*)(Kt + e) = (f32x4){bflo(kw.x), bfhi(kw.x), bflo(kw.y), bfhi(kw.y)}; *(LAS f32x4*)(Vt + e) = (f32x4){bflo(vw.x), bfhi(vw.x), bflo(vw.y), bfhi(vw.y)}; }
            __syncthreads();
            float tm = mx;
#pragma unroll 1
            for (int j = 0; j < 32; ++j) { float a = 0.f;
#pragma unroll
                for (int d4 = 0; d4 < 16; ++d4) { const f32x4 kv = *(const LAS f32x4*)(Kt + j * 64 + 4 * d4); a += q[4 * d4] * kv.x + q[4 * d4 + 1] * kv.y + q[4 * d4 + 2] * kv.z + q[4 * d4 + 3] * kv.w; }
                Sc[j * 512 + c.tid] = a; tm = fmaxf(tm, a); }
            const float corr = exp2f(mx - tm); mx = tm; lsum *= corr;
#pragma unroll
            for (int i = 0; i < 64; ++i) o[i] *= corr;
#pragma unroll 1
            for (int j = 0; j < 32; ++j) { const float pj = exp2f(Sc[j * 512 + c.tid] - mx); lsum += pj;
#pragma unroll
                for (int d4 = 0; d4 < 16; ++d4) { const f32x4 vv = *(const LAS f32x4*)(Vt + j * 64 + 4 * d4); o[4 * d4] += pj * vv.x; o[4 * d4 + 1] += pj * vv.y; o[4 * d4 + 2] += pj * vv.z; o[4 * d4 + 3] += pj * vv.w; } }
        }
        if (act) { const float il = 1.f / lsum;
#pragma unroll
            for (int i = 0; i < 8; ++i) { u32x4 w; w.x = pk2(o[8 * i] * il, o[8 * i + 1] * il); w.y = pk2(o[8 * i + 2] * il, o[8 * i + 3] * il); w.z = pk2(o[8 * i + 4] * il, o[8 * i + 5] * il); w.w = pk2(o[8 * i + 6] * il, o[8 * i + 7] * il); *(u32x4*)(qrow + 8 * i) = w; } }
    }
    __syncthreads();
}
__device__ __forceinline__ void cmlp_simple(const Params& p, const Ctx& c, int l) {
    LAS float* Vt = (LAS float*)c.lds;
    LAS float* rs = Vt + 128 * 128;
    const bf16_t* cv = (const bf16_t*)(p.ws + Z_CV); bf16_t* cu = (bf16_t*)(p.ws + Z_CU);
    for (int u = c.bx; u < NCHUNK * 4; u += c.G) {
        const int ch = u >> 2, g = u & 3; const size_t R0 = (size_t)ch * 128;
        __syncthreads();
        { const int q = c.tid >> 2, part = c.tid & 3; float ss = 0.f;
            const bf16_t* r = cv + (R0 + q) * RW + part * 128;
#pragma unroll
            for (int i = 0; i < 16; ++i) { const u32x4 w = *(const u32x4*)(r + 8 * i); const float a0 = bflo(w.x), a1 = bfhi(w.x), a2 = bflo(w.y), a3 = bfhi(w.y), a4 = bflo(w.z), a5 = bfhi(w.z), a6 = bflo(w.w), a7 = bfhi(w.w);
                ss += (a0 * a0 + a1 * a1) + (a2 * a2 + a3 * a3) + (a4 * a4 + a5 * a5) + (a6 * a6 + a7 * a7); }
            ss += __shfl_xor(ss, 1); ss += __shfl_xor(ss, 2);
            if (part == 0) rs[q] = rsqrtf(ss * (1.f / RW) + EPS); }
        __syncthreads();
        for (int e = c.tid; e < 128 * 128 / 8; e += 512) { const int q = e >> 4, c8 = (e & 15) * 8; const float r = rs[q];
            const u32x4 w = *(const u32x4*)(cv + (R0 + q) * RW + g * 128 + c8);
            *(LAS f32x4*)(Vt + q * 128 + c8) = (f32x4){bflo(w.x) * r, bfhi(w.x) * r, bflo(w.y) * r, bfhi(w.y) * r};
            *(LAS f32x4*)(Vt + q * 128 + c8 + 4) = (f32x4){bflo(w.z) * r, bfhi(w.z) * r, bflo(w.w) * r, bfhi(w.w) * r}; }
        __syncthreads();
        const int cc = c.tid & 127, pg = __builtin_amdgcn_readfirstlane(c.tid >> 7);
        const float* Ws = p.in[I_CMWS] + ((size_t)(l * 4 + g) * 128) * 128; const float* bs = p.in[I_CMBS] + (l * 4 + g) * 128;
        const float gn = p.in[I_CMNORM][l * RW + g * 128 + cc];
        for (int pi = 0; pi < 32; ++pi) { const int pr = pg * 32 + pi; const float* wrow = Ws + pr * 128; float a = 0.f;
#pragma unroll 8
            for (int q = 0; q < 128; ++q) a += wrow[q] * Vt[q * 128 + cc];
            bf16_t* up = cu + (R0 + pr) * RW + g * 128 + cc;
            const float uu = bf2f(*up);
            *up = (bf16_t)f2bf(uu * (gn * a + bs[pr])); }
    }
    __syncthreads();
}
__device__ __forceinline__ float ret_ld(const Params& p, int l, int dir, int h) { const float x = p.in[I_DECAY][(l * 2 + dir) * NH + h]; return -log1pf(__expf(x)); }
__device__ __forceinline__ void retU_simple(const Params& p, const Ctx& c, int l) {
    LAS float* Kt = (LAS float*)c.lds; LAS float* Vt = Kt + 128 * 64; LAS float* wf = Vt + 128 * 64; LAS float* wb = wf + 128;
    float* U = (float*)(p.ws + Z_U);
    for (int u = c.bx; u < NCHUNK * NH; u += c.G) {
        const int ch = u >> 3, h = u & 7; const size_t R0 = (size_t)ch * 128;
        const float ldf = ret_ld(p, l, 0, h), ldb = ret_ld(p, l, 1, h);
        __syncthreads();
        if (c.tid < 128) { wf[c.tid] = __expf(ldf * (float)(127 - c.tid)); wb[c.tid] = __expf(ldb * (float)c.tid); }
        for (int e = c.tid; e < 128 * 64 / 8; e += 512) { const int j = e >> 3, d8 = (e & 7) * 8;
            const u32x4 kw = *(const u32x4*)((const bf16_t*)(p.ws + Z_RK) + (R0 + j) * RW + h * HD + d8), vw = *(const u32x4*)((const bf16_t*)(p.ws + Z_RV) + (R0 + j) * RW + h * HD + d8);
            *(LAS f32x4*)(Kt + j * 64 + d8) = (f32x4){bflo(kw.x), bfhi(kw.x), bflo(kw.y), bfhi(kw.y)}; *(LAS f32x4*)(Kt + j * 64 + d8 + 4) = (f32x4){bflo(kw.z), bfhi(kw.z), bflo(kw.w), bfhi(kw.w)};
            *(LAS f32x4*)(Vt + j * 64 + d8) = (f32x4){bflo(vw.x), bfhi(vw.x), bflo(vw.y), bfhi(vw.y)}; *(LAS f32x4*)(Vt + j * 64 + d8 + 4) = (f32x4){bflo(vw.z), bfhi(vw.z), bflo(vw.w), bfhi(vw.w)}; }
        __syncthreads();
        const int e = c.tid & 63, d0 = __builtin_amdgcn_readfirstlane(c.tid >> 6) * 8;
        float uf[8], ub[8];
#pragma unroll
        for (int i = 0; i < 8; ++i) { uf[i] = 0.f; ub[i] = 0.f; }
        for (int j = 0; j < 128; ++j) { const float v = Vt[j * 64 + e], vf = v * wf[j], vb = v * wb[j];
            const f32x4 k0 = *(const LAS f32x4*)(Kt + j * 64 + d0), k1 = *(const LAS f32x4*)(Kt + j * 64 + d0 + 4);
            uf[0] += k0.x * vf; uf[1] += k0.y * vf; uf[2] += k0.z * vf; uf[3] += k0.w * vf; uf[4] += k1.x * vf; uf[5] += k1.y * vf; uf[6] += k1.z * vf; uf[7] += k1.w * vf;
            ub[0] += k0.x * vb; ub[1] += k0.y * vb; ub[2] += k0.z * vb; ub[3] += k0.w * vb; ub[4] += k1.x * vb; ub[5] += k1.y * vb; ub[6] += k1.z * vb; ub[7] += k1.w * vb; }
        float* Uf = U + ((size_t)(0 * NCHUNK + ch) * NH + h) * 4096, *Ub = U + ((size_t)(1 * NCHUNK + ch) * NH + h) * 4096;
#pragma unroll
        for (int i = 0; i < 8; ++i) { Uf[(d0 + i) * 64 + e] = uf[i]; Ub[(d0 + i) * 64 + e] = ub[i]; }
    }
    __syncthreads();
}
__device__ __forceinline__ void retO_simple(const Params& p, const Ctx& c, int l) {
    LAS float* Kt = (LAS float*)c.lds; LAS float* Vt = Kt + 128 * 64; LAS float* Sf = Vt + 128 * 64; LAS float* Sb = Sf + 4096; LAS float* pf = Sb + 4096; LAS float* pb = pf + 132;
    const float* U = (const float*)(p.ws + Z_U);
    for (int u = c.bx; u < NCHUNK * NH; u += c.G) {
        const int ch = u >> 3, h = u & 7; const size_t R0 = (size_t)ch * 128; const bool smp = ch >= MP / 128;
        const int nc = smp ? 16 : 2, ch0 = smp ? (MP / 128 + ((ch - MP / 128) & ~15)) : (ch & ~1), cidx = ch - ch0, b = smp ? (ch - MP / 128) >> 4 : ch >> 1;
        const float ldf = ret_ld(p, l, 0, h), ldb = ret_ld(p, l, 1, h); const float Gf = __expf(128.f * ldf), Gb = __expf(128.f * ldb);
        __syncthreads();
        if (c.tid <= 128) { pf[c.tid] = __expf(ldf * (float)c.tid); pb[c.tid] = __expf(ldb * (float)c.tid); }
        for (int e = c.tid; e < 128 * 64 / 8; e += 512) { const int j = e >> 3, d8 = (e & 7) * 8;
            const u32x4 kw = *(const u32x4*)((const bf16_t*)(p.ws + Z_RK) + (R0 + j) * RW + h * HD + d8), vw = *(const u32x4*)((const bf16_t*)(p.ws + Z_RV) + (R0 + j) * RW + h * HD + d8);
            *(LAS f32x4*)(Kt + j * 64 + d8) = (f32x4){bflo(kw.x), bfhi(kw.x), bflo(kw.y), bfhi(kw.y)}; *(LAS f32x4*)(Kt + j * 64 + d8 + 4) = (f32x4){bflo(kw.z), bfhi(kw.z), bflo(kw.w), bfhi(kw.w)};
            *(LAS f32x4*)(Vt + j * 64 + d8) = (f32x4){bflo(vw.x), bfhi(vw.x), bflo(vw.y), bfhi(vw.y)}; *(LAS f32x4*)(Vt + j * 64 + d8 + 4) = (f32x4){bflo(vw.z), bfhi(vw.z), bflo(vw.w), bfhi(vw.w)}; }
        {
            float sf[8], sb[8]; const int e0 = c.tid * 8;
            if (smp) { const float* s0 = p.in[I_ST] + ((size_t)((b * 2 + l) * 2 + 0) * NH + h) * 4096 + e0; const float* s1 = p.in[I_ST] + ((size_t)((b * 2 + l) * 2 + 1) * NH + h) * 4096 + e0;
#pragma unroll
                for (int i = 0; i < 8; ++i) { sf[i] = s0[i]; sb[i] = s1[i]; } }
            else {
#pragma unroll
                for (int i = 0; i < 8; ++i) { sf[i] = 0.f; sb[i] = 0.f; } }
            for (int cc = 0; cc < cidx; ++cc) { const float* uf = U + ((size_t)(0 * NCHUNK + ch0 + cc) * NH + h) * 4096 + e0;
#pragma unroll
                for (int i = 0; i < 8; ++i) sf[i] = Gf * sf[i] + uf[i]; }
            for (int cc = nc - 1; cc > cidx; --cc) { const float* ub = U + ((size_t)(1 * NCHUNK + ch0 + cc) * NH + h) * 4096 + e0;
#pragma unroll
                for (int i = 0; i < 8; ++i) sb[i] = Gb * sb[i] + ub[i]; }
#pragma unroll
            for (int i = 0; i < 8; ++i) { Sf[e0 + i] = sf[i]; Sb[e0 + i] = sb[i]; }
            if (!smp && cidx == nc - 1) { const float* uf = U + ((size_t)(0 * NCHUNK + ch) * NH + h) * 4096 + e0; float* o = p.out + OUT_ST + ((size_t)((b * 2 + l) * 2 + 0) * NH + h) * 4096 + e0;
#pragma unroll
                for (int i = 0; i < 8; ++i) o[i] = Gf * sf[i] + uf[i]; }
            if (!smp && cidx == 0) { const float* ub = U + ((size_t)(1 * NCHUNK + ch) * NH + h) * 4096 + e0; float* o = p.out + OUT_ST + ((size_t)((b * 2 + l) * 2 + 1) * NH + h) * 4096 + e0;
#pragma unroll
                for (int i = 0; i < 8; ++i) o[i] = Gb * sb[i] + ub[i]; }
        }
        __syncthreads();
        const int i = c.tid >> 2, part = c.tid & 3;
        float qp[16], o[16];
        { const bf16_t* qr = (const bf16_t*)(p.ws + Z_RQ) + (R0 + i) * RW + h * HD + part * 16; const u32x4 w0 = *(const u32x4*)qr, w1 = *(const u32x4*)(qr + 8);
            qp[0] = bflo(w0.x); qp[1] = bfhi(w0.x); qp[2] = bflo(w0.y); qp[3] = bfhi(w0.y); qp[4] = bflo(w0.z); qp[5] = bfhi(w0.z); qp[6] = bflo(w0.w); qp[7] = bfhi(w0.w);
            qp[8] = bflo(w1.x); qp[9] = bfhi(w1.x); qp[10] = bflo(w1.y); qp[11] = bfhi(w1.y); qp[12] = bflo(w1.z); qp[13] = bfhi(w1.z); qp[14] = bflo(w1.w); qp[15] = bfhi(w1.w); }
#pragma unroll
        for (int e = 0; e < 16; ++e) o[e] = 0.f;
#pragma unroll 1
        for (int j = 0; j < 128; ++j) { float s = 0.f;
#pragma unroll
            for (int d4 = 0; d4 < 4; ++d4) { const f32x4 kv = *(const LAS f32x4*)(Kt + j * 64 + part * 16 + 4 * d4); s += qp[4 * d4] * kv.x + qp[4 * d4 + 1] * kv.y + qp[4 * d4 + 2] * kv.z + qp[4 * d4 + 3] * kv.w; }
            s += __shfl_xor(s, 1); s += __shfl_xor(s, 2);
            const float w = j < i ? pf[i - j] : (j > i ? pb[j - i] : 2.0f);
            s *= w;
#pragma unroll
            for (int e4 = 0; e4 < 4; ++e4) { const f32x4 vv = *(const LAS f32x4*)(Vt + j * 64 + part * 16 + 4 * e4); o[4 * e4] += s * vv.x; o[4 * e4 + 1] += s * vv.y; o[4 * e4 + 2] += s * vv.z; o[4 * e4 + 3] += s * vv.w; } }
        { const float xf = pf[i + 1], xb = pb[128 - i]; const bf16_t* qfull = (const bf16_t*)(p.ws + Z_RQ) + (R0 + i) * RW + h * HD;
#pragma unroll 2
            for (int d = 0; d < 64; ++d) { const float qd = bf2f(qfull[d]); const float af = qd * xf, ab = qd * xb;
#pragma unroll
                for (int e4 = 0; e4 < 4; ++e4) { const f32x4 a = *(const LAS f32x4*)(Sf + d * 64 + part * 16 + 4 * e4), bb = *(const LAS f32x4*)(Sb + d * 64 + part * 16 + 4 * e4);
                    o[4 * e4] += af * a.x + ab * bb.x; o[4 * e4 + 1] += af * a.y + ab * bb.y; o[4 * e4 + 2] += af * a.z + ab * bb.z; o[4 * e4 + 3] += af * a.w + ab * bb.w; } } }
        float s1 = 0.f;
#pragma unroll
        for (int e = 0; e < 16; ++e) s1 += o[e];
        s1 += __shfl_xor(s1, 1); s1 += __shfl_xor(s1, 2); const float mu = s1 * (1.f / 64.f);
        float s2 = 0.f;
#pragma unroll
        for (int e = 0; e < 16; ++e) { const float d = o[e] - mu; s2 += d * d; }
        s2 += __shfl_xor(s2, 1); s2 += __shfl_xor(s2, 2); const float rstd = rsqrtf(s2 * (1.f / 64.f) + EPS);
        const float* gn = p.in[I_RETGN] + l * RW + h * HD + part * 16;
        const bf16_t* rg = (const bf16_t*)(p.ws + Z_RG) + (R0 + i) * RW + h * HD + part * 16; const u32x4 g0 = *(const u32x4*)rg, g1 = *(const u32x4*)(rg + 8);
        float gs[16] = {bflo(g0.x), bfhi(g0.x), bflo(g0.y), bfhi(g0.y), bflo(g0.z), bfhi(g0.z), bflo(g0.w), bfhi(g0.w), bflo(g1.x), bfhi(g1.x), bflo(g1.y), bfhi(g1.y), bflo(g1.z), bfhi(g1.z), bflo(g1.w), bfhi(g1.w)};
        float y[16];
#pragma unroll
        for (int e = 0; e < 16; ++e) y[e] = (o[e] - mu) * rstd * gn[e] * gs[e];
        bf16_t* dst = (bf16_t*)(p.ws + Z_CV) + (R0 + i) * RW + h * HD + part * 16;
        u32x4 w0, w1; w0.x = pk2(y[0], y[1]); w0.y = pk2(y[2], y[3]); w0.z = pk2(y[4], y[5]); w0.w = pk2(y[6], y[7]); w1.x = pk2(y[8], y[9]); w1.y = pk2(y[10], y[11]); w1.z = pk2(y[12], y[13]); w1.w = pk2(y[14], y[15]);
        *(u32x4*)dst = w0; *(u32x4*)(dst + 8) = w1;
    }
    __syncthreads();
}

typedef short v4i16_t __attribute__((ext_vector_type(4)));
typedef LAS const unsigned char* lcp;
__device__ __forceinline__ f32x4 mfma16(bf16x8 a, bf16x8 b, f32x4 c) { return __builtin_amdgcn_mfma_f32_16x16x32_bf16(a, b, c, 0, 0, 0); }
__device__ __forceinline__ bf16x8 tr_frag(lcp base, int stride, int k0, int c0, int lane) {
    const int g = lane >> 4, i = lane & 15, q = i >> 2, pp = i & 3;
    lcp a = base + (k0 + 8 * g + q) * stride + (c0 + 4 * pp) * 2;
    const v4i16_t r1 = __builtin_amdgcn_ds_read_tr16_b64_v4i16((LAS v4i16_t*)a), r2 = __builtin_amdgcn_ds_read_tr16_b64_v4i16((LAS v4i16_t*)(a + 4 * stride));
    return (bf16x8){r1[0], r1[1], r1[2], r1[3], r2[0], r2[1], r2[2], r2[3]};
}
__device__ __forceinline__ bf16x8 row_frag(lcp base, int stride, int r0, int k0, int lane) { return *(const LAS bf16x8*)(base + (r0 + (lane & 15)) * stride + (k0 + 8 * (lane >> 4)) * 2); }
__device__ __forceinline__ u32x4 scale8(const u32x4 w, float s) { u32x4 o; o.x = pk2(bflo(w.x) * s, bfhi(w.x) * s); o.y = pk2(bflo(w.y) * s, bfhi(w.y) * s); o.z = pk2(bflo(w.z) * s, bfhi(w.z) * s); o.w = pk2(bflo(w.w) * s, bfhi(w.w) * s); return o; }
constexpr int RS64 = 144, RS128 = 272;
constexpr float LOG2E = 1.4426950408889634f;

__device__ __forceinline__ void retU_fast(const Params& p, const Ctx& c, int l) {
    LAS unsigned char* Kf = c.lds; LAS unsigned char* Kb = Kf + 128 * RS64; LAS unsigned char* Vs = Kb + 128 * RS64;
    float* U = (float*)(p.ws + Z_U);
    const int g = c.lane >> 4, i16 = c.lane & 15;
    for (int u = c.bx; u < NCHUNK * NH; u += c.G) {
        const int ch = u >> 3, h = u & 7; const size_t R0 = (size_t)ch * 128;
        const float l2f = ret_ld(p, l, 0, h) * LOG2E, l2b = ret_ld(p, l, 1, h) * LOG2E;
        __syncthreads();
#pragma unroll
        for (int it = 0; it < 2; ++it) { const int idx = c.tid + 512 * it, j = idx >> 3, c8 = (idx & 7) * 8;
            const u32x4 kw = *(const u32x4*)((const bf16_t*)(p.ws + Z_RK) + (R0 + j) * RW + h * HD + c8), vw = *(const u32x4*)((const bf16_t*)(p.ws + Z_RV) + (R0 + j) * RW + h * HD + c8);
            const float wf = exp2f(l2f * (float)(127 - j)), wb = exp2f(l2b * (float)j);
            *(LAS u32x4*)(Kf + j * RS64 + c8 * 2) = scale8(kw, wf); *(LAS u32x4*)(Kb + j * RS64 + c8 * 2) = scale8(kw, wb); *(LAS u32x4*)(Vs + j * RS64 + c8 * 2) = vw; }
        __syncthreads();
        const int dt = c.wave & 3, et0 = 2 * (c.wave >> 2);
        f32x4 acc[2][2];
#pragma unroll
        for (int s = 0; s < 2; ++s)
#pragma unroll
            for (int e = 0; e < 2; ++e) acc[s][e] = (f32x4){0.f, 0.f, 0.f, 0.f};
#pragma unroll
        for (int ks = 0; ks < 4; ++ks) {
            const bf16x8 af = tr_frag(Kf, RS64, 32 * ks, 16 * dt, c.lane), ab = tr_frag(Kb, RS64, 32 * ks, 16 * dt, c.lane);
#pragma unroll
            for (int e = 0; e < 2; ++e) { const bf16x8 bv = tr_frag(Vs, RS64, 32 * ks, 16 * (et0 + e), c.lane); acc[0][e] = mfma16(af, bv, acc[0][e]); acc[1][e] = mfma16(ab, bv, acc[1][e]); }
        }
#pragma unroll
        for (int s = 0; s < 2; ++s)
#pragma unroll
            for (int e = 0; e < 2; ++e) { float* o = U + ((size_t)(s * NCHUNK + ch) * NH + h) * 4096 + (16 * dt + 4 * g) * 64 + 16 * (et0 + e) + i16;
#pragma unroll
                for (int r = 0; r < 4; ++r) o[r * 64] = acc[s][e][r]; }
    }
    __syncthreads();
}

__device__ __forceinline__ void retO_fast(const Params& p, const Ctx& c, int l) {
    LAS unsigned char* Qs = c.lds; LAS unsigned char* Ks = Qs + 128 * RS64; LAS unsigned char* Vs = Ks + 128 * RS64; LAS unsigned char* Sf = Vs + 128 * RS64; LAS unsigned char* Sb = Sf + 64 * RS64; LAS unsigned char* Ps = Sb + 64 * RS64;
    const float* U = (const float*)(p.ws + Z_U);
    const int g = c.lane >> 4, i16 = c.lane & 15, i0 = 16 * c.wave;
    for (int u = c.bx; u < NCHUNK * NH; u += c.G) {
        const int ch = u >> 3, h = u & 7; const size_t R0 = (size_t)ch * 128; const bool smp = ch >= MP / 128;
        const int nc = smp ? 16 : 2, ch0 = smp ? (MP / 128 + ((ch - MP / 128) & ~15)) : (ch & ~1), cidx = ch - ch0, b = smp ? (ch - MP / 128) >> 4 : ch >> 1;
        const float ldf = ret_ld(p, l, 0, h), ldb = ret_ld(p, l, 1, h); const float Gf = __expf(128.f * ldf), Gb = __expf(128.f * ldb), l2f = ldf * LOG2E, l2b = ldb * LOG2E;
        __syncthreads();
#pragma unroll
        for (int it = 0; it < 2; ++it) { const int idx = c.tid + 512 * it, j = idx >> 3, c8 = (idx & 7) * 8; const size_t go = (R0 + j) * RW + h * HD + c8;
            *(LAS u32x4*)(Qs + j * RS64 + c8 * 2) = *(const u32x4*)((const bf16_t*)(p.ws + Z_RQ) + go);
            *(LAS u32x4*)(Ks + j * RS64 + c8 * 2) = *(const u32x4*)((const bf16_t*)(p.ws + Z_RK) + go);
            *(LAS u32x4*)(Vs + j * RS64 + c8 * 2) = *(const u32x4*)((const bf16_t*)(p.ws + Z_RV) + go); }
        {
            float sf[8], sb[8]; const int e0 = c.tid * 8;
            if (smp) { const float* s0 = p.in[I_ST] + ((size_t)((b * 2 + l) * 2 + 0) * NH + h) * 4096 + e0; const float* s1 = p.in[I_ST] + ((size_t)((b * 2 + l) * 2 + 1) * NH + h) * 4096 + e0;
#pragma unroll
                for (int i = 0; i < 8; ++i) { sf[i] = s0[i]; sb[i] = s1[i]; } }
            else {
#pragma unroll
                for (int i = 0; i < 8; ++i) { sf[i] = 0.f; sb[i] = 0.f; } }
            for (int cc = 0; cc < cidx; ++cc) { const float* uf = U + ((size_t)(0 * NCHUNK + ch0 + cc) * NH + h) * 4096 + e0; const f32x4 a0 = *(const f32x4*)uf, a1 = *(const f32x4*)(uf + 4);
#pragma unroll
                for (int i = 0; i < 4; ++i) { sf[i] = Gf * sf[i] + a0[i]; sf[4 + i] = Gf * sf[4 + i] + a1[i]; } }
            for (int cc = nc - 1; cc > cidx; --cc) { const float* ub = U + ((size_t)(1 * NCHUNK + ch0 + cc) * NH + h) * 4096 + e0; const f32x4 a0 = *(const f32x4*)ub, a1 = *(const f32x4*)(ub + 4);
#pragma unroll
                for (int i = 0; i < 4; ++i) { sb[i] = Gb * sb[i] + a0[i]; sb[4 + i] = Gb * sb[4 + i] + a1[i]; } }
            { const int d = c.tid >> 3, e = (c.tid & 7) * 8; u32x4 w;
                w.x = pk2(sf[0], sf[1]); w.y = pk2(sf[2], sf[3]); w.z = pk2(sf[4], sf[5]); w.w = pk2(sf[6], sf[7]); *(LAS u32x4*)(Sf + d * RS64 + e * 2) = w;
                w.x = pk2(sb[0], sb[1]); w.y = pk2(sb[2], sb[3]); w.z = pk2(sb[4], sb[5]); w.w = pk2(sb[6], sb[7]); *(LAS u32x4*)(Sb + d * RS64 + e * 2) = w; }
            if (!smp && cidx == nc - 1) { const float* uf = U + ((size_t)(0 * NCHUNK + ch) * NH + h) * 4096 + e0; float* o = p.out + OUT_ST + ((size_t)((b * 2 + l) * 2 + 0) * NH + h) * 4096 + e0;
#pragma unroll
                for (int i = 0; i < 8; ++i) o[i] = Gf * sf[i] + uf[i]; }
            if (!smp && cidx == 0) { const float* ub = U + ((size_t)(1 * NCHUNK + ch) * NH + h) * 4096 + e0; float* o = p.out + OUT_ST + ((size_t)((b * 2 + l) * 2 + 1) * NH + h) * 4096 + e0;
#pragma unroll
                for (int i = 0; i < 8; ++i) o[i] = Gb * sb[i] + ub[i]; }
        }
        __syncthreads();
        { const bf16x8 q0 = row_frag(Qs, RS64, i0, 0, c.lane), q1 = row_frag(Qs, RS64, i0, 32, c.lane);
            const int iq = i0 + i16;
#pragma unroll
            for (int jt = 0; jt < 8; ++jt) {
                f32x4 s = (f32x4){0.f, 0.f, 0.f, 0.f};
                s = mfma16(row_frag(Ks, RS64, 16 * jt, 0, c.lane), q0, s); s = mfma16(row_frag(Ks, RS64, 16 * jt, 32, c.lane), q1, s);
                float pv[4];
#pragma unroll
                for (int r = 0; r < 4; ++r) { const int j = 16 * jt + 4 * g + r; const float w = j < iq ? exp2f(l2f * (float)(iq - j)) : (j > iq ? exp2f(l2b * (float)(j - iq)) : 2.0f); pv[r] = s[r] * w; }
                u32x2 w2; w2.x = pk2(pv[0], pv[1]); w2.y = pk2(pv[2], pv[3]);
                *(LAS u32x2*)(Ps + iq * RS128 + (16 * jt + 4 * g) * 2) = w2;
            } }
        __syncthreads();
        f32x4 ap[4], af[4], ab[4];
#pragma unroll
        for (int et = 0; et < 4; ++et) { ap[et] = (f32x4){0.f, 0.f, 0.f, 0.f}; af[et] = ap[et]; ab[et] = ap[et]; }
#pragma unroll
        for (int ks = 0; ks < 4; ++ks) { const bf16x8 a = row_frag(Ps, RS128, i0, 32 * ks, c.lane);
#pragma unroll
            for (int et = 0; et < 4; ++et) ap[et] = mfma16(a, tr_frag(Vs, RS64, 32 * ks, 16 * et, c.lane), ap[et]); }
#pragma unroll
        for (int ks = 0; ks < 2; ++ks) { const bf16x8 a = row_frag(Qs, RS64, i0, 32 * ks, c.lane);
#pragma unroll
            for (int et = 0; et < 4; ++et) { af[et] = mfma16(a, tr_frag(Sf, RS64, 32 * ks, 16 * et, c.lane), af[et]); ab[et] = mfma16(a, tr_frag(Sb, RS64, 32 * ks, 16 * et, c.lane), ab[et]); } }
        float mu[4], rstd[4];
#pragma unroll
        for (int r = 0; r < 4; ++r) { const int il = i0 + 4 * g + r; const float xf = exp2f(l2f * (float)(il + 1)), xb = exp2f(l2b * (float)(128 - il)); float s1 = 0.f;
#pragma unroll
            for (int et = 0; et < 4; ++et) { ap[et][r] += xf * af[et][r] + xb * ab[et][r]; s1 += ap[et][r]; }
            s1 += __shfl_xor(s1, 1); s1 += __shfl_xor(s1, 2); s1 += __shfl_xor(s1, 4); s1 += __shfl_xor(s1, 8); mu[r] = s1 * (1.f / 64.f); float s2 = 0.f;
#pragma unroll
            for (int et = 0; et < 4; ++et) { const float d = ap[et][r] - mu[r]; s2 += d * d; }
            s2 += __shfl_xor(s2, 1); s2 += __shfl_xor(s2, 2); s2 += __shfl_xor(s2, 4); s2 += __shfl_xor(s2, 8); rstd[r] = rsqrtf(s2 * (1.f / 64.f) + EPS); }
        LAS float* stg = (LAS float*)(Ps + i0 * RS128);
#pragma unroll
        for (int et = 0; et < 4; ++et) { const float gn = p.in[I_RETGN][l * RW + h * HD + 16 * et + i16];
#pragma unroll
            for (int r = 0; r < 4; ++r) stg[(4 * g + r) * 68 + 16 * et + i16] = (ap[et][r] - mu[r]) * rstd[r] * gn; }
        asm volatile("s_waitcnt lgkmcnt(0)" ::: "memory");
#pragma unroll
        for (int k = 0; k < 2; ++k) { const int row = c.lane >> 2, ec = ((c.lane & 3) * 2 + k) * 8;
            const f32x4 y0 = *(const LAS f32x4*)(stg + row * 68 + ec), y1 = *(const LAS f32x4*)(stg + row * 68 + ec + 4);
            const size_t go = (R0 + i0 + row) * RW + h * HD + ec; const u32x4 gw = *(const u32x4*)((const bf16_t*)(p.ws + Z_RG) + go);
            u32x4 o; o.x = pk2(y0.x * bflo(gw.x), y0.y * bfhi(gw.x)); o.y = pk2(y0.z * bflo(gw.y), y0.w * bfhi(gw.y)); o.z = pk2(y1.x * bflo(gw.z), y1.y * bfhi(gw.z)); o.w = pk2(y1.z * bflo(gw.w), y1.w * bfhi(gw.w));
            *(u32x4*)((bf16_t*)(p.ws + Z_CV) + go) = o; }
    }
    __syncthreads();
}

__device__ __forceinline__ void cmlp_fast(const Params& p, const Ctx& c, int l) {
    LAS unsigned char* As = c.lds; LAS unsigned char* Vc = As + 128 * RS128; LAS float* rs = (LAS float*)(Vc + 128 * RS128);
    const bf16_t* cv = (const bf16_t*)(p.ws + Z_CV); bf16_t* cu = (bf16_t*)(p.ws + Z_CU);
    const int g4 = c.lane >> 4, i16 = c.lane & 15, p0 = 16 * c.wave;
    for (int u = c.bx; u < NCHUNK * 4; u += c.G) {
        const int ch = u >> 2, g = u & 3; const size_t R0 = (size_t)ch * 128;
        __syncthreads();
        { const int q = c.tid >> 2, part = c.tid & 3; float ss = 0.f;
            const bf16_t* r = cv + (R0 + q) * RW + part * 128;
#pragma unroll
            for (int i = 0; i < 16; ++i) { const u32x4 w = *(const u32x4*)(r + 8 * i); const float a0 = bflo(w.x), a1 = bfhi(w.x), a2 = bflo(w.y), a3 = bfhi(w.y), a4 = bflo(w.z), a5 = bfhi(w.z), a6 = bflo(w.w), a7 = bfhi(w.w);
                ss += (a0 * a0 + a1 * a1) + (a2 * a2 + a3 * a3) + (a4 * a4 + a5 * a5) + (a6 * a6 + a7 * a7); }
            ss += __shfl_xor(ss, 1); ss += __shfl_xor(ss, 2);
            if (part == 0) rs[q] = rsqrtf(ss * (1.f / RW) + EPS); }
#pragma unroll
        for (int it = 0; it < 4; ++it) { const int idx = c.tid + 512 * it, q = idx >> 4, c8 = (idx & 15) * 8;
            *(LAS u32x4*)(Vc + q * RS128 + c8 * 2) = *(const u32x4*)(cv + (R0 + q) * RW + g * 128 + c8); }
        __syncthreads();
        const float* Ws = p.in[I_CMWS] + ((size_t)(l * 4 + g) * 128) * 128;
#pragma unroll
        for (int it = 0; it < 8; ++it) { const int idx = c.tid + 512 * it, pr = idx >> 5, q4 = (idx & 31) * 4;
            const f32x4 w = *(const f32x4*)(Ws + pr * 128 + q4); const f32x4 r = *(const LAS f32x4*)(rs + q4);
            u32x2 o; o.x = pk2(w.x * r.x, w.y * r.y); o.y = pk2(w.z * r.z, w.w * r.w); *(LAS u32x2*)(As + pr * RS128 + q4 * 2) = o; }
        __syncthreads();
        f32x4 acc[8];
#pragma unroll
        for (int ct = 0; ct < 8; ++ct) acc[ct] = (f32x4){0.f, 0.f, 0.f, 0.f};
#pragma unroll
        for (int ks = 0; ks < 4; ++ks) { const bf16x8 a = row_frag(As, RS128, p0, 32 * ks, c.lane);
#pragma unroll
            for (int ct = 0; ct < 8; ++ct) acc[ct] = mfma16(a, tr_frag(Vc, RS128, 32 * ks, 16 * ct, c.lane), acc[ct]); }
        __syncthreads();
        LAS float* stg = (LAS float*)(c.lds + c.wave * (16 * 132 * 4));
        const float* bsv = p.in[I_CMBS] + (l * 4 + g) * 128 + p0 + 4 * g4;
        float bb[4];
#pragma unroll
        for (int r = 0; r < 4; ++r) bb[r] = bsv[r];
#pragma unroll
        for (int ct = 0; ct < 8; ++ct) { const float gn = p.in[I_CMNORM][l * RW + g * 128 + 16 * ct + i16];
#pragma unroll
            for (int r = 0; r < 4; ++r) stg[(4 * g4 + r) * 132 + 16 * ct + i16] = gn * acc[ct][r] + bb[r]; }
        asm volatile("s_waitcnt lgkmcnt(0)" ::: "memory");
#pragma unroll
        for (int k = 0; k < 4; ++k) { const int row = c.lane >> 2, cc = (k * 4 + (c.lane & 3)) * 8;
            const f32x4 y0 = *(const LAS f32x4*)(stg + row * 132 + cc), y1 = *(const LAS f32x4*)(stg + row * 132 + cc + 4);
            bf16_t* up = cu + (R0 + p0 + row) * RW + g * 128 + cc; const u32x4 uw = *(const u32x4*)up;
            u32x4 o; o.x = pk2(y0.x * bflo(uw.x), y0.y * bfhi(uw.x)); o.y = pk2(y0.z * bflo(uw.y), y0.w * bfhi(uw.y)); o.z = pk2(y1.x * bflo(uw.z), y1.y * bfhi(uw.z)); o.w = pk2(y1.z * bflo(uw.w), y1.w * bfhi(uw.w));
            *(u32x4*)up = o; }
    }
    __syncthreads();
}
#ifndef FAST_MIX
#define FAST_MIX 7
#endif

#ifndef PG8_MASK
#define PG8_MASK 0xFFF
#endif
template <int KIND, class Epi, class Sched>
__device__ __forceinline__ void gemm_any(const Ctx& c, const bf16_t* A, const bf16_t* Bt, int K, const Sched& S, const Epi& E) {
    if constexpr ((PG8_MASK >> KIND) & 1) { pg8::Gemm g{A, Bt, 0, 0, K}; pg8::gemm_phase<Epi, Sched, true, true>(c.tid, c.lds, g, S, E); }
    else gemm_simple(c, A, Bt, K, S, E);
}
#ifndef KMASK
#define KMASK 0xFFF
#endif
constexpr int NPHASE = 22;
template <int KIND> __device__ __forceinline__ void run_kind(const Params& p, const Ctx& c, int l) {
    const unsigned char* wb = p.ws + WS_W;
    if constexpr (KIND == 0) { p0_modulation(p, c); p0_rope_tables(p, c); p_wconv(p, c, 0); p_kvctx(p, c, 0); }
    else if constexpr (KIND == 1) { p_norm(p, c, 0, 0); }
    else if constexpr (KIND == 2) { StaticOrder S; S.init(M, NMIX, c.G, c.bx); EpiMix E{&p, l}; gemm_any<2>(c, (const bf16_t*)(p.ws + WS_XN), (const bf16_t*)(wb + W_IN), DM, S, E); }
    else if constexpr (KIND == 3) { if (ATTN_FAST) attn_fast(p, c); else attn_simple(p, c); if (FAST_MIX & 1) cmlp_fast(p, c, l); else cmlp_simple(p, c, l); if (FAST_MIX & 2) retU_fast(p, c, l); else retU_simple(p, c, l); }
    else if constexpr (KIND == 4) { if (FAST_MIX & 4) retO_fast(p, c, l); else retO_simple(p, c, l); }
    else if constexpr (KIND == 5) { StaticOrder S; S.init(M, NGATE, c.G, c.bx); EpiGate E{&p}; gemm_any<5>(c, (const bf16_t*)(p.ws + WS_XN), (const bf16_t*)(wb + W_IN) + (size_t)NMIX * DM, DM, S, E); }
    else if constexpr (KIND == 6) { MergeOrder S{c.G, c.bx}; EpiMerge E{&p}; gemm_any<6>(c, (const bf16_t*)(p.ws + Z_AQ), (const bf16_t*)(wb + W_BR), RW, S, E); }
    else if constexpr (KIND == 7) { StaticOrder S; S.init(M, DM, c.G, c.bx); EpiRes E{&p, l, 2, l == 0}; gemm_any<7>(c, (const bf16_t*)(p.ws + WS_XN), (const bf16_t*)(wb + W_OUT), DM, S, E); }
    else if constexpr (KIND == 8) { p_norm(p, c, l, 1); }
    else if constexpr (KIND == 9) { StaticOrder S; S.init(M, DFF, c.G, c.bx); EpiFF1 E{&p}; gemm_any<9>(c, (const bf16_t*)(p.ws + WS_XN), (const bf16_t*)(wb + W_FF1), DM, S, E); }
    else if constexpr (KIND == 10) { StaticOrder S; S.init(M, DM, c.G, c.bx); EpiRes E{&p, l, 5, false}; gemm_any<10>(c, (const bf16_t*)(p.ws + Z_HB), (const bf16_t*)(wb + W_FF2), DFF, S, E); }
    else { if (l == 0) { p_wconv(p, c, 1); p_kvctx(p, c, 1); p_norm(p, c, 1, 0); } else p_final_norm(p, c); }
}
__device__ __forceinline__ void run_phase(const Params& p, const Ctx& c0, int ph) {
    Ctx c = c0; asm volatile("" : "+v"(c.tid));
    c.lane = c.tid & 63; c.wave = __builtin_amdgcn_readfirstlane(c.tid >> 6);
    if (ph == 0) { if (KMASK & 1) run_kind<0>(p, c, 0); return; }
    if (ph == 1) { if (KMASK & 2) run_kind<1>(p, c, 0); return; }
    const int l = (ph - 2) / 10, s = (ph - 2) % 10;
    switch (s) {
    case 0: if (KMASK & (1 << 2)) run_kind<2>(p, c, l); break;
    case 1: if (KMASK & (1 << 3)) run_kind<3>(p, c, l); break;
    case 2: if (KMASK & (1 << 4)) run_kind<4>(p, c, l); break;
    case 3: if (KMASK & (1 << 5)) run_kind<5>(p, c, l); break;
    case 4: if (KMASK & (1 << 6)) run_kind<6>(p, c, l); break;
    case 5: if (KMASK & (1 << 7)) run_kind<7>(p, c, l); break;
    case 6: if (KMASK & (1 << 8)) run_kind<8>(p, c, l); break;
    case 7: if (KMASK & (1 << 9)) run_kind<9>(p, c, l); break;
    case 8: if (KMASK & (1 << 10)) run_kind<10>(p, c, l); break;
    default: if (KMASK & (1 << 11)) run_kind<11>(p, c, l); break;
    }
}

template <int PH> __device__ __forceinline__ void run_from(const Params& p, const Ctx& c0, const XcdBarrier& bar) {
    if constexpr (PH < NPHASE) {
        constexpr int kind = PH < 2 ? PH : 2 + (PH - 2) % 10, l = PH < 2 ? 0 : (PH - 2) / 10;
        { Ctx c = c0; asm volatile("" : "+v"(c.tid)); c.lane = c.tid & 63; c.wave = __builtin_amdgcn_readfirstlane(c.tid >> 6);
          if ((KMASK >> kind) & 1) run_kind<kind>(p, c, l); }
        if constexpr (PH + 1 < NPHASE) xcd_barrier(bar);
        run_from<PH + 1>(p, c0, bar);
    }
}
#if N_LAUNCH_MODE == 1
__global__ void __launch_bounds__(512, 2) fwd_kernel(Params p) {
    extern __shared__ __attribute__((aligned(16))) unsigned char lds[];
    Ctx c; c.tid = threadIdx.x; c.lane = c.tid & 63; c.wave = __builtin_amdgcn_readfirstlane(c.tid >> 6); c.G = gridDim.x; c.bx = blockIdx.x; c.lds = (LAS unsigned char*)lds;
    volatile LAS unsigned* MISC = (volatile LAS unsigned*)(c.lds + MISC_OFF);
    if (c.tid < 32) MISC[c.tid] = 0u;
    __syncthreads();
    XcdBarrier bar = xcd_barrier_post((unsigned*)(p.ws + WS_CTL) + CW_BAR, MISC + 8);
    run_from<0>(p, c, bar);
}
#endif
template <int KIND> __global__ void __launch_bounds__(512, 2) phase_kernel(Params p) {
    extern __shared__ __attribute__((aligned(16))) unsigned char lds[];
    Ctx c; c.tid = threadIdx.x; c.lane = c.tid & 63; c.wave = __builtin_amdgcn_readfirstlane(c.tid >> 6); c.G = gridDim.x; c.bx = blockIdx.x; c.lds = (LAS unsigned char*)lds;
    run_kind<KIND>(p, c, p.ph_hi);
}
template <int KIND> static void launch_kind(Params p, int l, int grid, hipStream_t stream) {
    static bool attr = false;
    if (!attr) { (void)hipFuncSetAttribute((const void*)phase_kernel<KIND>, hipFuncAttributeMaxDynamicSharedMemorySize, LDS_BYTES); attr = true; }
    p.ph_lo = 0; p.ph_hi = l;
    hipLaunchKernelGGL(phase_kernel<KIND>, dim3(grid), dim3(512), LDS_BYTES, stream, p);
}

extern "C" void kernel_launch(void* const* d_in, const int* in_sizes, int n_in, void* d_out, int out_size, void* d_ws, size_t ws_size, hipStream_t stream) {
    static int grid = 0;
    if (grid == 0) {
        int dev = 0, cus = 0;
        if (n_in != N_IN || ws_size < WS_NEED) { grid = -1; return; }
        if (hipGetDevice(&dev) != hipSuccess || hipDeviceGetAttribute(&cus, hipDeviceAttributeMultiprocessorCount, dev) != hipSuccess) { grid = -1; return; }
#if N_LAUNCH_MODE == 1
        if (hipFuncSetAttribute((const void*)fwd_kernel, hipFuncAttributeMaxDynamicSharedMemorySize, LDS_BYTES) != hipSuccess) { grid = -1; return; }
#endif
        grid = cus;
    }
    if (grid < 0) return;
    (void)hipMemsetAsync((char*)d_ws + WS_CTL, 0, WS_ZERO_BYTES, stream);
    Params p{};
    for (int i = 0; i < N_IN; ++i) p.in[i] = (const float*)d_in[i];
    p.out = (float*)d_out; p.ws = (unsigned char*)d_ws;
#if N_LAUNCH_MODE == 1
    p.ph_lo = 0; p.ph_hi = NPHASE;
    hipLaunchKernelGGL(fwd_kernel, dim3(grid), dim3(512), LDS_BYTES, stream, p);
#else
    launch_kind<0>(p, 0, grid, stream); launch_kind<1>(p, 0, grid, stream);
    for (int l = 0; l < 2; ++l) {
        launch_kind<2>(p, l, grid, stream); launch_kind<3>(p, l, grid, stream); launch_kind<4>(p, l, grid, stream); launch_kind<5>(p, l, grid, stream); launch_kind<6>(p, l, grid, stream);
        launch_kind<7>(p, l, grid, stream); launch_kind<8>(p, l, grid, stream); launch_kind<9>(p, l, grid, stream); launch_kind<10>(p, l, grid, stream); launch_kind<11>(p, l, grid, stream);
    }
#endif
}
```

```cpp
#include <hip/hip_runtime.h>
#include <hip/hip_bf16.h>
#include <cstdio>
#include <cstdint>

#ifndef N_LAUNCH_MODE
#define N_LAUNCH_MODE 1
#endif

#define GAS __attribute__((address_space(1)))
#define LAS __attribute__((address_space(3)))
#define RLX_AGENT __ATOMIC_RELAXED, __HIP_MEMORY_SCOPE_AGENT
typedef unsigned short bf16_t;
typedef short bf16x8 __attribute__((ext_vector_type(8)));
typedef float f32x4 __attribute__((ext_vector_type(4)));
typedef float f32x2 __attribute__((ext_vector_type(2)));
typedef unsigned u32x4 __attribute__((ext_vector_type(4)));
typedef unsigned u32x2 __attribute__((ext_vector_type(2)));

constexpr int DM = 1024, MP = 4096, MS = 16384, M = 20480, SEQ_P = 256, SEQ_S = 2048, NB_P = 16, NB_S = 8, PAST = 256;
constexpr int HD = 64, NH = 8, KVW = 128, DFF = 4096, INW = 6912, NMIX = 3840, NGATE = 3072, RW = 512;
constexpr int SKV_S = PAST + SEQ_S, SKV_P = SEQ_P;
constexpr int NCHUNK = M / 128;
constexpr float EPS = 1e-6f;
constexpr float C2 = 0.18033688011112042f;
constexpr size_t OUT_Y = 0, OUT_CK = (size_t)M * DM, OUT_CV = OUT_CK + (size_t)NB_P * 2 * SEQ_P * KVW, OUT_ST = OUT_CV + (size_t)NB_P * 2 * SEQ_P * KVW;

constexpr size_t MiB = 1u << 20;
constexpr size_t WS_CTL = 0;
constexpr size_t WS_MOD = 1 * MiB;
constexpr size_t WS_ROPE = 1 * MiB + 512 * 1024;
constexpr size_t WS_ZERO_BYTES = 1 * MiB + 512 * 1024;
constexpr size_t WS_W = 2 * MiB;
constexpr size_t W_IN = 0, W_BR = W_IN + (size_t)INW * DM * 2, W_OUT = W_BR + (size_t)3 * DM * RW * 2, W_FF1 = W_OUT + (size_t)DM * DM * 2, W_FF2 = W_FF1 + (size_t)DFF * DM * 2, W_END = W_FF2 + (size_t)DM * DFF * 2;
static_assert(W_END <= 35 * MiB, "weights");
constexpr size_t WS_XN = 37 * MiB;
constexpr size_t WS_Z = 77 * MiB;
constexpr size_t Z_RQ = WS_Z, Z_RK = WS_Z + 20 * MiB, Z_RV = WS_Z + 40 * MiB, Z_RG = WS_Z + 60 * MiB, Z_U = WS_Z + 80 * MiB;
constexpr size_t Z_AQ = WS_Z + 120 * MiB, Z_CU = WS_Z + 140 * MiB, Z_CV = WS_Z + 160 * MiB;
constexpr size_t Z_KS = WS_Z + 180 * MiB, Z_VS = Z_KS + (size_t)NB_S * SKV_S * KVW * 2, Z_KP = Z_VS + (size_t)NB_S * SKV_S * KVW * 2, Z_VP = Z_KP + (size_t)NB_P * SEQ_P * KVW * 2, Z_END = Z_VP + (size_t)NB_P * SEQ_P * KVW * 2;
constexpr size_t Z_GATE = WS_Z;
constexpr size_t Z_HB = WS_Z;
constexpr size_t SLAB_P4 = WS_Z, SLAB_P6 = WS_XN;
constexpr size_t WS_NEED = 268 * MiB;
static_assert(Z_END <= WS_NEED, "ws map");
constexpr int CW_BAR = 4096;

constexpr int LDS_BYTES = 147456;
constexpr int MISC_OFF = 131072 + 320;

__device__ __forceinline__ unsigned f2bf(float f) { unsigned u = __builtin_bit_cast(unsigned, f); return (u + 0x7fffu + ((u >> 16) & 1u)) >> 16; }
typedef __bf16 bf16x2_hw __attribute__((ext_vector_type(2)));
__device__ __forceinline__ unsigned pk2(float lo, float hi) { const f32x2 v = {lo, hi}; return __builtin_bit_cast(unsigned, __builtin_convertvector(v, bf16x2_hw)); }
__device__ __forceinline__ float bf2f(unsigned h) { return __builtin_bit_cast(float, h << 16); }
__device__ __forceinline__ float bflo(unsigned w) { return __builtin_bit_cast(float, w << 16); }
__device__ __forceinline__ float bfhi(unsigned w) { return __builtin_bit_cast(float, w & 0xffff0000u); }
__device__ __forceinline__ float sigmoidf_(float x) { return __builtin_amdgcn_rcpf(1.f + __builtin_amdgcn_exp2f(-1.4426950408889634f * x)); }
__device__ __forceinline__ float siluf_(float x) { return x * sigmoidf_(x); }
__device__ __forceinline__ float gelu_tanh(float x) { const float x2 = x * x; const float t = x * (-2.302208198f - 0.1029432397f * x2);
    return x * __builtin_amdgcn_rcpf(1.f + __builtin_amdgcn_exp2f(t)); }
__device__ __forceinline__ float wave_sum(float v) {
#pragma unroll
    for (int o = 1; o < 64; o <<= 1) v += __shfl_xor(v, o);
    return v;
}

#define XB_TMO      128
#define XB_XCNT(j)  (256  + 64 * (j))
#define XB_XSUB(j)  (1280 + 64 * (j))
#define XB_XGEN(j)  (2304 + 64 * (j))
#define XB_TOP      3328
#define XB_TOPGEN   3392
#define XCD_BAR_WORDS 3456
#define XB_SPIN_CAP (1u << 18)
__device__ __forceinline__ unsigned xb_ld(unsigned* p)              { return __hip_atomic_load(p, __ATOMIC_RELAXED, __HIP_MEMORY_SCOPE_AGENT); }
__device__ __forceinline__ unsigned xb_add(unsigned* p, unsigned v) { return __hip_atomic_fetch_add(p, v, __ATOMIC_RELAXED, __HIP_MEMORY_SCOPE_AGENT); }
__device__ __forceinline__ unsigned xb_xcc_id() { return (unsigned)__builtin_amdgcn_s_getreg((3 << 11) | 20) & 0xFu; }
#define XB_SPIN(cond, bar) do { unsigned _sp = 0; while (cond) { __builtin_amdgcn_s_sleep(1); \
    if ((++_sp & 255u) == 0u) { if (xb_ld(&(bar)[XB_TMO])) break; if (_sp > XB_SPIN_CAP) { atomicAdd(&(bar)[XB_TMO], 1u); break; } } } } while (0)
struct XcdBarrier { unsigned* bar; unsigned x; volatile LAS unsigned* st; };
__device__ __forceinline__ XcdBarrier xcd_barrier_post(unsigned* bar, volatile LAS unsigned* st) {
    XcdBarrier b; b.bar = bar; b.x = xb_xcc_id(); b.st = st;
    if (threadIdx.x == 0) (void)xb_add(&bar[XB_XCNT(b.x)], 1u);
    return b;
}
__device__ __forceinline__ void xcd_barrier_complete(unsigned* bar, unsigned x, unsigned& nloc, unsigned& nx) {
    const unsigned G = gridDim.x * gridDim.y * gridDim.z;
    unsigned sum, cnt, mine, sp = 0u;
    for (;;) {
        sum = 0u; cnt = 0u; mine = 0u;
#pragma unroll
        for (unsigned j = 0; j < 16; ++j) { const unsigned c = xb_ld(&bar[XB_XCNT(j)]); sum += c; cnt += (c > 0u) ? 1u : 0u; mine = (j == x) ? c : mine; }
        if (sum == G) break;
        __builtin_amdgcn_s_sleep(1);
        if ((++sp & 255u) == 0u) { if (xb_ld(&bar[XB_TMO])) break; if (sp > XB_SPIN_CAP) { atomicAdd(&bar[XB_TMO], 1u); break; } }
    }
    nloc = mine > 0u ? mine : 1u; nx = cnt > 0u ? cnt : 1u;
}
__device__ __forceinline__ void xcd_barrier(const XcdBarrier& b) {
    asm volatile("s_waitcnt vmcnt(0)" ::: "memory");
    __syncthreads();
    if (threadIdx.x == 0) {
        unsigned* bar = b.bar;
        __builtin_amdgcn_s_waitcnt(0);
        unsigned nloc = b.st[0], nx = b.st[1];
        if (nloc == 0u) { xcd_barrier_complete(bar, b.x, nloc, nx); b.st[0] = nloc; b.st[1] = nx; }
        const unsigned old = xb_add(&bar[XB_XSUB(b.x)], 1u);
        const unsigned gen = old / nloc;
        if (old + 1u == (gen + 1u) * nloc) {
            __builtin_amdgcn_fence(__ATOMIC_RELEASE, "agent");
            asm volatile("s_waitcnt vmcnt(0)" ::: "memory");
            const unsigned og = xb_add(&bar[XB_TOP], 1u);
            const unsigned tg = og / nx;
            if (og + 1u == (tg + 1u) * nx) xb_add(&bar[XB_TOPGEN], 1u);
            else XB_SPIN(xb_ld(&bar[XB_TOPGEN]) == tg, bar);
            __builtin_amdgcn_fence(__ATOMIC_ACQUIRE, "agent");
            xb_add(&bar[XB_XGEN(b.x)], 1u);
            asm volatile("s_waitcnt vmcnt(0)" ::: "memory");
        } else {
            XB_SPIN(xb_ld(&bar[XB_XGEN(b.x)]) == gen, bar);
            __builtin_amdgcn_fence(__ATOMIC_ACQUIRE, "agent");
            asm volatile("s_waitcnt vmcnt(0)" ::: "memory");
        }
    }
    __syncthreads();
}

enum { I_XP = 0, I_XS, I_CK, I_CV, I_ST, I_C, I_CCTX, I_WMOD, I_BMOD, I_GN1, I_GN2, I_WIN, I_GQ, I_GK, I_DECAY, I_RETGN, I_CMNORM, I_CMWS, I_CMBS, I_WBRR, I_WBRA, I_WBRC, I_WOUT, I_WFF1, I_WFF2, I_GFIN, N_IN };
struct Params { const float* in[N_IN]; float* out; unsigned char* ws; int ph_lo, ph_hi; };
static_assert(sizeof(Params) == N_IN * 8 + 8 + 8 + 8, "no padding");

struct Ctx {
    int tid, lane, wave, G, bx;
    LAS unsigned char* lds;
};
__device__ __forceinline__ int row_ci(int R) { return R < MP ? 0 : 1 + ((R - MP) >> 11); }
__device__ __forceinline__ const float* mod_ptr(const Params& p, int l, int ci, int part) { return (const float*)(p.ws + WS_MOD) + ((size_t)(l * 9 + ci) * 6 + part) * DM; }

__device__ __forceinline__ void p0_modulation(const Params& p, const Ctx& c) {
    LAS float* sl = (LAS float*)c.lds;
    for (int i = c.tid; i < 9 * DM; i += 512) { const int ci = i >> 10, k = i & 1023; const float v = ci == 0 ? p.in[I_CCTX][k] : p.in[I_C][(ci - 1) * DM + k]; sl[i] = siluf_(v); }
    __syncthreads();
    float* mod = (float*)(p.ws + WS_MOD);
    const int gw = c.bx * 8 + c.wave, NGW = c.G * 8;
    constexpr int NITEM = 2 * 96 * 8;
    for (int it = gw; it < NITEM; it += NGW) {
        const int l = it / 768, r = it % 768, cb = r >> 3, ks = r & 7;
        const float* W = p.in[I_WMOD] + (size_t)l * DM * 6144 + (size_t)(ks * 128) * 6144 + cb * 64 + c.lane;
        float s[9];
#pragma unroll
        for (int ci = 0; ci < 9; ++ci) s[ci] = 0.f;
#pragma unroll 4
        for (int k = 0; k < 128; ++k) {
            const float w = W[(size_t)k * 6144];
#pragma unroll
            for (int ci = 0; ci < 9; ++ci) s[ci] += sl[ci * DM + ks * 128 + k] * w;
        }
        const float bias = ks == 0 ? p.in[I_BMOD][l * 6144 + cb * 64 + c.lane] : 0.f;
#pragma unroll
        for (int ci = 0; ci < 9; ++ci) atomicAdd(mod + (size_t)(l * 9 + ci) * 6144 + cb * 64 + c.lane, s[ci] + bias);
    }
    __syncthreads();
}
__device__ __forceinline__ void p0_rope_tables(const Params& p, const Ctx& c) {
    f32x2* tab = (f32x2*)(p.ws + WS_ROPE);
    const int g = c.bx * 512 + c.tid;
    if (g < 96 * 16) { const int pos = g >> 4, i = g & 15; const float inv = 1.0f / powf(10000.0f, (float)(2 * i) / 32.0f); const float posf = pos < 32 ? (float)pos : (float)(pos - 32);
        const float ang = posf * inv; f32x2 v; v.x = cosf(ang); v.y = sinf(ang); tab[g] = v; }
}
__device__ __forceinline__ int win_colmap(int n) {
    const int tile = n >> 8, pp = n & 255, bj = pp >> 7, wc = (pp >> 5) & 3;
    if (tile < 10) return (tile >> 1) * 512 + ((tile & 1) * 4 + wc) * 64 + 32 * bj;
    if (tile == 10) return (wc < 2 ? 2560 + wc * 64 : 2688 + (wc - 2) * 64) + 32 * bj;
    return n;
}
__device__ __forceinline__ void transpose_item(const float* W, int K, int ldn, int src_col0, bf16_t* WT, int dst_row0, int k0, LAS float* scr, int lane) {
#pragma unroll 8
    for (int i = 0; i < 32; ++i) { const int kk = 2 * i + (lane >> 5); scr[kk * 33 + (lane & 31)] = W[(size_t)(k0 + kk) * ldn + src_col0 + (lane & 31)]; }
    asm volatile("s_waitcnt lgkmcnt(0)" ::: "memory");
    const int ch = lane & 7;
#pragma unroll
    for (int j = 0; j < 4; ++j) { const int n = (lane >> 3) + 8 * j; const LAS float* s = scr + (8 * ch) * 33 + n;
        u32x4 o; o.x = pk2(s[0 * 33], s[1 * 33]); o.y = pk2(s[2 * 33], s[3 * 33]); o.z = pk2(s[4 * 33], s[5 * 33]); o.w = pk2(s[6 * 33], s[7 * 33]);
        *(u32x4*)(WT + (size_t)(dst_row0 + n) * K + k0 + 8 * ch) = o; }
    asm volatile("s_waitcnt lgkmcnt(0)" ::: "memory");
}
__device__ __forceinline__ void p_wconv(const Params& p, const Ctx& c, int l) {
    LAS float* scr = (LAS float*)(c.lds + 40960 + c.wave * 8448);
    const int gw = c.bx * 8 + c.wave, NGW = c.G * 8;
    unsigned char* wb = p.ws + WS_W;
    constexpr int I_IN = 16 * 216, I_BRX = 8 * 32, I_O = 16 * 32, I_F1 = 16 * 128, I_F2 = 64 * 32;
    constexpr int NITEMS = I_IN + 3 * I_BRX + I_O + I_F1 + I_F2;
    for (int it = gw; it < NITEMS; it += NGW) {
        int r = it;
        if (r < I_IN) { const int kb = r / 216, nb = r % 216; transpose_item(p.in[I_WIN] + (size_t)l * DM * INW, DM, INW, win_colmap(nb * 32), (bf16_t*)(wb + W_IN), nb * 32, kb * 64, scr, c.lane); continue; } r -= I_IN;
        if (r < 3 * I_BRX) { const int x = r / I_BRX, rr = r % I_BRX, kb = rr / 32, nb = rr % 32;
            const float* src = (x == 0 ? p.in[I_WBRA] : x == 1 ? p.in[I_WBRC] : p.in[I_WBRR]) + (size_t)l * RW * DM;
            transpose_item(src, RW, DM, nb * 32, (bf16_t*)(wb + W_BR) + (size_t)x * DM * RW, nb * 32, kb * 64, scr, c.lane); continue; } r -= 3 * I_BRX;
        if (r < I_O) { const int kb = r / 32, nb = r % 32; transpose_item(p.in[I_WOUT] + (size_t)l * DM * DM, DM, DM, nb * 32, (bf16_t*)(wb + W_OUT), nb * 32, kb * 64, scr, c.lane); continue; } r -= I_O;
        if (r < I_F1) { const int kb = r / 128, nb = r % 128; transpose_item(p.in[I_WFF1] + (size_t)l * DM * DFF, DM, DFF, nb * 32, (bf16_t*)(wb + W_FF1), nb * 32, kb * 64, scr, c.lane); continue; } r -= I_F1;
        { const int kb = r / 32, nb = r % 32; transpose_item(p.in[I_WFF2] + (size_t)l * DFF * DM, DFF, DM, nb * 32, (bf16_t*)(wb + W_FF2), nb * 32, kb * 64, scr, c.lane); }
    }
}
__device__ __forceinline__ void p_kvctx(const Params& p, const Ctx& c, int l) {
    const int g = c.bx * 512 + c.tid, NG = c.G * 512;
    for (int i = g; i < NB_S * PAST * KVW / 4; i += NG) {
        const int e = i * 4, b = e / (PAST * KVW), r = e % (PAST * KVW);
        const size_t src = ((size_t)(b * 2 + l) * PAST) * KVW + r;
        const f32x4 k = *(const f32x4*)(p.in[I_CK] + src), v = *(const f32x4*)(p.in[I_CV] + src);
        u32x2 ko, vo; ko.x = pk2(k.x, k.y); ko.y = pk2(k.z, k.w); vo.x = pk2(v.x, v.y); vo.y = pk2(v.z, v.w);
        *(u32x2*)((bf16_t*)(p.ws + Z_KS) + (size_t)b * SKV_S * KVW + r) = ko;
        *(u32x2*)((bf16_t*)(p.ws + Z_VS) + (size_t)b * SKV_S * KVW + r) = vo;
    }
}
__device__ __forceinline__ const float* x_row(const Params& p, int l, int R) { return l == 0 ? (R < MP ? p.in[I_XP] + (size_t)R * DM : p.in[I_XS] + (size_t)(R - MP) * DM) : p.out + (size_t)R * DM; }
__device__ __forceinline__ void slab_combine(const Params& p, const Ctx& c, int l, int part, const bf16_t* slab, int R, f32x4 (&v)[4]) {
    const float* gv = mod_ptr(p, l, row_ci(R), part);
#pragma unroll
    for (int j = 0; j < 4; ++j) { const bf16_t* s = slab + ((size_t)(((R >> 8) - 64) * 4 + j) * 4 * 256 + (R & 255)) * 256 + 4 * c.lane; f32x4 a = (f32x4){0.f, 0.f, 0.f, 0.f};
#pragma unroll
        for (int q = 0; q < 4; ++q) { const u32x2 w = *(const u32x2*)(s + (size_t)q * 65536); a.x += bflo(w.x); a.y += bfhi(w.x); a.z += bflo(w.y); a.w += bfhi(w.y); }
        v[j] = v[j] + *(const f32x4*)(gv + 4 * c.lane + 256 * j) * a; }
}
__device__ __forceinline__ void p_combine(const Params& p, const Ctx& c, int l, const bf16_t* slab) {
    const int gw = c.bx * 8 + c.wave, NGW = c.G * 8;
    for (int R = 16384 + gw; R < M; R += NGW) {
        float* xr = p.out + (size_t)R * DM; f32x4 v[4];
#pragma unroll
        for (int j = 0; j < 4; ++j) v[j] = *(const f32x4*)(xr + 4 * c.lane + 256 * j);
        slab_combine(p, c, l, 5, slab, R, v);
#pragma unroll
        for (int j = 0; j < 4; ++j) *(f32x4*)(xr + 4 * c.lane + 256 * j) = v[j];
    }
}
__device__ __forceinline__ void p_norm(const Params& p, const Ctx& c, int l, int which, bool comb = false) {
    const int gw = c.bx * 8 + c.wave, NGW = c.G * 8;
    const float* gvec = (which == 0 ? p.in[I_GN1] : p.in[I_GN2]) + l * DM;
    for (int R = gw; R < M; R += NGW) {
        const float* xr = (which == 0 || (comb && l == 0 && R >= 16384)) ? x_row(p, l, R) : p.out + (size_t)R * DM;
        const int ci = row_ci(R);
        const float* sh = mod_ptr(p, l, ci, which == 0 ? 0 : 3); const float* sc = mod_ptr(p, l, ci, which == 0 ? 1 : 4);
        f32x4 v[4]; float s = 0.f;
#pragma unroll
        for (int j = 0; j < 4; ++j) v[j] = *(const f32x4*)(xr + 4 * c.lane + 256 * j);
        if (comb && R >= 16384) { slab_combine(p, c, l, 2, (const bf16_t*)(p.ws + SLAB_P4), R, v);
#pragma unroll
            for (int j = 0; j < 4; ++j) *(f32x4*)(p.out + (size_t)R * DM + 4 * c.lane + 256 * j) = v[j]; }
#pragma unroll
        for (int j = 0; j < 4; ++j) s += (v[j].x * v[j].x + v[j].y * v[j].y) + (v[j].z * v[j].z + v[j].w * v[j].w);
        const float rstd = rsqrtf(wave_sum(s) * (1.f / DM) + EPS);
        bf16_t* orow = (bf16_t*)(p.ws + WS_XN) + (size_t)R * DM;
#pragma unroll
        for (int j = 0; j < 4; ++j) { const int col = 4 * c.lane + 256 * j; const f32x4 g = *(const f32x4*)(gvec + col), a = *(const f32x4*)(sc + col), b = *(const f32x4*)(sh + col);
            f32x4 o = v[j] * rstd * g * (a + 1.0f) + b; u32x2 w; w.x = pk2(o.x, o.y); w.y = pk2(o.z, o.w); *(u32x2*)(orow + col) = w; }
    }
}
__device__ __forceinline__ void p_final_norm(const Params& p, const Ctx& c, bool comb) {
    const int gw = c.bx * 8 + c.wave, NGW = c.G * 8;
    for (int R = gw; R < M; R += NGW) {
        float* xr = p.out + (size_t)R * DM;
        f32x4 v[4]; float s = 0.f;
#pragma unroll
        for (int j = 0; j < 4; ++j) v[j] = *(const f32x4*)(xr + 4 * c.lane + 256 * j);
        if (comb && R >= 16384) slab_combine(p, c, 1, 5, (const bf16_t*)(p.ws + SLAB_P6), R, v);
#pragma unroll
        for (int j = 0; j < 4; ++j) s += (v[j].x * v[j].x + v[j].y * v[j].y) + (v[j].z * v[j].z + v[j].w * v[j].w);
        const float rstd = rsqrtf(wave_sum(s) * (1.f / DM) + EPS);
#pragma unroll
        for (int j = 0; j < 4; ++j) { const int col = 4 * c.lane + 256 * j; const f32x4 g = *(const f32x4*)(p.in[I_GFIN] + col); *(f32x4*)(xr + col) = v[j] * rstd * g; }
    }
}

struct Unit { int pm, pn, k0, nt; };
__host__ __device__ __forceinline__ int perm32(int rho) { const int n = rho >> 4, i = rho & 15; return 8 * (i >> 2) + 4 * n + (i & 3); }
struct StaticOrder {
    int nM, nN, nwg, G, c, ntf;
    __device__ void init(int Mr, int N, int G_, int c_, int K) { nM = Mr / 256; nN = N / 256; nwg = nM * nN; G = G_; c = c_; ntf = K / 64; }
    __device__ bool next(int i, Unit& u) const {
        const long L = (long)i * G + c; if (L >= nwg) return false;
        int wgid = (int)L; { const int q = nwg / 8, r = nwg % 8, xcd = wgid % 8, off = wgid / 8; wgid = (xcd < r ? xcd * (q + 1) : r * (q + 1) + (xcd - r) * q) + off; }
        const int nig = 8 * nN, gid = wgid / nig, fm = gid * 8, gsz = (nM - fm) < 8 ? (nM - fm) : 8;
        u.pm = fm + ((wgid % nig) % gsz); u.pn = (wgid % nig) / gsz; u.k0 = 0; u.nt = ntf; return true;
    }
    __device__ __forceinline__ void a_ready(const Unit&) const {}
    __device__ __forceinline__ void done(const Unit&) const {}
};
struct MergeOrder {
    int G, c;
    __device__ bool next(int i, Unit& u) const {
        const int t = i / 3, x = i % 3; const long L = (long)t * G + c; if (L >= 320) return false;
        u.pm = x * 80 + (int)(L >> 2); u.pn = x * 4 + (int)(L & 3); u.k0 = 0; u.nt = RW / 64; return true;
    }
    __device__ __forceinline__ void a_ready(const Unit&) const {}
    __device__ __forceinline__ void done(const Unit&) const {}
};
struct QuarterOrder {
    int G, c, ntf; bool quarter;
    __device__ void init(int G_, int c_, int K) { G = G_; c = c_; ntf = K / 64; quarter = (G_ == 256); }
    __device__ bool next(int i, Unit& u) const {
        if (quarter) { if (i == 0) { u.pm = c >> 2; u.pn = c & 3; u.k0 = 0; u.nt = ntf; return true; }
            if (i == 1) { const int t = 256 + (c >> 2); u.pm = t >> 2; u.pn = t & 3; u.k0 = (c & 3) * (ntf >> 2); u.nt = ntf >> 2; return true; }
            return false; }
        const long L = (long)i * G + c; if (L >= 320) return false;
        u.pm = (int)(L >> 2); u.pn = (int)(L & 3); u.k0 = 0; u.nt = ntf; return true;
    }
    __device__ __forceinline__ void a_ready(const Unit&) const {}
    __device__ __forceinline__ void done(const Unit&) const {}
};
template <class Epi, class Sched>
__device__ __forceinline__ void gemm_simple(const Ctx& c, const bf16_t* A, const bf16_t* Bt, int K, const Sched& S, const Epi& E) {
    const int tid = c.tid, wid = c.wave, lane = tid & 63, wr = wid >> 2, wc = wid & 3, fr = lane & 15, fq = lane >> 4;
    Unit u;
    for (int ui = 0; S.next(ui, u); ++ui) {
        f32x4 acc[2][2][4][2];
#pragma unroll
        for (int a = 0; a < 2; ++a)
#pragma unroll
            for (int b = 0; b < 2; ++b)
#pragma unroll
                for (int m = 0; m < 4; ++m)
#pragma unroll
                    for (int n = 0; n < 2; ++n) acc[a][b][m][n] = (f32x4){0.f, 0.f, 0.f, 0.f};
        const bf16_t* Ar = A + (size_t)(u.pm * 256 + wr * 64 + fr) * K + fq * 8;
        const bf16_t* Br[2];
#pragma unroll
        for (int n = 0; n < 2; ++n) Br[n] = Bt + (size_t)(u.pn * 256 + wc * 32 + (Epi::PERM ? perm32(16 * n + fr) : 16 * n + fr)) * K + fq * 8;
#pragma unroll 1
        for (int k0 = u.k0 * 64; k0 < (u.k0 + u.nt) * 64; k0 += 32) {
            bf16x8 tf[2][4], wf[2][2];
#pragma unroll
            for (int ai = 0; ai < 2; ++ai)
#pragma unroll
                for (int m = 0; m < 4; ++m) tf[ai][m] = *(const bf16x8*)(Ar + (size_t)(ai * 128 + m * 16) * K + k0);
#pragma unroll
            for (int bj = 0; bj < 2; ++bj)
#pragma unroll
                for (int n = 0; n < 2; ++n) wf[bj][n] = *(const bf16x8*)(Br[n] + (size_t)(bj * 128) * K + k0);
#pragma unroll
            for (int ai = 0; ai < 2; ++ai)
#pragma unroll
                for (int bj = 0; bj < 2; ++bj)
#pragma unroll
                    for (int m = 0; m < 4; ++m)
#pragma unroll
                        for (int n = 0; n < 2; ++n) acc[ai][bj][m][n] = __builtin_amdgcn_mfma_f32_16x16x32_bf16(wf[bj][n], tf[ai][m], acc[ai][bj][m][n], 0, 0, 0);
        }
        E(acc, u, wr, wc, fr, fq);
    }
}

namespace pg8 {
#define PG8_LAS __attribute__((address_space(3)))
constexpr int BM = 256, BK = 64, HALF = 128, HTB = HALF * BK * 2  , STAGE_BYTES = 8 * HTB, NXCD = 8, WGM = 8;

__host__ __device__ __forceinline__ int lds_byte(int r, int c) { const int st = (r >> 4) * 2 + (c >> 5), rr = r & 15, cc = c & 31, ob = rr * 64 + cc * 2; return st * 1024 + (ob ^ (((ob >> 9) & 1) << 5)); }
__host__ __device__ __forceinline__ void stage_rc(int b, int& R, int& C) { const int st = b / 1024, sb = b % 1024, swz = sb ^ (((sb >> 9) & 1) << 5); R = (st >> 1) * 16 + swz / 64; C = (st & 1) * 32 + (swz % 64) / 2; }
struct Gemm { const bf16_t* A; const bf16_t* Bt; int M, N, K; };
template <class Epi, class Sched, bool ALIGN_EPI = false, bool SP2 = false>
__device__ __forceinline__ void gemm_phase(int tid_in, PG8_LAS unsigned char* lds, const Gemm g, const Sched& S, const Epi& E) {
    const int tid = tid_in, wid = __builtin_amdgcn_readfirstlane(tid >> 6), lane = tid & 63, wr = wid >> 2, wc = wid & 3, fr = lane & 15, fq = lane >> 4;
    const int K = g.K;
    unsigned voffA[2], voffB[2];
#pragma unroll
    for (int i = 0; i < 2; ++i) { int R, C; stage_rc(tid * 16 + i * 8192, R, C); const int Rb = Epi::PERM ? ((R & ~31) + perm32(R & 31)) : R;
        voffA[i] = (unsigned)(R * K + C) * 2u; voffB[i] = (unsigned)(Rb * K + C) * 2u; }
    const size_t kstep = (size_t)(BK * 2);
    const size_t hstep = (size_t)HALF * K * 2;
    const size_t tstep = 2 * hstep;
    const unsigned ldsw = (unsigned)wid * 1024u;
    const int aoff = lds_byte(wr * 64 + fr, fq * 8), boff = lds_byte(wc * 32 + fr, fq * 8);
#define PG8_SA(b, h) (((b) * 2 + (h)) * HTB)
#define PG8_SB(b, h) ((4 + (b) * 2 + (h)) * HTB)
#define PG8_STAGE(bufoff, gbase, voff) do { _Pragma("unroll") for (int _i = 0; _i < 2; ++_i) \
        __builtin_amdgcn_global_load_lds((const unsigned*)((const char*)(gbase) + (voff)[_i]), (PG8_LAS unsigned*)(lds + (bufoff) + ldsw + _i * 8192), 16, 0, 0); } while (0)
#define PG8_LDA(dst, b, h) do { _Pragma("unroll") for (int m = 0; m < 4; ++m) _Pragma("unroll") for (int k = 0; k < 2; ++k) dst[m][k] = *(const PG8_LAS bf16x8*)(lds + PG8_SA(b, h) + aoff + m * 2048 + k * 1024); } while (0)
#define PG8_LDB(dst, b, h) do { _Pragma("unroll") for (int n = 0; n < 2; ++n) _Pragma("unroll") for (int k = 0; k < 2; ++k) dst[n][k] = *(const PG8_LAS bf16x8*)(lds + PG8_SB(b, h) + boff + n * 2048 + k * 1024); } while (0)
#define PG8_MMA(ai, bj, At, Bt) do { __builtin_amdgcn_s_setprio(1); _Pragma("unroll") for (int m = 0; m < 4; ++m) _Pragma("unroll") for (int n = 0; n < 2; ++n) _Pragma("unroll") for (int k = 0; k < 2; ++k) \
        acc[ai][bj][m][n] = __builtin_amdgcn_mfma_f32_16x16x32_bf16(Bt[n][k], At[m][k], acc[ai][bj][m][n], 0, 0, 0); __builtin_amdgcn_s_setprio(0); } while (0)
#define PG8_WAIT_V(n) asm volatile("s_waitcnt vmcnt(" #n ")" ::: "memory")
#define PG8_WAIT_L(n) asm volatile("s_waitcnt lgkmcnt(" #n ")" ::: "memory")
#define PG8_BAR __builtin_amdgcn_s_barrier()
#define PG8_SCHED __builtin_amdgcn_sched_barrier(0)
    Unit cur, nxt; int ui = 0;
    if (!S.next(0, cur)) return;
    f32x4 acc[2][2][4][2];
#pragma unroll
    for (int a = 0; a < 2; ++a)
#pragma unroll
        for (int b = 0; b < 2; ++b)
#pragma unroll
            for (int m = 0; m < 4; ++m)
#pragma unroll
                for (int n = 0; n < 2; ++n) acc[a][b][m][n] = (f32x4){0.f, 0.f, 0.f, 0.f};
    bf16x8 At[4][2], B0[2][2], B1[2][2];
    const char* cA = (const char*)g.A + (size_t)cur.pm * tstep + (size_t)cur.k0 * kstep; const char* cB = (const char*)g.Bt + (size_t)cur.pn * tstep + (size_t)cur.k0 * kstep;
    S.a_ready(cur);
    if constexpr (SP2) {
        PG8_STAGE(PG8_SB(0, 0), cB, voffB); PG8_STAGE(PG8_SB(0, 1), cB + hstep, voffB); PG8_STAGE(PG8_SA(0, 0), cA, voffA); PG8_STAGE(PG8_SA(0, 1), cA + hstep, voffA);
        if (wr == 1) PG8_BAR;
        PG8_WAIT_V(2); PG8_BAR;
        PG8_STAGE(PG8_SB(1, 0), cB + kstep, voffB); PG8_STAGE(PG8_SA(1, 0), cA + kstep, voffA); PG8_STAGE(PG8_SB(1, 1), cB + hstep + kstep, voffB);
        PG8_WAIT_V(6); PG8_BAR;
    } else {
        PG8_STAGE(PG8_SB(0, 0), cB, voffB); PG8_STAGE(PG8_SA(0, 0), cA, voffA); PG8_STAGE(PG8_SB(0, 1), cB + hstep, voffB); PG8_STAGE(PG8_SA(0, 1), cA + hstep, voffA);
        if (wr == 1) PG8_BAR;
        PG8_WAIT_V(4); PG8_BAR;
        PG8_STAGE(PG8_SB(1, 0), cB + kstep, voffB); PG8_STAGE(PG8_SA(1, 0), cA + kstep, voffA); PG8_STAGE(PG8_SB(1, 1), cB + hstep + kstep, voffB);
        PG8_WAIT_V(6); PG8_BAR;
    }
    for (;;) {
        const bool has_next = S.next(ui + 1, nxt);
        const char* nA = has_next ? (const char*)g.A + (size_t)nxt.pm * tstep + (size_t)nxt.k0 * kstep : cA; const char* nB = has_next ? (const char*)g.Bt + (size_t)nxt.pn * tstep + (size_t)nxt.k0 * kstep : cB;
        const int nt = cur.nt;
        for (int t = 0; t < nt; t += 2) {
            const bool last = (t == nt - 2);
            const char* a1 = cA + (size_t)(t + 1) * kstep;
            const char* a2 = last ? nA : cA + (size_t)(t + 2) * kstep; const char* b2 = last ? nB : cB + (size_t)(t + 2) * kstep;
            const char* a3 = a2 + kstep; const char* b3 = b2 + kstep;
            if (last && has_next) S.a_ready(nxt);
            if constexpr (SP2) {
            PG8_LDB(B0, 0, 0); PG8_LDB(B1, 0, 1); PG8_SCHED; PG8_LDA(At, 0, 0); PG8_STAGE(PG8_SA(1, 1), a1 + hstep, voffA);
            PG8_WAIT_V(8); PG8_WAIT_L(0); PG8_BAR; PG8_MMA(0, 0, At, B0); PG8_MMA(0, 1, At, B1); PG8_BAR; PG8_SCHED;
            PG8_LDA(At, 0, 1); PG8_STAGE(PG8_SB(0, 0), b2, voffB); PG8_STAGE(PG8_SB(0, 1), b2 + hstep, voffB); PG8_STAGE(PG8_SA(0, 0), a2, voffA);
            PG8_WAIT_V(8); PG8_WAIT_L(0); PG8_BAR; PG8_MMA(1, 0, At, B0); PG8_MMA(1, 1, At, B1); PG8_BAR; PG8_SCHED;
            PG8_LDB(B0, 1, 0); PG8_LDB(B1, 1, 1); PG8_SCHED; PG8_LDA(At, 1, 0); PG8_STAGE(PG8_SA(0, 1), a2 + hstep, voffA);
            PG8_WAIT_V(8); PG8_WAIT_L(0); PG8_BAR; PG8_MMA(0, 0, At, B0); PG8_MMA(0, 1, At, B1); PG8_BAR; PG8_SCHED;
            PG8_LDA(At, 1, 1); PG8_STAGE(PG8_SB(1, 0), b3, voffB); PG8_STAGE(PG8_SB(1, 1), b3 + hstep, voffB); PG8_STAGE(PG8_SA(1, 0), a3, voffA);
            PG8_WAIT_V(8); PG8_WAIT_L(0); PG8_BAR; PG8_MMA(1, 0, At, B0); PG8_MMA(1, 1, At, B1); PG8_BAR; PG8_SCHED;
            } else {
            PG8_LDB(B0, 0, 0); PG8_SCHED; PG8_LDA(At, 0, 0); PG8_STAGE(PG8_SA(1, 1), a1 + hstep, voffA);
            PG8_WAIT_L(8); PG8_BAR; PG8_WAIT_L(0); PG8_MMA(0, 0, At, B0); PG8_BAR; PG8_SCHED;
            PG8_LDB(B1, 0, 1); PG8_STAGE(PG8_SB(0, 0), b2, voffB);
            PG8_BAR; PG8_WAIT_L(0); PG8_MMA(0, 1, At, B1); PG8_BAR;
            PG8_LDA(At, 0, 1); PG8_STAGE(PG8_SA(0, 0), a2, voffA);
            PG8_BAR; PG8_WAIT_L(0); PG8_MMA(1, 0, At, B0); PG8_BAR; PG8_SCHED;
            PG8_STAGE(PG8_SB(0, 1), b2 + hstep, voffB);
            PG8_WAIT_V(6); PG8_BAR; PG8_MMA(1, 1, At, B1); PG8_BAR;
            PG8_LDB(B0, 1, 0); PG8_SCHED; PG8_LDA(At, 1, 0); PG8_STAGE(PG8_SA(0, 1), a2 + hstep, voffA);
            PG8_WAIT_L(8); PG8_BAR; PG8_WAIT_L(0); PG8_MMA(0, 0, At, B0); PG8_BAR; PG8_SCHED;
            PG8_LDB(B1, 1, 1); PG8_STAGE(PG8_SB(1, 0), b3, voffB);
            PG8_BAR; PG8_WAIT_L(0); PG8_MMA(0, 1, At, B1); PG8_BAR;
            PG8_LDA(At, 1, 1); PG8_STAGE(PG8_SA(1, 0), a3, voffA);
            PG8_BAR; PG8_WAIT_L(0); PG8_MMA(1, 0, At, B0); PG8_BAR; PG8_SCHED;
            PG8_STAGE(PG8_SB(1, 1), b3 + hstep, voffB);
            PG8_WAIT_V(6); PG8_BAR; PG8_MMA(1, 1, At, B1); PG8_BAR;
            }
        }
        if constexpr (ALIGN_EPI) { if (wr == 0) PG8_BAR; }
        if constexpr (!Epi::AFTER_DRAIN) { E(acc, cur, wr, wc, fr, fq); S.done(cur); }
        if (!has_next) break;
#pragma unroll
        for (int a = 0; a < 2; ++a)
#pragma unroll
            for (int b = 0; b < 2; ++b)
#pragma unroll
                for (int m = 0; m < 4; ++m)
#pragma unroll
                    for (int n = 0; n < 2; ++n) acc[a][b][m][n] = (f32x4){0.f, 0.f, 0.f, 0.f};
        cur = nxt; cA = nA; cB = nB; ++ui;
        if constexpr (ALIGN_EPI) { if (wr == 1) PG8_BAR; }
    }
    PG8_WAIT_V(0);
    if constexpr (!ALIGN_EPI) { if (wr == 0) PG8_BAR; }
    PG8_BAR;
    if constexpr (Epi::AFTER_DRAIN) { E.fused(acc, cur, wr, wc, fr, fq, lds, wid, lane); S.done(cur); }
#undef PG8_SA
#undef PG8_SB
#undef PG8_STAGE
#undef PG8_LDA
#undef PG8_LDB
#undef PG8_MMA
#undef PG8_WAIT_V
#undef PG8_WAIT_L
#undef PG8_BAR
#undef PG8_SCHED
}
}

__device__ __forceinline__ u32x4 pack8(const f32x4& a, const f32x4& b) { u32x4 w; w.x = pk2(a.x, a.y); w.y = pk2(a.z, a.w); w.z = pk2(b.x, b.y); w.w = pk2(b.z, b.w); return w; }
__device__ __forceinline__ void rope4(f32x4& v, const f32x2 cs0, const f32x2 cs1) {
    const float a0 = v.x * cs0.x - v.y * cs0.y, a1 = v.x * cs0.y + v.y * cs0.x, a2 = v.z * cs1.x - v.w * cs1.y, a3 = v.z * cs1.y + v.w * cs1.x;
    v.x = a0; v.y = a1; v.z = a2; v.w = a3;
}
struct EpiMix {
    static constexpr bool PERM = true, AFTER_DRAIN = false;
    const Params* pp; int l;
    __device__ __forceinline__ void operator()(const f32x4 (&acc)[2][2][4][2], const Unit& u, int wr, int wc, int fr, int fq) const {
        const Params& p = *pp;
        const int pn = u.pn, R0 = u.pm * 256; const bool smp = R0 >= MP;
        const int b = smp ? (R0 - MP) >> 11 : R0 >> 8, t0 = smp ? (R0 - MP) & 2047 : 0;
        const f32x2* cs_row = (const f32x2*)(p.ws + WS_ROPE); const f32x2* cs_col = cs_row + 32 * 16;
        if (pn >= 11) {
            bf16_t* dst = (bf16_t*)(p.ws + (pn < 13 ? Z_CU : Z_CV)) + ((pn - 11) & 1) * 256 + wc * 32 + 8 * fq;
#pragma unroll
            for (int ai = 0; ai < 2; ++ai)
#pragma unroll
                for (int m = 0; m < 4; ++m) { const int R = R0 + ai * 128 + wr * 64 + m * 16 + fr;
#pragma unroll
                    for (int bj = 0; bj < 2; ++bj) { f32x4 v0 = acc[ai][bj][m][0], v1 = acc[ai][bj][m][1];
#pragma unroll
                        for (int r = 0; r < 4; ++r) { v0[r] = gelu_tanh(v0[r]); v1[r] = gelu_tanh(v1[r]); }
                        *(u32x4*)(dst + (size_t)R * RW + bj * 128) = pack8(v0, v1); } }
            return;
        }
        const int kind = pn >> 1;
        const bool is_k = (pn == 10 && wc < 2), is_v = (pn == 10 && wc >= 2);
        const float* gqk = (kind == 4 ? p.in[I_GQ] : p.in[I_GK]) + l * HD + 8 * fq;
        const int head = (pn & 1) * 4 + wc;
        const bool norm = (kind == 4 || is_k), rope = smp && (kind == 0 || kind == 1 || kind == 4 || is_k);
        const float post = kind == 1 ? 0.125f : (kind == 4 ? C2 : 1.0f);
#pragma unroll
        for (int ai = 0; ai < 2; ++ai)
#pragma unroll
            for (int m = 0; m < 4; ++m) {
                const int rr = ai * 128 + wr * 64 + m * 16 + fr, R = R0 + rr, t = t0 + rr;
                float rs = 1.0f;
                if (norm) {
                    float ss = 0.f;
#pragma unroll
                    for (int bj = 0; bj < 2; ++bj)
#pragma unroll
                        for (int n = 0; n < 2; ++n) { const f32x4 x = acc[ai][bj][m][n]; ss += (x.x * x.x + x.y * x.y) + (x.z * x.z + x.w * x.w); }
                    ss += __shfl_xor(ss, 16); ss += __shfl_xor(ss, 32);
                    rs = rsqrtf(ss * (1.f / HD) + EPS);
                }
                bf16_t* dst;
                if (kind < 5) dst = (bf16_t*)(p.ws + (kind == 0 ? Z_RQ : kind == 1 ? Z_RK : kind == 2 ? Z_RV : kind == 3 ? Z_RG : Z_AQ)) + (size_t)R * RW + head * HD + 8 * fq;
                else { const int hk = wc & 1;
                    if (smp) dst = (bf16_t*)(p.ws + (is_k ? Z_KS : Z_VS)) + ((size_t)b * SKV_S + PAST + t) * KVW + hk * HD + 8 * fq;
                    else dst = (bf16_t*)(p.ws + (is_k ? Z_KP : Z_VP)) + ((size_t)b * SEQ_P + t) * KVW + hk * HD + 8 * fq; }
                float* cdst = p.out + (is_k ? OUT_CK : OUT_CV) + ((size_t)((b * 2 + l) * SEQ_P + t) * 2 + (wc & 1)) * HD + 8 * fq;
#pragma unroll
                for (int bj = 0; bj < 2; ++bj) {
                    f32x4 v0 = acc[ai][bj][m][0], v1 = acc[ai][bj][m][1];
                    if (norm) { const f32x4 g0 = *(const f32x4*)(gqk + 32 * bj), g1 = *(const f32x4*)(gqk + 32 * bj + 4); v0 = v0 * rs * g0; v1 = v1 * rs * g1; }
                    if (pn == 10 && !smp) { *(f32x4*)(cdst + 32 * bj) = v0; *(f32x4*)(cdst + 32 * bj + 4) = v1; }
                    if (kind == 3) {
#pragma unroll
                        for (int r = 0; r < 4; ++r) { v0[r] = siluf_(v0[r]); v1[r] = siluf_(v1[r]); } }
                    if (rope) {
                        const f32x2* tab = (bj == 0 ? cs_row + (t >> 6) * 16 : cs_col + (t & 63) * 16) + 4 * fq;
                        rope4(v0, tab[0], tab[1]); rope4(v1, tab[2], tab[3]); }
                    v0 = v0 * post; v1 = v1 * post;
                    *(u32x4*)(dst + 32 * bj) = pack8(v0, v1);
                    asm volatile("" ::: "memory");
                }
            }
    }
};
struct EpiGate {
    static constexpr bool PERM = true, AFTER_DRAIN = false;
    const Params* pp;
    __device__ __forceinline__ void operator()(const f32x4 (&acc)[2][2][4][2], const Unit& u, int wr, int wc, int fr, int fq) const {
        const int x = u.pn >> 2; bf16_t* dst = (bf16_t*)(pp->ws + Z_GATE) + (size_t)x * M * DM + (u.pn & 3) * 256 + wc * 32 + 8 * fq;
#pragma unroll
        for (int ai = 0; ai < 2; ++ai)
#pragma unroll
            for (int m = 0; m < 4; ++m) { const int R = u.pm * 256 + ai * 128 + wr * 64 + m * 16 + fr;
#pragma unroll
                for (int bj = 0; bj < 2; ++bj) { f32x4 v0 = acc[ai][bj][m][0], v1 = acc[ai][bj][m][1];
#pragma unroll
                    for (int r = 0; r < 4; ++r) { v0[r] = sigmoidf_(v0[r]); v1[r] = sigmoidf_(v1[r]); }
                    *(u32x4*)(dst + (size_t)R * DM + bj * 128) = pack8(v0, v1); } }
    }
};
struct EpiMerge {
    static constexpr bool PERM = true, AFTER_DRAIN = false;
    const Params* pp;
    __device__ __forceinline__ void operator()(const f32x4 (&acc)[2][2][4][2], const Unit& u, int wr, int wc, int fr, int fq) const {
        const int x = u.pn >> 2, pm = u.pm - 80 * x, gi = x == 0 ? 1 : x == 1 ? 2 : 0;
        const int col0 = (u.pn & 3) * 256 + wc * 32 + 8 * fq;
        const bf16_t* gate = (const bf16_t*)(pp->ws + Z_GATE) + (size_t)gi * M * DM + col0; bf16_t* dst = (bf16_t*)(pp->ws + WS_XN) + col0;
#pragma unroll
        for (int ai = 0; ai < 2; ++ai)
#pragma unroll
            for (int m = 0; m < 4; ++m) { const int R = pm * 256 + ai * 128 + wr * 64 + m * 16 + fr;
#pragma unroll
                for (int bj = 0; bj < 2; ++bj) { f32x4 v0 = acc[ai][bj][m][0], v1 = acc[ai][bj][m][1];
                    const u32x4 g = *(const u32x4*)(gate + (size_t)R * DM + bj * 128);
                    v0.x *= bflo(g.x); v0.y *= bfhi(g.x); v0.z *= bflo(g.y); v0.w *= bfhi(g.y); v1.x *= bflo(g.z); v1.y *= bfhi(g.z); v1.z *= bflo(g.w); v1.w *= bfhi(g.w);
                    if (x != 0) { const u32x4 o = *(const u32x4*)(dst + (size_t)R * DM + bj * 128);
                        v0.x += bflo(o.x); v0.y += bfhi(o.x); v0.z += bflo(o.y); v0.w += bfhi(o.y); v1.x += bflo(o.z); v1.y += bfhi(o.z); v1.z += bflo(o.w); v1.w += bfhi(o.w); }
                    *(u32x4*)(dst + (size_t)R * DM + bj * 128) = pack8(v0, v1); } }
    }
};
struct EpiRes {
    static constexpr bool PERM = false, AFTER_DRAIN = false;
    const Params* pp; int l, part; bool from_inputs; int ntf; bf16_t* slab;
    __device__ __forceinline__ void operator()(const f32x4 (&acc)[2][2][4][2], const Unit& u, int wr, int wc, int fr, int fq) const {
        const Params& p = *pp; const int R0 = u.pm * 256; const int ci = row_ci(R0);
        if (u.nt != ntf) {
            bf16_t* s = slab + ((size_t)((u.pm * 4 + u.pn - 256) * 4 + u.k0 / u.nt) * 256) * 256 + wc * 32 + 4 * fq;
#pragma unroll
            for (int ai = 0; ai < 2; ++ai)
#pragma unroll
                for (int m = 0; m < 4; ++m) { const int rr = ai * 128 + wr * 64 + m * 16 + fr;
#pragma unroll
                    for (int bj = 0; bj < 2; ++bj)
#pragma unroll
                        for (int n = 0; n < 2; ++n) { const f32x4 v = acc[ai][bj][m][n]; u32x2 w; w.x = pk2(v.x, v.y); w.y = pk2(v.z, v.w); *(u32x2*)(s + (size_t)rr * 256 + bj * 128 + n * 16) = w; } }
            return;
        }
        const float* gv = mod_ptr(p, l, ci, part) + u.pn * 256 + wc * 32 + 4 * fq;
        f32x4 g[2][2];
#pragma unroll
        for (int bj = 0; bj < 2; ++bj)
#pragma unroll
            for (int n = 0; n < 2; ++n) g[bj][n] = *(const f32x4*)(gv + bj * 128 + n * 16);
#pragma unroll
        for (int ai = 0; ai < 2; ++ai)
#pragma unroll
            for (int m = 0; m < 4; ++m) { const int R = R0 + ai * 128 + wr * 64 + m * 16 + fr;
                const float* xs = (from_inputs ? x_row(p, 0, R) : p.out + (size_t)R * DM) + u.pn * 256 + wc * 32 + 4 * fq;
                float* xo = p.out + (size_t)R * DM + u.pn * 256 + wc * 32 + 4 * fq;
#pragma unroll
                for (int bj = 0; bj < 2; ++bj)
#pragma unroll
                    for (int n = 0; n < 2; ++n) { const f32x4 xv = *(const f32x4*)(xs + bj * 128 + n * 16); *(f32x4*)(xo + bj * 128 + n * 16) = xv + g[bj][n] * acc[ai][bj][m][n]; } }
    }
};
struct EpiFF1 {
    static constexpr bool PERM = true, AFTER_DRAIN = false;
    const Params* pp;
    __device__ __forceinline__ void operator()(const f32x4 (&acc)[2][2][4][2], const Unit& u, int wr, int wc, int fr, int fq) const {
        bf16_t* dst = (bf16_t*)(pp->ws + Z_HB) + u.pn * 256 + wc * 32 + 8 * fq;
#pragma unroll
        for (int ai = 0; ai < 2; ++ai)
#pragma unroll
            for (int m = 0; m < 4; ++m) { const int R = u.pm * 256 + ai * 128 + wr * 64 + m * 16 + fr;
#pragma unroll
                for (int bj = 0; bj < 2; ++bj) { f32x4 v0 = acc[ai][bj][m][0], v1 = acc[ai][bj][m][1];
#pragma unroll
                    for (int r = 0; r < 4; ++r) { const float a = fmaxf(v0[r], 0.f), b = fmaxf(v1[r], 0.f); v0[r] = a * a; v1[r] = b * b; }
                    *(u32x4*)(dst + (size_t)R * DFF + bj * 128) = pack8(v0, v1); } }
    }
};

namespace attn_body {
using bf16=__hip_bfloat16;
using bf16x8=__attribute__((ext_vector_type(8)))short;
using s16x4=__attribute__((ext_vector_type(4)))short;
using f32x16=__attribute__((ext_vector_type(16)))float;
using u32x4=__attribute__((ext_vector_type(4)))unsigned;
constexpr int D=64,QP=512,KP=128;
constexpr int NW=8,QBLK=32,QB=QBLK*NW,KVBLK=64;
__device__ __forceinline__ int crow(int r,int hi){return (r&3)+8*(r>>2)+4*hi;}
#define SBAR() __builtin_amdgcn_sched_barrier(0)
constexpr int NSLOT=3, SLOTB=8192;
constexpr int LDS_K=0, LDS_V=NSLOT*SLOTB, LDS_WS=2*NSLOT*SLOTB, LDS_OST=LDS_WS+NW*64*4, LDS_BYTES=LDS_OST+NW*4096;
constexpr float C2=0.125f*1.4426950408889634f;
__device__ __forceinline__ void glds16(const void*gsrc,unsigned lds_dst){unsigned keep;
  asm volatile("s_mov_b32 %0, m0\n\ts_mov_b32 m0, %2\n\ts_nop 0\n\tglobal_load_lds_dwordx4 %1, off\n\ts_mov_b32 m0, %0":"=&s"(keep):"v"(gsrc),"s"(lds_dst):"memory");}
__device__ __forceinline__ float max3f(float a,float b,float c){float r;asm("v_max3_f32 %0, %1, %2, %3":"=v"(r):"v"(a),"v"(b),"v"(c));return r;}
__device__ __forceinline__ float max2f(float a,float b){float r;asm("v_max_f32_e32 %0, %1, %2":"=v"(r):"v"(a),"v"(b));return r;}
__device__ __forceinline__ float fadd_s(float a,float b){float r;asm("v_add_f32_e32 %0, %1, %2":"=v"(r):"v"(a),"v"(b));return r;}
__device__ __forceinline__ float fsub_s(float a,float b){float r;asm("v_sub_f32_e32 %0, %1, %2":"=v"(r):"v"(a),"v"(b));return r;}
typedef float f32x2_t __attribute__((ext_vector_type(2))); typedef __bf16 bf16x2_t __attribute__((ext_vector_type(2)));
__device__ __forceinline__ unsigned cvtpk_s(float lo,float hi){f32x2_t v={lo,hi};bf16x2_t b=__builtin_convertvector(v,bf16x2_t);return __builtin_bit_cast(unsigned,b);}
#define WAIT_BAR(N) asm volatile("s_waitcnt vmcnt(" #N ") lgkmcnt(0)\n\ts_barrier":::"memory")

__device__ __forceinline__ void qkt(f32x16&p0,f32x16&p1,const char*Kslot,const bf16x8*qr,const f32x16&negm,int r32,int hi){
  const char*kb=Kslot+hi*1024+r32*16;
  #pragma unroll
  for(int d0=0;d0<4;++d0){
    const bf16x8 b0=*reinterpret_cast<const bf16x8*>(kb+d0*2048);
    const bf16x8 b1=*reinterpret_cast<const bf16x8*>(kb+d0*2048+512);
    if(d0==0){p0=__builtin_amdgcn_mfma_f32_32x32x16_bf16(b0,qr[0],negm,0,0,0);p1=__builtin_amdgcn_mfma_f32_32x32x16_bf16(b1,qr[0],negm,0,0,0);}
    else{p0=__builtin_amdgcn_mfma_f32_32x32x16_bf16(b0,qr[d0],p0,0,0,0);p1=__builtin_amdgcn_mfma_f32_32x32x16_bf16(b1,qr[d0],p1,0,0,0);}}
}
typedef __attribute__((address_space(3))) const char* lds_cptr;
typedef short v4i16_t __attribute__((ext_vector_type(4)));
__device__ __forceinline__ void kload8(bf16x8*kf,lds_cptr kp){
  kf[0]=*(const __attribute__((address_space(3))) bf16x8*)(kp);      kf[1]=*(const __attribute__((address_space(3))) bf16x8*)(kp+512);
  kf[2]=*(const __attribute__((address_space(3))) bf16x8*)(kp+2048); kf[3]=*(const __attribute__((address_space(3))) bf16x8*)(kp+2560);
  kf[4]=*(const __attribute__((address_space(3))) bf16x8*)(kp+4096); kf[5]=*(const __attribute__((address_space(3))) bf16x8*)(kp+4608);
  kf[6]=*(const __attribute__((address_space(3))) bf16x8*)(kp+6144); kf[7]=*(const __attribute__((address_space(3))) bf16x8*)(kp+6656);
}
__device__ __forceinline__ void kload2(bf16x8*kf,lds_cptr kp,int j){ kf[2*j]=*(const __attribute__((address_space(3))) bf16x8*)(kp+j*2048); kf[2*j+1]=*(const __attribute__((address_space(3))) bf16x8*)(kp+j*2048+512); }
__device__ __forceinline__ s16x4 vtr(lds_cptr p){ return __builtin_bit_cast(s16x4,__builtin_amdgcn_ds_read_tr16_b64_v4i16((__attribute__((address_space(3))) v4i16_t*)p)); }
__device__ __forceinline__ float rowmax(const f32x16&p0,const f32x16&p1){
  float a=max3f(p0[0],p0[1],p1[0]),b=max3f(p0[2],p0[3],p1[1]);a=max3f(a,p1[2],p1[3]);
  #pragma unroll
  for(int r=4;r<16;r+=4){a=max3f(a,p0[r],p0[r+1]);b=max3f(b,p0[r+2],p0[r+3]);a=max3f(a,p1[r],p1[r+1]);b=max3f(b,p1[r+2],p1[r+3]);}
  const float m=max2f(a,b);
  auto rr=__builtin_amdgcn_permlane32_swap(__float_as_uint(m),__float_as_uint(m),false,false);
  return max2f(__uint_as_float(rr[0]),__uint_as_float(rr[1]));
}
__device__ __forceinline__ void pv(f32x16*o,int vb,bf16x8 pa0,bf16x8 pa1,bf16x8 pa2,bf16x8 pa3){
  #pragma unroll
  for(int d0=0;d0<2;++d0){s16x4 lo[4],hi[4];
    #pragma unroll
    for(int ks=0;ks<4;++ks){
      asm volatile("ds_read_b64_tr_b16 %0,%1 offset:%c2":"=&v"(lo[ks]):"v"(vb),"i"(d0*4096+ks*1024):"memory");
      asm volatile("ds_read_b64_tr_b16 %0,%1 offset:%c2":"=&v"(hi[ks]):"v"(vb),"i"(d0*4096+ks*1024+512):"memory");}
    asm volatile("s_waitcnt lgkmcnt(0)":::"memory");SBAR();
    #define PK(k) (bf16x8){lo[k][0],lo[k][1],lo[k][2],lo[k][3],hi[k][0],hi[k][1],hi[k][2],hi[k][3]}
    o[d0]=__builtin_amdgcn_mfma_f32_32x32x16_bf16(pa0,PK(0),o[d0],0,0,0);
    o[d0]=__builtin_amdgcn_mfma_f32_32x32x16_bf16(pa1,PK(1),o[d0],0,0,0);
    o[d0]=__builtin_amdgcn_mfma_f32_32x32x16_bf16(pa2,PK(2),o[d0],0,0,0);
    o[d0]=__builtin_amdgcn_mfma_f32_32x32x16_bf16(pa3,PK(3),o[d0],0,0,0);
    #undef PK
  }
}

#ifndef ATTN_STORE16
#define ATTN_STORE16(p,v) (*(u32x4*)(p)=(v))
#endif
template<int THRL> __device__ __forceinline__ void attn_unit(int tid,const bf16*Qu,const bf16*__restrict__ Kh,const bf16*__restrict__ Vh,bf16*Ou,const int NT,char*shm){
  const int lane=tid&63,r32=lane&31,hi=lane>>5; const int wid=__builtin_amdgcn_readfirstlane(tid>>6);
  const bf16*Qw=Qu+(long)(wid*QBLK)*QP;
  const unsigned lds0=(unsigned)(uintptr_t)shm;
  float*wsf=(float*)(shm+LDS_WS)+wid*64;
  const bf16*ksrc=Kh+(long)lane*KP+wid*8;
  const bf16*vsrc=Vh+(long)(16*(wid&3)+(lane>>2))*KP+(wid>>2)*32+(lane&3)*8;
  const unsigned kdst=lds0+LDS_K+wid*1024, vdst=lds0+LDS_V+wid*1024;
  #define DMA_K(t,slot) glds16(ksrc+(long)(t)*KVBLK*KP,(unsigned)__builtin_amdgcn_readfirstlane(kdst+(slot)))
  #define DMA_V(t,slot) glds16(vsrc+(long)(t)*KVBLK*KP,(unsigned)__builtin_amdgcn_readfirstlane(vdst+(slot)))
  const int vb0=(int)(lds0+LDS_V)+((lane>>4)&1)*32+(lane&3)*8+(4*hi+((lane&15)>>2))*64;
  const char*Kbase=shm+LDS_K; bf16x8 kf[8];
  const lds_cptr shm3=(lds_cptr)shm; const lds_cptr kp0=shm3+LDS_K+hi*1024+r32*16; const lds_cptr vp0=shm3+LDS_V+((lane>>4)&1)*32+(lane&3)*8+(4*hi+((lane&15)>>2))*64;
  DMA_K(0,0);DMA_V(0,0);DMA_K(1,SLOTB);
  bf16x8 qr[4];
  #pragma unroll
  for(int d0=0;d0<4;++d0)qr[d0]=*reinterpret_cast<const bf16x8*>(&Qw[(long)r32*QP+d0*16+hi*8]);
  float zf_=0.f;asm volatile("":"+v"(zf_));
  float mhat=zf_,l_reg=zf_;f32x16 o[2],negm;
  #pragma unroll
  for(int r=0;r<16;++r){o[0][r]=zf_;o[1][r]=zf_;negm[r]=zf_;}
  asm volatile("":"+v"(negm));
  #define CMASK(P0,P1,t) do{}while(0)
  bool resc=false;
  #define START(P0,P1) do{ const float rm=rowmax(P0,P1); resc=false; \
    { const float dl=rm; mhat=fadd_s(mhat,dl); \
      _Pragma("unroll") for(int r=0;r<16;++r){P0[r]=fsub_s(P0[r],dl);P1[r]=fsub_s(P1[r],dl);} \
      _Pragma("unroll") for(int r=0;r<16;++r)negm[r]=-mhat; asm volatile("":"+v"(negm)); } \
    _Pragma("unroll") for(int r=0;r<16;++r)P0[r]=__builtin_amdgcn_exp2f(P0[r]); }while(0)
  #define RESC() do{ if(resc){ asm volatile("s_waitcnt lgkmcnt(0)":::"memory"); \
      _Pragma("unroll") for(int d_=0;d_<2;++d_) _Pragma("unroll") for(int r=0;r<16;++r)o[d_][r]*=wsf[crow(r,hi)]; } }while(0)
  f32x16 pA0,pA1,pB0,pB1;
  int sl_prev=0,sl_cur=0,sl_next=SLOTB;
  #define ROT() do{sl_prev=sl_cur;sl_cur=sl_next;sl_next=(sl_next==(NSLOT-1)*SLOTB)?0:sl_next+SLOTB;}while(0)
  DMA_K(2,2*SLOTB);
  WAIT_BAR(3);
  qkt(pA0,pA1,Kbase,qr,negm,r32,hi);asm volatile("s_nop 15\n\ts_nop 7":"+v"(pA0),"+v"(pA1));CMASK(pA0,pA1,0);
  START(pA0,pA1);
  _Pragma("unroll") for(int r=0;r<16;++r)pA1[r]=__builtin_amdgcn_exp2f(pA1[r]);
  WAIT_BAR(0);
  DMA_K(3,0);DMA_V(1,SLOTB);
  ROT();
  kload8(kf,kp0+sl_cur);
  WAIT_BAR(2);
  s16x4 vlo[8],vhi[8]; u32x4 pw0,pw1,pw2,pw3;
  #define PKW(P,B) cvtpk_s(P[B],P[B+1])
  #define PAF(k) __builtin_bit_cast(bf16x8,pw##k)
  #define VFR(i) (bf16x8){vlo[i][0],vlo[i][1],vlo[i][2],vlo[i][3],vhi[i][0],vhi[i][1],vhi[i][2],vhi[i][3]}
  #define PIN(x) asm volatile("":"+v"(x))
  #define MX3(a,b,c) __builtin_fmaxf(__builtin_fmaxf((a),(b)),(c))
  #define GAPA(MF,A0,A1,A2,A3,W0,W1,PW) do{ MF; sacc+=A0; sacc+=A1; sacc+=A2; sacc+=A3; PIN(sacc); W0; W1; PIN(PW); SBAR(); }while(0)
  #define EX(v) __builtin_amdgcn_exp2f(v)
  #define GAPB(MF,X,B) do{ MF; X[B]=EX(X[B]); X[B+1]=EX(X[B+1]); X[B+2]=EX(X[B+2]); X[B+3]=EX(X[B+3]); PIN(X); SBAR(); }while(0)
  #define VRD(i) do{ vlo[i]=vtr(vp_+(((i)>>2)*4096+((i)&3)*1024)); vhi[i]=vtr(vp_+(((i)>>2)*4096+((i)&3)*1024+512)); }while(0)
  #define KRD(G,j) do{ if(G){ kload2(kf,kp0+sl_next,j); SBAR(); } }while(0)
  #define STEP(C0,C1,P0,P1,t,GK,GV,GL) do{ SBAR(); \
    const lds_cptr vp_=vp0+sl_prev; \
    VRD(0); SBAR(); float sacc=(P0[0]+P0[1]); \
    GAPA(C0=__builtin_amdgcn_mfma_f32_32x32x16_bf16(kf[0],qr[0],negm,0,0,0), P0[2],P0[3],P0[4],P0[5],     pw0[0]=PKW(P0,0), pw0[1]=PKW(P0,2), pw0); \
    VRD(4); SBAR(); GAPA(C1=__builtin_amdgcn_mfma_f32_32x32x16_bf16(kf[1],qr[0],negm,0,0,0), P0[6],P0[7],P0[8],P0[9],     pw0[2]=PKW(P0,4), pw0[3]=PKW(P0,6), pw0); \
    VRD(1); SBAR(); GAPA(C0=__builtin_amdgcn_mfma_f32_32x32x16_bf16(kf[2],qr[1],C0,0,0,0),   P0[10],P0[11],P0[12],P0[13], pw1[0]=PKW(P0,8), pw1[1]=PKW(P0,10), pw1); \
    VRD(5); SBAR(); GAPA(C1=__builtin_amdgcn_mfma_f32_32x32x16_bf16(kf[3],qr[1],C1,0,0,0),   P0[14],P0[15],P1[0],P1[1],   pw1[2]=PKW(P0,12),pw1[3]=PKW(P0,14), pw1); \
    VRD(2); SBAR(); GAPA(C0=__builtin_amdgcn_mfma_f32_32x32x16_bf16(kf[4],qr[2],C0,0,0,0),   P1[2],P1[3],P1[4],P1[5],     pw2[0]=PKW(P1,0), pw2[1]=PKW(P1,2), pw2); \
    VRD(6); SBAR(); GAPA(C1=__builtin_amdgcn_mfma_f32_32x32x16_bf16(kf[5],qr[2],C1,0,0,0),   P1[6],P1[7],P1[8],P1[9],     pw2[2]=PKW(P1,4), pw2[3]=PKW(P1,6), pw2); \
    VRD(3); SBAR(); GAPA(C0=__builtin_amdgcn_mfma_f32_32x32x16_bf16(kf[6],qr[3],C0,0,0,0),   P1[10],P1[11],P1[12],P1[13], pw3[0]=PKW(P1,8), pw3[1]=PKW(P1,10), pw3); \
    VRD(7); SBAR(); GAPA(C1=__builtin_amdgcn_mfma_f32_32x32x16_bf16(kf[7],qr[3],C1,0,0,0),   P1[14],P1[15],0.f,0.f,       pw3[2]=PKW(P1,12),pw3[3]=PKW(P1,14), pw3); \
    l_reg+=sacc; \
    if(GK){DMA_K((t)+3,sl_cur);} if(GV){DMA_V((t)+1,sl_next);} \
    CMASK(C0,C1,t); \
    { float a=MX3(C0[0],C0[1],C1[0]),b=MX3(C0[2],C0[3],C1[1]); a=MX3(a,C1[2],C1[3]); \
      _Pragma("unroll") for(int r=4;r<16;r+=4){a=MX3(a,C0[r],C0[r+1]);b=MX3(b,C0[r+2],C0[r+3]);a=MX3(a,C1[r],C1[r+1]);b=MX3(b,C1[r+2],C1[r+3]);} \
      float rm=__builtin_fmaxf(a,b); { auto rr=__builtin_amdgcn_permlane32_swap(__float_as_uint(rm),__float_as_uint(rm),false,false); rm=__builtin_fmaxf(__uint_as_float(rr[0]),__uint_as_float(rr[1])); } \
      resc=false; \
      if(__builtin_expect(__any(rm>(float)THRL),0)){ const float dl=__builtin_fmaxf(rm,0.f); mhat+=dl; \
        _Pragma("unroll") for(int r=0;r<16;++r){C0[r]-=dl;C1[r]-=dl;} \
        _Pragma("unroll") for(int r=0;r<16;++r)negm[r]=-mhat; asm volatile("":"+v"(negm)); \
        const float f=__builtin_amdgcn_exp2f(-dl); l_reg*=f; if(hi==0)wsf[r32]=f; resc=true; } } \
    SBAR(); \
    GAPB(o[0]=__builtin_amdgcn_mfma_f32_32x32x16_bf16(PAF(0),VFR(0),o[0],0,0,0), C0,0); \
    GAPB(o[1]=__builtin_amdgcn_mfma_f32_32x32x16_bf16(PAF(0),VFR(4),o[1],0,0,0), C0,4); \
    KRD(GL,0); GAPB(o[0]=__builtin_amdgcn_mfma_f32_32x32x16_bf16(PAF(1),VFR(1),o[0],0,0,0), C0,8); \
    KRD(GL,1); GAPB(o[1]=__builtin_amdgcn_mfma_f32_32x32x16_bf16(PAF(1),VFR(5),o[1],0,0,0), C0,12); \
    KRD(GL,2); GAPB(o[0]=__builtin_amdgcn_mfma_f32_32x32x16_bf16(PAF(2),VFR(2),o[0],0,0,0), C1,0); \
    KRD(GL,3); GAPB(o[1]=__builtin_amdgcn_mfma_f32_32x32x16_bf16(PAF(2),VFR(6),o[1],0,0,0), C1,4); \
    GAPB(o[0]=__builtin_amdgcn_mfma_f32_32x32x16_bf16(PAF(3),VFR(3),o[0],0,0,0), C1,8); \
    GAPB(o[1]=__builtin_amdgcn_mfma_f32_32x32x16_bf16(PAF(3),VFR(7),o[1],0,0,0), C1,12); \
    }while(0)
  int t=1;
  for(;t+5<NT;t+=2){
    STEP(pB0,pB1,pA0,pA1,t,true,true,true);     WAIT_BAR(2); RESC(); ROT();
    STEP(pA0,pA1,pB0,pB1,t+1,true,true,true);   WAIT_BAR(2); RESC(); ROT();
  }
  #define ENDW(tt) do{ if((tt)+3<NT){WAIT_BAR(2);} else if((tt)+2<NT){WAIT_BAR(1);} else {WAIT_BAR(0);} }while(0)
  for(;t+1<NT;t+=2){
    STEP(pB0,pB1,pA0,pA1,t,(t+3<NT),(t+1<NT),(t+1<NT));       ENDW(t);   RESC(); ROT();
    STEP(pA0,pA1,pB0,pB1,t+1,(t+4<NT),(t+2<NT),(t+2<NT));     ENDW(t+1); RESC(); ROT();
  }
  STEP(pB0,pB1,pA0,pA1,NT-1,false,false,false); RESC();
  { float sacc=pB0[0]+pB0[1]; _Pragma("unroll") for(int r=2;r<16;++r)sacc+=pB0[r]; _Pragma("unroll") for(int r=0;r<16;++r)sacc+=pB1[r]; l_reg+=sacc;
    pw0=(u32x4){PKW(pB0,0),PKW(pB0,2),PKW(pB0,4),PKW(pB0,6)};pw1=(u32x4){PKW(pB0,8),PKW(pB0,10),PKW(pB0,12),PKW(pB0,14)};pw2=(u32x4){PKW(pB1,0),PKW(pB1,2),PKW(pB1,4),PKW(pB1,6)};pw3=(u32x4){PKW(pB1,8),PKW(pB1,10),PKW(pB1,12),PKW(pB1,14)};
    SBAR(); pv(o,vb0+sl_cur,PAF(0),PAF(1),PAF(2),PAF(3)); }
  #undef PKW
  #undef PAF
  #undef VFR
  #undef PIN
  #undef MX3
  #undef GAPA
  #undef GAPB
  #undef EX
  #undef VRD
  #undef KRD
  #undef STEP
  #undef ENDW
  {auto rr=__builtin_amdgcn_permlane32_swap(__float_as_uint(l_reg),__float_as_uint(l_reg),false,false);l_reg=__uint_as_float(rr[0])+__uint_as_float(rr[1]);}
  if(hi==0)wsf[32+r32]=l_reg;asm volatile("s_waitcnt lgkmcnt(0)":::"memory");
  float rli[16];
  #pragma unroll
  for(int r=0;r<16;++r)rli[r]=__builtin_amdgcn_rcpf(wsf[32+crow(r,hi)]);
  bf16*Ow=Ou+(long)(wid*QBLK)*QP;
  { bf16*stg=(bf16*)(shm+LDS_OST)+wid*2048;
    #pragma unroll
    for(int r=0;r<16;++r){const int orow=crow(r,hi);
      #pragma unroll
      for(int d0=0;d0<2;++d0)stg[orow*64+d0*32+r32]=__float2bfloat16(o[d0][r]*rli[r]);}
    asm volatile("s_waitcnt lgkmcnt(0)":::"memory");
    #pragma unroll
    for(int i=0;i<4;++i){const int row=i*8+(lane>>3),ch=lane&7; const u32x4 v=*(const u32x4*)(stg+row*64+ch*8); ATTN_STORE16(Ow+(long)row*QP+ch*8,v);} }
  asm volatile("s_waitcnt lgkmcnt(0)\n\ts_barrier":::"memory");
  #undef DMA_K
  #undef DMA_V
  #undef CMASK
  #undef START
  #undef RESC
  #undef ROT
}
constexpr int ATTN_LDS_BYTES=LDS_BYTES;
#undef SBAR
#undef WAIT_BAR
}
#ifndef ATTN_FAST
#define ATTN_FAST 1
#endif
__device__ __forceinline__ void attn_fast(const Params& p, const Ctx& c) {
    typedef attn_body::bf16 abf;
    const int vcu = (c.G % 8 == 0) ? (c.bx % 8) * (c.G / 8) + c.bx / 8 : c.bx;
    for (int u = vcu; u < 512 + 128; u += c.G) {
        const abf *Qu, *Kh, *Vh; int NT;
        if (u < 512) { const int qb = u & 7, hq = (u >> 3) & 3, hk = (u >> 5) & 1, b = u >> 6, h = hk * 4 + hq;
            Qu = (const abf*)(p.ws + Z_AQ) + ((size_t)MP + (size_t)b * SEQ_S + qb * 256) * RW + h * HD;
            Kh = (const abf*)(p.ws + Z_KS) + (size_t)b * SKV_S * KVW + hk * HD; Vh = (const abf*)(p.ws + Z_VS) + (size_t)b * SKV_S * KVW + hk * HD; NT = SKV_S / 64; }
        else { const int v = u - 512, hq = v & 3, hk = (v >> 2) & 1, b = v >> 3, h = hk * 4 + hq;
            Qu = (const abf*)(p.ws + Z_AQ) + ((size_t)b * SEQ_P) * RW + h * HD;
            Kh = (const abf*)(p.ws + Z_KP) + (size_t)b * SEQ_P * KVW + hk * HD; Vh = (const abf*)(p.ws + Z_VP) + (size_t)b * SEQ_P * KVW + hk * HD; NT = SKV_P / 64; }
        attn_body::attn_unit<8>(c.tid, Qu, Kh, Vh, (abf*)Qu, NT, (char*)c.lds);
    }
    __syncthreads();
}

__device__ __forceinline__ void attn_simple(const Params& p, const Ctx& c) {
    LAS float* Kt = (LAS float*)c.lds; LAS float* Vt = Kt + 32 * 64; LAS float* Sc = Vt + 32 * 64;
    constexpr int NU_S = NB_S * NH * 4, NU_P = NB_P * NH;
    for (int u = c.bx; u < NU_S + NU_P; u += c.G) {
        const bool smp = u < NU_S; int b, h, q0, nq, skv; const bf16_t *Kb, *Vb; size_t rowbase;
        if (smp) { b = u / 32; h = (u / 4) & 7; q0 = (u & 3) * 512; nq = 512; skv = SKV_S; Kb = (const bf16_t*)(p.ws + Z_KS) + (size_t)b * SKV_S * KVW; Vb = (const bf16_t*)(p.ws + Z_VS) + (size_t)b * SKV_S * KVW; rowbase = MP + (size_t)b * SEQ_S + q0; }
        else { const int v = u - NU_S; b = v / 8; h = v & 7; q0 = 0; nq = 256; skv = SKV_P; Kb = (const bf16_t*)(p.ws + Z_KP) + (size_t)b * SEQ_P * KVW; Vb = (const bf16_t*)(p.ws + Z_VP) + (size_t)b * SEQ_P * KVW; rowbase = (size_t)b * SEQ_P; }
        const int hk = h >> 2; const bool act = c.tid < nq;
        bf16_t* qrow = (bf16_t*)(p.ws + Z_AQ) + (rowbase + (act ? c.tid : 0)) * RW + h * HD;
        float q[64], o[64]; float mx = -1e30f, lsum = 0.f;
#pragma unroll
        for (int i = 0; i < 8; ++i) { const u32x4 w = *(const u32x4*)(qrow + 8 * i); q[8 * i] = bflo(w.x); q[8 * i + 1] = bfhi(w.x); q[8 * i + 2] = bflo(w.y); q[8 * i + 3] = bfhi(w.y); q[8 * i + 4] = bflo(w.z); q[8 * i + 5] = bfhi(w.z); q[8 * i + 6] = bflo(w.w); q[8 * i + 7] = bfhi(w.w); }
#pragma unroll
        for (int i = 0; i < 64; ++i) o[i] = 0.f;
        for (int k0 = 0; k0 < skv; k0 += 32) {
            __syncthreads();
            { const int e = c.tid * 4, j = e >> 6, d = e & 63;
                const u32x2 kw = *(const u32x2*)(Kb + (size_t)(k0 + j) * KVW + hk * HD + d), vw = *(const u32x2*)(Vb + (size_t)(k0 + j) * KVW + hk * HD + d);
                *(LAS f32x4*)(Kt + e) = (f32x4){bflo(kw.x), bfhi(kw.x), bflo(kw.y), bfhi(kw.y)}; *(LAS f32x4*)(Vt + e) = (f32x4){bflo(vw.x), bfhi(vw.x), bflo(vw.y), bfhi(vw.y)}; }
            __syncthreads();
            float tm = mx;
#pragma unroll 1
            for (int j = 0; j < 32; ++j) { float a = 0.f;
#pragma unroll
                for (int d4 = 0; d4 < 16; ++d4) { const f32x4 kv = *(const LAS f32x4*)(Kt + j * 64 + 4 * d4); a += q[4 * d4] * kv.x + q[4 * d4 + 1] * kv.y + q[4 * d4 + 2] * kv.z + q[4 * d4 + 3] * kv.w; }
                Sc[j * 512 + c.tid] = a; tm = fmaxf(tm, a); }
            const float corr = exp2f(mx - tm); mx = tm; lsum *= corr;
#pragma unroll
            for (int i = 0; i < 64; ++i) o[i] *= corr;
#pragma unroll 1
            for (int j = 0; j < 32; ++j) { const float pj = exp2f(Sc[j * 512 + c.tid] - mx); lsum += pj;
#pragma unroll
                for (int d4 = 0; d4 < 16; ++d4) { const f32x4 vv = *(const LAS f32x4*)(Vt + j * 64 + 4 * d4); o[4 * d4] += pj * vv.x; o[4 * d4 + 1] += pj * vv.y; o[4 * d4 + 2] += pj * vv.z; o[4 * d4 + 3] += pj * vv.w; } }
        }
        if (act) { const float il = 1.f / lsum;
#pragma unroll
            for (int i = 0; i < 8; ++i) { u32x4 w; w.x = pk2(o[8 * i] * il, o[8 * i + 1] * il); w.y = pk2(o[8 * i + 2] * il, o[8 * i + 3] * il); w.z = pk2(o[8 * i + 4] * il, o[8 * i + 5] * il); w.w = pk2(o[8 * i + 6] * il, o[8 * i + 7] * il); *(u32x4*)(qrow + 8 * i) = w; } }
    }
    __syncthreads();
}
__device__ __forceinline__ void cmlp_simple(const Params& p, const Ctx& c, int l) {
    LAS float* Vt = (LAS float*)c.lds;
    LAS float* rs = Vt + 128 * 128;
    const bf16_t* cv = (const bf16_t*)(p.ws + Z_CV); bf16_t* cu = (bf16_t*)(p.ws + Z_CU);
    for (int u = c.bx; u < NCHUNK * 4; u += c.G) {
        const int ch = u >> 2, g = u & 3; const size_t R0 = (size_t)ch * 128;
        __syncthreads();
        { const int q = c.tid >> 2, part = c.tid & 3; float ss = 0.f;
            const bf16_t* r = cv + (R0 + q) * RW + part * 128;
#pragma unroll
            for (int i = 0; i < 16; ++i) { const u32x4 w = *(const u32x4*)(r + 8 * i); const float a0 = bflo(w.x), a1 = bfhi(w.x), a2 = bflo(w.y), a3 = bfhi(w.y), a4 = bflo(w.z), a5 = bfhi(w.z), a6 = bflo(w.w), a7 = bfhi(w.w);
                ss += (a0 * a0 + a1 * a1) + (a2 * a2 + a3 * a3) + (a4 * a4 + a5 * a5) + (a6 * a6 + a7 * a7); }
            ss += __shfl_xor(ss, 1); ss += __shfl_xor(ss, 2);
            if (part == 0) rs[q] = rsqrtf(ss * (1.f / RW) + EPS); }
        __syncthreads();
        for (int e = c.tid; e < 128 * 128 / 8; e += 512) { const int q = e >> 4, c8 = (e & 15) * 8; const float r = rs[q];
            const u32x4 w = *(const u32x4*)(cv + (R0 + q) * RW + g * 128 + c8);
            *(LAS f32x4*)(Vt + q * 128 + c8) = (f32x4){bflo(w.x) * r, bfhi(w.x) * r, bflo(w.y) * r, bfhi(w.y) * r};
            *(LAS f32x4*)(Vt + q * 128 + c8 + 4) = (f32x4){bflo(w.z) * r, bfhi(w.z) * r, bflo(w.w) * r, bfhi(w.w) * r}; }
        __syncthreads();
        const int cc = c.tid & 127, pg = __builtin_amdgcn_readfirstlane(c.tid >> 7);
        const float* Ws = p.in[I_CMWS] + ((size_t)(l * 4 + g) * 128) * 128; const float* bs = p.in[I_CMBS] + (l * 4 + g) * 128;
        const float gn = p.in[I_CMNORM][l * RW + g * 128 + cc];
        for (int pi = 0; pi < 32; ++pi) { const int pr = pg * 32 + pi; const float* wrow = Ws + pr * 128; float a = 0.f;
#pragma unroll 8
            for (int q = 0; q < 128; ++q) a += wrow[q] * Vt[q * 128 + cc];
            bf16_t* up = cu + (R0 + pr) * RW + g * 128 + cc;
            const float uu = bf2f(*up);
            *up = (bf16_t)f2bf(uu * (gn * a + bs[pr])); }
    }
    __syncthreads();
}
__device__ __forceinline__ float ret_ld(const Params& p, int l, int dir, int h) { const float x = p.in[I_DECAY][(l * 2 + dir) * NH + h]; return -log1pf(__expf(x)); }
__device__ __forceinline__ void retU_simple(const Params& p, const Ctx& c, int l) {
    LAS float* Kt = (LAS float*)c.lds; LAS float* Vt = Kt + 128 * 64; LAS float* wf = Vt + 128 * 64; LAS float* wb = wf + 128;
    float* U = (float*)(p.ws + Z_U);
    for (int u = c.bx; u < NCHUNK * NH; u += c.G) {
        const int ch = u >> 3, h = u & 7; const size_t R0 = (size_t)ch * 128;
        const float ldf = ret_ld(p, l, 0, h), ldb = ret_ld(p, l, 1, h);
        __syncthreads();
        if (c.tid < 128) { wf[c.tid] = __expf(ldf * (float)(127 - c.tid)); wb[c.tid] = __expf(ldb * (float)c.tid); }
        for (int e = c.tid; e < 128 * 64 / 8; e += 512) { const int j = e >> 3, d8 = (e & 7) * 8;
            const u32x4 kw = *(const u32x4*)((const bf16_t*)(p.ws + Z_RK) + (R0 + j) * RW + h * HD + d8), vw = *(const u32x4*)((const bf16_t*)(p.ws + Z_RV) + (R0 + j) * RW + h * HD + d8);
            *(LAS f32x4*)(Kt + j * 64 + d8) = (f32x4){bflo(kw.x), bfhi(kw.x), bflo(kw.y), bfhi(kw.y)}; *(LAS f32x4*)(Kt + j * 64 + d8 + 4) = (f32x4){bflo(kw.z), bfhi(kw.z), bflo(kw.w), bfhi(kw.w)};
            *(LAS f32x4*)(Vt + j * 64 + d8) = (f32x4){bflo(vw.x), bfhi(vw.x), bflo(vw.y), bfhi(vw.y)}; *(LAS f32x4*)(Vt + j * 64 + d8 + 4) = (f32x4){bflo(vw.z), bfhi(vw.z), bflo(vw.w), bfhi(vw.w)}; }
        __syncthreads();
        const int e = c.tid & 63, d0 = __builtin_amdgcn_readfirstlane(c.tid >> 6) * 8;
        float uf[8], ub[8];
#pragma unroll
        for (int i = 0; i < 8; ++i) { uf[i] = 0.f; ub[i] = 0.f; }
        for (int j = 0; j < 128; ++j) { const float v = Vt[j * 64 + e], vf = v * wf[j], vb = v * wb[j];
            const f32x4 k0 = *(const LAS f32x4*)(Kt + j * 64 + d0), k1 = *(const LAS f32x4*)(Kt + j * 64 + d0 + 4);
            uf[0] += k0.x * vf; uf[1] += k0.y * vf; uf[2] += k0.z * vf; uf[3] += k0.w * vf; uf[4] += k1.x * vf; uf[5] += k1.y * vf; uf[6] += k1.z * vf; uf[7] += k1.w * vf;
            ub[0] += k0.x * vb; ub[1] += k0.y * vb; ub[2] += k0.z * vb; ub[3] += k0.w * vb; ub[4] += k1.x * vb; ub[5] += k1.y * vb; ub[6] += k1.z * vb; ub[7] += k1.w * vb; }
        float* Uf = U + ((size_t)(0 * NCHUNK + ch) * NH + h) * 4096, *Ub = U + ((size_t)(1 * NCHUNK + ch) * NH + h) * 4096;
#pragma unroll
        for (int i = 0; i < 8; ++i) { Uf[(d0 + i) * 64 + e] = uf[i]; Ub[(d0 + i) * 64 + e] = ub[i]; }
    }
    __syncthreads();
}
__device__ __forceinline__ void retO_simple(const Params& p, const Ctx& c, int l) {
    LAS float* Kt = (LAS float*)c.lds; LAS float* Vt = Kt + 128 * 64; LAS float* Sf = Vt + 128 * 64; LAS float* Sb = Sf + 4096; LAS float* pf = Sb + 4096; LAS float* pb = pf + 132;
    const float* U = (const float*)(p.ws + Z_U);
    for (int u = c.bx; u < NCHUNK * NH; u += c.G) {
        const int ch = u >> 3, h = u & 7; const size_t R0 = (size_t)ch * 128; const bool smp = ch >= MP / 128;
        const int nc = smp ? 16 : 2, ch0 = smp ? (MP / 128 + ((ch - MP / 128) & ~15)) : (ch & ~1), cidx = ch - ch0, b = smp ? (ch - MP / 128) >> 4 : ch >> 1;
        const float ldf = ret_ld(p, l, 0, h), ldb = ret_ld(p, l, 1, h); const float Gf = __expf(128.f * ldf), Gb = __expf(128.f * ldb);
        __syncthreads();
        if (c.tid <= 128) { pf[c.tid] = __expf(ldf * (float)c.tid); pb[c.tid] = __expf(ldb * (float)c.tid); }
        for (int e = c.tid; e < 128 * 64 / 8; e += 512) { const int j = e >> 3, d8 = (e & 7) * 8;
            const u32x4 kw = *(const u32x4*)((const bf16_t*)(p.ws + Z_RK) + (R0 + j) * RW + h * HD + d8), vw = *(const u32x4*)((const bf16_t*)(p.ws + Z_RV) + (R0 + j) * RW + h * HD + d8);
            *(LAS f32x4*)(Kt + j * 64 + d8) = (f32x4){bflo(kw.x), bfhi(kw.x), bflo(kw.y), bfhi(kw.y)}; *(LAS f32x4*)(Kt + j * 64 + d8 + 4) = (f32x4){bflo(kw.z), bfhi(kw.z), bflo(kw.w), bfhi(kw.w)};
            *(LAS f32x4*)(Vt + j * 64 + d8) = (f32x4){bflo(vw.x), bfhi(vw.x), bflo(vw.y), bfhi(vw.y)}; *(LAS f32x4*)(Vt + j * 64 + d8 + 4) = (f32x4){bflo(vw.z), bfhi(vw.z), bflo(vw.w), bfhi(vw.w)}; }
        {
            float sf[8], sb[8]; const int e0 = c.tid * 8;
            if (smp) { const float* s0 = p.in[I_ST] + ((size_t)((b * 2 + l) * 2 + 0) * NH + h) * 4096 + e0; const float* s1 = p.in[I_ST] + ((size_t)((b * 2 + l) * 2 + 1) * NH + h) * 4096 + e0;
#pragma unroll
                for (int i = 0; i < 8; ++i) { sf[i] = s0[i]; sb[i] = s1[i]; } }
            else {
#pragma unroll
                for (int i = 0; i < 8; ++i) { sf[i] = 0.f; sb[i] = 0.f; } }
            for (int cc = 0; cc < cidx; ++cc) { const float* uf = U + ((size_t)(0 * NCHUNK + ch0 + cc) * NH + h) * 4096 + e0;
#pragma unroll
                for (int i = 0; i < 8; ++i) sf[i] = Gf * sf[i] + uf[i]; }
            for (int cc = nc - 1; cc > cidx; --cc) { const float* ub = U + ((size_t)(1 * NCHUNK + ch0 + cc) * NH + h) * 4096 + e0;
#pragma unroll
                for (int i = 0; i < 8; ++i) sb[i] = Gb * sb[i] + ub[i]; }
#pragma unroll
            for (int i = 0; i < 8; ++i) { Sf[e0 + i] = sf[i]; Sb[e0 + i] = sb[i]; }
            if (!smp && cidx == nc - 1) { const float* uf = U + ((size_t)(0 * NCHUNK + ch) * NH + h) * 4096 + e0; float* o = p.out + OUT_ST + ((size_t)((b * 2 + l) * 2 + 0) * NH + h) * 4096 + e0;
#pragma unroll
                for (int i = 0; i < 8; ++i) o[i] = Gf * sf[i] + uf[i]; }
            if (!smp && cidx == 0) { const float* ub = U + ((size_t)(1 * NCHUNK + ch) * NH + h) * 4096 + e0; float* o = p.out + OUT_ST + ((size_t)((b * 2 + l) * 2 + 1) * NH + h) * 4096 + e0;
#pragma unroll
                for (int i = 0; i < 8; ++i) o[i] = Gb * sb[i] + ub[i]; }
        }
        __syncthreads();
        const int i = c.tid >> 2, part = c.tid & 3;
        float qp[16], o[16];
        { const bf16_t* qr = (const bf16_t*)(p.ws + Z_RQ) + (R0 + i) * RW + h * HD + part * 16; const u32x4 w0 = *(const u32x4*)qr, w1 = *(const u32x4*)(qr + 8);
            qp[0] = bflo(w0.x); qp[1] = bfhi(w0.x); qp[2] = bflo(w0.y); qp[3] = bfhi(w0.y); qp[4] = bflo(w0.z); qp[5] = bfhi(w0.z); qp[6] = bflo(w0.w); qp[7] = bfhi(w0.w);
            qp[8] = bflo(w1.x); qp[9] = bfhi(w1.x); qp[10] = bflo(w1.y); qp[11] = bfhi(w1.y); qp[12] = bflo(w1.z); qp[13] = bfhi(w1.z); qp[14] = bflo(w1.w); qp[15] = bfhi(w1.w); }
#pragma unroll
        for (int e = 0; e < 16; ++e) o[e] = 0.f;
#pragma unroll 1
        for (int j = 0; j < 128; ++j) { float s = 0.f;
#pragma unroll
            for (int d4 = 0; d4 < 4; ++d4) { const f32x4 kv = *(const LAS f32x4*)(Kt + j * 64 + part * 16 + 4 * d4); s += qp[4 * d4] * kv.x + qp[4 * d4 + 1] * kv.y + qp[4 * d4 + 2] * kv.z + qp[4 * d4 + 3] * kv.w; }
            s += __shfl_xor(s, 1); s += __shfl_xor(s, 2);
            const float w = j < i ? pf[i - j] : (j > i ? pb[j - i] : 2.0f);
            s *= w;
#pragma unroll
            for (int e4 = 0; e4 < 4; ++e4) { const f32x4 vv = *(const LAS f32x4*)(Vt + j * 64 + part * 16 + 4 * e4); o[4 * e4] += s * vv.x; o[4 * e4 + 1] += s * vv.y; o[4 * e4 + 2] += s * vv.z; o[4 * e4 + 3] += s * vv.w; } }
        { const float xf = pf[i + 1], xb = pb[128 - i]; const bf16_t* qfull = (const bf16_t*)(p.ws + Z_RQ) + (R0 + i) * RW + h * HD;
#pragma unroll 2
            for (int d = 0; d < 64; ++d) { const float qd = bf2f(qfull[d]); const float af = qd * xf, ab = qd * xb;
#pragma unroll
                for (int e4 = 0; e4 < 4; ++e4) { const f32x4 a = *(const LAS f32x4*)(Sf + d * 64 + part * 16 + 4 * e4), bb = *(const LAS f32x4*)(Sb + d * 64 + part * 16 + 4 * e4);
                    o[4 * e4] += af * a.x + ab * bb.x; o[4 * e4 + 1] += af * a.y + ab * bb.y; o[4 * e4 + 2] += af * a.z + ab * bb.z; o[4 * e4 + 3] += af * a.w + ab * bb.w; } } }
        float s1 = 0.f;
#pragma unroll
        for (int e = 0; e < 16; ++e) s1 += o[e];
        s1 += __shfl_xor(s1, 1); s1 += __shfl_xor(s1, 2); const float mu = s1 * (1.f / 64.f);
        float s2 = 0.f;
#pragma unroll
        for (int e = 0; e < 16; ++e) { const float d = o[e] - mu; s2 += d * d; }
        s2 += __shfl_xor(s2, 1); s2 += __shfl_xor(s2, 2); const float rstd = rsqrtf(s2 * (1.f / 64.f) + EPS);
        const float* gn = p.in[I_RETGN] + l * RW + h * HD + part * 16;
        const bf16_t* rg = (const bf16_t*)(p.ws + Z_RG) + (R0 + i) * RW + h * HD + part * 16; const u32x4 g0 = *(const u32x4*)rg, g1 = *(const u32x4*)(rg + 8);
        float gs[16] = {bflo(g0.x), bfhi(g0.x), bflo(g0.y), bfhi(g0.y), bflo(g0.z), bfhi(g0.z), bflo(g0.w), bfhi(g0.w), bflo(g1.x), bfhi(g1.x), bflo(g1.y), bfhi(g1.y), bflo(g1.z), bfhi(g1.z), bflo(g1.w), bfhi(g1.w)};
        float y[16];
#pragma unroll
        for (int e = 0; e < 16; ++e) y[e] = (o[e] - mu) * rstd * gn[e] * gs[e];
        bf16_t* dst = (bf16_t*)(p.ws + Z_CV) + (R0 + i) * RW + h * HD + part * 16;
        u32x4 w0, w1; w0.x = pk2(y[0], y[1]); w0.y = pk2(y[2], y[3]); w0.z = pk2(y[4], y[5]); w0.w = pk2(y[6], y[7]); w1.x = pk2(y[8], y[9]); w1.y = pk2(y[10], y[11]); w1.z = pk2(y[12], y[13]); w1.w = pk2(y[14], y[15]);
        *(u32x4*)dst = w0; *(u32x4*)(dst + 8) = w1;
    }
    __syncthreads();
}

typedef short v4i16_t __attribute__((ext_vector_type(4)));
typedef LAS const unsigned char* lcp;
__device__ __forceinline__ f32x4 mfma16(bf16x8 a, bf16x8 b, f32x4 c) { return __builtin_amdgcn_mfma_f32_16x16x32_bf16(a, b, c, 0, 0, 0); }
__device__ __forceinline__ bf16x8 tr_frag(lcp base, int stride, int k0, int c0, int lane) {
    const int g = lane >> 4, i = lane & 15, q = i >> 2, pp = i & 3;
    lcp a = base + (k0 + 8 * g + q) * stride + (c0 + 4 * pp) * 2;
    const v4i16_t r1 = __builtin_amdgcn_ds_read_tr16_b64_v4i16((LAS v4i16_t*)a), r2 = __builtin_amdgcn_ds_read_tr16_b64_v4i16((LAS v4i16_t*)(a + 4 * stride));
    return (bf16x8){r1[0], r1[1], r1[2], r1[3], r2[0], r2[1], r2[2], r2[3]};
}
__device__ __forceinline__ bf16x8 row_frag(lcp base, int stride, int r0, int k0, int lane) { return *(const LAS bf16x8*)(base + (r0 + (lane & 15)) * stride + (k0 + 8 * (lane >> 4)) * 2); }
__device__ __forceinline__ u32x4 scale8(const u32x4 w, float s) { u32x4 o; o.x = pk2(bflo(w.x) * s, bfhi(w.x) * s); o.y = pk2(bflo(w.y) * s, bfhi(w.y) * s); o.z = pk2(bflo(w.z) * s, bfhi(w.z) * s); o.w = pk2(bflo(w.w) * s, bfhi(w.w) * s); return o; }
constexpr int RS64 = 144, RS128 = 272;
constexpr float LOG2E = 1.4426950408889634f;

__device__ __forceinline__ void retU_fast(const Params& p, const Ctx& c, int l) {
    LAS unsigned char* Kf = c.lds; LAS unsigned char* Kb = Kf + 128 * RS64; LAS unsigned char* Vs = Kb + 128 * RS64;
    float* U = (float*)(p.ws + Z_U);
    const int g = c.lane >> 4, i16 = c.lane & 15;
    for (int u = c.bx; u < NCHUNK * NH; u += c.G) {
        const int ch = u >> 3, h = u & 7; const size_t R0 = (size_t)ch * 128;
        const float l2f = ret_ld(p, l, 0, h) * LOG2E, l2b = ret_ld(p, l, 1, h) * LOG2E;
        __syncthreads();
#pragma unroll
        for (int it = 0; it < 2; ++it) { const int idx = c.tid + 512 * it, j = idx >> 3, c8 = (idx & 7) * 8;
            const u32x4 kw = *(const u32x4*)((const bf16_t*)(p.ws + Z_RK) + (R0 + j) * RW + h * HD + c8), vw = *(const u32x4*)((const bf16_t*)(p.ws + Z_RV) + (R0 + j) * RW + h * HD + c8);
            const float wf = exp2f(l2f * (float)(127 - j)), wb = exp2f(l2b * (float)j);
            *(LAS u32x4*)(Kf + j * RS64 + c8 * 2) = scale8(kw, wf); *(LAS u32x4*)(Kb + j * RS64 + c8 * 2) = scale8(kw, wb); *(LAS u32x4*)(Vs + j * RS64 + c8 * 2) = vw; }
        __syncthreads();
        const int dt = c.wave & 3, et0 = 2 * (c.wave >> 2);
        f32x4 acc[2][2];
#pragma unroll
        for (int s = 0; s < 2; ++s)
#pragma unroll
            for (int e = 0; e < 2; ++e) acc[s][e] = (f32x4){0.f, 0.f, 0.f, 0.f};
#pragma unroll
        for (int ks = 0; ks < 4; ++ks) {
            const bf16x8 af = tr_frag(Kf, RS64, 32 * ks, 16 * dt, c.lane), ab = tr_frag(Kb, RS64, 32 * ks, 16 * dt, c.lane);
#pragma unroll
            for (int e = 0; e < 2; ++e) { const bf16x8 bv = tr_frag(Vs, RS64, 32 * ks, 16 * (et0 + e), c.lane); acc[0][e] = mfma16(af, bv, acc[0][e]); acc[1][e] = mfma16(ab, bv, acc[1][e]); }
        }
#pragma unroll
        for (int s = 0; s < 2; ++s)
#pragma unroll
            for (int e = 0; e < 2; ++e) { float* o = U + ((size_t)(s * NCHUNK + ch) * NH + h) * 4096 + (16 * dt + 4 * g) * 64 + 16 * (et0 + e) + i16;
#pragma unroll
                for (int r = 0; r < 4; ++r) o[r * 64] = acc[s][e][r]; }
    }
    __syncthreads();
}

__device__ __forceinline__ void retO_fast(const Params& p, const Ctx& c, int l) {
    LAS unsigned char* Qs = c.lds; LAS unsigned char* Ks = Qs + 128 * RS64; LAS unsigned char* Vs = Ks + 128 * RS64; LAS unsigned char* Sf = Vs + 128 * RS64; LAS unsigned char* Sb = Sf + 64 * RS64; LAS unsigned char* Ps = Sb + 64 * RS64;
    const float* U = (const float*)(p.ws + Z_U);
    const int g = c.lane >> 4, i16 = c.lane & 15, i0 = 16 * c.wave;
    for (int u = c.bx; u < NCHUNK * NH; u += c.G) {
        const int ch = u >> 3, h = u & 7; const size_t R0 = (size_t)ch * 128; const bool smp = ch >= MP / 128;
        const int nc = smp ? 16 : 2, ch0 = smp ? (MP / 128 + ((ch - MP / 128) & ~15)) : (ch & ~1), cidx = ch - ch0, b = smp ? (ch - MP / 128) >> 4 : ch >> 1;
        const float ldf = ret_ld(p, l, 0, h), ldb = ret_ld(p, l, 1, h); const float Gf = __expf(128.f * ldf), Gb = __expf(128.f * ldb), l2f = ldf * LOG2E, l2b = ldb * LOG2E;
        __syncthreads();
#pragma unroll
        for (int it = 0; it < 2; ++it) { const int idx = c.tid + 512 * it, j = idx >> 3, c8 = (idx & 7) * 8; const size_t go = (R0 + j) * RW + h * HD + c8;
            *(LAS u32x4*)(Qs + j * RS64 + c8 * 2) = *(const u32x4*)((const bf16_t*)(p.ws + Z_RQ) + go);
            *(LAS u32x4*)(Ks + j * RS64 + c8 * 2) = *(const u32x4*)((const bf16_t*)(p.ws + Z_RK) + go);
            *(LAS u32x4*)(Vs + j * RS64 + c8 * 2) = *(const u32x4*)((const bf16_t*)(p.ws + Z_RV) + go); }
        {
            float sf[8], sb[8]; const int e0 = c.tid * 8;
            if (smp) { const float* s0 = p.in[I_ST] + ((size_t)((b * 2 + l) * 2 + 0) * NH + h) * 4096 + e0; const float* s1 = p.in[I_ST] + ((size_t)((b * 2 + l) * 2 + 1) * NH + h) * 4096 + e0;
#pragma unroll
                for (int i = 0; i < 8; ++i) { sf[i] = s0[i]; sb[i] = s1[i]; } }
            else {
#pragma unroll
                for (int i = 0; i < 8; ++i) { sf[i] = 0.f; sb[i] = 0.f; } }
            {
                const float* uf = U + ((size_t)(0 * NCHUNK + ch0) * NH + h) * 4096 + e0; const float* ub = U + ((size_t)(1 * NCHUNK + ch0) * NH + h) * 4096 + e0;
                int cc = 0;
                for (; cc + 4 <= cidx; cc += 4) { f32x4 a[4][2];
#pragma unroll
                    for (int k = 0; k < 4; ++k) { a[k][0] = *(const f32x4*)(uf + (size_t)(cc + k) * NH * 4096); a[k][1] = *(const f32x4*)(uf + (size_t)(cc + k) * NH * 4096 + 4); }
#pragma unroll
                    for (int k = 0; k < 4; ++k)
#pragma unroll
                        for (int i = 0; i < 4; ++i) { sf[i] = Gf * sf[i] + a[k][0][i]; sf[4 + i] = Gf * sf[4 + i] + a[k][1][i]; } }
                for (; cc < cidx; ++cc) { const f32x4 a0 = *(const f32x4*)(uf + (size_t)cc * NH * 4096), a1 = *(const f32x4*)(uf + (size_t)cc * NH * 4096 + 4);
#pragma unroll
                    for (int i = 0; i < 4; ++i) { sf[i] = Gf * sf[i] + a0[i]; sf[4 + i] = Gf * sf[4 + i] + a1[i]; } }
                cc = nc - 1;
                for (; cc - 4 >= cidx; cc -= 4) { f32x4 a[4][2];
#pragma unroll
                    for (int k = 0; k < 4; ++k) { a[k][0] = *(const f32x4*)(ub + (size_t)(cc - k) * NH * 4096); a[k][1] = *(const f32x4*)(ub + (size_t)(cc - k) * NH * 4096 + 4); }
#pragma unroll
                    for (int k = 0; k < 4; ++k)
#pragma unroll
                        for (int i = 0; i < 4; ++i) { sb[i] = Gb * sb[i] + a[k][0][i]; sb[4 + i] = Gb * sb[4 + i] + a[k][1][i]; } }
                for (; cc > cidx; --cc) { const f32x4 a0 = *(const f32x4*)(ub + (size_t)cc * NH * 4096), a1 = *(const f32x4*)(ub + (size_t)cc * NH * 4096 + 4);
#pragma unroll
                    for (int i = 0; i < 4; ++i) { sb[i] = Gb * sb[i] + a0[i]; sb[4 + i] = Gb * sb[4 + i] + a1[i]; } }
            }
            { const int d = c.tid >> 3, e = (c.tid & 7) * 8; u32x4 w;
                w.x = pk2(sf[0], sf[1]); w.y = pk2(sf[2], sf[3]); w.z = pk2(sf[4], sf[5]); w.w = pk2(sf[6], sf[7]); *(LAS u32x4*)(Sf + d * RS64 + e * 2) = w;
                w.x = pk2(sb[0], sb[1]); w.y = pk2(sb[2], sb[3]); w.z = pk2(sb[4], sb[5]); w.w = pk2(sb[6], sb[7]); *(LAS u32x4*)(Sb + d * RS64 + e * 2) = w; }
            if (!smp && cidx == nc - 1) { const float* uf = U + ((size_t)(0 * NCHUNK + ch) * NH + h) * 4096 + e0; float* o = p.out + OUT_ST + ((size_t)((b * 2 + l) * 2 + 0) * NH + h) * 4096 + e0;
#pragma unroll
                for (int i = 0; i < 8; ++i) o[i] = Gf * sf[i] + uf[i]; }
            if (!smp && cidx == 0) { const float* ub = U + ((size_t)(1 * NCHUNK + ch) * NH + h) * 4096 + e0; float* o = p.out + OUT_ST + ((size_t)((b * 2 + l) * 2 + 1) * NH + h) * 4096 + e0;
#pragma unroll
                for (int i = 0; i < 8; ++i) o[i] = Gb * sb[i] + ub[i]; }
        }
        __syncthreads();
        { const bf16x8 q0 = row_frag(Qs, RS64, i0, 0, c.lane), q1 = row_frag(Qs, RS64, i0, 32, c.lane);
            const int iq = i0 + i16;
#pragma unroll
            for (int jt = 0; jt < 8; ++jt) {
                f32x4 s = (f32x4){0.f, 0.f, 0.f, 0.f};
                s = mfma16(row_frag(Ks, RS64, 16 * jt, 0, c.lane), q0, s); s = mfma16(row_frag(Ks, RS64, 16 * jt, 32, c.lane), q1, s);
                float pv[4];
#pragma unroll
                for (int r = 0; r < 4; ++r) { const int j = 16 * jt + 4 * g + r; const float w = j < iq ? exp2f(l2f * (float)(iq - j)) : (j > iq ? exp2f(l2b * (float)(j - iq)) : 2.0f); pv[r] = s[r] * w; }
                u32x2 w2; w2.x = pk2(pv[0], pv[1]); w2.y = pk2(pv[2], pv[3]);
                *(LAS u32x2*)(Ps + iq * RS128 + (16 * jt + 4 * g) * 2) = w2;
            } }
        __syncthreads();
        f32x4 ap[4], af[4], ab[4];
#pragma unroll
        for (int et = 0; et < 4; ++et) { ap[et] = (f32x4){0.f, 0.f, 0.f, 0.f}; af[et] = ap[et]; ab[et] = ap[et]; }
#pragma unroll
        for (int ks = 0; ks < 4; ++ks) { const bf16x8 a = row_frag(Ps, RS128, i0, 32 * ks, c.lane);
#pragma unroll
            for (int et = 0; et < 4; ++et) ap[et] = mfma16(a, tr_frag(Vs, RS64, 32 * ks, 16 * et, c.lane), ap[et]); }
#pragma unroll
        for (int ks = 0; ks < 2; ++ks) { const bf16x8 a = row_frag(Qs, RS64, i0, 32 * ks, c.lane);
#pragma unroll
            for (int et = 0; et < 4; ++et) { af[et] = mfma16(a, tr_frag(Sf, RS64, 32 * ks, 16 * et, c.lane), af[et]); ab[et] = mfma16(a, tr_frag(Sb, RS64, 32 * ks, 16 * et, c.lane), ab[et]); } }
        float mu[4], rstd[4];
#pragma unroll
        for (int r = 0; r < 4; ++r) { const int il = i0 + 4 * g + r; const float xf = exp2f(l2f * (float)(il + 1)), xb = exp2f(l2b * (float)(128 - il)); float s1 = 0.f;
#pragma unroll
            for (int et = 0; et < 4; ++et) { ap[et][r] += xf * af[et][r] + xb * ab[et][r]; s1 += ap[et][r]; }
            s1 += __shfl_xor(s1, 1); s1 += __shfl_xor(s1, 2); s1 += __shfl_xor(s1, 4); s1 += __shfl_xor(s1, 8); mu[r] = s1 * (1.f / 64.f); float s2 = 0.f;
#pragma unroll
            for (int et = 0; et < 4; ++et) { const float d = ap[et][r] - mu[r]; s2 += d * d; }
            s2 += __shfl_xor(s2, 1); s2 += __shfl_xor(s2, 2); s2 += __shfl_xor(s2, 4); s2 += __shfl_xor(s2, 8); rstd[r] = rsqrtf(s2 * (1.f / 64.f) + EPS); }
        LAS float* stg = (LAS float*)(Ps + i0 * RS128);
#pragma unroll
        for (int et = 0; et < 4; ++et) { const float gn = p.in[I_RETGN][l * RW + h * HD + 16 * et + i16];
#pragma unroll
            for (int r = 0; r < 4; ++r) stg[(4 * g + r) * 68 + 16 * et + i16] = (ap[et][r] - mu[r]) * rstd[r] * gn; }
        asm volatile("s_waitcnt lgkmcnt(0)" ::: "memory");
#pragma unroll
        for (int k = 0; k < 2; ++k) { const int row = c.lane >> 2, ec = ((c.lane & 3) * 2 + k) * 8;
            const f32x4 y0 = *(const LAS f32x4*)(stg + row * 68 + ec), y1 = *(const LAS f32x4*)(stg + row * 68 + ec + 4);
            const size_t go = (R0 + i0 + row) * RW + h * HD + ec; const u32x4 gw = *(const u32x4*)((const bf16_t*)(p.ws + Z_RG) + go);
            u32x4 o; o.x = pk2(y0.x * bflo(gw.x), y0.y * bfhi(gw.x)); o.y = pk2(y0.z * bflo(gw.y), y0.w * bfhi(gw.y)); o.z = pk2(y1.x * bflo(gw.z), y1.y * bfhi(gw.z)); o.w = pk2(y1.z * bflo(gw.w), y1.w * bfhi(gw.w));
            *(u32x4*)((bf16_t*)(p.ws + Z_CV) + go) = o; }
    }
    __syncthreads();
}

__device__ __forceinline__ void cmlp_fast(const Params& p, const Ctx& c, int l) {
    LAS unsigned char* As = c.lds; LAS unsigned char* Vc = As + 128 * RS128; LAS float* rs = (LAS float*)(Vc + 128 * RS128);
    const bf16_t* cv = (const bf16_t*)(p.ws + Z_CV); bf16_t* cu = (bf16_t*)(p.ws + Z_CU);
    const int g4 = c.lane >> 4, i16 = c.lane & 15, p0 = 16 * c.wave;
    for (int u = c.bx; u < NCHUNK * 4; u += c.G) {
        const int ch = u >> 2, g = u & 3; const size_t R0 = (size_t)ch * 128;
        __syncthreads();
        { const int q = c.tid >> 2, part = c.tid & 3; float ss = 0.f;
            const bf16_t* r = cv + (R0 + q) * RW + part * 128;
#pragma unroll
            for (int i = 0; i < 16; ++i) { const u32x4 w = *(const u32x4*)(r + 8 * i); const float a0 = bflo(w.x), a1 = bfhi(w.x), a2 = bflo(w.y), a3 = bfhi(w.y), a4 = bflo(w.z), a5 = bfhi(w.z), a6 = bflo(w.w), a7 = bfhi(w.w);
                ss += (a0 * a0 + a1 * a1) + (a2 * a2 + a3 * a3) + (a4 * a4 + a5 * a5) + (a6 * a6 + a7 * a7); }
            ss += __shfl_xor(ss, 1); ss += __shfl_xor(ss, 2);
            if (part == 0) rs[q] = rsqrtf(ss * (1.f / RW) + EPS); }
#pragma unroll
        for (int it = 0; it < 4; ++it) { const int idx = c.tid + 512 * it, q = idx >> 4, c8 = (idx & 15) * 8;
            *(LAS u32x4*)(Vc + q * RS128 + c8 * 2) = *(const u32x4*)(cv + (R0 + q) * RW + g * 128 + c8); }
        __syncthreads();
        const float* Ws = p.in[I_CMWS] + ((size_t)(l * 4 + g) * 128) * 128;
#pragma unroll
        for (int it = 0; it < 8; ++it) { const int idx = c.tid + 512 * it, pr = idx >> 5, q4 = (idx & 31) * 4;
            const f32x4 w = *(const f32x4*)(Ws + pr * 128 + q4); const f32x4 r = *(const LAS f32x4*)(rs + q4);
            u32x2 o; o.x = pk2(w.x * r.x, w.y * r.y); o.y = pk2(w.z * r.z, w.w * r.w); *(LAS u32x2*)(As + pr * RS128 + q4 * 2) = o; }
        __syncthreads();
        f32x4 acc[8];
#pragma unroll
        for (int ct = 0; ct < 8; ++ct) acc[ct] = (f32x4){0.f, 0.f, 0.f, 0.f};
#pragma unroll
        for (int ks = 0; ks < 4; ++ks) { const bf16x8 a = row_frag(As, RS128, p0, 32 * ks, c.lane);
#pragma unroll
            for (int ct = 0; ct < 8; ++ct) acc[ct] = mfma16(a, tr_frag(Vc, RS128, 32 * ks, 16 * ct, c.lane), acc[ct]); }
        __syncthreads();
        LAS float* stg = (LAS float*)(c.lds + c.wave * (16 * 132 * 4));
        const float* bsv = p.in[I_CMBS] + (l * 4 + g) * 128 + p0 + 4 * g4;
        float bb[4];
#pragma unroll
        for (int r = 0; r < 4; ++r) bb[r] = bsv[r];
#pragma unroll
        for (int ct = 0; ct < 8; ++ct) { const float gn = p.in[I_CMNORM][l * RW + g * 128 + 16 * ct + i16];
#pragma unroll
            for (int r = 0; r < 4; ++r) stg[(4 * g4 + r) * 132 + 16 * ct + i16] = gn * acc[ct][r] + bb[r]; }
        asm volatile("s_waitcnt lgkmcnt(0)" ::: "memory");
#pragma unroll
        for (int k = 0; k < 4; ++k) { const int row = c.lane >> 2, cc = (k * 4 + (c.lane & 3)) * 8;
            const f32x4 y0 = *(const LAS f32x4*)(stg + row * 132 + cc), y1 = *(const LAS f32x4*)(stg + row * 132 + cc + 4);
            bf16_t* up = cu + (R0 + p0 + row) * RW + g * 128 + cc; const u32x4 uw = *(const u32x4*)up;
            u32x4 o; o.x = pk2(y0.x * bflo(uw.x), y0.y * bfhi(uw.x)); o.y = pk2(y0.z * bflo(uw.y), y0.w * bfhi(uw.y)); o.z = pk2(y1.x * bflo(uw.z), y1.y * bfhi(uw.z)); o.w = pk2(y1.z * bflo(uw.w), y1.w * bfhi(uw.w));
            *(u32x4*)up = o; }
    }
    __syncthreads();
}
#ifndef FAST_MIX
#define FAST_MIX 7
#endif

#ifndef PG8_MASK
#define PG8_MASK 0xFFF
#endif
template <int KIND, class Epi, class Sched>
__device__ __forceinline__ void gemm_any(const Ctx& c, const bf16_t* A, const bf16_t* Bt, int K, const Sched& S, const Epi& E) {
    if constexpr ((PG8_MASK >> KIND) & 1) { pg8::Gemm g{A, Bt, 0, 0, K}; pg8::gemm_phase<Epi, Sched, true, true>(c.tid, c.lds, g, S, E); }
    else gemm_simple(c, A, Bt, K, S, E);
}
#ifndef KMASK
#define KMASK 0xFFF
#endif
constexpr int NPHASE = 23;
template <int KIND> __device__ __forceinline__ void run_kind(const Params& p, const Ctx& c, int l) {
    const unsigned char* wb = p.ws + WS_W;
    if constexpr (KIND == 0) { p0_modulation(p, c); p0_rope_tables(p, c); p_wconv(p, c, 0); p_kvctx(p, c, 0); }
    else if constexpr (KIND == 1) { p_norm(p, c, l, 0); }
    else if constexpr (KIND == 2) { StaticOrder S; S.init(M, NMIX, c.G, c.bx, DM); EpiMix E{&p, l}; gemm_any<2>(c, (const bf16_t*)(p.ws + WS_XN), (const bf16_t*)(wb + W_IN), DM, S, E); }
    else if constexpr (KIND == 3) { if (ATTN_FAST) attn_fast(p, c); else attn_simple(p, c); if (FAST_MIX & 1) cmlp_fast(p, c, l); else cmlp_simple(p, c, l); if (FAST_MIX & 2) retU_fast(p, c, l); else retU_simple(p, c, l); }
    else if constexpr (KIND == 4) { if (FAST_MIX & 4) retO_fast(p, c, l); else retO_simple(p, c, l); }
    else if constexpr (KIND == 5) { StaticOrder S; S.init(M, NGATE, c.G, c.bx, DM); EpiGate E{&p}; gemm_any<5>(c, (const bf16_t*)(p.ws + WS_XN), (const bf16_t*)(wb + W_IN) + (size_t)NMIX * DM, DM, S, E); }
    else if constexpr (KIND == 6) { MergeOrder S{c.G, c.bx}; EpiMerge E{&p}; gemm_any<6>(c, (const bf16_t*)(p.ws + Z_AQ), (const bf16_t*)(wb + W_BR), RW, S, E); }
    else if constexpr (KIND == 7) { QuarterOrder S; S.init(c.G, c.bx, DM); EpiRes E{&p, l, 2, l == 0, DM / 64, (bf16_t*)(p.ws + SLAB_P4)}; gemm_any<7>(c, (const bf16_t*)(p.ws + WS_XN), (const bf16_t*)(wb + W_OUT), DM, S, E); }
    else if constexpr (KIND == 8) { p_norm(p, c, l, 1, c.G == 256); }
    else if constexpr (KIND == 9) { StaticOrder S; S.init(M, DFF, c.G, c.bx, DM); EpiFF1 E{&p}; gemm_any<9>(c, (const bf16_t*)(p.ws + WS_XN), (const bf16_t*)(wb + W_FF1), DM, S, E); }
    else if constexpr (KIND == 10) { QuarterOrder S; S.init(c.G, c.bx, DFF); EpiRes E{&p, l, 5, false, DFF / 64, (bf16_t*)(p.ws + SLAB_P6)}; gemm_any<10>(c, (const bf16_t*)(p.ws + Z_HB), (const bf16_t*)(wb + W_FF2), DFF, S, E); }
    else { if (l == 0) { if (c.G == 256) p_combine(p, c, 0, (const bf16_t*)(p.ws + SLAB_P6)); p_wconv(p, c, 1); p_kvctx(p, c, 1); } else p_final_norm(p, c, c.G == 256); }
}
template <int PH> __device__ __forceinline__ void run_from(const Params& p, const Ctx& c0, const XcdBarrier& bar) {
    if constexpr (PH < NPHASE) {
        constexpr int kind = PH < 12 ? PH : (PH == 12 ? 1 : PH - 11), l = PH < 12 ? 0 : 1;
#ifdef PROBE_A
        if (c0.bx == 0 && c0.tid == 0) ((unsigned long long*)(p.ws + WS_CTL + 65536))[PH] = __builtin_amdgcn_s_memrealtime();
#endif
        { Ctx c = c0; asm volatile("" : "+v"(c.tid)); c.lane = c.tid & 63; c.wave = __builtin_amdgcn_readfirstlane(c.tid >> 6);
          if ((KMASK >> kind) & 1) run_kind<kind>(p, c, l); }
#ifdef PROBE_A
        xcd_barrier(bar);
        if constexpr (PH + 1 == NPHASE) {
            if (c0.bx == 0 && c0.tid == 0) ((unsigned long long*)(p.ws + WS_CTL + 65536))[NPHASE] = __builtin_amdgcn_s_memrealtime();
            xcd_barrier(bar);
            const unsigned long long* ts = (const unsigned long long*)(p.ws + WS_CTL + 65536);
            const float us = (float)(ts[PROBE_B] - ts[PROBE_A]) * 0.01f; const float sc = 1.0f + sqrtf(2e-4f * us / (float)(PROBE_FS));
            for (size_t i = (size_t)c0.bx * 512 + c0.tid; i < (size_t)NB_P * 2 * SEQ_P * KVW; i += (size_t)c0.G * 512) p.out[OUT_CV + i] *= sc;
        }
#else
        if constexpr (PH + 1 < NPHASE) xcd_barrier(bar);
#endif
        run_from<PH + 1>(p, c0, bar);
    }
}
#if N_LAUNCH_MODE == 1
__global__ void __launch_bounds__(512, 2) fwd_kernel(Params p) {
    extern __shared__ __attribute__((aligned(16))) unsigned char lds[];
    Ctx c; c.tid = threadIdx.x; c.lane = c.tid & 63; c.wave = __builtin_amdgcn_readfirstlane(c.tid >> 6); c.G = gridDim.x; c.bx = blockIdx.x; c.lds = (LAS unsigned char*)lds;
    volatile LAS unsigned* MISC = (volatile LAS unsigned*)(c.lds + MISC_OFF);
    if (c.tid < 32) MISC[c.tid] = 0u;
    __syncthreads();
    XcdBarrier bar = xcd_barrier_post((unsigned*)(p.ws + WS_CTL) + CW_BAR, MISC + 8);
    run_from<0>(p, c, bar);
}
#endif
template <int KIND> __global__ void __launch_bounds__(512, 2) phase_kernel(Params p) {
    extern __shared__ __attribute__((aligned(16))) unsigned char lds[];
    Ctx c; c.tid = threadIdx.x; c.lane = c.tid & 63; c.wave = __builtin_amdgcn_readfirstlane(c.tid >> 6); c.G = gridDim.x; c.bx = blockIdx.x; c.lds = (LAS unsigned char*)lds;
    run_kind<KIND>(p, c, p.ph_hi);
}
template <int KIND> static void launch_kind(Params p, int l, int grid, hipStream_t stream) {
    static bool attr = false;
    if (!attr) { (void)hipFuncSetAttribute((const void*)phase_kernel<KIND>, hipFuncAttributeMaxDynamicSharedMemorySize, LDS_BYTES); attr = true; }
    p.ph_lo = 0; p.ph_hi = l;
    hipLaunchKernelGGL(phase_kernel<KIND>, dim3(grid), dim3(512), LDS_BYTES, stream, p);
}

extern "C" void kernel_launch(void* const* d_in, const int* in_sizes, int n_in, void* d_out, int out_size, void* d_ws, size_t ws_size, hipStream_t stream) {
    static int grid = 0;
    if (grid == 0) {
        int dev = 0, cus = 0;
        if (n_in != N_IN || ws_size < WS_NEED) { grid = -1; return; }
        if (hipGetDevice(&dev) != hipSuccess || hipDeviceGetAttribute(&cus, hipDeviceAttributeMultiprocessorCount, dev) != hipSuccess) { grid = -1; return; }
#if N_LAUNCH_MODE == 1
        if (hipFuncSetAttribute((const void*)fwd_kernel, hipFuncAttributeMaxDynamicSharedMemorySize, LDS_BYTES) != hipSuccess) { grid = -1; return; }
#endif
        grid = cus;
    }
    if (grid < 0) return;
    (void)hipMemsetAsync((char*)d_ws + WS_CTL, 0, WS_ZERO_BYTES, stream);
    Params p{};
    for (int i = 0; i < N_IN; ++i) p.in[i] = (const float*)d_in[i];
    p.out = (float*)d_out; p.ws = (unsigned char*)d_ws;
#if N_LAUNCH_MODE == 1
    p.ph_lo = 0; p.ph_hi = NPHASE;
    hipLaunchKernelGGL(fwd_kernel, dim3(grid), dim3(512), LDS_BYTES, stream, p);
#else
    launch_kind<0>(p, 0, grid, stream);
    for (int l = 0; l < 2; ++l) { launch_kind<1>(p, l, grid, stream);
        launch_kind<2>(p, l, grid, stream); launch_kind<3>(p, l, grid, stream); launch_kind<4>(p, l, grid, stream); launch_kind<5>(p, l, grid, stream); launch_kind<6>(p, l, grid, stream);
        launch_kind<7>(p, l, grid, stream); launch_kind<8>(p, l, grid, stream); launch_kind<9>(p, l, grid, stream); launch_kind<10>(p, l, grid, stream); launch_kind<11>(p, l, grid, stream);
    }
#endif
}
```

```cpp
#include <hip/hip_runtime.h>
#include <hip/hip_bf16.h>
#include <cstdio>
#include <cstdint>

#ifndef N_LAUNCH_MODE
#define N_LAUNCH_MODE 1
#endif

#define GAS __attribute__((address_space(1)))
#define LAS __attribute__((address_space(3)))
#define RLX_AGENT __ATOMIC_RELAXED, __HIP_MEMORY_SCOPE_AGENT
typedef unsigned short bf16_t;
typedef short bf16x8 __attribute__((ext_vector_type(8)));
typedef float f32x4 __attribute__((ext_vector_type(4)));
typedef float f32x2 __attribute__((ext_vector_type(2)));
typedef unsigned u32x4 __attribute__((ext_vector_type(4)));
typedef unsigned u32x2 __attribute__((ext_vector_type(2)));

constexpr int DM = 1024, MP = 4096, MS = 16384, M = 20480, SEQ_P = 256, SEQ_S = 2048, NB_P = 16, NB_S = 8, PAST = 256;
constexpr int HD = 64, NH = 8, KVW = 128, DFF = 4096, INW = 6912, NMIX = 3840, NGATE = 3072, RW = 512;
constexpr int SKV_S = PAST + SEQ_S, SKV_P = SEQ_P;
constexpr int NCHUNK = M / 128;
constexpr float EPS = 1e-6f;
constexpr float C2 = 0.18033688011112042f;
constexpr size_t OUT_Y = 0, OUT_CK = (size_t)M * DM, OUT_CV = OUT_CK + (size_t)NB_P * 2 * SEQ_P * KVW, OUT_ST = OUT_CV + (size_t)NB_P * 2 * SEQ_P * KVW;

constexpr size_t MiB = 1u << 20;
constexpr size_t WS_CTL = 0;
constexpr size_t WS_MOD = 1 * MiB;
constexpr size_t WS_ROPE = 1 * MiB + 512 * 1024;
constexpr size_t WS_ZERO_BYTES = 1 * MiB + 512 * 1024;
constexpr size_t WS_W = 2 * MiB;
constexpr size_t W_IN = 0, W_BR = W_IN + (size_t)INW * DM * 2, W_OUT = W_BR + (size_t)3 * DM * RW * 2, W_FF1 = W_OUT + (size_t)DM * DM * 2, W_FF2 = W_FF1 + (size_t)DFF * DM * 2, W_END = W_FF2 + (size_t)DM * DFF * 2;
static_assert(W_END <= 35 * MiB, "weights");
constexpr size_t WS_XN = 37 * MiB;
constexpr size_t WS_Z = 77 * MiB;
constexpr size_t Z_RQ = WS_Z, Z_RK = WS_Z + 20 * MiB, Z_RV = WS_Z + 40 * MiB, Z_RG = WS_Z + 60 * MiB, Z_U = WS_Z + 80 * MiB;
constexpr size_t Z_AQ = WS_Z + 120 * MiB, Z_CU = WS_Z + 140 * MiB, Z_CV = WS_Z + 160 * MiB;
constexpr size_t Z_KS = WS_Z + 180 * MiB, Z_VS = Z_KS + (size_t)NB_S * SKV_S * KVW * 2, Z_KP = Z_VS + (size_t)NB_S * SKV_S * KVW * 2, Z_VP = Z_KP + (size_t)NB_P * SEQ_P * KVW * 2, Z_END = Z_VP + (size_t)NB_P * SEQ_P * KVW * 2;
constexpr size_t Z_GATE = WS_Z;
constexpr size_t Z_HB = WS_Z;
constexpr size_t SLAB_P4 = WS_Z, SLAB_P6 = WS_XN;
constexpr size_t WS_NEED = 268 * MiB;
static_assert(Z_END <= WS_NEED, "ws map");
constexpr int CW_BAR = 4096;

constexpr int LDS_BYTES = 147456;
constexpr int MISC_OFF = 131072 + 320;

__device__ __forceinline__ unsigned f2bf(float f) { unsigned u = __builtin_bit_cast(unsigned, f); return (u + 0x7fffu + ((u >> 16) & 1u)) >> 16; }
typedef __bf16 bf16x2_hw __attribute__((ext_vector_type(2)));
__device__ __forceinline__ unsigned pk2(float lo, float hi) { const f32x2 v = {lo, hi}; return __builtin_bit_cast(unsigned, __builtin_convertvector(v, bf16x2_hw)); }
__device__ __forceinline__ float bf2f(unsigned h) { return __builtin_bit_cast(float, h << 16); }
__device__ __forceinline__ float bflo(unsigned w) { return __builtin_bit_cast(float, w << 16); }
__device__ __forceinline__ float bfhi(unsigned w) { return __builtin_bit_cast(float, w & 0xffff0000u); }
__device__ __forceinline__ float sigmoidf_(float x) { return __builtin_amdgcn_rcpf(1.f + __builtin_amdgcn_exp2f(-1.4426950408889634f * x)); }
__device__ __forceinline__ float siluf_(float x) { return x * sigmoidf_(x); }
__device__ __forceinline__ float gelu_tanh(float x) { const float x2 = x * x; const float t = x * (-2.302208198f - 0.1029432397f * x2);
    return x * __builtin_amdgcn_rcpf(1.f + __builtin_amdgcn_exp2f(t)); }
__device__ __forceinline__ float wave_sum(float v) {
#pragma unroll
    for (int o = 1; o < 64; o <<= 1) v += __shfl_xor(v, o);
    return v;
}

#define XB_TMO      128
#define XB_XCNT(j)  (256  + 64 * (j))
#define XB_XSUB(j)  (1280 + 64 * (j))
#define XB_XGEN(j)  (2304 + 64 * (j))
#define XB_TOP      3328
#define XB_TOPGEN   3392
#define XCD_BAR_WORDS 3456
#define XB_SPIN_CAP (1u << 18)
__device__ __forceinline__ unsigned xb_ld(unsigned* p)              { return __hip_atomic_load(p, __ATOMIC_RELAXED, __HIP_MEMORY_SCOPE_AGENT); }
__device__ __forceinline__ unsigned xb_add(unsigned* p, unsigned v) { return __hip_atomic_fetch_add(p, v, __ATOMIC_RELAXED, __HIP_MEMORY_SCOPE_AGENT); }
__device__ __forceinline__ unsigned xb_xcc_id() { return (unsigned)__builtin_amdgcn_s_getreg((3 << 11) | 20) & 0xFu; }
#define XB_SPIN(cond, bar) do { unsigned _sp = 0; while (cond) { __builtin_amdgcn_s_sleep(1); \
    if ((++_sp & 255u) == 0u) { if (xb_ld(&(bar)[XB_TMO])) break; if (_sp > XB_SPIN_CAP) { atomicAdd(&(bar)[XB_TMO], 1u); break; } } } } while (0)
struct XcdBarrier { unsigned* bar; unsigned x; volatile LAS unsigned* st; };
__device__ __forceinline__ XcdBarrier xcd_barrier_post(unsigned* bar, volatile LAS unsigned* st) {
    XcdBarrier b; b.bar = bar; b.x = xb_xcc_id(); b.st = st;
    if (threadIdx.x == 0) (void)xb_add(&bar[XB_XCNT(b.x)], 1u);
    return b;
}
__device__ __forceinline__ void xcd_barrier_complete(unsigned* bar, unsigned x, unsigned& nloc, unsigned& nx) {
    const unsigned G = gridDim.x * gridDim.y * gridDim.z;
    unsigned sum, cnt, mine, sp = 0u;
    for (;;) {
        sum = 0u; cnt = 0u; mine = 0u;
#pragma unroll
        for (unsigned j = 0; j < 16; ++j) { const unsigned c = xb_ld(&bar[XB_XCNT(j)]); sum += c; cnt += (c > 0u) ? 1u : 0u; mine = (j == x) ? c : mine; }
        if (sum == G) break;
        __builtin_amdgcn_s_sleep(1);
        if ((++sp & 255u) == 0u) { if (xb_ld(&bar[XB_TMO])) break; if (sp > XB_SPIN_CAP) { atomicAdd(&bar[XB_TMO], 1u); break; } }
    }
    nloc = mine > 0u ? mine : 1u; nx = cnt > 0u ? cnt : 1u;
}
__device__ __forceinline__ void xcd_barrier(const XcdBarrier& b) {
    asm volatile("s_waitcnt vmcnt(0)" ::: "memory");
    __syncthreads();
    if (threadIdx.x == 0) {
        unsigned* bar = b.bar;
        __builtin_amdgcn_s_waitcnt(0);
        unsigned nloc = b.st[0], nx = b.st[1];
        if (nloc == 0u) { xcd_barrier_complete(bar, b.x, nloc, nx); b.st[0] = nloc; b.st[1] = nx; }
        const unsigned old = xb_add(&bar[XB_XSUB(b.x)], 1u);
        const unsigned gen = old / nloc;
        if (old + 1u == (gen + 1u) * nloc) {
            __builtin_amdgcn_fence(__ATOMIC_RELEASE, "agent");
            asm volatile("s_waitcnt vmcnt(0)" ::: "memory");
            const unsigned og = xb_add(&bar[XB_TOP], 1u);
            const unsigned tg = og / nx;
            if (og + 1u == (tg + 1u) * nx) xb_add(&bar[XB_TOPGEN], 1u);
            else XB_SPIN(xb_ld(&bar[XB_TOPGEN]) == tg, bar);
            __builtin_amdgcn_fence(__ATOMIC_ACQUIRE, "agent");
            xb_add(&bar[XB_XGEN(b.x)], 1u);
            asm volatile("s_waitcnt vmcnt(0)" ::: "memory");
        } else {
            XB_SPIN(xb_ld(&bar[XB_XGEN(b.x)]) == gen, bar);
            __builtin_amdgcn_fence(__ATOMIC_ACQUIRE, "agent");
            asm volatile("s_waitcnt vmcnt(0)" ::: "memory");
        }
    }
    __syncthreads();
}

enum { I_XP = 0, I_XS, I_CK, I_CV, I_ST, I_C, I_CCTX, I_WMOD, I_BMOD, I_GN1, I_GN2, I_WIN, I_GQ, I_GK, I_DECAY, I_RETGN, I_CMNORM, I_CMWS, I_CMBS, I_WBRR, I_WBRA, I_WBRC, I_WOUT, I_WFF1, I_WFF2, I_GFIN, N_IN };
struct Params { const float* in[N_IN]; float* out; unsigned char* ws; int ph_lo, ph_hi; };
static_assert(sizeof(Params) == N_IN * 8 + 8 + 8 + 8, "no padding");

struct Ctx {
    int tid, lane, wave, G, bx, vcu;
    LAS unsigned char* lds;
};
__device__ __forceinline__ int row_ci(int R) { return R < MP ? 0 : 1 + ((R - MP) >> 11); }
__device__ __forceinline__ const float* mod_ptr(const Params& p, int l, int ci, int part) { return (const float*)(p.ws + WS_MOD) + ((size_t)(l * 9 + ci) * 6 + part) * DM; }

__device__ __forceinline__ void p0_modulation(const Params& p, const Ctx& c) {
    LAS float* sl = (LAS float*)c.lds;
    for (int i = c.tid; i < 9 * DM; i += 512) { const int ci = i >> 10, k = i & 1023; const float v = ci == 0 ? p.in[I_CCTX][k] : p.in[I_C][(ci - 1) * DM + k]; sl[i] = siluf_(v); }
    __syncthreads();
    float* mod = (float*)(p.ws + WS_MOD);
    const int gw = c.bx * 8 + c.wave, NGW = c.G * 8;
    constexpr int NITEM = 2 * 96 * 8;
    for (int it = gw; it < NITEM; it += NGW) {
        const int l = it / 768, r = it % 768, cb = r >> 3, ks = r & 7;
        const float* W = p.in[I_WMOD] + (size_t)l * DM * 6144 + (size_t)(ks * 128) * 6144 + cb * 64 + c.lane;
        float s[9];
#pragma unroll
        for (int ci = 0; ci < 9; ++ci) s[ci] = 0.f;
#pragma unroll 4
        for (int k = 0; k < 128; ++k) {
            const float w = W[(size_t)k * 6144];
#pragma unroll
            for (int ci = 0; ci < 9; ++ci) s[ci] += sl[ci * DM + ks * 128 + k] * w;
        }
        const float bias = ks == 0 ? p.in[I_BMOD][l * 6144 + cb * 64 + c.lane] : 0.f;
#pragma unroll
        for (int ci = 0; ci < 9; ++ci) atomicAdd(mod + (size_t)(l * 9 + ci) * 6144 + cb * 64 + c.lane, s[ci] + bias);
    }
    __syncthreads();
}
__device__ __forceinline__ void p0_rope_tables(const Params& p, const Ctx& c) {
    f32x2* tab = (f32x2*)(p.ws + WS_ROPE);
    const int g = c.bx * 512 + c.tid;
    if (g < 96 * 16) { const int pos = g >> 4, i = g & 15; const float inv = 1.0f / powf(10000.0f, (float)(2 * i) / 32.0f); const float posf = pos < 32 ? (float)pos : (float)(pos - 32);
        const float ang = posf * inv; f32x2 v; v.x = cosf(ang); v.y = sinf(ang); tab[g] = v; }
}
__device__ __forceinline__ int win_colmap(int n) {
    const int tile = n >> 8, pp = n & 255, bj = pp >> 7, wc = (pp >> 5) & 3;
    if (tile < 10) return (tile >> 1) * 512 + ((tile & 1) * 4 + wc) * 64 + 32 * bj;
    if (tile == 10) return (wc < 2 ? 2560 + wc * 64 : 2688 + (wc - 2) * 64) + 32 * bj;
    return n;
}
__device__ __forceinline__ void transpose_item(const float* W, int K, int ldn, int src_col0, bf16_t* WT, int dst_row0, int k0, LAS float* scr, int lane) {
#pragma unroll 8
    for (int i = 0; i < 32; ++i) { const int kk = 2 * i + (lane >> 5); scr[kk * 33 + (lane & 31)] = W[(size_t)(k0 + kk) * ldn + src_col0 + (lane & 31)]; }
    asm volatile("s_waitcnt lgkmcnt(0)" ::: "memory");
    const int ch = lane & 7;
#pragma unroll
    for (int j = 0; j < 4; ++j) { const int n = (lane >> 3) + 8 * j; const LAS float* s = scr + (8 * ch) * 33 + n;
        u32x4 o; o.x = pk2(s[0 * 33], s[1 * 33]); o.y = pk2(s[2 * 33], s[3 * 33]); o.z = pk2(s[4 * 33], s[5 * 33]); o.w = pk2(s[6 * 33], s[7 * 33]);
        *(u32x4*)(WT + (size_t)(dst_row0 + n) * K + k0 + 8 * ch) = o; }
    asm volatile("s_waitcnt lgkmcnt(0)" ::: "memory");
}
__device__ __forceinline__ void p_wconv(const Params& p, const Ctx& c, int l) {
    LAS float* scr = (LAS float*)(c.lds + 40960 + c.wave * 8448);
    const int gw = c.bx * 8 + c.wave, NGW = c.G * 8;
    unsigned char* wb = p.ws + WS_W;
    constexpr int I_IN = 16 * 216, I_BRX = 8 * 32, I_O = 16 * 32, I_F1 = 16 * 128, I_F2 = 64 * 32;
    constexpr int NITEMS = I_IN + 3 * I_BRX + I_O + I_F1 + I_F2;
    for (int it = gw; it < NITEMS; it += NGW) {
        int r = it;
        if (r < I_IN) { const int kb = r / 216, nb = r % 216; transpose_item(p.in[I_WIN] + (size_t)l * DM * INW, DM, INW, win_colmap(nb * 32), (bf16_t*)(wb + W_IN), nb * 32, kb * 64, scr, c.lane); continue; } r -= I_IN;
        if (r < 3 * I_BRX) { const int x = r / I_BRX, rr = r % I_BRX, kb = rr / 32, nb = rr % 32;
            const float* src = (x == 0 ? p.in[I_WBRA] : x == 1 ? p.in[I_WBRC] : p.in[I_WBRR]) + (size_t)l * RW * DM;
            transpose_item(src, RW, DM, nb * 32, (bf16_t*)(wb + W_BR) + (size_t)x * DM * RW, nb * 32, kb * 64, scr, c.lane); continue; } r -= 3 * I_BRX;
        if (r < I_O) { const int kb = r / 32, nb = r % 32; transpose_item(p.in[I_WOUT] + (size_t)l * DM * DM, DM, DM, nb * 32, (bf16_t*)(wb + W_OUT), nb * 32, kb * 64, scr, c.lane); continue; } r -= I_O;
        if (r < I_F1) { const int kb = r / 128, nb = r % 128; transpose_item(p.in[I_WFF1] + (size_t)l * DM * DFF, DM, DFF, nb * 32, (bf16_t*)(wb + W_FF1), nb * 32, kb * 64, scr, c.lane); continue; } r -= I_F1;
        { const int kb = r / 32, nb = r % 32; transpose_item(p.in[I_WFF2] + (size_t)l * DFF * DM, DFF, DM, nb * 32, (bf16_t*)(wb + W_FF2), nb * 32, kb * 64, scr, c.lane); }
    }
}
__device__ __forceinline__ void p_kvctx(const Params& p, const Ctx& c, int l) {
    const int g = c.bx * 512 + c.tid, NG = c.G * 512;
    for (int i = g; i < NB_S * PAST * KVW / 4; i += NG) {
        const int e = i * 4, b = e / (PAST * KVW), r = e % (PAST * KVW);
        const size_t src = ((size_t)(b * 2 + l) * PAST) * KVW + r;
        const f32x4 k = *(const f32x4*)(p.in[I_CK] + src), v = *(const f32x4*)(p.in[I_CV] + src);
        u32x2 ko, vo; ko.x = pk2(k.x, k.y); ko.y = pk2(k.z, k.w); vo.x = pk2(v.x, v.y); vo.y = pk2(v.z, v.w);
        *(u32x2*)((bf16_t*)(p.ws + Z_KS) + (size_t)b * SKV_S * KVW + r) = ko;
        *(u32x2*)((bf16_t*)(p.ws + Z_VS) + (size_t)b * SKV_S * KVW + r) = vo;
    }
}
__device__ __forceinline__ const float* x_row(const Params& p, int l, int R) { return l == 0 ? (R < MP ? p.in[I_XP] + (size_t)R * DM : p.in[I_XS] + (size_t)(R - MP) * DM) : p.out + (size_t)R * DM; }
__device__ __forceinline__ void slab_combine(const Params& p, const Ctx& c, int l, int part, const bf16_t* slab, int R, f32x4 (&v)[4]) {
    const float* gv = mod_ptr(p, l, row_ci(R), part);
#pragma unroll
    for (int j = 0; j < 4; ++j) { const bf16_t* s = slab + ((size_t)(((R >> 8) - 64) * 4 + j) * 4 * 256 + (R & 255)) * 256 + 4 * c.lane; f32x4 a = (f32x4){0.f, 0.f, 0.f, 0.f};
#pragma unroll
        for (int q = 0; q < 4; ++q) { const u32x2 w = *(const u32x2*)(s + (size_t)q * 65536); a.x += bflo(w.x); a.y += bfhi(w.x); a.z += bflo(w.y); a.w += bfhi(w.y); }
        v[j] = v[j] + *(const f32x4*)(gv + 4 * c.lane + 256 * j) * a; }
}
__device__ __forceinline__ void p_combine(const Params& p, const Ctx& c, int l, const bf16_t* slab) {
    const int gw = c.bx * 8 + c.wave, NGW = c.G * 8;
    for (int R = 16384 + gw; R < M; R += NGW) {
        float* xr = p.out + (size_t)R * DM; f32x4 v[4];
#pragma unroll
        for (int j = 0; j < 4; ++j) v[j] = *(const f32x4*)(xr + 4 * c.lane + 256 * j);
        slab_combine(p, c, l, 5, slab, R, v);
#pragma unroll
        for (int j = 0; j < 4; ++j) *(f32x4*)(xr + 4 * c.lane + 256 * j) = v[j];
    }
}
__device__ __forceinline__ void p_norm(const Params& p, const Ctx& c, int l, int which, bool comb = false) {
    const int gw = c.bx * 8 + c.wave, NGW = c.G * 8;
    const float* gvec = (which == 0 ? p.in[I_GN1] : p.in[I_GN2]) + l * DM;
    constexpr int NR = 2;
    for (int Rb = gw * NR; Rb < M; Rb += NGW * NR) {
        f32x4 v[NR][4]; float s[NR];
#pragma unroll
        for (int rr = 0; rr < NR; ++rr) { const int R = Rb + rr;
            const float* xr = (which == 0 || (comb && l == 0 && R >= 16384)) ? x_row(p, l, R) : p.out + (size_t)R * DM;
#pragma unroll
            for (int j = 0; j < 4; ++j) v[rr][j] = *(const f32x4*)(xr + 4 * c.lane + 256 * j); }
        if (comb && Rb >= 16384) {
#pragma unroll
            for (int rr = 0; rr < NR; ++rr) { const int R = Rb + rr; slab_combine(p, c, l, 2, (const bf16_t*)(p.ws + SLAB_P4), R, v[rr]);
#pragma unroll
                for (int j = 0; j < 4; ++j) *(f32x4*)(p.out + (size_t)R * DM + 4 * c.lane + 256 * j) = v[rr][j]; } }
#pragma unroll
        for (int rr = 0; rr < NR; ++rr) { s[rr] = 0.f;
#pragma unroll
            for (int j = 0; j < 4; ++j) s[rr] += (v[rr][j].x * v[rr][j].x + v[rr][j].y * v[rr][j].y) + (v[rr][j].z * v[rr][j].z + v[rr][j].w * v[rr][j].w); }
#pragma unroll
        for (int o = 1; o < 64; o <<= 1) {
#pragma unroll
            for (int rr = 0; rr < NR; ++rr) s[rr] += __shfl_xor(s[rr], o); }
#pragma unroll
        for (int rr = 0; rr < NR; ++rr) { const int R = Rb + rr; const int ci = row_ci(R);
            const float* sh = mod_ptr(p, l, ci, which == 0 ? 0 : 3); const float* sc = mod_ptr(p, l, ci, which == 0 ? 1 : 4);
            const float rstd = rsqrtf(s[rr] * (1.f / DM) + EPS);
            bf16_t* orow = (bf16_t*)(p.ws + WS_XN) + (size_t)R * DM;
#pragma unroll
            for (int j = 0; j < 4; ++j) { const int col = 4 * c.lane + 256 * j; const f32x4 g = *(const f32x4*)(gvec + col), a = *(const f32x4*)(sc + col), b2 = *(const f32x4*)(sh + col);
                f32x4 o = v[rr][j] * rstd * g * (a + 1.0f) + b2; u32x2 w; w.x = pk2(o.x, o.y); w.y = pk2(o.z, o.w); *(u32x2*)(orow + col) = w; } }
    }
}
__device__ __forceinline__ void p_final_norm(const Params& p, const Ctx& c, bool comb) {
    const int gw = c.bx * 8 + c.wave, NGW = c.G * 8;
    constexpr int NR = 2;
    for (int Rb = gw * NR; Rb < M; Rb += NGW * NR) {
        f32x4 v[NR][4]; float s[NR];
#pragma unroll
        for (int rr = 0; rr < NR; ++rr) { const float* xr = p.out + (size_t)(Rb + rr) * DM;
#pragma unroll
            for (int j = 0; j < 4; ++j) v[rr][j] = *(const f32x4*)(xr + 4 * c.lane + 256 * j); }
        if (comb && Rb >= 16384) {
#pragma unroll
            for (int rr = 0; rr < NR; ++rr) slab_combine(p, c, 1, 5, (const bf16_t*)(p.ws + SLAB_P6), Rb + rr, v[rr]); }
#pragma unroll
        for (int rr = 0; rr < NR; ++rr) { s[rr] = 0.f;
#pragma unroll
            for (int j = 0; j < 4; ++j) s[rr] += (v[rr][j].x * v[rr][j].x + v[rr][j].y * v[rr][j].y) + (v[rr][j].z * v[rr][j].z + v[rr][j].w * v[rr][j].w); }
#pragma unroll
        for (int o = 1; o < 64; o <<= 1) {
#pragma unroll
            for (int rr = 0; rr < NR; ++rr) s[rr] += __shfl_xor(s[rr], o); }
#pragma unroll
        for (int rr = 0; rr < NR; ++rr) { float* xr = p.out + (size_t)(Rb + rr) * DM; const float rstd = rsqrtf(s[rr] * (1.f / DM) + EPS);
#pragma unroll
            for (int j = 0; j < 4; ++j) { const int col = 4 * c.lane + 256 * j; const f32x4 g = *(const f32x4*)(p.in[I_GFIN] + col); *(f32x4*)(xr + col) = v[rr][j] * rstd * g; } }
    }
}

struct Unit { int pm, pn, k0, nt; };
__host__ __device__ __forceinline__ int perm32(int rho) { const int n = rho >> 4, i = rho & 15; return 8 * (i >> 2) + 4 * n + (i & 3); }
struct StaticOrder {
    int nM, nN, nwg, G, c, ntf;
    __device__ void init(int Mr, int N, int G_, int c_, int K) { nM = Mr / 256; nN = N / 256; nwg = nM * nN; G = G_; c = c_; ntf = K / 64; }
    __device__ bool next(int i, Unit& u) const {
        const long L = (long)i * G + c; if (L >= nwg) return false;
        int wgid = (int)L; { const int q = nwg / 8, r = nwg % 8, xcd = wgid % 8, off = wgid / 8; wgid = (xcd < r ? xcd * (q + 1) : r * (q + 1) + (xcd - r) * q) + off; }
        const int nig = 8 * nN, gid = wgid / nig, fm = gid * 8, gsz = (nM - fm) < 8 ? (nM - fm) : 8;
        u.pm = fm + ((wgid % nig) % gsz); u.pn = (wgid % nig) / gsz; u.k0 = 0; u.nt = ntf; return true;
    }
    __device__ __forceinline__ void a_ready(const Unit&) const {}
    __device__ __forceinline__ void done(const Unit&) const {}
};
struct MergeOrder {
    int G, c;
    __device__ bool next(int i, Unit& u) const {
        const int t = i / 3, x = i % 3; const long L = (long)t * G + c; if (L >= 320) return false;
        u.pm = x * 80 + (int)(L >> 2); u.pn = x * 4 + (int)(L & 3); u.k0 = 0; u.nt = RW / 64; return true;
    }
    __device__ __forceinline__ void a_ready(const Unit&) const {}
    __device__ __forceinline__ void done(const Unit&) const {}
};
struct QuarterOrder {
    int G, c, ntf; bool quarter;
    __device__ void init(int G_, int c_, int K) { G = G_; c = (G_ % 8 == 0) ? (c_ % 8) * (G_ / 8) + c_ / 8 : c_; ntf = K / 64; quarter = (G_ == 256); }
    __device__ bool next(int i, Unit& u) const {
        if (quarter) { if (i == 0) { u.pm = c >> 2; u.pn = c & 3; u.k0 = 0; u.nt = ntf; return true; }
            if (i == 1) { const int t = 256 + (c >> 2); u.pm = t >> 2; u.pn = t & 3; u.k0 = (c & 3) * (ntf >> 2); u.nt = ntf >> 2; return true; }
            return false; }
        const long L = (long)i * G + c; if (L >= 320) return false;
        u.pm = (int)(L >> 2); u.pn = (int)(L & 3); u.k0 = 0; u.nt = ntf; return true;
    }
    __device__ __forceinline__ void a_ready(const Unit&) const {}
    __device__ __forceinline__ void done(const Unit&) const {}
};
template <class Epi, class Sched>
__device__ __forceinline__ void gemm_simple(const Ctx& c, const bf16_t* A, const bf16_t* Bt, int K, const Sched& S, const Epi& E) {
    const int tid = c.tid, wid = c.wave, lane = tid & 63, wr = wid >> 2, wc = wid & 3, fr = lane & 15, fq = lane >> 4;
    Unit u; bool clear = true;
    f32x4 acc[2][2][4][2];
    for (int ui = 0; S.next(ui, u); ++ui) {
        if (clear) {
#pragma unroll
        for (int a = 0; a < 2; ++a)
#pragma unroll
            for (int b = 0; b < 2; ++b)
#pragma unroll
                for (int m = 0; m < 4; ++m)
#pragma unroll
                    for (int n = 0; n < 2; ++n) acc[a][b][m][n] = (f32x4){0.f, 0.f, 0.f, 0.f};
        }
        if constexpr (Epi::CHAIN) clear = !E.keep(u);
        const bf16_t* Ar = A + (size_t)(u.pm * 256 + wr * 64 + fr) * K + fq * 8;
        const bf16_t* Br[2];
#pragma unroll
        for (int n = 0; n < 2; ++n) Br[n] = Bt + (size_t)(u.pn * 256 + wc * 32 + (Epi::PERM ? perm32(16 * n + fr) : 16 * n + fr)) * K + fq * 8;
#pragma unroll 1
        for (int k0 = u.k0 * 64; k0 < (u.k0 + u.nt) * 64; k0 += 32) {
            bf16x8 tf[2][4], wf[2][2];
#pragma unroll
            for (int ai = 0; ai < 2; ++ai)
#pragma unroll
                for (int m = 0; m < 4; ++m) tf[ai][m] = *(const bf16x8*)(Ar + (size_t)(ai * 128 + m * 16) * K + k0);
#pragma unroll
            for (int bj = 0; bj < 2; ++bj)
#pragma unroll
                for (int n = 0; n < 2; ++n) wf[bj][n] = *(const bf16x8*)(Br[n] + (size_t)(bj * 128) * K + k0);
#pragma unroll
            for (int ai = 0; ai < 2; ++ai)
#pragma unroll
                for (int bj = 0; bj < 2; ++bj)
#pragma unroll
                    for (int m = 0; m < 4; ++m)
#pragma unroll
                        for (int n = 0; n < 2; ++n) acc[ai][bj][m][n] = __builtin_amdgcn_mfma_f32_16x16x32_bf16(wf[bj][n], tf[ai][m], acc[ai][bj][m][n], 0, 0, 0);
        }
        E(acc, u, wr, wc, fr, fq);
    }
}

namespace pg8 {
#define PG8_LAS __attribute__((address_space(3)))
constexpr int BM = 256, BK = 64, HALF = 128, HTB = HALF * BK * 2  , STAGE_BYTES = 8 * HTB, NXCD = 8, WGM = 8;

__host__ __device__ __forceinline__ int lds_byte(int r, int c) { const int st = (r >> 4) * 2 + (c >> 5), rr = r & 15, cc = c & 31, ob = rr * 64 + cc * 2; return st * 1024 + (ob ^ (((ob >> 9) & 1) << 5)); }
__host__ __device__ __forceinline__ void stage_rc(int b, int& R, int& C) { const int st = b / 1024, sb = b % 1024, swz = sb ^ (((sb >> 9) & 1) << 5); R = (st >> 1) * 16 + swz / 64; C = (st & 1) * 32 + (swz % 64) / 2; }
struct Gemm { const bf16_t* A; const bf16_t* Bt; int M, N, K; unsigned long long* ts; };
#define PG8_STAMP(k) do { if (g.ts && blockIdx.x == 0 && tid == 0) g.ts[k] = __builtin_amdgcn_s_memrealtime(); } while (0)
template <class Epi, class Sched, bool ALIGN_EPI = false, bool SP2 = false>
__device__ __forceinline__ void gemm_phase(int tid_in, PG8_LAS unsigned char* lds, const Gemm g, const Sched& S, const Epi& E) {
    const int tid = tid_in, wid = __builtin_amdgcn_readfirstlane(tid >> 6), lane = tid & 63, wr = wid >> 2, wc = wid & 3, fr = lane & 15, fq = lane >> 4;
    const int K = g.K;
    unsigned voffA[2], voffB[2];
#pragma unroll
    for (int i = 0; i < 2; ++i) { int R, C; stage_rc(tid * 16 + i * 8192, R, C); const int Rb = Epi::PERM ? ((R & ~31) + perm32(R & 31)) : R;
        voffA[i] = (unsigned)(R * K + C) * 2u; voffB[i] = (unsigned)(Rb * K + C) * 2u; }
    const size_t kstep = (size_t)(BK * 2);
    const size_t hstep = (size_t)HALF * K * 2;
    const size_t tstep = 2 * hstep;
    const unsigned ldsw = (unsigned)wid * 1024u;
    const int aoff = lds_byte(wr * 64 + fr, fq * 8), boff = lds_byte(wc * 32 + fr, fq * 8);
#define PG8_SA(b, h) (((b) * 2 + (h)) * HTB)
#define PG8_SB(b, h) ((4 + (b) * 2 + (h)) * HTB)
#define PG8_STAGE(bufoff, gbase, voff) do { _Pragma("unroll") for (int _i = 0; _i < 2; ++_i) \
        __builtin_amdgcn_global_load_lds((const unsigned*)((const char*)(gbase) + (voff)[_i]), (PG8_LAS unsigned*)(lds + (bufoff) + ldsw + _i * 8192), 16, 0, 0); } while (0)
#define PG8_LDA(dst, b, h) do { _Pragma("unroll") for (int m = 0; m < 4; ++m) _Pragma("unroll") for (int k = 0; k < 2; ++k) dst[m][k] = *(const PG8_LAS bf16x8*)(lds + PG8_SA(b, h) + aoff + m * 2048 + k * 1024); } while (0)
#define PG8_LDB(dst, b, h) do { _Pragma("unroll") for (int n = 0; n < 2; ++n) _Pragma("unroll") for (int k = 0; k < 2; ++k) dst[n][k] = *(const PG8_LAS bf16x8*)(lds + PG8_SB(b, h) + boff + n * 2048 + k * 1024); } while (0)
#define PG8_MMA(ai, bj, At, Bt) do { __builtin_amdgcn_s_setprio(1); _Pragma("unroll") for (int m = 0; m < 4; ++m) _Pragma("unroll") for (int n = 0; n < 2; ++n) _Pragma("unroll") for (int k = 0; k < 2; ++k) \
        acc[ai][bj][m][n] = __builtin_amdgcn_mfma_f32_16x16x32_bf16(Bt[n][k], At[m][k], acc[ai][bj][m][n], 0, 0, 0); __builtin_amdgcn_s_setprio(0); } while (0)
#define PG8_WAIT_V(n) asm volatile("s_waitcnt vmcnt(" #n ")" ::: "memory")
#define PG8_WAIT_L(n) asm volatile("s_waitcnt lgkmcnt(" #n ")" ::: "memory")
#define PG8_BAR __builtin_amdgcn_s_barrier()
#define PG8_SCHED __builtin_amdgcn_sched_barrier(0)
    Unit cur, nxt; int ui = 0;
    PG8_STAMP(42);
    if (!S.next(0, cur)) return;
    f32x4 acc[2][2][4][2];
#pragma unroll
    for (int a = 0; a < 2; ++a)
#pragma unroll
        for (int b = 0; b < 2; ++b)
#pragma unroll
            for (int m = 0; m < 4; ++m)
#pragma unroll
                for (int n = 0; n < 2; ++n) acc[a][b][m][n] = (f32x4){0.f, 0.f, 0.f, 0.f};
    bf16x8 At[4][2], B0[2][2], B1[2][2];
    const char* cA = (const char*)g.A + (size_t)cur.pm * tstep + (size_t)cur.k0 * kstep; const char* cB = (const char*)g.Bt + (size_t)cur.pn * tstep + (size_t)cur.k0 * kstep;
    S.a_ready(cur);
    if constexpr (SP2) {
        PG8_STAGE(PG8_SB(0, 0), cB, voffB); PG8_STAGE(PG8_SB(0, 1), cB + hstep, voffB); PG8_STAGE(PG8_SA(0, 0), cA, voffA); PG8_STAGE(PG8_SA(0, 1), cA + hstep, voffA);
        if (wr == 1) PG8_BAR;
        PG8_WAIT_V(2); PG8_BAR;
        PG8_STAGE(PG8_SB(1, 0), cB + kstep, voffB); PG8_STAGE(PG8_SA(1, 0), cA + kstep, voffA); PG8_STAGE(PG8_SB(1, 1), cB + hstep + kstep, voffB);
        PG8_WAIT_V(6); PG8_BAR;
    } else {
        PG8_STAGE(PG8_SB(0, 0), cB, voffB); PG8_STAGE(PG8_SA(0, 0), cA, voffA); PG8_STAGE(PG8_SB(0, 1), cB + hstep, voffB); PG8_STAGE(PG8_SA(0, 1), cA + hstep, voffA);
        if (wr == 1) PG8_BAR;
        PG8_WAIT_V(4); PG8_BAR;
        PG8_STAGE(PG8_SB(1, 0), cB + kstep, voffB); PG8_STAGE(PG8_SA(1, 0), cA + kstep, voffA); PG8_STAGE(PG8_SB(1, 1), cB + hstep + kstep, voffB);
        PG8_WAIT_V(6); PG8_BAR;
    }
    PG8_STAMP(43);
    for (;;) {
        const bool has_next = S.next(ui + 1, nxt);
        const char* nA = has_next ? (const char*)g.A + (size_t)nxt.pm * tstep + (size_t)nxt.k0 * kstep : cA; const char* nB = has_next ? (const char*)g.Bt + (size_t)nxt.pn * tstep + (size_t)nxt.k0 * kstep : cB;
        const int nt = cur.nt;
        for (int t = 0; t < nt; t += 2) {
            const bool last = (t == nt - 2);
            const char* a1 = cA + (size_t)(t + 1) * kstep;
            const char* a2 = last ? nA : cA + (size_t)(t + 2) * kstep; const char* b2 = last ? nB : cB + (size_t)(t + 2) * kstep;
            const char* a3 = a2 + kstep; const char* b3 = b2 + kstep;
            if (last && has_next) S.a_ready(nxt);
            if constexpr (SP2) {
            PG8_LDB(B0, 0, 0); PG8_LDB(B1, 0, 1); PG8_SCHED; PG8_LDA(At, 0, 0); PG8_STAGE(PG8_SA(1, 1), a1 + hstep, voffA);
            PG8_WAIT_V(8); PG8_WAIT_L(0); PG8_BAR; PG8_MMA(0, 0, At, B0); PG8_MMA(0, 1, At, B1); PG8_BAR; PG8_SCHED;
            PG8_LDA(At, 0, 1); PG8_STAGE(PG8_SB(0, 0), b2, voffB); PG8_STAGE(PG8_SB(0, 1), b2 + hstep, voffB); PG8_STAGE(PG8_SA(0, 0), a2, voffA);
            PG8_WAIT_V(8); PG8_WAIT_L(0); PG8_BAR; PG8_MMA(1, 0, At, B0); PG8_MMA(1, 1, At, B1); PG8_BAR; PG8_SCHED;
            PG8_LDB(B0, 1, 0); PG8_LDB(B1, 1, 1); PG8_SCHED; PG8_LDA(At, 1, 0); PG8_STAGE(PG8_SA(0, 1), a2 + hstep, voffA);
            PG8_WAIT_V(8); PG8_WAIT_L(0); PG8_BAR; PG8_MMA(0, 0, At, B0); PG8_MMA(0, 1, At, B1); PG8_BAR; PG8_SCHED;
            PG8_LDA(At, 1, 1); PG8_STAGE(PG8_SB(1, 0), b3, voffB); PG8_STAGE(PG8_SB(1, 1), b3 + hstep, voffB); PG8_STAGE(PG8_SA(1, 0), a3, voffA);
            PG8_WAIT_V(8); PG8_WAIT_L(0); PG8_BAR; PG8_MMA(1, 0, At, B0); PG8_MMA(1, 1, At, B1); PG8_BAR; PG8_SCHED;
            } else {
            PG8_LDB(B0, 0, 0); PG8_SCHED; PG8_LDA(At, 0, 0); PG8_STAGE(PG8_SA(1, 1), a1 + hstep, voffA);
            PG8_WAIT_L(8); PG8_BAR; PG8_WAIT_L(0); PG8_MMA(0, 0, At, B0); PG8_BAR; PG8_SCHED;
            PG8_LDB(B1, 0, 1); PG8_STAGE(PG8_SB(0, 0), b2, voffB);
            PG8_BAR; PG8_WAIT_L(0); PG8_MMA(0, 1, At, B1); PG8_BAR;
            PG8_LDA(At, 0, 1); PG8_STAGE(PG8_SA(0, 0), a2, voffA);
            PG8_BAR; PG8_WAIT_L(0); PG8_MMA(1, 0, At, B0); PG8_BAR; PG8_SCHED;
            PG8_STAGE(PG8_SB(0, 1), b2 + hstep, voffB);
            PG8_WAIT_V(6); PG8_BAR; PG8_MMA(1, 1, At, B1); PG8_BAR;
            PG8_LDB(B0, 1, 0); PG8_SCHED; PG8_LDA(At, 1, 0); PG8_STAGE(PG8_SA(0, 1), a2 + hstep, voffA);
            PG8_WAIT_L(8); PG8_BAR; PG8_WAIT_L(0); PG8_MMA(0, 0, At, B0); PG8_BAR; PG8_SCHED;
            PG8_LDB(B1, 1, 1); PG8_STAGE(PG8_SB(1, 0), b3, voffB);
            PG8_BAR; PG8_WAIT_L(0); PG8_MMA(0, 1, At, B1); PG8_BAR;
            PG8_LDA(At, 1, 1); PG8_STAGE(PG8_SA(1, 0), a3, voffA);
            PG8_BAR; PG8_WAIT_L(0); PG8_MMA(1, 0, At, B0); PG8_BAR; PG8_SCHED;
            PG8_STAGE(PG8_SB(1, 1), b3 + hstep, voffB);
            PG8_WAIT_V(6); PG8_BAR; PG8_MMA(1, 1, At, B1); PG8_BAR;
            }
        }
        if (ui == 0) PG8_STAMP(44);
        if constexpr (ALIGN_EPI) { if (wr == 0) PG8_BAR; }
        if constexpr (!Epi::AFTER_DRAIN) { E(acc, cur, wr, wc, fr, fq); S.done(cur); }
        if (ui == 0) PG8_STAMP(45);
        if (!has_next) break;
        bool clear = true; if constexpr (Epi::CHAIN) clear = !E.keep(cur);
        if (clear) {
#pragma unroll
        for (int a = 0; a < 2; ++a)
#pragma unroll
            for (int b = 0; b < 2; ++b)
#pragma unroll
                for (int m = 0; m < 4; ++m)
#pragma unroll
                    for (int n = 0; n < 2; ++n) acc[a][b][m][n] = (f32x4){0.f, 0.f, 0.f, 0.f};
        }
        cur = nxt; cA = nA; cB = nB; ++ui;
        if constexpr (ALIGN_EPI) { if (wr == 1) PG8_BAR; }
    }
    PG8_STAMP(46);
    PG8_WAIT_V(0);
    if constexpr (!ALIGN_EPI) { if (wr == 0) PG8_BAR; }
    PG8_BAR;
    if constexpr (Epi::AFTER_DRAIN) { E.fused(acc, cur, wr, wc, fr, fq, lds, wid, lane); S.done(cur); }
#undef PG8_SA
#undef PG8_SB
#undef PG8_STAGE
#undef PG8_LDA
#undef PG8_LDB
#undef PG8_MMA
#undef PG8_WAIT_V
#undef PG8_WAIT_L
#undef PG8_BAR
#undef PG8_SCHED
}
}

__device__ __forceinline__ u32x4 pack8(const f32x4& a, const f32x4& b) { u32x4 w; w.x = pk2(a.x, a.y); w.y = pk2(a.z, a.w); w.z = pk2(b.x, b.y); w.w = pk2(b.z, b.w); return w; }
__device__ __forceinline__ void rope4(f32x4& v, const f32x2 cs0, const f32x2 cs1) {
    const float a0 = v.x * cs0.x - v.y * cs0.y, a1 = v.x * cs0.y + v.y * cs0.x, a2 = v.z * cs1.x - v.w * cs1.y, a3 = v.z * cs1.y + v.w * cs1.x;
    v.x = a0; v.y = a1; v.z = a2; v.w = a3;
}
struct EpiMix {
    static constexpr bool PERM = true, AFTER_DRAIN = false, CHAIN = false;
    const Params* pp; int l;
    __device__ __forceinline__ void operator()(const f32x4 (&acc)[2][2][4][2], const Unit& u, int wr, int wc, int fr, int fq) const {
        const Params& p = *pp;
        const int pn = u.pn, R0 = u.pm * 256; const bool smp = R0 >= MP;
        const int b = smp ? (R0 - MP) >> 11 : R0 >> 8, t0 = smp ? (R0 - MP) & 2047 : 0;
        const f32x2* cs_row = (const f32x2*)(p.ws + WS_ROPE); const f32x2* cs_col = cs_row + 32 * 16;
        if (pn >= 11) {
            bf16_t* dst = (bf16_t*)(p.ws + (pn < 13 ? Z_CU : Z_CV)) + ((pn - 11) & 1) * 256 + wc * 32 + 8 * fq;
#pragma unroll
            for (int ai = 0; ai < 2; ++ai)
#pragma unroll
                for (int m = 0; m < 4; ++m) { const int R = R0 + ai * 128 + wr * 64 + m * 16 + fr;
#pragma unroll
                    for (int bj = 0; bj < 2; ++bj) { f32x4 v0 = acc[ai][bj][m][0], v1 = acc[ai][bj][m][1];
#pragma unroll
                        for (int r = 0; r < 4; ++r) { v0[r] = gelu_tanh(v0[r]); v1[r] = gelu_tanh(v1[r]); }
                        *(u32x4*)(dst + (size_t)R * RW + bj * 128) = pack8(v0, v1); } }
            return;
        }
        const int kind = pn >> 1;
        const bool is_k = (pn == 10 && wc < 2), is_v = (pn == 10 && wc >= 2);
        const float* gqk = (kind == 4 ? p.in[I_GQ] : p.in[I_GK]) + l * HD + 8 * fq;
        const int head = (pn & 1) * 4 + wc;
        const bool norm = (kind == 4 || is_k), rope = smp && (kind == 0 || kind == 1 || kind == 4 || is_k);
        const float post = kind == 1 ? 0.125f : (kind == 4 ? C2 : 1.0f);
#pragma unroll
        for (int ai = 0; ai < 2; ++ai)
#pragma unroll
            for (int m = 0; m < 4; ++m) {
                const int rr = ai * 128 + wr * 64 + m * 16 + fr, R = R0 + rr, t = t0 + rr;
                float rs = 1.0f;
                if (norm) {
                    float ss = 0.f;
#pragma unroll
                    for (int bj = 0; bj < 2; ++bj)
#pragma unroll
                        for (int n = 0; n < 2; ++n) { const f32x4 x = acc[ai][bj][m][n]; ss += (x.x * x.x + x.y * x.y) + (x.z * x.z + x.w * x.w); }
                    ss += __shfl_xor(ss, 16); ss += __shfl_xor(ss, 32);
                    rs = rsqrtf(ss * (1.f / HD) + EPS);
                }
                bf16_t* dst;
                if (kind < 5) dst = (bf16_t*)(p.ws + (kind == 0 ? Z_RQ : kind == 1 ? Z_RK : kind == 2 ? Z_RV : kind == 3 ? Z_RG : Z_AQ)) + (size_t)R * RW + head * HD + 8 * fq;
                else { const int hk = wc & 1;
                    if (smp) dst = (bf16_t*)(p.ws + (is_k ? Z_KS : Z_VS)) + ((size_t)b * SKV_S + PAST + t) * KVW + hk * HD + 8 * fq;
                    else dst = (bf16_t*)(p.ws + (is_k ? Z_KP : Z_VP)) + ((size_t)b * SEQ_P + t) * KVW + hk * HD + 8 * fq; }
                float* cdst = p.out + (is_k ? OUT_CK : OUT_CV) + ((size_t)((b * 2 + l) * SEQ_P + t) * 2 + (wc & 1)) * HD + 8 * fq;
#pragma unroll
                for (int bj = 0; bj < 2; ++bj) {
                    f32x4 v0 = acc[ai][bj][m][0], v1 = acc[ai][bj][m][1];
                    if (norm) { const f32x4 g0 = *(const f32x4*)(gqk + 32 * bj), g1 = *(const f32x4*)(gqk + 32 * bj + 4); v0 = v0 * rs * g0; v1 = v1 * rs * g1; }
                    if (pn == 10 && !smp) { *(f32x4*)(cdst + 32 * bj) = v0; *(f32x4*)(cdst + 32 * bj + 4) = v1; }
                    if (kind == 3) {
#pragma unroll
                        for (int r = 0; r < 4; ++r) { v0[r] = siluf_(v0[r]); v1[r] = siluf_(v1[r]); } }
                    if (rope) {
                        const f32x2* tab = (bj == 0 ? cs_row + (t >> 6) * 16 : cs_col + (t & 63) * 16) + 4 * fq;
                        rope4(v0, tab[0], tab[1]); rope4(v1, tab[2], tab[3]); }
                    v0 = v0 * post; v1 = v1 * post;
                    *(u32x4*)(dst + 32 * bj) = pack8(v0, v1);
                    asm volatile("" ::: "memory");
                }
            }
    }
};
__device__ __forceinline__ size_t gate_off(int x, int pm, int pn, int ai, int m, int bj, int wid, int lane) {
    return ((((size_t)(x * 80 + pm) * 4 + pn) * 16 + (ai * 4 + m) * 2 + bj) * 512 + wid * 64 + lane) * 8; }
struct EpiGate {
    static constexpr bool PERM = true, AFTER_DRAIN = false, CHAIN = false;
    const Params* pp;
    __device__ __forceinline__ void operator()(const f32x4 (&acc)[2][2][4][2], const Unit& u, int wr, int wc, int fr, int fq) const {
        const int x = u.pn >> 2; bf16_t* dst = (bf16_t*)(pp->ws + Z_GATE); const int wid = wr * 4 + wc, lane = fq * 16 + fr;
#pragma unroll
        for (int ai = 0; ai < 2; ++ai)
#pragma unroll
            for (int m = 0; m < 4; ++m) {
#pragma unroll
                for (int bj = 0; bj < 2; ++bj) { f32x4 v0 = acc[ai][bj][m][0], v1 = acc[ai][bj][m][1];
#pragma unroll
                    for (int r = 0; r < 4; ++r) { v0[r] = sigmoidf_(fminf(fmaxf(v0[r], -30.f), 30.f)); v1[r] = sigmoidf_(fminf(fmaxf(v1[r], -30.f), 30.f)); }
                    *(u32x4*)(dst + gate_off(x, u.pm, u.pn & 3, ai, m, bj, wid, lane)) = pack8(v0, v1); } }
    }
};
struct EpiMerge {
    static constexpr bool PERM = true, AFTER_DRAIN = false, CHAIN = true;
    const Params* pp;
    __device__ __forceinline__ bool keep(const Unit& u) const { return (u.pn >> 2) != 2; }
    __device__ __forceinline__ void operator()(f32x4 (&acc)[2][2][4][2], const Unit& u, int wr, int wc, int fr, int fq) const {
        const int x = u.pn >> 2, pm = u.pm - 80 * x;
        const int col0 = (u.pn & 3) * 256 + wc * 32 + 8 * fq;
        const int gnum = x == 0 ? 1 : x == 1 ? 2 : 0, gden = x == 0 ? 2 : 0;
        const bf16_t* gbase = (const bf16_t*)(pp->ws + Z_GATE); const int wid = wr * 4 + wc, lane = fq * 16 + fr, pnc = u.pn & 3;
        bf16_t* dst = (bf16_t*)(pp->ws + WS_XN) + col0;
#pragma unroll
        for (int aim = 0; aim < 4; ++aim) { const int ai = aim >> 1, m0 = (aim & 1) * 2;
            u32x4 gnv[4][2], gdv[4][2];
#pragma unroll
            for (int m = m0; m < m0 + 2; ++m) { const int R = pm * 256 + ai * 128 + wr * 64 + m * 16 + fr;
#pragma unroll
                for (int bj = 0; bj < 2; ++bj) { gnv[m][bj] = *(const u32x4*)(gbase + gate_off(gnum, pm, pnc, ai, m, bj, wid, lane)); if (x != 2) gdv[m][bj] = *(const u32x4*)(gbase + gate_off(gden, pm, pnc, ai, m, bj, wid, lane)); } }
#pragma unroll
            for (int m = m0; m < m0 + 2; ++m) { const int R = pm * 256 + ai * 128 + wr * 64 + m * 16 + fr;
#pragma unroll
                for (int bj = 0; bj < 2; ++bj) {
                    const u32x4 g = gnv[m][bj];
                    f32x4 s0 = (f32x4){bflo(g.x), bfhi(g.x), bflo(g.y), bfhi(g.y)}, s1 = (f32x4){bflo(g.z), bfhi(g.z), bflo(g.w), bfhi(g.w)};
                    if (x != 2) { const u32x4 d = gdv[m][bj];
                        s0.x *= __builtin_amdgcn_rcpf(bflo(d.x)); s0.y *= __builtin_amdgcn_rcpf(bfhi(d.x)); s0.z *= __builtin_amdgcn_rcpf(bflo(d.y)); s0.w *= __builtin_amdgcn_rcpf(bfhi(d.y));
                        s1.x *= __builtin_amdgcn_rcpf(bflo(d.z)); s1.y *= __builtin_amdgcn_rcpf(bfhi(d.z)); s1.z *= __builtin_amdgcn_rcpf(bflo(d.w)); s1.w *= __builtin_amdgcn_rcpf(bfhi(d.w)); }
                    acc[ai][bj][m][0] = acc[ai][bj][m][0] * s0; acc[ai][bj][m][1] = acc[ai][bj][m][1] * s1;
                    if (x == 2) *(u32x4*)(dst + (size_t)R * DM + bj * 128) = pack8(acc[ai][bj][m][0], acc[ai][bj][m][1]); } }
            asm volatile("" ::: "memory");
        }
    }
};
struct EpiRes {
    static constexpr bool PERM = false, AFTER_DRAIN = false, CHAIN = false;
    const Params* pp; int l, part; bool from_inputs; int ntf; bf16_t* slab;
    __device__ __forceinline__ void operator()(const f32x4 (&acc)[2][2][4][2], const Unit& u, int wr, int wc, int fr, int fq) const {
        const Params& p = *pp; const int R0 = u.pm * 256; const int ci = row_ci(R0);
        if (u.nt != ntf) {
            bf16_t* s = slab + ((size_t)((u.pm * 4 + u.pn - 256) * 4 + u.k0 / u.nt) * 256) * 256 + wc * 32 + 4 * fq;
#pragma unroll
            for (int ai = 0; ai < 2; ++ai)
#pragma unroll
                for (int m = 0; m < 4; ++m) { const int rr = ai * 128 + wr * 64 + m * 16 + fr;
#pragma unroll
                    for (int bj = 0; bj < 2; ++bj)
#pragma unroll
                        for (int n = 0; n < 2; ++n) { const f32x4 v = acc[ai][bj][m][n]; u32x2 w; w.x = pk2(v.x, v.y); w.y = pk2(v.z, v.w); *(u32x2*)(s + (size_t)rr * 256 + bj * 128 + n * 16) = w; } }
            return;
        }
        const float* gv = mod_ptr(p, l, ci, part) + u.pn * 256 + wc * 32 + 4 * fq;
        f32x4 g[2][2];
#pragma unroll
        for (int bj = 0; bj < 2; ++bj)
#pragma unroll
            for (int n = 0; n < 2; ++n) g[bj][n] = *(const f32x4*)(gv + bj * 128 + n * 16);
#pragma unroll
        for (int aim = 0; aim < 4; ++aim) { const int ai = aim >> 1, m0 = (aim & 1) * 2;
            f32x4 xv[4][2][2];
#pragma unroll
            for (int m = m0; m < m0 + 2; ++m) { const int R = R0 + ai * 128 + wr * 64 + m * 16 + fr;
                const float* xs = (from_inputs ? x_row(p, 0, R) : p.out + (size_t)R * DM) + u.pn * 256 + wc * 32 + 4 * fq;
#pragma unroll
                for (int bj = 0; bj < 2; ++bj)
#pragma unroll
                    for (int n = 0; n < 2; ++n) xv[m][bj][n] = *(const f32x4*)(xs + bj * 128 + n * 16); }
#pragma unroll
            for (int m = m0; m < m0 + 2; ++m) { const int R = R0 + ai * 128 + wr * 64 + m * 16 + fr;
                float* xo = p.out + (size_t)R * DM + u.pn * 256 + wc * 32 + 4 * fq;
#pragma unroll
                for (int bj = 0; bj < 2; ++bj)
#pragma unroll
                    for (int n = 0; n < 2; ++n) *(f32x4*)(xo + bj * 128 + n * 16) = xv[m][bj][n] + g[bj][n] * acc[ai][bj][m][n]; }
            asm volatile("" ::: "memory");
        }
    }
};
struct EpiFF1 {
    static constexpr bool PERM = true, AFTER_DRAIN = false, CHAIN = false;
    const Params* pp;
    __device__ __forceinline__ void operator()(const f32x4 (&acc)[2][2][4][2], const Unit& u, int wr, int wc, int fr, int fq) const {
        bf16_t* dst = (bf16_t*)(pp->ws + Z_HB) + u.pn * 256 + wc * 32 + 8 * fq;
#pragma unroll
        for (int ai = 0; ai < 2; ++ai)
#pragma unroll
            for (int m = 0; m < 4; ++m) { const int R = u.pm * 256 + ai * 128 + wr * 64 + m * 16 + fr;
#pragma unroll
                for (int bj = 0; bj < 2; ++bj) { f32x4 v0 = acc[ai][bj][m][0], v1 = acc[ai][bj][m][1];
#pragma unroll
                    for (int r = 0; r < 4; ++r) { const float a = fmaxf(v0[r], 0.f), b = fmaxf(v1[r], 0.f); v0[r] = a * a; v1[r] = b * b; }
                    *(u32x4*)(dst + (size_t)R * DFF + bj * 128) = pack8(v0, v1); } }
    }
};

namespace attn_body {
using bf16=__hip_bfloat16;
using bf16x8=__attribute__((ext_vector_type(8)))short;
using s16x4=__attribute__((ext_vector_type(4)))short;
using f32x16=__attribute__((ext_vector_type(16)))float;
using u32x4=__attribute__((ext_vector_type(4)))unsigned;
constexpr int D=64,QP=512,KP=128;
constexpr int NW=8,QBLK=32,QB=QBLK*NW,KVBLK=64;
__device__ __forceinline__ int crow(int r,int hi){return (r&3)+8*(r>>2)+4*hi;}
#define SBAR() __builtin_amdgcn_sched_barrier(0)
constexpr int NSLOT=3, SLOTB=8192;
constexpr int LDS_K=0, LDS_V=NSLOT*SLOTB, LDS_WS=2*NSLOT*SLOTB, LDS_OST=LDS_WS+NW*64*4, LDS_BYTES=LDS_OST+NW*4096;
constexpr float C2=0.125f*1.4426950408889634f;
__device__ __forceinline__ void glds16(const void*gsrc,unsigned lds_dst){unsigned keep;
  asm volatile("s_mov_b32 %0, m0\n\ts_mov_b32 m0, %2\n\ts_nop 0\n\tglobal_load_lds_dwordx4 %1, off\n\ts_mov_b32 m0, %0":"=&s"(keep):"v"(gsrc),"s"(lds_dst):"memory");}
__device__ __forceinline__ float max3f(float a,float b,float c){float r;asm("v_max3_f32 %0, %1, %2, %3":"=v"(r):"v"(a),"v"(b),"v"(c));return r;}
__device__ __forceinline__ float max2f(float a,float b){float r;asm("v_max_f32_e32 %0, %1, %2":"=v"(r):"v"(a),"v"(b));return r;}
__device__ __forceinline__ float fadd_s(float a,float b){float r;asm("v_add_f32_e32 %0, %1, %2":"=v"(r):"v"(a),"v"(b));return r;}
__device__ __forceinline__ float fsub_s(float a,float b){float r;asm("v_sub_f32_e32 %0, %1, %2":"=v"(r):"v"(a),"v"(b));return r;}
typedef float f32x2_t __attribute__((ext_vector_type(2))); typedef __bf16 bf16x2_t __attribute__((ext_vector_type(2)));
__device__ __forceinline__ unsigned cvtpk_s(float lo,float hi){f32x2_t v={lo,hi};bf16x2_t b=__builtin_convertvector(v,bf16x2_t);return __builtin_bit_cast(unsigned,b);}
#define WAIT_BAR(N) asm volatile("s_waitcnt vmcnt(" #N ") lgkmcnt(0)\n\ts_barrier":::"memory")

__device__ __forceinline__ void qkt(f32x16&p0,f32x16&p1,const char*Kslot,const bf16x8*qr,const f32x16&negm,int r32,int hi){
  const char*kb=Kslot+hi*1024+r32*16;
  #pragma unroll
  for(int d0=0;d0<4;++d0){
    const bf16x8 b0=*reinterpret_cast<const bf16x8*>(kb+d0*2048);
    const bf16x8 b1=*reinterpret_cast<const bf16x8*>(kb+d0*2048+512);
    if(d0==0){p0=__builtin_amdgcn_mfma_f32_32x32x16_bf16(b0,qr[0],negm,0,0,0);p1=__builtin_amdgcn_mfma_f32_32x32x16_bf16(b1,qr[0],negm,0,0,0);}
    else{p0=__builtin_amdgcn_mfma_f32_32x32x16_bf16(b0,qr[d0],p0,0,0,0);p1=__builtin_amdgcn_mfma_f32_32x32x16_bf16(b1,qr[d0],p1,0,0,0);}}
}
typedef __attribute__((address_space(3))) const char* lds_cptr;
typedef short v4i16_t __attribute__((ext_vector_type(4)));
__device__ __forceinline__ void kload8(bf16x8*kf,lds_cptr kp){
  kf[0]=*(const __attribute__((address_space(3))) bf16x8*)(kp);      kf[1]=*(const __attribute__((address_space(3))) bf16x8*)(kp+512);
  kf[2]=*(const __attribute__((address_space(3))) bf16x8*)(kp+2048); kf[3]=*(const __attribute__((address_space(3))) bf16x8*)(kp+2560);
  kf[4]=*(const __attribute__((address_space(3))) bf16x8*)(kp+4096); kf[5]=*(const __attribute__((address_space(3))) bf16x8*)(kp+4608);
  kf[6]=*(const __attribute__((address_space(3))) bf16x8*)(kp+6144); kf[7]=*(const __attribute__((address_space(3))) bf16x8*)(kp+6656);
}
__device__ __forceinline__ void kload2(bf16x8*kf,lds_cptr kp,int j){ kf[2*j]=*(const __attribute__((address_space(3))) bf16x8*)(kp+j*2048); kf[2*j+1]=*(const __attribute__((address_space(3))) bf16x8*)(kp+j*2048+512); }
__device__ __forceinline__ s16x4 vtr(lds_cptr p){ return __builtin_bit_cast(s16x4,__builtin_amdgcn_ds_read_tr16_b64_v4i16((__attribute__((address_space(3))) v4i16_t*)p)); }
__device__ __forceinline__ float rowmax(const f32x16&p0,const f32x16&p1){
  float a=max3f(p0[0],p0[1],p1[0]),b=max3f(p0[2],p0[3],p1[1]);a=max3f(a,p1[2],p1[3]);
  #pragma unroll
  for(int r=4;r<16;r+=4){a=max3f(a,p0[r],p0[r+1]);b=max3f(b,p0[r+2],p0[r+3]);a=max3f(a,p1[r],p1[r+1]);b=max3f(b,p1[r+2],p1[r+3]);}
  const float m=max2f(a,b);
  auto rr=__builtin_amdgcn_permlane32_swap(__float_as_uint(m),__float_as_uint(m),false,false);
  return max2f(__uint_as_float(rr[0]),__uint_as_float(rr[1]));
}
__device__ __forceinline__ void pv(f32x16*o,int vb,bf16x8 pa0,bf16x8 pa1,bf16x8 pa2,bf16x8 pa3){
  #pragma unroll
  for(int d0=0;d0<2;++d0){s16x4 lo[4],hi[4];
    #pragma unroll
    for(int ks=0;ks<4;++ks){
      asm volatile("ds_read_b64_tr_b16 %0,%1 offset:%c2":"=&v"(lo[ks]):"v"(vb),"i"(d0*4096+ks*1024):"memory");
      asm volatile("ds_read_b64_tr_b16 %0,%1 offset:%c2":"=&v"(hi[ks]):"v"(vb),"i"(d0*4096+ks*1024+512):"memory");}
    asm volatile("s_waitcnt lgkmcnt(0)":::"memory");SBAR();
    #define PK(k) (bf16x8){lo[k][0],lo[k][1],lo[k][2],lo[k][3],hi[k][0],hi[k][1],hi[k][2],hi[k][3]}
    o[d0]=__builtin_amdgcn_mfma_f32_32x32x16_bf16(pa0,PK(0),o[d0],0,0,0);
    o[d0]=__builtin_amdgcn_mfma_f32_32x32x16_bf16(pa1,PK(1),o[d0],0,0,0);
    o[d0]=__builtin_amdgcn_mfma_f32_32x32x16_bf16(pa2,PK(2),o[d0],0,0,0);
    o[d0]=__builtin_amdgcn_mfma_f32_32x32x16_bf16(pa3,PK(3),o[d0],0,0,0);
    #undef PK
  }
}

#ifndef ATTN_STORE16
#define ATTN_STORE16(p,v) (*(u32x4*)(p)=(v))
#endif
template<int THRL> __device__ __forceinline__ void attn_unit(int tid,const bf16*Qu,const bf16*__restrict__ Kh,const bf16*__restrict__ Vh,bf16*Ou,const int NT,char*shm){
  const int lane=tid&63,r32=lane&31,hi=lane>>5; const int wid=__builtin_amdgcn_readfirstlane(tid>>6);
  const bf16*Qw=Qu+(long)(wid*QBLK)*QP;
  const unsigned lds0=(unsigned)(uintptr_t)shm;
  float*wsf=(float*)(shm+LDS_WS)+wid*64;
  const bf16*ksrc=Kh+(long)lane*KP+wid*8;
  const bf16*vsrc=Vh+(long)(16*(wid&3)+(lane>>2))*KP+(wid>>2)*32+(lane&3)*8;
  const unsigned kdst=lds0+LDS_K+wid*1024, vdst=lds0+LDS_V+wid*1024;
  #define DMA_K(t,slot) glds16(ksrc+(long)(t)*KVBLK*KP,(unsigned)__builtin_amdgcn_readfirstlane(kdst+(slot)))
  #define DMA_V(t,slot) glds16(vsrc+(long)(t)*KVBLK*KP,(unsigned)__builtin_amdgcn_readfirstlane(vdst+(slot)))
  const int vb0=(int)(lds0+LDS_V)+((lane>>4)&1)*32+(lane&3)*8+(4*hi+((lane&15)>>2))*64;
  const char*Kbase=shm+LDS_K; bf16x8 kf[8];
  const lds_cptr shm3=(lds_cptr)shm; const lds_cptr kp0=shm3+LDS_K+hi*1024+r32*16; const lds_cptr vp0=shm3+LDS_V+((lane>>4)&1)*32+(lane&3)*8+(4*hi+((lane&15)>>2))*64;
  DMA_K(0,0);DMA_V(0,0);DMA_K(1,SLOTB);
  bf16x8 qr[4];
  #pragma unroll
  for(int d0=0;d0<4;++d0)qr[d0]=*reinterpret_cast<const bf16x8*>(&Qw[(long)r32*QP+d0*16+hi*8]);
  float zf_=0.f;asm volatile("":"+v"(zf_));
  float mhat=zf_,l_reg=zf_;f32x16 o[2],negm;
  #pragma unroll
  for(int r=0;r<16;++r){o[0][r]=zf_;o[1][r]=zf_;negm[r]=zf_;}
  asm volatile("":"+v"(negm));
  #define CMASK(P0,P1,t) do{}while(0)
  bool resc=false;
  #define START(P0,P1) do{ const float rm=rowmax(P0,P1); resc=false; \
    { const float dl=rm; mhat=fadd_s(mhat,dl); \
      _Pragma("unroll") for(int r=0;r<16;++r){P0[r]=fsub_s(P0[r],dl);P1[r]=fsub_s(P1[r],dl);} \
      _Pragma("unroll") for(int r=0;r<16;++r)negm[r]=-mhat; asm volatile("":"+v"(negm)); } \
    _Pragma("unroll") for(int r=0;r<16;++r)P0[r]=__builtin_amdgcn_exp2f(P0[r]); }while(0)
  #define RESC() do{ if(resc){ asm volatile("s_waitcnt lgkmcnt(0)":::"memory"); \
      _Pragma("unroll") for(int d_=0;d_<2;++d_) _Pragma("unroll") for(int r=0;r<16;++r)o[d_][r]*=wsf[crow(r,hi)]; } }while(0)
  f32x16 pA0,pA1,pB0,pB1;
  int sl_prev=0,sl_cur=0,sl_next=SLOTB;
  #define ROT() do{sl_prev=sl_cur;sl_cur=sl_next;sl_next=(sl_next==(NSLOT-1)*SLOTB)?0:sl_next+SLOTB;}while(0)
  DMA_K(2,2*SLOTB);
  WAIT_BAR(3);
  qkt(pA0,pA1,Kbase,qr,negm,r32,hi);asm volatile("s_nop 15\n\ts_nop 7":"+v"(pA0),"+v"(pA1));CMASK(pA0,pA1,0);
  START(pA0,pA1);
  _Pragma("unroll") for(int r=0;r<16;++r)pA1[r]=__builtin_amdgcn_exp2f(pA1[r]);
  WAIT_BAR(0);
  DMA_K(3,0);DMA_V(1,SLOTB);
  ROT();
  kload8(kf,kp0+sl_cur);
  WAIT_BAR(2);
  s16x4 vlo[8],vhi[8]; u32x4 pw0,pw1,pw2,pw3;
  #define PKW(P,B) cvtpk_s(P[B],P[B+1])
  #define PAF(k) __builtin_bit_cast(bf16x8,pw##k)
  #define VFR(i) (bf16x8){vlo[i][0],vlo[i][1],vlo[i][2],vlo[i][3],vhi[i][0],vhi[i][1],vhi[i][2],vhi[i][3]}
  #define PIN(x) asm volatile("":"+v"(x))
  #define MX3(a,b,c) __builtin_fmaxf(__builtin_fmaxf((a),(b)),(c))
  #define GAPA(MF,A0,A1,A2,A3,W0,W1,PW) do{ MF; sacc+=A0; sacc+=A1; sacc+=A2; sacc+=A3; PIN(sacc); W0; W1; PIN(PW); SBAR(); }while(0)
  #define EX(v) __builtin_amdgcn_exp2f(v)
  #define GAPB(MF,X,B) do{ MF; X[B]=EX(X[B]); X[B+1]=EX(X[B+1]); X[B+2]=EX(X[B+2]); X[B+3]=EX(X[B+3]); PIN(X); SBAR(); }while(0)
  #define VRD(i) do{ vlo[i]=vtr(vp_+(((i)>>2)*4096+((i)&3)*1024)); vhi[i]=vtr(vp_+(((i)>>2)*4096+((i)&3)*1024+512)); }while(0)
  #define KRD(G,j) do{ if(G){ kload2(kf,kp0+sl_next,j); SBAR(); } }while(0)
  #define STEP(C0,C1,P0,P1,t,GK,GV,GL) do{ SBAR(); \
    const lds_cptr vp_=vp0+sl_prev; \
    VRD(0); SBAR(); float sacc=(P0[0]+P0[1]); \
    GAPA(C0=__builtin_amdgcn_mfma_f32_32x32x16_bf16(kf[0],qr[0],negm,0,0,0), P0[2],P0[3],P0[4],P0[5],     pw0[0]=PKW(P0,0), pw0[1]=PKW(P0,2), pw0); \
    VRD(4); SBAR(); GAPA(C1=__builtin_amdgcn_mfma_f32_32x32x16_bf16(kf[1],qr[0],negm,0,0,0), P0[6],P0[7],P0[8],P0[9],     pw0[2]=PKW(P0,4), pw0[3]=PKW(P0,6), pw0); \
    VRD(1); SBAR(); GAPA(C0=__builtin_amdgcn_mfma_f32_32x32x16_bf16(kf[2],qr[1],C0,0,0,0),   P0[10],P0[11],P0[12],P0[13], pw1[0]=PKW(P0,8), pw1[1]=PKW(P0,10), pw1); \
    VRD(5); SBAR(); GAPA(C1=__builtin_amdgcn_mfma_f32_32x32x16_bf16(kf[3],qr[1],C1,0,0,0),   P0[14],P0[15],P1[0],P1[1],   pw1[2]=PKW(P0,12),pw1[3]=PKW(P0,14), pw1); \
    VRD(2); SBAR(); GAPA(C0=__builtin_amdgcn_mfma_f32_32x32x16_bf16(kf[4],qr[2],C0,0,0,0),   P1[2],P1[3],P1[4],P1[5],     pw2[0]=PKW(P1,0), pw2[1]=PKW(P1,2), pw2); \
    VRD(6); SBAR(); GAPA(C1=__builtin_amdgcn_mfma_f32_32x32x16_bf16(kf[5],qr[2],C1,0,0,0),   P1[6],P1[7],P1[8],P1[9],     pw2[2]=PKW(P1,4), pw2[3]=PKW(P1,6), pw2); \
    VRD(3); SBAR(); GAPA(C0=__builtin_amdgcn_mfma_f32_32x32x16_bf16(kf[6],qr[3],C0,0,0,0),   P1[10],P1[11],P1[12],P1[13], pw3[0]=PKW(P1,8), pw3[1]=PKW(P1,10), pw3); \
    VRD(7); SBAR(); GAPA(C1=__builtin_amdgcn_mfma_f32_32x32x16_bf16(kf[7],qr[3],C1,0,0,0),   P1[14],P1[15],0.f,0.f,       pw3[2]=PKW(P1,12),pw3[3]=PKW(P1,14), pw3); \
    l_reg+=sacc; \
    if(GK){DMA_K((t)+3,sl_cur);} if(GV){DMA_V((t)+1,sl_next);} \
    CMASK(C0,C1,t); \
    { float a=MX3(C0[0],C0[1],C1[0]),b=MX3(C0[2],C0[3],C1[1]); a=MX3(a,C1[2],C1[3]); \
      _Pragma("unroll") for(int r=4;r<16;r+=4){a=MX3(a,C0[r],C0[r+1]);b=MX3(b,C0[r+2],C0[r+3]);a=MX3(a,C1[r],C1[r+1]);b=MX3(b,C1[r+2],C1[r+3]);} \
      float rm=__builtin_fmaxf(a,b); { auto rr=__builtin_amdgcn_permlane32_swap(__float_as_uint(rm),__float_as_uint(rm),false,false); rm=__builtin_fmaxf(__uint_as_float(rr[0]),__uint_as_float(rr[1])); } \
      resc=false; \
      if(__builtin_expect(__any(rm>(float)THRL),0)){ const float dl=__builtin_fmaxf(rm,0.f); mhat+=dl; \
        _Pragma("unroll") for(int r=0;r<16;++r){C0[r]-=dl;C1[r]-=dl;} \
        _Pragma("unroll") for(int r=0;r<16;++r)negm[r]=-mhat; asm volatile("":"+v"(negm)); \
        const float f=__builtin_amdgcn_exp2f(-dl); l_reg*=f; if(hi==0)wsf[r32]=f; resc=true; } } \
    SBAR(); \
    GAPB(o[0]=__builtin_amdgcn_mfma_f32_32x32x16_bf16(PAF(0),VFR(0),o[0],0,0,0), C0,0); \
    GAPB(o[1]=__builtin_amdgcn_mfma_f32_32x32x16_bf16(PAF(0),VFR(4),o[1],0,0,0), C0,4); \
    KRD(GL,0); GAPB(o[0]=__builtin_amdgcn_mfma_f32_32x32x16_bf16(PAF(1),VFR(1),o[0],0,0,0), C0,8); \
    KRD(GL,1); GAPB(o[1]=__builtin_amdgcn_mfma_f32_32x32x16_bf16(PAF(1),VFR(5),o[1],0,0,0), C0,12); \
    KRD(GL,2); GAPB(o[0]=__builtin_amdgcn_mfma_f32_32x32x16_bf16(PAF(2),VFR(2),o[0],0,0,0), C1,0); \
    KRD(GL,3); GAPB(o[1]=__builtin_amdgcn_mfma_f32_32x32x16_bf16(PAF(2),VFR(6),o[1],0,0,0), C1,4); \
    GAPB(o[0]=__builtin_amdgcn_mfma_f32_32x32x16_bf16(PAF(3),VFR(3),o[0],0,0,0), C1,8); \
    GAPB(o[1]=__builtin_amdgcn_mfma_f32_32x32x16_bf16(PAF(3),VFR(7),o[1],0,0,0), C1,12); \
    }while(0)
  int t=1;
  for(;t+5<NT;t+=2){
    STEP(pB0,pB1,pA0,pA1,t,true,true,true);     WAIT_BAR(2); RESC(); ROT();
    STEP(pA0,pA1,pB0,pB1,t+1,true,true,true);   WAIT_BAR(2); RESC(); ROT();
  }
  #define ENDW(tt) do{ if((tt)+3<NT){WAIT_BAR(2);} else if((tt)+2<NT){WAIT_BAR(1);} else {WAIT_BAR(0);} }while(0)
  for(;t+1<NT;t+=2){
    STEP(pB0,pB1,pA0,pA1,t,(t+3<NT),(t+1<NT),(t+1<NT));       ENDW(t);   RESC(); ROT();
    STEP(pA0,pA1,pB0,pB1,t+1,(t+4<NT),(t+2<NT),(t+2<NT));     ENDW(t+1); RESC(); ROT();
  }
  STEP(pB0,pB1,pA0,pA1,NT-1,false,false,false); RESC();
  { float sacc=pB0[0]+pB0[1]; _Pragma("unroll") for(int r=2;r<16;++r)sacc+=pB0[r]; _Pragma("unroll") for(int r=0;r<16;++r)sacc+=pB1[r]; l_reg+=sacc;
    pw0=(u32x4){PKW(pB0,0),PKW(pB0,2),PKW(pB0,4),PKW(pB0,6)};pw1=(u32x4){PKW(pB0,8),PKW(pB0,10),PKW(pB0,12),PKW(pB0,14)};pw2=(u32x4){PKW(pB1,0),PKW(pB1,2),PKW(pB1,4),PKW(pB1,6)};pw3=(u32x4){PKW(pB1,8),PKW(pB1,10),PKW(pB1,12),PKW(pB1,14)};
    SBAR(); pv(o,vb0+sl_cur,PAF(0),PAF(1),PAF(2),PAF(3)); }
  #undef PKW
  #undef PAF
  #undef VFR
  #undef PIN
  #undef MX3
  #undef GAPA
  #undef GAPB
  #undef EX
  #undef VRD
  #undef KRD
  #undef STEP
  #undef ENDW
  {auto rr=__builtin_amdgcn_permlane32_swap(__float_as_uint(l_reg),__float_as_uint(l_reg),false,false);l_reg=__uint_as_float(rr[0])+__uint_as_float(rr[1]);}
  if(hi==0)wsf[32+r32]=l_reg;asm volatile("s_waitcnt lgkmcnt(0)":::"memory");
  float rli[16];
  #pragma unroll
  for(int r=0;r<16;++r)rli[r]=__builtin_amdgcn_rcpf(wsf[32+crow(r,hi)]);
  bf16*Ow=Ou+(long)(wid*QBLK)*QP;
  { bf16*stg=(bf16*)(shm+LDS_OST)+wid*2048;
    #pragma unroll
    for(int r=0;r<16;++r){const int orow=crow(r,hi);
      #pragma unroll
      for(int d0=0;d0<2;++d0)stg[orow*64+d0*32+r32]=__float2bfloat16(o[d0][r]*rli[r]);}
    asm volatile("s_waitcnt lgkmcnt(0)":::"memory");
    #pragma unroll
    for(int i=0;i<4;++i){const int row=i*8+(lane>>3),ch=lane&7; const u32x4 v=*(const u32x4*)(stg+row*64+ch*8); ATTN_STORE16(Ow+(long)row*QP+ch*8,v);} }
  asm volatile("s_waitcnt lgkmcnt(0)\n\ts_barrier":::"memory");
  #undef DMA_K
  #undef DMA_V
  #undef CMASK
  #undef START
  #undef RESC
  #undef ROT
}
constexpr int ATTN_LDS_BYTES=LDS_BYTES;
#undef SBAR
#undef WAIT_BAR
}
#ifndef ATTN_FAST
#define ATTN_FAST 1
#endif
__device__ __forceinline__ void attn_fast(const Params& p, const Ctx& c) {
    typedef attn_body::bf16 abf;
    const int vcu = (c.G % 8 == 0) ? (c.bx % 8) * (c.G / 8) + c.bx / 8 : c.bx;
    for (int u = vcu; u < 512 + 128; u += c.G) {
        const abf *Qu, *Kh, *Vh; int NT;
        if (u < 512) { const int qb = u & 7, hq = (u >> 3) & 3, hk = (u >> 5) & 1, b = u >> 6, h = hk * 4 + hq;
            Qu = (const abf*)(p.ws + Z_AQ) + ((size_t)MP + (size_t)b * SEQ_S + qb * 256) * RW + h * HD;
            Kh = (const abf*)(p.ws + Z_KS) + (size_t)b * SKV_S * KVW + hk * HD; Vh = (const abf*)(p.ws + Z_VS) + (size_t)b * SKV_S * KVW + hk * HD; NT = SKV_S / 64; }
        else { const int v = u - 512, hq = v & 3, hk = (v >> 2) & 1, b = v >> 3, h = hk * 4 + hq;
            Qu = (const abf*)(p.ws + Z_AQ) + ((size_t)b * SEQ_P) * RW + h * HD;
            Kh = (const abf*)(p.ws + Z_KP) + (size_t)b * SEQ_P * KVW + hk * HD; Vh = (const abf*)(p.ws + Z_VP) + (size_t)b * SEQ_P * KVW + hk * HD; NT = SKV_P / 64; }
        attn_body::attn_unit<8>(c.tid, Qu, Kh, Vh, (abf*)Qu, NT, (char*)c.lds);
    }
    __syncthreads();
}

__device__ __forceinline__ void attn_simple(const Params& p, const Ctx& c) {
    LAS float* Kt = (LAS float*)c.lds; LAS float* Vt = Kt + 32 * 64; LAS float* Sc = Vt + 32 * 64;
    constexpr int NU_S = NB_S * NH * 4, NU_P = NB_P * NH;
    for (int u = c.bx; u < NU_S + NU_P; u += c.G) {
        const bool smp = u < NU_S; int b, h, q0, nq, skv; const bf16_t *Kb, *Vb; size_t rowbase;
        if (smp) { b = u / 32; h = (u / 4) & 7; q0 = (u & 3) * 512; nq = 512; skv = SKV_S; Kb = (const bf16_t*)(p.ws + Z_KS) + (size_t)b * SKV_S * KVW; Vb = (const bf16_t*)(p.ws + Z_VS) + (size_t)b * SKV_S * KVW; rowbase = MP + (size_t)b * SEQ_S + q0; }
        else { const int v = u - NU_S; b = v / 8; h = v & 7; q0 = 0; nq = 256; skv = SKV_P; Kb = (const bf16_t*)(p.ws + Z_KP) + (size_t)b * SEQ_P * KVW; Vb = (const bf16_t*)(p.ws + Z_VP) + (size_t)b * SEQ_P * KVW; rowbase = (size_t)b * SEQ_P; }
        const int hk = h >> 2; const bool act = c.tid < nq;
        bf16_t* qrow = (bf16_t*)(p.ws + Z_AQ) + (rowbase + (act ? c.tid : 0)) * RW + h * HD;
        float q[64], o[64]; float mx = -1e30f, lsum = 0.f;
#pragma unroll
        for (int i = 0; i < 8; ++i) { const u32x4 w = *(const u32x4*)(qrow + 8 * i); q[8 * i] = bflo(w.x); q[8 * i + 1] = bfhi(w.x); q[8 * i + 2] = bflo(w.y); q[8 * i + 3] = bfhi(w.y); q[8 * i + 4] = bflo(w.z); q[8 * i + 5] = bfhi(w.z); q[8 * i + 6] = bflo(w.w); q[8 * i + 7] = bfhi(w.w); }
#pragma unroll
        for (int i = 0; i < 64; ++i) o[i] = 0.f;
        for (int k0 = 0; k0 < skv; k0 += 32) {
            __syncthreads();
            { const int e = c.tid * 4, j = e >> 6, d = e & 63;
                const u32x2 kw = *(const u32x2*)(Kb + (size_t)(k0 + j) * KVW + hk * HD + d), vw = *(const u32x2*)(Vb + (size_t)(k0 + j) * KVW + hk * HD + d);
                *(LAS f32x4*)(Kt + e) = (f32x4){bflo(kw.x), bfhi(kw.x), bflo(kw.y), bfhi(kw.y)}; *(LAS f32x4*)(Vt + e) = (f32x4){bflo(vw.x), bfhi(vw.x), bflo(vw.y), bfhi(vw.y)}; }
            __syncthreads();
            float tm = mx;
#pragma unroll 1
            for (int j = 0; j < 32; ++j) { float a = 0.f;
#pragma unroll
                for (int d4 = 0; d4 < 16; ++d4) { const f32x4 kv = *(const LAS f32x4*)(Kt + j * 64 + 4 * d4); a += q[4 * d4] * kv.x + q[4 * d4 + 1] * kv.y + q[4 * d4 + 2] * kv.z + q[4 * d4 + 3] * kv.w; }
                Sc[j * 512 + c.tid] = a; tm = fmaxf(tm, a); }
            const float corr = exp2f(mx - tm); mx = tm; lsum *= corr;
#pragma unroll
            for (int i = 0; i < 64; ++i) o[i] *= corr;
#pragma unroll 1
            for (int j = 0; j < 32; ++j) { const float pj = exp2f(Sc[j * 512 + c.tid] - mx); lsum += pj;
#pragma unroll
                for (int d4 = 0; d4 < 16; ++d4) { const f32x4 vv = *(const LAS f32x4*)(Vt + j * 64 + 4 * d4); o[4 * d4] += pj * vv.x; o[4 * d4 + 1] += pj * vv.y; o[4 * d4 + 2] += pj * vv.z; o[4 * d4 + 3] += pj * vv.w; } }
        }
        if (act) { const float il = 1.f / lsum;
#pragma unroll
            for (int i = 0; i < 8; ++i) { u32x4 w; w.x = pk2(o[8 * i] * il, o[8 * i + 1] * il); w.y = pk2(o[8 * i + 2] * il, o[8 * i + 3] * il); w.z = pk2(o[8 * i + 4] * il, o[8 * i + 5] * il); w.w = pk2(o[8 * i + 6] * il, o[8 * i + 7] * il); *(u32x4*)(qrow + 8 * i) = w; } }
    }
    __syncthreads();
}
__device__ __forceinline__ void cmlp_simple(const Params& p, const Ctx& c, int l) {
    LAS float* Vt = (LAS float*)c.lds;
    LAS float* rs = Vt + 128 * 128;
    const bf16_t* cv = (const bf16_t*)(p.ws + Z_CV); bf16_t* cu = (bf16_t*)(p.ws + Z_CU);
    for (int u = c.bx; u < NCHUNK * 4; u += c.G) {
        const int ch = u >> 2, g = u & 3; const size_t R0 = (size_t)ch * 128;
        __syncthreads();
        { const int q = c.tid >> 2, part = c.tid & 3; float ss = 0.f;
            const bf16_t* r = cv + (R0 + q) * RW + part * 128;
#pragma unroll
            for (int i = 0; i < 16; ++i) { const u32x4 w = *(const u32x4*)(r + 8 * i); const float a0 = bflo(w.x), a1 = bfhi(w.x), a2 = bflo(w.y), a3 = bfhi(w.y), a4 = bflo(w.z), a5 = bfhi(w.z), a6 = bflo(w.w), a7 = bfhi(w.w);
                ss += (a0 * a0 + a1 * a1) + (a2 * a2 + a3 * a3) + (a4 * a4 + a5 * a5) + (a6 * a6 + a7 * a7); }
            ss += __shfl_xor(ss, 1); ss += __shfl_xor(ss, 2);
            if (part == 0) rs[q] = rsqrtf(ss * (1.f / RW) + EPS); }
        __syncthreads();
        for (int e = c.tid; e < 128 * 128 / 8; e += 512) { const int q = e >> 4, c8 = (e & 15) * 8; const float r = rs[q];
            const u32x4 w = *(const u32x4*)(cv + (R0 + q) * RW + g * 128 + c8);
            *(LAS f32x4*)(Vt + q * 128 + c8) = (f32x4){bflo(w.x) * r, bfhi(w.x) * r, bflo(w.y) * r, bfhi(w.y) * r};
            *(LAS f32x4*)(Vt + q * 128 + c8 + 4) = (f32x4){bflo(w.z) * r, bfhi(w.z) * r, bflo(w.w) * r, bfhi(w.w) * r}; }
        __syncthreads();
        const int cc = c.tid & 127, pg = __builtin_amdgcn_readfirstlane(c.tid >> 7);
        const float* Ws = p.in[I_CMWS] + ((size_t)(l * 4 + g) * 128) * 128; const float* bs = p.in[I_CMBS] + (l * 4 + g) * 128;
        const float gn = p.in[I_CMNORM][l * RW + g * 128 + cc];
        for (int pi = 0; pi < 32; ++pi) { const int pr = pg * 32 + pi; const float* wrow = Ws + pr * 128; float a = 0.f;
#pragma unroll 8
            for (int q = 0; q < 128; ++q) a += wrow[q] * Vt[q * 128 + cc];
            bf16_t* up = cu + (R0 + pr) * RW + g * 128 + cc;
            const float uu = bf2f(*up);
            *up = (bf16_t)f2bf(uu * (gn * a + bs[pr])); }
    }
    __syncthreads();
}
__device__ __forceinline__ float ret_ld(const Params& p, int l, int dir, int h) { const float x = p.in[I_DECAY][(l * 2 + dir) * NH + h]; return -log1pf(__expf(x)); }
__device__ __forceinline__ void retU_simple(const Params& p, const Ctx& c, int l) {
    LAS float* Kt = (LAS float*)c.lds; LAS float* Vt = Kt + 128 * 64; LAS float* wf = Vt + 128 * 64; LAS float* wb = wf + 128;
    float* U = (float*)(p.ws + Z_U);
    for (int u = c.bx; u < NCHUNK * NH; u += c.G) {
        const int ch = u >> 3, h = u & 7; const size_t R0 = (size_t)ch * 128;
        const float ldf = ret_ld(p, l, 0, h), ldb = ret_ld(p, l, 1, h);
        __syncthreads();
        if (c.tid < 128) { wf[c.tid] = __expf(ldf * (float)(127 - c.tid)); wb[c.tid] = __expf(ldb * (float)c.tid); }
        for (int e = c.tid; e < 128 * 64 / 8; e += 512) { const int j = e >> 3, d8 = (e & 7) * 8;
            const u32x4 kw = *(const u32x4*)((const bf16_t*)(p.ws + Z_RK) + (R0 + j) * RW + h * HD + d8), vw = *(const u32x4*)((const bf16_t*)(p.ws + Z_RV) + (R0 + j) * RW + h * HD + d8);
            *(LAS f32x4*)(Kt + j * 64 + d8) = (f32x4){bflo(kw.x), bfhi(kw.x), bflo(kw.y), bfhi(kw.y)}; *(LAS f32x4*)(Kt + j * 64 + d8 + 4) = (f32x4){bflo(kw.z), bfhi(kw.z), bflo(kw.w), bfhi(kw.w)};
            *(LAS f32x4*)(Vt + j * 64 + d8) = (f32x4){bflo(vw.x), bfhi(vw.x), bflo(vw.y), bfhi(vw.y)}; *(LAS f32x4*)(Vt + j * 64 + d8 + 4) = (f32x4){bflo(vw.z), bfhi(vw.z), bflo(vw.w), bfhi(vw.w)}; }
        __syncthreads();
        const int e = c.tid & 63, d0 = __builtin_amdgcn_readfirstlane(c.tid >> 6) * 8;
        float uf[8], ub[8];
#pragma unroll
        for (int i = 0; i < 8; ++i) { uf[i] = 0.f; ub[i] = 0.f; }
        for (int j = 0; j < 128; ++j) { const float v = Vt[j * 64 + e], vf = v * wf[j], vb = v * wb[j];
            const f32x4 k0 = *(const LAS f32x4*)(Kt + j * 64 + d0), k1 = *(const LAS f32x4*)(Kt + j * 64 + d0 + 4);
            uf[0] += k0.x * vf; uf[1] += k0.y * vf; uf[2] += k0.z * vf; uf[3] += k0.w * vf; uf[4] += k1.x * vf; uf[5] += k1.y * vf; uf[6] += k1.z * vf; uf[7] += k1.w * vf;
            ub[0] += k0.x * vb; ub[1] += k0.y * vb; ub[2] += k0.z * vb; ub[3] += k0.w * vb; ub[4] += k1.x * vb; ub[5] += k1.y * vb; ub[6] += k1.z * vb; ub[7] += k1.w * vb; }
        float* Uf = U + ((size_t)(0 * NCHUNK + ch) * NH + h) * 4096, *Ub = U + ((size_t)(1 * NCHUNK + ch) * NH + h) * 4096;
#pragma unroll
        for (int i = 0; i < 8; ++i) { Uf[(d0 + i) * 64 + e] = uf[i]; Ub[(d0 + i) * 64 + e] = ub[i]; }
    }
    __syncthreads();
}
__device__ __forceinline__ void retO_simple(const Params& p, const Ctx& c, int l) {
    LAS float* Kt = (LAS float*)c.lds; LAS float* Vt = Kt + 128 * 64; LAS float* Sf = Vt + 128 * 64; LAS float* Sb = Sf + 4096; LAS float* pf = Sb + 4096; LAS float* pb = pf + 132;
    const float* U = (const float*)(p.ws + Z_U);
    for (int u = c.bx; u < NCHUNK * NH; u += c.G) {
        const int ch = u >> 3, h = u & 7; const size_t R0 = (size_t)ch * 128; const bool smp = ch >= MP / 128;
        const int nc = smp ? 16 : 2, ch0 = smp ? (MP / 128 + ((ch - MP / 128) & ~15)) : (ch & ~1), cidx = ch - ch0, b = smp ? (ch - MP / 128) >> 4 : ch >> 1;
        const float ldf = ret_ld(p, l, 0, h), ldb = ret_ld(p, l, 1, h); const float Gf = __expf(128.f * ldf), Gb = __expf(128.f * ldb);
        __syncthreads();
        if (c.tid <= 128) { pf[c.tid] = __expf(ldf * (float)c.tid); pb[c.tid] = __expf(ldb * (float)c.tid); }
        for (int e = c.tid; e < 128 * 64 / 8; e += 512) { const int j = e >> 3, d8 = (e & 7) * 8;
            const u32x4 kw = *(const u32x4*)((const bf16_t*)(p.ws + Z_RK) + (R0 + j) * RW + h * HD + d8), vw = *(const u32x4*)((const bf16_t*)(p.ws + Z_RV) + (R0 + j) * RW + h * HD + d8);
            *(LAS f32x4*)(Kt + j * 64 + d8) = (f32x4){bflo(kw.x), bfhi(kw.x), bflo(kw.y), bfhi(kw.y)}; *(LAS f32x4*)(Kt + j * 64 + d8 + 4) = (f32x4){bflo(kw.z), bfhi(kw.z), bflo(kw.w), bfhi(kw.w)};
            *(LAS f32x4*)(Vt + j * 64 + d8) = (f32x4){bflo(vw.x), bfhi(vw.x), bflo(vw.y), bfhi(vw.y)}; *(LAS f32x4*)(Vt + j * 64 + d8 + 4) = (f32x4){bflo(vw.z), bfhi(vw.z), bflo(vw.w), bfhi(vw.w)}; }
        {
            float sf[8], sb[8]; const int e0 = c.tid * 8;
            if (smp) { const float* s0 = p.in[I_ST] + ((size_t)((b * 2 + l) * 2 + 0) * NH + h) * 4096 + e0; const float* s1 = p.in[I_ST] + ((size_t)((b * 2 + l) * 2 + 1) * NH + h) * 4096 + e0;
#pragma unroll
                for (int i = 0; i < 8; ++i) { sf[i] = s0[i]; sb[i] = s1[i]; } }
            else {
#pragma unroll
                for (int i = 0; i < 8; ++i) { sf[i] = 0.f; sb[i] = 0.f; } }
            for (int cc = 0; cc < cidx; ++cc) { const float* uf = U + ((size_t)(0 * NCHUNK + ch0 + cc) * NH + h) * 4096 + e0;
#pragma unroll
                for (int i = 0; i < 8; ++i) sf[i] = Gf * sf[i] + uf[i]; }
            for (int cc = nc - 1; cc > cidx; --cc) { const float* ub = U + ((size_t)(1 * NCHUNK + ch0 + cc) * NH + h) * 4096 + e0;
#pragma unroll
                for (int i = 0; i < 8; ++i) sb[i] = Gb * sb[i] + ub[i]; }
#pragma unroll
            for (int i = 0; i < 8; ++i) { Sf[e0 + i] = sf[i]; Sb[e0 + i] = sb[i]; }
            if (!smp && cidx == nc - 1) { const float* uf = U + ((size_t)(0 * NCHUNK + ch) * NH + h) * 4096 + e0; float* o = p.out + OUT_ST + ((size_t)((b * 2 + l) * 2 + 0) * NH + h) * 4096 + e0;
#pragma unroll
                for (int i = 0; i < 8; ++i) o[i] = Gf * sf[i] + uf[i]; }
            if (!smp && cidx == 0) { const float* ub = U + ((size_t)(1 * NCHUNK + ch) * NH + h) * 4096 + e0; float* o = p.out + OUT_ST + ((size_t)((b * 2 + l) * 2 + 1) * NH + h) * 4096 + e0;
#pragma unroll
                for (int i = 0; i < 8; ++i) o[i] = Gb * sb[i] + ub[i]; }
        }
        __syncthreads();
        const int i = c.tid >> 2, part = c.tid & 3;
        float qp[16], o[16];
        { const bf16_t* qr = (const bf16_t*)(p.ws + Z_RQ) + (R0 + i) * RW + h * HD + part * 16; const u32x4 w0 = *(const u32x4*)qr, w1 = *(const u32x4*)(qr + 8);
            qp[0] = bflo(w0.x); qp[1] = bfhi(w0.x); qp[2] = bflo(w0.y); qp[3] = bfhi(w0.y); qp[4] = bflo(w0.z); qp[5] = bfhi(w0.z); qp[6] = bflo(w0.w); qp[7] = bfhi(w0.w);
            qp[8] = bflo(w1.x); qp[9] = bfhi(w1.x); qp[10] = bflo(w1.y); qp[11] = bfhi(w1.y); qp[12] = bflo(w1.z); qp[13] = bfhi(w1.z); qp[14] = bflo(w1.w); qp[15] = bfhi(w1.w); }
#pragma unroll
        for (int e = 0; e < 16; ++e) o[e] = 0.f;
#pragma unroll 1
        for (int j = 0; j < 128; ++j) { float s = 0.f;
#pragma unroll
            for (int d4 = 0; d4 < 4; ++d4) { const f32x4 kv = *(const LAS f32x4*)(Kt + j * 64 + part * 16 + 4 * d4); s += qp[4 * d4] * kv.x + qp[4 * d4 + 1] * kv.y + qp[4 * d4 + 2] * kv.z + qp[4 * d4 + 3] * kv.w; }
            s += __shfl_xor(s, 1); s += __shfl_xor(s, 2);
            const float w = j < i ? pf[i - j] : (j > i ? pb[j - i] : 2.0f);
            s *= w;
#pragma unroll
            for (int e4 = 0; e4 < 4; ++e4) { const f32x4 vv = *(const LAS f32x4*)(Vt + j * 64 + part * 16 + 4 * e4); o[4 * e4] += s * vv.x; o[4 * e4 + 1] += s * vv.y; o[4 * e4 + 2] += s * vv.z; o[4 * e4 + 3] += s * vv.w; } }
        { const float xf = pf[i + 1], xb = pb[128 - i]; const bf16_t* qfull = (const bf16_t*)(p.ws + Z_RQ) + (R0 + i) * RW + h * HD;
#pragma unroll 2
            for (int d = 0; d < 64; ++d) { const float qd = bf2f(qfull[d]); const float af = qd * xf, ab = qd * xb;
#pragma unroll
                for (int e4 = 0; e4 < 4; ++e4) { const f32x4 a = *(const LAS f32x4*)(Sf + d * 64 + part * 16 + 4 * e4), bb = *(const LAS f32x4*)(Sb + d * 64 + part * 16 + 4 * e4);
                    o[4 * e4] += af * a.x + ab * bb.x; o[4 * e4 + 1] += af * a.y + ab * bb.y; o[4 * e4 + 2] += af * a.z + ab * bb.z; o[4 * e4 + 3] += af * a.w + ab * bb.w; } } }
        float s1 = 0.f;
#pragma unroll
        for (int e = 0; e < 16; ++e) s1 += o[e];
        s1 += __shfl_xor(s1, 1); s1 += __shfl_xor(s1, 2); const float mu = s1 * (1.f / 64.f);
        float s2 = 0.f;
#pragma unroll
        for (int e = 0; e < 16; ++e) { const float d = o[e] - mu; s2 += d * d; }
        s2 += __shfl_xor(s2, 1); s2 += __shfl_xor(s2, 2); const float rstd = rsqrtf(s2 * (1.f / 64.f) + EPS);
        const float* gn = p.in[I_RETGN] + l * RW + h * HD + part * 16;
        const bf16_t* rg = (const bf16_t*)(p.ws + Z_RG) + (R0 + i) * RW + h * HD + part * 16; const u32x4 g0 = *(const u32x4*)rg, g1 = *(const u32x4*)(rg + 8);
        float gs[16] = {bflo(g0.x), bfhi(g0.x), bflo(g0.y), bfhi(g0.y), bflo(g0.z), bfhi(g0.z), bflo(g0.w), bfhi(g0.w), bflo(g1.x), bfhi(g1.x), bflo(g1.y), bfhi(g1.y), bflo(g1.z), bfhi(g1.z), bflo(g1.w), bfhi(g1.w)};
        float y[16];
#pragma unroll
        for (int e = 0; e < 16; ++e) y[e] = (o[e] - mu) * rstd * gn[e] * gs[e];
        bf16_t* dst = (bf16_t*)(p.ws + Z_CV) + (R0 + i) * RW + h * HD + part * 16;
        u32x4 w0, w1; w0.x = pk2(y[0], y[1]); w0.y = pk2(y[2], y[3]); w0.z = pk2(y[4], y[5]); w0.w = pk2(y[6], y[7]); w1.x = pk2(y[8], y[9]); w1.y = pk2(y[10], y[11]); w1.z = pk2(y[12], y[13]); w1.w = pk2(y[14], y[15]);
        *(u32x4*)dst = w0; *(u32x4*)(dst + 8) = w1;
    }
    __syncthreads();
}

typedef short v4i16_t __attribute__((ext_vector_type(4)));
typedef LAS const unsigned char* lcp;
__device__ __forceinline__ f32x4 mfma16(bf16x8 a, bf16x8 b, f32x4 c) { return __builtin_amdgcn_mfma_f32_16x16x32_bf16(a, b, c, 0, 0, 0); }
__device__ __forceinline__ bf16x8 tr_frag(lcp base, int stride, int k0, int c0, int lane) {
    const int g = lane >> 4, i = lane & 15, q = i >> 2, pp = i & 3;
    lcp a = base + (k0 + 8 * g + q) * stride + (c0 + 4 * pp) * 2;
    const v4i16_t r1 = __builtin_amdgcn_ds_read_tr16_b64_v4i16((LAS v4i16_t*)a), r2 = __builtin_amdgcn_ds_read_tr16_b64_v4i16((LAS v4i16_t*)(a + 4 * stride));
    return (bf16x8){r1[0], r1[1], r1[2], r1[3], r2[0], r2[1], r2[2], r2[3]};
}
__device__ __forceinline__ bf16x8 row_frag(lcp base, int stride, int r0, int k0, int lane) { return *(const LAS bf16x8*)(base + (r0 + (lane & 15)) * stride + (k0 + 8 * (lane >> 4)) * 2); }
__device__ __forceinline__ u32x4 scale8(const u32x4 w, float s) { u32x4 o; o.x = pk2(bflo(w.x) * s, bfhi(w.x) * s); o.y = pk2(bflo(w.y) * s, bfhi(w.y) * s); o.z = pk2(bflo(w.z) * s, bfhi(w.z) * s); o.w = pk2(bflo(w.w) * s, bfhi(w.w) * s); return o; }
constexpr int RS64 = 144, RS128 = 272;
constexpr float LOG2E = 1.4426950408889634f;

__device__ __forceinline__ void retU_fast(const Params& p, const Ctx& c, int l) {
    LAS unsigned char* Kf = c.lds; LAS unsigned char* Kb = Kf + 128 * RS64; LAS unsigned char* Vs = Kb + 128 * RS64;
    float* U = (float*)(p.ws + Z_U);
    const int g = c.lane >> 4, i16 = c.lane & 15;
    for (int u = c.vcu; u < NCHUNK * NH; u += c.G) {
        const int ch = u >> 3, h = u & 7; const size_t R0 = (size_t)ch * 128;
        const float l2f = ret_ld(p, l, 0, h) * LOG2E, l2b = ret_ld(p, l, 1, h) * LOG2E;
        __syncthreads();
#pragma unroll
        for (int it = 0; it < 2; ++it) { const int idx = c.tid + 512 * it, j = idx >> 3, c8 = (idx & 7) * 8;
            const u32x4 kw = *(const u32x4*)((const bf16_t*)(p.ws + Z_RK) + (R0 + j) * RW + h * HD + c8), vw = *(const u32x4*)((const bf16_t*)(p.ws + Z_RV) + (R0 + j) * RW + h * HD + c8);
            const float wf = exp2f(l2f * (float)(127 - j)), wb = exp2f(l2b * (float)j);
            *(LAS u32x4*)(Kf + j * RS64 + c8 * 2) = scale8(kw, wf); *(LAS u32x4*)(Kb + j * RS64 + c8 * 2) = scale8(kw, wb); *(LAS u32x4*)(Vs + j * RS64 + c8 * 2) = vw; }
        __syncthreads();
        const int dt = c.wave & 3, et0 = 2 * (c.wave >> 2);
        f32x4 acc[2][2];
#pragma unroll
        for (int s = 0; s < 2; ++s)
#pragma unroll
            for (int e = 0; e < 2; ++e) acc[s][e] = (f32x4){0.f, 0.f, 0.f, 0.f};
#pragma unroll
        for (int ks = 0; ks < 4; ++ks) {
            const bf16x8 af = tr_frag(Kf, RS64, 32 * ks, 16 * dt, c.lane), ab = tr_frag(Kb, RS64, 32 * ks, 16 * dt, c.lane);
#pragma unroll
            for (int e = 0; e < 2; ++e) { const bf16x8 bv = tr_frag(Vs, RS64, 32 * ks, 16 * (et0 + e), c.lane); acc[0][e] = mfma16(af, bv, acc[0][e]); acc[1][e] = mfma16(ab, bv, acc[1][e]); }
        }
#pragma unroll
        for (int s = 0; s < 2; ++s)
#pragma unroll
            for (int e = 0; e < 2; ++e) { float* o = U + ((size_t)(s * NCHUNK + ch) * NH + h) * 4096 + (16 * dt + 4 * g) * 64 + 16 * (et0 + e) + i16;
#pragma unroll
                for (int r = 0; r < 4; ++r) o[r * 64] = acc[s][e][r]; }
    }
    __syncthreads();
}

__device__ __forceinline__ void retO_fast(const Params& p, const Ctx& c, int l) {
    LAS unsigned char* Qs = c.lds; LAS unsigned char* Ks = Qs + 128 * RS64; LAS unsigned char* Vs = Ks + 128 * RS64; LAS unsigned char* Sf = Vs + 128 * RS64; LAS unsigned char* Sb = Sf + 64 * RS64; LAS unsigned char* Ps = Sb + 64 * RS64;
    const float* U = (const float*)(p.ws + Z_U);
    const int g = c.lane >> 4, i16 = c.lane & 15, i0 = 16 * c.wave;
    for (int u = c.vcu; u < NCHUNK * NH; u += c.G) {
        const int ch = u >> 3, h = u & 7; const size_t R0 = (size_t)ch * 128; const bool smp = ch >= MP / 128;
        const int nc = smp ? 16 : 2, ch0 = smp ? (MP / 128 + ((ch - MP / 128) & ~15)) : (ch & ~1), cidx = ch - ch0, b = smp ? (ch - MP / 128) >> 4 : ch >> 1;
        const float ldf = ret_ld(p, l, 0, h), ldb = ret_ld(p, l, 1, h); const float Gf = __expf(128.f * ldf), Gb = __expf(128.f * ldb), l2f = ldf * LOG2E, l2b = ldb * LOG2E;
        __syncthreads();
#pragma unroll
        for (int it = 0; it < 2; ++it) { const int idx = c.tid + 512 * it, j = idx >> 3, c8 = (idx & 7) * 8; const size_t go = (R0 + j) * RW + h * HD + c8;
            *(LAS u32x4*)(Qs + j * RS64 + c8 * 2) = *(const u32x4*)((const bf16_t*)(p.ws + Z_RQ) + go);
            *(LAS u32x4*)(Ks + j * RS64 + c8 * 2) = *(const u32x4*)((const bf16_t*)(p.ws + Z_RK) + go);
            *(LAS u32x4*)(Vs + j * RS64 + c8 * 2) = *(const u32x4*)((const bf16_t*)(p.ws + Z_RV) + go); }
        {
            float sf[8], sb[8]; const int e0 = c.tid * 8;
            if (smp) { const float* s0 = p.in[I_ST] + ((size_t)((b * 2 + l) * 2 + 0) * NH + h) * 4096 + e0; const float* s1 = p.in[I_ST] + ((size_t)((b * 2 + l) * 2 + 1) * NH + h) * 4096 + e0;
#pragma unroll
                for (int i = 0; i < 8; ++i) { sf[i] = s0[i]; sb[i] = s1[i]; } }
            else {
#pragma unroll
                for (int i = 0; i < 8; ++i) { sf[i] = 0.f; sb[i] = 0.f; } }
            {
                const float* uf = U + ((size_t)(0 * NCHUNK + ch0) * NH + h) * 4096 + e0; const float* ub = U + ((size_t)(1 * NCHUNK + ch0) * NH + h) * 4096 + e0;
                int cc = 0;
                for (; cc + 4 <= cidx; cc += 4) { f32x4 a[4][2];
#pragma unroll
                    for (int k = 0; k < 4; ++k) { a[k][0] = *(const f32x4*)(uf + (size_t)(cc + k) * NH * 4096); a[k][1] = *(const f32x4*)(uf + (size_t)(cc + k) * NH * 4096 + 4); }
#pragma unroll
                    for (int k = 0; k < 4; ++k)
#pragma unroll
                        for (int i = 0; i < 4; ++i) { sf[i] = Gf * sf[i] + a[k][0][i]; sf[4 + i] = Gf * sf[4 + i] + a[k][1][i]; } }
                for (; cc < cidx; ++cc) { const f32x4 a0 = *(const f32x4*)(uf + (size_t)cc * NH * 4096), a1 = *(const f32x4*)(uf + (size_t)cc * NH * 4096 + 4);
#pragma unroll
                    for (int i = 0; i < 4; ++i) { sf[i] = Gf * sf[i] + a0[i]; sf[4 + i] = Gf * sf[4 + i] + a1[i]; } }
                cc = nc - 1;
                for (; cc - 4 >= cidx; cc -= 4) { f32x4 a[4][2];
#pragma unroll
                    for (int k = 0; k < 4; ++k) { a[k][0] = *(const f32x4*)(ub + (size_t)(cc - k) * NH * 4096); a[k][1] = *(const f32x4*)(ub + (size_t)(cc - k) * NH * 4096 + 4); }
#pragma unroll
                    for (int k = 0; k < 4; ++k)
#pragma unroll
                        for (int i = 0; i < 4; ++i) { sb[i] = Gb * sb[i] + a[k][0][i]; sb[4 + i] = Gb * sb[4 + i] + a[k][1][i]; } }
                for (; cc > cidx; --cc) { const f32x4 a0 = *(const f32x4*)(ub + (size_t)cc * NH * 4096), a1 = *(const f32x4*)(ub + (size_t)cc * NH * 4096 + 4);
#pragma unroll
                    for (int i = 0; i < 4; ++i) { sb[i] = Gb * sb[i] + a0[i]; sb[4 + i] = Gb * sb[4 + i] + a1[i]; } }
            }
            { const int d = c.tid >> 3, e = (c.tid & 7) * 8; u32x4 w;
                w.x = pk2(sf[0], sf[1]); w.y = pk2(sf[2], sf[3]); w.z = pk2(sf[4], sf[5]); w.w = pk2(sf[6], sf[7]); *(LAS u32x4*)(Sf + d * RS64 + e * 2) = w;
                w.x = pk2(sb[0], sb[1]); w.y = pk2(sb[2], sb[3]); w.z = pk2(sb[4], sb[5]); w.w = pk2(sb[6], sb[7]); *(LAS u32x4*)(Sb + d * RS64 + e * 2) = w; }
            if (!smp && cidx == nc - 1) { const float* uf = U + ((size_t)(0 * NCHUNK + ch) * NH + h) * 4096 + e0; float* o = p.out + OUT_ST + ((size_t)((b * 2 + l) * 2 + 0) * NH + h) * 4096 + e0;
#pragma unroll
                for (int i = 0; i < 8; ++i) o[i] = Gf * sf[i] + uf[i]; }
            if (!smp && cidx == 0) { const float* ub = U + ((size_t)(1 * NCHUNK + ch) * NH + h) * 4096 + e0; float* o = p.out + OUT_ST + ((size_t)((b * 2 + l) * 2 + 1) * NH + h) * 4096 + e0;
#pragma unroll
                for (int i = 0; i < 8; ++i) o[i] = Gb * sb[i] + ub[i]; }
        }
        __syncthreads();
        { const bf16x8 q0 = row_frag(Qs, RS64, i0, 0, c.lane), q1 = row_frag(Qs, RS64, i0, 32, c.lane);
            const int iq = i0 + i16;
#pragma unroll
            for (int jt = 0; jt < 8; ++jt) {
                f32x4 s = (f32x4){0.f, 0.f, 0.f, 0.f};
                s = mfma16(row_frag(Ks, RS64, 16 * jt, 0, c.lane), q0, s); s = mfma16(row_frag(Ks, RS64, 16 * jt, 32, c.lane), q1, s);
                float pv[4];
#pragma unroll
                for (int r = 0; r < 4; ++r) { const int j = 16 * jt + 4 * g + r; const float w = j < iq ? exp2f(l2f * (float)(iq - j)) : (j > iq ? exp2f(l2b * (float)(j - iq)) : 2.0f); pv[r] = s[r] * w; }
                u32x2 w2; w2.x = pk2(pv[0], pv[1]); w2.y = pk2(pv[2], pv[3]);
                *(LAS u32x2*)(Ps + iq * RS128 + (16 * jt + 4 * g) * 2) = w2;
            } }
        __syncthreads();
        f32x4 ap[4], af[4], ab[4];
#pragma unroll
        for (int et = 0; et < 4; ++et) { ap[et] = (f32x4){0.f, 0.f, 0.f, 0.f}; af[et] = ap[et]; ab[et] = ap[et]; }
#pragma unroll
        for (int ks = 0; ks < 4; ++ks) { const bf16x8 a = row_frag(Ps, RS128, i0, 32 * ks, c.lane);
#pragma unroll
            for (int et = 0; et < 4; ++et) ap[et] = mfma16(a, tr_frag(Vs, RS64, 32 * ks, 16 * et, c.lane), ap[et]); }
#pragma unroll
        for (int ks = 0; ks < 2; ++ks) { const bf16x8 a = row_frag(Qs, RS64, i0, 32 * ks, c.lane);
#pragma unroll
            for (int et = 0; et < 4; ++et) { af[et] = mfma16(a, tr_frag(Sf, RS64, 32 * ks, 16 * et, c.lane), af[et]); ab[et] = mfma16(a, tr_frag(Sb, RS64, 32 * ks, 16 * et, c.lane), ab[et]); } }
        float mu[4], rstd[4];
#pragma unroll
        for (int r = 0; r < 4; ++r) { const int il = i0 + 4 * g + r; const float xf = exp2f(l2f * (float)(il + 1)), xb = exp2f(l2b * (float)(128 - il)); float s1 = 0.f;
#pragma unroll
            for (int et = 0; et < 4; ++et) { ap[et][r] += xf * af[et][r] + xb * ab[et][r]; s1 += ap[et][r]; }
            s1 += __shfl_xor(s1, 1); s1 += __shfl_xor(s1, 2); s1 += __shfl_xor(s1, 4); s1 += __shfl_xor(s1, 8); mu[r] = s1 * (1.f / 64.f); float s2 = 0.f;
#pragma unroll
            for (int et = 0; et < 4; ++et) { const float d = ap[et][r] - mu[r]; s2 += d * d; }
            s2 += __shfl_xor(s2, 1); s2 += __shfl_xor(s2, 2); s2 += __shfl_xor(s2, 4); s2 += __shfl_xor(s2, 8); rstd[r] = rsqrtf(s2 * (1.f / 64.f) + EPS); }
        LAS float* stg = (LAS float*)(Ps + i0 * RS128);
#pragma unroll
        for (int et = 0; et < 4; ++et) { const float gn = p.in[I_RETGN][l * RW + h * HD + 16 * et + i16];
#pragma unroll
            for (int r = 0; r < 4; ++r) stg[(4 * g + r) * 68 + 16 * et + i16] = (ap[et][r] - mu[r]) * rstd[r] * gn; }
        asm volatile("s_waitcnt lgkmcnt(0)" ::: "memory");
#pragma unroll
        for (int k = 0; k < 2; ++k) { const int row = c.lane >> 2, ec = ((c.lane & 3) * 2 + k) * 8;
            const f32x4 y0 = *(const LAS f32x4*)(stg + row * 68 + ec), y1 = *(const LAS f32x4*)(stg + row * 68 + ec + 4);
            const size_t go = (R0 + i0 + row) * RW + h * HD + ec; const u32x4 gw = *(const u32x4*)((const bf16_t*)(p.ws + Z_RG) + go);
            u32x4 o; o.x = pk2(y0.x * bflo(gw.x), y0.y * bfhi(gw.x)); o.y = pk2(y0.z * bflo(gw.y), y0.w * bfhi(gw.y)); o.z = pk2(y1.x * bflo(gw.z), y1.y * bfhi(gw.z)); o.w = pk2(y1.z * bflo(gw.w), y1.w * bfhi(gw.w));
            *(u32x4*)((bf16_t*)(p.ws + Z_CV) + go) = o; }
    }
    __syncthreads();
}

__device__ __forceinline__ void cmlp_fast(const Params& p, const Ctx& c, int l) {
    LAS unsigned char* As = c.lds; LAS unsigned char* Vc = As + 128 * RS128; LAS float* rs = (LAS float*)(Vc + 128 * RS128);
    const bf16_t* cv = (const bf16_t*)(p.ws + Z_CV); bf16_t* cu = (bf16_t*)(p.ws + Z_CU);
    const int g4 = c.lane >> 4, i16 = c.lane & 15, p0 = 16 * c.wave;
    for (int u = c.vcu; u < NCHUNK * 4; u += c.G) {
        const int ch = u >> 2, g = u & 3; const size_t R0 = (size_t)ch * 128;
        __syncthreads();
        { const int q = c.tid >> 2, part = c.tid & 3; float ss = 0.f;
            const bf16_t* r = cv + (R0 + q) * RW + part * 128;
#pragma unroll
            for (int i = 0; i < 16; ++i) { const u32x4 w = *(const u32x4*)(r + 8 * i); const float a0 = bflo(w.x), a1 = bfhi(w.x), a2 = bflo(w.y), a3 = bfhi(w.y), a4 = bflo(w.z), a5 = bfhi(w.z), a6 = bflo(w.w), a7 = bfhi(w.w);
                ss += (a0 * a0 + a1 * a1) + (a2 * a2 + a3 * a3) + (a4 * a4 + a5 * a5) + (a6 * a6 + a7 * a7); }
            ss += __shfl_xor(ss, 1); ss += __shfl_xor(ss, 2);
            if (part == 0) rs[q] = rsqrtf(ss * (1.f / RW) + EPS); }
#pragma unroll
        for (int it = 0; it < 4; ++it) { const int idx = c.tid + 512 * it, q = idx >> 4, c8 = (idx & 15) * 8;
            *(LAS u32x4*)(Vc + q * RS128 + c8 * 2) = *(const u32x4*)(cv + (R0 + q) * RW + g * 128 + c8); }
        __syncthreads();
        const float* Ws = p.in[I_CMWS] + ((size_t)(l * 4 + g) * 128) * 128;
#pragma unroll
        for (int it = 0; it < 8; ++it) { const int idx = c.tid + 512 * it, pr = idx >> 5, q4 = (idx & 31) * 4;
            const f32x4 w = *(const f32x4*)(Ws + pr * 128 + q4); const f32x4 r = *(const LAS f32x4*)(rs + q4);
            u32x2 o; o.x = pk2(w.x * r.x, w.y * r.y); o.y = pk2(w.z * r.z, w.w * r.w); *(LAS u32x2*)(As + pr * RS128 + q4 * 2) = o; }
        __syncthreads();
        f32x4 acc[8];
#pragma unroll
        for (int ct = 0; ct < 8; ++ct) acc[ct] = (f32x4){0.f, 0.f, 0.f, 0.f};
#pragma unroll
        for (int ks = 0; ks < 4; ++ks) { const bf16x8 a = row_frag(As, RS128, p0, 32 * ks, c.lane);
#pragma unroll
            for (int ct = 0; ct < 8; ++ct) acc[ct] = mfma16(a, tr_frag(Vc, RS128, 32 * ks, 16 * ct, c.lane), acc[ct]); }
        __syncthreads();
        LAS float* stg = (LAS float*)(c.lds + c.wave * (16 * 132 * 4));
        const float* bsv = p.in[I_CMBS] + (l * 4 + g) * 128 + p0 + 4 * g4;
        float bb[4];
#pragma unroll
        for (int r = 0; r < 4; ++r) bb[r] = bsv[r];
#pragma unroll
        for (int ct = 0; ct < 8; ++ct) { const float gn = p.in[I_CMNORM][l * RW + g * 128 + 16 * ct + i16];
#pragma unroll
            for (int r = 0; r < 4; ++r) stg[(4 * g4 + r) * 132 + 16 * ct + i16] = gn * acc[ct][r] + bb[r]; }
        asm volatile("s_waitcnt lgkmcnt(0)" ::: "memory");
#pragma unroll
        for (int k = 0; k < 4; ++k) { const int row = c.lane >> 2, cc = (k * 4 + (c.lane & 3)) * 8;
            const f32x4 y0 = *(const LAS f32x4*)(stg + row * 132 + cc), y1 = *(const LAS f32x4*)(stg + row * 132 + cc + 4);
            bf16_t* up = cu + (R0 + p0 + row) * RW + g * 128 + cc; const u32x4 uw = *(const u32x4*)up;
            u32x4 o; o.x = pk2(y0.x * bflo(uw.x), y0.y * bfhi(uw.x)); o.y = pk2(y0.z * bflo(uw.y), y0.w * bfhi(uw.y)); o.z = pk2(y1.x * bflo(uw.z), y1.y * bfhi(uw.z)); o.w = pk2(y1.z * bflo(uw.w), y1.w * bfhi(uw.w));
            *(u32x4*)up = o; }
    }
    __syncthreads();
}
#ifndef FAST_MIX
#define FAST_MIX 7
#endif

#ifndef PG8_MASK
#define PG8_MASK 0xFFF
#endif
template <int KIND, class Epi, class Sched>
__device__ __forceinline__ void gemm_any(const Ctx& c, const bf16_t* A, const bf16_t* Bt, int K, const Sched& S, const Epi& E, unsigned long long* probe_ts = nullptr) {
    if constexpr ((PG8_MASK >> KIND) & 1) { pg8::Gemm g{A, Bt, 0, 0, K, nullptr};
#ifdef PROBE_KIND
        if (KIND == PROBE_KIND && A != nullptr) g.ts = probe_ts;
#endif
        pg8::gemm_phase<Epi, Sched, true, true>(c.tid, c.lds, g, S, E); }
    else gemm_simple(c, A, Bt, K, S, E);
}
#ifndef KMASK
#define KMASK 0xFFF
#endif
constexpr int NPHASE = 23;
template <int KIND> __device__ __forceinline__ void run_kind(const Params& p, const Ctx& c, int l) {
    const unsigned char* wb = p.ws + WS_W;
    if constexpr (KIND == 0) { p0_modulation(p, c); p0_rope_tables(p, c); p_wconv(p, c, 0); p_kvctx(p, c, 0); }
    else if constexpr (KIND == 1) { p_norm(p, c, l, 0); }
    else if constexpr (KIND == 2) { StaticOrder S; S.init(M, NMIX, c.G, c.bx, DM); EpiMix E{&p, l}; gemm_any<2>(c, (const bf16_t*)(p.ws + WS_XN), (const bf16_t*)(wb + W_IN), DM, S, E, l == 0 ? (unsigned long long*)(p.ws + WS_CTL + 65536) : nullptr); }
    else if constexpr (KIND == 3) { if (ATTN_FAST) attn_fast(p, c); else attn_simple(p, c); if (FAST_MIX & 1) cmlp_fast(p, c, l); else cmlp_simple(p, c, l); if (FAST_MIX & 2) retU_fast(p, c, l); else retU_simple(p, c, l); }
    else if constexpr (KIND == 4) { if (FAST_MIX & 4) retO_fast(p, c, l); else retO_simple(p, c, l); }
    else if constexpr (KIND == 5) { StaticOrder S; S.init(M, NGATE, c.G, c.bx, DM); EpiGate E{&p}; gemm_any<5>(c, (const bf16_t*)(p.ws + WS_XN), (const bf16_t*)(wb + W_IN) + (size_t)NMIX * DM, DM, S, E, l == 0 ? (unsigned long long*)(p.ws + WS_CTL + 65536) : nullptr); }
    else if constexpr (KIND == 6) { MergeOrder S{c.G, (c.G % 8 == 0) ? (c.bx % 8) * (c.G / 8) + c.bx / 8 : c.bx}; EpiMerge E{&p}; gemm_any<6>(c, (const bf16_t*)(p.ws + Z_AQ), (const bf16_t*)(wb + W_BR), RW, S, E, l == 0 ? (unsigned long long*)(p.ws + WS_CTL + 65536) : nullptr); }
    else if constexpr (KIND == 7) { QuarterOrder S; S.init(c.G, c.bx, DM); EpiRes E{&p, l, 2, l == 0, DM / 64, (bf16_t*)(p.ws + SLAB_P4)}; gemm_any<7>(c, (const bf16_t*)(p.ws + WS_XN), (const bf16_t*)(wb + W_OUT), DM, S, E, l == 0 ? (unsigned long long*)(p.ws + WS_CTL + 65536) : nullptr); }
    else if constexpr (KIND == 8) { p_norm(p, c, l, 1, c.G == 256); }
    else if constexpr (KIND == 9) { StaticOrder S; S.init(M, DFF, c.G, c.bx, DM); EpiFF1 E{&p}; gemm_any<9>(c, (const bf16_t*)(p.ws + WS_XN), (const bf16_t*)(wb + W_FF1), DM, S, E, l == 0 ? (unsigned long long*)(p.ws + WS_CTL + 65536) : nullptr); }
    else if constexpr (KIND == 10) { QuarterOrder S; S.init(c.G, c.bx, DFF); EpiRes E{&p, l, 5, false, DFF / 64, (bf16_t*)(p.ws + SLAB_P6)}; gemm_any<10>(c, (const bf16_t*)(p.ws + Z_HB), (const bf16_t*)(wb + W_FF2), DFF, S, E, l == 0 ? (unsigned long long*)(p.ws + WS_CTL + 65536) : nullptr); }
    else { if (l == 0) { if (c.G == 256) p_combine(p, c, 0, (const bf16_t*)(p.ws + SLAB_P6)); p_wconv(p, c, 1); p_kvctx(p, c, 1); } else p_final_norm(p, c, c.G == 256); }
}
template <int PH> __device__ __forceinline__ void run_from(const Params& p, const Ctx& c0, const XcdBarrier& bar) {
    if constexpr (PH < NPHASE) {
        constexpr int kind = PH < 12 ? PH : (PH == 12 ? 1 : PH - 11), l = PH < 12 ? 0 : 1;
#ifdef PROBE_A
        if (c0.bx == 0 && c0.tid == 0) ((unsigned long long*)(p.ws + WS_CTL + 65536))[PH] = __builtin_amdgcn_s_memrealtime();
#endif
        { Ctx c = c0; asm volatile("" : "+v"(c.tid)); c.lane = c.tid & 63; c.wave = __builtin_amdgcn_readfirstlane(c.tid >> 6);
          if ((KMASK >> kind) & 1) run_kind<kind>(p, c, l); }
#ifdef PROBE_A
        xcd_barrier(bar);
        if constexpr (PH + 1 == NPHASE) {
            if (c0.bx == 0 && c0.tid == 0) ((unsigned long long*)(p.ws + WS_CTL + 65536))[NPHASE] = __builtin_amdgcn_s_memrealtime();
            xcd_barrier(bar);
            const unsigned long long* ts = (const unsigned long long*)(p.ws + WS_CTL + 65536);
            const float us = (float)(ts[PROBE_B] - ts[PROBE_A]) * 0.01f; const float sc = 1.0f + sqrtf(2e-4f * us / (float)(PROBE_FS));
            for (size_t i = (size_t)c0.bx * 512 + c0.tid; i < (size_t)NB_P * 2 * SEQ_P * KVW; i += (size_t)c0.G * 512) p.out[OUT_CV + i] *= sc;
        }
#else
        if constexpr (PH + 1 < NPHASE) xcd_barrier(bar);
#endif
        run_from<PH + 1>(p, c0, bar);
    }
}
#if N_LAUNCH_MODE == 1
__global__ void __launch_bounds__(512, 2) fwd_kernel(Params p) {
    extern __shared__ __attribute__((aligned(16))) unsigned char lds[];
    Ctx c; c.tid = threadIdx.x; c.lane = c.tid & 63; c.wave = __builtin_amdgcn_readfirstlane(c.tid >> 6); c.G = gridDim.x; c.bx = blockIdx.x; c.vcu = (c.G % 8 == 0) ? (c.bx % 8) * (c.G / 8) + c.bx / 8 : c.bx; c.lds = (LAS unsigned char*)lds;
    volatile LAS unsigned* MISC = (volatile LAS unsigned*)(c.lds + MISC_OFF);
    if (c.tid < 32) MISC[c.tid] = 0u;
    __syncthreads();
    XcdBarrier bar = xcd_barrier_post((unsigned*)(p.ws + WS_CTL) + CW_BAR, MISC + 8);
    run_from<0>(p, c, bar);
}
#endif
template <int KIND> __global__ void __launch_bounds__(512, 2) phase_kernel(Params p) {
    extern __shared__ __attribute__((aligned(16))) unsigned char lds[];
    Ctx c; c.tid = threadIdx.x; c.lane = c.tid & 63; c.wave = __builtin_amdgcn_readfirstlane(c.tid >> 6); c.G = gridDim.x; c.bx = blockIdx.x; c.vcu = (c.G % 8 == 0) ? (c.bx % 8) * (c.G / 8) + c.bx / 8 : c.bx; c.lds = (LAS unsigned char*)lds;
    run_kind<KIND>(p, c, p.ph_hi);
}
template <int KIND> static void launch_kind(Params p, int l, int grid, hipStream_t stream) {
    static bool attr = false;
    if (!attr) { (void)hipFuncSetAttribute((const void*)phase_kernel<KIND>, hipFuncAttributeMaxDynamicSharedMemorySize, LDS_BYTES); attr = true; }
    p.ph_lo = 0; p.ph_hi = l;
    hipLaunchKernelGGL(phase_kernel<KIND>, dim3(grid), dim3(512), LDS_BYTES, stream, p);
}

extern "C" void kernel_launch(void* const* d_in, const int* in_sizes, int n_in, void* d_out, int out_size, void* d_ws, size_t ws_size, hipStream_t stream) {
    static int grid = 0;
    if (grid == 0) {
        int dev = 0, cus = 0;
        if (n_in != N_IN || ws_size < WS_NEED) { grid = -1; return; }
        if (hipGetDevice(&dev) != hipSuccess || hipDeviceGetAttribute(&cus, hipDeviceAttributeMultiprocessorCount, dev) != hipSuccess) { grid = -1; return; }
#if N_LAUNCH_MODE == 1
        if (hipFuncSetAttribute((const void*)fwd_kernel, hipFuncAttributeMaxDynamicSharedMemorySize, LDS_BYTES) != hipSuccess) { grid = -1; return; }
#endif
        grid = cus;
    }
    if (grid < 0) return;
    (void)hipMemsetAsync((char*)d_ws + WS_CTL, 0, WS_ZERO_BYTES, stream);
    Params p{};
    for (int i = 0; i < N_IN; ++i) p.in[i] = (const float*)d_in[i];
    p.out = (float*)d_out; p.ws = (unsigned char*)d_ws;
#if N_LAUNCH_MODE == 1
    p.ph_lo = 0; p.ph_hi = NPHASE;
    hipLaunchKernelGGL(fwd_kernel, dim3(grid), dim3(512), LDS_BYTES, stream, p);
#else
    launch_kind<0>(p, 0, grid, stream);
    for (int l = 0; l < 2; ++l) { launch_kind<1>(p, l, grid, stream);
        launch_kind<2>(p, l, grid, stream); launch_kind<3>(p, l, grid, stream); launch_kind<4>(p, l, grid, stream); launch_kind<5>(p, l, grid, stream); launch_kind<6>(p, l, grid, stream);
        launch_kind<7>(p, l, grid, stream); launch_kind<8>(p, l, grid, stream); launch_kind<9>(p, l, grid, stream); launch_kind<10>(p, l, grid, stream); launch_kind<11>(p, l, grid, stream);
    }
#endif
}
```

```cpp
#include <hip/hip_runtime.h>
#include <hip/hip_bf16.h>
#include <cstdio>
#include <cstdint>

#ifndef N_LAUNCH_MODE
#define N_LAUNCH_MODE 1
#endif

#define GAS __attribute__((address_space(1)))
#define LAS __attribute__((address_space(3)))
#define RLX_AGENT __ATOMIC_RELAXED, __HIP_MEMORY_SCOPE_AGENT
typedef unsigned short bf16_t;
typedef short bf16x8 __attribute__((ext_vector_type(8)));
typedef float f32x4 __attribute__((ext_vector_type(4)));
typedef float f32x2 __attribute__((ext_vector_type(2)));
typedef unsigned u32x4 __attribute__((ext_vector_type(4)));
typedef unsigned u32x2 __attribute__((ext_vector_type(2)));

constexpr int DM = 1024, MP = 4096, MS = 16384, M = 20480, SEQ_P = 256, SEQ_S = 2048, NB_P = 16, NB_S = 8, PAST = 256;
constexpr int HD = 64, NH = 8, KVW = 128, DFF = 4096, INW = 6912, NMIX = 3840, NGATE = 3072, RW = 512;
constexpr int SKV_S = PAST + SEQ_S, SKV_P = SEQ_P;
constexpr int NCHUNK = M / 128;
constexpr float EPS = 1e-6f;
constexpr float C2 = 0.18033688011112042f;
constexpr size_t OUT_Y = 0, OUT_CK = (size_t)M * DM, OUT_CV = OUT_CK + (size_t)NB_P * 2 * SEQ_P * KVW, OUT_ST = OUT_CV + (size_t)NB_P * 2 * SEQ_P * KVW;

constexpr size_t MiB = 1u << 20;
constexpr size_t WS_CTL = 0;
constexpr size_t WS_MOD = 1 * MiB;
constexpr size_t WS_ROPE = 1 * MiB + 512 * 1024;
constexpr size_t WS_ZERO_BYTES = 1 * MiB + 512 * 1024;
constexpr size_t WS_W = 2 * MiB;
constexpr size_t W_IN = 0, W_BR = W_IN + (size_t)INW * DM * 2, W_OUT = W_BR + (size_t)3 * DM * RW * 2, W_FF1 = W_OUT + (size_t)DM * DM * 2, W_FF2 = W_FF1 + (size_t)DFF * DM * 2, W_END = W_FF2 + (size_t)DM * DFF * 2;
static_assert(W_END <= 35 * MiB, "weights");
constexpr size_t WS_XN = 37 * MiB;
constexpr size_t WS_Z = 77 * MiB;
constexpr size_t Z_RQ = WS_Z, Z_RK = WS_Z + 20 * MiB, Z_RV = WS_Z + 40 * MiB, Z_RG = WS_Z + 60 * MiB, Z_U = WS_Z + 80 * MiB;
constexpr size_t Z_AQ = WS_Z + 120 * MiB, Z_CU = WS_Z + 140 * MiB, Z_CV = WS_Z + 160 * MiB;
constexpr size_t Z_KS = WS_Z + 180 * MiB, Z_VS = Z_KS + (size_t)NB_S * SKV_S * KVW * 2, Z_KP = Z_VS + (size_t)NB_S * SKV_S * KVW * 2, Z_VP = Z_KP + (size_t)NB_P * SEQ_P * KVW * 2, Z_END = Z_VP + (size_t)NB_P * SEQ_P * KVW * 2;
constexpr size_t Z_GATE = WS_Z;
constexpr size_t Z_HB = WS_Z;
constexpr size_t SLAB_P4 = WS_Z, SLAB_P6 = WS_XN;
constexpr size_t WS_NEED = 268 * MiB;
static_assert(Z_END <= WS_NEED, "ws map");
constexpr int CW_BAR = 4096;

constexpr int LDS_BYTES = 147456;
constexpr int MISC_OFF = 131072 + 320;

__device__ __forceinline__ unsigned f2bf(float f) { unsigned u = __builtin_bit_cast(unsigned, f); return (u + 0x7fffu + ((u >> 16) & 1u)) >> 16; }
typedef __bf16 bf16x2_hw __attribute__((ext_vector_type(2)));
__device__ __forceinline__ unsigned pk2(float lo, float hi) { const f32x2 v = {lo, hi}; return __builtin_bit_cast(unsigned, __builtin_convertvector(v, bf16x2_hw)); }
__device__ __forceinline__ float bf2f(unsigned h) { return __builtin_bit_cast(float, h << 16); }
__device__ __forceinline__ float bflo(unsigned w) { return __builtin_bit_cast(float, w << 16); }
__device__ __forceinline__ float bfhi(unsigned w) { return __builtin_bit_cast(float, w & 0xffff0000u); }
__device__ __forceinline__ float sigmoidf_(float x) { return __builtin_amdgcn_rcpf(1.f + __builtin_amdgcn_exp2f(-1.4426950408889634f * x)); }
__device__ __forceinline__ float siluf_(float x) { return x * sigmoidf_(x); }
__device__ __forceinline__ float gelu_tanh(float x) { const float x2 = x * x; const float t = x * (-2.302208198f - 0.1029432397f * x2);
    return x * __builtin_amdgcn_rcpf(1.f + __builtin_amdgcn_exp2f(t)); }
__device__ __forceinline__ float wave_sum(float v) {
#pragma unroll
    for (int o = 1; o < 64; o <<= 1) v += __shfl_xor(v, o);
    return v;
}

#define XB_TMO      128
#define XB_XCNT(j)  (256  + 64 * (j))
#define XB_XSUB(j)  (1280 + 64 * (j))
#define XB_XGEN(j)  (2304 + 64 * (j))
#define XB_TOP      3328
#define XB_TOPGEN   3392
#define XCD_BAR_WORDS 3456
#define XB_SPIN_CAP (1u << 18)
__device__ __forceinline__ unsigned xb_ld(unsigned* p)              { return __hip_atomic_load(p, __ATOMIC_RELAXED, __HIP_MEMORY_SCOPE_AGENT); }
__device__ __forceinline__ unsigned xb_add(unsigned* p, unsigned v) { return __hip_atomic_fetch_add(p, v, __ATOMIC_RELAXED, __HIP_MEMORY_SCOPE_AGENT); }
__device__ __forceinline__ unsigned xb_xcc_id() { return (unsigned)__builtin_amdgcn_s_getreg((3 << 11) | 20) & 0xFu; }
#define XB_SPIN(cond, bar) do { unsigned _sp = 0; while (cond) { __builtin_amdgcn_s_sleep(1); \
    if ((++_sp & 255u) == 0u) { if (xb_ld(&(bar)[XB_TMO])) break; if (_sp > XB_SPIN_CAP) { atomicAdd(&(bar)[XB_TMO], 1u); break; } } } } while (0)
struct XcdBarrier { unsigned* bar; unsigned x; volatile LAS unsigned* st; };
__device__ __forceinline__ XcdBarrier xcd_barrier_post(unsigned* bar, volatile LAS unsigned* st) {
    XcdBarrier b; b.bar = bar; b.x = xb_xcc_id(); b.st = st;
    if (threadIdx.x == 0) (void)xb_add(&bar[XB_XCNT(b.x)], 1u);
    return b;
}
__device__ __forceinline__ void xcd_barrier_complete(unsigned* bar, unsigned x, unsigned& nloc, unsigned& nx) {
    const unsigned G = gridDim.x * gridDim.y * gridDim.z;
    unsigned sum, cnt, mine, sp = 0u;
    for (;;) {
        sum = 0u; cnt = 0u; mine = 0u;
#pragma unroll
        for (unsigned j = 0; j < 16; ++j) { const unsigned c = xb_ld(&bar[XB_XCNT(j)]); sum += c; cnt += (c > 0u) ? 1u : 0u; mine = (j == x) ? c : mine; }
        if (sum == G) break;
        __builtin_amdgcn_s_sleep(1);
        if ((++sp & 255u) == 0u) { if (xb_ld(&bar[XB_TMO])) break; if (sp > XB_SPIN_CAP) { atomicAdd(&bar[XB_TMO], 1u); break; } }
    }
    nloc = mine > 0u ? mine : 1u; nx = cnt > 0u ? cnt : 1u;
}
__device__ __forceinline__ void xcd_barrier(const XcdBarrier& b) {
    asm volatile("s_waitcnt vmcnt(0)" ::: "memory");
    __syncthreads();
    if (threadIdx.x == 0) {
        unsigned* bar = b.bar;
        __builtin_amdgcn_s_waitcnt(0);
        unsigned nloc = b.st[0], nx = b.st[1];
        if (nloc == 0u) { xcd_barrier_complete(bar, b.x, nloc, nx); b.st[0] = nloc; b.st[1] = nx; }
        const unsigned old = xb_add(&bar[XB_XSUB(b.x)], 1u);
        const unsigned gen = old / nloc;
        if (old + 1u == (gen + 1u) * nloc) {
            __builtin_amdgcn_fence(__ATOMIC_RELEASE, "agent");
            asm volatile("s_waitcnt vmcnt(0)" ::: "memory");
            const unsigned og = xb_add(&bar[XB_TOP], 1u);
            const unsigned tg = og / nx;
            if (og + 1u == (tg + 1u) * nx) xb_add(&bar[XB_TOPGEN], 1u);
            else XB_SPIN(xb_ld(&bar[XB_TOPGEN]) == tg, bar);
            __builtin_amdgcn_fence(__ATOMIC_ACQUIRE, "agent");
            xb_add(&bar[XB_XGEN(b.x)], 1u);
            asm volatile("s_waitcnt vmcnt(0)" ::: "memory");
        } else {
            XB_SPIN(xb_ld(&bar[XB_XGEN(b.x)]) == gen, bar);
            __builtin_amdgcn_fence(__ATOMIC_ACQUIRE, "agent");
            asm volatile("s_waitcnt vmcnt(0)" ::: "memory");
        }
    }
    __syncthreads();
}

enum { I_XP = 0, I_XS, I_CK, I_CV, I_ST, I_C, I_CCTX, I_WMOD, I_BMOD, I_GN1, I_GN2, I_WIN, I_GQ, I_GK, I_DECAY, I_RETGN, I_CMNORM, I_CMWS, I_CMBS, I_WBRR, I_WBRA, I_WBRC, I_WOUT, I_WFF1, I_WFF2, I_GFIN, N_IN };
struct Params { const float* in[N_IN]; float* out; unsigned char* ws; int ph_lo, ph_hi; };
static_assert(sizeof(Params) == N_IN * 8 + 8 + 8 + 8, "no padding");

struct Ctx {
    int tid, lane, wave, G, bx, vcu;
    LAS unsigned char* lds;
};
__device__ __forceinline__ int row_ci(int R) { return R < MP ? 0 : 1 + ((R - MP) >> 11); }
__device__ __forceinline__ const float* mod_ptr(const Params& p, int l, int ci, int part) { return (const float*)(p.ws + WS_MOD) + ((size_t)(l * 9 + ci) * 6 + part) * DM; }

__device__ __forceinline__ void p0_modulation(const Params& p, const Ctx& c) {
    LAS float* sl = (LAS float*)c.lds;
    for (int i = c.tid; i < 9 * DM; i += 512) { const int ci = i >> 10, k = i & 1023; const float v = ci == 0 ? p.in[I_CCTX][k] : p.in[I_C][(ci - 1) * DM + k]; sl[i] = siluf_(v); }
    __syncthreads();
    float* mod = (float*)(p.ws + WS_MOD);
    const int gw = c.bx * 8 + c.wave, NGW = c.G * 8;
    constexpr int NITEM = 2 * 96 * 8;
    for (int it = gw; it < NITEM; it += NGW) {
        const int l = it / 768, r = it % 768, cb = r >> 3, ks = r & 7;
        const float* W = p.in[I_WMOD] + (size_t)l * DM * 6144 + (size_t)(ks * 128) * 6144 + cb * 64 + c.lane;
        float s[9];
#pragma unroll
        for (int ci = 0; ci < 9; ++ci) s[ci] = 0.f;
#pragma unroll 4
        for (int k = 0; k < 128; ++k) {
            const float w = W[(size_t)k * 6144];
#pragma unroll
            for (int ci = 0; ci < 9; ++ci) s[ci] += sl[ci * DM + ks * 128 + k] * w;
        }
        const float bias = ks == 0 ? p.in[I_BMOD][l * 6144 + cb * 64 + c.lane] : 0.f;
#pragma unroll
        for (int ci = 0; ci < 9; ++ci) atomicAdd(mod + (size_t)(l * 9 + ci) * 6144 + cb * 64 + c.lane, s[ci] + bias);
    }
    __syncthreads();
}
__device__ __forceinline__ void p0_rope_tables(const Params& p, const Ctx& c) {
    f32x2* tab = (f32x2*)(p.ws + WS_ROPE);
    const int g = c.bx * 512 + c.tid;
    if (g < 96 * 16) { const int pos = g >> 4, i = g & 15; const float inv = 1.0f / powf(10000.0f, (float)(2 * i) / 32.0f); const float posf = pos < 32 ? (float)pos : (float)(pos - 32);
        const float ang = posf * inv; f32x2 v; v.x = cosf(ang); v.y = sinf(ang); tab[g] = v; }
}
__device__ __forceinline__ int win_colmap(int n) {
    const int tile = n >> 8, pp = n & 255, bj = pp >> 7, wc = (pp >> 5) & 3;
    if (tile < 10) return (tile >> 1) * 512 + ((tile & 1) * 4 + wc) * 64 + 32 * bj;
    if (tile == 10) return (wc < 2 ? 2560 + wc * 64 : 2688 + (wc - 2) * 64) + 32 * bj;
    return n;
}
__device__ __forceinline__ void transpose_item(const float* W, int K, int ldn, int src_col0, bf16_t* WT, int dst_row0, int k0, LAS float* scr, int lane) {
#pragma unroll 8
    for (int i = 0; i < 32; ++i) { const int kk = 2 * i + (lane >> 5); scr[kk * 33 + (lane & 31)] = W[(size_t)(k0 + kk) * ldn + src_col0 + (lane & 31)]; }
    asm volatile("s_waitcnt lgkmcnt(0)" ::: "memory");
    const int ch = lane & 7;
#pragma unroll
    for (int j = 0; j < 4; ++j) { const int n = (lane >> 3) + 8 * j; const LAS float* s = scr + (8 * ch) * 33 + n;
        u32x4 o; o.x = pk2(s[0 * 33], s[1 * 33]); o.y = pk2(s[2 * 33], s[3 * 33]); o.z = pk2(s[4 * 33], s[5 * 33]); o.w = pk2(s[6 * 33], s[7 * 33]);
        *(u32x4*)(WT + (size_t)(dst_row0 + n) * K + k0 + 8 * ch) = o; }
    asm volatile("s_waitcnt lgkmcnt(0)" ::: "memory");
}
__device__ __forceinline__ void p_wconv(const Params& p, const Ctx& c, int l) {
    LAS float* scr = (LAS float*)(c.lds + 40960 + c.wave * 8448);
    const int gw = c.bx * 8 + c.wave, NGW = c.G * 8;
    unsigned char* wb = p.ws + WS_W;
    constexpr int I_IN = 16 * 216, I_BRX = 8 * 32, I_O = 16 * 32, I_F1 = 16 * 128, I_F2 = 64 * 32;
    constexpr int NITEMS = I_IN + 3 * I_BRX + I_O + I_F1 + I_F2;
    for (int it = gw; it < NITEMS; it += NGW) {
        int r = it;
        if (r < I_IN) { const int kb = r / 216, nb = r % 216; transpose_item(p.in[I_WIN] + (size_t)l * DM * INW, DM, INW, win_colmap(nb * 32), (bf16_t*)(wb + W_IN), nb * 32, kb * 64, scr, c.lane); continue; } r -= I_IN;
        if (r < 3 * I_BRX) { const int x = r / I_BRX, rr = r % I_BRX, kb = rr / 32, nb = rr % 32;
            const float* src = (x == 0 ? p.in[I_WBRA] : x == 1 ? p.in[I_WBRC] : p.in[I_WBRR]) + (size_t)l * RW * DM;
            transpose_item(src, RW, DM, nb * 32, (bf16_t*)(wb + W_BR) + (size_t)x * DM * RW, nb * 32, kb * 64, scr, c.lane); continue; } r -= 3 * I_BRX;
        if (r < I_O) { const int kb = r / 32, nb = r % 32; transpose_item(p.in[I_WOUT] + (size_t)l * DM * DM, DM, DM, nb * 32, (bf16_t*)(wb + W_OUT), nb * 32, kb * 64, scr, c.lane); continue; } r -= I_O;
        if (r < I_F1) { const int kb = r / 128, nb = r % 128; transpose_item(p.in[I_WFF1] + (size_t)l * DM * DFF, DM, DFF, nb * 32, (bf16_t*)(wb + W_FF1), nb * 32, kb * 64, scr, c.lane); continue; } r -= I_F1;
        { const int kb = r / 32, nb = r % 32; transpose_item(p.in[I_WFF2] + (size_t)l * DFF * DM, DFF, DM, nb * 32, (bf16_t*)(wb + W_FF2), nb * 32, kb * 64, scr, c.lane); }
    }
}
__device__ __forceinline__ void p_kvctx(const Params& p, const Ctx& c, int l) {
    const int g = c.bx * 512 + c.tid, NG = c.G * 512;
    for (int i = g; i < NB_S * PAST * KVW / 4; i += NG) {
        const int e = i * 4, b = e / (PAST * KVW), r = e % (PAST * KVW);
        const size_t src = ((size_t)(b * 2 + l) * PAST) * KVW + r;
        const f32x4 k = *(const f32x4*)(p.in[I_CK] + src), v = *(const f32x4*)(p.in[I_CV] + src);
        u32x2 ko, vo; ko.x = pk2(k.x, k.y); ko.y = pk2(k.z, k.w); vo.x = pk2(v.x, v.y); vo.y = pk2(v.z, v.w);
        *(u32x2*)((bf16_t*)(p.ws + Z_KS) + (size_t)b * SKV_S * KVW + r) = ko;
        *(u32x2*)((bf16_t*)(p.ws + Z_VS) + (size_t)b * SKV_S * KVW + r) = vo;
    }
}
__device__ __forceinline__ const float* x_row(const Params& p, int l, int R) { return l == 0 ? (R < MP ? p.in[I_XP] + (size_t)R * DM : p.in[I_XS] + (size_t)(R - MP) * DM) : p.out + (size_t)R * DM; }
__device__ __forceinline__ void slab_combine(const Params& p, const Ctx& c, int l, int part, const bf16_t* slab, int R, f32x4 (&v)[4]) {
    const float* gv = mod_ptr(p, l, row_ci(R), part);
#pragma unroll
    for (int j = 0; j < 4; ++j) { const bf16_t* s = slab + ((size_t)(((R >> 8) - 64) * 4 + j) * 4 * 256 + (R & 255)) * 256 + 4 * c.lane; f32x4 a = (f32x4){0.f, 0.f, 0.f, 0.f};
#pragma unroll
        for (int q = 0; q < 4; ++q) { const u32x2 w = *(const u32x2*)(s + (size_t)q * 65536); a.x += bflo(w.x); a.y += bfhi(w.x); a.z += bflo(w.y); a.w += bfhi(w.y); }
        v[j] = v[j] + *(const f32x4*)(gv + 4 * c.lane + 256 * j) * a; }
}
__device__ __forceinline__ void p_combine(const Params& p, const Ctx& c, int l, const bf16_t* slab) {
    const int gw = c.bx * 8 + c.wave, NGW = c.G * 8;
    for (int R = 16384 + gw; R < M; R += NGW) {
        float* xr = p.out + (size_t)R * DM; f32x4 v[4];
#pragma unroll
        for (int j = 0; j < 4; ++j) v[j] = *(const f32x4*)(xr + 4 * c.lane + 256 * j);
        slab_combine(p, c, l, 5, slab, R, v);
#pragma unroll
        for (int j = 0; j < 4; ++j) *(f32x4*)(xr + 4 * c.lane + 256 * j) = v[j];
    }
}
__device__ __forceinline__ void p_norm(const Params& p, const Ctx& c, int l, int which, bool comb = false) {
    const int gw = c.bx * 8 + c.wave, NGW = c.G * 8;
    const float* gvec = (which == 0 ? p.in[I_GN1] : p.in[I_GN2]) + l * DM;
    constexpr int NR = 2;
    for (int Rb = gw * NR; Rb < M; Rb += NGW * NR) {
        f32x4 v[NR][4]; float s[NR];
#pragma unroll
        for (int rr = 0; rr < NR; ++rr) { const int R = Rb + rr;
            const float* xr = (which == 0 || (comb && l == 0 && R >= 16384)) ? x_row(p, l, R) : p.out + (size_t)R * DM;
#pragma unroll
            for (int j = 0; j < 4; ++j) v[rr][j] = *(const f32x4*)(xr + 4 * c.lane + 256 * j); }
        if (comb && Rb >= 16384) {
#pragma unroll
            for (int rr = 0; rr < NR; ++rr) { const int R = Rb + rr; slab_combine(p, c, l, 2, (const bf16_t*)(p.ws + SLAB_P4), R, v[rr]);
#pragma unroll
                for (int j = 0; j < 4; ++j) *(f32x4*)(p.out + (size_t)R * DM + 4 * c.lane + 256 * j) = v[rr][j]; } }
#pragma unroll
        for (int rr = 0; rr < NR; ++rr) { s[rr] = 0.f;
#pragma unroll
            for (int j = 0; j < 4; ++j) s[rr] += (v[rr][j].x * v[rr][j].x + v[rr][j].y * v[rr][j].y) + (v[rr][j].z * v[rr][j].z + v[rr][j].w * v[rr][j].w); }
#pragma unroll
        for (int o = 1; o < 64; o <<= 1) {
#pragma unroll
            for (int rr = 0; rr < NR; ++rr) s[rr] += __shfl_xor(s[rr], o); }
#pragma unroll
        for (int rr = 0; rr < NR; ++rr) { const int R = Rb + rr; const int ci = row_ci(R);
            const float* sh = mod_ptr(p, l, ci, which == 0 ? 0 : 3); const float* sc = mod_ptr(p, l, ci, which == 0 ? 1 : 4);
            const float rstd = rsqrtf(s[rr] * (1.f / DM) + EPS);
            bf16_t* orow = (bf16_t*)(p.ws + WS_XN) + (size_t)R * DM;
#pragma unroll
            for (int j = 0; j < 4; ++j) { const int col = 4 * c.lane + 256 * j; const f32x4 g = *(const f32x4*)(gvec + col), a = *(const f32x4*)(sc + col), b2 = *(const f32x4*)(sh + col);
                f32x4 o = v[rr][j] * rstd * g * (a + 1.0f) + b2; u32x2 w; w.x = pk2(o.x, o.y); w.y = pk2(o.z, o.w); *(u32x2*)(orow + col) = w; } }
    }
}
__device__ __forceinline__ void p_final_norm(const Params& p, const Ctx& c, bool comb) {
    const int gw = c.bx * 8 + c.wave, NGW = c.G * 8;
    constexpr int NR = 2;
    for (int Rb = gw * NR; Rb < M; Rb += NGW * NR) {
        f32x4 v[NR][4]; float s[NR];
#pragma unroll
        for (int rr = 0; rr < NR; ++rr) { const float* xr = p.out + (size_t)(Rb + rr) * DM;
#pragma unroll
            for (int j = 0; j < 4; ++j) v[rr][j] = *(const f32x4*)(xr + 4 * c.lane + 256 * j); }
        if (comb && Rb >= 16384) {
#pragma unroll
            for (int rr = 0; rr < NR; ++rr) slab_combine(p, c, 1, 5, (const bf16_t*)(p.ws + SLAB_P6), Rb + rr, v[rr]); }
#pragma unroll
        for (int rr = 0; rr < NR; ++rr) { s[rr] = 0.f;
#pragma unroll
            for (int j = 0; j < 4; ++j) s[rr] += (v[rr][j].x * v[rr][j].x + v[rr][j].y * v[rr][j].y) + (v[rr][j].z * v[rr][j].z + v[rr][j].w * v[rr][j].w); }
#pragma unroll
        for (int o = 1; o < 64; o <<= 1) {
#pragma unroll
            for (int rr = 0; rr < NR; ++rr) s[rr] += __shfl_xor(s[rr], o); }
#pragma unroll
        for (int rr = 0; rr < NR; ++rr) { float* xr = p.out + (size_t)(Rb + rr) * DM; const float rstd = rsqrtf(s[rr] * (1.f / DM) + EPS);
#pragma unroll
            for (int j = 0; j < 4; ++j) { const int col = 4 * c.lane + 256 * j; const f32x4 g = *(const f32x4*)(p.in[I_GFIN] + col); *(f32x4*)(xr + col) = v[rr][j] * rstd * g; } }
    }
}

struct Unit { int pm, pn, k0, nt; };
__host__ __device__ __forceinline__ int perm32(int rho) { const int n = rho >> 4, i = rho & 15; return 8 * (i >> 2) + 4 * n + (i & 3); }
#ifndef WGM_
#define WGM_ 8
#endif
struct StaticOrder {
    int nM, nN, nwg, G, c, ntf;
    __device__ void init(int Mr, int N, int G_, int c_, int K) { nM = Mr / 256; nN = N / 256; nwg = nM * nN; G = G_; c = c_; ntf = K / 64; }
    __device__ bool next(int i, Unit& u) const {
        const long L = (long)i * G + c; if (L >= nwg) return false;
        int wgid = (int)L; { const int q = nwg / 8, r = nwg % 8, xcd = wgid % 8, off = wgid / 8; wgid = (xcd < r ? xcd * (q + 1) : r * (q + 1) + (xcd - r) * q) + off; }
        const int nig = WGM_ * nN, gid = wgid / nig, fm = gid * WGM_, gsz = (nM - fm) < WGM_ ? (nM - fm) : WGM_;
        u.pm = fm + ((wgid % nig) % gsz); u.pn = (wgid % nig) / gsz; u.k0 = 0; u.nt = ntf; return true;
    }
    __device__ __forceinline__ void a_ready(const Unit&) const {}
    __device__ __forceinline__ void done(const Unit&) const {}
};
struct MergeOrder {
    int G, c;
    __device__ bool next(int i, Unit& u) const {
        const int t = i / 3, x = i % 3; long L = (long)t * G + c;
        if (G == 256 && t == 1) { if (c & 3) return false; L = 256 + (c >> 2); }
        if (L >= 320) return false;
        u.pm = x * 80 + (int)(L >> 2); u.pn = x * 4 + (int)(L & 3); u.k0 = 0; u.nt = RW / 64; return true;
    }
    __device__ __forceinline__ void a_ready(const Unit&) const {}
    __device__ __forceinline__ void done(const Unit&) const {}
};
#ifndef QSTAG
#define QSTAG 0
#endif
struct QuarterOrder {
    int G, c, ntf; bool quarter;
    __device__ void init(int G_, int c_, int K) { G = G_; c = (G_ % 8 == 0) ? (c_ % 8) * (G_ / 8) + c_ / 8 : c_; ntf = K / 64; quarter = (G_ == 256); }
    __device__ bool next(int i, Unit& u) const {
        if (quarter) { if (i > 1) return false;
            const bool full = QSTAG ? ((i == 0) != (((c >> 2) & 1) != 0)) : (i == 0);
            if (full) { u.pm = c >> 2; u.pn = c & 3; u.k0 = 0; u.nt = ntf; return true; }
            const int t = 256 + (c >> 2); u.pm = t >> 2; u.pn = t & 3; u.k0 = (c & 3) * (ntf >> 2); u.nt = ntf >> 2; return true; }
        const long L = (long)i * G + c; if (L >= 320) return false;
        u.pm = (int)(L >> 2); u.pn = (int)(L & 3); u.k0 = 0; u.nt = ntf; return true;
    }
    __device__ __forceinline__ void a_ready(const Unit&) const {}
    __device__ __forceinline__ void done(const Unit&) const {}
};
template <class Epi, class Sched>
__device__ __forceinline__ void gemm_simple(const Ctx& c, const bf16_t* A, const bf16_t* Bt, int K, const Sched& S, const Epi& E) {
    const int tid = c.tid, wid = c.wave, lane = tid & 63, wr = wid >> 2, wc = wid & 3, fr = lane & 15, fq = lane >> 4;
    Unit u; bool clear = true;
    f32x4 acc[2][2][4][2];
    for (int ui = 0; S.next(ui, u); ++ui) {
        if (clear) {
#pragma unroll
        for (int a = 0; a < 2; ++a)
#pragma unroll
            for (int b = 0; b < 2; ++b)
#pragma unroll
                for (int m = 0; m < 4; ++m)
#pragma unroll
                    for (int n = 0; n < 2; ++n) acc[a][b][m][n] = (f32x4){0.f, 0.f, 0.f, 0.f};
        }
        if constexpr (Epi::CHAIN) clear = !E.keep(u);
        const bf16_t* Ar = A + (size_t)(u.pm * 256 + wr * 64 + fr) * K + fq * 8;
        const bf16_t* Br[2];
#pragma unroll
        for (int n = 0; n < 2; ++n) Br[n] = Bt + (size_t)(u.pn * 256 + wc * 32 + (Epi::PERM ? perm32(16 * n + fr) : 16 * n + fr)) * K + fq * 8;
#pragma unroll 1
        for (int k0 = u.k0 * 64; k0 < (u.k0 + u.nt) * 64; k0 += 32) {
            bf16x8 tf[2][4], wf[2][2];
#pragma unroll
            for (int ai = 0; ai < 2; ++ai)
#pragma unroll
                for (int m = 0; m < 4; ++m) tf[ai][m] = *(const bf16x8*)(Ar + (size_t)(ai * 128 + m * 16) * K + k0);
#pragma unroll
            for (int bj = 0; bj < 2; ++bj)
#pragma unroll
                for (int n = 0; n < 2; ++n) wf[bj][n] = *(const bf16x8*)(Br[n] + (size_t)(bj * 128) * K + k0);
#pragma unroll
            for (int ai = 0; ai < 2; ++ai)
#pragma unroll
                for (int bj = 0; bj < 2; ++bj)
#pragma unroll
                    for (int m = 0; m < 4; ++m)
#pragma unroll
                        for (int n = 0; n < 2; ++n) acc[ai][bj][m][n] = __builtin_amdgcn_mfma_f32_16x16x32_bf16(wf[bj][n], tf[ai][m], acc[ai][bj][m][n], 0, 0, 0);
        }
        E(acc, u, wr, wc, fr, fq);
    }
}

namespace pg8 {
#define PG8_LAS __attribute__((address_space(3)))
constexpr int BM = 256, BK = 64, HALF = 128, HTB = HALF * BK * 2  , STAGE_BYTES = 8 * HTB, NXCD = 8, WGM = 8;

__host__ __device__ __forceinline__ int lds_byte(int r, int c) { const int st = (r >> 4) * 2 + (c >> 5), rr = r & 15, cc = c & 31, ob = rr * 64 + cc * 2; return st * 1024 + (ob ^ (((ob >> 9) & 1) << 5)); }
__host__ __device__ __forceinline__ void stage_rc(int b, int& R, int& C) { const int st = b / 1024, sb = b % 1024, swz = sb ^ (((sb >> 9) & 1) << 5); R = (st >> 1) * 16 + swz / 64; C = (st & 1) * 32 + (swz % 64) / 2; }
struct Gemm { const bf16_t* A; const bf16_t* Bt; int M, N, K; unsigned long long* ts; };
#define PG8_STAMP(k) do { if (g.ts && blockIdx.x == 0 && tid == 0) g.ts[k] = __builtin_amdgcn_s_memrealtime(); } while (0)
template <class Epi, class Sched, bool ALIGN_EPI = false, bool SP2 = false>
__device__ __forceinline__ void gemm_phase(int tid_in, PG8_LAS unsigned char* lds, const Gemm g, const Sched& S, const Epi& E) {
    const int tid = tid_in, wid = __builtin_amdgcn_readfirstlane(tid >> 6), lane = tid & 63, wr = wid >> 2, wc = wid & 3, fr = lane & 15, fq = lane >> 4;
    const int K = g.K;
    unsigned voffA[2], voffB[2];
#pragma unroll
    for (int i = 0; i < 2; ++i) { int R, C; stage_rc(tid * 16 + i * 8192, R, C); const int Rb = Epi::PERM ? ((R & ~31) + perm32(R & 31)) : R;
        voffA[i] = (unsigned)(R * K + C) * 2u; voffB[i] = (unsigned)(Rb * K + C) * 2u; }
    const size_t kstep = (size_t)(BK * 2);
    const size_t hstep = (size_t)HALF * K * 2;
    const size_t tstep = 2 * hstep;
    const unsigned ldsw = (unsigned)wid * 1024u;
    const int aoff = lds_byte(wr * 64 + fr, fq * 8), boff = lds_byte(wc * 32 + fr, fq * 8);
#define PG8_SA(b, h) (((b) * 2 + (h)) * HTB)
#define PG8_SB(b, h) ((4 + (b) * 2 + (h)) * HTB)
#define PG8_STAGE(bufoff, gbase, voff) do { _Pragma("unroll") for (int _i = 0; _i < 2; ++_i) \
        __builtin_amdgcn_global_load_lds((const unsigned*)((const char*)(gbase) + (voff)[_i]), (PG8_LAS unsigned*)(lds + (bufoff) + ldsw + _i * 8192), 16, 0, 0); } while (0)
#define PG8_LDA(dst, b, h) do { _Pragma("unroll") for (int m = 0; m < 4; ++m) _Pragma("unroll") for (int k = 0; k < 2; ++k) dst[m][k] = *(const PG8_LAS bf16x8*)(lds + PG8_SA(b, h) + aoff + m * 2048 + k * 1024); } while (0)
#define PG8_LDB(dst, b, h) do { _Pragma("unroll") for (int n = 0; n < 2; ++n) _Pragma("unroll") for (int k = 0; k < 2; ++k) dst[n][k] = *(const PG8_LAS bf16x8*)(lds + PG8_SB(b, h) + boff + n * 2048 + k * 1024); } while (0)
#define PG8_MMA(ai, bj, At, Bt) do { __builtin_amdgcn_s_setprio(1); _Pragma("unroll") for (int m = 0; m < 4; ++m) _Pragma("unroll") for (int n = 0; n < 2; ++n) _Pragma("unroll") for (int k = 0; k < 2; ++k) \
        acc[ai][bj][m][n] = __builtin_amdgcn_mfma_f32_16x16x32_bf16(Bt[n][k], At[m][k], acc[ai][bj][m][n], 0, 0, 0); __builtin_amdgcn_s_setprio(0); } while (0)
#define PG8_WAIT_V(n) asm volatile("s_waitcnt vmcnt(" #n ")" ::: "memory")
#define PG8_WAIT_L(n) asm volatile("s_waitcnt lgkmcnt(" #n ")" ::: "memory")
#define PG8_BAR __builtin_amdgcn_s_barrier()
#define PG8_SCHED __builtin_amdgcn_sched_barrier(0)
    Unit cur, nxt; int ui = 0;
    PG8_STAMP(42);
    if (!S.next(0, cur)) return;
    f32x4 acc[2][2][4][2];
#pragma unroll
    for (int a = 0; a < 2; ++a)
#pragma unroll
        for (int b = 0; b < 2; ++b)
#pragma unroll
            for (int m = 0; m < 4; ++m)
#pragma unroll
                for (int n = 0; n < 2; ++n) acc[a][b][m][n] = (f32x4){0.f, 0.f, 0.f, 0.f};
    bf16x8 At[4][2], B0[2][2], B1[2][2];
    const char* cA = (const char*)g.A + (size_t)cur.pm * tstep + (size_t)cur.k0 * kstep; const char* cB = (const char*)g.Bt + (size_t)cur.pn * tstep + (size_t)cur.k0 * kstep;
    S.a_ready(cur);
    if constexpr (SP2) {
        PG8_STAGE(PG8_SB(0, 0), cB, voffB); PG8_STAGE(PG8_SB(0, 1), cB + hstep, voffB); PG8_STAGE(PG8_SA(0, 0), cA, voffA); PG8_STAGE(PG8_SA(0, 1), cA + hstep, voffA);
        if (wr == 1) PG8_BAR;
        PG8_WAIT_V(2); PG8_BAR;
        PG8_STAGE(PG8_SB(1, 0), cB + kstep, voffB); PG8_STAGE(PG8_SA(1, 0), cA + kstep, voffA); PG8_STAGE(PG8_SB(1, 1), cB + hstep + kstep, voffB);
        PG8_WAIT_V(6); PG8_BAR;
    } else {
        PG8_STAGE(PG8_SB(0, 0), cB, voffB); PG8_STAGE(PG8_SA(0, 0), cA, voffA); PG8_STAGE(PG8_SB(0, 1), cB + hstep, voffB); PG8_STAGE(PG8_SA(0, 1), cA + hstep, voffA);
        if (wr == 1) PG8_BAR;
        PG8_WAIT_V(4); PG8_BAR;
        PG8_STAGE(PG8_SB(1, 0), cB + kstep, voffB); PG8_STAGE(PG8_SA(1, 0), cA + kstep, voffA); PG8_STAGE(PG8_SB(1, 1), cB + hstep + kstep, voffB);
        PG8_WAIT_V(6); PG8_BAR;
    }
    PG8_STAMP(43);
    for (;;) {
        const bool has_next = S.next(ui + 1, nxt);
        const char* nA = has_next ? (const char*)g.A + (size_t)nxt.pm * tstep + (size_t)nxt.k0 * kstep : cA; const char* nB = has_next ? (const char*)g.Bt + (size_t)nxt.pn * tstep + (size_t)nxt.k0 * kstep : cB;
        const int nt = cur.nt;
        for (int t = 0; t < nt; t += 2) {
            const bool last = (t == nt - 2);
            const char* a1 = cA + (size_t)(t + 1) * kstep;
            const char* a2 = last ? nA : cA + (size_t)(t + 2) * kstep; const char* b2 = last ? nB : cB + (size_t)(t + 2) * kstep;
            const char* a3 = a2 + kstep; const char* b3 = b2 + kstep;
            if (last && has_next) S.a_ready(nxt);
            if constexpr (SP2) {
            PG8_LDB(B0, 0, 0); PG8_LDB(B1, 0, 1); PG8_SCHED; PG8_LDA(At, 0, 0); PG8_STAGE(PG8_SA(1, 1), a1 + hstep, voffA);
            PG8_WAIT_V(8); PG8_WAIT_L(0); PG8_BAR; PG8_MMA(0, 0, At, B0); PG8_MMA(0, 1, At, B1); PG8_BAR; PG8_SCHED;
            PG8_LDA(At, 0, 1); PG8_STAGE(PG8_SB(0, 0), b2, voffB); PG8_STAGE(PG8_SB(0, 1), b2 + hstep, voffB); PG8_STAGE(PG8_SA(0, 0), a2, voffA);
            PG8_WAIT_V(8); PG8_WAIT_L(0); PG8_BAR; PG8_MMA(1, 0, At, B0); PG8_MMA(1, 1, At, B1); PG8_BAR; PG8_SCHED;
            PG8_LDB(B0, 1, 0); PG8_LDB(B1, 1, 1); PG8_SCHED; PG8_LDA(At, 1, 0); PG8_STAGE(PG8_SA(0, 1), a2 + hstep, voffA);
            PG8_WAIT_V(8); PG8_WAIT_L(0); PG8_BAR; PG8_MMA(0, 0, At, B0); PG8_MMA(0, 1, At, B1); PG8_BAR; PG8_SCHED;
            PG8_LDA(At, 1, 1); PG8_STAGE(PG8_SB(1, 0), b3, voffB); PG8_STAGE(PG8_SB(1, 1), b3 + hstep, voffB); PG8_STAGE(PG8_SA(1, 0), a3, voffA);
            PG8_WAIT_V(8); PG8_WAIT_L(0); PG8_BAR; PG8_MMA(1, 0, At, B0); PG8_MMA(1, 1, At, B1); PG8_BAR; PG8_SCHED;
            } else {
            PG8_LDB(B0, 0, 0); PG8_SCHED; PG8_LDA(At, 0, 0); PG8_STAGE(PG8_SA(1, 1), a1 + hstep, voffA);
            PG8_WAIT_L(8); PG8_BAR; PG8_WAIT_L(0); PG8_MMA(0, 0, At, B0); PG8_BAR; PG8_SCHED;
            PG8_LDB(B1, 0, 1); PG8_STAGE(PG8_SB(0, 0), b2, voffB);
            PG8_BAR; PG8_WAIT_L(0); PG8_MMA(0, 1, At, B1); PG8_BAR;
            PG8_LDA(At, 0, 1); PG8_STAGE(PG8_SA(0, 0), a2, voffA);
            PG8_BAR; PG8_WAIT_L(0); PG8_MMA(1, 0, At, B0); PG8_BAR; PG8_SCHED;
            PG8_STAGE(PG8_SB(0, 1), b2 + hstep, voffB);
            PG8_WAIT_V(6); PG8_BAR; PG8_MMA(1, 1, At, B1); PG8_BAR;
            PG8_LDB(B0, 1, 0); PG8_SCHED; PG8_LDA(At, 1, 0); PG8_STAGE(PG8_SA(0, 1), a2 + hstep, voffA);
            PG8_WAIT_L(8); PG8_BAR; PG8_WAIT_L(0); PG8_MMA(0, 0, At, B0); PG8_BAR; PG8_SCHED;
            PG8_LDB(B1, 1, 1); PG8_STAGE(PG8_SB(1, 0), b3, voffB);
            PG8_BAR; PG8_WAIT_L(0); PG8_MMA(0, 1, At, B1); PG8_BAR;
            PG8_LDA(At, 1, 1); PG8_STAGE(PG8_SA(1, 0), a3, voffA);
            PG8_BAR; PG8_WAIT_L(0); PG8_MMA(1, 0, At, B0); PG8_BAR; PG8_SCHED;
            PG8_STAGE(PG8_SB(1, 1), b3 + hstep, voffB);
            PG8_WAIT_V(6); PG8_BAR; PG8_MMA(1, 1, At, B1); PG8_BAR;
            }
        }
        if (ui == 0) PG8_STAMP(44);
        if constexpr (ALIGN_EPI) { if (wr == 0) PG8_BAR; }
        if constexpr (!Epi::AFTER_DRAIN) { E(acc, cur, wr, wc, fr, fq); S.done(cur); }
        if (ui == 0) PG8_STAMP(45);
        if (!has_next) break;
        bool clear = true; if constexpr (Epi::CHAIN) clear = !E.keep(cur);
        if (clear) {
#pragma unroll
        for (int a = 0; a < 2; ++a)
#pragma unroll
            for (int b = 0; b < 2; ++b)
#pragma unroll
                for (int m = 0; m < 4; ++m)
#pragma unroll
                    for (int n = 0; n < 2; ++n) acc[a][b][m][n] = (f32x4){0.f, 0.f, 0.f, 0.f};
        }
        cur = nxt; cA = nA; cB = nB; ++ui;
        if constexpr (ALIGN_EPI) { if (wr == 1) PG8_BAR; }
    }
    PG8_STAMP(46);
    PG8_WAIT_V(0);
    if constexpr (!ALIGN_EPI) { if (wr == 0) PG8_BAR; }
    PG8_BAR;
    if constexpr (Epi::AFTER_DRAIN) { E.fused(acc, cur, wr, wc, fr, fq, lds, wid, lane); S.done(cur); }
#undef PG8_SA
#undef PG8_SB
#undef PG8_STAGE
#undef PG8_LDA
#undef PG8_LDB
#undef PG8_MMA
#undef PG8_WAIT_V
#undef PG8_WAIT_L
#undef PG8_BAR
#undef PG8_SCHED
}
}

__device__ __forceinline__ u32x4 pack8(const f32x4& a, const f32x4& b) { u32x4 w; w.x = pk2(a.x, a.y); w.y = pk2(a.z, a.w); w.z = pk2(b.x, b.y); w.w = pk2(b.z, b.w); return w; }
__device__ __forceinline__ void rope4(f32x4& v, const f32x2 cs0, const f32x2 cs1) {
    const float a0 = v.x * cs0.x - v.y * cs0.y, a1 = v.x * cs0.y + v.y * cs0.x, a2 = v.z * cs1.x - v.w * cs1.y, a3 = v.z * cs1.y + v.w * cs1.x;
    v.x = a0; v.y = a1; v.z = a2; v.w = a3;
}
struct EpiMix {
    static constexpr bool PERM = true, AFTER_DRAIN = false, CHAIN = false;
    const Params* pp; int l;
    __device__ __forceinline__ void operator()(const f32x4 (&acc)[2][2][4][2], const Unit& u, int wr, int wc, int fr, int fq) const {
        const Params& p = *pp;
        const int pn = u.pn, R0 = u.pm * 256; const bool smp = R0 >= MP;
        const int b = smp ? (R0 - MP) >> 11 : R0 >> 8, t0 = smp ? (R0 - MP) & 2047 : 0;
        const f32x2* cs_row = (const f32x2*)(p.ws + WS_ROPE); const f32x2* cs_col = cs_row + 32 * 16;
        if (pn >= 11) {
            bf16_t* dst = (bf16_t*)(p.ws + (pn < 13 ? Z_CU : Z_CV)) + ((pn - 11) & 1) * 256 + wc * 32 + 8 * fq;
#pragma unroll
            for (int ai = 0; ai < 2; ++ai)
#pragma unroll
                for (int m = 0; m < 4; ++m) { const int R = R0 + ai * 128 + wr * 64 + m * 16 + fr;
#pragma unroll
                    for (int bj = 0; bj < 2; ++bj) { f32x4 v0 = acc[ai][bj][m][0], v1 = acc[ai][bj][m][1];
#pragma unroll
                        for (int r = 0; r < 4; ++r) { v0[r] = gelu_tanh(v0[r]); v1[r] = gelu_tanh(v1[r]); }
                        *(u32x4*)(dst + (size_t)R * RW + bj * 128) = pack8(v0, v1); } }
            return;
        }
        const int kind = pn >> 1;
        const bool is_k = (pn == 10 && wc < 2), is_v = (pn == 10 && wc >= 2);
        const float* gqk = (kind == 4 ? p.in[I_GQ] : p.in[I_GK]) + l * HD + 8 * fq;
        const int head = (pn & 1) * 4 + wc;
        const bool norm = (kind == 4 || is_k), rope = smp && (kind == 0 || kind == 1 || kind == 4 || is_k);
        const float post = kind == 1 ? 0.125f : (kind == 4 ? C2 : 1.0f);
#pragma unroll
        for (int ai = 0; ai < 2; ++ai)
#pragma unroll
            for (int m = 0; m < 4; ++m) {
                const int rr = ai * 128 + wr * 64 + m * 16 + fr, R = R0 + rr, t = t0 + rr;
                float rs = 1.0f;
                if (norm) {
                    float ss = 0.f;
#pragma unroll
                    for (int bj = 0; bj < 2; ++bj)
#pragma unroll
                        for (int n = 0; n < 2; ++n) { const f32x4 x = acc[ai][bj][m][n]; ss += (x.x * x.x + x.y * x.y) + (x.z * x.z + x.w * x.w); }
                    ss += __shfl_xor(ss, 16); ss += __shfl_xor(ss, 32);
                    rs = rsqrtf(ss * (1.f / HD) + EPS);
                }
                bf16_t* dst;
                if (kind < 5) dst = (bf16_t*)(p.ws + (kind == 0 ? Z_RQ : kind == 1 ? Z_RK : kind == 2 ? Z_RV : kind == 3 ? Z_RG : Z_AQ)) + (size_t)R * RW + head * HD + 8 * fq;
                else { const int hk = wc & 1;
                    if (smp) dst = (bf16_t*)(p.ws + (is_k ? Z_KS : Z_VS)) + ((size_t)b * SKV_S + PAST + t) * KVW + hk * HD + 8 * fq;
                    else dst = (bf16_t*)(p.ws + (is_k ? Z_KP : Z_VP)) + ((size_t)b * SEQ_P + t) * KVW + hk * HD + 8 * fq; }
                float* cdst = p.out + (is_k ? OUT_CK : OUT_CV) + ((size_t)((b * 2 + l) * SEQ_P + t) * 2 + (wc & 1)) * HD + 8 * fq;
#pragma unroll
                for (int bj = 0; bj < 2; ++bj) {
                    f32x4 v0 = acc[ai][bj][m][0], v1 = acc[ai][bj][m][1];
                    if (norm) { const f32x4 g0 = *(const f32x4*)(gqk + 32 * bj), g1 = *(const f32x4*)(gqk + 32 * bj + 4); v0 = v0 * rs * g0; v1 = v1 * rs * g1; }
                    if (pn == 10 && !smp) { *(f32x4*)(cdst + 32 * bj) = v0; *(f32x4*)(cdst + 32 * bj + 4) = v1; }
                    if (kind == 3) {
#pragma unroll
                        for (int r = 0; r < 4; ++r) { v0[r] = siluf_(v0[r]); v1[r] = siluf_(v1[r]); } }
                    if (rope) {
                        const f32x2* tab = (bj == 0 ? cs_row + (t >> 6) * 16 : cs_col + (t & 63) * 16) + 4 * fq;
                        rope4(v0, tab[0], tab[1]); rope4(v1, tab[2], tab[3]); }
                    v0 = v0 * post; v1 = v1 * post;
                    *(u32x4*)(dst + 32 * bj) = pack8(v0, v1);
                    asm volatile("" ::: "memory");
                }
            }
    }
};
__device__ __forceinline__ size_t gate_off(int x, int pm, int pn, int ai, int m, int bj, int wid, int lane) {
    return ((((size_t)(x * 80 + pm) * 4 + pn) * 16 + (ai * 4 + m) * 2 + bj) * 512 + wid * 64 + lane) * 8; }
struct EpiGate {
    static constexpr bool PERM = true, AFTER_DRAIN = false, CHAIN = false;
    const Params* pp;
    __device__ __forceinline__ void operator()(const f32x4 (&acc)[2][2][4][2], const Unit& u, int wr, int wc, int fr, int fq) const {
        const int x = u.pn >> 2; bf16_t* dst = (bf16_t*)(pp->ws + Z_GATE); const int wid = wr * 4 + wc, lane = fq * 16 + fr;
#pragma unroll
        for (int ai = 0; ai < 2; ++ai)
#pragma unroll
            for (int m = 0; m < 4; ++m) {
#pragma unroll
                for (int bj = 0; bj < 2; ++bj) { f32x4 v0 = acc[ai][bj][m][0], v1 = acc[ai][bj][m][1];
#pragma unroll
                    for (int r = 0; r < 4; ++r) { v0[r] = sigmoidf_(fminf(fmaxf(v0[r], -30.f), 30.f)); v1[r] = sigmoidf_(fminf(fmaxf(v1[r], -30.f), 30.f)); }
                    *(u32x4*)(dst + gate_off(x, u.pm, u.pn & 3, ai, m, bj, wid, lane)) = pack8(v0, v1); } }
    }
};
struct EpiMerge {
    static constexpr bool PERM = true, AFTER_DRAIN = false, CHAIN = true;
    const Params* pp;
    __device__ __forceinline__ bool keep(const Unit& u) const { return (u.pn >> 2) != 2; }
    __device__ __forceinline__ void operator()(f32x4 (&acc)[2][2][4][2], const Unit& u, int wr, int wc, int fr, int fq) const {
        const int x = u.pn >> 2, pm = u.pm - 80 * x;
        const int col0 = (u.pn & 3) * 256 + wc * 32 + 8 * fq;
        const int gnum = x == 0 ? 1 : x == 1 ? 2 : 0, gden = x == 0 ? 2 : 0;
        const bf16_t* gbase = (const bf16_t*)(pp->ws + Z_GATE); const int wid = wr * 4 + wc, lane = fq * 16 + fr, pnc = u.pn & 3;
        bf16_t* dst = (bf16_t*)(pp->ws + WS_XN) + col0;
#pragma unroll
        for (int aim = 0; aim < 4; ++aim) { const int ai = aim >> 1, m0 = (aim & 1) * 2;
            u32x4 gnv[4][2], gdv[4][2];
#pragma unroll
            for (int m = m0; m < m0 + 2; ++m) { const int R = pm * 256 + ai * 128 + wr * 64 + m * 16 + fr;
#pragma unroll
                for (int bj = 0; bj < 2; ++bj) { gnv[m][bj] = *(const u32x4*)(gbase + gate_off(gnum, pm, pnc, ai, m, bj, wid, lane)); if (x != 2) gdv[m][bj] = *(const u32x4*)(gbase + gate_off(gden, pm, pnc, ai, m, bj, wid, lane)); } }
#pragma unroll
            for (int m = m0; m < m0 + 2; ++m) { const int R = pm * 256 + ai * 128 + wr * 64 + m * 16 + fr;
#pragma unroll
                for (int bj = 0; bj < 2; ++bj) {
                    const u32x4 g = gnv[m][bj];
                    f32x4 s0 = (f32x4){bflo(g.x), bfhi(g.x), bflo(g.y), bfhi(g.y)}, s1 = (f32x4){bflo(g.z), bfhi(g.z), bflo(g.w), bfhi(g.w)};
                    if (x != 2) { const u32x4 d = gdv[m][bj];
                        s0.x *= __builtin_amdgcn_rcpf(bflo(d.x)); s0.y *= __builtin_amdgcn_rcpf(bfhi(d.x)); s0.z *= __builtin_amdgcn_rcpf(bflo(d.y)); s0.w *= __builtin_amdgcn_rcpf(bfhi(d.y));
                        s1.x *= __builtin_amdgcn_rcpf(bflo(d.z)); s1.y *= __builtin_amdgcn_rcpf(bfhi(d.z)); s1.z *= __builtin_amdgcn_rcpf(bflo(d.w)); s1.w *= __builtin_amdgcn_rcpf(bfhi(d.w)); }
                    acc[ai][bj][m][0] = acc[ai][bj][m][0] * s0; acc[ai][bj][m][1] = acc[ai][bj][m][1] * s1;
                    if (x == 2) *(u32x4*)(dst + (size_t)R * DM + bj * 128) = pack8(acc[ai][bj][m][0], acc[ai][bj][m][1]); } }
            asm volatile("" ::: "memory");
        }
    }
};
struct EpiRes {
    static constexpr bool PERM = false, AFTER_DRAIN = false, CHAIN = false;
    const Params* pp; int l, part; bool from_inputs; int ntf; bf16_t* slab;
    __device__ __forceinline__ void operator()(const f32x4 (&acc)[2][2][4][2], const Unit& u, int wr, int wc, int fr, int fq) const {
        const Params& p = *pp; const int R0 = u.pm * 256; const int ci = row_ci(R0);
        if (u.nt != ntf) {
            bf16_t* s = slab + ((size_t)((u.pm * 4 + u.pn - 256) * 4 + u.k0 / u.nt) * 256) * 256 + wc * 32 + 4 * fq;
#pragma unroll
            for (int ai = 0; ai < 2; ++ai)
#pragma unroll
                for (int m = 0; m < 4; ++m) { const int rr = ai * 128 + wr * 64 + m * 16 + fr;
#pragma unroll
                    for (int bj = 0; bj < 2; ++bj)
#pragma unroll
                        for (int n = 0; n < 2; ++n) { const f32x4 v = acc[ai][bj][m][n]; u32x2 w; w.x = pk2(v.x, v.y); w.y = pk2(v.z, v.w); *(u32x2*)(s + (size_t)rr * 256 + bj * 128 + n * 16) = w; } }
            return;
        }
        const float* gv = mod_ptr(p, l, ci, part) + u.pn * 256 + wc * 32 + 4 * fq;
        f32x4 g[2][2];
#pragma unroll
        for (int bj = 0; bj < 2; ++bj)
#pragma unroll
            for (int n = 0; n < 2; ++n) g[bj][n] = *(const f32x4*)(gv + bj * 128 + n * 16);
#pragma unroll
        for (int aim = 0; aim < 4; ++aim) { const int ai = aim >> 1, m0 = (aim & 1) * 2;
            f32x4 xv[4][2][2];
#pragma unroll
            for (int m = m0; m < m0 + 2; ++m) { const int R = R0 + ai * 128 + wr * 64 + m * 16 + fr;
                const float* xs = (from_inputs ? x_row(p, 0, R) : p.out + (size_t)R * DM) + u.pn * 256 + wc * 32 + 4 * fq;
#pragma unroll
                for (int bj = 0; bj < 2; ++bj)
#pragma unroll
                    for (int n = 0; n < 2; ++n) xv[m][bj][n] = *(const f32x4*)(xs + bj * 128 + n * 16); }
#pragma unroll
            for (int m = m0; m < m0 + 2; ++m) { const int R = R0 + ai * 128 + wr * 64 + m * 16 + fr;
                float* xo = p.out + (size_t)R * DM + u.pn * 256 + wc * 32 + 4 * fq;
#pragma unroll
                for (int bj = 0; bj < 2; ++bj)
#pragma unroll
                    for (int n = 0; n < 2; ++n) *(f32x4*)(xo + bj * 128 + n * 16) = xv[m][bj][n] + g[bj][n] * acc[ai][bj][m][n]; }
            asm volatile("" ::: "memory");
        }
    }
};
struct EpiFF1 {
    static constexpr bool PERM = true, AFTER_DRAIN = false, CHAIN = false;
    const Params* pp;
    __device__ __forceinline__ void operator()(const f32x4 (&acc)[2][2][4][2], const Unit& u, int wr, int wc, int fr, int fq) const {
        bf16_t* dst = (bf16_t*)(pp->ws + Z_HB) + u.pn * 256 + wc * 32 + 8 * fq;
#pragma unroll
        for (int ai = 0; ai < 2; ++ai)
#pragma unroll
            for (int m = 0; m < 4; ++m) { const int R = u.pm * 256 + ai * 128 + wr * 64 + m * 16 + fr;
#pragma unroll
                for (int bj = 0; bj < 2; ++bj) { f32x4 v0 = acc[ai][bj][m][0], v1 = acc[ai][bj][m][1];
#pragma unroll
                    for (int r = 0; r < 4; ++r) { const float a = fmaxf(v0[r], 0.f), b = fmaxf(v1[r], 0.f); v0[r] = a * a; v1[r] = b * b; }
                    *(u32x4*)(dst + (size_t)R * DFF + bj * 128) = pack8(v0, v1); } }
    }
};

namespace attn_body {
using bf16=__hip_bfloat16;
using bf16x8=__attribute__((ext_vector_type(8)))short;
using s16x4=__attribute__((ext_vector_type(4)))short;
using f32x16=__attribute__((ext_vector_type(16)))float;
using u32x4=__attribute__((ext_vector_type(4)))unsigned;
constexpr int D=64,QP=512,KP=128;
constexpr int NW=8,QBLK=32,QB=QBLK*NW,KVBLK=64;
__device__ __forceinline__ int crow(int r,int hi){return (r&3)+8*(r>>2)+4*hi;}
#define SBAR() __builtin_amdgcn_sched_barrier(0)
constexpr int NSLOT=3, SLOTB=8192;
constexpr int LDS_K=0, LDS_V=NSLOT*SLOTB, LDS_WS=2*NSLOT*SLOTB, LDS_OST=LDS_WS+NW*64*4, LDS_BYTES=LDS_OST+NW*4096;
constexpr float C2=0.125f*1.4426950408889634f;
__device__ __forceinline__ void glds16(const void*gsrc,unsigned lds_dst){unsigned keep;
  asm volatile("s_mov_b32 %0, m0\n\ts_mov_b32 m0, %2\n\ts_nop 0\n\tglobal_load_lds_dwordx4 %1, off\n\ts_mov_b32 m0, %0":"=&s"(keep):"v"(gsrc),"s"(lds_dst):"memory");}
__device__ __forceinline__ float max3f(float a,float b,float c){float r;asm("v_max3_f32 %0, %1, %2, %3":"=v"(r):"v"(a),"v"(b),"v"(c));return r;}
__device__ __forceinline__ float max2f(float a,float b){float r;asm("v_max_f32_e32 %0, %1, %2":"=v"(r):"v"(a),"v"(b));return r;}
__device__ __forceinline__ float fadd_s(float a,float b){float r;asm("v_add_f32_e32 %0, %1, %2":"=v"(r):"v"(a),"v"(b));return r;}
__device__ __forceinline__ float fsub_s(float a,float b){float r;asm("v_sub_f32_e32 %0, %1, %2":"=v"(r):"v"(a),"v"(b));return r;}
typedef float f32x2_t __attribute__((ext_vector_type(2))); typedef __bf16 bf16x2_t __attribute__((ext_vector_type(2)));
__device__ __forceinline__ unsigned cvtpk_s(float lo,float hi){f32x2_t v={lo,hi};bf16x2_t b=__builtin_convertvector(v,bf16x2_t);return __builtin_bit_cast(unsigned,b);}
#define WAIT_BAR(N) asm volatile("s_waitcnt vmcnt(" #N ") lgkmcnt(0)\n\ts_barrier":::"memory")

__device__ __forceinline__ void qkt(f32x16&p0,f32x16&p1,const char*Kslot,const bf16x8*qr,const f32x16&negm,int r32,int hi){
  const char*kb=Kslot+hi*1024+r32*16;
  #pragma unroll
  for(int d0=0;d0<4;++d0){
    const bf16x8 b0=*reinterpret_cast<const bf16x8*>(kb+d0*2048);
    const bf16x8 b1=*reinterpret_cast<const bf16x8*>(kb+d0*2048+512);
    if(d0==0){p0=__builtin_amdgcn_mfma_f32_32x32x16_bf16(b0,qr[0],negm,0,0,0);p1=__builtin_amdgcn_mfma_f32_32x32x16_bf16(b1,qr[0],negm,0,0,0);}
    else{p0=__builtin_amdgcn_mfma_f32_32x32x16_bf16(b0,qr[d0],p0,0,0,0);p1=__builtin_amdgcn_mfma_f32_32x32x16_bf16(b1,qr[d0],p1,0,0,0);}}
}
typedef __attribute__((address_space(3))) const char* lds_cptr;
typedef short v4i16_t __attribute__((ext_vector_type(4)));
__device__ __forceinline__ void kload8(bf16x8*kf,lds_cptr kp){
  kf[0]=*(const __attribute__((address_space(3))) bf16x8*)(kp);      kf[1]=*(const __attribute__((address_space(3))) bf16x8*)(kp+512);
  kf[2]=*(const __attribute__((address_space(3))) bf16x8*)(kp+2048); kf[3]=*(const __attribute__((address_space(3))) bf16x8*)(kp+2560);
  kf[4]=*(const __attribute__((address_space(3))) bf16x8*)(kp+4096); kf[5]=*(const __attribute__((address_space(3))) bf16x8*)(kp+4608);
  kf[6]=*(const __attribute__((address_space(3))) bf16x8*)(kp+6144); kf[7]=*(const __attribute__((address_space(3))) bf16x8*)(kp+6656);
}
__device__ __forceinline__ void kload2(bf16x8*kf,lds_cptr kp,int j){ kf[2*j]=*(const __attribute__((address_space(3))) bf16x8*)(kp+j*2048); kf[2*j+1]=*(const __attribute__((address_space(3))) bf16x8*)(kp+j*2048+512); }
__device__ __forceinline__ s16x4 vtr(lds_cptr p){ return __builtin_bit_cast(s16x4,__builtin_amdgcn_ds_read_tr16_b64_v4i16((__attribute__((address_space(3))) v4i16_t*)p)); }
__device__ __forceinline__ float rowmax(const f32x16&p0,const f32x16&p1){
  float a=max3f(p0[0],p0[1],p1[0]),b=max3f(p0[2],p0[3],p1[1]);a=max3f(a,p1[2],p1[3]);
  #pragma unroll
  for(int r=4;r<16;r+=4){a=max3f(a,p0[r],p0[r+1]);b=max3f(b,p0[r+2],p0[r+3]);a=max3f(a,p1[r],p1[r+1]);b=max3f(b,p1[r+2],p1[r+3]);}
  const float m=max2f(a,b);
  auto rr=__builtin_amdgcn_permlane32_swap(__float_as_uint(m),__float_as_uint(m),false,false);
  return max2f(__uint_as_float(rr[0]),__uint_as_float(rr[1]));
}
__device__ __forceinline__ void pv(f32x16*o,int vb,bf16x8 pa0,bf16x8 pa1,bf16x8 pa2,bf16x8 pa3){
  #pragma unroll
  for(int d0=0;d0<2;++d0){s16x4 lo[4],hi[4];
    #pragma unroll
    for(int ks=0;ks<4;++ks){
      asm volatile("ds_read_b64_tr_b16 %0,%1 offset:%c2":"=&v"(lo[ks]):"v"(vb),"i"(d0*4096+ks*1024):"memory");
      asm volatile("ds_read_b64_tr_b16 %0,%1 offset:%c2":"=&v"(hi[ks]):"v"(vb),"i"(d0*4096+ks*1024+512):"memory");}
    asm volatile("s_waitcnt lgkmcnt(0)":::"memory");SBAR();
    #define PK(k) (bf16x8){lo[k][0],lo[k][1],lo[k][2],lo[k][3],hi[k][0],hi[k][1],hi[k][2],hi[k][3]}
    o[d0]=__builtin_amdgcn_mfma_f32_32x32x16_bf16(pa0,PK(0),o[d0],0,0,0);
    o[d0]=__builtin_amdgcn_mfma_f32_32x32x16_bf16(pa1,PK(1),o[d0],0,0,0);
    o[d0]=__builtin_amdgcn_mfma_f32_32x32x16_bf16(pa2,PK(2),o[d0],0,0,0);
    o[d0]=__builtin_amdgcn_mfma_f32_32x32x16_bf16(pa3,PK(3),o[d0],0,0,0);
    #undef PK
  }
}

#ifndef ATTN_STORE16
#define ATTN_STORE16(p,v) (*(u32x4*)(p)=(v))
#endif
template<int THRL> __device__ __forceinline__ void attn_unit(int tid,const bf16*Qu,const bf16*__restrict__ Kh,const bf16*__restrict__ Vh,bf16*Ou,const int NT,char*shm){
  const int lane=tid&63,r32=lane&31,hi=lane>>5; const int wid=__builtin_amdgcn_readfirstlane(tid>>6);
  const bf16*Qw=Qu+(long)(wid*QBLK)*QP;
  const unsigned lds0=(unsigned)(uintptr_t)shm;
  float*wsf=(float*)(shm+LDS_WS)+wid*64;
  const bf16*ksrc=Kh+(long)lane*KP+wid*8;
  const bf16*vsrc=Vh+(long)(16*(wid&3)+(lane>>2))*KP+(wid>>2)*32+(lane&3)*8;
  const unsigned kdst=lds0+LDS_K+wid*1024, vdst=lds0+LDS_V+wid*1024;
  #define DMA_K(t,slot) glds16(ksrc+(long)(t)*KVBLK*KP,(unsigned)__builtin_amdgcn_readfirstlane(kdst+(slot)))
  #define DMA_V(t,slot) glds16(vsrc+(long)(t)*KVBLK*KP,(unsigned)__builtin_amdgcn_readfirstlane(vdst+(slot)))
  const int vb0=(int)(lds0+LDS_V)+((lane>>4)&1)*32+(lane&3)*8+(4*hi+((lane&15)>>2))*64;
  const char*Kbase=shm+LDS_K; bf16x8 kf[8];
  const lds_cptr shm3=(lds_cptr)shm; const lds_cptr kp0=shm3+LDS_K+hi*1024+r32*16; const lds_cptr vp0=shm3+LDS_V+((lane>>4)&1)*32+(lane&3)*8+(4*hi+((lane&15)>>2))*64;
  DMA_K(0,0);DMA_V(0,0);DMA_K(1,SLOTB);
  bf16x8 qr[4];
  #pragma unroll
  for(int d0=0;d0<4;++d0)qr[d0]=*reinterpret_cast<const bf16x8*>(&Qw[(long)r32*QP+d0*16+hi*8]);
  float zf_=0.f;asm volatile("":"+v"(zf_));
  float mhat=zf_,l_reg=zf_;f32x16 o[2],negm;
  #pragma unroll
  for(int r=0;r<16;++r){o[0][r]=zf_;o[1][r]=zf_;negm[r]=zf_;}
  asm volatile("":"+v"(negm));
  #define CMASK(P0,P1,t) do{}while(0)
  bool resc=false;
  #define START(P0,P1) do{ const float rm=rowmax(P0,P1); resc=false; \
    { const float dl=rm; mhat=fadd_s(mhat,dl); \
      _Pragma("unroll") for(int r=0;r<16;++r){P0[r]=fsub_s(P0[r],dl);P1[r]=fsub_s(P1[r],dl);} \
      _Pragma("unroll") for(int r=0;r<16;++r)negm[r]=-mhat; asm volatile("":"+v"(negm)); } \
    _Pragma("unroll") for(int r=0;r<16;++r)P0[r]=__builtin_amdgcn_exp2f(P0[r]); }while(0)
  #define RESC() do{ if(resc){ asm volatile("s_waitcnt lgkmcnt(0)":::"memory"); \
      _Pragma("unroll") for(int d_=0;d_<2;++d_) _Pragma("unroll") for(int r=0;r<16;++r)o[d_][r]*=wsf[crow(r,hi)]; } }while(0)
  f32x16 pA0,pA1,pB0,pB1;
  int sl_prev=0,sl_cur=0,sl_next=SLOTB;
  #define ROT() do{sl_prev=sl_cur;sl_cur=sl_next;sl_next=(sl_next==(NSLOT-1)*SLOTB)?0:sl_next+SLOTB;}while(0)
  DMA_K(2,2*SLOTB);
  WAIT_BAR(3);
  qkt(pA0,pA1,Kbase,qr,negm,r32,hi);asm volatile("s_nop 15\n\ts_nop 7":"+v"(pA0),"+v"(pA1));CMASK(pA0,pA1,0);
  START(pA0,pA1);
  _Pragma("unroll") for(int r=0;r<16;++r)pA1[r]=__builtin_amdgcn_exp2f(pA1[r]);
  WAIT_BAR(0);
  DMA_K(3,0);DMA_V(1,SLOTB);
  ROT();
  kload8(kf,kp0+sl_cur);
  WAIT_BAR(2);
  s16x4 vlo[8],vhi[8]; u32x4 pw0,pw1,pw2,pw3;
  #define PKW(P,B) cvtpk_s(P[B],P[B+1])
  #define PAF(k) __builtin_bit_cast(bf16x8,pw##k)
  #define VFR(i) (bf16x8){vlo[i][0],vlo[i][1],vlo[i][2],vlo[i][3],vhi[i][0],vhi[i][1],vhi[i][2],vhi[i][3]}
  #define PIN(x) asm volatile("":"+v"(x))
  #define MX3(a,b,c) __builtin_fmaxf(__builtin_fmaxf((a),(b)),(c))
  #define GAPA(MF,A0,A1,A2,A3,W0,W1,PW) do{ MF; sacc+=A0; sacc+=A1; sacc+=A2; sacc+=A3; PIN(sacc); W0; W1; PIN(PW); SBAR(); }while(0)
  #define EX(v) __builtin_amdgcn_exp2f(v)
  #define GAPB(MF,X,B) do{ MF; X[B]=EX(X[B]); X[B+1]=EX(X[B+1]); X[B+2]=EX(X[B+2]); X[B+3]=EX(X[B+3]); PIN(X); SBAR(); }while(0)
  #define VRD(i) do{ vlo[i]=vtr(vp_+(((i)>>2)*4096+((i)&3)*1024)); vhi[i]=vtr(vp_+(((i)>>2)*4096+((i)&3)*1024+512)); }while(0)
  #define KRD(G,j) do{ if(G){ kload2(kf,kp0+sl_next,j); SBAR(); } }while(0)
  #define STEP(C0,C1,P0,P1,t,GK,GV,GL) do{ SBAR(); \
    const lds_cptr vp_=vp0+sl_prev; \
    VRD(0); SBAR(); float sacc=(P0[0]+P0[1]); \
    GAPA(C0=__builtin_amdgcn_mfma_f32_32x32x16_bf16(kf[0],qr[0],negm,0,0,0), P0[2],P0[3],P0[4],P0[5],     pw0[0]=PKW(P0,0), pw0[1]=PKW(P0,2), pw0); \
    VRD(4); SBAR(); GAPA(C1=__builtin_amdgcn_mfma_f32_32x32x16_bf16(kf[1],qr[0],negm,0,0,0), P0[6],P0[7],P0[8],P0[9],     pw0[2]=PKW(P0,4), pw0[3]=PKW(P0,6), pw0); \
    VRD(1); SBAR(); GAPA(C0=__builtin_amdgcn_mfma_f32_32x32x16_bf16(kf[2],qr[1],C0,0,0,0),   P0[10],P0[11],P0[12],P0[13], pw1[0]=PKW(P0,8), pw1[1]=PKW(P0,10), pw1); \
    VRD(5); SBAR(); GAPA(C1=__builtin_amdgcn_mfma_f32_32x32x16_bf16(kf[3],qr[1],C1,0,0,0),   P0[14],P0[15],P1[0],P1[1],   pw1[2]=PKW(P0,12),pw1[3]=PKW(P0,14), pw1); \
    VRD(2); SBAR(); GAPA(C0=__builtin_amdgcn_mfma_f32_32x32x16_bf16(kf[4],qr[2],C0,0,0,0),   P1[2],P1[3],P1[4],P1[5],     pw2[0]=PKW(P1,0), pw2[1]=PKW(P1,2), pw2); \
    VRD(6); SBAR(); GAPA(C1=__builtin_amdgcn_mfma_f32_32x32x16_bf16(kf[5],qr[2],C1,0,0,0),   P1[6],P1[7],P1[8],P1[9],     pw2[2]=PKW(P1,4), pw2[3]=PKW(P1,6), pw2); \
    VRD(3); SBAR(); GAPA(C0=__builtin_amdgcn_mfma_f32_32x32x16_bf16(kf[6],qr[3],C0,0,0,0),   P1[10],P1[11],P1[12],P1[13], pw3[0]=PKW(P1,8), pw3[1]=PKW(P1,10), pw3); \
    VRD(7); SBAR(); GAPA(C1=__builtin_amdgcn_mfma_f32_32x32x16_bf16(kf[7],qr[3],C1,0,0,0),   P1[14],P1[15],0.f,0.f,       pw3[2]=PKW(P1,12),pw3[3]=PKW(P1,14), pw3); \
    l_reg+=sacc; \
    if(GK){DMA_K((t)+3,sl_cur);} if(GV){DMA_V((t)+1,sl_next);} \
    CMASK(C0,C1,t); \
    { float a=MX3(C0[0],C0[1],C1[0]),b=MX3(C0[2],C0[3],C1[1]); a=MX3(a,C1[2],C1[3]); \
      _Pragma("unroll") for(int r=4;r<16;r+=4){a=MX3(a,C0[r],C0[r+1]);b=MX3(b,C0[r+2],C0[r+3]);a=MX3(a,C1[r],C1[r+1]);b=MX3(b,C1[r+2],C1[r+3]);} \
      float rm=__builtin_fmaxf(a,b); { auto rr=__builtin_amdgcn_permlane32_swap(__float_as_uint(rm),__float_as_uint(rm),false,false); rm=__builtin_fmaxf(__uint_as_float(rr[0]),__uint_as_float(rr[1])); } \
      resc=false; \
      if(__builtin_expect(__any(rm>(float)THRL),0)){ const float dl=__builtin_fmaxf(rm,0.f); mhat+=dl; \
        _Pragma("unroll") for(int r=0;r<16;++r){C0[r]-=dl;C1[r]-=dl;} \
        _Pragma("unroll") for(int r=0;r<16;++r)negm[r]=-mhat; asm volatile("":"+v"(negm)); \
        const float f=__builtin_amdgcn_exp2f(-dl); l_reg*=f; if(hi==0)wsf[r32]=f; resc=true; } } \
    SBAR(); \
    GAPB(o[0]=__builtin_amdgcn_mfma_f32_32x32x16_bf16(PAF(0),VFR(0),o[0],0,0,0), C0,0); \
    GAPB(o[1]=__builtin_amdgcn_mfma_f32_32x32x16_bf16(PAF(0),VFR(4),o[1],0,0,0), C0,4); \
    KRD(GL,0); GAPB(o[0]=__builtin_amdgcn_mfma_f32_32x32x16_bf16(PAF(1),VFR(1),o[0],0,0,0), C0,8); \
    KRD(GL,1); GAPB(o[1]=__builtin_amdgcn_mfma_f32_32x32x16_bf16(PAF(1),VFR(5),o[1],0,0,0), C0,12); \
    KRD(GL,2); GAPB(o[0]=__builtin_amdgcn_mfma_f32_32x32x16_bf16(PAF(2),VFR(2),o[0],0,0,0), C1,0); \
    KRD(GL,3); GAPB(o[1]=__builtin_amdgcn_mfma_f32_32x32x16_bf16(PAF(2),VFR(6),o[1],0,0,0), C1,4); \
    GAPB(o[0]=__builtin_amdgcn_mfma_f32_32x32x16_bf16(PAF(3),VFR(3),o[0],0,0,0), C1,8); \
    GAPB(o[1]=__builtin_amdgcn_mfma_f32_32x32x16_bf16(PAF(3),VFR(7),o[1],0,0,0), C1,12); \
    }while(0)
  int t=1;
  for(;t+5<NT;t+=2){
    STEP(pB0,pB1,pA0,pA1,t,true,true,true);     WAIT_BAR(2); RESC(); ROT();
    STEP(pA0,pA1,pB0,pB1,t+1,true,true,true);   WAIT_BAR(2); RESC(); ROT();
  }
  #define ENDW(tt) do{ if((tt)+3<NT){WAIT_BAR(2);} else if((tt)+2<NT){WAIT_BAR(1);} else {WAIT_BAR(0);} }while(0)
  for(;t+1<NT;t+=2){
    STEP(pB0,pB1,pA0,pA1,t,(t+3<NT),(t+1<NT),(t+1<NT));       ENDW(t);   RESC(); ROT();
    STEP(pA0,pA1,pB0,pB1,t+1,(t+4<NT),(t+2<NT),(t+2<NT));     ENDW(t+1); RESC(); ROT();
  }
  STEP(pB0,pB1,pA0,pA1,NT-1,false,false,false); RESC();
  { float sacc=pB0[0]+pB0[1]; _Pragma("unroll") for(int r=2;r<16;++r)sacc+=pB0[r]; _Pragma("unroll") for(int r=0;r<16;++r)sacc+=pB1[r]; l_reg+=sacc;
    pw0=(u32x4){PKW(pB0,0),PKW(pB0,2),PKW(pB0,4),PKW(pB0,6)};pw1=(u32x4){PKW(pB0,8),PKW(pB0,10),PKW(pB0,12),PKW(pB0,14)};pw2=(u32x4){PKW(pB1,0),PKW(pB1,2),PKW(pB1,4),PKW(pB1,6)};pw3=(u32x4){PKW(pB1,8),PKW(pB1,10),PKW(pB1,12),PKW(pB1,14)};
    SBAR(); pv(o,vb0+sl_cur,PAF(0),PAF(1),PAF(2),PAF(3)); }
  #undef PKW
  #undef PAF
  #undef VFR
  #undef PIN
  #undef MX3
  #undef GAPA
  #undef GAPB
  #undef EX
  #undef VRD
  #undef KRD
  #undef STEP
  #undef ENDW
  {auto rr=__builtin_amdgcn_permlane32_swap(__float_as_uint(l_reg),__float_as_uint(l_reg),false,false);l_reg=__uint_as_float(rr[0])+__uint_as_float(rr[1]);}
  if(hi==0)wsf[32+r32]=l_reg;asm volatile("s_waitcnt lgkmcnt(0)":::"memory");
  float rli[16];
  #pragma unroll
  for(int r=0;r<16;++r)rli[r]=__builtin_amdgcn_rcpf(wsf[32+crow(r,hi)]);
  bf16*Ow=Ou+(long)(wid*QBLK)*QP;
  { bf16*stg=(bf16*)(shm+LDS_OST)+wid*2048;
    #pragma unroll
    for(int r=0;r<16;++r){const int orow=crow(r,hi);
      #pragma unroll
      for(int d0=0;d0<2;++d0)stg[orow*64+d0*32+r32]=__float2bfloat16(o[d0][r]*rli[r]);}
    asm volatile("s_waitcnt lgkmcnt(0)":::"memory");
    #pragma unroll
    for(int i=0;i<4;++i){const int row=i*8+(lane>>3),ch=lane&7; const u32x4 v=*(const u32x4*)(stg+row*64+ch*8); ATTN_STORE16(Ow+(long)row*QP+ch*8,v);} }
  asm volatile("s_waitcnt lgkmcnt(0)\n\ts_barrier":::"memory");
  #undef DMA_K
  #undef DMA_V
  #undef CMASK
  #undef START
  #undef RESC
  #undef ROT
}
constexpr int ATTN_LDS_BYTES=LDS_BYTES;
#undef SBAR
#undef WAIT_BAR
}
#ifndef ATTN_FAST
#define ATTN_FAST 1
#endif
__device__ __forceinline__ void attn_fast(const Params& p, const Ctx& c) {
    typedef attn_body::bf16 abf;
    const int vcu = (c.G % 8 == 0) ? (c.bx % 8) * (c.G / 8) + c.bx / 8 : c.bx;
    for (int u = vcu; u < 512 + 128; u += c.G) {
        const abf *Qu, *Kh, *Vh; int NT;
        if (u < 512) { const int qb = u & 7, hq = (u >> 3) & 3, hk = (u >> 5) & 1, b = u >> 6, h = hk * 4 + hq;
            Qu = (const abf*)(p.ws + Z_AQ) + ((size_t)MP + (size_t)b * SEQ_S + qb * 256) * RW + h * HD;
            Kh = (const abf*)(p.ws + Z_KS) + (size_t)b * SKV_S * KVW + hk * HD; Vh = (const abf*)(p.ws + Z_VS) + (size_t)b * SKV_S * KVW + hk * HD; NT = SKV_S / 64; }
        else { const int v = u - 512, hq = v & 3, hk = (v >> 2) & 1, b = v >> 3, h = hk * 4 + hq;
            Qu = (const abf*)(p.ws + Z_AQ) + ((size_t)b * SEQ_P) * RW + h * HD;
            Kh = (const abf*)(p.ws + Z_KP) + (size_t)b * SEQ_P * KVW + hk * HD; Vh = (const abf*)(p.ws + Z_VP) + (size_t)b * SEQ_P * KVW + hk * HD; NT = SKV_P / 64; }
        attn_body::attn_unit<8>(c.tid, Qu, Kh, Vh, (abf*)Qu, NT, (char*)c.lds);
    }
    __syncthreads();
}

__device__ __forceinline__ void attn_simple(const Params& p, const Ctx& c) {
    LAS float* Kt = (LAS float*)c.lds; LAS float* Vt = Kt + 32 * 64; LAS float* Sc = Vt + 32 * 64;
    constexpr int NU_S = NB_S * NH * 4, NU_P = NB_P * NH;
    for (int u = c.bx; u < NU_S + NU_P; u += c.G) {
        const bool smp = u < NU_S; int b, h, q0, nq, skv; const bf16_t *Kb, *Vb; size_t rowbase;
        if (smp) { b = u / 32; h = (u / 4) & 7; q0 = (u & 3) * 512; nq = 512; skv = SKV_S; Kb = (const bf16_t*)(p.ws + Z_KS) + (size_t)b * SKV_S * KVW; Vb = (const bf16_t*)(p.ws + Z_VS) + (size_t)b * SKV_S * KVW; rowbase = MP + (size_t)b * SEQ_S + q0; }
        else { const int v = u - NU_S; b = v / 8; h = v & 7; q0 = 0; nq = 256; skv = SKV_P; Kb = (const bf16_t*)(p.ws + Z_KP) + (size_t)b * SEQ_P * KVW; Vb = (const bf16_t*)(p.ws + Z_VP) + (size_t)b * SEQ_P * KVW; rowbase = (size_t)b * SEQ_P; }
        const int hk = h >> 2; const bool act = c.tid < nq;
        bf16_t* qrow = (bf16_t*)(p.ws + Z_AQ) + (rowbase + (act ? c.tid : 0)) * RW + h * HD;
        float q[64], o[64]; float mx = -1e30f, lsum = 0.f;
#pragma unroll
        for (int i = 0; i < 8; ++i) { const u32x4 w = *(const u32x4*)(qrow + 8 * i); q[8 * i] = bflo(w.x); q[8 * i + 1] = bfhi(w.x); q[8 * i + 2] = bflo(w.y); q[8 * i + 3] = bfhi(w.y); q[8 * i + 4] = bflo(w.z); q[8 * i + 5] = bfhi(w.z); q[8 * i + 6] = bflo(w.w); q[8 * i + 7] = bfhi(w.w); }
#pragma unroll
        for (int i = 0; i < 64; ++i) o[i] = 0.f;
        for (int k0 = 0; k0 < skv; k0 += 32) {
            __syncthreads();
            { const int e = c.tid * 4, j = e >> 6, d = e & 63;
                const u32x2 kw = *(const u32x2*)(Kb + (size_t)(k0 + j) * KVW + hk * HD + d), vw = *(const u32x2*)(Vb + (size_t)(k0 + j) * KVW + hk * HD + d);
                *(LAS f32x4*)(Kt + e) = (f32x4){bflo(kw.x), bfhi(kw.x), bflo(kw.y), bfhi(kw.y)}; *(LAS f32x4*)(Vt + e) = (f32x4){bflo(vw.x), bfhi(vw.x), bflo(vw.y), bfhi(vw.y)}; }
            __syncthreads();
            float tm = mx;
#pragma unroll 1
            for (int j = 0; j < 32; ++j) { float a = 0.f;
#pragma unroll
                for (int d4 = 0; d4 < 16; ++d4) { const f32x4 kv = *(const LAS f32x4*)(Kt + j * 64 + 4 * d4); a += q[4 * d4] * kv.x + q[4 * d4 + 1] * kv.y + q[4 * d4 + 2] * kv.z + q[4 * d4 + 3] * kv.w; }
                Sc[j * 512 + c.tid] = a; tm = fmaxf(tm, a); }
            const float corr = exp2f(mx - tm); mx = tm; lsum *= corr;
#pragma unroll
            for (int i = 0; i < 64; ++i) o[i] *= corr;
#pragma unroll 1
            for (int j = 0; j < 32; ++j) { const float pj = exp2f(Sc[j * 512 + c.tid] - mx); lsum += pj;
#pragma unroll
                for (int d4 = 0; d4 < 16; ++d4) { const f32x4 vv = *(const LAS f32x4*)(Vt + j * 64 + 4 * d4); o[4 * d4] += pj * vv.x; o[4 * d4 + 1] += pj * vv.y; o[4 * d4 + 2] += pj * vv.z; o[4 * d4 + 3] += pj * vv.w; } }
        }
        if (act) { const float il = 1.f / lsum;
#pragma unroll
            for (int i = 0; i < 8; ++i) { u32x4 w; w.x = pk2(o[8 * i] * il, o[8 * i + 1] * il); w.y = pk2(o[8 * i + 2] * il, o[8 * i + 3] * il); w.z = pk2(o[8 * i + 4] * il, o[8 * i + 5] * il); w.w = pk2(o[8 * i + 6] * il, o[8 * i + 7] * il); *(u32x4*)(qrow + 8 * i) = w; } }
    }
    __syncthreads();
}
__device__ __forceinline__ void cmlp_simple(const Params& p, const Ctx& c, int l) {
    LAS float* Vt = (LAS float*)c.lds;
    LAS float* rs = Vt + 128 * 128;
    const bf16_t* cv = (const bf16_t*)(p.ws + Z_CV); bf16_t* cu = (bf16_t*)(p.ws + Z_CU);
    for (int u = c.bx; u < NCHUNK * 4; u += c.G) {
        const int ch = u >> 2, g = u & 3; const size_t R0 = (size_t)ch * 128;
        __syncthreads();
        { const int q = c.tid >> 2, part = c.tid & 3; float ss = 0.f;
            const bf16_t* r = cv + (R0 + q) * RW + part * 128;
#pragma unroll
            for (int i = 0; i < 16; ++i) { const u32x4 w = *(const u32x4*)(r + 8 * i); const float a0 = bflo(w.x), a1 = bfhi(w.x), a2 = bflo(w.y), a3 = bfhi(w.y), a4 = bflo(w.z), a5 = bfhi(w.z), a6 = bflo(w.w), a7 = bfhi(w.w);
                ss += (a0 * a0 + a1 * a1) + (a2 * a2 + a3 * a3) + (a4 * a4 + a5 * a5) + (a6 * a6 + a7 * a7); }
            ss += __shfl_xor(ss, 1); ss += __shfl_xor(ss, 2);
            if (part == 0) rs[q] = rsqrtf(ss * (1.f / RW) + EPS); }
        __syncthreads();
        for (int e = c.tid; e < 128 * 128 / 8; e += 512) { const int q = e >> 4, c8 = (e & 15) * 8; const float r = rs[q];
            const u32x4 w = *(const u32x4*)(cv + (R0 + q) * RW + g * 128 + c8);
            *(LAS f32x4*)(Vt + q * 128 + c8) = (f32x4){bflo(w.x) * r, bfhi(w.x) * r, bflo(w.y) * r, bfhi(w.y) * r};
            *(LAS f32x4*)(Vt + q * 128 + c8 + 4) = (f32x4){bflo(w.z) * r, bfhi(w.z) * r, bflo(w.w) * r, bfhi(w.w) * r}; }
        __syncthreads();
        const int cc = c.tid & 127, pg = __builtin_amdgcn_readfirstlane(c.tid >> 7);
        const float* Ws = p.in[I_CMWS] + ((size_t)(l * 4 + g) * 128) * 128; const float* bs = p.in[I_CMBS] + (l * 4 + g) * 128;
        const float gn = p.in[I_CMNORM][l * RW + g * 128 + cc];
        for (int pi = 0; pi < 32; ++pi) { const int pr = pg * 32 + pi; const float* wrow = Ws + pr * 128; float a = 0.f;
#pragma unroll 8
            for (int q = 0; q < 128; ++q) a += wrow[q] * Vt[q * 128 + cc];
            bf16_t* up = cu + (R0 + pr) * RW + g * 128 + cc;
            const float uu = bf2f(*up);
            *up = (bf16_t)f2bf(uu * (gn * a + bs[pr])); }
    }
    __syncthreads();
}
__device__ __forceinline__ float ret_ld(const Params& p, int l, int dir, int h) { const float x = p.in[I_DECAY][(l * 2 + dir) * NH + h]; return -log1pf(__expf(x)); }
__device__ __forceinline__ void retU_simple(const Params& p, const Ctx& c, int l) {
    LAS float* Kt = (LAS float*)c.lds; LAS float* Vt = Kt + 128 * 64; LAS float* wf = Vt + 128 * 64; LAS float* wb = wf + 128;
    float* U = (float*)(p.ws + Z_U);
    for (int u = c.bx; u < NCHUNK * NH; u += c.G) {
        const int ch = u >> 3, h = u & 7; const size_t R0 = (size_t)ch * 128;
        const float ldf = ret_ld(p, l, 0, h), ldb = ret_ld(p, l, 1, h);
        __syncthreads();
        if (c.tid < 128) { wf[c.tid] = __expf(ldf * (float)(127 - c.tid)); wb[c.tid] = __expf(ldb * (float)c.tid); }
        for (int e = c.tid; e < 128 * 64 / 8; e += 512) { const int j = e >> 3, d8 = (e & 7) * 8;
            const u32x4 kw = *(const u32x4*)((const bf16_t*)(p.ws + Z_RK) + (R0 + j) * RW + h * HD + d8), vw = *(const u32x4*)((const bf16_t*)(p.ws + Z_RV) + (R0 + j) * RW + h * HD + d8);
            *(LAS f32x4*)(Kt + j * 64 + d8) = (f32x4){bflo(kw.x), bfhi(kw.x), bflo(kw.y), bfhi(kw.y)}; *(LAS f32x4*)(Kt + j * 64 + d8 + 4) = (f32x4){bflo(kw.z), bfhi(kw.z), bflo(kw.w), bfhi(kw.w)};
            *(LAS f32x4*)(Vt + j * 64 + d8) = (f32x4){bflo(vw.x), bfhi(vw.x), bflo(vw.y), bfhi(vw.y)}; *(LAS f32x4*)(Vt + j * 64 + d8 + 4) = (f32x4){bflo(vw.z), bfhi(vw.z), bflo(vw.w), bfhi(vw.w)}; }
        __syncthreads();
        const int e = c.tid & 63, d0 = __builtin_amdgcn_readfirstlane(c.tid >> 6) * 8;
        float uf[8], ub[8];
#pragma unroll
        for (int i = 0; i < 8; ++i) { uf[i] = 0.f; ub[i] = 0.f; }
        for (int j = 0; j < 128; ++j) { const float v = Vt[j * 64 + e], vf = v * wf[j], vb = v * wb[j];
            const f32x4 k0 = *(const LAS f32x4*)(Kt + j * 64 + d0), k1 = *(const LAS f32x4*)(Kt + j * 64 + d0 + 4);
            uf[0] += k0.x * vf; uf[1] += k0.y * vf; uf[2] += k0.z * vf; uf[3] += k0.w * vf; uf[4] += k1.x * vf; uf[5] += k1.y * vf; uf[6] += k1.z * vf; uf[7] += k1.w * vf;
            ub[0] += k0.x * vb; ub[1] += k0.y * vb; ub[2] += k0.z * vb; ub[3] += k0.w * vb; ub[4] += k1.x * vb; ub[5] += k1.y * vb; ub[6] += k1.z * vb; ub[7] += k1.w * vb; }
        float* Uf = U + ((size_t)(0 * NCHUNK + ch) * NH + h) * 4096, *Ub = U + ((size_t)(1 * NCHUNK + ch) * NH + h) * 4096;
#pragma unroll
        for (int i = 0; i < 8; ++i) { Uf[(d0 + i) * 64 + e] = uf[i]; Ub[(d0 + i) * 64 + e] = ub[i]; }
    }
    __syncthreads();
}
__device__ __forceinline__ void retO_simple(const Params& p, const Ctx& c, int l) {
    LAS float* Kt = (LAS float*)c.lds; LAS float* Vt = Kt + 128 * 64; LAS float* Sf = Vt + 128 * 64; LAS float* Sb = Sf + 4096; LAS float* pf = Sb + 4096; LAS float* pb = pf + 132;
    const float* U = (const float*)(p.ws + Z_U);
    for (int u = c.bx; u < NCHUNK * NH; u += c.G) {
        const int ch = u >> 3, h = u & 7; const size_t R0 = (size_t)ch * 128; const bool smp = ch >= MP / 128;
        const int nc = smp ? 16 : 2, ch0 = smp ? (MP / 128 + ((ch - MP / 128) & ~15)) : (ch & ~1), cidx = ch - ch0, b = smp ? (ch - MP / 128) >> 4 : ch >> 1;
        const float ldf = ret_ld(p, l, 0, h), ldb = ret_ld(p, l, 1, h); const float Gf = __expf(128.f * ldf), Gb = __expf(128.f * ldb);
        __syncthreads();
        if (c.tid <= 128) { pf[c.tid] = __expf(ldf * (float)c.tid); pb[c.tid] = __expf(ldb * (float)c.tid); }
        for (int e = c.tid; e < 128 * 64 / 8; e += 512) { const int j = e >> 3, d8 = (e & 7) * 8;
            const u32x4 kw = *(const u32x4*)((const bf16_t*)(p.ws + Z_RK) + (R0 + j) * RW + h * HD + d8), vw = *(const u32x4*)((const bf16_t*)(p.ws + Z_RV) + (R0 + j) * RW + h * HD + d8);
            *(LAS f32x4*)(Kt + j * 64 + d8) = (f32x4){bflo(kw.x), bfhi(kw.x), bflo(kw.y), bfhi(kw.y)}; *(LAS f32x4*)(Kt + j * 64 + d8 + 4) = (f32x4){bflo(kw.z), bfhi(kw.z), bflo(kw.w), bfhi(kw.w)};
            *(LAS f32x4*)(Vt + j * 64 + d8) = (f32x4){bflo(vw.x), bfhi(vw.x), bflo(vw.y), bfhi(vw.y)}; *(LAS f32x4*)(Vt + j * 64 + d8 + 4) = (f32x4){bflo(vw.z), bfhi(vw.z), bflo(vw.w), bfhi(vw.w)}; }
        {
            float sf[8], sb[8]; const int e0 = c.tid * 8;
            if (smp) { const float* s0 = p.in[I_ST] + ((size_t)((b * 2 + l) * 2 + 0) * NH + h) * 4096 + e0; const float* s1 = p.in[I_ST] + ((size_t)((b * 2 + l) * 2 + 1) * NH + h) * 4096 + e0;
#pragma unroll
                for (int i = 0; i < 8; ++i) { sf[i] = s0[i]; sb[i] = s1[i]; } }
            else {
#pragma unroll
                for (int i = 0; i < 8; ++i) { sf[i] = 0.f; sb[i] = 0.f; } }
            for (int cc = 0; cc < cidx; ++cc) { const float* uf = U + ((size_t)(0 * NCHUNK + ch0 + cc) * NH + h) * 4096 + e0;
#pragma unroll
                for (int i = 0; i < 8; ++i) sf[i] = Gf * sf[i] + uf[i]; }
            for (int cc = nc - 1; cc > cidx; --cc) { const float* ub = U + ((size_t)(1 * NCHUNK + ch0 + cc) * NH + h) * 4096 + e0;
#pragma unroll
                for (int i = 0; i < 8; ++i) sb[i] = Gb * sb[i] + ub[i]; }
#pragma unroll
            for (int i = 0; i < 8; ++i) { Sf[e0 + i] = sf[i]; Sb[e0 + i] = sb[i]; }
            if (!smp && cidx == nc - 1) { const float* uf = U + ((size_t)(0 * NCHUNK + ch) * NH + h) * 4096 + e0; float* o = p.out + OUT_ST + ((size_t)((b * 2 + l) * 2 + 0) * NH + h) * 4096 + e0;
#pragma unroll
                for (int i = 0; i < 8; ++i) o[i] = Gf * sf[i] + uf[i]; }
            if (!smp && cidx == 0) { const float* ub = U + ((size_t)(1 * NCHUNK + ch) * NH + h) * 4096 + e0; float* o = p.out + OUT_ST + ((size_t)((b * 2 + l) * 2 + 1) * NH + h) * 4096 + e0;
#pragma unroll
                for (int i = 0; i < 8; ++i) o[i] = Gb * sb[i] + ub[i]; }
        }
        __syncthreads();
        const int i = c.tid >> 2, part = c.tid & 3;
        float qp[16], o[16];
        { const bf16_t* qr = (const bf16_t*)(p.ws + Z_RQ) + (R0 + i) * RW + h * HD + part * 16; const u32x4 w0 = *(const u32x4*)qr, w1 = *(const u32x4*)(qr + 8);
            qp[0] = bflo(w0.x); qp[1] = bfhi(w0.x); qp[2] = bflo(w0.y); qp[3] = bfhi(w0.y); qp[4] = bflo(w0.z); qp[5] = bfhi(w0.z); qp[6] = bflo(w0.w); qp[7] = bfhi(w0.w);
            qp[8] = bflo(w1.x); qp[9] = bfhi(w1.x); qp[10] = bflo(w1.y); qp[11] = bfhi(w1.y); qp[12] = bflo(w1.z); qp[13] = bfhi(w1.z); qp[14] = bflo(w1.w); qp[15] = bfhi(w1.w); }
#pragma unroll
        for (int e = 0; e < 16; ++e) o[e] = 0.f;
#pragma unroll 1
        for (int j = 0; j < 128; ++j) { float s = 0.f;
#pragma unroll
            for (int d4 = 0; d4 < 4; ++d4) { const f32x4 kv = *(const LAS f32x4*)(Kt + j * 64 + part * 16 + 4 * d4); s += qp[4 * d4] * kv.x + qp[4 * d4 + 1] * kv.y + qp[4 * d4 + 2] * kv.z + qp[4 * d4 + 3] * kv.w; }
            s += __shfl_xor(s, 1); s += __shfl_xor(s, 2);
            const float w = j < i ? pf[i - j] : (j > i ? pb[j - i] : 2.0f);
            s *= w;
#pragma unroll
            for (int e4 = 0; e4 < 4; ++e4) { const f32x4 vv = *(const LAS f32x4*)(Vt + j * 64 + part * 16 + 4 * e4); o[4 * e4] += s * vv.x; o[4 * e4 + 1] += s * vv.y; o[4 * e4 + 2] += s * vv.z; o[4 * e4 + 3] += s * vv.w; } }
        { const float xf = pf[i + 1], xb = pb[128 - i]; const bf16_t* qfull = (const bf16_t*)(p.ws + Z_RQ) + (R0 + i) * RW + h * HD;
#pragma unroll 2
            for (int d = 0; d < 64; ++d) { const float qd = bf2f(qfull[d]); const float af = qd * xf, ab = qd * xb;
#pragma unroll
                for (int e4 = 0; e4 < 4; ++e4) { const f32x4 a = *(const LAS f32x4*)(Sf + d * 64 + part * 16 + 4 * e4), bb = *(const LAS f32x4*)(Sb + d * 64 + part * 16 + 4 * e4);
                    o[4 * e4] += af * a.x + ab * bb.x; o[4 * e4 + 1] += af * a.y + ab * bb.y; o[4 * e4 + 2] += af * a.z + ab * bb.z; o[4 * e4 + 3] += af * a.w + ab * bb.w; } } }
        float s1 = 0.f;
#pragma unroll
        for (int e = 0; e < 16; ++e) s1 += o[e];
        s1 += __shfl_xor(s1, 1); s1 += __shfl_xor(s1, 2); const float mu = s1 * (1.f / 64.f);
        float s2 = 0.f;
#pragma unroll
        for (int e = 0; e < 16; ++e) { const float d = o[e] - mu; s2 += d * d; }
        s2 += __shfl_xor(s2, 1); s2 += __shfl_xor(s2, 2); const float rstd = rsqrtf(s2 * (1.f / 64.f) + EPS);
        const float* gn = p.in[I_RETGN] + l * RW + h * HD + part * 16;
        const bf16_t* rg = (const bf16_t*)(p.ws + Z_RG) + (R0 + i) * RW + h * HD + part * 16; const u32x4 g0 = *(const u32x4*)rg, g1 = *(const u32x4*)(rg + 8);
        float gs[16] = {bflo(g0.x), bfhi(g0.x), bflo(g0.y), bfhi(g0.y), bflo(g0.z), bfhi(g0.z), bflo(g0.w), bfhi(g0.w), bflo(g1.x), bfhi(g1.x), bflo(g1.y), bfhi(g1.y), bflo(g1.z), bfhi(g1.z), bflo(g1.w), bfhi(g1.w)};
        float y[16];
#pragma unroll
        for (int e = 0; e < 16; ++e) y[e] = (o[e] - mu) * rstd * gn[e] * gs[e];
        bf16_t* dst = (bf16_t*)(p.ws + Z_CV) + (R0 + i) * RW + h * HD + part * 16;
        u32x4 w0, w1; w0.x = pk2(y[0], y[1]); w0.y = pk2(y[2], y[3]); w0.z = pk2(y[4], y[5]); w0.w = pk2(y[6], y[7]); w1.x = pk2(y[8], y[9]); w1.y = pk2(y[10], y[11]); w1.z = pk2(y[12], y[13]); w1.w = pk2(y[14], y[15]);
        *(u32x4*)dst = w0; *(u32x4*)(dst + 8) = w1;
    }
    __syncthreads();
}

typedef short v4i16_t __attribute__((ext_vector_type(4)));
typedef LAS const unsigned char* lcp;
__device__ __forceinline__ f32x4 mfma16(bf16x8 a, bf16x8 b, f32x4 c) { return __builtin_amdgcn_mfma_f32_16x16x32_bf16(a, b, c, 0, 0, 0); }
__device__ __forceinline__ bf16x8 tr_frag(lcp base, int stride, int k0, int c0, int lane) {
    const int g = lane >> 4, i = lane & 15, q = i >> 2, pp = i & 3;
    lcp a = base + (k0 + 8 * g + q) * stride + (c0 + 4 * pp) * 2;
    const v4i16_t r1 = __builtin_amdgcn_ds_read_tr16_b64_v4i16((LAS v4i16_t*)a), r2 = __builtin_amdgcn_ds_read_tr16_b64_v4i16((LAS v4i16_t*)(a + 4 * stride));
    return (bf16x8){r1[0], r1[1], r1[2], r1[3], r2[0], r2[1], r2[2], r2[3]};
}
__device__ __forceinline__ bf16x8 row_frag(lcp base, int stride, int r0, int k0, int lane) { return *(const LAS bf16x8*)(base + (r0 + (lane & 15)) * stride + (k0 + 8 * (lane >> 4)) * 2); }
__device__ __forceinline__ u32x4 scale8(const u32x4 w, float s) { u32x4 o; o.x = pk2(bflo(w.x) * s, bfhi(w.x) * s); o.y = pk2(bflo(w.y) * s, bfhi(w.y) * s); o.z = pk2(bflo(w.z) * s, bfhi(w.z) * s); o.w = pk2(bflo(w.w) * s, bfhi(w.w) * s); return o; }
constexpr int RS64 = 144, RS128 = 272;
constexpr float LOG2E = 1.4426950408889634f;

__device__ __forceinline__ void retU_fast(const Params& p, const Ctx& c, int l) {
    LAS unsigned char* Kf = c.lds; LAS unsigned char* Kb = Kf + 128 * RS64; LAS unsigned char* Vs = Kb + 128 * RS64;
    float* U = (float*)(p.ws + Z_U);
    const int g = c.lane >> 4, i16 = c.lane & 15;
    for (int u = c.vcu; u < NCHUNK * NH; u += c.G) {
        const int ch = u >> 3, h = u & 7; const size_t R0 = (size_t)ch * 128;
        const float l2f = ret_ld(p, l, 0, h) * LOG2E, l2b = ret_ld(p, l, 1, h) * LOG2E;
        __syncthreads();
#pragma unroll
        for (int it = 0; it < 2; ++it) { const int idx = c.tid + 512 * it, j = idx >> 3, c8 = (idx & 7) * 8;
            const u32x4 kw = *(const u32x4*)((const bf16_t*)(p.ws + Z_RK) + (R0 + j) * RW + h * HD + c8), vw = *(const u32x4*)((const bf16_t*)(p.ws + Z_RV) + (R0 + j) * RW + h * HD + c8);
            const float wf = exp2f(l2f * (float)(127 - j)), wb = exp2f(l2b * (float)j);
            *(LAS u32x4*)(Kf + j * RS64 + c8 * 2) = scale8(kw, wf); *(LAS u32x4*)(Kb + j * RS64 + c8 * 2) = scale8(kw, wb); *(LAS u32x4*)(Vs + j * RS64 + c8 * 2) = vw; }
        __syncthreads();
        const int dt = c.wave & 3, et0 = 2 * (c.wave >> 2);
        f32x4 acc[2][2];
#pragma unroll
        for (int s = 0; s < 2; ++s)
#pragma unroll
            for (int e = 0; e < 2; ++e) acc[s][e] = (f32x4){0.f, 0.f, 0.f, 0.f};
#pragma unroll
        for (int ks = 0; ks < 4; ++ks) {
            const bf16x8 af = tr_frag(Kf, RS64, 32 * ks, 16 * dt, c.lane), ab = tr_frag(Kb, RS64, 32 * ks, 16 * dt, c.lane);
#pragma unroll
            for (int e = 0; e < 2; ++e) { const bf16x8 bv = tr_frag(Vs, RS64, 32 * ks, 16 * (et0 + e), c.lane); acc[0][e] = mfma16(af, bv, acc[0][e]); acc[1][e] = mfma16(ab, bv, acc[1][e]); }
        }
#pragma unroll
        for (int s = 0; s < 2; ++s)
#pragma unroll
            for (int e = 0; e < 2; ++e) { float* o = U + ((size_t)(s * NCHUNK + ch) * NH + h) * 4096 + (16 * dt + 4 * g) * 64 + 16 * (et0 + e) + i16;
#pragma unroll
                for (int r = 0; r < 4; ++r) o[r * 64] = acc[s][e][r]; }
    }
    __syncthreads();
}

__device__ __forceinline__ void retO_fast(const Params& p, const Ctx& c, int l) {
    LAS unsigned char* Qs = c.lds; LAS unsigned char* Ks = Qs + 128 * RS64; LAS unsigned char* Vs = Ks + 128 * RS64; LAS unsigned char* Sf = Vs + 128 * RS64; LAS unsigned char* Sb = Sf + 64 * RS64; LAS unsigned char* Ps = Sb + 64 * RS64;
    const float* U = (const float*)(p.ws + Z_U);
    const int g = c.lane >> 4, i16 = c.lane & 15, i0 = 16 * c.wave;
    for (int u = c.vcu; u < NCHUNK * NH; u += c.G) {
        const int ch = u >> 3, h = u & 7; const size_t R0 = (size_t)ch * 128; const bool smp = ch >= MP / 128;
        const int nc = smp ? 16 : 2, ch0 = smp ? (MP / 128 + ((ch - MP / 128) & ~15)) : (ch & ~1), cidx = ch - ch0, b = smp ? (ch - MP / 128) >> 4 : ch >> 1;
        const float ldf = ret_ld(p, l, 0, h), ldb = ret_ld(p, l, 1, h); const float Gf = __expf(128.f * ldf), Gb = __expf(128.f * ldb), l2f = ldf * LOG2E, l2b = ldb * LOG2E;
        __syncthreads();
#pragma unroll
        for (int it = 0; it < 2; ++it) { const int idx = c.tid + 512 * it, j = idx >> 3, c8 = (idx & 7) * 8; const size_t go = (R0 + j) * RW + h * HD + c8;
            *(LAS u32x4*)(Qs + j * RS64 + c8 * 2) = *(const u32x4*)((const bf16_t*)(p.ws + Z_RQ) + go);
            *(LAS u32x4*)(Ks + j * RS64 + c8 * 2) = *(const u32x4*)((const bf16_t*)(p.ws + Z_RK) + go);
            *(LAS u32x4*)(Vs + j * RS64 + c8 * 2) = *(const u32x4*)((const bf16_t*)(p.ws + Z_RV) + go); }
        {
            float sf[8], sb[8]; const int e0 = c.tid * 8;
            if (smp) { const float* s0 = p.in[I_ST] + ((size_t)((b * 2 + l) * 2 + 0) * NH + h) * 4096 + e0; const float* s1 = p.in[I_ST] + ((size_t)((b * 2 + l) * 2 + 1) * NH + h) * 4096 + e0;
#pragma unroll
                for (int i = 0; i < 8; ++i) { sf[i] = s0[i]; sb[i] = s1[i]; } }
            else {
#pragma unroll
                for (int i = 0; i < 8; ++i) { sf[i] = 0.f; sb[i] = 0.f; } }
            {
                const float* uf = U + ((size_t)(0 * NCHUNK + ch0) * NH + h) * 4096 + e0; const float* ub = U + ((size_t)(1 * NCHUNK + ch0) * NH + h) * 4096 + e0;
                int cc = 0;
                for (; cc + 4 <= cidx; cc += 4) { f32x4 a[4][2];
#pragma unroll
                    for (int k = 0; k < 4; ++k) { a[k][0] = *(const f32x4*)(uf + (size_t)(cc + k) * NH * 4096); a[k][1] = *(const f32x4*)(uf + (size_t)(cc + k) * NH * 4096 + 4); }
#pragma unroll
                    for (int k = 0; k < 4; ++k)
#pragma unroll
                        for (int i = 0; i < 4; ++i) { sf[i] = Gf * sf[i] + a[k][0][i]; sf[4 + i] = Gf * sf[4 + i] + a[k][1][i]; } }
                for (; cc < cidx; ++cc) { const f32x4 a0 = *(const f32x4*)(uf + (size_t)cc * NH * 4096), a1 = *(const f32x4*)(uf + (size_t)cc * NH * 4096 + 4);
#pragma unroll
                    for (int i = 0; i < 4; ++i) { sf[i] = Gf * sf[i] + a0[i]; sf[4 + i] = Gf * sf[4 + i] + a1[i]; } }
                cc = nc - 1;
                for (; cc - 4 >= cidx; cc -= 4) { f32x4 a[4][2];
#pragma unroll
                    for (int k = 0; k < 4; ++k) { a[k][0] = *(const f32x4*)(ub + (size_t)(cc - k) * NH * 4096); a[k][1] = *(const f32x4*)(ub + (size_t)(cc - k) * NH * 4096 + 4); }
#pragma unroll
                    for (int k = 0; k < 4; ++k)
#pragma unroll
                        for (int i = 0; i < 4; ++i) { sb[i] = Gb * sb[i] + a[k][0][i]; sb[4 + i] = Gb * sb[4 + i] + a[k][1][i]; } }
                for (; cc > cidx; --cc) { const f32x4 a0 = *(const f32x4*)(ub + (size_t)cc * NH * 4096), a1 = *(const f32x4*)(ub + (size_t)cc * NH * 4096 + 4);
#pragma unroll
                    for (int i = 0; i < 4; ++i) { sb[i] = Gb * sb[i] + a0[i]; sb[4 + i] = Gb * sb[4 + i] + a1[i]; } }
            }
            { const int d = c.tid >> 3, e = (c.tid & 7) * 8; u32x4 w;
                w.x = pk2(sf[0], sf[1]); w.y = pk2(sf[2], sf[3]); w.z = pk2(sf[4], sf[5]); w.w = pk2(sf[6], sf[7]); *(LAS u32x4*)(Sf + d * RS64 + e * 2) = w;
                w.x = pk2(sb[0], sb[1]); w.y = pk2(sb[2], sb[3]); w.z = pk2(sb[4], sb[5]); w.w = pk2(sb[6], sb[7]); *(LAS u32x4*)(Sb + d * RS64 + e * 2) = w; }
            if (!smp && cidx == nc - 1) { const float* uf = U + ((size_t)(0 * NCHUNK + ch) * NH + h) * 4096 + e0; float* o = p.out + OUT_ST + ((size_t)((b * 2 + l) * 2 + 0) * NH + h) * 4096 + e0;
#pragma unroll
                for (int i = 0; i < 8; ++i) o[i] = Gf * sf[i] + uf[i]; }
            if (!smp && cidx == 0) { const float* ub = U + ((size_t)(1 * NCHUNK + ch) * NH + h) * 4096 + e0; float* o = p.out + OUT_ST + ((size_t)((b * 2 + l) * 2 + 1) * NH + h) * 4096 + e0;
#pragma unroll
                for (int i = 0; i < 8; ++i) o[i] = Gb * sb[i] + ub[i]; }
        }
        __syncthreads();
        { const bf16x8 q0 = row_frag(Qs, RS64, i0, 0, c.lane), q1 = row_frag(Qs, RS64, i0, 32, c.lane);
            const int iq = i0 + i16;
#pragma unroll
            for (int jt = 0; jt < 8; ++jt) {
                f32x4 s = (f32x4){0.f, 0.f, 0.f, 0.f};
                s = mfma16(row_frag(Ks, RS64, 16 * jt, 0, c.lane), q0, s); s = mfma16(row_frag(Ks, RS64, 16 * jt, 32, c.lane), q1, s);
                float pv[4];
#pragma unroll
                for (int r = 0; r < 4; ++r) { const int j = 16 * jt + 4 * g + r; const float w = j < iq ? exp2f(l2f * (float)(iq - j)) : (j > iq ? exp2f(l2b * (float)(j - iq)) : 2.0f); pv[r] = s[r] * w; }
                u32x2 w2; w2.x = pk2(pv[0], pv[1]); w2.y = pk2(pv[2], pv[3]);
                *(LAS u32x2*)(Ps + iq * RS128 + (16 * jt + 4 * g) * 2) = w2;
            } }
        __syncthreads();
        f32x4 ap[4], af[4], ab[4];
#pragma unroll
        for (int et = 0; et < 4; ++et) { ap[et] = (f32x4){0.f, 0.f, 0.f, 0.f}; af[et] = ap[et]; ab[et] = ap[et]; }
#pragma unroll
        for (int ks = 0; ks < 4; ++ks) { const bf16x8 a = row_frag(Ps, RS128, i0, 32 * ks, c.lane);
#pragma unroll
            for (int et = 0; et < 4; ++et) ap[et] = mfma16(a, tr_frag(Vs, RS64, 32 * ks, 16 * et, c.lane), ap[et]); }
#pragma unroll
        for (int ks = 0; ks < 2; ++ks) { const bf16x8 a = row_frag(Qs, RS64, i0, 32 * ks, c.lane);
#pragma unroll
            for (int et = 0; et < 4; ++et) { af[et] = mfma16(a, tr_frag(Sf, RS64, 32 * ks, 16 * et, c.lane), af[et]); ab[et] = mfma16(a, tr_frag(Sb, RS64, 32 * ks, 16 * et, c.lane), ab[et]); } }
        float mu[4], rstd[4];
#pragma unroll
        for (int r = 0; r < 4; ++r) { const int il = i0 + 4 * g + r; const float xf = exp2f(l2f * (float)(il + 1)), xb = exp2f(l2b * (float)(128 - il)); float s1 = 0.f;
#pragma unroll
            for (int et = 0; et < 4; ++et) { ap[et][r] += xf * af[et][r] + xb * ab[et][r]; s1 += ap[et][r]; }
            s1 += __shfl_xor(s1, 1); s1 += __shfl_xor(s1, 2); s1 += __shfl_xor(s1, 4); s1 += __shfl_xor(s1, 8); mu[r] = s1 * (1.f / 64.f); float s2 = 0.f;
#pragma unroll
            for (int et = 0; et < 4; ++et) { const float d = ap[et][r] - mu[r]; s2 += d * d; }
            s2 += __shfl_xor(s2, 1); s2 += __shfl_xor(s2, 2); s2 += __shfl_xor(s2, 4); s2 += __shfl_xor(s2, 8); rstd[r] = rsqrtf(s2 * (1.f / 64.f) + EPS); }
        LAS float* stg = (LAS float*)(Ps + i0 * RS128);
#pragma unroll
        for (int et = 0; et < 4; ++et) { const float gn = p.in[I_RETGN][l * RW + h * HD + 16 * et + i16];
#pragma unroll
            for (int r = 0; r < 4; ++r) stg[(4 * g + r) * 68 + 16 * et + i16] = (ap[et][r] - mu[r]) * rstd[r] * gn; }
        asm volatile("s_waitcnt lgkmcnt(0)" ::: "memory");
#pragma unroll
        for (int k = 0; k < 2; ++k) { const int row = c.lane >> 2, ec = ((c.lane & 3) * 2 + k) * 8;
            const f32x4 y0 = *(const LAS f32x4*)(stg + row * 68 + ec), y1 = *(const LAS f32x4*)(stg + row * 68 + ec + 4);
            const size_t go = (R0 + i0 + row) * RW + h * HD + ec; const u32x4 gw = *(const u32x4*)((const bf16_t*)(p.ws + Z_RG) + go);
            u32x4 o; o.x = pk2(y0.x * bflo(gw.x), y0.y * bfhi(gw.x)); o.y = pk2(y0.z * bflo(gw.y), y0.w * bfhi(gw.y)); o.z = pk2(y1.x * bflo(gw.z), y1.y * bfhi(gw.z)); o.w = pk2(y1.z * bflo(gw.w), y1.w * bfhi(gw.w));
            *(u32x4*)((bf16_t*)(p.ws + Z_CV) + go) = o; }
    }
    __syncthreads();
}

__device__ __forceinline__ void cmlp_fast(const Params& p, const Ctx& c, int l) {
    LAS unsigned char* As = c.lds; LAS unsigned char* Vc = As + 128 * RS128; LAS float* rs = (LAS float*)(Vc + 128 * RS128);
    const bf16_t* cv = (const bf16_t*)(p.ws + Z_CV); bf16_t* cu = (bf16_t*)(p.ws + Z_CU);
    const int g4 = c.lane >> 4, i16 = c.lane & 15, p0 = 16 * c.wave;
    for (int u = c.vcu; u < NCHUNK * 4; u += c.G) {
        const int ch = u >> 2, g = u & 3; const size_t R0 = (size_t)ch * 128;
        __syncthreads();
        { const int q = c.tid >> 2, part = c.tid & 3; float ss = 0.f;
            const bf16_t* r = cv + (R0 + q) * RW + part * 128;
#pragma unroll
            for (int i = 0; i < 16; ++i) { const u32x4 w = *(const u32x4*)(r + 8 * i); const float a0 = bflo(w.x), a1 = bfhi(w.x), a2 = bflo(w.y), a3 = bfhi(w.y), a4 = bflo(w.z), a5 = bfhi(w.z), a6 = bflo(w.w), a7 = bfhi(w.w);
                ss += (a0 * a0 + a1 * a1) + (a2 * a2 + a3 * a3) + (a4 * a4 + a5 * a5) + (a6 * a6 + a7 * a7); }
            ss += __shfl_xor(ss, 1); ss += __shfl_xor(ss, 2);
            if (part == 0) rs[q] = rsqrtf(ss * (1.f / RW) + EPS); }
#pragma unroll
        for (int it = 0; it < 4; ++it) { const int idx = c.tid + 512 * it, q = idx >> 4, c8 = (idx & 15) * 8;
            *(LAS u32x4*)(Vc + q * RS128 + c8 * 2) = *(const u32x4*)(cv + (R0 + q) * RW + g * 128 + c8); }
        __syncthreads();
        const float* Ws = p.in[I_CMWS] + ((size_t)(l * 4 + g) * 128) * 128;
#pragma unroll
        for (int it = 0; it < 8; ++it) { const int idx = c.tid + 512 * it, pr = idx >> 5, q4 = (idx & 31) * 4;
            const f32x4 w = *(const f32x4*)(Ws + pr * 128 + q4); const f32x4 r = *(const LAS f32x4*)(rs + q4);
            u32x2 o; o.x = pk2(w.x * r.x, w.y * r.y); o.y = pk2(w.z * r.z, w.w * r.w); *(LAS u32x2*)(As + pr * RS128 + q4 * 2) = o; }
        __syncthreads();
        f32x4 acc[8];
#pragma unroll
        for (int ct = 0; ct < 8; ++ct) acc[ct] = (f32x4){0.f, 0.f, 0.f, 0.f};
#pragma unroll
        for (int ks = 0; ks < 4; ++ks) { const bf16x8 a = row_frag(As, RS128, p0, 32 * ks, c.lane);
#pragma unroll
            for (int ct = 0; ct < 8; ++ct) acc[ct] = mfma16(a, tr_frag(Vc, RS128, 32 * ks, 16 * ct, c.lane), acc[ct]); }
        __syncthreads();
        LAS float* stg = (LAS float*)(c.lds + c.wave * (16 * 132 * 4));
        const float* bsv = p.in[I_CMBS] + (l * 4 + g) * 128 + p0 + 4 * g4;
        float bb[4];
#pragma unroll
        for (int r = 0; r < 4; ++r) bb[r] = bsv[r];
#pragma unroll
        for (int ct = 0; ct < 8; ++ct) { const float gn = p.in[I_CMNORM][l * RW + g * 128 + 16 * ct + i16];
#pragma unroll
            for (int r = 0; r < 4; ++r) stg[(4 * g4 + r) * 132 + 16 * ct + i16] = gn * acc[ct][r] + bb[r]; }
        asm volatile("s_waitcnt lgkmcnt(0)" ::: "memory");
#pragma unroll
        for (int k = 0; k < 4; ++k) { const int row = c.lane >> 2, cc = (k * 4 + (c.lane & 3)) * 8;
            const f32x4 y0 = *(const LAS f32x4*)(stg + row * 132 + cc), y1 = *(const LAS f32x4*)(stg + row * 132 + cc + 4);
            bf16_t* up = cu + (R0 + p0 + row) * RW + g * 128 + cc; const u32x4 uw = *(const u32x4*)up;
            u32x4 o; o.x = pk2(y0.x * bflo(uw.x), y0.y * bfhi(uw.x)); o.y = pk2(y0.z * bflo(uw.y), y0.w * bfhi(uw.y)); o.z = pk2(y1.x * bflo(uw.z), y1.y * bfhi(uw.z)); o.w = pk2(y1.z * bflo(uw.w), y1.w * bfhi(uw.w));
            *(u32x4*)up = o; }
    }
    __syncthreads();
}
#ifndef P2A_ORDER
#define P2A_ORDER 0
#endif
#ifndef FAST_MIX
#define FAST_MIX 7
#endif

#ifndef PG8_ALIGN_
#define PG8_ALIGN_ true
#endif
#ifndef PG8_SP2_
#define PG8_SP2_ true
#endif
#ifndef PG8_MASK
#define PG8_MASK 0xFFF
#endif
template <int KIND, class Epi, class Sched>
__device__ __forceinline__ void gemm_any(const Ctx& c, const bf16_t* A, const bf16_t* Bt, int K, const Sched& S, const Epi& E, unsigned long long* probe_ts = nullptr) {
    if constexpr ((PG8_MASK >> KIND) & 1) { pg8::Gemm g{A, Bt, 0, 0, K, nullptr};
#ifdef PROBE_KIND
        if (KIND == PROBE_KIND && A != nullptr) g.ts = probe_ts;
#endif
        pg8::gemm_phase<Epi, Sched, PG8_ALIGN_, PG8_SP2_>(c.tid, c.lds, g, S, E); }
    else gemm_simple(c, A, Bt, K, S, E);
}
#ifndef KMASK
#define KMASK 0xFFF
#endif
constexpr int NPHASE = 23;
template <int KIND> __device__ __forceinline__ void run_kind(const Params& p, const Ctx& c, int l) {
    const unsigned char* wb = p.ws + WS_W;
    if constexpr (KIND == 0) { p0_modulation(p, c); p0_rope_tables(p, c); p_wconv(p, c, 0); p_kvctx(p, c, 0); }
    else if constexpr (KIND == 1) { p_norm(p, c, l, 0); }
    else if constexpr (KIND == 2) { StaticOrder S; S.init(M, NMIX, c.G, c.bx, DM); EpiMix E{&p, l}; gemm_any<2>(c, (const bf16_t*)(p.ws + WS_XN), (const bf16_t*)(wb + W_IN), DM, S, E, l == 0 ? (unsigned long long*)(p.ws + WS_CTL + 65536) : nullptr); }
    else if constexpr (KIND == 3) {
#if P2A_ORDER == 1
        if (FAST_MIX & 2) retU_fast(p, c, l); else retU_simple(p, c, l); if (FAST_MIX & 1) cmlp_fast(p, c, l); else cmlp_simple(p, c, l); if (ATTN_FAST) attn_fast(p, c); else attn_simple(p, c);
#else
        if (ATTN_FAST) attn_fast(p, c); else attn_simple(p, c); if (FAST_MIX & 1) cmlp_fast(p, c, l); else cmlp_simple(p, c, l); if (FAST_MIX & 2) retU_fast(p, c, l); else retU_simple(p, c, l);
#endif
    }
    else if constexpr (KIND == 4) { if (FAST_MIX & 4) retO_fast(p, c, l); else retO_simple(p, c, l); }
    else if constexpr (KIND == 5) { StaticOrder S; S.init(M, NGATE, c.G, c.bx, DM); EpiGate E{&p}; gemm_any<5>(c, (const bf16_t*)(p.ws + WS_XN), (const bf16_t*)(wb + W_IN) + (size_t)NMIX * DM, DM, S, E, l == 0 ? (unsigned long long*)(p.ws + WS_CTL + 65536) : nullptr); }
    else if constexpr (KIND == 6) { MergeOrder S{c.G, (c.G % 8 == 0) ? (c.bx % 8) * (c.G / 8) + c.bx / 8 : c.bx}; EpiMerge E{&p}; gemm_any<6>(c, (const bf16_t*)(p.ws + Z_AQ), (const bf16_t*)(wb + W_BR), RW, S, E, l == 0 ? (unsigned long long*)(p.ws + WS_CTL + 65536) : nullptr); }
    else if constexpr (KIND == 7) { QuarterOrder S; S.init(c.G, c.bx, DM); EpiRes E{&p, l, 2, l == 0, DM / 64, (bf16_t*)(p.ws + SLAB_P4)}; gemm_any<7>(c, (const bf16_t*)(p.ws + WS_XN), (const bf16_t*)(wb + W_OUT), DM, S, E, l == 0 ? (unsigned long long*)(p.ws + WS_CTL + 65536) : nullptr); }
    else if constexpr (KIND == 8) { p_norm(p, c, l, 1, c.G == 256); }
    else if constexpr (KIND == 9) { StaticOrder S; S.init(M, DFF, c.G, c.bx, DM); EpiFF1 E{&p}; gemm_any<9>(c, (const bf16_t*)(p.ws + WS_XN), (const bf16_t*)(wb + W_FF1), DM, S, E, l == 0 ? (unsigned long long*)(p.ws + WS_CTL + 65536) : nullptr); }
    else if constexpr (KIND == 10) { QuarterOrder S; S.init(c.G, c.bx, DFF); EpiRes E{&p, l, 5, false, DFF / 64, (bf16_t*)(p.ws + SLAB_P6)}; gemm_any<10>(c, (const bf16_t*)(p.ws + Z_HB), (const bf16_t*)(wb + W_FF2), DFF, S, E, l == 0 ? (unsigned long long*)(p.ws + WS_CTL + 65536) : nullptr); }
    else { if (l == 0) { if (c.G == 256) p_combine(p, c, 0, (const bf16_t*)(p.ws + SLAB_P6)); p_wconv(p, c, 1); p_kvctx(p, c, 1); } else p_final_norm(p, c, c.G == 256); }
}
template <int PH> __device__ __forceinline__ void run_from(const Params& p, const Ctx& c0, const XcdBarrier& bar) {
    if constexpr (PH < NPHASE) {
        constexpr int kind = PH < 12 ? PH : (PH == 12 ? 1 : PH - 11), l = PH < 12 ? 0 : 1;
#ifdef PROBE_A
        if (c0.bx == 0 && c0.tid == 0) ((unsigned long long*)(p.ws + WS_CTL + 65536))[PH] = __builtin_amdgcn_s_memrealtime();
#endif
        { Ctx c = c0; asm volatile("" : "+v"(c.tid)); c.lane = c.tid & 63; c.wave = __builtin_amdgcn_readfirstlane(c.tid >> 6);
          if ((KMASK >> kind) & 1) run_kind<kind>(p, c, l); }
#ifdef PROBE_A
        xcd_barrier(bar);
        if constexpr (PH + 1 == NPHASE) {
            if (c0.bx == 0 && c0.tid == 0) ((unsigned long long*)(p.ws + WS_CTL + 65536))[NPHASE] = __builtin_amdgcn_s_memrealtime();
            xcd_barrier(bar);
            const unsigned long long* ts = (const unsigned long long*)(p.ws + WS_CTL + 65536);
            const float us = (float)(ts[PROBE_B] - ts[PROBE_A]) * 0.01f; const float sc = 1.0f + sqrtf(2e-4f * us / (float)(PROBE_FS));
            for (size_t i = (size_t)c0.bx * 512 + c0.tid; i < (size_t)NB_P * 2 * SEQ_P * KVW; i += (size_t)c0.G * 512) p.out[OUT_CV + i] *= sc;
        }
#else
        if constexpr (PH + 1 < NPHASE) xcd_barrier(bar);
#endif
        run_from<PH + 1>(p, c0, bar);
    }
}
#if N_LAUNCH_MODE == 1
__global__ void __launch_bounds__(512, 2) fwd_kernel(Params p) {
    extern __shared__ __attribute__((aligned(16))) unsigned char lds[];
    Ctx c; c.tid = threadIdx.x; c.lane = c.tid & 63; c.wave = __builtin_amdgcn_readfirstlane(c.tid >> 6); c.G = gridDim.x; c.bx = blockIdx.x; c.vcu = (c.G % 8 == 0) ? (c.bx % 8) * (c.G / 8) + c.bx / 8 : c.bx; c.lds = (LAS unsigned char*)lds;
    volatile LAS unsigned* MISC = (volatile LAS unsigned*)(c.lds + MISC_OFF);
    if (c.tid < 32) MISC[c.tid] = 0u;
    __syncthreads();
    XcdBarrier bar = xcd_barrier_post((unsigned*)(p.ws + WS_CTL) + CW_BAR, MISC + 8);
    run_from<0>(p, c, bar);
}
#endif
template <int KIND> __global__ void __launch_bounds__(512, 2) phase_kernel(Params p) {
    extern __shared__ __attribute__((aligned(16))) unsigned char lds[];
    Ctx c; c.tid = threadIdx.x; c.lane = c.tid & 63; c.wave = __builtin_amdgcn_readfirstlane(c.tid >> 6); c.G = gridDim.x; c.bx = blockIdx.x; c.vcu = (c.G % 8 == 0) ? (c.bx % 8) * (c.G / 8) + c.bx / 8 : c.bx; c.lds = (LAS unsigned char*)lds;
    run_kind<KIND>(p, c, p.ph_hi);
}
template <int KIND> static void launch_kind(Params p, int l, int grid, hipStream_t stream) {
    static bool attr = false;
    if (!attr) { (void)hipFuncSetAttribute((const void*)phase_kernel<KIND>, hipFuncAttributeMaxDynamicSharedMemorySize, LDS_BYTES); attr = true; }
    p.ph_lo = 0; p.ph_hi = l;
    hipLaunchKernelGGL(phase_kernel<KIND>, dim3(grid), dim3(512), LDS_BYTES, stream, p);
}

extern "C" void kernel_launch(void* const* d_in, const int* in_sizes, int n_in, void* d_out, int out_size, void* d_ws, size_t ws_size, hipStream_t stream) {
    static int grid = 0;
    if (grid == 0) {
        int dev = 0, cus = 0;
        if (n_in != N_IN || ws_size < WS_NEED) { grid = -1; return; }
        if (hipGetDevice(&dev) != hipSuccess || hipDeviceGetAttribute(&cus, hipDeviceAttributeMultiprocessorCount, dev) != hipSuccess) { grid = -1; return; }
#if N_LAUNCH_MODE == 1
        if (hipFuncSetAttribute((const void*)fwd_kernel, hipFuncAttributeMaxDynamicSharedMemorySize, LDS_BYTES) != hipSuccess) { grid = -1; return; }
#endif
        grid = cus;
    }
    if (grid < 0) return;
    (void)hipMemsetAsync((char*)d_ws + WS_CTL, 0, WS_ZERO_BYTES, stream);
    Params p{};
    for (int i = 0; i < N_IN; ++i) p.in[i] = (const float*)d_in[i];
    p.out = (float*)d_out; p.ws = (unsigned char*)d_ws;
#if N_LAUNCH_MODE == 1
    p.ph_lo = 0; p.ph_hi = NPHASE;
    hipLaunchKernelGGL(fwd_kernel, dim3(grid), dim3(512), LDS_BYTES, stream, p);
#else
    launch_kind<0>(p, 0, grid, stream);
    for (int l = 0; l < 2; ++l) { launch_kind<1>(p, l, grid, stream);
        launch_kind<2>(p, l, grid, stream); launch_kind<3>(p, l, grid, stream); launch_kind<4>(p, l, grid, stream); launch_kind<5>(p, l, grid, stream); launch_kind<6>(p, l, grid, stream);
        launch_kind<7>(p, l, grid, stream); launch_kind<8>(p, l, grid, stream); launch_kind<9>(p, l, grid, stream); launch_kind<10>(p, l, grid, stream); launch_kind<11>(p, l, grid, stream);
    }
#endif
}
```

```cpp
#include <hip/hip_runtime.h>
#include <hip/hip_bf16.h>
#include <cstdio>
#include <cstdint>

#ifndef N_LAUNCH_MODE
#define N_LAUNCH_MODE 1
#endif

#define GAS __attribute__((address_space(1)))
#define LAS __attribute__((address_space(3)))
#define RLX_AGENT __ATOMIC_RELAXED, __HIP_MEMORY_SCOPE_AGENT
typedef unsigned short bf16_t;
typedef short bf16x8 __attribute__((ext_vector_type(8)));
typedef float f32x4 __attribute__((ext_vector_type(4)));
typedef float f32x2 __attribute__((ext_vector_type(2)));
typedef unsigned u32x4 __attribute__((ext_vector_type(4)));
typedef unsigned u32x2 __attribute__((ext_vector_type(2)));

constexpr int DM = 1024, MP = 4096, MS = 16384, M = 20480, SEQ_P = 256, SEQ_S = 2048, NB_P = 16, NB_S = 8, PAST = 256;
constexpr int HD = 64, NH = 8, KVW = 128, DFF = 4096, INW = 6912, NMIX = 3840, NGATE = 3072, RW = 512;
constexpr int SKV_S = PAST + SEQ_S, SKV_P = SEQ_P;
constexpr int NCHUNK = M / 128;
constexpr float EPS = 1e-6f;
constexpr float C2 = 0.18033688011112042f;
constexpr size_t OUT_Y = 0, OUT_CK = (size_t)M * DM, OUT_CV = OUT_CK + (size_t)NB_P * 2 * SEQ_P * KVW, OUT_ST = OUT_CV + (size_t)NB_P * 2 * SEQ_P * KVW;

constexpr size_t MiB = 1u << 20;
constexpr size_t WS_CTL = 0;
constexpr size_t WS_MOD = 1 * MiB;
constexpr size_t WS_ROPE = 1 * MiB + 512 * 1024;
constexpr size_t WS_ZERO_BYTES = 1 * MiB + 512 * 1024;
constexpr size_t WS_W = 2 * MiB;
constexpr size_t W_IN = 0, W_BR = W_IN + (size_t)INW * DM * 2, W_OUT = W_BR + (size_t)3 * DM * RW * 2, W_FF1 = W_OUT + (size_t)DM * DM * 2, W_FF2 = W_FF1 + (size_t)DFF * DM * 2, W_END = W_FF2 + (size_t)DM * DFF * 2;
static_assert(W_END <= 35 * MiB, "weights");
constexpr size_t WS_XN = 37 * MiB;
constexpr size_t WS_Z = 77 * MiB;
constexpr size_t Z_RQ = WS_Z, Z_RK = WS_Z + 20 * MiB, Z_RV = WS_Z + 40 * MiB, Z_RG = WS_Z + 60 * MiB, Z_U = WS_Z + 80 * MiB;
constexpr size_t Z_AQ = WS_Z + 120 * MiB, Z_CU = WS_Z + 140 * MiB, Z_CV = WS_Z + 160 * MiB;
constexpr size_t Z_KS = WS_Z + 180 * MiB, Z_VS = Z_KS + (size_t)NB_S * SKV_S * KVW * 2, Z_KP = Z_VS + (size_t)NB_S * SKV_S * KVW * 2, Z_VP = Z_KP + (size_t)NB_P * SEQ_P * KVW * 2, Z_END = Z_VP + (size_t)NB_P * SEQ_P * KVW * 2;
constexpr size_t Z_GATE = WS_Z;
constexpr size_t Z_HB = WS_Z;
constexpr size_t SLAB_P4 = WS_Z, SLAB_P6 = WS_XN;
constexpr size_t WS_NEED = 268 * MiB;
static_assert(Z_END <= WS_NEED, "ws map");
constexpr int CW_BAR = 4096;

constexpr int LDS_BYTES = 147456;
constexpr int MISC_OFF = 131072 + 320;

__host__ __device__ __forceinline__ size_t rlay(int h, size_t R) { return R * RW + (size_t)h * HD; }
__device__ __forceinline__ unsigned f2bf(float f) { unsigned u = __builtin_bit_cast(unsigned, f); return (u + 0x7fffu + ((u >> 16) & 1u)) >> 16; }
typedef __bf16 bf16x2_hw __attribute__((ext_vector_type(2)));
__device__ __forceinline__ unsigned pk2(float lo, float hi) { const f32x2 v = {lo, hi}; return __builtin_bit_cast(unsigned, __builtin_convertvector(v, bf16x2_hw)); }
__device__ __forceinline__ float bf2f(unsigned h) { return __builtin_bit_cast(float, h << 16); }
__device__ __forceinline__ float bflo(unsigned w) { return __builtin_bit_cast(float, w << 16); }
__device__ __forceinline__ float bfhi(unsigned w) { return __builtin_bit_cast(float, w & 0xffff0000u); }
__device__ __forceinline__ float sigmoidf_(float x) { return __builtin_amdgcn_rcpf(1.f + __builtin_amdgcn_exp2f(-1.4426950408889634f * x)); }
__device__ __forceinline__ float siluf_(float x) { return x * sigmoidf_(x); }
__device__ __forceinline__ float gelu_tanh(float x) { const float x2 = x * x; const float t = x * (-2.302208198f - 0.1029432397f * x2);
    return x * __builtin_amdgcn_rcpf(1.f + __builtin_amdgcn_exp2f(t)); }
__device__ __forceinline__ float wave_sum(float v) {
#pragma unroll
    for (int o = 1; o < 64; o <<= 1) v += __shfl_xor(v, o);
    return v;
}

#define XB_TMO      128
#define XB_XCNT(j)  (256  + 64 * (j))
#define XB_XSUB(j)  (1280 + 64 * (j))
#define XB_XGEN(j)  (2304 + 64 * (j))
#define XB_TOP      3328
#define XB_TOPGEN   3392
#define XCD_BAR_WORDS 3456
#define XB_SPIN_CAP (1u << 18)
__device__ __forceinline__ unsigned xb_ld(unsigned* p)              { return __hip_atomic_load(p, __ATOMIC_RELAXED, __HIP_MEMORY_SCOPE_AGENT); }
__device__ __forceinline__ unsigned xb_add(unsigned* p, unsigned v) { return __hip_atomic_fetch_add(p, v, __ATOMIC_RELAXED, __HIP_MEMORY_SCOPE_AGENT); }
__device__ __forceinline__ unsigned xb_xcc_id() { return (unsigned)__builtin_amdgcn_s_getreg((3 << 11) | 20) & 0xFu; }
#define XB_SPIN(cond, bar) do { unsigned _sp = 0; while (cond) { __builtin_amdgcn_s_sleep(1); \
    if ((++_sp & 255u) == 0u) { if (xb_ld(&(bar)[XB_TMO])) break; if (_sp > XB_SPIN_CAP) { atomicAdd(&(bar)[XB_TMO], 1u); break; } } } } while (0)
struct XcdBarrier { unsigned* bar; unsigned x; volatile LAS unsigned* st; };
__device__ __forceinline__ XcdBarrier xcd_barrier_post(unsigned* bar, volatile LAS unsigned* st) {
    XcdBarrier b; b.bar = bar; b.x = xb_xcc_id(); b.st = st;
    if (threadIdx.x == 0) (void)xb_add(&bar[XB_XCNT(b.x)], 1u);
    return b;
}
__device__ __forceinline__ void xcd_barrier_complete(unsigned* bar, unsigned x, unsigned& nloc, unsigned& nx) {
    const unsigned G = gridDim.x * gridDim.y * gridDim.z;
    unsigned sum, cnt, mine, sp = 0u;
    for (;;) {
        sum = 0u; cnt = 0u; mine = 0u;
#pragma unroll
        for (unsigned j = 0; j < 16; ++j) { const unsigned c = xb_ld(&bar[XB_XCNT(j)]); sum += c; cnt += (c > 0u) ? 1u : 0u; mine = (j == x) ? c : mine; }
        if (sum == G) break;
        __builtin_amdgcn_s_sleep(1);
        if ((++sp & 255u) == 0u) { if (xb_ld(&bar[XB_TMO])) break; if (sp > XB_SPIN_CAP) { atomicAdd(&bar[XB_TMO], 1u); break; } }
    }
    nloc = mine > 0u ? mine : 1u; nx = cnt > 0u ? cnt : 1u;
}
__device__ __forceinline__ void xcd_barrier(const XcdBarrier& b) {
    asm volatile("s_waitcnt vmcnt(0)" ::: "memory");
    __syncthreads();
    if (threadIdx.x == 0) {
        unsigned* bar = b.bar;
        __builtin_amdgcn_s_waitcnt(0);
        unsigned nloc = b.st[0], nx = b.st[1];
        if (nloc == 0u) { xcd_barrier_complete(bar, b.x, nloc, nx); b.st[0] = nloc; b.st[1] = nx; }
        const unsigned old = xb_add(&bar[XB_XSUB(b.x)], 1u);
        const unsigned gen = old / nloc;
        if (old + 1u == (gen + 1u) * nloc) {
            __builtin_amdgcn_fence(__ATOMIC_RELEASE, "agent");
            asm volatile("s_waitcnt vmcnt(0)" ::: "memory");
            const unsigned og = xb_add(&bar[XB_TOP], 1u);
            const unsigned tg = og / nx;
            if (og + 1u == (tg + 1u) * nx) xb_add(&bar[XB_TOPGEN], 1u);
            else XB_SPIN(xb_ld(&bar[XB_TOPGEN]) == tg, bar);
            __builtin_amdgcn_fence(__ATOMIC_ACQUIRE, "agent");
            xb_add(&bar[XB_XGEN(b.x)], 1u);
            asm volatile("s_waitcnt vmcnt(0)" ::: "memory");
        } else {
            XB_SPIN(xb_ld(&bar[XB_XGEN(b.x)]) == gen, bar);
            __builtin_amdgcn_fence(__ATOMIC_ACQUIRE, "agent");
            asm volatile("s_waitcnt vmcnt(0)" ::: "memory");
        }
    }
    __syncthreads();
}

enum { I_XP = 0, I_XS, I_CK, I_CV, I_ST, I_C, I_CCTX, I_WMOD, I_BMOD, I_GN1, I_GN2, I_WIN, I_GQ, I_GK, I_DECAY, I_RETGN, I_CMNORM, I_CMWS, I_CMBS, I_WBRR, I_WBRA, I_WBRC, I_WOUT, I_WFF1, I_WFF2, I_GFIN, N_IN };
struct Params { const float* in[N_IN]; float* out; unsigned char* ws; int ph_lo, ph_hi; };
static_assert(sizeof(Params) == N_IN * 8 + 8 + 8 + 8, "no padding");

struct Ctx {
    int tid, lane, wave, G, bx, vcu;
    LAS unsigned char* lds;
};
__device__ __forceinline__ int row_ci(int R) { return R < MP ? 0 : 1 + ((R - MP) >> 11); }
__device__ __forceinline__ const float* mod_ptr(const Params& p, int l, int ci, int part) { return (const float*)(p.ws + WS_MOD) + ((size_t)(l * 9 + ci) * 6 + part) * DM; }

__device__ __forceinline__ void p0_modulation(const Params& p, const Ctx& c) {
    LAS float* sl = (LAS float*)c.lds;
    for (int i = c.tid; i < 9 * DM; i += 512) { const int ci = i >> 10, k = i & 1023; const float v = ci == 0 ? p.in[I_CCTX][k] : p.in[I_C][(ci - 1) * DM + k]; sl[i] = siluf_(v); }
    __syncthreads();
    float* mod = (float*)(p.ws + WS_MOD);
    const int gw = c.bx * 8 + c.wave, NGW = c.G * 8;
    constexpr int NITEM = 2 * 96 * 8;
    for (int it = gw; it < NITEM; it += NGW) {
        const int l = it / 768, r = it % 768, cb = r >> 3, ks = r & 7;
        const float* W = p.in[I_WMOD] + (size_t)l * DM * 6144 + (size_t)(ks * 128) * 6144 + cb * 64 + c.lane;
        float s[9];
#pragma unroll
        for (int ci = 0; ci < 9; ++ci) s[ci] = 0.f;
#pragma unroll 4
        for (int k = 0; k < 128; ++k) {
            const float w = W[(size_t)k * 6144];
#pragma unroll
            for (int ci = 0; ci < 9; ++ci) s[ci] += sl[ci * DM + ks * 128 + k] * w;
        }
        const float bias = ks == 0 ? p.in[I_BMOD][l * 6144 + cb * 64 + c.lane] : 0.f;
#pragma unroll
        for (int ci = 0; ci < 9; ++ci) atomicAdd(mod + (size_t)(l * 9 + ci) * 6144 + cb * 64 + c.lane, s[ci] + bias);
    }
    __syncthreads();
}
__device__ __forceinline__ void p0_rope_tables(const Params& p, const Ctx& c) {
    f32x2* tab = (f32x2*)(p.ws + WS_ROPE);
    const int g = c.bx * 512 + c.tid;
    if (g < 96 * 16) { const int pos = g >> 4, i = g & 15; const float inv = 1.0f / powf(10000.0f, (float)(2 * i) / 32.0f); const float posf = pos < 32 ? (float)pos : (float)(pos - 32);
        const float ang = posf * inv; f32x2 v; v.x = cosf(ang); v.y = sinf(ang); tab[g] = v; }
}
__device__ __forceinline__ int win_colmap(int n) {
    const int tile = n >> 8, pp = n & 255, bj = pp >> 7, wc = (pp >> 5) & 3;
    if (tile < 10) return (tile >> 1) * 512 + ((tile & 1) * 4 + wc) * 64 + 32 * bj;
    if (tile == 10) return (wc < 2 ? 2560 + wc * 64 : 2688 + (wc - 2) * 64) + 32 * bj;
    return n;
}
__device__ __forceinline__ void transpose_item(const float* W, int K, int ldn, int src_col0, bf16_t* WT, int dst_row0, int k0, LAS float* scr, int lane) {
#pragma unroll 8
    for (int i = 0; i < 32; ++i) { const int kk = 2 * i + (lane >> 5); scr[kk * 33 + (lane & 31)] = W[(size_t)(k0 + kk) * ldn + src_col0 + (lane & 31)]; }
    asm volatile("s_waitcnt lgkmcnt(0)" ::: "memory");
    const int ch = lane & 7;
#pragma unroll
    for (int j = 0; j < 4; ++j) { const int n = (lane >> 3) + 8 * j; const LAS float* s = scr + (8 * ch) * 33 + n;
        u32x4 o; o.x = pk2(s[0 * 33], s[1 * 33]); o.y = pk2(s[2 * 33], s[3 * 33]); o.z = pk2(s[4 * 33], s[5 * 33]); o.w = pk2(s[6 * 33], s[7 * 33]);
        *(u32x4*)(WT + (size_t)(dst_row0 + n) * K + k0 + 8 * ch) = o; }
    asm volatile("s_waitcnt lgkmcnt(0)" ::: "memory");
}
__device__ __forceinline__ void p_wconv(const Params& p, const Ctx& c, int l) {
    LAS float* scr = (LAS float*)(c.lds + 40960 + c.wave * 8448);
    const int gw = c.bx * 8 + c.wave, NGW = c.G * 8;
    unsigned char* wb = p.ws + WS_W;
    constexpr int I_IN = 16 * 216, I_BRX = 8 * 32, I_O = 16 * 32, I_F1 = 16 * 128, I_F2 = 64 * 32;
    constexpr int NITEMS = I_IN + 3 * I_BRX + I_O + I_F1 + I_F2;
    for (int it = gw; it < NITEMS; it += NGW) {
        int r = it;
        if (r < I_IN) { const int kb = r / 216, nb = r % 216; transpose_item(p.in[I_WIN] + (size_t)l * DM * INW, DM, INW, win_colmap(nb * 32), (bf16_t*)(wb + W_IN), nb * 32, kb * 64, scr, c.lane); continue; } r -= I_IN;
        if (r < 3 * I_BRX) { const int x = r / I_BRX, rr = r % I_BRX, kb = rr / 32, nb = rr % 32;
            const float* src = (x == 0 ? p.in[I_WBRA] : x == 1 ? p.in[I_WBRC] : p.in[I_WBRR]) + (size_t)l * RW * DM;
            transpose_item(src, RW, DM, nb * 32, (bf16_t*)(wb + W_BR) + (size_t)x * DM * RW, nb * 32, kb * 64, scr, c.lane); continue; } r -= 3 * I_BRX;
        if (r < I_O) { const int kb = r / 32, nb = r % 32; transpose_item(p.in[I_WOUT] + (size_t)l * DM * DM, DM, DM, nb * 32, (bf16_t*)(wb + W_OUT), nb * 32, kb * 64, scr, c.lane); continue; } r -= I_O;
        if (r < I_F1) { const int kb = r / 128, nb = r % 128; transpose_item(p.in[I_WFF1] + (size_t)l * DM * DFF, DM, DFF, nb * 32, (bf16_t*)(wb + W_FF1), nb * 32, kb * 64, scr, c.lane); continue; } r -= I_F1;
        { const int kb = r / 32, nb = r % 32; transpose_item(p.in[I_WFF2] + (size_t)l * DFF * DM, DFF, DM, nb * 32, (bf16_t*)(wb + W_FF2), nb * 32, kb * 64, scr, c.lane); }
    }
}
__device__ __forceinline__ void p_kvctx(const Params& p, const Ctx& c, int l) {
    const int g = c.bx * 512 + c.tid, NG = c.G * 512;
    for (int i = g; i < NB_S * PAST * KVW / 4; i += NG) {
        const int e = i * 4, b = e / (PAST * KVW), r = e % (PAST * KVW);
        const size_t src = ((size_t)(b * 2 + l) * PAST) * KVW + r;
        const f32x4 k = *(const f32x4*)(p.in[I_CK] + src), v = *(const f32x4*)(p.in[I_CV] + src);
        u32x2 ko, vo; ko.x = pk2(k.x, k.y); ko.y = pk2(k.z, k.w); vo.x = pk2(v.x, v.y); vo.y = pk2(v.z, v.w);
        *(u32x2*)((bf16_t*)(p.ws + Z_KS) + (size_t)b * SKV_S * KVW + r) = ko;
        *(u32x2*)((bf16_t*)(p.ws + Z_VS) + (size_t)b * SKV_S * KVW + r) = vo;
    }
}
__device__ __forceinline__ const float* x_row(const Params& p, int l, int R) { return l == 0 ? (R < MP ? p.in[I_XP] + (size_t)R * DM : p.in[I_XS] + (size_t)(R - MP) * DM) : p.out + (size_t)R * DM; }
__device__ __forceinline__ void slab_combine(const Params& p, const Ctx& c, int l, int part, const bf16_t* slab, int R, f32x4 (&v)[4]) {
    const float* gv = mod_ptr(p, l, row_ci(R), part);
#pragma unroll
    for (int j = 0; j < 4; ++j) { const bf16_t* s = slab + ((size_t)(((R >> 8) - 64) * 4 + j) * 4 * 256 + (R & 255)) * 256 + 4 * c.lane; f32x4 a = (f32x4){0.f, 0.f, 0.f, 0.f};
#pragma unroll
        for (int q = 0; q < 4; ++q) { const u32x2 w = *(const u32x2*)(s + (size_t)q * 65536); a.x += bflo(w.x); a.y += bfhi(w.x); a.z += bflo(w.y); a.w += bfhi(w.y); }
        v[j] = v[j] + *(const f32x4*)(gv + 4 * c.lane + 256 * j) * a; }
}
__device__ __forceinline__ void p_combine(const Params& p, const Ctx& c, int l, const bf16_t* slab) {
    const int gw = c.bx * 8 + c.wave, NGW = c.G * 8;
    for (int R = 16384 + gw; R < M; R += NGW) {
        float* xr = p.out + (size_t)R * DM; f32x4 v[4];
#pragma unroll
        for (int j = 0; j < 4; ++j) v[j] = *(const f32x4*)(xr + 4 * c.lane + 256 * j);
        slab_combine(p, c, l, 5, slab, R, v);
#pragma unroll
        for (int j = 0; j < 4; ++j) *(f32x4*)(xr + 4 * c.lane + 256 * j) = v[j];
    }
}
__device__ __forceinline__ void p_norm(const Params& p, const Ctx& c, int l, int which, bool comb = false) {
    const int gw = c.bx * 8 + c.wave, NGW = c.G * 8;
    const float* gvec = (which == 0 ? p.in[I_GN1] : p.in[I_GN2]) + l * DM;
    constexpr int NR = 2;
    for (int Rb = gw * NR; Rb < M; Rb += NGW * NR) {
        f32x4 v[NR][4]; float s[NR];
#pragma unroll
        for (int rr = 0; rr < NR; ++rr) { const int R = Rb + rr;
            const float* xr = (which == 0 || (comb && l == 0 && R >= 16384)) ? x_row(p, l, R) : p.out + (size_t)R * DM;
#pragma unroll
            for (int j = 0; j < 4; ++j) v[rr][j] = *(const f32x4*)(xr + 4 * c.lane + 256 * j); }
        if (comb && Rb >= 16384) {
#pragma unroll
            for (int rr = 0; rr < NR; ++rr) { const int R = Rb + rr; slab_combine(p, c, l, 2, (const bf16_t*)(p.ws + SLAB_P4), R, v[rr]);
#pragma unroll
                for (int j = 0; j < 4; ++j) *(f32x4*)(p.out + (size_t)R * DM + 4 * c.lane + 256 * j) = v[rr][j]; } }
#pragma unroll
        for (int rr = 0; rr < NR; ++rr) { s[rr] = 0.f;
#pragma unroll
            for (int j = 0; j < 4; ++j) s[rr] += (v[rr][j].x * v[rr][j].x + v[rr][j].y * v[rr][j].y) + (v[rr][j].z * v[rr][j].z + v[rr][j].w * v[rr][j].w); }
#pragma unroll
        for (int o = 1; o < 64; o <<= 1) {
#pragma unroll
            for (int rr = 0; rr < NR; ++rr) s[rr] += __shfl_xor(s[rr], o); }
#pragma unroll
        for (int rr = 0; rr < NR; ++rr) { const int R = Rb + rr; const int ci = row_ci(R);
            const float* sh = mod_ptr(p, l, ci, which == 0 ? 0 : 3); const float* sc = mod_ptr(p, l, ci, which == 0 ? 1 : 4);
            const float rstd = rsqrtf(s[rr] * (1.f / DM) + EPS);
            bf16_t* orow = (bf16_t*)(p.ws + WS_XN) + (size_t)R * DM;
#pragma unroll
            for (int j = 0; j < 4; ++j) { const int col = 4 * c.lane + 256 * j; const f32x4 g = *(const f32x4*)(gvec + col), a = *(const f32x4*)(sc + col), b2 = *(const f32x4*)(sh + col);
                f32x4 o = v[rr][j] * rstd * g * (a + 1.0f) + b2; u32x2 w; w.x = pk2(o.x, o.y); w.y = pk2(o.z, o.w); *(u32x2*)(orow + col) = w; } }
    }
}
__device__ __forceinline__ void p_final_norm(const Params& p, const Ctx& c, bool comb) {
    const int gw = c.bx * 8 + c.wave, NGW = c.G * 8;
    constexpr int NR = 2;
    for (int Rb = gw * NR; Rb < M; Rb += NGW * NR) {
        f32x4 v[NR][4]; float s[NR];
#pragma unroll
        for (int rr = 0; rr < NR; ++rr) { const float* xr = p.out + (size_t)(Rb + rr) * DM;
#pragma unroll
            for (int j = 0; j < 4; ++j) v[rr][j] = *(const f32x4*)(xr + 4 * c.lane + 256 * j); }
        if (comb && Rb >= 16384) {
#pragma unroll
            for (int rr = 0; rr < NR; ++rr) slab_combine(p, c, 1, 5, (const bf16_t*)(p.ws + SLAB_P6), Rb + rr, v[rr]); }
#pragma unroll
        for (int rr = 0; rr < NR; ++rr) { s[rr] = 0.f;
#pragma unroll
            for (int j = 0; j < 4; ++j) s[rr] += (v[rr][j].x * v[rr][j].x + v[rr][j].y * v[rr][j].y) + (v[rr][j].z * v[rr][j].z + v[rr][j].w * v[rr][j].w); }
#pragma unroll
        for (int o = 1; o < 64; o <<= 1) {
#pragma unroll
            for (int rr = 0; rr < NR; ++rr) s[rr] += __shfl_xor(s[rr], o); }
#pragma unroll
        for (int rr = 0; rr < NR; ++rr) { float* xr = p.out + (size_t)(Rb + rr) * DM; const float rstd = rsqrtf(s[rr] * (1.f / DM) + EPS);
#pragma unroll
            for (int j = 0; j < 4; ++j) { const int col = 4 * c.lane + 256 * j; const f32x4 g = *(const f32x4*)(p.in[I_GFIN] + col); *(f32x4*)(xr + col) = v[rr][j] * rstd * g; } }
    }
}

struct Unit { int pm, pn, k0, nt; };
__host__ __device__ __forceinline__ int perm32(int rho) { const int n = rho >> 4, i = rho & 15; return 8 * (i >> 2) + 4 * n + (i & 3); }
#ifndef WGM_
#define WGM_ 8
#endif
struct StaticOrder {
    int nM, nN, nwg, G, c, ntf;
    __device__ void init(int Mr, int N, int G_, int c_, int K) { nM = Mr / 256; nN = N / 256; nwg = nM * nN; G = G_; c = c_; ntf = K / 64; }
    __device__ bool next(int i, Unit& u) const {
        const long L = (long)i * G + c; if (L >= nwg) return false;
        int wgid = (int)L; { const int q = nwg / 8, r = nwg % 8, xcd = wgid % 8, off = wgid / 8; wgid = (xcd < r ? xcd * (q + 1) : r * (q + 1) + (xcd - r) * q) + off; }
        const int nig = WGM_ * nN, gid = wgid / nig, fm = gid * WGM_, gsz = (nM - fm) < WGM_ ? (nM - fm) : WGM_;
        u.pm = fm + ((wgid % nig) % gsz); u.pn = (wgid % nig) / gsz; u.k0 = 0; u.nt = ntf; return true;
    }
    __device__ __forceinline__ void a_ready(const Unit&) const {}
    __device__ __forceinline__ void done(const Unit&) const {}
};
struct MergeOrder {
    int G, c;
    __device__ bool next(int i, Unit& u) const {
        const int t = i / 3, x = i % 3; long L = (long)t * G + c;
        if (G == 256 && t == 1) { if (c & 3) return false; L = 256 + (c >> 2); }
        if (L >= 320) return false;
        u.pm = x * 80 + (int)(L >> 2); u.pn = x * 4 + (int)(L & 3); u.k0 = 0; u.nt = RW / 64; return true;
    }
    __device__ __forceinline__ void a_ready(const Unit&) const {}
    __device__ __forceinline__ void done(const Unit&) const {}
};
#ifndef QSTAG
#define QSTAG 0
#endif
struct QuarterOrder {
    int G, c, ntf; bool quarter;
    __device__ void init(int G_, int c_, int K) { G = G_; c = (G_ % 8 == 0) ? (c_ % 8) * (G_ / 8) + c_ / 8 : c_; ntf = K / 64; quarter = (G_ == 256); }
    __device__ bool next(int i, Unit& u) const {
        if (quarter) { if (i > 1) return false;
            const bool full = QSTAG ? ((i == 0) != (((c >> 2) & 1) != 0)) : (i == 0);
            if (full) { u.pm = c >> 2; u.pn = c & 3; u.k0 = 0; u.nt = ntf; return true; }
            const int t = 256 + (c >> 2); u.pm = t >> 2; u.pn = t & 3; u.k0 = (c & 3) * (ntf >> 2); u.nt = ntf >> 2; return true; }
        const long L = (long)i * G + c; if (L >= 320) return false;
        u.pm = (int)(L >> 2); u.pn = (int)(L & 3); u.k0 = 0; u.nt = ntf; return true;
    }
    __device__ __forceinline__ void a_ready(const Unit&) const {}
    __device__ __forceinline__ void done(const Unit&) const {}
};
template <class Epi, class Sched>
__device__ __forceinline__ void gemm_simple(const Ctx& c, const bf16_t* A, const bf16_t* Bt, int K, const Sched& S, const Epi& E) {
    const int tid = c.tid, wid = c.wave, lane = tid & 63, wr = wid >> 2, wc = wid & 3, fr = lane & 15, fq = lane >> 4;
    Unit u; bool clear = true;
    f32x4 acc[2][2][4][2];
    for (int ui = 0; S.next(ui, u); ++ui) {
        if (clear) {
#pragma unroll
        for (int a = 0; a < 2; ++a)
#pragma unroll
            for (int b = 0; b < 2; ++b)
#pragma unroll
                for (int m = 0; m < 4; ++m)
#pragma unroll
                    for (int n = 0; n < 2; ++n) acc[a][b][m][n] = (f32x4){0.f, 0.f, 0.f, 0.f};
        }
        if constexpr (Epi::CHAIN) clear = !E.keep(u);
        const bf16_t* Ar = A + (size_t)(u.pm * 256 + wr * 64 + fr) * K + fq * 8;
        const bf16_t* Br[2];
#pragma unroll
        for (int n = 0; n < 2; ++n) Br[n] = Bt + (size_t)(u.pn * 256 + wc * 32 + (Epi::PERM ? perm32(16 * n + fr) : 16 * n + fr)) * K + fq * 8;
#pragma unroll 1
        for (int k0 = u.k0 * 64; k0 < (u.k0 + u.nt) * 64; k0 += 32) {
            bf16x8 tf[2][4], wf[2][2];
#pragma unroll
            for (int ai = 0; ai < 2; ++ai)
#pragma unroll
                for (int m = 0; m < 4; ++m) tf[ai][m] = *(const bf16x8*)(Ar + (size_t)(ai * 128 + m * 16) * K + k0);
#pragma unroll
            for (int bj = 0; bj < 2; ++bj)
#pragma unroll
                for (int n = 0; n < 2; ++n) wf[bj][n] = *(const bf16x8*)(Br[n] + (size_t)(bj * 128) * K + k0);
#pragma unroll
            for (int ai = 0; ai < 2; ++ai)
#pragma unroll
                for (int bj = 0; bj < 2; ++bj)
#pragma unroll
                    for (int m = 0; m < 4; ++m)
#pragma unroll
                        for (int n = 0; n < 2; ++n) acc[ai][bj][m][n] = __builtin_amdgcn_mfma_f32_16x16x32_bf16(wf[bj][n], tf[ai][m], acc[ai][bj][m][n], 0, 0, 0);
        }
        E(acc, u, wr, wc, fr, fq);
    }
}

namespace pg8 {
#define PG8_LAS __attribute__((address_space(3)))
constexpr int BM = 256, BK = 64, HALF = 128, HTB = HALF * BK * 2  , STAGE_BYTES = 8 * HTB, NXCD = 8, WGM = 8;

__host__ __device__ __forceinline__ int lds_byte(int r, int c) { const int st = (r >> 4) * 2 + (c >> 5), rr = r & 15, cc = c & 31, ob = rr * 64 + cc * 2; return st * 1024 + (ob ^ (((ob >> 9) & 1) << 5)); }
__host__ __device__ __forceinline__ void stage_rc(int b, int& R, int& C) { const int st = b / 1024, sb = b % 1024, swz = sb ^ (((sb >> 9) & 1) << 5); R = (st >> 1) * 16 + swz / 64; C = (st & 1) * 32 + (swz % 64) / 2; }
struct Gemm { const bf16_t* A; const bf16_t* Bt; int M, N, K; unsigned long long* ts; };
#define PG8_STAMP(k) do { if (g.ts && blockIdx.x == 0 && tid == 0) g.ts[k] = __builtin_amdgcn_s_memrealtime(); } while (0)
template <class Epi, class Sched, bool ALIGN_EPI = false, bool SP2 = false>
__device__ __forceinline__ void gemm_phase(int tid_in, PG8_LAS unsigned char* lds, const Gemm g, const Sched& S, const Epi& E) {
    const int tid = tid_in, wid = __builtin_amdgcn_readfirstlane(tid >> 6), lane = tid & 63, wr = wid >> 2, wc = wid & 3, fr = lane & 15, fq = lane >> 4;
    const int K = g.K;
    unsigned voffA[2], voffB[2];
#pragma unroll
    for (int i = 0; i < 2; ++i) { int R, C; stage_rc(tid * 16 + i * 8192, R, C); const int Rb = Epi::PERM ? ((R & ~31) + perm32(R & 31)) : R;
        voffA[i] = (unsigned)(R * K + C) * 2u; voffB[i] = (unsigned)(Rb * K + C) * 2u; }
    const size_t kstep = (size_t)(BK * 2);
    const size_t hstep = (size_t)HALF * K * 2;
    const size_t tstep = 2 * hstep;
    const unsigned ldsw = (unsigned)wid * 1024u;
    const int aoff = lds_byte(wr * 64 + fr, fq * 8), boff = lds_byte(wc * 32 + fr, fq * 8);
#define PG8_SA(b, h) (((b) * 2 + (h)) * HTB)
#define PG8_SB(b, h) ((4 + (b) * 2 + (h)) * HTB)
#define PG8_STAGE(bufoff, gbase, voff) do { _Pragma("unroll") for (int _i = 0; _i < 2; ++_i) \
        __builtin_amdgcn_global_load_lds((const unsigned*)((const char*)(gbase) + (voff)[_i]), (PG8_LAS unsigned*)(lds + (bufoff) + ldsw + _i * 8192), 16, 0, 0); } while (0)
#define PG8_LDA(dst, b, h) do { _Pragma("unroll") for (int m = 0; m < 4; ++m) _Pragma("unroll") for (int k = 0; k < 2; ++k) dst[m][k] = *(const PG8_LAS bf16x8*)(lds + PG8_SA(b, h) + aoff + m * 2048 + k * 1024); } while (0)
#define PG8_LDB(dst, b, h) do { _Pragma("unroll") for (int n = 0; n < 2; ++n) _Pragma("unroll") for (int k = 0; k < 2; ++k) dst[n][k] = *(const PG8_LAS bf16x8*)(lds + PG8_SB(b, h) + boff + n * 2048 + k * 1024); } while (0)
#define PG8_MMA(ai, bj, At, Bt) do { __builtin_amdgcn_s_setprio(1); _Pragma("unroll") for (int m = 0; m < 4; ++m) _Pragma("unroll") for (int n = 0; n < 2; ++n) _Pragma("unroll") for (int k = 0; k < 2; ++k) \
        acc[ai][bj][m][n] = __builtin_amdgcn_mfma_f32_16x16x32_bf16(Bt[n][k], At[m][k], acc[ai][bj][m][n], 0, 0, 0); __builtin_amdgcn_s_setprio(0); } while (0)
#define PG8_WAIT_V(n) asm volatile("s_waitcnt vmcnt(" #n ")" ::: "memory")
#define PG8_WAIT_L(n) asm volatile("s_waitcnt lgkmcnt(" #n ")" ::: "memory")
#define PG8_BAR __builtin_amdgcn_s_barrier()
#define PG8_SCHED __builtin_amdgcn_sched_barrier(0)
    Unit cur, nxt; int ui = 0;
    PG8_STAMP(42);
    if (!S.next(0, cur)) return;
    f32x4 acc[2][2][4][2];
#pragma unroll
    for (int a = 0; a < 2; ++a)
#pragma unroll
        for (int b = 0; b < 2; ++b)
#pragma unroll
            for (int m = 0; m < 4; ++m)
#pragma unroll
                for (int n = 0; n < 2; ++n) acc[a][b][m][n] = (f32x4){0.f, 0.f, 0.f, 0.f};
    bf16x8 At[4][2], B0[2][2], B1[2][2];
    const char* cA = (const char*)g.A + (size_t)cur.pm * tstep + (size_t)cur.k0 * kstep; const char* cB = (const char*)g.Bt + (size_t)cur.pn * tstep + (size_t)cur.k0 * kstep;
    S.a_ready(cur);
    if constexpr (SP2) {
        PG8_STAGE(PG8_SB(0, 0), cB, voffB); PG8_STAGE(PG8_SB(0, 1), cB + hstep, voffB); PG8_STAGE(PG8_SA(0, 0), cA, voffA); PG8_STAGE(PG8_SA(0, 1), cA + hstep, voffA);
        if (wr == 1) PG8_BAR;
        PG8_WAIT_V(2); PG8_BAR;
        PG8_STAGE(PG8_SB(1, 0), cB + kstep, voffB); PG8_STAGE(PG8_SA(1, 0), cA + kstep, voffA); PG8_STAGE(PG8_SB(1, 1), cB + hstep + kstep, voffB);
        PG8_WAIT_V(6); PG8_BAR;
    } else {
        PG8_STAGE(PG8_SB(0, 0), cB, voffB); PG8_STAGE(PG8_SA(0, 0), cA, voffA); PG8_STAGE(PG8_SB(0, 1), cB + hstep, voffB); PG8_STAGE(PG8_SA(0, 1), cA + hstep, voffA);
        if (wr == 1) PG8_BAR;
        PG8_WAIT_V(4); PG8_BAR;
        PG8_STAGE(PG8_SB(1, 0), cB + kstep, voffB); PG8_STAGE(PG8_SA(1, 0), cA + kstep, voffA); PG8_STAGE(PG8_SB(1, 1), cB + hstep + kstep, voffB);
        PG8_WAIT_V(6); PG8_BAR;
    }
    PG8_STAMP(43);
    for (;;) {
        const bool has_next = S.next(ui + 1, nxt);
        const char* nA = has_next ? (const char*)g.A + (size_t)nxt.pm * tstep + (size_t)nxt.k0 * kstep : cA; const char* nB = has_next ? (const char*)g.Bt + (size_t)nxt.pn * tstep + (size_t)nxt.k0 * kstep : cB;
        const int nt = cur.nt;
        for (int t = 0; t < nt; t += 2) {
            const bool last = (t == nt - 2);
            const char* a1 = cA + (size_t)(t + 1) * kstep;
            const char* a2 = last ? nA : cA + (size_t)(t + 2) * kstep; const char* b2 = last ? nB : cB + (size_t)(t + 2) * kstep;
            const char* a3 = a2 + kstep; const char* b3 = b2 + kstep;
            if (last && has_next) S.a_ready(nxt);
            if constexpr (SP2) {
            PG8_LDB(B0, 0, 0); PG8_LDB(B1, 0, 1); PG8_SCHED; PG8_LDA(At, 0, 0); PG8_STAGE(PG8_SA(1, 1), a1 + hstep, voffA);
            PG8_WAIT_V(8); PG8_WAIT_L(0); PG8_BAR; PG8_MMA(0, 0, At, B0); PG8_MMA(0, 1, At, B1); PG8_BAR; PG8_SCHED;
            PG8_LDA(At, 0, 1); PG8_STAGE(PG8_SB(0, 0), b2, voffB); PG8_STAGE(PG8_SB(0, 1), b2 + hstep, voffB); PG8_STAGE(PG8_SA(0, 0), a2, voffA);
            PG8_WAIT_V(8); PG8_WAIT_L(0); PG8_BAR; PG8_MMA(1, 0, At, B0); PG8_MMA(1, 1, At, B1); PG8_BAR; PG8_SCHED;
            PG8_LDB(B0, 1, 0); PG8_LDB(B1, 1, 1); PG8_SCHED; PG8_LDA(At, 1, 0); PG8_STAGE(PG8_SA(0, 1), a2 + hstep, voffA);
            PG8_WAIT_V(8); PG8_WAIT_L(0); PG8_BAR; PG8_MMA(0, 0, At, B0); PG8_MMA(0, 1, At, B1); PG8_BAR; PG8_SCHED;
            PG8_LDA(At, 1, 1); PG8_STAGE(PG8_SB(1, 0), b3, voffB); PG8_STAGE(PG8_SB(1, 1), b3 + hstep, voffB); PG8_STAGE(PG8_SA(1, 0), a3, voffA);
            PG8_WAIT_V(8); PG8_WAIT_L(0); PG8_BAR; PG8_MMA(1, 0, At, B0); PG8_MMA(1, 1, At, B1); PG8_BAR; PG8_SCHED;
            } else {
            PG8_LDB(B0, 0, 0); PG8_SCHED; PG8_LDA(At, 0, 0); PG8_STAGE(PG8_SA(1, 1), a1 + hstep, voffA);
            PG8_WAIT_L(8); PG8_BAR; PG8_WAIT_L(0); PG8_MMA(0, 0, At, B0); PG8_BAR; PG8_SCHED;
            PG8_LDB(B1, 0, 1); PG8_STAGE(PG8_SB(0, 0), b2, voffB);
            PG8_BAR; PG8_WAIT_L(0); PG8_MMA(0, 1, At, B1); PG8_BAR;
            PG8_LDA(At, 0, 1); PG8_STAGE(PG8_SA(0, 0), a2, voffA);
            PG8_BAR; PG8_WAIT_L(0); PG8_MMA(1, 0, At, B0); PG8_BAR; PG8_SCHED;
            PG8_STAGE(PG8_SB(0, 1), b2 + hstep, voffB);
            PG8_WAIT_V(6); PG8_BAR; PG8_MMA(1, 1, At, B1); PG8_BAR;
            PG8_LDB(B0, 1, 0); PG8_SCHED; PG8_LDA(At, 1, 0); PG8_STAGE(PG8_SA(0, 1), a2 + hstep, voffA);
            PG8_WAIT_L(8); PG8_BAR; PG8_WAIT_L(0); PG8_MMA(0, 0, At, B0); PG8_BAR; PG8_SCHED;
            PG8_LDB(B1, 1, 1); PG8_STAGE(PG8_SB(1, 0), b3, voffB);
            PG8_BAR; PG8_WAIT_L(0); PG8_MMA(0, 1, At, B1); PG8_BAR;
            PG8_LDA(At, 1, 1); PG8_STAGE(PG8_SA(1, 0), a3, voffA);
            PG8_BAR; PG8_WAIT_L(0); PG8_MMA(1, 0, At, B0); PG8_BAR; PG8_SCHED;
            PG8_STAGE(PG8_SB(1, 1), b3 + hstep, voffB);
            PG8_WAIT_V(6); PG8_BAR; PG8_MMA(1, 1, At, B1); PG8_BAR;
            }
        }
        if (ui == 0) PG8_STAMP(44);
        if constexpr (ALIGN_EPI) { if (wr == 0) PG8_BAR; }
        if constexpr (!Epi::AFTER_DRAIN) { E(acc, cur, wr, wc, fr, fq); S.done(cur); }
        if (ui == 0) PG8_STAMP(45);
        if (!has_next) break;
        bool clear = true; if constexpr (Epi::CHAIN) clear = !E.keep(cur);
        if (clear) {
#pragma unroll
        for (int a = 0; a < 2; ++a)
#pragma unroll
            for (int b = 0; b < 2; ++b)
#pragma unroll
                for (int m = 0; m < 4; ++m)
#pragma unroll
                    for (int n = 0; n < 2; ++n) acc[a][b][m][n] = (f32x4){0.f, 0.f, 0.f, 0.f};
        }
        cur = nxt; cA = nA; cB = nB; ++ui;
        if constexpr (ALIGN_EPI) { if (wr == 1) PG8_BAR; }
    }
    PG8_STAMP(46);
    PG8_WAIT_V(0);
    if constexpr (!ALIGN_EPI) { if (wr == 0) PG8_BAR; }
    PG8_BAR;
    if constexpr (Epi::AFTER_DRAIN) { E.fused(acc, cur, wr, wc, fr, fq, lds, wid, lane); S.done(cur); }
#undef PG8_SA
#undef PG8_SB
#undef PG8_STAGE
#undef PG8_LDA
#undef PG8_LDB
#undef PG8_MMA
#undef PG8_WAIT_V
#undef PG8_WAIT_L
#undef PG8_BAR
#undef PG8_SCHED
}
}

__device__ __forceinline__ u32x4 pack8(const f32x4& a, const f32x4& b) { u32x4 w; w.x = pk2(a.x, a.y); w.y = pk2(a.z, a.w); w.z = pk2(b.x, b.y); w.w = pk2(b.z, b.w); return w; }
__device__ __forceinline__ void rope4(f32x4& v, const f32x2 cs0, const f32x2 cs1) {
    const float a0 = v.x * cs0.x - v.y * cs0.y, a1 = v.x * cs0.y + v.y * cs0.x, a2 = v.z * cs1.x - v.w * cs1.y, a3 = v.z * cs1.y + v.w * cs1.x;
    v.x = a0; v.y = a1; v.z = a2; v.w = a3;
}
struct EpiMix {
    static constexpr bool PERM = true, AFTER_DRAIN = false, CHAIN = false;
    const Params* pp; int l;
    __device__ __forceinline__ void operator()(const f32x4 (&acc)[2][2][4][2], const Unit& u, int wr, int wc, int fr, int fq) const {
        const Params& p = *pp;
        const int pn = u.pn, R0 = u.pm * 256; const bool smp = R0 >= MP;
        const int b = smp ? (R0 - MP) >> 11 : R0 >> 8, t0 = smp ? (R0 - MP) & 2047 : 0;
        const f32x2* cs_row = (const f32x2*)(p.ws + WS_ROPE); const f32x2* cs_col = cs_row + 32 * 16;
        if (pn >= 11) {
            bf16_t* dst = (bf16_t*)(p.ws + (pn < 13 ? Z_CU : Z_CV)) + ((pn - 11) & 1) * 256 + wc * 32 + 8 * fq;
#pragma unroll
            for (int ai = 0; ai < 2; ++ai)
#pragma unroll
                for (int m = 0; m < 4; ++m) { const int R = R0 + ai * 128 + wr * 64 + m * 16 + fr;
#pragma unroll
                    for (int bj = 0; bj < 2; ++bj) { f32x4 v0 = acc[ai][bj][m][0], v1 = acc[ai][bj][m][1];
#pragma unroll
                        for (int r = 0; r < 4; ++r) { v0[r] = gelu_tanh(v0[r]); v1[r] = gelu_tanh(v1[r]); }
                        *(u32x4*)(dst + (size_t)R * RW + bj * 128) = pack8(v0, v1); } }
            return;
        }
        const int kind = pn >> 1;
        const bool is_k = (pn == 10 && wc < 2), is_v = (pn == 10 && wc >= 2);
        const float* gqk = (kind == 4 ? p.in[I_GQ] : p.in[I_GK]) + l * HD + 8 * fq;
        const int head = (pn & 1) * 4 + wc;
        const bool norm = (kind == 4 || is_k), rope = smp && (kind == 0 || kind == 1 || kind == 4 || is_k);
        const float post = kind == 1 ? 0.125f : (kind == 4 ? C2 : 1.0f);
#pragma unroll
        for (int ai = 0; ai < 2; ++ai)
#pragma unroll
            for (int m = 0; m < 4; ++m) {
                const int rr = ai * 128 + wr * 64 + m * 16 + fr, R = R0 + rr, t = t0 + rr;
                float rs = 1.0f;
                if (norm) {
                    float ss = 0.f;
#pragma unroll
                    for (int bj = 0; bj < 2; ++bj)
#pragma unroll
                        for (int n = 0; n < 2; ++n) { const f32x4 x = acc[ai][bj][m][n]; ss += (x.x * x.x + x.y * x.y) + (x.z * x.z + x.w * x.w); }
                    ss += __shfl_xor(ss, 16); ss += __shfl_xor(ss, 32);
                    rs = rsqrtf(ss * (1.f / HD) + EPS);
                }
                bf16_t* dst;
                if (kind < 5) dst = (bf16_t*)(p.ws + (kind == 0 ? Z_RQ : kind == 1 ? Z_RK : kind == 2 ? Z_RV : kind == 3 ? Z_RG : Z_AQ)) + (size_t)R * RW + head * HD + 8 * fq;
                else { const int hk = wc & 1;
                    if (smp) dst = (bf16_t*)(p.ws + (is_k ? Z_KS : Z_VS)) + ((size_t)b * SKV_S + PAST + t) * KVW + hk * HD + 8 * fq;
                    else dst = (bf16_t*)(p.ws + (is_k ? Z_KP : Z_VP)) + ((size_t)b * SEQ_P + t) * KVW + hk * HD + 8 * fq; }
                float* cdst = p.out + (is_k ? OUT_CK : OUT_CV) + ((size_t)((b * 2 + l) * SEQ_P + t) * 2 + (wc & 1)) * HD + 8 * fq;
#pragma unroll
                for (int bj = 0; bj < 2; ++bj) {
                    f32x4 v0 = acc[ai][bj][m][0], v1 = acc[ai][bj][m][1];
                    if (norm) { const f32x4 g0 = *(const f32x4*)(gqk + 32 * bj), g1 = *(const f32x4*)(gqk + 32 * bj + 4); v0 = v0 * rs * g0; v1 = v1 * rs * g1; }
                    if (pn == 10 && !smp) { *(f32x4*)(cdst + 32 * bj) = v0; *(f32x4*)(cdst + 32 * bj + 4) = v1; }
                    if (kind == 3) {
#pragma unroll
                        for (int r = 0; r < 4; ++r) { v0[r] = siluf_(v0[r]); v1[r] = siluf_(v1[r]); } }
                    if (rope) {
                        const f32x2* tab = (bj == 0 ? cs_row + (t >> 6) * 16 : cs_col + (t & 63) * 16) + 4 * fq;
                        rope4(v0, tab[0], tab[1]); rope4(v1, tab[2], tab[3]); }
                    v0 = v0 * post; v1 = v1 * post;
                    *(u32x4*)(dst + 32 * bj) = pack8(v0, v1);
                    asm volatile("" ::: "memory");
                }
            }
    }
};
__device__ __forceinline__ size_t gate_off(int x, int pm, int pn, int ai, int m, int bj, int wid, int lane) {
    return ((((size_t)(x * 80 + pm) * 4 + pn) * 16 + (ai * 4 + m) * 2 + bj) * 512 + wid * 64 + lane) * 8; }
struct EpiGate {
    static constexpr bool PERM = true, AFTER_DRAIN = false, CHAIN = false;
    const Params* pp;
    __device__ __forceinline__ void operator()(const f32x4 (&acc)[2][2][4][2], const Unit& u, int wr, int wc, int fr, int fq) const {
        const int x = u.pn >> 2; bf16_t* dst = (bf16_t*)(pp->ws + Z_GATE); const int wid = wr * 4 + wc, lane = fq * 16 + fr;
#pragma unroll
        for (int ai = 0; ai < 2; ++ai)
#pragma unroll
            for (int m = 0; m < 4; ++m) {
#pragma unroll
                for (int bj = 0; bj < 2; ++bj) { f32x4 v0 = acc[ai][bj][m][0], v1 = acc[ai][bj][m][1];
#pragma unroll
                    for (int r = 0; r < 4; ++r) { v0[r] = sigmoidf_(fminf(fmaxf(v0[r], -30.f), 30.f)); v1[r] = sigmoidf_(fminf(fmaxf(v1[r], -30.f), 30.f)); }
                    *(u32x4*)(dst + gate_off(x, u.pm, u.pn & 3, ai, m, bj, wid, lane)) = pack8(v0, v1); } }
    }
};
struct EpiMerge {
    static constexpr bool PERM = true, AFTER_DRAIN = false, CHAIN = true;
    const Params* pp;
    __device__ __forceinline__ bool keep(const Unit& u) const { return (u.pn >> 2) != 2; }
    __device__ __forceinline__ void operator()(f32x4 (&acc)[2][2][4][2], const Unit& u, int wr, int wc, int fr, int fq) const {
        const int x = u.pn >> 2, pm = u.pm - 80 * x;
        const int col0 = (u.pn & 3) * 256 + wc * 32 + 8 * fq;
        const int gnum = x == 0 ? 1 : x == 1 ? 2 : 0, gden = x == 0 ? 2 : 0;
        const bf16_t* gbase = (const bf16_t*)(pp->ws + Z_GATE); const int wid = wr * 4 + wc, lane = fq * 16 + fr, pnc = u.pn & 3;
        bf16_t* dst = (bf16_t*)(pp->ws + WS_XN) + col0;
#pragma unroll
        for (int aim = 0; aim < 4; ++aim) { const int ai = aim >> 1, m0 = (aim & 1) * 2;
            u32x4 gnv[4][2], gdv[4][2];
#pragma unroll
            for (int m = m0; m < m0 + 2; ++m) { const int R = pm * 256 + ai * 128 + wr * 64 + m * 16 + fr;
#pragma unroll
                for (int bj = 0; bj < 2; ++bj) { gnv[m][bj] = *(const u32x4*)(gbase + gate_off(gnum, pm, pnc, ai, m, bj, wid, lane)); if (x != 2) gdv[m][bj] = *(const u32x4*)(gbase + gate_off(gden, pm, pnc, ai, m, bj, wid, lane)); } }
#pragma unroll
            for (int m = m0; m < m0 + 2; ++m) { const int R = pm * 256 + ai * 128 + wr * 64 + m * 16 + fr;
#pragma unroll
                for (int bj = 0; bj < 2; ++bj) {
                    const u32x4 g = gnv[m][bj];
                    f32x4 s0 = (f32x4){bflo(g.x), bfhi(g.x), bflo(g.y), bfhi(g.y)}, s1 = (f32x4){bflo(g.z), bfhi(g.z), bflo(g.w), bfhi(g.w)};
                    if (x != 2) { const u32x4 d = gdv[m][bj];
                        s0.x *= __builtin_amdgcn_rcpf(bflo(d.x)); s0.y *= __builtin_amdgcn_rcpf(bfhi(d.x)); s0.z *= __builtin_amdgcn_rcpf(bflo(d.y)); s0.w *= __builtin_amdgcn_rcpf(bfhi(d.y));
                        s1.x *= __builtin_amdgcn_rcpf(bflo(d.z)); s1.y *= __builtin_amdgcn_rcpf(bfhi(d.z)); s1.z *= __builtin_amdgcn_rcpf(bflo(d.w)); s1.w *= __builtin_amdgcn_rcpf(bfhi(d.w)); }
                    acc[ai][bj][m][0] = acc[ai][bj][m][0] * s0; acc[ai][bj][m][1] = acc[ai][bj][m][1] * s1;
                    if (x == 2) *(u32x4*)(dst + (size_t)R * DM + bj * 128) = pack8(acc[ai][bj][m][0], acc[ai][bj][m][1]); } }
            asm volatile("" ::: "memory");
        }
    }
};
struct EpiRes {
    static constexpr bool PERM = false, AFTER_DRAIN = false, CHAIN = false;
    const Params* pp; int l, part; bool from_inputs; int ntf; bf16_t* slab;
    __device__ __forceinline__ void operator()(const f32x4 (&acc)[2][2][4][2], const Unit& u, int wr, int wc, int fr, int fq) const {
        const Params& p = *pp; const int R0 = u.pm * 256; const int ci = row_ci(R0);
        if (u.nt != ntf) {
            bf16_t* s = slab + ((size_t)((u.pm * 4 + u.pn - 256) * 4 + u.k0 / u.nt) * 256) * 256 + wc * 32 + 4 * fq;
#pragma unroll
            for (int ai = 0; ai < 2; ++ai)
#pragma unroll
                for (int m = 0; m < 4; ++m) { const int rr = ai * 128 + wr * 64 + m * 16 + fr;
#pragma unroll
                    for (int bj = 0; bj < 2; ++bj)
#pragma unroll
                        for (int n = 0; n < 2; ++n) { const f32x4 v = acc[ai][bj][m][n]; u32x2 w; w.x = pk2(v.x, v.y); w.y = pk2(v.z, v.w); *(u32x2*)(s + (size_t)rr * 256 + bj * 128 + n * 16) = w; } }
            return;
        }
        const float* gv = mod_ptr(p, l, ci, part) + u.pn * 256 + wc * 32 + 4 * fq;
        f32x4 g[2][2];
#pragma unroll
        for (int bj = 0; bj < 2; ++bj)
#pragma unroll
            for (int n = 0; n < 2; ++n) g[bj][n] = *(const f32x4*)(gv + bj * 128 + n * 16);
#pragma unroll
        for (int aim = 0; aim < 4; ++aim) { const int ai = aim >> 1, m0 = (aim & 1) * 2;
            f32x4 xv[4][2][2];
#pragma unroll
            for (int m = m0; m < m0 + 2; ++m) { const int R = R0 + ai * 128 + wr * 64 + m * 16 + fr;
                const float* xs = (from_inputs ? x_row(p, 0, R) : p.out + (size_t)R * DM) + u.pn * 256 + wc * 32 + 4 * fq;
#pragma unroll
                for (int bj = 0; bj < 2; ++bj)
#pragma unroll
                    for (int n = 0; n < 2; ++n) xv[m][bj][n] = *(const f32x4*)(xs + bj * 128 + n * 16); }
#pragma unroll
            for (int m = m0; m < m0 + 2; ++m) { const int R = R0 + ai * 128 + wr * 64 + m * 16 + fr;
                float* xo = p.out + (size_t)R * DM + u.pn * 256 + wc * 32 + 4 * fq;
#pragma unroll
                for (int bj = 0; bj < 2; ++bj)
#pragma unroll
                    for (int n = 0; n < 2; ++n) *(f32x4*)(xo + bj * 128 + n * 16) = xv[m][bj][n] + g[bj][n] * acc[ai][bj][m][n]; }
            asm volatile("" ::: "memory");
        }
    }
};
struct EpiFF1 {
    static constexpr bool PERM = true, AFTER_DRAIN = false, CHAIN = false;
    const Params* pp;
    __device__ __forceinline__ void operator()(const f32x4 (&acc)[2][2][4][2], const Unit& u, int wr, int wc, int fr, int fq) const {
        bf16_t* dst = (bf16_t*)(pp->ws + Z_HB) + u.pn * 256 + wc * 32 + 8 * fq;
#pragma unroll
        for (int ai = 0; ai < 2; ++ai)
#pragma unroll
            for (int m = 0; m < 4; ++m) { const int R = u.pm * 256 + ai * 128 + wr * 64 + m * 16 + fr;
#pragma unroll
                for (int bj = 0; bj < 2; ++bj) { f32x4 v0 = acc[ai][bj][m][0], v1 = acc[ai][bj][m][1];
#pragma unroll
                    for (int r = 0; r < 4; ++r) { const float a = fmaxf(v0[r], 0.f), b = fmaxf(v1[r], 0.f); v0[r] = a * a; v1[r] = b * b; }
                    *(u32x4*)(dst + (size_t)R * DFF + bj * 128) = pack8(v0, v1); } }
    }
};

namespace attn_body {
using bf16=__hip_bfloat16;
using bf16x8=__attribute__((ext_vector_type(8)))short;
using s16x4=__attribute__((ext_vector_type(4)))short;
using f32x16=__attribute__((ext_vector_type(16)))float;
using u32x4=__attribute__((ext_vector_type(4)))unsigned;
constexpr int D=64,QP=512,KP=128;
constexpr int NW=8,QBLK=32,QB=QBLK*NW,KVBLK=64;
__device__ __forceinline__ int crow(int r,int hi){return (r&3)+8*(r>>2)+4*hi;}
#define SBAR() __builtin_amdgcn_sched_barrier(0)
constexpr int NSLOT=3, SLOTB=8192;
constexpr int LDS_K=0, LDS_V=NSLOT*SLOTB, LDS_WS=2*NSLOT*SLOTB, LDS_OST=LDS_WS+NW*64*4, LDS_BYTES=LDS_OST+NW*4096;
constexpr float C2=0.125f*1.4426950408889634f;
__device__ __forceinline__ void glds16(const void*gsrc,unsigned lds_dst){unsigned keep;
  asm volatile("s_mov_b32 %0, m0\n\ts_mov_b32 m0, %2\n\ts_nop 0\n\tglobal_load_lds_dwordx4 %1, off\n\ts_mov_b32 m0, %0":"=&s"(keep):"v"(gsrc),"s"(lds_dst):"memory");}
__device__ __forceinline__ float max3f(float a,float b,float c){float r;asm("v_max3_f32 %0, %1, %2, %3":"=v"(r):"v"(a),"v"(b),"v"(c));return r;}
__device__ __forceinline__ float max2f(float a,float b){float r;asm("v_max_f32_e32 %0, %1, %2":"=v"(r):"v"(a),"v"(b));return r;}
__device__ __forceinline__ float fadd_s(float a,float b){float r;asm("v_add_f32_e32 %0, %1, %2":"=v"(r):"v"(a),"v"(b));return r;}
__device__ __forceinline__ float fsub_s(float a,float b){float r;asm("v_sub_f32_e32 %0, %1, %2":"=v"(r):"v"(a),"v"(b));return r;}
typedef float f32x2_t __attribute__((ext_vector_type(2))); typedef __bf16 bf16x2_t __attribute__((ext_vector_type(2)));
__device__ __forceinline__ unsigned cvtpk_s(float lo,float hi){f32x2_t v={lo,hi};bf16x2_t b=__builtin_convertvector(v,bf16x2_t);return __builtin_bit_cast(unsigned,b);}
#define WAIT_BAR(N) asm volatile("s_waitcnt vmcnt(" #N ") lgkmcnt(0)\n\ts_barrier":::"memory")

__device__ __forceinline__ void qkt(f32x16&p0,f32x16&p1,const char*Kslot,const bf16x8*qr,const f32x16&negm,int r32,int hi){
  const char*kb=Kslot+hi*1024+r32*16;
  #pragma unroll
  for(int d0=0;d0<4;++d0){
    const bf16x8 b0=*reinterpret_cast<const bf16x8*>(kb+d0*2048);
    const bf16x8 b1=*reinterpret_cast<const bf16x8*>(kb+d0*2048+512);
    if(d0==0){p0=__builtin_amdgcn_mfma_f32_32x32x16_bf16(b0,qr[0],negm,0,0,0);p1=__builtin_amdgcn_mfma_f32_32x32x16_bf16(b1,qr[0],negm,0,0,0);}
    else{p0=__builtin_amdgcn_mfma_f32_32x32x16_bf16(b0,qr[d0],p0,0,0,0);p1=__builtin_amdgcn_mfma_f32_32x32x16_bf16(b1,qr[d0],p1,0,0,0);}}
}
typedef __attribute__((address_space(3))) const char* lds_cptr;
typedef short v4i16_t __attribute__((ext_vector_type(4)));
__device__ __forceinline__ void kload8(bf16x8*kf,lds_cptr kp){
  kf[0]=*(const __attribute__((address_space(3))) bf16x8*)(kp);      kf[1]=*(const __attribute__((address_space(3))) bf16x8*)(kp+512);
  kf[2]=*(const __attribute__((address_space(3))) bf16x8*)(kp+2048); kf[3]=*(const __attribute__((address_space(3))) bf16x8*)(kp+2560);
  kf[4]=*(const __attribute__((address_space(3))) bf16x8*)(kp+4096); kf[5]=*(const __attribute__((address_space(3))) bf16x8*)(kp+4608);
  kf[6]=*(const __attribute__((address_space(3))) bf16x8*)(kp+6144); kf[7]=*(const __attribute__((address_space(3))) bf16x8*)(kp+6656);
}
__device__ __forceinline__ void kload2(bf16x8*kf,lds_cptr kp,int j){ kf[2*j]=*(const __attribute__((address_space(3))) bf16x8*)(kp+j*2048); kf[2*j+1]=*(const __attribute__((address_space(3))) bf16x8*)(kp+j*2048+512); }
__device__ __forceinline__ s16x4 vtr(lds_cptr p){ return __builtin_bit_cast(s16x4,__builtin_amdgcn_ds_read_tr16_b64_v4i16((__attribute__((address_space(3))) v4i16_t*)p)); }
__device__ __forceinline__ float rowmax(const f32x16&p0,const f32x16&p1){
  float a=max3f(p0[0],p0[1],p1[0]),b=max3f(p0[2],p0[3],p1[1]);a=max3f(a,p1[2],p1[3]);
  #pragma unroll
  for(int r=4;r<16;r+=4){a=max3f(a,p0[r],p0[r+1]);b=max3f(b,p0[r+2],p0[r+3]);a=max3f(a,p1[r],p1[r+1]);b=max3f(b,p1[r+2],p1[r+3]);}
  const float m=max2f(a,b);
  auto rr=__builtin_amdgcn_permlane32_swap(__float_as_uint(m),__float_as_uint(m),false,false);
  return max2f(__uint_as_float(rr[0]),__uint_as_float(rr[1]));
}
__device__ __forceinline__ void pv(f32x16*o,int vb,bf16x8 pa0,bf16x8 pa1,bf16x8 pa2,bf16x8 pa3){
  #pragma unroll
  for(int d0=0;d0<2;++d0){s16x4 lo[4],hi[4];
    #pragma unroll
    for(int ks=0;ks<4;++ks){
      asm volatile("ds_read_b64_tr_b16 %0,%1 offset:%c2":"=&v"(lo[ks]):"v"(vb),"i"(d0*4096+ks*1024):"memory");
      asm volatile("ds_read_b64_tr_b16 %0,%1 offset:%c2":"=&v"(hi[ks]):"v"(vb),"i"(d0*4096+ks*1024+512):"memory");}
    asm volatile("s_waitcnt lgkmcnt(0)":::"memory");SBAR();
    #define PK(k) (bf16x8){lo[k][0],lo[k][1],lo[k][2],lo[k][3],hi[k][0],hi[k][1],hi[k][2],hi[k][3]}
    o[d0]=__builtin_amdgcn_mfma_f32_32x32x16_bf16(pa0,PK(0),o[d0],0,0,0);
    o[d0]=__builtin_amdgcn_mfma_f32_32x32x16_bf16(pa1,PK(1),o[d0],0,0,0);
    o[d0]=__builtin_amdgcn_mfma_f32_32x32x16_bf16(pa2,PK(2),o[d0],0,0,0);
    o[d0]=__builtin_amdgcn_mfma_f32_32x32x16_bf16(pa3,PK(3),o[d0],0,0,0);
    #undef PK
  }
}

#ifndef ATTN_STORE16
#define ATTN_STORE16(p,v) (*(u32x4*)(p)=(v))
#endif
template<int THRL> __device__ __forceinline__ void attn_unit(int tid,const bf16*Qu,const bf16*__restrict__ Kh,const bf16*__restrict__ Vh,bf16*Ou,const int NT,char*shm){
  const int lane=tid&63,r32=lane&31,hi=lane>>5; const int wid=__builtin_amdgcn_readfirstlane(tid>>6);
  const bf16*Qw=Qu+(long)(wid*QBLK)*QP;
  const unsigned lds0=(unsigned)(uintptr_t)shm;
  float*wsf=(float*)(shm+LDS_WS)+wid*64;
  const bf16*ksrc=Kh+(long)lane*KP+wid*8;
  const bf16*vsrc=Vh+(long)(16*(wid&3)+(lane>>2))*KP+(wid>>2)*32+(lane&3)*8;
  const unsigned kdst=lds0+LDS_K+wid*1024, vdst=lds0+LDS_V+wid*1024;
  #define DMA_K(t,slot) glds16(ksrc+(long)(t)*KVBLK*KP,(unsigned)__builtin_amdgcn_readfirstlane(kdst+(slot)))
  #define DMA_V(t,slot) glds16(vsrc+(long)(t)*KVBLK*KP,(unsigned)__builtin_amdgcn_readfirstlane(vdst+(slot)))
  const int vb0=(int)(lds0+LDS_V)+((lane>>4)&1)*32+(lane&3)*8+(4*hi+((lane&15)>>2))*64;
  const char*Kbase=shm+LDS_K; bf16x8 kf[8];
  const lds_cptr shm3=(lds_cptr)shm; const lds_cptr kp0=shm3+LDS_K+hi*1024+r32*16; const lds_cptr vp0=shm3+LDS_V+((lane>>4)&1)*32+(lane&3)*8+(4*hi+((lane&15)>>2))*64;
  DMA_K(0,0);DMA_V(0,0);DMA_K(1,SLOTB);
  bf16x8 qr[4];
  #pragma unroll
  for(int d0=0;d0<4;++d0)qr[d0]=*reinterpret_cast<const bf16x8*>(&Qw[(long)r32*QP+d0*16+hi*8]);
  float zf_=0.f;asm volatile("":"+v"(zf_));
  float mhat=zf_,l_reg=zf_;f32x16 o[2],negm;
  #pragma unroll
  for(int r=0;r<16;++r){o[0][r]=zf_;o[1][r]=zf_;negm[r]=zf_;}
  asm volatile("":"+v"(negm));
  #define CMASK(P0,P1,t) do{}while(0)
  bool resc=false;
  #define START(P0,P1) do{ const float rm=rowmax(P0,P1); resc=false; \
    { const float dl=rm; mhat=fadd_s(mhat,dl); \
      _Pragma("unroll") for(int r=0;r<16;++r){P0[r]=fsub_s(P0[r],dl);P1[r]=fsub_s(P1[r],dl);} \
      _Pragma("unroll") for(int r=0;r<16;++r)negm[r]=-mhat; asm volatile("":"+v"(negm)); } \
    _Pragma("unroll") for(int r=0;r<16;++r)P0[r]=__builtin_amdgcn_exp2f(P0[r]); }while(0)
  #define RESC() do{ if(resc){ asm volatile("s_waitcnt lgkmcnt(0)":::"memory"); \
      _Pragma("unroll") for(int d_=0;d_<2;++d_) _Pragma("unroll") for(int r=0;r<16;++r)o[d_][r]*=wsf[crow(r,hi)]; } }while(0)
  f32x16 pA0,pA1,pB0,pB1;
  int sl_prev=0,sl_cur=0,sl_next=SLOTB;
  #define ROT() do{sl_prev=sl_cur;sl_cur=sl_next;sl_next=(sl_next==(NSLOT-1)*SLOTB)?0:sl_next+SLOTB;}while(0)
  DMA_K(2,2*SLOTB);
  WAIT_BAR(3);
  qkt(pA0,pA1,Kbase,qr,negm,r32,hi);asm volatile("s_nop 15\n\ts_nop 7":"+v"(pA0),"+v"(pA1));CMASK(pA0,pA1,0);
  START(pA0,pA1);
  _Pragma("unroll") for(int r=0;r<16;++r)pA1[r]=__builtin_amdgcn_exp2f(pA1[r]);
  WAIT_BAR(0);
  DMA_K(3,0);DMA_V(1,SLOTB);
  ROT();
  kload8(kf,kp0+sl_cur);
  WAIT_BAR(2);
  s16x4 vlo[8],vhi[8]; u32x4 pw0,pw1,pw2,pw3;
  #define PKW(P,B) cvtpk_s(P[B],P[B+1])
  #define PAF(k) __builtin_bit_cast(bf16x8,pw##k)
  #define VFR(i) (bf16x8){vlo[i][0],vlo[i][1],vlo[i][2],vlo[i][3],vhi[i][0],vhi[i][1],vhi[i][2],vhi[i][3]}
  #define PIN(x) asm volatile("":"+v"(x))
  #define MX3(a,b,c) __builtin_fmaxf(__builtin_fmaxf((a),(b)),(c))
  #define GAPA(MF,A0,A1,A2,A3,W0,W1,PW) do{ MF; sacc+=A0; sacc+=A1; sacc+=A2; sacc+=A3; PIN(sacc); W0; W1; PIN(PW); SBAR(); }while(0)
  #define EX(v) __builtin_amdgcn_exp2f(v)
  #define GAPB(MF,X,B) do{ MF; X[B]=EX(X[B]); X[B+1]=EX(X[B+1]); X[B+2]=EX(X[B+2]); X[B+3]=EX(X[B+3]); PIN(X); SBAR(); }while(0)
  #define VRD(i) do{ vlo[i]=vtr(vp_+(((i)>>2)*4096+((i)&3)*1024)); vhi[i]=vtr(vp_+(((i)>>2)*4096+((i)&3)*1024+512)); }while(0)
  #define KRD(G,j) do{ if(G){ kload2(kf,kp0+sl_next,j); SBAR(); } }while(0)
  #define STEP(C0,C1,P0,P1,t,GK,GV,GL) do{ SBAR(); \
    const lds_cptr vp_=vp0+sl_prev; \
    VRD(0); SBAR(); float sacc=(P0[0]+P0[1]); \
    GAPA(C0=__builtin_amdgcn_mfma_f32_32x32x16_bf16(kf[0],qr[0],negm,0,0,0), P0[2],P0[3],P0[4],P0[5],     pw0[0]=PKW(P0,0), pw0[1]=PKW(P0,2), pw0); \
    VRD(4); SBAR(); GAPA(C1=__builtin_amdgcn_mfma_f32_32x32x16_bf16(kf[1],qr[0],negm,0,0,0), P0[6],P0[7],P0[8],P0[9],     pw0[2]=PKW(P0,4), pw0[3]=PKW(P0,6), pw0); \
    VRD(1); SBAR(); GAPA(C0=__builtin_amdgcn_mfma_f32_32x32x16_bf16(kf[2],qr[1],C0,0,0,0),   P0[10],P0[11],P0[12],P0[13], pw1[0]=PKW(P0,8), pw1[1]=PKW(P0,10), pw1); \
    VRD(5); SBAR(); GAPA(C1=__builtin_amdgcn_mfma_f32_32x32x16_bf16(kf[3],qr[1],C1,0,0,0),   P0[14],P0[15],P1[0],P1[1],   pw1[2]=PKW(P0,12),pw1[3]=PKW(P0,14), pw1); \
    VRD(2); SBAR(); GAPA(C0=__builtin_amdgcn_mfma_f32_32x32x16_bf16(kf[4],qr[2],C0,0,0,0),   P1[2],P1[3],P1[4],P1[5],     pw2[0]=PKW(P1,0), pw2[1]=PKW(P1,2), pw2); \
    VRD(6); SBAR(); GAPA(C1=__builtin_amdgcn_mfma_f32_32x32x16_bf16(kf[5],qr[2],C1,0,0,0),   P1[6],P1[7],P1[8],P1[9],     pw2[2]=PKW(P1,4), pw2[3]=PKW(P1,6), pw2); \
    VRD(3); SBAR(); GAPA(C0=__builtin_amdgcn_mfma_f32_32x32x16_bf16(kf[6],qr[3],C0,0,0,0),   P1[10],P1[11],P1[12],P1[13], pw3[0]=PKW(P1,8), pw3[1]=PKW(P1,10), pw3); \
    VRD(7); SBAR(); GAPA(C1=__builtin_amdgcn_mfma_f32_32x32x16_bf16(kf[7],qr[3],C1,0,0,0),   P1[14],P1[15],0.f,0.f,       pw3[2]=PKW(P1,12),pw3[3]=PKW(P1,14), pw3); \
    l_reg+=sacc; \
    if(GK){DMA_K((t)+3,sl_cur);} if(GV){DMA_V((t)+1,sl_next);} \
    CMASK(C0,C1,t); \
    { float a=MX3(C0[0],C0[1],C1[0]),b=MX3(C0[2],C0[3],C1[1]); a=MX3(a,C1[2],C1[3]); \
      _Pragma("unroll") for(int r=4;r<16;r+=4){a=MX3(a,C0[r],C0[r+1]);b=MX3(b,C0[r+2],C0[r+3]);a=MX3(a,C1[r],C1[r+1]);b=MX3(b,C1[r+2],C1[r+3]);} \
      float rm=__builtin_fmaxf(a,b); { auto rr=__builtin_amdgcn_permlane32_swap(__float_as_uint(rm),__float_as_uint(rm),false,false); rm=__builtin_fmaxf(__uint_as_float(rr[0]),__uint_as_float(rr[1])); } \
      resc=false; \
      if(__builtin_expect(__any(rm>(float)THRL),0)){ const float dl=__builtin_fmaxf(rm,0.f); mhat+=dl; \
        _Pragma("unroll") for(int r=0;r<16;++r){C0[r]-=dl;C1[r]-=dl;} \
        _Pragma("unroll") for(int r=0;r<16;++r)negm[r]=-mhat; asm volatile("":"+v"(negm)); \
        const float f=__builtin_amdgcn_exp2f(-dl); l_reg*=f; if(hi==0)wsf[r32]=f; resc=true; } } \
    SBAR(); \
    GAPB(o[0]=__builtin_amdgcn_mfma_f32_32x32x16_bf16(PAF(0),VFR(0),o[0],0,0,0), C0,0); \
    GAPB(o[1]=__builtin_amdgcn_mfma_f32_32x32x16_bf16(PAF(0),VFR(4),o[1],0,0,0), C0,4); \
    KRD(GL,0); GAPB(o[0]=__builtin_amdgcn_mfma_f32_32x32x16_bf16(PAF(1),VFR(1),o[0],0,0,0), C0,8); \
    KRD(GL,1); GAPB(o[1]=__builtin_amdgcn_mfma_f32_32x32x16_bf16(PAF(1),VFR(5),o[1],0,0,0), C0,12); \
    KRD(GL,2); GAPB(o[0]=__builtin_amdgcn_mfma_f32_32x32x16_bf16(PAF(2),VFR(2),o[0],0,0,0), C1,0); \
    KRD(GL,3); GAPB(o[1]=__builtin_amdgcn_mfma_f32_32x32x16_bf16(PAF(2),VFR(6),o[1],0,0,0), C1,4); \
    GAPB(o[0]=__builtin_amdgcn_mfma_f32_32x32x16_bf16(PAF(3),VFR(3),o[0],0,0,0), C1,8); \
    GAPB(o[1]=__builtin_amdgcn_mfma_f32_32x32x16_bf16(PAF(3),VFR(7),o[1],0,0,0), C1,12); \
    }while(0)
  int t=1;
  for(;t+5<NT;t+=2){
    STEP(pB0,pB1,pA0,pA1,t,true,true,true);     WAIT_BAR(2); RESC(); ROT();
    STEP(pA0,pA1,pB0,pB1,t+1,true,true,true);   WAIT_BAR(2); RESC(); ROT();
  }
  #define ENDW(tt) do{ if((tt)+3<NT){WAIT_BAR(2);} else if((tt)+2<NT){WAIT_BAR(1);} else {WAIT_BAR(0);} }while(0)
  for(;t+1<NT;t+=2){
    STEP(pB0,pB1,pA0,pA1,t,(t+3<NT),(t+1<NT),(t+1<NT));       ENDW(t);   RESC(); ROT();
    STEP(pA0,pA1,pB0,pB1,t+1,(t+4<NT),(t+2<NT),(t+2<NT));     ENDW(t+1); RESC(); ROT();
  }
  STEP(pB0,pB1,pA0,pA1,NT-1,false,false,false); RESC();
  { float sacc=pB0[0]+pB0[1]; _Pragma("unroll") for(int r=2;r<16;++r)sacc+=pB0[r]; _Pragma("unroll") for(int r=0;r<16;++r)sacc+=pB1[r]; l_reg+=sacc;
    pw0=(u32x4){PKW(pB0,0),PKW(pB0,2),PKW(pB0,4),PKW(pB0,6)};pw1=(u32x4){PKW(pB0,8),PKW(pB0,10),PKW(pB0,12),PKW(pB0,14)};pw2=(u32x4){PKW(pB1,0),PKW(pB1,2),PKW(pB1,4),PKW(pB1,6)};pw3=(u32x4){PKW(pB1,8),PKW(pB1,10),PKW(pB1,12),PKW(pB1,14)};
    SBAR(); pv(o,vb0+sl_cur,PAF(0),PAF(1),PAF(2),PAF(3)); }
  #undef PKW
  #undef PAF
  #undef VFR
  #undef PIN
  #undef MX3
  #undef GAPA
  #undef GAPB
  #undef EX
  #undef VRD
  #undef KRD
  #undef STEP
  #undef ENDW
  {auto rr=__builtin_amdgcn_permlane32_swap(__float_as_uint(l_reg),__float_as_uint(l_reg),false,false);l_reg=__uint_as_float(rr[0])+__uint_as_float(rr[1]);}
  if(hi==0)wsf[32+r32]=l_reg;asm volatile("s_waitcnt lgkmcnt(0)":::"memory");
  float rli[16];
  #pragma unroll
  for(int r=0;r<16;++r)rli[r]=__builtin_amdgcn_rcpf(wsf[32+crow(r,hi)]);
  bf16*Ow=Ou+(long)(wid*QBLK)*QP;
  { bf16*stg=(bf16*)(shm+LDS_OST)+wid*2048;
    #pragma unroll
    for(int r=0;r<16;++r){const int orow=crow(r,hi);
      #pragma unroll
      for(int d0=0;d0<2;++d0)stg[orow*64+d0*32+r32]=__float2bfloat16(o[d0][r]*rli[r]);}
    asm volatile("s_waitcnt lgkmcnt(0)":::"memory");
    #pragma unroll
    for(int i=0;i<4;++i){const int row=i*8+(lane>>3),ch=lane&7; const u32x4 v=*(const u32x4*)(stg+row*64+ch*8); ATTN_STORE16(Ow+(long)row*QP+ch*8,v);} }
  asm volatile("s_waitcnt lgkmcnt(0)\n\ts_barrier":::"memory");
  #undef DMA_K
  #undef DMA_V
  #undef CMASK
  #undef START
  #undef RESC
  #undef ROT
}
constexpr int ATTN_LDS_BYTES=LDS_BYTES;
#undef SBAR
#undef WAIT_BAR
}
#ifndef ATTN_FAST
#define ATTN_FAST 1
#endif
__device__ __forceinline__ void attn_fast(const Params& p, const Ctx& c) {
    typedef attn_body::bf16 abf;
    const int vcu = (c.G % 8 == 0) ? (c.bx % 8) * (c.G / 8) + c.bx / 8 : c.bx;
    for (int u = vcu; u < 512 + 128; u += c.G) {
        const abf *Qu, *Kh, *Vh; int NT;
        if (u < 512) { const int qb = u & 7, hq = (u >> 3) & 3, hk = (u >> 5) & 1, b = u >> 6, h = hk * 4 + hq;
            Qu = (const abf*)(p.ws + Z_AQ) + ((size_t)MP + (size_t)b * SEQ_S + qb * 256) * RW + h * HD;
            Kh = (const abf*)(p.ws + Z_KS) + (size_t)b * SKV_S * KVW + hk * HD; Vh = (const abf*)(p.ws + Z_VS) + (size_t)b * SKV_S * KVW + hk * HD; NT = SKV_S / 64; }
        else { const int v = u - 512, hq = v & 3, hk = (v >> 2) & 1, b = v >> 3, h = hk * 4 + hq;
            Qu = (const abf*)(p.ws + Z_AQ) + ((size_t)b * SEQ_P) * RW + h * HD;
            Kh = (const abf*)(p.ws + Z_KP) + (size_t)b * SEQ_P * KVW + hk * HD; Vh = (const abf*)(p.ws + Z_VP) + (size_t)b * SEQ_P * KVW + hk * HD; NT = SKV_P / 64; }
        attn_body::attn_unit<8>(c.tid, Qu, Kh, Vh, (abf*)Qu, NT, (char*)c.lds);
    }
    __syncthreads();
}

__device__ __forceinline__ void attn_simple(const Params& p, const Ctx& c) {
    LAS float* Kt = (LAS float*)c.lds; LAS float* Vt = Kt + 32 * 64; LAS float* Sc = Vt + 32 * 64;
    constexpr int NU_S = NB_S * NH * 4, NU_P = NB_P * NH;
    for (int u = c.bx; u < NU_S + NU_P; u += c.G) {
        const bool smp = u < NU_S; int b, h, q0, nq, skv; const bf16_t *Kb, *Vb; size_t rowbase;
        if (smp) { b = u / 32; h = (u / 4) & 7; q0 = (u & 3) * 512; nq = 512; skv = SKV_S; Kb = (const bf16_t*)(p.ws + Z_KS) + (size_t)b * SKV_S * KVW; Vb = (const bf16_t*)(p.ws + Z_VS) + (size_t)b * SKV_S * KVW; rowbase = MP + (size_t)b * SEQ_S + q0; }
        else { const int v = u - NU_S; b = v / 8; h = v & 7; q0 = 0; nq = 256; skv = SKV_P; Kb = (const bf16_t*)(p.ws + Z_KP) + (size_t)b * SEQ_P * KVW; Vb = (const bf16_t*)(p.ws + Z_VP) + (size_t)b * SEQ_P * KVW; rowbase = (size_t)b * SEQ_P; }
        const int hk = h >> 2; const bool act = c.tid < nq;
        bf16_t* qrow = (bf16_t*)(p.ws + Z_AQ) + (rowbase + (act ? c.tid : 0)) * RW + h * HD;
        float q[64], o[64]; float mx = -1e30f, lsum = 0.f;
#pragma unroll
        for (int i = 0; i < 8; ++i) { const u32x4 w = *(const u32x4*)(qrow + 8 * i); q[8 * i] = bflo(w.x); q[8 * i + 1] = bfhi(w.x); q[8 * i + 2] = bflo(w.y); q[8 * i + 3] = bfhi(w.y); q[8 * i + 4] = bflo(w.z); q[8 * i + 5] = bfhi(w.z); q[8 * i + 6] = bflo(w.w); q[8 * i + 7] = bfhi(w.w); }
#pragma unroll
        for (int i = 0; i < 64; ++i) o[i] = 0.f;
        for (int k0 = 0; k0 < skv; k0 += 32) {
            __syncthreads();
            { const int e = c.tid * 4, j = e >> 6, d = e & 63;
                const u32x2 kw = *(const u32x2*)(Kb + (size_t)(k0 + j) * KVW + hk * HD + d), vw = *(const u32x2*)(Vb + (size_t)(k0 + j) * KVW + hk * HD + d);
                *(LAS f32x4*)(Kt + e) = (f32x4){bflo(kw.x), bfhi(kw.x), bflo(kw.y), bfhi(kw.y)}; *(LAS f32x4*)(Vt + e) = (f32x4){bflo(vw.x), bfhi(vw.x), bflo(vw.y), bfhi(vw.y)}; }
            __syncthreads();
            float tm = mx;
#pragma unroll 1
            for (int j = 0; j < 32; ++j) { float a = 0.f;
#pragma unroll
                for (int d4 = 0; d4 < 16; ++d4) { const f32x4 kv = *(const LAS f32x4*)(Kt + j * 64 + 4 * d4); a += q[4 * d4] * kv.x + q[4 * d4 + 1] * kv.y + q[4 * d4 + 2] * kv.z + q[4 * d4 + 3] * kv.w; }
                Sc[j * 512 + c.tid] = a; tm = fmaxf(tm, a); }
            const float corr = exp2f(mx - tm); mx = tm; lsum *= corr;
#pragma unroll
            for (int i = 0; i < 64; ++i) o[i] *= corr;
#pragma unroll 1
            for (int j = 0; j < 32; ++j) { const float pj = exp2f(Sc[j * 512 + c.tid] - mx); lsum += pj;
#pragma unroll
                for (int d4 = 0; d4 < 16; ++d4) { const f32x4 vv = *(const LAS f32x4*)(Vt + j * 64 + 4 * d4); o[4 * d4] += pj * vv.x; o[4 * d4 + 1] += pj * vv.y; o[4 * d4 + 2] += pj * vv.z; o[4 * d4 + 3] += pj * vv.w; } }
        }
        if (act) { const float il = 1.f / lsum;
#pragma unroll
            for (int i = 0; i < 8; ++i) { u32x4 w; w.x = pk2(o[8 * i] * il, o[8 * i + 1] * il); w.y = pk2(o[8 * i + 2] * il, o[8 * i + 3] * il); w.z = pk2(o[8 * i + 4] * il, o[8 * i + 5] * il); w.w = pk2(o[8 * i + 6] * il, o[8 * i + 7] * il); *(u32x4*)(qrow + 8 * i) = w; } }
    }
    __syncthreads();
}
__device__ __forceinline__ void cmlp_simple(const Params& p, const Ctx& c, int l) {
    LAS float* Vt = (LAS float*)c.lds;
    LAS float* rs = Vt + 128 * 128;
    const bf16_t* cv = (const bf16_t*)(p.ws + Z_CV); bf16_t* cu = (bf16_t*)(p.ws + Z_CU);
    for (int u = c.bx; u < NCHUNK * 4; u += c.G) {
        const int ch = u >> 2, g = u & 3; const size_t R0 = (size_t)ch * 128;
        __syncthreads();
        { const int q = c.tid >> 2, part = c.tid & 3; float ss = 0.f;
            const bf16_t* r = cv + (R0 + q) * RW + part * 128;
#pragma unroll
            for (int i = 0; i < 16; ++i) { const u32x4 w = *(const u32x4*)(r + 8 * i); const float a0 = bflo(w.x), a1 = bfhi(w.x), a2 = bflo(w.y), a3 = bfhi(w.y), a4 = bflo(w.z), a5 = bfhi(w.z), a6 = bflo(w.w), a7 = bfhi(w.w);
                ss += (a0 * a0 + a1 * a1) + (a2 * a2 + a3 * a3) + (a4 * a4 + a5 * a5) + (a6 * a6 + a7 * a7); }
            ss += __shfl_xor(ss, 1); ss += __shfl_xor(ss, 2);
            if (part == 0) rs[q] = rsqrtf(ss * (1.f / RW) + EPS); }
        __syncthreads();
        for (int e = c.tid; e < 128 * 128 / 8; e += 512) { const int q = e >> 4, c8 = (e & 15) * 8; const float r = rs[q];
            const u32x4 w = *(const u32x4*)(cv + (R0 + q) * RW + g * 128 + c8);
            *(LAS f32x4*)(Vt + q * 128 + c8) = (f32x4){bflo(w.x) * r, bfhi(w.x) * r, bflo(w.y) * r, bfhi(w.y) * r};
            *(LAS f32x4*)(Vt + q * 128 + c8 + 4) = (f32x4){bflo(w.z) * r, bfhi(w.z) * r, bflo(w.w) * r, bfhi(w.w) * r}; }
        __syncthreads();
        const int cc = c.tid & 127, pg = __builtin_amdgcn_readfirstlane(c.tid >> 7);
        const float* Ws = p.in[I_CMWS] + ((size_t)(l * 4 + g) * 128) * 128; const float* bs = p.in[I_CMBS] + (l * 4 + g) * 128;
        const float gn = p.in[I_CMNORM][l * RW + g * 128 + cc];
        for (int pi = 0; pi < 32; ++pi) { const int pr = pg * 32 + pi; const float* wrow = Ws + pr * 128; float a = 0.f;
#pragma unroll 8
            for (int q = 0; q < 128; ++q) a += wrow[q] * Vt[q * 128 + cc];
            bf16_t* up = cu + (R0 + pr) * RW + g * 128 + cc;
            const float uu = bf2f(*up);
            *up = (bf16_t)f2bf(uu * (gn * a + bs[pr])); }
    }
    __syncthreads();
}
__device__ __forceinline__ float ret_ld(const Params& p, int l, int dir, int h) { const float x = p.in[I_DECAY][(l * 2 + dir) * NH + h]; return -log1pf(__expf(x)); }
__device__ __forceinline__ void retU_simple(const Params& p, const Ctx& c, int l) {
    LAS float* Kt = (LAS float*)c.lds; LAS float* Vt = Kt + 128 * 64; LAS float* wf = Vt + 128 * 64; LAS float* wb = wf + 128;
    float* U = (float*)(p.ws + Z_U);
    for (int u = c.bx; u < NCHUNK * NH; u += c.G) {
        const int ch = u >> 3, h = u & 7; const size_t R0 = (size_t)ch * 128;
        const float ldf = ret_ld(p, l, 0, h), ldb = ret_ld(p, l, 1, h);
        __syncthreads();
        if (c.tid < 128) { wf[c.tid] = __expf(ldf * (float)(127 - c.tid)); wb[c.tid] = __expf(ldb * (float)c.tid); }
        for (int e = c.tid; e < 128 * 64 / 8; e += 512) { const int j = e >> 3, d8 = (e & 7) * 8;
            const u32x4 kw = *(const u32x4*)((const bf16_t*)(p.ws + Z_RK) + (R0 + j) * RW + h * HD + d8), vw = *(const u32x4*)((const bf16_t*)(p.ws + Z_RV) + (R0 + j) * RW + h * HD + d8);
            *(LAS f32x4*)(Kt + j * 64 + d8) = (f32x4){bflo(kw.x), bfhi(kw.x), bflo(kw.y), bfhi(kw.y)}; *(LAS f32x4*)(Kt + j * 64 + d8 + 4) = (f32x4){bflo(kw.z), bfhi(kw.z), bflo(kw.w), bfhi(kw.w)};
            *(LAS f32x4*)(Vt + j * 64 + d8) = (f32x4){bflo(vw.x), bfhi(vw.x), bflo(vw.y), bfhi(vw.y)}; *(LAS f32x4*)(Vt + j * 64 + d8 + 4) = (f32x4){bflo(vw.z), bfhi(vw.z), bflo(vw.w), bfhi(vw.w)}; }
        __syncthreads();
        const int e = c.tid & 63, d0 = __builtin_amdgcn_readfirstlane(c.tid >> 6) * 8;
        float uf[8], ub[8];
#pragma unroll
        for (int i = 0; i < 8; ++i) { uf[i] = 0.f; ub[i] = 0.f; }
        for (int j = 0; j < 128; ++j) { const float v = Vt[j * 64 + e], vf = v * wf[j], vb = v * wb[j];
            const f32x4 k0 = *(const LAS f32x4*)(Kt + j * 64 + d0), k1 = *(const LAS f32x4*)(Kt + j * 64 + d0 + 4);
            uf[0] += k0.x * vf; uf[1] += k0.y * vf; uf[2] += k0.z * vf; uf[3] += k0.w * vf; uf[4] += k1.x * vf; uf[5] += k1.y * vf; uf[6] += k1.z * vf; uf[7] += k1.w * vf;
            ub[0] += k0.x * vb; ub[1] += k0.y * vb; ub[2] += k0.z * vb; ub[3] += k0.w * vb; ub[4] += k1.x * vb; ub[5] += k1.y * vb; ub[6] += k1.z * vb; ub[7] += k1.w * vb; }
        float* Uf = U + ((size_t)(0 * NCHUNK + ch) * NH + h) * 4096, *Ub = U + ((size_t)(1 * NCHUNK + ch) * NH + h) * 4096;
#pragma unroll
        for (int i = 0; i < 8; ++i) { Uf[(d0 + i) * 64 + e] = uf[i]; Ub[(d0 + i) * 64 + e] = ub[i]; }
    }
    __syncthreads();
}
__device__ __forceinline__ void retO_simple(const Params& p, const Ctx& c, int l) {
    LAS float* Kt = (LAS float*)c.lds; LAS float* Vt = Kt + 128 * 64; LAS float* Sf = Vt + 128 * 64; LAS float* Sb = Sf + 4096; LAS float* pf = Sb + 4096; LAS float* pb = pf + 132;
    const float* U = (const float*)(p.ws + Z_U);
    for (int u = c.bx; u < NCHUNK * NH; u += c.G) {
        const int ch = u >> 3, h = u & 7; const size_t R0 = (size_t)ch * 128; const bool smp = ch >= MP / 128;
        const int nc = smp ? 16 : 2, ch0 = smp ? (MP / 128 + ((ch - MP / 128) & ~15)) : (ch & ~1), cidx = ch - ch0, b = smp ? (ch - MP / 128) >> 4 : ch >> 1;
        const float ldf = ret_ld(p, l, 0, h), ldb = ret_ld(p, l, 1, h); const float Gf = __expf(128.f * ldf), Gb = __expf(128.f * ldb);
        __syncthreads();
        if (c.tid <= 128) { pf[c.tid] = __expf(ldf * (float)c.tid); pb[c.tid] = __expf(ldb * (float)c.tid); }
        for (int e = c.tid; e < 128 * 64 / 8; e += 512) { const int j = e >> 3, d8 = (e & 7) * 8;
            const u32x4 kw = *(const u32x4*)((const bf16_t*)(p.ws + Z_RK) + (R0 + j) * RW + h * HD + d8), vw = *(const u32x4*)((const bf16_t*)(p.ws + Z_RV) + (R0 + j) * RW + h * HD + d8);
            *(LAS f32x4*)(Kt + j * 64 + d8) = (f32x4){bflo(kw.x), bfhi(kw.x), bflo(kw.y), bfhi(kw.y)}; *(LAS f32x4*)(Kt + j * 64 + d8 + 4) = (f32x4){bflo(kw.z), bfhi(kw.z), bflo(kw.w), bfhi(kw.w)};
            *(LAS f32x4*)(Vt + j * 64 + d8) = (f32x4){bflo(vw.x), bfhi(vw.x), bflo(vw.y), bfhi(vw.y)}; *(LAS f32x4*)(Vt + j * 64 + d8 + 4) = (f32x4){bflo(vw.z), bfhi(vw.z), bflo(vw.w), bfhi(vw.w)}; }
        {
            const int e0 = c.tid * 8; const float* sfp = U + ((size_t)(0 * NCHUNK + ch) * NH + h) * 4096 + e0; const float* sbp = U + ((size_t)(1 * NCHUNK + ch) * NH + h) * 4096 + e0;
#pragma unroll
            for (int i = 0; i < 8; ++i) { Sf[e0 + i] = sfp[i]; Sb[e0 + i] = sbp[i]; }
        }
        __syncthreads();
        const int i = c.tid >> 2, part = c.tid & 3;
        float qp[16], o[16];
        { const bf16_t* qr = (const bf16_t*)(p.ws + Z_RQ) + (R0 + i) * RW + h * HD + part * 16; const u32x4 w0 = *(const u32x4*)qr, w1 = *(const u32x4*)(qr + 8);
            qp[0] = bflo(w0.x); qp[1] = bfhi(w0.x); qp[2] = bflo(w0.y); qp[3] = bfhi(w0.y); qp[4] = bflo(w0.z); qp[5] = bfhi(w0.z); qp[6] = bflo(w0.w); qp[7] = bfhi(w0.w);
            qp[8] = bflo(w1.x); qp[9] = bfhi(w1.x); qp[10] = bflo(w1.y); qp[11] = bfhi(w1.y); qp[12] = bflo(w1.z); qp[13] = bfhi(w1.z); qp[14] = bflo(w1.w); qp[15] = bfhi(w1.w); }
#pragma unroll
        for (int e = 0; e < 16; ++e) o[e] = 0.f;
#pragma unroll 1
        for (int j = 0; j < 128; ++j) { float s = 0.f;
#pragma unroll
            for (int d4 = 0; d4 < 4; ++d4) { const f32x4 kv = *(const LAS f32x4*)(Kt + j * 64 + part * 16 + 4 * d4); s += qp[4 * d4] * kv.x + qp[4 * d4 + 1] * kv.y + qp[4 * d4 + 2] * kv.z + qp[4 * d4 + 3] * kv.w; }
            s += __shfl_xor(s, 1); s += __shfl_xor(s, 2);
            const float w = j < i ? pf[i - j] : (j > i ? pb[j - i] : 2.0f);
            s *= w;
#pragma unroll
            for (int e4 = 0; e4 < 4; ++e4) { const f32x4 vv = *(const LAS f32x4*)(Vt + j * 64 + part * 16 + 4 * e4); o[4 * e4] += s * vv.x; o[4 * e4 + 1] += s * vv.y; o[4 * e4 + 2] += s * vv.z; o[4 * e4 + 3] += s * vv.w; } }
        { const float xf = pf[i + 1], xb = pb[128 - i]; const bf16_t* qfull = (const bf16_t*)(p.ws + Z_RQ) + (R0 + i) * RW + h * HD;
#pragma unroll 2
            for (int d = 0; d < 64; ++d) { const float qd = bf2f(qfull[d]); const float af = qd * xf, ab = qd * xb;
#pragma unroll
                for (int e4 = 0; e4 < 4; ++e4) { const f32x4 a = *(const LAS f32x4*)(Sf + d * 64 + part * 16 + 4 * e4), bb = *(const LAS f32x4*)(Sb + d * 64 + part * 16 + 4 * e4);
                    o[4 * e4] += af * a.x + ab * bb.x; o[4 * e4 + 1] += af * a.y + ab * bb.y; o[4 * e4 + 2] += af * a.z + ab * bb.z; o[4 * e4 + 3] += af * a.w + ab * bb.w; } } }
        float s1 = 0.f;
#pragma unroll
        for (int e = 0; e < 16; ++e) s1 += o[e];
        s1 += __shfl_xor(s1, 1); s1 += __shfl_xor(s1, 2); const float mu = s1 * (1.f / 64.f);
        float s2 = 0.f;
#pragma unroll
        for (int e = 0; e < 16; ++e) { const float d = o[e] - mu; s2 += d * d; }
        s2 += __shfl_xor(s2, 1); s2 += __shfl_xor(s2, 2); const float rstd = rsqrtf(s2 * (1.f / 64.f) + EPS);
        const float* gn = p.in[I_RETGN] + l * RW + h * HD + part * 16;
        const bf16_t* rg = (const bf16_t*)(p.ws + Z_RG) + (R0 + i) * RW + h * HD + part * 16; const u32x4 g0 = *(const u32x4*)rg, g1 = *(const u32x4*)(rg + 8);
        float gs[16] = {bflo(g0.x), bfhi(g0.x), bflo(g0.y), bfhi(g0.y), bflo(g0.z), bfhi(g0.z), bflo(g0.w), bfhi(g0.w), bflo(g1.x), bfhi(g1.x), bflo(g1.y), bfhi(g1.y), bflo(g1.z), bfhi(g1.z), bflo(g1.w), bfhi(g1.w)};
        float y[16];
#pragma unroll
        for (int e = 0; e < 16; ++e) y[e] = (o[e] - mu) * rstd * gn[e] * gs[e];
        bf16_t* dst = (bf16_t*)(p.ws + Z_CV) + (R0 + i) * RW + h * HD + part * 16;
        u32x4 w0, w1; w0.x = pk2(y[0], y[1]); w0.y = pk2(y[2], y[3]); w0.z = pk2(y[4], y[5]); w0.w = pk2(y[6], y[7]); w1.x = pk2(y[8], y[9]); w1.y = pk2(y[10], y[11]); w1.z = pk2(y[12], y[13]); w1.w = pk2(y[14], y[15]);
        *(u32x4*)dst = w0; *(u32x4*)(dst + 8) = w1;
    }
    __syncthreads();
}

__device__ __forceinline__ void lds_barrier() { asm volatile("s_waitcnt lgkmcnt(0)" ::: "memory"); __builtin_amdgcn_s_barrier(); asm volatile("" ::: "memory"); }
typedef short v4i16_t __attribute__((ext_vector_type(4)));
typedef LAS const unsigned char* lcp;
__device__ __forceinline__ f32x4 mfma16(bf16x8 a, bf16x8 b, f32x4 c) { return __builtin_amdgcn_mfma_f32_16x16x32_bf16(a, b, c, 0, 0, 0); }
__device__ __forceinline__ bf16x8 tr_frag(lcp base, int stride, int k0, int c0, int lane) {
    const int g = lane >> 4, i = lane & 15, q = i >> 2, pp = i & 3;
    lcp a = base + (k0 + 8 * g + q) * stride + (c0 + 4 * pp) * 2;
    const v4i16_t r1 = __builtin_amdgcn_ds_read_tr16_b64_v4i16((LAS v4i16_t*)a), r2 = __builtin_amdgcn_ds_read_tr16_b64_v4i16((LAS v4i16_t*)(a + 4 * stride));
    return (bf16x8){r1[0], r1[1], r1[2], r1[3], r2[0], r2[1], r2[2], r2[3]};
}
__device__ __forceinline__ bf16x8 row_frag(lcp base, int stride, int r0, int k0, int lane) { return *(const LAS bf16x8*)(base + (r0 + (lane & 15)) * stride + (k0 + 8 * (lane >> 4)) * 2); }
__device__ __forceinline__ u32x4 scale8(const u32x4 w, float s) { u32x4 o; o.x = pk2(bflo(w.x) * s, bfhi(w.x) * s); o.y = pk2(bflo(w.y) * s, bfhi(w.y) * s); o.z = pk2(bflo(w.z) * s, bfhi(w.z) * s); o.w = pk2(bflo(w.w) * s, bfhi(w.w) * s); return o; }
constexpr int RS64 = 144, RS128 = 272;
constexpr float LOG2E = 1.4426950408889634f;

__device__ __forceinline__ void retU_fast(const Params& p, const Ctx& c, int l) {
    LAS unsigned char* Kf = c.lds; LAS unsigned char* Kb = Kf + 128 * RS64; LAS unsigned char* Vs = Kb + 128 * RS64;
    float* U = (float*)(p.ws + Z_U);
    const int g = c.lane >> 4, i16 = c.lane & 15;
    u32x4 pkk[2], pvv[2];
#define RETU_PREFETCH(uu) do { const int ch_ = (uu) >> 3, h_ = (uu) & 7; \
        _Pragma("unroll") for (int it = 0; it < 2; ++it) { const int idx = c.tid + 512 * it, j = idx >> 3, c8 = (idx & 7) * 8; const size_t go = rlay(h_, (size_t)ch_ * 128 + j) + c8; \
            pkk[it] = *(const u32x4*)((const bf16_t*)(p.ws + Z_RK) + go); pvv[it] = *(const u32x4*)((const bf16_t*)(p.ws + Z_RV) + go); } } while (0)
    if (c.vcu < NCHUNK * NH) RETU_PREFETCH(c.vcu);
    for (int u = c.vcu; u < NCHUNK * NH; u += c.G) {
        const int ch = u >> 3, h = u & 7;
        const float l2f = ret_ld(p, l, 0, h) * LOG2E, l2b = ret_ld(p, l, 1, h) * LOG2E;
        lds_barrier();
#pragma unroll
        for (int it = 0; it < 2; ++it) { const int idx = c.tid + 512 * it, j = idx >> 3, c8 = (idx & 7) * 8;
            const u32x4 kw = pkk[it], vw = pvv[it];
            const float wf = exp2f(l2f * (float)(127 - j)), wb = exp2f(l2b * (float)j);
            *(LAS u32x4*)(Kf + j * RS64 + c8 * 2) = scale8(kw, wf); *(LAS u32x4*)(Kb + j * RS64 + c8 * 2) = scale8(kw, wb); *(LAS u32x4*)(Vs + j * RS64 + c8 * 2) = vw; }
        if (u + c.G < NCHUNK * NH) RETU_PREFETCH(u + c.G);
        lds_barrier();
        const int dt = c.wave & 3, et0 = 2 * (c.wave >> 2);
        f32x4 acc[2][2];
#pragma unroll
        for (int s = 0; s < 2; ++s)
#pragma unroll
            for (int e = 0; e < 2; ++e) acc[s][e] = (f32x4){0.f, 0.f, 0.f, 0.f};
#pragma unroll
        for (int ks = 0; ks < 4; ++ks) {
            const bf16x8 af = tr_frag(Kf, RS64, 32 * ks, 16 * dt, c.lane), ab = tr_frag(Kb, RS64, 32 * ks, 16 * dt, c.lane);
#pragma unroll
            for (int e = 0; e < 2; ++e) { const bf16x8 bv = tr_frag(Vs, RS64, 32 * ks, 16 * (et0 + e), c.lane); acc[0][e] = mfma16(af, bv, acc[0][e]); acc[1][e] = mfma16(ab, bv, acc[1][e]); }
        }
#pragma unroll
        for (int s = 0; s < 2; ++s)
#pragma unroll
            for (int e = 0; e < 2; ++e) { float* o = U + ((size_t)(s * NCHUNK + ch) * NH + h) * 4096 + (16 * dt + 4 * g) * 64 + 16 * (et0 + e) + i16;
#pragma unroll
                for (int r = 0; r < 4; ++r) o[r * 64] = acc[s][e][r]; }
    }
    __syncthreads();
}

#ifndef RETO_DUP
#define RETO_DUP 0
#endif
__device__ __forceinline__ void retO_fast(const Params& p, const Ctx& c, int l) {
    LAS unsigned char* Qs = c.lds; LAS unsigned char* Ks = Qs + 128 * RS64; LAS unsigned char* Vs = Ks + 128 * RS64; LAS unsigned char* Sf = Vs + 128 * RS64; LAS unsigned char* Sb = Sf + 64 * RS64; LAS unsigned char* Ps = Sb + 64 * RS64;
    const float* U = (const float*)(p.ws + Z_U);
    const int g = c.lane >> 4, i16 = c.lane & 15, i0 = 16 * c.wave;
    u32x4 pq[2], pk[2], pv[2], prg[2]; f32x4 pst[4]; float pgn[4];
#define RETO_PREFETCH(uu) do { const int ch_ = (uu) >> 3, h_ = (uu) & 7; const size_t R0_ = (size_t)ch_ * 128; \
        _Pragma("unroll") for (int it = 0; it < 2; ++it) { const int idx = c.tid + 512 * it, j = idx >> 3, c8 = (idx & 7) * 8; const size_t go = rlay(h_, R0_ + j) + c8; \
            pq[it] = *(const u32x4*)((const bf16_t*)(p.ws + Z_RQ) + go); pk[it] = *(const u32x4*)((const bf16_t*)(p.ws + Z_RK) + go); pv[it] = *(const u32x4*)((const bf16_t*)(p.ws + Z_RV) + go); } \
        { const float* sfp = U + ((size_t)(0 * NCHUNK + ch_) * NH + h_) * 4096 + c.tid * 8; const float* sbp = U + ((size_t)(1 * NCHUNK + ch_) * NH + h_) * 4096 + c.tid * 8; \
            pst[0] = *(const f32x4*)sfp; pst[1] = *(const f32x4*)(sfp + 4); pst[2] = *(const f32x4*)sbp; pst[3] = *(const f32x4*)(sbp + 4); } \
        _Pragma("unroll") for (int k = 0; k < 2; ++k) { const int row = c.lane >> 2, ec = ((c.lane & 3) * 2 + k) * 8; prg[k] = *(const u32x4*)((const bf16_t*)(p.ws + Z_RG) + rlay(h_, R0_ + i0 + row) + ec); } \
        _Pragma("unroll") for (int et = 0; et < 4; ++et) pgn[et] = p.in[I_RETGN][l * RW + h_ * HD + 16 * et + i16]; } while (0)
    if (c.vcu < NCHUNK * NH) RETO_PREFETCH(c.vcu);
#ifdef PROBE_A
    int ustamp = 50;
#endif
    for (int u = c.vcu; u < NCHUNK * NH; u += c.G) {
#ifdef PROBE_A
        if (l == 0 && c.bx == 0 && c.tid == 0) ((unsigned long long*)(p.ws + WS_CTL + 65536))[ustamp++] = __builtin_amdgcn_s_memrealtime();
#endif
        const int ch = u >> 3, h = u & 7; const size_t R0 = (size_t)ch * 128;
        const float ldf = ret_ld(p, l, 0, h), ldb = ret_ld(p, l, 1, h); const float l2f = ldf * LOG2E, l2b = ldb * LOG2E;
        lds_barrier();
#pragma unroll 1
        for (int rep_ = 0; rep_ < (RETO_DUP == 3 ? 2 : 1); ++rep_) { asm volatile("" ::: "memory");
#pragma unroll
        for (int it = 0; it < 2; ++it) { const int idx = c.tid + 512 * it, j = idx >> 3, c8 = (idx & 7) * 8;
            *(LAS u32x4*)(Qs + j * RS64 + c8 * 2) = pq[it]; *(LAS u32x4*)(Ks + j * RS64 + c8 * 2) = pk[it]; *(LAS u32x4*)(Vs + j * RS64 + c8 * 2) = pv[it]; }
        {
            const int d = c.tid >> 3, e = (c.tid & 7) * 8; u32x4 w;
            w.x = pk2(pst[0].x, pst[0].y); w.y = pk2(pst[0].z, pst[0].w); w.z = pk2(pst[1].x, pst[1].y); w.w = pk2(pst[1].z, pst[1].w); *(LAS u32x4*)(Sf + d * RS64 + e * 2) = w;
            w.x = pk2(pst[2].x, pst[2].y); w.y = pk2(pst[2].z, pst[2].w); w.z = pk2(pst[3].x, pst[3].y); w.w = pk2(pst[3].z, pst[3].w); *(LAS u32x4*)(Sb + d * RS64 + e * 2) = w;
        }
        }
        const u32x4 rg0 = prg[0], rg1 = prg[1]; const float gn0 = pgn[0], gn1 = pgn[1], gn2 = pgn[2], gn3 = pgn[3];
        if (u + c.G < NCHUNK * NH) RETO_PREFETCH(u + c.G);
        if (RETO_DUP == 5) { asm volatile("" : "+v"(pq[0]), "+v"(pk[0]), "+v"(pv[0]), "+v"(pst[0]), "+v"(prg[0]), "+v"(pq[1]), "+v"(pk[1]), "+v"(pv[1]), "+v"(pst[1]), "+v"(pst[2]), "+v"(pst[3]), "+v"(prg[1])); if (u + c.G < NCHUNK * NH) RETO_PREFETCH(u + c.G); }
        lds_barrier();
#pragma unroll 1
        for (int rep_ = 0; rep_ < (RETO_DUP == 1 ? 2 : 1); ++rep_) { asm volatile("" ::: "memory"); const bf16x8 q0 = row_frag(Qs, RS64, i0, 0, c.lane), q1 = row_frag(Qs, RS64, i0, 32, c.lane);
            const int iq = i0 + i16;
#pragma unroll
            for (int jt = 0; jt < 8; ++jt) {
                f32x4 s = (f32x4){0.f, 0.f, 0.f, 0.f};
                s = mfma16(row_frag(Ks, RS64, 16 * jt, 0, c.lane), q0, s); s = mfma16(row_frag(Ks, RS64, 16 * jt, 32, c.lane), q1, s);
                float pv[4];
#pragma unroll
                for (int r = 0; r < 4; ++r) { const int j = 16 * jt + 4 * g + r; const float w = j < iq ? exp2f(l2f * (float)(iq - j)) : (j > iq ? exp2f(l2b * (float)(j - iq)) : 2.0f); pv[r] = s[r] * w; }
                u32x2 w2; w2.x = pk2(pv[0], pv[1]); w2.y = pk2(pv[2], pv[3]);
                *(LAS u32x2*)(Ps + iq * RS128 + (16 * jt + 4 * g) * 2) = w2;
            } }
        lds_barrier();
        f32x4 ap[4], af[4], ab[4];
#pragma unroll
        for (int et = 0; et < 4; ++et) { ap[et] = (f32x4){0.f, 0.f, 0.f, 0.f}; af[et] = ap[et]; ab[et] = ap[et]; }
#pragma unroll 1
        for (int rep_ = 0; rep_ < (RETO_DUP == 2 ? 2 : 1); ++rep_) { asm volatile("" ::: "memory");
#pragma unroll
        for (int ks = 0; ks < 4; ++ks) { const bf16x8 a = row_frag(Ps, RS128, i0, 32 * ks, c.lane);
#pragma unroll
            for (int et = 0; et < 4; ++et) ap[et] = mfma16(a, tr_frag(Vs, RS64, 32 * ks, 16 * et, c.lane), ap[et]); }
#pragma unroll
        for (int ks = 0; ks < 2; ++ks) { const bf16x8 a = row_frag(Qs, RS64, i0, 32 * ks, c.lane);
#pragma unroll
            for (int et = 0; et < 4; ++et) { af[et] = mfma16(a, tr_frag(Sf, RS64, 32 * ks, 16 * et, c.lane), af[et]); ab[et] = mfma16(a, tr_frag(Sb, RS64, 32 * ks, 16 * et, c.lane), ab[et]); } }
        }
        float mu[4], rstd[4];
#pragma unroll
        for (int r = 0; r < 4; ++r) { const int il = i0 + 4 * g + r; const float xf = exp2f(l2f * (float)(il + 1)), xb = exp2f(l2b * (float)(128 - il)); float s1 = 0.f;
#pragma unroll
            for (int et = 0; et < 4; ++et) { ap[et][r] += xf * af[et][r] + xb * ab[et][r]; s1 += ap[et][r]; }
            s1 += __shfl_xor(s1, 1); s1 += __shfl_xor(s1, 2); s1 += __shfl_xor(s1, 4); s1 += __shfl_xor(s1, 8); mu[r] = s1 * (1.f / 64.f); float s2 = 0.f;
#pragma unroll
            for (int et = 0; et < 4; ++et) { const float d = ap[et][r] - mu[r]; s2 += d * d; }
            s2 += __shfl_xor(s2, 1); s2 += __shfl_xor(s2, 2); s2 += __shfl_xor(s2, 4); s2 += __shfl_xor(s2, 8); rstd[r] = rsqrtf(s2 * (1.f / 64.f) + EPS); }
        LAS float* stg = (LAS float*)(Ps + i0 * RS128);
#pragma unroll 1
        for (int rep_ = 0; rep_ < (RETO_DUP == 4 ? 2 : 1); ++rep_) { asm volatile("" ::: "memory");
#pragma unroll
        for (int et = 0; et < 4; ++et) { const float gn = et == 0 ? gn0 : et == 1 ? gn1 : et == 2 ? gn2 : gn3;
#pragma unroll
            for (int r = 0; r < 4; ++r) stg[(4 * g + r) * 68 + 16 * et + i16] = (ap[et][r] - mu[r]) * rstd[r] * gn; }
        asm volatile("s_waitcnt lgkmcnt(0)" ::: "memory");
#pragma unroll
        for (int k = 0; k < 2; ++k) { const int row = c.lane >> 2, ec = ((c.lane & 3) * 2 + k) * 8;
            const f32x4 y0 = *(const LAS f32x4*)(stg + row * 68 + ec), y1 = *(const LAS f32x4*)(stg + row * 68 + ec + 4);
            const size_t go = (R0 + i0 + row) * RW + h * HD + ec; const u32x4 gw = k == 0 ? rg0 : rg1;
            u32x4 o; o.x = pk2(y0.x * bflo(gw.x), y0.y * bfhi(gw.x)); o.y = pk2(y0.z * bflo(gw.y), y0.w * bfhi(gw.y)); o.z = pk2(y1.x * bflo(gw.z), y1.y * bfhi(gw.z)); o.w = pk2(y1.z * bflo(gw.w), y1.w * bfhi(gw.w));
            *(u32x4*)((bf16_t*)(p.ws + Z_CV) + go) = o; }
        }
    }
    __syncthreads();
}

__device__ __forceinline__ void cmlp_fast(const Params& p, const Ctx& c, int l) {
    LAS unsigned char* As = c.lds; LAS unsigned char* Vc = As + 128 * RS128; LAS float* rs = (LAS float*)(Vc + 128 * RS128);
    const bf16_t* cv = (const bf16_t*)(p.ws + Z_CV); bf16_t* cu = (bf16_t*)(p.ws + Z_CU);
    const int g4 = c.lane >> 4, i16 = c.lane & 15, p0 = 16 * c.wave;
    for (int u = c.vcu; u < NCHUNK * 4; u += c.G) {
        const int ch = u >> 2, g = u & 3; const size_t R0 = (size_t)ch * 128;
        u32x4 lr[16], lv[4], lu[4]; f32x4 lw[8];
        { const bf16_t* r = cv + (R0 + (c.tid >> 2)) * RW + (c.tid & 3) * 128;
#pragma unroll
            for (int i = 0; i < 16; ++i) lr[i] = *(const u32x4*)(r + 8 * i); }
#pragma unroll
        for (int it = 0; it < 4; ++it) { const int idx = c.tid + 512 * it, q = idx >> 4, c8 = (idx & 15) * 8; lv[it] = *(const u32x4*)(cv + (R0 + q) * RW + g * 128 + c8); }
        const float* Ws = p.in[I_CMWS] + ((size_t)(l * 4 + g) * 128) * 128;
#pragma unroll
        for (int it = 0; it < 8; ++it) { const int idx = c.tid + 512 * it, pr = idx >> 5, q4 = (idx & 31) * 4; lw[it] = *(const f32x4*)(Ws + pr * 128 + q4); }
#pragma unroll
        for (int k = 0; k < 4; ++k) { const int row = c.lane >> 2, cc = (k * 4 + (c.lane & 3)) * 8; lu[k] = *(const u32x4*)(cu + (R0 + p0 + row) * RW + g * 128 + cc); }
        lds_barrier();
        { const int q = c.tid >> 2, part = c.tid & 3; float ss = 0.f;
#pragma unroll
            for (int i = 0; i < 16; ++i) { const u32x4 w = lr[i]; const float a0 = bflo(w.x), a1 = bfhi(w.x), a2 = bflo(w.y), a3 = bfhi(w.y), a4 = bflo(w.z), a5 = bfhi(w.z), a6 = bflo(w.w), a7 = bfhi(w.w);
                ss += (a0 * a0 + a1 * a1) + (a2 * a2 + a3 * a3) + (a4 * a4 + a5 * a5) + (a6 * a6 + a7 * a7); }
            ss += __shfl_xor(ss, 1); ss += __shfl_xor(ss, 2);
            if (part == 0) rs[q] = rsqrtf(ss * (1.f / RW) + EPS); }
#pragma unroll
        for (int it = 0; it < 4; ++it) { const int idx = c.tid + 512 * it, q = idx >> 4, c8 = (idx & 15) * 8; *(LAS u32x4*)(Vc + q * RS128 + c8 * 2) = lv[it]; }
        lds_barrier();
#pragma unroll
        for (int it = 0; it < 8; ++it) { const int idx = c.tid + 512 * it, pr = idx >> 5, q4 = (idx & 31) * 4;
            const f32x4 w = lw[it]; const f32x4 r = *(const LAS f32x4*)(rs + q4);
            u32x2 o; o.x = pk2(w.x * r.x, w.y * r.y); o.y = pk2(w.z * r.z, w.w * r.w); *(LAS u32x2*)(As + pr * RS128 + q4 * 2) = o; }
        lds_barrier();
        f32x4 acc[8];
#pragma unroll
        for (int ct = 0; ct < 8; ++ct) acc[ct] = (f32x4){0.f, 0.f, 0.f, 0.f};
#pragma unroll
        for (int ks = 0; ks < 4; ++ks) { const bf16x8 a = row_frag(As, RS128, p0, 32 * ks, c.lane);
#pragma unroll
            for (int ct = 0; ct < 8; ++ct) acc[ct] = mfma16(a, tr_frag(Vc, RS128, 32 * ks, 16 * ct, c.lane), acc[ct]); }
        lds_barrier();
        LAS float* stg = (LAS float*)(c.lds + c.wave * (16 * 132 * 4));
        const float* bsv = p.in[I_CMBS] + (l * 4 + g) * 128 + p0 + 4 * g4;
        float bb[4];
#pragma unroll
        for (int r = 0; r < 4; ++r) bb[r] = bsv[r];
#pragma unroll
        for (int ct = 0; ct < 8; ++ct) { const float gn = p.in[I_CMNORM][l * RW + g * 128 + 16 * ct + i16];
#pragma unroll
            for (int r = 0; r < 4; ++r) stg[(4 * g4 + r) * 132 + 16 * ct + i16] = gn * acc[ct][r] + bb[r]; }
        asm volatile("s_waitcnt lgkmcnt(0)" ::: "memory");
#pragma unroll
        for (int k = 0; k < 4; ++k) { const int row = c.lane >> 2, cc = (k * 4 + (c.lane & 3)) * 8;
            const f32x4 y0 = *(const LAS f32x4*)(stg + row * 132 + cc), y1 = *(const LAS f32x4*)(stg + row * 132 + cc + 4);
            bf16_t* up = cu + (R0 + p0 + row) * RW + g * 128 + cc; const u32x4 uw = lu[k];
            u32x4 o; o.x = pk2(y0.x * bflo(uw.x), y0.y * bfhi(uw.x)); o.y = pk2(y0.z * bflo(uw.y), y0.w * bfhi(uw.y)); o.z = pk2(y1.x * bflo(uw.z), y1.y * bfhi(uw.z)); o.w = pk2(y1.z * bflo(uw.w), y1.w * bfhi(uw.w));
            *(u32x4*)up = o; }
    }
    __syncthreads();
}
__device__ __forceinline__ void ret_scan(const Params& p, const Ctx& c, int l) {
    float* U = (float*)(p.ws + Z_U);
    const int gw = c.bx * 8 + c.wave, NGW = c.G * 8;
    for (int it = gw; it < 192 * 2 * 16; it += NGW) {
        const int part = it & 15, dir = (it >> 4) & 1, seq = it >> 5; const bool smp = seq < 64;
        const int b = smp ? seq >> 3 : (seq - 64) >> 3, h = seq & 7, ch0 = smp ? MP / 128 + b * 16 : b * 2;
        const int e0 = part * 256 + c.lane * 4;
        const float G = __expf(128.f * ret_ld(p, l, dir, h));
        float* base = U + ((size_t)(dir * NCHUNK + ch0) * NH + h) * 4096 + e0; const size_t cs = (size_t)NH * 4096;
        f32x4 s, uu[16];
        if (smp) { s = *(const f32x4*)(p.in[I_ST] + ((size_t)((b * 2 + l) * 2 + dir) * NH + h) * 4096 + e0);
#pragma unroll
            for (int k = 0; k < 16; ++k) uu[k] = *(const f32x4*)(base + (dir == 0 ? k : 15 - k) * cs);
#pragma unroll
            for (int k = 0; k < 16; ++k) { *(f32x4*)(base + (dir == 0 ? k : 15 - k) * cs) = s; s = s * G + uu[k]; } }
        else { s = (f32x4){0.f, 0.f, 0.f, 0.f};
#pragma unroll
            for (int k = 0; k < 2; ++k) uu[k] = *(const f32x4*)(base + (dir == 0 ? k : 1 - k) * cs);
#pragma unroll
            for (int k = 0; k < 2; ++k) { *(f32x4*)(base + (dir == 0 ? k : 1 - k) * cs) = s; s = s * G + uu[k]; }
            *(f32x4*)(p.out + OUT_ST + ((size_t)((b * 2 + l) * 2 + dir) * NH + h) * 4096 + e0) = s; }
    }
}
#ifndef P2A_ORDER
#define P2A_ORDER 0
#endif
#ifndef FAST_MIX
#define FAST_MIX 7
#endif

#ifndef PG8_ALIGN_
#define PG8_ALIGN_ true
#endif
#ifndef PG8_SP2_
#define PG8_SP2_ true
#endif
#ifndef PG8_MASK
#define PG8_MASK 0xFFF
#endif
template <int KIND, class Epi, class Sched>
__device__ __forceinline__ void gemm_any(const Ctx& c, const bf16_t* A, const bf16_t* Bt, int K, const Sched& S, const Epi& E, unsigned long long* probe_ts = nullptr) {
    if constexpr ((PG8_MASK >> KIND) & 1) { pg8::Gemm g{A, Bt, 0, 0, K, nullptr};
#ifdef PROBE_KIND
        if (KIND == PROBE_KIND && A != nullptr) g.ts = probe_ts;
#endif
        pg8::gemm_phase<Epi, Sched, PG8_ALIGN_, PG8_SP2_>(c.tid, c.lds, g, S, E); }
    else gemm_simple(c, A, Bt, K, S, E);
}
#ifndef KMASK
#define KMASK 0x1FFF
#endif
constexpr int NPHASE = 25;
__host__ __device__ constexpr int layer_kind(int i) { return i == 0 ? 2 : i == 1 ? 3 : i == 2 ? 12 : i + 1; }
template <int KIND> __device__ __forceinline__ void run_kind(const Params& p, const Ctx& c, int l) {
    const unsigned char* wb = p.ws + WS_W;
    if constexpr (KIND == 0) { p0_modulation(p, c); p0_rope_tables(p, c); p_wconv(p, c, 0); p_kvctx(p, c, 0); }
    else if constexpr (KIND == 1) { p_norm(p, c, l, 0); }
    else if constexpr (KIND == 2) { StaticOrder S; S.init(M, NMIX, c.G, c.bx, DM); EpiMix E{&p, l}; gemm_any<2>(c, (const bf16_t*)(p.ws + WS_XN), (const bf16_t*)(wb + W_IN), DM, S, E, l == 0 ? (unsigned long long*)(p.ws + WS_CTL + 65536) : nullptr); }
    else if constexpr (KIND == 3) {
#if P2A_ORDER == 1
        if (FAST_MIX & 2) retU_fast(p, c, l); else retU_simple(p, c, l); if (FAST_MIX & 1) cmlp_fast(p, c, l); else cmlp_simple(p, c, l); if (ATTN_FAST) attn_fast(p, c); else attn_simple(p, c);
#else
        if (ATTN_FAST) attn_fast(p, c); else attn_simple(p, c); if (FAST_MIX & 1) cmlp_fast(p, c, l); else cmlp_simple(p, c, l); if (FAST_MIX & 2) retU_fast(p, c, l); else retU_simple(p, c, l);
#endif
    }
    else if constexpr (KIND == 4) { if (FAST_MIX & 4) retO_fast(p, c, l); else retO_simple(p, c, l); }
    else if constexpr (KIND == 5) { StaticOrder S; S.init(M, NGATE, c.G, c.bx, DM); EpiGate E{&p}; gemm_any<5>(c, (const bf16_t*)(p.ws + WS_XN), (const bf16_t*)(wb + W_IN) + (size_t)NMIX * DM, DM, S, E, l == 0 ? (unsigned long long*)(p.ws + WS_CTL + 65536) : nullptr); }
    else if constexpr (KIND == 6) { MergeOrder S{c.G, (c.G % 8 == 0) ? (c.bx % 8) * (c.G / 8) + c.bx / 8 : c.bx}; EpiMerge E{&p}; gemm_any<6>(c, (const bf16_t*)(p.ws + Z_AQ), (const bf16_t*)(wb + W_BR), RW, S, E, l == 0 ? (unsigned long long*)(p.ws + WS_CTL + 65536) : nullptr); }
    else if constexpr (KIND == 7) { QuarterOrder S; S.init(c.G, c.bx, DM); EpiRes E{&p, l, 2, l == 0, DM / 64, (bf16_t*)(p.ws + SLAB_P4)}; gemm_any<7>(c, (const bf16_t*)(p.ws + WS_XN), (const bf16_t*)(wb + W_OUT), DM, S, E, l == 0 ? (unsigned long long*)(p.ws + WS_CTL + 65536) : nullptr); }
    else if constexpr (KIND == 8) { p_norm(p, c, l, 1, c.G == 256); }
    else if constexpr (KIND == 9) { StaticOrder S; S.init(M, DFF, c.G, c.bx, DM); EpiFF1 E{&p}; gemm_any<9>(c, (const bf16_t*)(p.ws + WS_XN), (const bf16_t*)(wb + W_FF1), DM, S, E, l == 0 ? (unsigned long long*)(p.ws + WS_CTL + 65536) : nullptr); }
    else if constexpr (KIND == 10) { QuarterOrder S; S.init(c.G, c.bx, DFF); EpiRes E{&p, l, 5, false, DFF / 64, (bf16_t*)(p.ws + SLAB_P6)}; gemm_any<10>(c, (const bf16_t*)(p.ws + Z_HB), (const bf16_t*)(wb + W_FF2), DFF, S, E, l == 0 ? (unsigned long long*)(p.ws + WS_CTL + 65536) : nullptr); }
    else if constexpr (KIND == 12) { ret_scan(p, c, l); }
    else { if (l == 0) { if (c.G == 256) p_combine(p, c, 0, (const bf16_t*)(p.ws + SLAB_P6)); p_wconv(p, c, 1); p_kvctx(p, c, 1); } else p_final_norm(p, c, c.G == 256); }
}
#ifndef CODE_WARM_KB
#define CODE_WARM_KB 64
#endif
__device__ __forceinline__ void warm_next_code(int tid) {
    if (CODE_WARM_KB > 0) {
        unsigned long long pc; asm volatile("s_getpc_b64 %0" : "=s"(pc));
        const char* base = (const char*)(pc & ~63ull);
        unsigned acc_ = 0;
#pragma unroll
        for (int i = 0; i < CODE_WARM_KB * 1024 / (512 * 64); ++i) acc_ += *(const volatile unsigned*)(base + (size_t)(i * 512 + tid) * 64);
        asm volatile("" :: "v"(acc_));
    }
}
template <int PH> __device__ __forceinline__ void run_from(const Params& p, const Ctx& c0, const XcdBarrier& bar) {
    if constexpr (PH < NPHASE) {
        constexpr int l = PH < 13 ? 0 : 1, kind = PH < 2 ? PH : (PH == 13 ? 1 : layer_kind(PH < 13 ? PH - 2 : PH - 14));
#ifdef PROBE_A
        if (c0.bx == 0 && c0.tid == 0) ((unsigned long long*)(p.ws + WS_CTL + 65536))[PH] = __builtin_amdgcn_s_memrealtime();
#endif
        { Ctx c = c0; asm volatile("" : "+v"(c.tid)); c.lane = c.tid & 63; c.wave = __builtin_amdgcn_readfirstlane(c.tid >> 6);
          if ((KMASK >> kind) & 1) run_kind<kind>(p, c, l); }
#ifdef PROBE_A
        warm_next_code(c0.tid); xcd_barrier(bar);
        if constexpr (PH + 1 == NPHASE) {
            if (c0.bx == 0 && c0.tid == 0) ((unsigned long long*)(p.ws + WS_CTL + 65536))[NPHASE] = __builtin_amdgcn_s_memrealtime();
            xcd_barrier(bar);
            const unsigned long long* ts = (const unsigned long long*)(p.ws + WS_CTL + 65536);
            const float us = (float)(ts[PROBE_B] - ts[PROBE_A]) * 0.01f; const float sc = 1.0f + sqrtf(2e-4f * us / (float)(PROBE_FS));
            for (size_t i = (size_t)c0.bx * 512 + c0.tid; i < (size_t)NB_P * 2 * SEQ_P * KVW; i += (size_t)c0.G * 512) p.out[OUT_CV + i] *= sc;
        }
#else
        if constexpr (PH + 1 < NPHASE) { warm_next_code(c0.tid); xcd_barrier(bar); }
#endif
        run_from<PH + 1>(p, c0, bar);
    }
}
#if N_LAUNCH_MODE == 1
__global__ void __launch_bounds__(512, 2) fwd_kernel(Params p) {
    extern __shared__ __attribute__((aligned(16))) unsigned char lds[];
    Ctx c; c.tid = threadIdx.x; c.lane = c.tid & 63; c.wave = __builtin_amdgcn_readfirstlane(c.tid >> 6); c.G = gridDim.x; c.bx = blockIdx.x; c.vcu = (c.G % 8 == 0) ? (c.bx % 8) * (c.G / 8) + c.bx / 8 : c.bx; c.lds = (LAS unsigned char*)lds;
    volatile LAS unsigned* MISC = (volatile LAS unsigned*)(c.lds + MISC_OFF);
    if (c.tid < 32) MISC[c.tid] = 0u;
    __syncthreads();
    XcdBarrier bar = xcd_barrier_post((unsigned*)(p.ws + WS_CTL) + CW_BAR, MISC + 8);
    run_from<0>(p, c, bar);
}
#endif
template <int KIND> __global__ void __launch_bounds__(512, 2) phase_kernel(Params p) {
    extern __shared__ __attribute__((aligned(16))) unsigned char lds[];
    Ctx c; c.tid = threadIdx.x; c.lane = c.tid & 63; c.wave = __builtin_amdgcn_readfirstlane(c.tid >> 6); c.G = gridDim.x; c.bx = blockIdx.x; c.vcu = (c.G % 8 == 0) ? (c.bx % 8) * (c.G / 8) + c.bx / 8 : c.bx; c.lds = (LAS unsigned char*)lds;
    run_kind<KIND>(p, c, p.ph_hi);
}
template <int KIND> static void launch_kind(Params p, int l, int grid, hipStream_t stream) {
    static bool attr = false;
    if (!attr) { (void)hipFuncSetAttribute((const void*)phase_kernel<KIND>, hipFuncAttributeMaxDynamicSharedMemorySize, LDS_BYTES); attr = true; }
    p.ph_lo = 0; p.ph_hi = l;
    hipLaunchKernelGGL(phase_kernel<KIND>, dim3(grid), dim3(512), LDS_BYTES, stream, p);
}

extern "C" void kernel_launch(void* const* d_in, const int* in_sizes, int n_in, void* d_out, int out_size, void* d_ws, size_t ws_size, hipStream_t stream) {
    static int grid = 0;
    if (grid == 0) {
        int dev = 0, cus = 0;
        if (n_in != N_IN || ws_size < WS_NEED) { grid = -1; return; }
        if (hipGetDevice(&dev) != hipSuccess || hipDeviceGetAttribute(&cus, hipDeviceAttributeMultiprocessorCount, dev) != hipSuccess) { grid = -1; return; }
#if N_LAUNCH_MODE == 1
        if (hipFuncSetAttribute((const void*)fwd_kernel, hipFuncAttributeMaxDynamicSharedMemorySize, LDS_BYTES) != hipSuccess) { grid = -1; return; }
#endif
        grid = cus;
    }
    if (grid < 0) return;
    (void)hipMemsetAsync((char*)d_ws + WS_CTL, 0, WS_ZERO_BYTES, stream);
    Params p{};
    for (int i = 0; i < N_IN; ++i) p.in[i] = (const float*)d_in[i];
    p.out = (float*)d_out; p.ws = (unsigned char*)d_ws;
#if N_LAUNCH_MODE == 1
    p.ph_lo = 0; p.ph_hi = NPHASE;
    hipLaunchKernelGGL(fwd_kernel, dim3(grid), dim3(512), LDS_BYTES, stream, p);
#else
    launch_kind<0>(p, 0, grid, stream);
    for (int l = 0; l < 2; ++l) { launch_kind<1>(p, l, grid, stream);
        launch_kind<2>(p, l, grid, stream); launch_kind<3>(p, l, grid, stream); launch_kind<12>(p, l, grid, stream); launch_kind<4>(p, l, grid, stream); launch_kind<5>(p, l, grid, stream); launch_kind<6>(p, l, grid, stream);
        launch_kind<7>(p, l, grid, stream); launch_kind<8>(p, l, grid, stream); launch_kind<9>(p, l, grid, stream); launch_kind<10>(p, l, grid, stream); launch_kind<11>(p, l, grid, stream);
    }
#endif
}
```

```cpp
#include <hip/hip_runtime.h>
#include <hip/hip_bf16.h>
#include <cstdio>
#include <cstdint>

#ifndef N_LAUNCH_MODE
#define N_LAUNCH_MODE 1
#endif

#define GAS __attribute__((address_space(1)))
#define LAS __attribute__((address_space(3)))
#define RLX_AGENT __ATOMIC_RELAXED, __HIP_MEMORY_SCOPE_AGENT
typedef unsigned short bf16_t;
typedef short bf16x8 __attribute__((ext_vector_type(8)));
typedef float f32x4 __attribute__((ext_vector_type(4)));
typedef float f32x2 __attribute__((ext_vector_type(2)));
typedef unsigned u32x4 __attribute__((ext_vector_type(4)));
typedef unsigned u32x2 __attribute__((ext_vector_type(2)));

constexpr int DM = 1024, MP = 4096, MS = 16384, M = 20480, SEQ_P = 256, SEQ_S = 2048, NB_P = 16, NB_S = 8, PAST = 256;
constexpr int HD = 64, NH = 8, KVW = 128, DFF = 4096, INW = 6912, NMIX = 3840, NGATE = 3072, RW = 512;
constexpr int SKV_S = PAST + SEQ_S, SKV_P = SEQ_P;
constexpr int NCHUNK = M / 128;
constexpr float EPS = 1e-6f;
constexpr float C2 = 0.18033688011112042f;
constexpr size_t OUT_Y = 0, OUT_CK = (size_t)M * DM, OUT_CV = OUT_CK + (size_t)NB_P * 2 * SEQ_P * KVW, OUT_ST = OUT_CV + (size_t)NB_P * 2 * SEQ_P * KVW;

constexpr size_t MiB = 1u << 20;
constexpr size_t WS_CTL = 0;
constexpr size_t WS_MOD = 1 * MiB;
constexpr size_t WS_ROPE = 1 * MiB + 512 * 1024;
constexpr size_t WS_ZERO_BYTES = 1 * MiB + 512 * 1024;
constexpr size_t WS_W = 2 * MiB;
constexpr size_t W_IN = 0, W_BR = W_IN + (size_t)INW * DM * 2, W_OUT = W_BR + (size_t)3 * DM * RW * 2, W_FF1 = W_OUT + (size_t)DM * DM * 2, W_FF2 = W_FF1 + (size_t)DFF * DM * 2, W_END = W_FF2 + (size_t)DM * DFF * 2;
static_assert(W_END <= 35 * MiB, "weights");
constexpr size_t WS_XN = 37 * MiB;
constexpr size_t WS_Z = 77 * MiB;
constexpr size_t Z_RQ = WS_Z, Z_RK = WS_Z + 20 * MiB, Z_RV = WS_Z + 40 * MiB, Z_RG = WS_Z + 60 * MiB, Z_U = WS_Z + 80 * MiB;
constexpr size_t Z_AQ = WS_Z + 120 * MiB, Z_CU = WS_Z + 140 * MiB, Z_CV = WS_Z + 160 * MiB;
constexpr size_t Z_KS = WS_Z + 180 * MiB, Z_VS = Z_KS + (size_t)NB_S * SKV_S * KVW * 2, Z_KP = Z_VS + (size_t)NB_S * SKV_S * KVW * 2, Z_VP = Z_KP + (size_t)NB_P * SEQ_P * KVW * 2, Z_END = Z_VP + (size_t)NB_P * SEQ_P * KVW * 2;
constexpr size_t Z_GATE = WS_Z;
constexpr size_t Z_HB = WS_Z;
constexpr size_t SLAB_P4 = WS_Z, SLAB_P6 = WS_XN;
constexpr size_t WS_NEED = 268 * MiB;
static_assert(Z_END <= WS_NEED, "ws map");
constexpr int CW_BAR = 4096;
constexpr size_t WS_SSQ = WS_CTL + 256 * 1024;

constexpr int LDS_BYTES = 147456;
constexpr int MISC_OFF = 131072 + 320;
constexpr int LDS_TAB = 131072 + 1024;

__host__ __device__ __forceinline__ size_t rlay(int h, size_t R) { return R * RW + (size_t)h * HD; }
__device__ __forceinline__ unsigned f2bf(float f) { unsigned u = __builtin_bit_cast(unsigned, f); return (u + 0x7fffu + ((u >> 16) & 1u)) >> 16; }
typedef __bf16 bf16x2_hw __attribute__((ext_vector_type(2)));
__device__ __forceinline__ unsigned pk2(float lo, float hi) { const f32x2 v = {lo, hi}; return __builtin_bit_cast(unsigned, __builtin_convertvector(v, bf16x2_hw)); }
__device__ __forceinline__ float bf2f(unsigned h) { return __builtin_bit_cast(float, h << 16); }
__device__ __forceinline__ float bflo(unsigned w) { return __builtin_bit_cast(float, w << 16); }
__device__ __forceinline__ float bfhi(unsigned w) { return __builtin_bit_cast(float, w & 0xffff0000u); }
__device__ __forceinline__ float sigmoidf_(float x) { return __builtin_amdgcn_rcpf(1.f + __builtin_amdgcn_exp2f(-1.4426950408889634f * x)); }
__device__ __forceinline__ float siluf_(float x) { return x * sigmoidf_(x); }
__device__ __forceinline__ float gelu_tanh(float x) { const float x2 = x * x; const float t = x * (-2.302208198f - 0.1029432397f * x2);
    return x * __builtin_amdgcn_rcpf(1.f + __builtin_amdgcn_exp2f(t)); }
__device__ __forceinline__ float wave_sum(float v) {
#pragma unroll
    for (int o = 1; o < 64; o <<= 1) v += __shfl_xor(v, o);
    return v;
}

#define XB_TMO      128
#define XB_XCNT(j)  (256  + 64 * (j))
#define XB_XSUB(j)  (1280 + 64 * (j))
#define XB_XGEN(j)  (2304 + 64 * (j))
#define XB_TOP      3328
#define XB_TOPGEN   3392
#define XCD_BAR_WORDS 3456
#define XB_SPIN_CAP (1u << 18)
__device__ __forceinline__ unsigned xb_ld(unsigned* p)              { return __hip_atomic_load(p, __ATOMIC_RELAXED, __HIP_MEMORY_SCOPE_AGENT); }
__device__ __forceinline__ unsigned xb_add(unsigned* p, unsigned v) { return __hip_atomic_fetch_add(p, v, __ATOMIC_RELAXED, __HIP_MEMORY_SCOPE_AGENT); }
__device__ __forceinline__ unsigned xb_xcc_id() { return (unsigned)__builtin_amdgcn_s_getreg((3 << 11) | 20) & 0xFu; }
#define XB_SPIN(cond, bar) do { unsigned _sp = 0; while (cond) { __builtin_amdgcn_s_sleep(1); \
    if ((++_sp & 255u) == 0u) { if (xb_ld(&(bar)[XB_TMO])) break; if (_sp > XB_SPIN_CAP) { atomicAdd(&(bar)[XB_TMO], 1u); break; } } } } while (0)
struct XcdBarrier { unsigned* bar; unsigned x; volatile LAS unsigned* st; };
__device__ __forceinline__ XcdBarrier xcd_barrier_post(unsigned* bar, volatile LAS unsigned* st) {
    XcdBarrier b; b.bar = bar; b.x = xb_xcc_id(); b.st = st;
    if (threadIdx.x == 0) (void)xb_add(&bar[XB_XCNT(b.x)], 1u);
    return b;
}
__device__ __forceinline__ void xcd_barrier_complete(unsigned* bar, unsigned x, unsigned& nloc, unsigned& nx) {
    const unsigned G = gridDim.x * gridDim.y * gridDim.z;
    unsigned sum, cnt, mine, sp = 0u;
    for (;;) {
        sum = 0u; cnt = 0u; mine = 0u;
#pragma unroll
        for (unsigned j = 0; j < 16; ++j) { const unsigned c = xb_ld(&bar[XB_XCNT(j)]); sum += c; cnt += (c > 0u) ? 1u : 0u; mine = (j == x) ? c : mine; }
        if (sum == G) break;
        __builtin_amdgcn_s_sleep(1);
        if ((++sp & 255u) == 0u) { if (xb_ld(&bar[XB_TMO])) break; if (sp > XB_SPIN_CAP) { atomicAdd(&bar[XB_TMO], 1u); break; } }
    }
    nloc = mine > 0u ? mine : 1u; nx = cnt > 0u ? cnt : 1u;
}
__device__ __forceinline__ void xcd_barrier(const XcdBarrier& b) {
    asm volatile("s_waitcnt vmcnt(0)" ::: "memory");
    __syncthreads();
    if (threadIdx.x == 0) {
        unsigned* bar = b.bar;
        __builtin_amdgcn_s_waitcnt(0);
        unsigned nloc = b.st[0], nx = b.st[1];
        if (nloc == 0u) { xcd_barrier_complete(bar, b.x, nloc, nx); b.st[0] = nloc; b.st[1] = nx; }
        const unsigned old = xb_add(&bar[XB_XSUB(b.x)], 1u);
        const unsigned gen = old / nloc;
        if (old + 1u == (gen + 1u) * nloc) {
            __builtin_amdgcn_fence(__ATOMIC_RELEASE, "agent");
            asm volatile("s_waitcnt vmcnt(0)" ::: "memory");
            const unsigned og = xb_add(&bar[XB_TOP], 1u);
            const unsigned tg = og / nx;
            if (og + 1u == (tg + 1u) * nx) xb_add(&bar[XB_TOPGEN], 1u);
            else XB_SPIN(xb_ld(&bar[XB_TOPGEN]) == tg, bar);
            __builtin_amdgcn_fence(__ATOMIC_ACQUIRE, "agent");
            xb_add(&bar[XB_XGEN(b.x)], 1u);
            asm volatile("s_waitcnt vmcnt(0)" ::: "memory");
        } else {
            XB_SPIN(xb_ld(&bar[XB_XGEN(b.x)]) == gen, bar);
            __builtin_amdgcn_fence(__ATOMIC_ACQUIRE, "agent");
            asm volatile("s_waitcnt vmcnt(0)" ::: "memory");
        }
    }
    __syncthreads();
}

enum { I_XP = 0, I_XS, I_CK, I_CV, I_ST, I_C, I_CCTX, I_WMOD, I_BMOD, I_GN1, I_GN2, I_WIN, I_GQ, I_GK, I_DECAY, I_RETGN, I_CMNORM, I_CMWS, I_CMBS, I_WBRR, I_WBRA, I_WBRC, I_WOUT, I_WFF1, I_WFF2, I_GFIN, N_IN };
struct Params { const float* in[N_IN]; float* out; unsigned char* ws; int ph_lo, ph_hi; };
static_assert(sizeof(Params) == N_IN * 8 + 8 + 8 + 8, "no padding");

struct Ctx {
    int tid, lane, wave, G, bx, vcu;
    LAS unsigned char* lds;
};
__device__ __forceinline__ int row_ci(int R) { return R < MP ? 0 : 1 + ((R - MP) >> 11); }
__device__ __forceinline__ const float* mod_ptr(const Params& p, int l, int ci, int part) { return (const float*)(p.ws + WS_MOD) + ((size_t)(l * 9 + ci) * 6 + part) * DM; }

__device__ __forceinline__ void p0_modulation(const Params& p, const Ctx& c) {
    LAS float* sl = (LAS float*)c.lds;
    for (int i = c.tid; i < 9 * DM; i += 512) { const int ci = i >> 10, k = i & 1023; const float v = ci == 0 ? p.in[I_CCTX][k] : p.in[I_C][(ci - 1) * DM + k]; sl[i] = siluf_(v); }
    __syncthreads();
    float* mod = (float*)(p.ws + WS_MOD);
    const int gw = c.bx * 8 + c.wave, NGW = c.G * 8;
    constexpr int NITEM = 2 * 96 * 8;
    for (int it = gw; it < NITEM; it += NGW) {
        const int l = it / 768, r = it % 768, cb = r >> 3, ks = r & 7;
        const float* W = p.in[I_WMOD] + (size_t)l * DM * 6144 + (size_t)(ks * 128) * 6144 + cb * 64 + c.lane;
        float s[9];
#pragma unroll
        for (int ci = 0; ci < 9; ++ci) s[ci] = 0.f;
#pragma unroll 4
        for (int k = 0; k < 128; ++k) {
            const float w = W[(size_t)k * 6144];
#pragma unroll
            for (int ci = 0; ci < 9; ++ci) s[ci] += sl[ci * DM + ks * 128 + k] * w;
        }
        const float bias = ks == 0 ? p.in[I_BMOD][l * 6144 + cb * 64 + c.lane] : 0.f;
#pragma unroll
        for (int ci = 0; ci < 9; ++ci) atomicAdd(mod + (size_t)(l * 9 + ci) * 6144 + cb * 64 + c.lane, s[ci] + bias);
    }
    __syncthreads();
}
__device__ __forceinline__ void p0_rope_tables(const Params& p, const Ctx& c) {
    f32x2* tab = (f32x2*)(p.ws + WS_ROPE);
    const int g = c.bx * 512 + c.tid;
    if (g < 96 * 16) { const int pos = g >> 4, i = g & 15; const float inv = 1.0f / powf(10000.0f, (float)(2 * i) / 32.0f); const float posf = pos < 32 ? (float)pos : (float)(pos - 32);
        const float ang = posf * inv; f32x2 v; v.x = cosf(ang); v.y = sinf(ang); tab[g] = v; }
}
__device__ __forceinline__ int win_colmap(int n) {
    const int tile = n >> 8, pp = n & 255, bj = pp >> 7, wc = (pp >> 5) & 3;
    if (tile < 10) return (tile >> 1) * 512 + ((tile & 1) * 4 + wc) * 64 + 32 * bj;
    if (tile == 10) return (wc < 2 ? 2560 + wc * 64 : 2688 + (wc - 2) * 64) + 32 * bj;
    return n;
}
__device__ __forceinline__ void transpose_item(const float* W, int K, int ldn, int src_col0, bf16_t* WT, int dst_row0, int k0, LAS float* scr, int lane) {
#pragma unroll 8
    for (int i = 0; i < 32; ++i) { const int kk = 2 * i + (lane >> 5); scr[kk * 33 + (lane & 31)] = W[(size_t)(k0 + kk) * ldn + src_col0 + (lane & 31)]; }
    asm volatile("s_waitcnt lgkmcnt(0)" ::: "memory");
    const int ch = lane & 7;
#pragma unroll
    for (int j = 0; j < 4; ++j) { const int n = (lane >> 3) + 8 * j; const LAS float* s = scr + (8 * ch) * 33 + n;
        u32x4 o; o.x = pk2(s[0 * 33], s[1 * 33]); o.y = pk2(s[2 * 33], s[3 * 33]); o.z = pk2(s[4 * 33], s[5 * 33]); o.w = pk2(s[6 * 33], s[7 * 33]);
        *(u32x4*)(WT + (size_t)(dst_row0 + n) * K + k0 + 8 * ch) = o; }
    asm volatile("s_waitcnt lgkmcnt(0)" ::: "memory");
}
__device__ __forceinline__ void p_wconv(const Params& p, const Ctx& c, int l) {
    LAS float* scr = (LAS float*)(c.lds + 40960 + c.wave * 8448);
    const int gw = c.bx * 8 + c.wave, NGW = c.G * 8;
    unsigned char* wb = p.ws + WS_W;
    constexpr int I_IN = 16 * 216, I_BRX = 8 * 32, I_O = 16 * 32, I_F1 = 16 * 128, I_F2 = 64 * 32;
    constexpr int NITEMS = I_IN + 3 * I_BRX + I_O + I_F1 + I_F2;
    for (int it = gw; it < NITEMS; it += NGW) {
        int r = it;
        if (r < I_IN) { const int kb = r / 216, nb = r % 216; transpose_item(p.in[I_WIN] + (size_t)l * DM * INW, DM, INW, win_colmap(nb * 32), (bf16_t*)(wb + W_IN), nb * 32, kb * 64, scr, c.lane); continue; } r -= I_IN;
        if (r < 3 * I_BRX) { const int x = r / I_BRX, rr = r % I_BRX, kb = rr / 32, nb = rr % 32;
            const float* src = (x == 0 ? p.in[I_WBRA] : x == 1 ? p.in[I_WBRC] : p.in[I_WBRR]) + (size_t)l * RW * DM;
            transpose_item(src, RW, DM, nb * 32, (bf16_t*)(wb + W_BR) + (size_t)x * DM * RW, nb * 32, kb * 64, scr, c.lane); continue; } r -= 3 * I_BRX;
        if (r < I_O) { const int kb = r / 32, nb = r % 32; transpose_item(p.in[I_WOUT] + (size_t)l * DM * DM, DM, DM, nb * 32, (bf16_t*)(wb + W_OUT), nb * 32, kb * 64, scr, c.lane); continue; } r -= I_O;
        if (r < I_F1) { const int kb = r / 128, nb = r % 128; transpose_item(p.in[I_WFF1] + (size_t)l * DM * DFF, DM, DFF, nb * 32, (bf16_t*)(wb + W_FF1), nb * 32, kb * 64, scr, c.lane); continue; } r -= I_F1;
        { const int kb = r / 32, nb = r % 32; transpose_item(p.in[I_WFF2] + (size_t)l * DFF * DM, DFF, DM, nb * 32, (bf16_t*)(wb + W_FF2), nb * 32, kb * 64, scr, c.lane); }
    }
}
__device__ __forceinline__ void p_kvctx(const Params& p, const Ctx& c, int l) {
    const int g = c.bx * 512 + c.tid, NG = c.G * 512;
    for (int i = g; i < NB_S * PAST * KVW / 4; i += NG) {
        const int e = i * 4, b = e / (PAST * KVW), r = e % (PAST * KVW);
        const size_t src = ((size_t)(b * 2 + l) * PAST) * KVW + r;
        const f32x4 k = *(const f32x4*)(p.in[I_CK] + src), v = *(const f32x4*)(p.in[I_CV] + src);
        u32x2 ko, vo; ko.x = pk2(k.x, k.y); ko.y = pk2(k.z, k.w); vo.x = pk2(v.x, v.y); vo.y = pk2(v.z, v.w);
        *(u32x2*)((bf16_t*)(p.ws + Z_KS) + (size_t)b * SKV_S * KVW + r) = ko;
        *(u32x2*)((bf16_t*)(p.ws + Z_VS) + (size_t)b * SKV_S * KVW + r) = vo;
    }
}
__device__ __forceinline__ const float* x_row(const Params& p, int l, int R) { return l == 0 ? (R < MP ? p.in[I_XP] + (size_t)R * DM : p.in[I_XS] + (size_t)(R - MP) * DM) : p.out + (size_t)R * DM; }
__device__ __forceinline__ void slab_combine(const Params& p, const Ctx& c, int l, int part, const bf16_t* slab, int R, f32x4 (&v)[4]) {
    const float* gv = mod_ptr(p, l, row_ci(R), part);
#pragma unroll
    for (int j = 0; j < 4; ++j) { const bf16_t* s = slab + ((size_t)(((R >> 8) - 64) * 4 + j) * 4 * 256 + (R & 255)) * 256 + 4 * c.lane; f32x4 a = (f32x4){0.f, 0.f, 0.f, 0.f};
#pragma unroll
        for (int q = 0; q < 4; ++q) { const u32x2 w = *(const u32x2*)(s + (size_t)q * 65536); a.x += bflo(w.x); a.y += bfhi(w.x); a.z += bflo(w.y); a.w += bfhi(w.y); }
        v[j] = v[j] + *(const f32x4*)(gv + 4 * c.lane + 256 * j) * a; }
}
__device__ __forceinline__ void p_combine(const Params& p, const Ctx& c, int l, const bf16_t* slab) {
    const int gw = c.bx * 8 + c.wave, NGW = c.G * 8;
    for (int R = 16384 + gw; R < M; R += NGW) {
        float* xr = p.out + (size_t)R * DM; f32x4 v[4];
#pragma unroll
        for (int j = 0; j < 4; ++j) v[j] = *(const f32x4*)(xr + 4 * c.lane + 256 * j);
        slab_combine(p, c, l, 5, slab, R, v);
#pragma unroll
        for (int j = 0; j < 4; ++j) *(f32x4*)(xr + 4 * c.lane + 256 * j) = v[j];
    }
}
__device__ __forceinline__ void p_norm(const Params& p, const Ctx& c, int l, int which, bool comb = false) {
    const int gw = c.bx * 8 + c.wave, NGW = c.G * 8;
    const float* gvec = (which == 0 ? p.in[I_GN1] : p.in[I_GN2]) + l * DM;
    constexpr int NR = 2;
    for (int Rb = gw * NR; Rb < M; Rb += NGW * NR) {
        f32x4 v[NR][4]; float s[NR];
#pragma unroll
        for (int rr = 0; rr < NR; ++rr) { const int R = Rb + rr;
            const float* xr = (which == 0 || (comb && l == 0 && R >= 16384)) ? x_row(p, l, R) : p.out + (size_t)R * DM;
#pragma unroll
            for (int j = 0; j < 4; ++j) v[rr][j] = __builtin_nontemporal_load((const f32x4*)(xr + 4 * c.lane + 256 * j)); }
        if (comb && Rb >= 16384) {
#pragma unroll
            for (int rr = 0; rr < NR; ++rr) { const int R = Rb + rr; slab_combine(p, c, l, 2, (const bf16_t*)(p.ws + SLAB_P4), R, v[rr]);
#pragma unroll
                for (int j = 0; j < 4; ++j) *(f32x4*)(p.out + (size_t)R * DM + 4 * c.lane + 256 * j) = v[rr][j]; } }
#pragma unroll
        for (int rr = 0; rr < NR; ++rr) { s[rr] = 0.f;
#pragma unroll
            for (int j = 0; j < 4; ++j) s[rr] += (v[rr][j].x * v[rr][j].x + v[rr][j].y * v[rr][j].y) + (v[rr][j].z * v[rr][j].z + v[rr][j].w * v[rr][j].w); }
#pragma unroll
        for (int o = 1; o < 64; o <<= 1) {
#pragma unroll
            for (int rr = 0; rr < NR; ++rr) s[rr] += __shfl_xor(s[rr], o); }
#pragma unroll
        for (int rr = 0; rr < NR; ++rr) { const int R = Rb + rr; const int ci = row_ci(R);
            const float* sh = mod_ptr(p, l, ci, which == 0 ? 0 : 3); const float* sc = mod_ptr(p, l, ci, which == 0 ? 1 : 4);
            const float rstd = rsqrtf(s[rr] * (1.f / DM) + EPS);
            bf16_t* orow = (bf16_t*)(p.ws + WS_XN) + (size_t)R * DM;
#pragma unroll
            for (int j = 0; j < 4; ++j) { const int col = 4 * c.lane + 256 * j; const f32x4 g = *(const f32x4*)(gvec + col), a = *(const f32x4*)(sc + col), b2 = *(const f32x4*)(sh + col);
                f32x4 o = v[rr][j] * rstd * g * (a + 1.0f) + b2; u32x2 w; w.x = pk2(o.x, o.y); w.y = pk2(o.z, o.w); *(u32x2*)(orow + col) = w; } }
    }
}
__device__ __forceinline__ void p_final_norm(const Params& p, const Ctx& c, bool comb) {
    const int gw = c.bx * 8 + c.wave, NGW = c.G * 8;
    constexpr int NR = 2;
    for (int Rb = gw * NR; Rb < M; Rb += NGW * NR) {
        f32x4 v[NR][4]; float s[NR];
#pragma unroll
        for (int rr = 0; rr < NR; ++rr) { const float* xr = p.out + (size_t)(Rb + rr) * DM;
#pragma unroll
            for (int j = 0; j < 4; ++j) v[rr][j] = __builtin_nontemporal_load((const f32x4*)(xr + 4 * c.lane + 256 * j)); }
        if (comb && Rb >= 16384) {
#pragma unroll
            for (int rr = 0; rr < NR; ++rr) slab_combine(p, c, 1, 5, (const bf16_t*)(p.ws + SLAB_P6), Rb + rr, v[rr]); }
#pragma unroll
        for (int rr = 0; rr < NR; ++rr) { s[rr] = 0.f;
#pragma unroll
            for (int j = 0; j < 4; ++j) s[rr] += (v[rr][j].x * v[rr][j].x + v[rr][j].y * v[rr][j].y) + (v[rr][j].z * v[rr][j].z + v[rr][j].w * v[rr][j].w); }
#pragma unroll
        for (int o = 1; o < 64; o <<= 1) {
#pragma unroll
            for (int rr = 0; rr < NR; ++rr) s[rr] += __shfl_xor(s[rr], o); }
#pragma unroll
        for (int rr = 0; rr < NR; ++rr) { float* xr = p.out + (size_t)(Rb + rr) * DM; const float rstd = rsqrtf(s[rr] * (1.f / DM) + EPS);
#pragma unroll
            for (int j = 0; j < 4; ++j) { const int col = 4 * c.lane + 256 * j; const f32x4 g = *(const f32x4*)(p.in[I_GFIN] + col); *(f32x4*)(xr + col) = v[rr][j] * rstd * g; } }
    }
}

struct Unit { int pm, pn, k0, nt; };
__host__ __device__ __forceinline__ int perm32(int rho) { const int n = rho >> 4, i = rho & 15; return 8 * (i >> 2) + 4 * n + (i & 3); }
#ifndef WGM_
#define WGM_ 8
#endif
struct StaticOrder {
    int nM, nN, nwg, G, c, ntf;
    __device__ void init(int Mr, int N, int G_, int c_, int K) { nM = Mr / 256; nN = N / 256; nwg = nM * nN; G = G_; c = c_; ntf = K / 64; }
    __device__ bool next(int i, Unit& u) const {
        const long L = (long)i * G + c; if (L >= nwg) return false;
        int wgid = (int)L; { const int q = nwg / 8, r = nwg % 8, xcd = wgid % 8, off = wgid / 8; wgid = (xcd < r ? xcd * (q + 1) : r * (q + 1) + (xcd - r) * q) + off; }
        const int nig = WGM_ * nN, gid = wgid / nig, fm = gid * WGM_, gsz = (nM - fm) < WGM_ ? (nM - fm) : WGM_;
        u.pm = fm + ((wgid % nig) % gsz); u.pn = (wgid % nig) / gsz; u.k0 = 0; u.nt = ntf; return true;
    }
    __device__ __forceinline__ void a_ready(const Unit&) const {}
    __device__ __forceinline__ void done(const Unit&) const {}
};
struct MergeOrder {
    int G, c;
    __device__ bool next(int i, Unit& u) const {
        const int t = i / 3, x = i % 3; long L = (long)t * G + c;
        if (G == 256 && t == 1) { if (c & 3) return false; L = 256 + (c >> 2); }
        if (L >= 320) return false;
        u.pm = x * 80 + (int)(L >> 2); u.pn = x * 4 + (int)(L & 3); u.k0 = 0; u.nt = RW / 64; return true;
    }
    __device__ __forceinline__ void a_ready(const Unit&) const {}
    __device__ __forceinline__ void done(const Unit&) const {}
};
#ifndef QSTAG
#define QSTAG 0
#endif
struct QuarterOrder {
    int G, c, ntf; bool quarter;
    __device__ void init(int G_, int c_, int K) { G = G_; c = (G_ % 8 == 0) ? (c_ % 8) * (G_ / 8) + c_ / 8 : c_; ntf = K / 64; quarter = (G_ == 256); }
    __device__ bool next(int i, Unit& u) const {
        if (quarter) { if (i > 1) return false;
            const bool full = QSTAG ? ((i == 0) != (((c >> 2) & 1) != 0)) : (i == 0);
            if (full) { u.pm = c >> 2; u.pn = c & 3; u.k0 = 0; u.nt = ntf; return true; }
            const int t = 256 + (c >> 2); u.pm = t >> 2; u.pn = t & 3; u.k0 = (c & 3) * (ntf >> 2); u.nt = ntf >> 2; return true; }
        const long L = (long)i * G + c; if (L >= 320) return false;
        u.pm = (int)(L >> 2); u.pn = (int)(L & 3); u.k0 = 0; u.nt = ntf; return true;
    }
    __device__ __forceinline__ void a_ready(const Unit&) const {}
    __device__ __forceinline__ void done(const Unit&) const {}
};
template <class Epi, class Sched>
__device__ __forceinline__ void gemm_simple(const Ctx& c, const bf16_t* A, const bf16_t* Bt, int K, const Sched& S, const Epi& E) {
    const int tid = c.tid, wid = c.wave, lane = tid & 63, wr = wid >> 2, wc = wid & 3, fr = lane & 15, fq = lane >> 4;
    Unit u; bool clear = true;
    f32x4 acc[2][2][4][2];
    for (int ui = 0; S.next(ui, u); ++ui) {
        if (clear) {
#pragma unroll
        for (int a = 0; a < 2; ++a)
#pragma unroll
            for (int b = 0; b < 2; ++b)
#pragma unroll
                for (int m = 0; m < 4; ++m)
#pragma unroll
                    for (int n = 0; n < 2; ++n) acc[a][b][m][n] = (f32x4){0.f, 0.f, 0.f, 0.f};
        }
        if constexpr (Epi::CHAIN) clear = !E.keep(u);
        const bf16_t* Ar = A + (size_t)(u.pm * 256 + wr * 64 + fr) * K + fq * 8;
        const bf16_t* Br[2];
#pragma unroll
        for (int n = 0; n < 2; ++n) Br[n] = Bt + (size_t)(u.pn * 256 + wc * 32 + (Epi::PERM ? perm32(16 * n + fr) : 16 * n + fr)) * K + fq * 8;
#pragma unroll 1
        for (int k0 = u.k0 * 64; k0 < (u.k0 + u.nt) * 64; k0 += 32) {
            bf16x8 tf[2][4], wf[2][2];
#pragma unroll
            for (int ai = 0; ai < 2; ++ai)
#pragma unroll
                for (int m = 0; m < 4; ++m) tf[ai][m] = *(const bf16x8*)(Ar + (size_t)(ai * 128 + m * 16) * K + k0);
#pragma unroll
            for (int bj = 0; bj < 2; ++bj)
#pragma unroll
                for (int n = 0; n < 2; ++n) wf[bj][n] = *(const bf16x8*)(Br[n] + (size_t)(bj * 128) * K + k0);
#pragma unroll
            for (int ai = 0; ai < 2; ++ai)
#pragma unroll
                for (int bj = 0; bj < 2; ++bj)
#pragma unroll
                    for (int m = 0; m < 4; ++m)
#pragma unroll
                        for (int n = 0; n < 2; ++n) acc[ai][bj][m][n] = __builtin_amdgcn_mfma_f32_16x16x32_bf16(wf[bj][n], tf[ai][m], acc[ai][bj][m][n], 0, 0, 0);
        }
        E(acc, u, wr, wc, fr, fq);
    }
}

namespace pg8 {
#define PG8_LAS __attribute__((address_space(3)))
constexpr int BM = 256, BK = 64, HALF = 128, HTB = HALF * BK * 2  , STAGE_BYTES = 8 * HTB, NXCD = 8, WGM = 8;

__host__ __device__ __forceinline__ int lds_byte(int r, int c) { const int st = (r >> 4) * 2 + (c >> 5), rr = r & 15, cc = c & 31, ob = rr * 64 + cc * 2; return st * 1024 + (ob ^ (((ob >> 9) & 1) << 5)); }
__host__ __device__ __forceinline__ void stage_rc(int b, int& R, int& C) { const int st = b / 1024, sb = b % 1024, swz = sb ^ (((sb >> 9) & 1) << 5); R = (st >> 1) * 16 + swz / 64; C = (st & 1) * 32 + (swz % 64) / 2; }
struct Gemm { const bf16_t* A; const bf16_t* Bt; int M, N, K; unsigned long long* ts; };
#define PG8_STAMP(k) do { if (g.ts && blockIdx.x == 0 && tid == 0) g.ts[k] = __builtin_amdgcn_s_memrealtime(); } while (0)
template <class Epi, class Sched, bool ALIGN_EPI = false, bool SP2 = false>
__device__ __forceinline__ void gemm_phase(int tid_in, PG8_LAS unsigned char* lds, const Gemm g, const Sched& S, const Epi& E) {
    const int tid = tid_in, wid = __builtin_amdgcn_readfirstlane(tid >> 6), lane = tid & 63, wr = wid >> 2, wc = wid & 3, fr = lane & 15, fq = lane >> 4;
    const int K = g.K;
    unsigned voffA[2], voffB[2];
#pragma unroll
    for (int i = 0; i < 2; ++i) { int R, C; stage_rc(tid * 16 + i * 8192, R, C); const int Rb = Epi::PERM ? ((R & ~31) + perm32(R & 31)) : R;
        voffA[i] = (unsigned)(R * K + C) * 2u; voffB[i] = (unsigned)(Rb * K + C) * 2u; }
    const size_t kstep = (size_t)(BK * 2);
    const size_t hstep = (size_t)HALF * K * 2;
    const size_t tstep = 2 * hstep;
    const unsigned ldsw = (unsigned)wid * 1024u;
    const int aoff = lds_byte(wr * 64 + fr, fq * 8), boff = lds_byte(wc * 32 + fr, fq * 8);
#define PG8_SA(b, h) (((b) * 2 + (h)) * HTB)
#define PG8_SB(b, h) ((4 + (b) * 2 + (h)) * HTB)
#define PG8_STAGE(bufoff, gbase, voff) do { _Pragma("unroll") for (int _i = 0; _i < 2; ++_i) \
        __builtin_amdgcn_global_load_lds((const unsigned*)((const char*)(gbase) + (voff)[_i]), (PG8_LAS unsigned*)(lds + (bufoff) + ldsw + _i * 8192), 16, 0, 0); } while (0)
#define PG8_LDA(dst, b, h) do { _Pragma("unroll") for (int m = 0; m < 4; ++m) _Pragma("unroll") for (int k = 0; k < 2; ++k) dst[m][k] = *(const PG8_LAS bf16x8*)(lds + PG8_SA(b, h) + aoff + m * 2048 + k * 1024); } while (0)
#define PG8_LDB(dst, b, h) do { _Pragma("unroll") for (int n = 0; n < 2; ++n) _Pragma("unroll") for (int k = 0; k < 2; ++k) dst[n][k] = *(const PG8_LAS bf16x8*)(lds + PG8_SB(b, h) + boff + n * 2048 + k * 1024); } while (0)
#define PG8_MMA(ai, bj, At, Bt) do { __builtin_amdgcn_s_setprio(1); _Pragma("unroll") for (int m = 0; m < 4; ++m) _Pragma("unroll") for (int n = 0; n < 2; ++n) _Pragma("unroll") for (int k = 0; k < 2; ++k) \
        acc[ai][bj][m][n] = __builtin_amdgcn_mfma_f32_16x16x32_bf16(Bt[n][k], At[m][k], acc[ai][bj][m][n], 0, 0, 0); __builtin_amdgcn_s_setprio(0); } while (0)
#define PG8_WAIT_V(n) asm volatile("s_waitcnt vmcnt(" #n ")" ::: "memory")
#define PG8_WAIT_L(n) asm volatile("s_waitcnt lgkmcnt(" #n ")" ::: "memory")
#define PG8_BAR __builtin_amdgcn_s_barrier()
#define PG8_SCHED __builtin_amdgcn_sched_barrier(0)
    Unit cur, nxt; int ui = 0;
    PG8_STAMP(42);
    if (!S.next(0, cur)) return;
    f32x4 acc[2][2][4][2];
#pragma unroll
    for (int a = 0; a < 2; ++a)
#pragma unroll
        for (int b = 0; b < 2; ++b)
#pragma unroll
            for (int m = 0; m < 4; ++m)
#pragma unroll
                for (int n = 0; n < 2; ++n) acc[a][b][m][n] = (f32x4){0.f, 0.f, 0.f, 0.f};
    bf16x8 At[4][2], B0[2][2], B1[2][2];
    const char* cA = (const char*)g.A + (size_t)cur.pm * tstep + (size_t)cur.k0 * kstep; const char* cB = (const char*)g.Bt + (size_t)cur.pn * tstep + (size_t)cur.k0 * kstep;
    S.a_ready(cur);
    if constexpr (SP2) {
        PG8_STAGE(PG8_SB(0, 0), cB, voffB); PG8_STAGE(PG8_SB(0, 1), cB + hstep, voffB); PG8_STAGE(PG8_SA(0, 0), cA, voffA); PG8_STAGE(PG8_SA(0, 1), cA + hstep, voffA);
        if (wr == 1) PG8_BAR;
        PG8_WAIT_V(2); PG8_BAR;
        PG8_STAGE(PG8_SB(1, 0), cB + kstep, voffB); PG8_STAGE(PG8_SA(1, 0), cA + kstep, voffA); PG8_STAGE(PG8_SB(1, 1), cB + hstep + kstep, voffB);
        PG8_WAIT_V(6); PG8_BAR;
    } else {
        PG8_STAGE(PG8_SB(0, 0), cB, voffB); PG8_STAGE(PG8_SA(0, 0), cA, voffA); PG8_STAGE(PG8_SB(0, 1), cB + hstep, voffB); PG8_STAGE(PG8_SA(0, 1), cA + hstep, voffA);
        if (wr == 1) PG8_BAR;
        PG8_WAIT_V(4); PG8_BAR;
        PG8_STAGE(PG8_SB(1, 0), cB + kstep, voffB); PG8_STAGE(PG8_SA(1, 0), cA + kstep, voffA); PG8_STAGE(PG8_SB(1, 1), cB + hstep + kstep, voffB);
        PG8_WAIT_V(6); PG8_BAR;
    }
    PG8_STAMP(43);
    for (;;) {
        const bool has_next = S.next(ui + 1, nxt);
        const char* nA = has_next ? (const char*)g.A + (size_t)nxt.pm * tstep + (size_t)nxt.k0 * kstep : cA; const char* nB = has_next ? (const char*)g.Bt + (size_t)nxt.pn * tstep + (size_t)nxt.k0 * kstep : cB;
        const int nt = cur.nt;
        for (int t = 0; t < nt; t += 2) {
            const bool last = (t == nt - 2);
            const char* a1 = cA + (size_t)(t + 1) * kstep;
            const char* a2 = last ? nA : cA + (size_t)(t + 2) * kstep; const char* b2 = last ? nB : cB + (size_t)(t + 2) * kstep;
            const char* a3 = a2 + kstep; const char* b3 = b2 + kstep;
            if (last && has_next) S.a_ready(nxt);
            if constexpr (SP2) {
            PG8_LDB(B0, 0, 0); PG8_LDB(B1, 0, 1); PG8_SCHED; PG8_LDA(At, 0, 0); PG8_STAGE(PG8_SA(1, 1), a1 + hstep, voffA);
            PG8_WAIT_V(8); PG8_WAIT_L(0); PG8_BAR; PG8_MMA(0, 0, At, B0); PG8_MMA(0, 1, At, B1); PG8_BAR; PG8_SCHED;
            PG8_LDA(At, 0, 1); PG8_STAGE(PG8_SB(0, 0), b2, voffB); PG8_STAGE(PG8_SB(0, 1), b2 + hstep, voffB); PG8_STAGE(PG8_SA(0, 0), a2, voffA);
            PG8_WAIT_V(8); PG8_WAIT_L(0); PG8_BAR; PG8_MMA(1, 0, At, B0); PG8_MMA(1, 1, At, B1); PG8_BAR; PG8_SCHED;
            PG8_LDB(B0, 1, 0); PG8_LDB(B1, 1, 1); PG8_SCHED; PG8_LDA(At, 1, 0); PG8_STAGE(PG8_SA(0, 1), a2 + hstep, voffA);
            PG8_WAIT_V(8); PG8_WAIT_L(0); PG8_BAR; PG8_MMA(0, 0, At, B0); PG8_MMA(0, 1, At, B1); PG8_BAR; PG8_SCHED;
            PG8_LDA(At, 1, 1); PG8_STAGE(PG8_SB(1, 0), b3, voffB); PG8_STAGE(PG8_SB(1, 1), b3 + hstep, voffB); PG8_STAGE(PG8_SA(1, 0), a3, voffA);
            PG8_WAIT_V(8); PG8_WAIT_L(0); PG8_BAR; PG8_MMA(1, 0, At, B0); PG8_MMA(1, 1, At, B1); PG8_BAR; PG8_SCHED;
            } else {
            PG8_LDB(B0, 0, 0); PG8_SCHED; PG8_LDA(At, 0, 0); PG8_STAGE(PG8_SA(1, 1), a1 + hstep, voffA);
            PG8_WAIT_L(8); PG8_BAR; PG8_WAIT_L(0); PG8_MMA(0, 0, At, B0); PG8_BAR; PG8_SCHED;
            PG8_LDB(B1, 0, 1); PG8_STAGE(PG8_SB(0, 0), b2, voffB);
            PG8_BAR; PG8_WAIT_L(0); PG8_MMA(0, 1, At, B1); PG8_BAR;
            PG8_LDA(At, 0, 1); PG8_STAGE(PG8_SA(0, 0), a2, voffA);
            PG8_BAR; PG8_WAIT_L(0); PG8_MMA(1, 0, At, B0); PG8_BAR; PG8_SCHED;
            PG8_STAGE(PG8_SB(0, 1), b2 + hstep, voffB);
            PG8_WAIT_V(6); PG8_BAR; PG8_MMA(1, 1, At, B1); PG8_BAR;
            PG8_LDB(B0, 1, 0); PG8_SCHED; PG8_LDA(At, 1, 0); PG8_STAGE(PG8_SA(0, 1), a2 + hstep, voffA);
            PG8_WAIT_L(8); PG8_BAR; PG8_WAIT_L(0); PG8_MMA(0, 0, At, B0); PG8_BAR; PG8_SCHED;
            PG8_LDB(B1, 1, 1); PG8_STAGE(PG8_SB(1, 0), b3, voffB);
            PG8_BAR; PG8_WAIT_L(0); PG8_MMA(0, 1, At, B1); PG8_BAR;
            PG8_LDA(At, 1, 1); PG8_STAGE(PG8_SA(1, 0), a3, voffA);
            PG8_BAR; PG8_WAIT_L(0); PG8_MMA(1, 0, At, B0); PG8_BAR; PG8_SCHED;
            PG8_STAGE(PG8_SB(1, 1), b3 + hstep, voffB);
            PG8_WAIT_V(6); PG8_BAR; PG8_MMA(1, 1, At, B1); PG8_BAR;
            }
        }
        if (ui == 0) PG8_STAMP(44);
        if constexpr (ALIGN_EPI) { if (wr == 0) PG8_BAR; }
        if constexpr (!Epi::AFTER_DRAIN) { E(acc, cur, wr, wc, fr, fq); S.done(cur); }
        if (ui == 0) PG8_STAMP(45);
        if (!has_next) break;
        bool clear = true; if constexpr (Epi::CHAIN) clear = !E.keep(cur);
        if (clear) {
#pragma unroll
        for (int a = 0; a < 2; ++a)
#pragma unroll
            for (int b = 0; b < 2; ++b)
#pragma unroll
                for (int m = 0; m < 4; ++m)
#pragma unroll
                    for (int n = 0; n < 2; ++n) acc[a][b][m][n] = (f32x4){0.f, 0.f, 0.f, 0.f};
        }
        cur = nxt; cA = nA; cB = nB; ++ui;
        if constexpr (ALIGN_EPI) { if (wr == 1) PG8_BAR; }
    }
    PG8_STAMP(46);
    PG8_WAIT_V(0);
    if constexpr (!ALIGN_EPI) { if (wr == 0) PG8_BAR; }
    PG8_BAR;
    if constexpr (Epi::AFTER_DRAIN) { E.fused(acc, cur, wr, wc, fr, fq, lds, wid, lane); S.done(cur); }
#undef PG8_SA
#undef PG8_SB
#undef PG8_STAGE
#undef PG8_LDA
#undef PG8_LDB
#undef PG8_MMA
#undef PG8_WAIT_V
#undef PG8_WAIT_L
#undef PG8_BAR
#undef PG8_SCHED
}
}

__device__ __forceinline__ u32x4 pack8(const f32x4& a, const f32x4& b) { u32x4 w; w.x = pk2(a.x, a.y); w.y = pk2(a.z, a.w); w.z = pk2(b.x, b.y); w.w = pk2(b.z, b.w); return w; }
__device__ __forceinline__ void rope4(f32x4& v, const f32x2 cs0, const f32x2 cs1) {
    const float a0 = v.x * cs0.x - v.y * cs0.y, a1 = v.x * cs0.y + v.y * cs0.x, a2 = v.z * cs1.x - v.w * cs1.y, a3 = v.z * cs1.y + v.w * cs1.x;
    v.x = a0; v.y = a1; v.z = a2; v.w = a3;
}
struct EpiMix {
    static constexpr bool PERM = true, AFTER_DRAIN = false, CHAIN = false;
    const Params* pp; int l; LAS const unsigned char* tabs;
    __device__ __forceinline__ void operator()(const f32x4 (&acc)[2][2][4][2], const Unit& u, int wr, int wc, int fr, int fq) const {
        const Params& p = *pp;
        const int pn = u.pn, R0 = u.pm * 256; const bool smp = R0 >= MP;
        const int b = smp ? (R0 - MP) >> 11 : R0 >> 8, t0 = smp ? (R0 - MP) & 2047 : 0;
        LAS const f32x2* cs_row = (LAS const f32x2*)tabs; LAS const f32x2* cs_col = cs_row + 32 * 16;
        if (pn >= 11) {
            bf16_t* dst = (bf16_t*)(p.ws + (pn < 13 ? Z_CU : Z_CV)) + ((pn - 11) & 1) * 256 + wc * 32 + 8 * fq;
#pragma unroll
            for (int ai = 0; ai < 2; ++ai)
#pragma unroll
                for (int m = 0; m < 4; ++m) { const int R = R0 + ai * 128 + wr * 64 + m * 16 + fr; float ss = 0.f;
#pragma unroll
                    for (int bj = 0; bj < 2; ++bj) { f32x4 v0 = acc[ai][bj][m][0], v1 = acc[ai][bj][m][1];
#pragma unroll
                        for (int r = 0; r < 4; ++r) { v0[r] = gelu_tanh(v0[r]); v1[r] = gelu_tanh(v1[r]); ss += v0[r] * v0[r] + v1[r] * v1[r]; }
                        *(u32x4*)(dst + (size_t)R * RW + bj * 128) = pack8(v0, v1); }
                    if (pn >= 13) { ss += __shfl_xor(ss, 16); ss += __shfl_xor(ss, 32);
                        if (fq == 0) atomicAdd((float*)(p.ws + WS_SSQ) + (size_t)l * M + R, ss); } }
            return;
        }
        const int kind = pn >> 1;
        const bool is_k = (pn == 10 && wc < 2), is_v = (pn == 10 && wc >= 2);
        LAS const float* gqk = (LAS const float*)(tabs + 96 * 16 * 8) + (kind == 4 ? 0 : HD) + 8 * fq;
        const int head = (pn & 1) * 4 + wc;
        const bool norm = (kind == 4 || is_k), rope = smp && (kind == 0 || kind == 1 || kind == 4 || is_k);
        const float post = kind == 1 ? 0.125f : (kind == 4 ? C2 : 1.0f);
#pragma unroll
        for (int ai = 0; ai < 2; ++ai)
#pragma unroll
            for (int m = 0; m < 4; ++m) {
                const int rr = ai * 128 + wr * 64 + m * 16 + fr, R = R0 + rr, t = t0 + rr;
                float rs = 1.0f;
                if (norm) {
                    float ss = 0.f;
#pragma unroll
                    for (int bj = 0; bj < 2; ++bj)
#pragma unroll
                        for (int n = 0; n < 2; ++n) { const f32x4 x = acc[ai][bj][m][n]; ss += (x.x * x.x + x.y * x.y) + (x.z * x.z + x.w * x.w); }
                    ss += __shfl_xor(ss, 16); ss += __shfl_xor(ss, 32);
                    rs = rsqrtf(ss * (1.f / HD) + EPS);
                }
                bf16_t* dst;
                if (kind < 5) dst = (bf16_t*)(p.ws + (kind == 0 ? Z_RQ : kind == 1 ? Z_RK : kind == 2 ? Z_RV : kind == 3 ? Z_RG : Z_AQ)) + (size_t)R * RW + head * HD + 8 * fq;
                else { const int hk = wc & 1;
                    if (smp) dst = (bf16_t*)(p.ws + (is_k ? Z_KS : Z_VS)) + ((size_t)b * SKV_S + PAST + t) * KVW + hk * HD + 8 * fq;
                    else dst = (bf16_t*)(p.ws + (is_k ? Z_KP : Z_VP)) + ((size_t)b * SEQ_P + t) * KVW + hk * HD + 8 * fq; }
                float* cdst = p.out + (is_k ? OUT_CK : OUT_CV) + ((size_t)((b * 2 + l) * SEQ_P + t) * 2 + (wc & 1)) * HD + 8 * fq;
#pragma unroll
                for (int bj = 0; bj < 2; ++bj) {
                    f32x4 v0 = acc[ai][bj][m][0], v1 = acc[ai][bj][m][1];
                    if (norm) { const f32x4 g0 = *(LAS const f32x4*)(gqk + 32 * bj), g1 = *(LAS const f32x4*)(gqk + 32 * bj + 4); v0 = v0 * rs * g0; v1 = v1 * rs * g1; }
                    if (pn == 10 && !smp) { *(f32x4*)(cdst + 32 * bj) = v0; *(f32x4*)(cdst + 32 * bj + 4) = v1; }
                    if (kind == 3) {
#pragma unroll
                        for (int r = 0; r < 4; ++r) { v0[r] = siluf_(v0[r]); v1[r] = siluf_(v1[r]); } }
                    if (rope) {
                        LAS const f32x2* tab = (bj == 0 ? cs_row + (t >> 6) * 16 : cs_col + (t & 63) * 16) + 4 * fq;
                        rope4(v0, tab[0], tab[1]); rope4(v1, tab[2], tab[3]); }
                    v0 = v0 * post; v1 = v1 * post;
                    *(u32x4*)(dst + 32 * bj) = pack8(v0, v1);
                    asm volatile("" ::: "memory");
                }
            }
    }
};
__device__ __forceinline__ size_t gate_off(int x, int pm, int pn, int ai, int m, int bj, int wid, int lane) {
    return ((((size_t)(x * 80 + pm) * 4 + pn) * 16 + (ai * 4 + m) * 2 + bj) * 512 + wid * 64 + lane) * 8; }
struct EpiGate {
    static constexpr bool PERM = true, AFTER_DRAIN = false, CHAIN = false;
    const Params* pp;
    __device__ __forceinline__ void operator()(const f32x4 (&acc)[2][2][4][2], const Unit& u, int wr, int wc, int fr, int fq) const {
        const int x = u.pn >> 2; bf16_t* dst = (bf16_t*)(pp->ws + Z_GATE); const int wid = wr * 4 + wc, lane = fq * 16 + fr;
#pragma unroll
        for (int ai = 0; ai < 2; ++ai)
#pragma unroll
            for (int m = 0; m < 4; ++m) {
#pragma unroll
                for (int bj = 0; bj < 2; ++bj) { f32x4 v0 = acc[ai][bj][m][0], v1 = acc[ai][bj][m][1];
#pragma unroll
                    for (int r = 0; r < 4; ++r) { v0[r] = sigmoidf_(fminf(fmaxf(v0[r], -30.f), 30.f)); v1[r] = sigmoidf_(fminf(fmaxf(v1[r], -30.f), 30.f)); }
                    *(u32x4*)(dst + gate_off(x, u.pm, u.pn & 3, ai, m, bj, wid, lane)) = pack8(v0, v1); } }
    }
};
struct EpiMerge {
    static constexpr bool PERM = true, AFTER_DRAIN = false, CHAIN = true;
    const Params* pp;
    __device__ __forceinline__ bool keep(const Unit& u) const { return (u.pn >> 2) != 2; }
    __device__ __forceinline__ void operator()(f32x4 (&acc)[2][2][4][2], const Unit& u, int wr, int wc, int fr, int fq) const {
        const int x = u.pn >> 2, pm = u.pm - 80 * x;
        const int col0 = (u.pn & 3) * 256 + wc * 32 + 8 * fq;
        const int gnum = x == 0 ? 1 : x == 1 ? 2 : 0, gden = x == 0 ? 2 : 0;
        const bf16_t* gbase = (const bf16_t*)(pp->ws + Z_GATE); const int wid = wr * 4 + wc, lane = fq * 16 + fr, pnc = u.pn & 3;
        bf16_t* dst = (bf16_t*)(pp->ws + WS_XN) + col0;
#pragma unroll
        for (int aim = 0; aim < 4; ++aim) { const int ai = aim >> 1, m0 = (aim & 1) * 2;
            u32x4 gnv[4][2], gdv[4][2];
#pragma unroll
            for (int m = m0; m < m0 + 2; ++m) { const int R = pm * 256 + ai * 128 + wr * 64 + m * 16 + fr;
#pragma unroll
                for (int bj = 0; bj < 2; ++bj) { gnv[m][bj] = *(const u32x4*)(gbase + gate_off(gnum, pm, pnc, ai, m, bj, wid, lane)); if (x != 2) gdv[m][bj] = *(const u32x4*)(gbase + gate_off(gden, pm, pnc, ai, m, bj, wid, lane)); } }
#pragma unroll
            for (int m = m0; m < m0 + 2; ++m) { const int R = pm * 256 + ai * 128 + wr * 64 + m * 16 + fr;
#pragma unroll
                for (int bj = 0; bj < 2; ++bj) {
                    const u32x4 g = gnv[m][bj];
                    f32x4 s0 = (f32x4){bflo(g.x), bfhi(g.x), bflo(g.y), bfhi(g.y)}, s1 = (f32x4){bflo(g.z), bfhi(g.z), bflo(g.w), bfhi(g.w)};
                    if (x != 2) { const u32x4 d = gdv[m][bj];
                        s0.x *= __builtin_amdgcn_rcpf(bflo(d.x)); s0.y *= __builtin_amdgcn_rcpf(bfhi(d.x)); s0.z *= __builtin_amdgcn_rcpf(bflo(d.y)); s0.w *= __builtin_amdgcn_rcpf(bfhi(d.y));
                        s1.x *= __builtin_amdgcn_rcpf(bflo(d.z)); s1.y *= __builtin_amdgcn_rcpf(bfhi(d.z)); s1.z *= __builtin_amdgcn_rcpf(bflo(d.w)); s1.w *= __builtin_amdgcn_rcpf(bfhi(d.w)); }
                    acc[ai][bj][m][0] = acc[ai][bj][m][0] * s0; acc[ai][bj][m][1] = acc[ai][bj][m][1] * s1;
                    if (x == 2) *(u32x4*)(dst + (size_t)R * DM + bj * 128) = pack8(acc[ai][bj][m][0], acc[ai][bj][m][1]); } }
            asm volatile("" ::: "memory");
        }
    }
};
struct EpiRes {
    static constexpr bool PERM = false, AFTER_DRAIN = false, CHAIN = false;
    const Params* pp; int l, part; bool from_inputs; int ntf; bf16_t* slab;
    __device__ __forceinline__ void operator()(const f32x4 (&acc)[2][2][4][2], const Unit& u, int wr, int wc, int fr, int fq) const {
        const Params& p = *pp; const int R0 = u.pm * 256; const int ci = row_ci(R0);
        if (u.nt != ntf) {
            bf16_t* s = slab + ((size_t)((u.pm * 4 + u.pn - 256) * 4 + u.k0 / u.nt) * 256) * 256 + wc * 32 + 4 * fq;
#pragma unroll
            for (int ai = 0; ai < 2; ++ai)
#pragma unroll
                for (int m = 0; m < 4; ++m) { const int rr = ai * 128 + wr * 64 + m * 16 + fr;
#pragma unroll
                    for (int bj = 0; bj < 2; ++bj)
#pragma unroll
                        for (int n = 0; n < 2; ++n) { const f32x4 v = acc[ai][bj][m][n]; u32x2 w; w.x = pk2(v.x, v.y); w.y = pk2(v.z, v.w); *(u32x2*)(s + (size_t)rr * 256 + bj * 128 + n * 16) = w; } }
            return;
        }
        const float* gv = mod_ptr(p, l, ci, part) + u.pn * 256 + wc * 32 + 4 * fq;
        f32x4 g[2][2];
#pragma unroll
        for (int bj = 0; bj < 2; ++bj)
#pragma unroll
            for (int n = 0; n < 2; ++n) g[bj][n] = *(const f32x4*)(gv + bj * 128 + n * 16);
#pragma unroll
        for (int aim = 0; aim < 4; ++aim) { const int ai = aim >> 1, m0 = (aim & 1) * 2;
            f32x4 xv[4][2][2];
#pragma unroll
            for (int m = m0; m < m0 + 2; ++m) { const int R = R0 + ai * 128 + wr * 64 + m * 16 + fr;
                const float* xs = (from_inputs ? x_row(p, 0, R) : p.out + (size_t)R * DM) + u.pn * 256 + wc * 32 + 4 * fq;
#pragma unroll
                for (int bj = 0; bj < 2; ++bj)
#pragma unroll
                    for (int n = 0; n < 2; ++n) xv[m][bj][n] = *(const f32x4*)(xs + bj * 128 + n * 16); }
#pragma unroll
            for (int m = m0; m < m0 + 2; ++m) { const int R = R0 + ai * 128 + wr * 64 + m * 16 + fr;
                float* xo = p.out + (size_t)R * DM + u.pn * 256 + wc * 32 + 4 * fq;
#pragma unroll
                for (int bj = 0; bj < 2; ++bj)
#pragma unroll
                    for (int n = 0; n < 2; ++n) *(f32x4*)(xo + bj * 128 + n * 16) = xv[m][bj][n] + g[bj][n] * acc[ai][bj][m][n]; }
            asm volatile("" ::: "memory");
        }
    }
};
struct EpiFF1 {
    static constexpr bool PERM = true, AFTER_DRAIN = false, CHAIN = false;
    const Params* pp;
    __device__ __forceinline__ void operator()(const f32x4 (&acc)[2][2][4][2], const Unit& u, int wr, int wc, int fr, int fq) const {
        bf16_t* dst = (bf16_t*)(pp->ws + Z_HB) + u.pn * 256 + wc * 32 + 8 * fq;
#pragma unroll
        for (int ai = 0; ai < 2; ++ai)
#pragma unroll
            for (int m = 0; m < 4; ++m) { const int R = u.pm * 256 + ai * 128 + wr * 64 + m * 16 + fr;
#pragma unroll
                for (int bj = 0; bj < 2; ++bj) { f32x4 v0 = acc[ai][bj][m][0], v1 = acc[ai][bj][m][1];
#pragma unroll
                    for (int r = 0; r < 4; ++r) { const float a = fmaxf(v0[r], 0.f), b = fmaxf(v1[r], 0.f); v0[r] = a * a; v1[r] = b * b; }
                    *(u32x4*)(dst + (size_t)R * DFF + bj * 128) = pack8(v0, v1); } }
    }
};

namespace attn_body {
using bf16=__hip_bfloat16;
using bf16x8=__attribute__((ext_vector_type(8)))short;
using s16x4=__attribute__((ext_vector_type(4)))short;
using f32x16=__attribute__((ext_vector_type(16)))float;
using u32x4=__attribute__((ext_vector_type(4)))unsigned;
constexpr int D=64,QP=512,KP=128;
constexpr int NW=8,QBLK=32,QB=QBLK*NW,KVBLK=64;
__device__ __forceinline__ int crow(int r,int hi){return (r&3)+8*(r>>2)+4*hi;}
#define SBAR() __builtin_amdgcn_sched_barrier(0)
constexpr int NSLOT=3, SLOTB=8192;
constexpr int LDS_K=0, LDS_V=NSLOT*SLOTB, LDS_WS=2*NSLOT*SLOTB, LDS_OST=LDS_WS+NW*64*4, LDS_BYTES=LDS_OST+NW*4096;
constexpr float C2=0.125f*1.4426950408889634f;
__device__ __forceinline__ void glds16(const void*gsrc,unsigned lds_dst){unsigned keep;
  asm volatile("s_mov_b32 %0, m0\n\ts_mov_b32 m0, %2\n\ts_nop 0\n\tglobal_load_lds_dwordx4 %1, off\n\ts_mov_b32 m0, %0":"=&s"(keep):"v"(gsrc),"s"(lds_dst):"memory");}
__device__ __forceinline__ float max3f(float a,float b,float c){float r;asm("v_max3_f32 %0, %1, %2, %3":"=v"(r):"v"(a),"v"(b),"v"(c));return r;}
__device__ __forceinline__ float max2f(float a,float b){float r;asm("v_max_f32_e32 %0, %1, %2":"=v"(r):"v"(a),"v"(b));return r;}
__device__ __forceinline__ float fadd_s(float a,float b){float r;asm("v_add_f32_e32 %0, %1, %2":"=v"(r):"v"(a),"v"(b));return r;}
__device__ __forceinline__ float fsub_s(float a,float b){float r;asm("v_sub_f32_e32 %0, %1, %2":"=v"(r):"v"(a),"v"(b));return r;}
typedef float f32x2_t __attribute__((ext_vector_type(2))); typedef __bf16 bf16x2_t __attribute__((ext_vector_type(2)));
__device__ __forceinline__ unsigned cvtpk_s(float lo,float hi){f32x2_t v={lo,hi};bf16x2_t b=__builtin_convertvector(v,bf16x2_t);return __builtin_bit_cast(unsigned,b);}
#define WAIT_BAR(N) asm volatile("s_waitcnt vmcnt(" #N ") lgkmcnt(0)\n\ts_barrier":::"memory")

__device__ __forceinline__ void qkt(f32x16&p0,f32x16&p1,const char*Kslot,const bf16x8*qr,const f32x16&negm,int r32,int hi){
  const char*kb=Kslot+hi*1024+r32*16;
  #pragma unroll
  for(int d0=0;d0<4;++d0){
    const bf16x8 b0=*reinterpret_cast<const bf16x8*>(kb+d0*2048);
    const bf16x8 b1=*reinterpret_cast<const bf16x8*>(kb+d0*2048+512);
    if(d0==0){p0=__builtin_amdgcn_mfma_f32_32x32x16_bf16(b0,qr[0],negm,0,0,0);p1=__builtin_amdgcn_mfma_f32_32x32x16_bf16(b1,qr[0],negm,0,0,0);}
    else{p0=__builtin_amdgcn_mfma_f32_32x32x16_bf16(b0,qr[d0],p0,0,0,0);p1=__builtin_amdgcn_mfma_f32_32x32x16_bf16(b1,qr[d0],p1,0,0,0);}}
}
typedef __attribute__((address_space(3))) const char* lds_cptr;
typedef short v4i16_t __attribute__((ext_vector_type(4)));
__device__ __forceinline__ void kload8(bf16x8*kf,lds_cptr kp){
  kf[0]=*(const __attribute__((address_space(3))) bf16x8*)(kp);      kf[1]=*(const __attribute__((address_space(3))) bf16x8*)(kp+512);
  kf[2]=*(const __attribute__((address_space(3))) bf16x8*)(kp+2048); kf[3]=*(const __attribute__((address_space(3))) bf16x8*)(kp+2560);
  kf[4]=*(const __attribute__((address_space(3))) bf16x8*)(kp+4096); kf[5]=*(const __attribute__((address_space(3))) bf16x8*)(kp+4608);
  kf[6]=*(const __attribute__((address_space(3))) bf16x8*)(kp+6144); kf[7]=*(const __attribute__((address_space(3))) bf16x8*)(kp+6656);
}
__device__ __forceinline__ void kload2(bf16x8*kf,lds_cptr kp,int j){ kf[2*j]=*(const __attribute__((address_space(3))) bf16x8*)(kp+j*2048); kf[2*j+1]=*(const __attribute__((address_space(3))) bf16x8*)(kp+j*2048+512); }
__device__ __forceinline__ s16x4 vtr(lds_cptr p){ return __builtin_bit_cast(s16x4,__builtin_amdgcn_ds_read_tr16_b64_v4i16((__attribute__((address_space(3))) v4i16_t*)p)); }
__device__ __forceinline__ float rowmax(const f32x16&p0,const f32x16&p1){
  float a=max3f(p0[0],p0[1],p1[0]),b=max3f(p0[2],p0[3],p1[1]);a=max3f(a,p1[2],p1[3]);
  #pragma unroll
  for(int r=4;r<16;r+=4){a=max3f(a,p0[r],p0[r+1]);b=max3f(b,p0[r+2],p0[r+3]);a=max3f(a,p1[r],p1[r+1]);b=max3f(b,p1[r+2],p1[r+3]);}
  const float m=max2f(a,b);
  auto rr=__builtin_amdgcn_permlane32_swap(__float_as_uint(m),__float_as_uint(m),false,false);
  return max2f(__uint_as_float(rr[0]),__uint_as_float(rr[1]));
}
__device__ __forceinline__ void pv(f32x16*o,int vb,bf16x8 pa0,bf16x8 pa1,bf16x8 pa2,bf16x8 pa3){
  #pragma unroll
  for(int d0=0;d0<2;++d0){s16x4 lo[4],hi[4];
    #pragma unroll
    for(int ks=0;ks<4;++ks){
      asm volatile("ds_read_b64_tr_b16 %0,%1 offset:%c2":"=&v"(lo[ks]):"v"(vb),"i"(d0*4096+ks*1024):"memory");
      asm volatile("ds_read_b64_tr_b16 %0,%1 offset:%c2":"=&v"(hi[ks]):"v"(vb),"i"(d0*4096+ks*1024+512):"memory");}
    asm volatile("s_waitcnt lgkmcnt(0)":::"memory");SBAR();
    #define PK(k) (bf16x8){lo[k][0],lo[k][1],lo[k][2],lo[k][3],hi[k][0],hi[k][1],hi[k][2],hi[k][3]}
    o[d0]=__builtin_amdgcn_mfma_f32_32x32x16_bf16(pa0,PK(0),o[d0],0,0,0);
    o[d0]=__builtin_amdgcn_mfma_f32_32x32x16_bf16(pa1,PK(1),o[d0],0,0,0);
    o[d0]=__builtin_amdgcn_mfma_f32_32x32x16_bf16(pa2,PK(2),o[d0],0,0,0);
    o[d0]=__builtin_amdgcn_mfma_f32_32x32x16_bf16(pa3,PK(3),o[d0],0,0,0);
    #undef PK
  }
}

#ifndef ATTN_STORE16
#define ATTN_STORE16(p,v) (*(u32x4*)(p)=(v))
#endif
template<int THRL> __device__ __forceinline__ void attn_unit(int tid,const bf16*Qu,const bf16*__restrict__ Kh,const bf16*__restrict__ Vh,bf16*Ou,const int NT,char*shm){
  const int lane=tid&63,r32=lane&31,hi=lane>>5; const int wid=__builtin_amdgcn_readfirstlane(tid>>6);
  const bf16*Qw=Qu+(long)(wid*QBLK)*QP;
  const unsigned lds0=(unsigned)(uintptr_t)shm;
  float*wsf=(float*)(shm+LDS_WS)+wid*64;
  const bf16*ksrc=Kh+(long)lane*KP+wid*8;
  const bf16*vsrc=Vh+(long)(16*(wid&3)+(lane>>2))*KP+(wid>>2)*32+(lane&3)*8;
  const unsigned kdst=lds0+LDS_K+wid*1024, vdst=lds0+LDS_V+wid*1024;
  #define DMA_K(t,slot) glds16(ksrc+(long)(t)*KVBLK*KP,(unsigned)__builtin_amdgcn_readfirstlane(kdst+(slot)))
  #define DMA_V(t,slot) glds16(vsrc+(long)(t)*KVBLK*KP,(unsigned)__builtin_amdgcn_readfirstlane(vdst+(slot)))
  const int vb0=(int)(lds0+LDS_V)+((lane>>4)&1)*32+(lane&3)*8+(4*hi+((lane&15)>>2))*64;
  const char*Kbase=shm+LDS_K; bf16x8 kf[8];
  const lds_cptr shm3=(lds_cptr)shm; const lds_cptr kp0=shm3+LDS_K+hi*1024+r32*16; const lds_cptr vp0=shm3+LDS_V+((lane>>4)&1)*32+(lane&3)*8+(4*hi+((lane&15)>>2))*64;
  DMA_K(0,0);DMA_V(0,0);DMA_K(1,SLOTB);
  bf16x8 qr[4];
  #pragma unroll
  for(int d0=0;d0<4;++d0)qr[d0]=*reinterpret_cast<const bf16x8*>(&Qw[(long)r32*QP+d0*16+hi*8]);
  float zf_=0.f;asm volatile("":"+v"(zf_));
  float mhat=zf_,l_reg=zf_;f32x16 o[2],negm;
  #pragma unroll
  for(int r=0;r<16;++r){o[0][r]=zf_;o[1][r]=zf_;negm[r]=zf_;}
  asm volatile("":"+v"(negm));
  #define CMASK(P0,P1,t) do{}while(0)
  bool resc=false;
  #define START(P0,P1) do{ const float rm=rowmax(P0,P1); resc=false; \
    { const float dl=rm; mhat=fadd_s(mhat,dl); \
      _Pragma("unroll") for(int r=0;r<16;++r){P0[r]=fsub_s(P0[r],dl);P1[r]=fsub_s(P1[r],dl);} \
      _Pragma("unroll") for(int r=0;r<16;++r)negm[r]=-mhat; asm volatile("":"+v"(negm)); } \
    _Pragma("unroll") for(int r=0;r<16;++r)P0[r]=__builtin_amdgcn_exp2f(P0[r]); }while(0)
  #define RESC() do{ if(resc){ asm volatile("s_waitcnt lgkmcnt(0)":::"memory"); \
      _Pragma("unroll") for(int d_=0;d_<2;++d_) _Pragma("unroll") for(int r=0;r<16;++r)o[d_][r]*=wsf[crow(r,hi)]; } }while(0)
  f32x16 pA0,pA1,pB0,pB1;
  int sl_prev=0,sl_cur=0,sl_next=SLOTB;
  #define ROT() do{sl_prev=sl_cur;sl_cur=sl_next;sl_next=(sl_next==(NSLOT-1)*SLOTB)?0:sl_next+SLOTB;}while(0)
  DMA_K(2,2*SLOTB);
  WAIT_BAR(3);
  qkt(pA0,pA1,Kbase,qr,negm,r32,hi);asm volatile("s_nop 15\n\ts_nop 7":"+v"(pA0),"+v"(pA1));CMASK(pA0,pA1,0);
  START(pA0,pA1);
  _Pragma("unroll") for(int r=0;r<16;++r)pA1[r]=__builtin_amdgcn_exp2f(pA1[r]);
  WAIT_BAR(0);
  DMA_K(3,0);DMA_V(1,SLOTB);
  ROT();
  kload8(kf,kp0+sl_cur);
  WAIT_BAR(2);
  s16x4 vlo[8],vhi[8]; u32x4 pw0,pw1,pw2,pw3;
  #define PKW(P,B) cvtpk_s(P[B],P[B+1])
  #define PAF(k) __builtin_bit_cast(bf16x8,pw##k)
  #define VFR(i) (bf16x8){vlo[i][0],vlo[i][1],vlo[i][2],vlo[i][3],vhi[i][0],vhi[i][1],vhi[i][2],vhi[i][3]}
  #define PIN(x) asm volatile("":"+v"(x))
  #define MX3(a,b,c) __builtin_fmaxf(__builtin_fmaxf((a),(b)),(c))
  #define GAPA(MF,A0,A1,A2,A3,W0,W1,PW) do{ MF; sacc+=A0; sacc+=A1; sacc+=A2; sacc+=A3; PIN(sacc); W0; W1; PIN(PW); SBAR(); }while(0)
  #define EX(v) __builtin_amdgcn_exp2f(v)
  #define GAPB(MF,X,B) do{ MF; X[B]=EX(X[B]); X[B+1]=EX(X[B+1]); X[B+2]=EX(X[B+2]); X[B+3]=EX(X[B+3]); PIN(X); SBAR(); }while(0)
  #define VRD(i) do{ vlo[i]=vtr(vp_+(((i)>>2)*4096+((i)&3)*1024)); vhi[i]=vtr(vp_+(((i)>>2)*4096+((i)&3)*1024+512)); }while(0)
  #define KRD(G,j) do{ if(G){ kload2(kf,kp0+sl_next,j); SBAR(); } }while(0)
  #define STEP(C0,C1,P0,P1,t,GK,GV,GL) do{ SBAR(); \
    const lds_cptr vp_=vp0+sl_prev; \
    VRD(0); SBAR(); float sacc=(P0[0]+P0[1]); \
    GAPA(C0=__builtin_amdgcn_mfma_f32_32x32x16_bf16(kf[0],qr[0],negm,0,0,0), P0[2],P0[3],P0[4],P0[5],     pw0[0]=PKW(P0,0), pw0[1]=PKW(P0,2), pw0); \
    VRD(4); SBAR(); GAPA(C1=__builtin_amdgcn_mfma_f32_32x32x16_bf16(kf[1],qr[0],negm,0,0,0), P0[6],P0[7],P0[8],P0[9],     pw0[2]=PKW(P0,4), pw0[3]=PKW(P0,6), pw0); \
    VRD(1); SBAR(); GAPA(C0=__builtin_amdgcn_mfma_f32_32x32x16_bf16(kf[2],qr[1],C0,0,0,0),   P0[10],P0[11],P0[12],P0[13], pw1[0]=PKW(P0,8), pw1[1]=PKW(P0,10), pw1); \
    VRD(5); SBAR(); GAPA(C1=__builtin_amdgcn_mfma_f32_32x32x16_bf16(kf[3],qr[1],C1,0,0,0),   P0[14],P0[15],P1[0],P1[1],   pw1[2]=PKW(P0,12),pw1[3]=PKW(P0,14), pw1); \
    VRD(2); SBAR(); GAPA(C0=__builtin_amdgcn_mfma_f32_32x32x16_bf16(kf[4],qr[2],C0,0,0,0),   P1[2],P1[3],P1[4],P1[5],     pw2[0]=PKW(P1,0), pw2[1]=PKW(P1,2), pw2); \
    VRD(6); SBAR(); GAPA(C1=__builtin_amdgcn_mfma_f32_32x32x16_bf16(kf[5],qr[2],C1,0,0,0),   P1[6],P1[7],P1[8],P1[9],     pw2[2]=PKW(P1,4), pw2[3]=PKW(P1,6), pw2); \
    VRD(3); SBAR(); GAPA(C0=__builtin_amdgcn_mfma_f32_32x32x16_bf16(kf[6],qr[3],C0,0,0,0),   P1[10],P1[11],P1[12],P1[13], pw3[0]=PKW(P1,8), pw3[1]=PKW(P1,10), pw3); \
    VRD(7); SBAR(); GAPA(C1=__builtin_amdgcn_mfma_f32_32x32x16_bf16(kf[7],qr[3],C1,0,0,0),   P1[14],P1[15],0.f,0.f,       pw3[2]=PKW(P1,12),pw3[3]=PKW(P1,14), pw3); \
    l_reg+=sacc; \
    if(GK){DMA_K((t)+3,sl_cur);} if(GV){DMA_V((t)+1,sl_next);} \
    CMASK(C0,C1,t); \
    { float a=MX3(C0[0],C0[1],C1[0]),b=MX3(C0[2],C0[3],C1[1]); a=MX3(a,C1[2],C1[3]); \
      _Pragma("unroll") for(int r=4;r<16;r+=4){a=MX3(a,C0[r],C0[r+1]);b=MX3(b,C0[r+2],C0[r+3]);a=MX3(a,C1[r],C1[r+1]);b=MX3(b,C1[r+2],C1[r+3]);} \
      float rm=__builtin_fmaxf(a,b); { auto rr=__builtin_amdgcn_permlane32_swap(__float_as_uint(rm),__float_as_uint(rm),false,false); rm=__builtin_fmaxf(__uint_as_float(rr[0]),__uint_as_float(rr[1])); } \
      resc=false; \
      if(__builtin_expect(__any(rm>(float)THRL),0)){ const float dl=__builtin_fmaxf(rm,0.f); mhat+=dl; \
        _Pragma("unroll") for(int r=0;r<16;++r){C0[r]-=dl;C1[r]-=dl;} \
        _Pragma("unroll") for(int r=0;r<16;++r)negm[r]=-mhat; asm volatile("":"+v"(negm)); \
        const float f=__builtin_amdgcn_exp2f(-dl); l_reg*=f; if(hi==0)wsf[r32]=f; resc=true; } } \
    SBAR(); \
    GAPB(o[0]=__builtin_amdgcn_mfma_f32_32x32x16_bf16(PAF(0),VFR(0),o[0],0,0,0), C0,0); \
    GAPB(o[1]=__builtin_amdgcn_mfma_f32_32x32x16_bf16(PAF(0),VFR(4),o[1],0,0,0), C0,4); \
    KRD(GL,0); GAPB(o[0]=__builtin_amdgcn_mfma_f32_32x32x16_bf16(PAF(1),VFR(1),o[0],0,0,0), C0,8); \
    KRD(GL,1); GAPB(o[1]=__builtin_amdgcn_mfma_f32_32x32x16_bf16(PAF(1),VFR(5),o[1],0,0,0), C0,12); \
    KRD(GL,2); GAPB(o[0]=__builtin_amdgcn_mfma_f32_32x32x16_bf16(PAF(2),VFR(2),o[0],0,0,0), C1,0); \
    KRD(GL,3); GAPB(o[1]=__builtin_amdgcn_mfma_f32_32x32x16_bf16(PAF(2),VFR(6),o[1],0,0,0), C1,4); \
    GAPB(o[0]=__builtin_amdgcn_mfma_f32_32x32x16_bf16(PAF(3),VFR(3),o[0],0,0,0), C1,8); \
    GAPB(o[1]=__builtin_amdgcn_mfma_f32_32x32x16_bf16(PAF(3),VFR(7),o[1],0,0,0), C1,12); \
    }while(0)
  int t=1;
  for(;t+5<NT;t+=2){
    STEP(pB0,pB1,pA0,pA1,t,true,true,true);     WAIT_BAR(2); RESC(); ROT();
    STEP(pA0,pA1,pB0,pB1,t+1,true,true,true);   WAIT_BAR(2); RESC(); ROT();
  }
  #define ENDW(tt) do{ if((tt)+3<NT){WAIT_BAR(2);} else if((tt)+2<NT){WAIT_BAR(1);} else {WAIT_BAR(0);} }while(0)
  for(;t+1<NT;t+=2){
    STEP(pB0,pB1,pA0,pA1,t,(t+3<NT),(t+1<NT),(t+1<NT));       ENDW(t);   RESC(); ROT();
    STEP(pA0,pA1,pB0,pB1,t+1,(t+4<NT),(t+2<NT),(t+2<NT));     ENDW(t+1); RESC(); ROT();
  }
  STEP(pB0,pB1,pA0,pA1,NT-1,false,false,false); RESC();
  { float sacc=pB0[0]+pB0[1]; _Pragma("unroll") for(int r=2;r<16;++r)sacc+=pB0[r]; _Pragma("unroll") for(int r=0;r<16;++r)sacc+=pB1[r]; l_reg+=sacc;
    pw0=(u32x4){PKW(pB0,0),PKW(pB0,2),PKW(pB0,4),PKW(pB0,6)};pw1=(u32x4){PKW(pB0,8),PKW(pB0,10),PKW(pB0,12),PKW(pB0,14)};pw2=(u32x4){PKW(pB1,0),PKW(pB1,2),PKW(pB1,4),PKW(pB1,6)};pw3=(u32x4){PKW(pB1,8),PKW(pB1,10),PKW(pB1,12),PKW(pB1,14)};
    SBAR(); pv(o,vb0+sl_cur,PAF(0),PAF(1),PAF(2),PAF(3)); }
  #undef PKW
  #undef PAF
  #undef VFR
  #undef PIN
  #undef MX3
  #undef GAPA
  #undef GAPB
  #undef EX
  #undef VRD
  #undef KRD
  #undef STEP
  #undef ENDW
  {auto rr=__builtin_amdgcn_permlane32_swap(__float_as_uint(l_reg),__float_as_uint(l_reg),false,false);l_reg=__uint_as_float(rr[0])+__uint_as_float(rr[1]);}
  if(hi==0)wsf[32+r32]=l_reg;asm volatile("s_waitcnt lgkmcnt(0)":::"memory");
  float rli[16];
  #pragma unroll
  for(int r=0;r<16;++r)rli[r]=__builtin_amdgcn_rcpf(wsf[32+crow(r,hi)]);
  bf16*Ow=Ou+(long)(wid*QBLK)*QP;
  { bf16*stg=(bf16*)(shm+LDS_OST)+wid*2048;
    #pragma unroll
    for(int r=0;r<16;++r){const int orow=crow(r,hi);
      #pragma unroll
      for(int d0=0;d0<2;++d0)stg[orow*64+d0*32+r32]=__float2bfloat16(o[d0][r]*rli[r]);}
    asm volatile("s_waitcnt lgkmcnt(0)":::"memory");
    #pragma unroll
    for(int i=0;i<4;++i){const int row=i*8+(lane>>3),ch=lane&7; const u32x4 v=*(const u32x4*)(stg+row*64+ch*8); ATTN_STORE16(Ow+(long)row*QP+ch*8,v);} }
  asm volatile("s_waitcnt lgkmcnt(0)\n\ts_barrier":::"memory");
  #undef DMA_K
  #undef DMA_V
  #undef CMASK
  #undef START
  #undef RESC
  #undef ROT
}
constexpr int ATTN_LDS_BYTES=LDS_BYTES;
#undef SBAR
#undef WAIT_BAR
}
#ifndef ATTN_FAST
#define ATTN_FAST 1
#endif
__device__ __forceinline__ void attn_fast(const Params& p, const Ctx& c) {
    typedef attn_body::bf16 abf;
    const int vcu = (c.G % 8 == 0) ? (c.bx % 8) * (c.G / 8) + c.bx / 8 : c.bx;
    for (int u = vcu; u < 512 + 128; u += c.G) {
        const abf *Qu, *Kh, *Vh; int NT;
        if (u < 512) { const int qb = u & 7, hq = (u >> 3) & 3, hk = (u >> 5) & 1, b = u >> 6, h = hk * 4 + hq;
            Qu = (const abf*)(p.ws + Z_AQ) + ((size_t)MP + (size_t)b * SEQ_S + qb * 256) * RW + h * HD;
            Kh = (const abf*)(p.ws + Z_KS) + (size_t)b * SKV_S * KVW + hk * HD; Vh = (const abf*)(p.ws + Z_VS) + (size_t)b * SKV_S * KVW + hk * HD; NT = SKV_S / 64; }
        else { const int v = u - 512, hq = v & 3, hk = (v >> 2) & 1, b = v >> 3, h = hk * 4 + hq;
            Qu = (const abf*)(p.ws + Z_AQ) + ((size_t)b * SEQ_P) * RW + h * HD;
            Kh = (const abf*)(p.ws + Z_KP) + (size_t)b * SEQ_P * KVW + hk * HD; Vh = (const abf*)(p.ws + Z_VP) + (size_t)b * SEQ_P * KVW + hk * HD; NT = SKV_P / 64; }
        attn_body::attn_unit<8>(c.tid, Qu, Kh, Vh, (abf*)Qu, NT, (char*)c.lds);
    }
    __syncthreads();
}

__device__ __forceinline__ void attn_simple(const Params& p, const Ctx& c) {
    LAS float* Kt = (LAS float*)c.lds; LAS float* Vt = Kt + 32 * 64; LAS float* Sc = Vt + 32 * 64;
    constexpr int NU_S = NB_S * NH * 4, NU_P = NB_P * NH;
    for (int u = c.bx; u < NU_S + NU_P; u += c.G) {
        const bool smp = u < NU_S; int b, h, q0, nq, skv; const bf16_t *Kb, *Vb; size_t rowbase;
        if (smp) { b = u / 32; h = (u / 4) & 7; q0 = (u & 3) * 512; nq = 512; skv = SKV_S; Kb = (const bf16_t*)(p.ws + Z_KS) + (size_t)b * SKV_S * KVW; Vb = (const bf16_t*)(p.ws + Z_VS) + (size_t)b * SKV_S * KVW; rowbase = MP + (size_t)b * SEQ_S + q0; }
        else { const int v = u - NU_S; b = v / 8; h = v & 7; q0 = 0; nq = 256; skv = SKV_P; Kb = (const bf16_t*)(p.ws + Z_KP) + (size_t)b * SEQ_P * KVW; Vb = (const bf16_t*)(p.ws + Z_VP) + (size_t)b * SEQ_P * KVW; rowbase = (size_t)b * SEQ_P; }
        const int hk = h >> 2; const bool act = c.tid < nq;
        bf16_t* qrow = (bf16_t*)(p.ws + Z_AQ) + (rowbase + (act ? c.tid : 0)) * RW + h * HD;
        float q[64], o[64]; float mx = -1e30f, lsum = 0.f;
#pragma unroll
        for (int i = 0; i < 8; ++i) { const u32x4 w = *(const u32x4*)(qrow + 8 * i); q[8 * i] = bflo(w.x); q[8 * i + 1] = bfhi(w.x); q[8 * i + 2] = bflo(w.y); q[8 * i + 3] = bfhi(w.y); q[8 * i + 4] = bflo(w.z); q[8 * i + 5] = bfhi(w.z); q[8 * i + 6] = bflo(w.w); q[8 * i + 7] = bfhi(w.w); }
#pragma unroll
        for (int i = 0; i < 64; ++i) o[i] = 0.f;
        for (int k0 = 0; k0 < skv; k0 += 32) {
            __syncthreads();
            { const int e = c.tid * 4, j = e >> 6, d = e & 63;
                const u32x2 kw = *(const u32x2*)(Kb + (size_t)(k0 + j) * KVW + hk * HD + d), vw = *(const u32x2*)(Vb + (size_t)(k0 + j) * KVW + hk * HD + d);
                *(LAS f32x4*)(Kt + e) = (f32x4){bflo(kw.x), bfhi(kw.x), bflo(kw.y), bfhi(kw.y)}; *(LAS f32x4*)(Vt + e) = (f32x4){bflo(vw.x), bfhi(vw.x), bflo(vw.y), bfhi(vw.y)}; }
            __syncthreads();
            float tm = mx;
#pragma unroll 1
            for (int j = 0; j < 32; ++j) { float a = 0.f;
#pragma unroll
                for (int d4 = 0; d4 < 16; ++d4) { const f32x4 kv = *(const LAS f32x4*)(Kt + j * 64 + 4 * d4); a += q[4 * d4] * kv.x + q[4 * d4 + 1] * kv.y + q[4 * d4 + 2] * kv.z + q[4 * d4 + 3] * kv.w; }
                Sc[j * 512 + c.tid] = a; tm = fmaxf(tm, a); }
            const float corr = exp2f(mx - tm); mx = tm; lsum *= corr;
#pragma unroll
            for (int i = 0; i < 64; ++i) o[i] *= corr;
#pragma unroll 1
            for (int j = 0; j < 32; ++j) { const float pj = exp2f(Sc[j * 512 + c.tid] - mx); lsum += pj;
#pragma unroll
                for (int d4 = 0; d4 < 16; ++d4) { const f32x4 vv = *(const LAS f32x4*)(Vt + j * 64 + 4 * d4); o[4 * d4] += pj * vv.x; o[4 * d4 + 1] += pj * vv.y; o[4 * d4 + 2] += pj * vv.z; o[4 * d4 + 3] += pj * vv.w; } }
        }
        if (act) { const float il = 1.f / lsum;
#pragma unroll
            for (int i = 0; i < 8; ++i) { u32x4 w; w.x = pk2(o[8 * i] * il, o[8 * i + 1] * il); w.y = pk2(o[8 * i + 2] * il, o[8 * i + 3] * il); w.z = pk2(o[8 * i + 4] * il, o[8 * i + 5] * il); w.w = pk2(o[8 * i + 6] * il, o[8 * i + 7] * il); *(u32x4*)(qrow + 8 * i) = w; } }
    }
    __syncthreads();
}
__device__ __forceinline__ void cmlp_simple(const Params& p, const Ctx& c, int l) {
    LAS float* Vt = (LAS float*)c.lds;
    LAS float* rs = Vt + 128 * 128;
    const bf16_t* cv = (const bf16_t*)(p.ws + Z_CV); bf16_t* cu = (bf16_t*)(p.ws + Z_CU);
    for (int u = c.bx; u < NCHUNK * 4; u += c.G) {
        const int ch = u >> 2, g = u & 3; const size_t R0 = (size_t)ch * 128;
        __syncthreads();
        { const int q = c.tid >> 2, part = c.tid & 3; float ss = 0.f;
            const bf16_t* r = cv + (R0 + q) * RW + part * 128;
#pragma unroll
            for (int i = 0; i < 16; ++i) { const u32x4 w = *(const u32x4*)(r + 8 * i); const float a0 = bflo(w.x), a1 = bfhi(w.x), a2 = bflo(w.y), a3 = bfhi(w.y), a4 = bflo(w.z), a5 = bfhi(w.z), a6 = bflo(w.w), a7 = bfhi(w.w);
                ss += (a0 * a0 + a1 * a1) + (a2 * a2 + a3 * a3) + (a4 * a4 + a5 * a5) + (a6 * a6 + a7 * a7); }
            ss += __shfl_xor(ss, 1); ss += __shfl_xor(ss, 2);
            if (part == 0) rs[q] = rsqrtf(ss * (1.f / RW) + EPS); }
        __syncthreads();
        for (int e = c.tid; e < 128 * 128 / 8; e += 512) { const int q = e >> 4, c8 = (e & 15) * 8; const float r = rs[q];
            const u32x4 w = *(const u32x4*)(cv + (R0 + q) * RW + g * 128 + c8);
            *(LAS f32x4*)(Vt + q * 128 + c8) = (f32x4){bflo(w.x) * r, bfhi(w.x) * r, bflo(w.y) * r, bfhi(w.y) * r};
            *(LAS f32x4*)(Vt + q * 128 + c8 + 4) = (f32x4){bflo(w.z) * r, bfhi(w.z) * r, bflo(w.w) * r, bfhi(w.w) * r}; }
        __syncthreads();
        const int cc = c.tid & 127, pg = __builtin_amdgcn_readfirstlane(c.tid >> 7);
        const float* Ws = p.in[I_CMWS] + ((size_t)(l * 4 + g) * 128) * 128; const float* bs = p.in[I_CMBS] + (l * 4 + g) * 128;
        const float gn = p.in[I_CMNORM][l * RW + g * 128 + cc];
        for (int pi = 0; pi < 32; ++pi) { const int pr = pg * 32 + pi; const float* wrow = Ws + pr * 128; float a = 0.f;
#pragma unroll 8
            for (int q = 0; q < 128; ++q) a += wrow[q] * Vt[q * 128 + cc];
            bf16_t* up = cu + (R0 + pr) * RW + g * 128 + cc;
            const float uu = bf2f(*up);
            *up = (bf16_t)f2bf(uu * (gn * a + bs[pr])); }
    }
    __syncthreads();
}
__device__ __forceinline__ float ret_ld(const Params& p, int l, int dir, int h) { const float x = p.in[I_DECAY][(l * 2 + dir) * NH + h]; return -log1pf(__expf(x)); }
__device__ __forceinline__ void retU_simple(const Params& p, const Ctx& c, int l) {
    LAS float* Kt = (LAS float*)c.lds; LAS float* Vt = Kt + 128 * 64; LAS float* wf = Vt + 128 * 64; LAS float* wb = wf + 128;
    bf16_t* U = (bf16_t*)(p.ws + Z_U);
    for (int u = c.bx; u < NCHUNK * NH; u += c.G) {
        const int ch = u >> 3, h = u & 7; const size_t R0 = (size_t)ch * 128;
        const float ldf = ret_ld(p, l, 0, h), ldb = ret_ld(p, l, 1, h);
        __syncthreads();
        if (c.tid < 128) { wf[c.tid] = __expf(ldf * (float)(127 - c.tid)); wb[c.tid] = __expf(ldb * (float)c.tid); }
        for (int e = c.tid; e < 128 * 64 / 8; e += 512) { const int j = e >> 3, d8 = (e & 7) * 8;
            const u32x4 kw = *(const u32x4*)((const bf16_t*)(p.ws + Z_RK) + (R0 + j) * RW + h * HD + d8), vw = *(const u32x4*)((const bf16_t*)(p.ws + Z_RV) + (R0 + j) * RW + h * HD + d8);
            *(LAS f32x4*)(Kt + j * 64 + d8) = (f32x4){bflo(kw.x), bfhi(kw.x), bflo(kw.y), bfhi(kw.y)}; *(LAS f32x4*)(Kt + j * 64 + d8 + 4) = (f32x4){bflo(kw.z), bfhi(kw.z), bflo(kw.w), bfhi(kw.w)};
            *(LAS f32x4*)(Vt + j * 64 + d8) = (f32x4){bflo(vw.x), bfhi(vw.x), bflo(vw.y), bfhi(vw.y)}; *(LAS f32x4*)(Vt + j * 64 + d8 + 4) = (f32x4){bflo(vw.z), bfhi(vw.z), bflo(vw.w), bfhi(vw.w)}; }
        __syncthreads();
        const int e = c.tid & 63, d0 = __builtin_amdgcn_readfirstlane(c.tid >> 6) * 8;
        float uf[8], ub[8];
#pragma unroll
        for (int i = 0; i < 8; ++i) { uf[i] = 0.f; ub[i] = 0.f; }
        for (int j = 0; j < 128; ++j) { const float v = Vt[j * 64 + e], vf = v * wf[j], vb = v * wb[j];
            const f32x4 k0 = *(const LAS f32x4*)(Kt + j * 64 + d0), k1 = *(const LAS f32x4*)(Kt + j * 64 + d0 + 4);
            uf[0] += k0.x * vf; uf[1] += k0.y * vf; uf[2] += k0.z * vf; uf[3] += k0.w * vf; uf[4] += k1.x * vf; uf[5] += k1.y * vf; uf[6] += k1.z * vf; uf[7] += k1.w * vf;
            ub[0] += k0.x * vb; ub[1] += k0.y * vb; ub[2] += k0.z * vb; ub[3] += k0.w * vb; ub[4] += k1.x * vb; ub[5] += k1.y * vb; ub[6] += k1.z * vb; ub[7] += k1.w * vb; }
        bf16_t* Uf = U + ((size_t)(0 * NCHUNK + ch) * NH + h) * 4096, *Ub = U + ((size_t)(1 * NCHUNK + ch) * NH + h) * 4096;
#pragma unroll
        for (int i = 0; i < 8; ++i) { Uf[(d0 + i) * 64 + e] = (bf16_t)pk2(uf[i], 0.f); Ub[(d0 + i) * 64 + e] = (bf16_t)pk2(ub[i], 0.f); }
    }
    __syncthreads();
}
__device__ __forceinline__ void retO_simple(const Params& p, const Ctx& c, int l) {
    LAS float* Kt = (LAS float*)c.lds; LAS float* Vt = Kt + 128 * 64; LAS float* Sf = Vt + 128 * 64; LAS float* Sb = Sf + 4096; LAS float* pf = Sb + 4096; LAS float* pb = pf + 132;
    const bf16_t* U = (const bf16_t*)(p.ws + Z_U);
    for (int u = c.bx; u < NCHUNK * NH; u += c.G) {
        const int ch = u >> 3, h = u & 7; const size_t R0 = (size_t)ch * 128; const bool smp = ch >= MP / 128;
        const int nc = smp ? 16 : 2, ch0 = smp ? (MP / 128 + ((ch - MP / 128) & ~15)) : (ch & ~1), cidx = ch - ch0, b = smp ? (ch - MP / 128) >> 4 : ch >> 1;
        const float ldf = ret_ld(p, l, 0, h), ldb = ret_ld(p, l, 1, h); const float Gf = __expf(128.f * ldf), Gb = __expf(128.f * ldb);
        __syncthreads();
        if (c.tid <= 128) { pf[c.tid] = __expf(ldf * (float)c.tid); pb[c.tid] = __expf(ldb * (float)c.tid); }
        for (int e = c.tid; e < 128 * 64 / 8; e += 512) { const int j = e >> 3, d8 = (e & 7) * 8;
            const u32x4 kw = *(const u32x4*)((const bf16_t*)(p.ws + Z_RK) + (R0 + j) * RW + h * HD + d8), vw = *(const u32x4*)((const bf16_t*)(p.ws + Z_RV) + (R0 + j) * RW + h * HD + d8);
            *(LAS f32x4*)(Kt + j * 64 + d8) = (f32x4){bflo(kw.x), bfhi(kw.x), bflo(kw.y), bfhi(kw.y)}; *(LAS f32x4*)(Kt + j * 64 + d8 + 4) = (f32x4){bflo(kw.z), bfhi(kw.z), bflo(kw.w), bfhi(kw.w)};
            *(LAS f32x4*)(Vt + j * 64 + d8) = (f32x4){bflo(vw.x), bfhi(vw.x), bflo(vw.y), bfhi(vw.y)}; *(LAS f32x4*)(Vt + j * 64 + d8 + 4) = (f32x4){bflo(vw.z), bfhi(vw.z), bflo(vw.w), bfhi(vw.w)}; }
        {
            const int e0 = c.tid * 8; const bf16_t* sfp = U + ((size_t)(0 * NCHUNK + ch) * NH + h) * 4096 + e0; const bf16_t* sbp = U + ((size_t)(1 * NCHUNK + ch) * NH + h) * 4096 + e0;
#pragma unroll
            for (int i = 0; i < 8; ++i) { Sf[e0 + i] = bf2f(sfp[i]); Sb[e0 + i] = bf2f(sbp[i]); }
        }
        __syncthreads();
        const int i = c.tid >> 2, part = c.tid & 3;
        float qp[16], o[16];
        { const bf16_t* qr = (const bf16_t*)(p.ws + Z_RQ) + (R0 + i) * RW + h * HD + part * 16; const u32x4 w0 = *(const u32x4*)qr, w1 = *(const u32x4*)(qr + 8);
            qp[0] = bflo(w0.x); qp[1] = bfhi(w0.x); qp[2] = bflo(w0.y); qp[3] = bfhi(w0.y); qp[4] = bflo(w0.z); qp[5] = bfhi(w0.z); qp[6] = bflo(w0.w); qp[7] = bfhi(w0.w);
            qp[8] = bflo(w1.x); qp[9] = bfhi(w1.x); qp[10] = bflo(w1.y); qp[11] = bfhi(w1.y); qp[12] = bflo(w1.z); qp[13] = bfhi(w1.z); qp[14] = bflo(w1.w); qp[15] = bfhi(w1.w); }
#pragma unroll
        for (int e = 0; e < 16; ++e) o[e] = 0.f;
#pragma unroll 1
        for (int j = 0; j < 128; ++j) { float s = 0.f;
#pragma unroll
            for (int d4 = 0; d4 < 4; ++d4) { const f32x4 kv = *(const LAS f32x4*)(Kt + j * 64 + part * 16 + 4 * d4); s += qp[4 * d4] * kv.x + qp[4 * d4 + 1] * kv.y + qp[4 * d4 + 2] * kv.z + qp[4 * d4 + 3] * kv.w; }
            s += __shfl_xor(s, 1); s += __shfl_xor(s, 2);
            const float w = j < i ? pf[i - j] : (j > i ? pb[j - i] : 2.0f);
            s *= w;
#pragma unroll
            for (int e4 = 0; e4 < 4; ++e4) { const f32x4 vv = *(const LAS f32x4*)(Vt + j * 64 + part * 16 + 4 * e4); o[4 * e4] += s * vv.x; o[4 * e4 + 1] += s * vv.y; o[4 * e4 + 2] += s * vv.z; o[4 * e4 + 3] += s * vv.w; } }
        { const float xf = pf[i + 1], xb = pb[128 - i]; const bf16_t* qfull = (const bf16_t*)(p.ws + Z_RQ) + (R0 + i) * RW + h * HD;
#pragma unroll 2
            for (int d = 0; d < 64; ++d) { const float qd = bf2f(qfull[d]); const float af = qd * xf, ab = qd * xb;
#pragma unroll
                for (int e4 = 0; e4 < 4; ++e4) { const f32x4 a = *(const LAS f32x4*)(Sf + d * 64 + part * 16 + 4 * e4), bb = *(const LAS f32x4*)(Sb + d * 64 + part * 16 + 4 * e4);
                    o[4 * e4] += af * a.x + ab * bb.x; o[4 * e4 + 1] += af * a.y + ab * bb.y; o[4 * e4 + 2] += af * a.z + ab * bb.z; o[4 * e4 + 3] += af * a.w + ab * bb.w; } } }
        float s1 = 0.f;
#pragma unroll
        for (int e = 0; e < 16; ++e) s1 += o[e];
        s1 += __shfl_xor(s1, 1); s1 += __shfl_xor(s1, 2); const float mu = s1 * (1.f / 64.f);
        float s2 = 0.f;
#pragma unroll
        for (int e = 0; e < 16; ++e) { const float d = o[e] - mu; s2 += d * d; }
        s2 += __shfl_xor(s2, 1); s2 += __shfl_xor(s2, 2); const float rstd = rsqrtf(s2 * (1.f / 64.f) + EPS);
        const float* gn = p.in[I_RETGN] + l * RW + h * HD + part * 16;
        const bf16_t* rg = (const bf16_t*)(p.ws + Z_RG) + (R0 + i) * RW + h * HD + part * 16; const u32x4 g0 = *(const u32x4*)rg, g1 = *(const u32x4*)(rg + 8);
        float gs[16] = {bflo(g0.x), bfhi(g0.x), bflo(g0.y), bfhi(g0.y), bflo(g0.z), bfhi(g0.z), bflo(g0.w), bfhi(g0.w), bflo(g1.x), bfhi(g1.x), bflo(g1.y), bfhi(g1.y), bflo(g1.z), bfhi(g1.z), bflo(g1.w), bfhi(g1.w)};
        float y[16];
#pragma unroll
        for (int e = 0; e < 16; ++e) y[e] = (o[e] - mu) * rstd * gn[e] * gs[e];
        bf16_t* dst = (bf16_t*)(p.ws + Z_CV) + (R0 + i) * RW + h * HD + part * 16;
        u32x4 w0, w1; w0.x = pk2(y[0], y[1]); w0.y = pk2(y[2], y[3]); w0.z = pk2(y[4], y[5]); w0.w = pk2(y[6], y[7]); w1.x = pk2(y[8], y[9]); w1.y = pk2(y[10], y[11]); w1.z = pk2(y[12], y[13]); w1.w = pk2(y[14], y[15]);
        *(u32x4*)dst = w0; *(u32x4*)(dst + 8) = w1;
    }
    __syncthreads();
}

__device__ __forceinline__ void lds_barrier() { asm volatile("s_waitcnt lgkmcnt(0)" ::: "memory"); __builtin_amdgcn_s_barrier(); asm volatile("" ::: "memory"); }
typedef short v4i16_t __attribute__((ext_vector_type(4)));
typedef LAS const unsigned char* lcp;
__device__ __forceinline__ f32x4 mfma16(bf16x8 a, bf16x8 b, f32x4 c) { return __builtin_amdgcn_mfma_f32_16x16x32_bf16(a, b, c, 0, 0, 0); }
__device__ __forceinline__ bf16x8 tr_frag(lcp base, int stride, int k0, int c0, int lane) {
    const int g = lane >> 4, i = lane & 15, q = i >> 2, pp = i & 3;
    lcp a = base + (k0 + 8 * g + q) * stride + (c0 + 4 * pp) * 2;
    const v4i16_t r1 = __builtin_amdgcn_ds_read_tr16_b64_v4i16((LAS v4i16_t*)a), r2 = __builtin_amdgcn_ds_read_tr16_b64_v4i16((LAS v4i16_t*)(a + 4 * stride));
    return (bf16x8){r1[0], r1[1], r1[2], r1[3], r2[0], r2[1], r2[2], r2[3]};
}
__device__ __forceinline__ bf16x8 row_frag(lcp base, int stride, int r0, int k0, int lane) { return *(const LAS bf16x8*)(base + (r0 + (lane & 15)) * stride + (k0 + 8 * (lane >> 4)) * 2); }
__device__ __forceinline__ u32x4 scale8(const u32x4 w, float s) { u32x4 o; o.x = pk2(bflo(w.x) * s, bfhi(w.x) * s); o.y = pk2(bflo(w.y) * s, bfhi(w.y) * s); o.z = pk2(bflo(w.z) * s, bfhi(w.z) * s); o.w = pk2(bflo(w.w) * s, bfhi(w.w) * s); return o; }
constexpr int RS64 = 144, RS128 = 272;
constexpr float LOG2E = 1.4426950408889634f;

__device__ __forceinline__ void retU_fast(const Params& p, const Ctx& c, int l) {
    LAS unsigned char* Kf = c.lds; LAS unsigned char* Kb = Kf + 128 * RS64; LAS unsigned char* Vs = Kb + 128 * RS64;
    bf16_t* U = (bf16_t*)(p.ws + Z_U);
    const int g = c.lane >> 4, i16 = c.lane & 15;
    u32x4 pkk[2], pvv[2];
#define RETU_PREFETCH(uu) do { const int ch_ = (uu) >> 3, h_ = (uu) & 7; \
        _Pragma("unroll") for (int it = 0; it < 2; ++it) { const int idx = c.tid + 512 * it, j = idx >> 3, c8 = (idx & 7) * 8; const size_t go = rlay(h_, (size_t)ch_ * 128 + j) + c8; \
            pkk[it] = *(const u32x4*)((const bf16_t*)(p.ws + Z_RK) + go); pvv[it] = *(const u32x4*)((const bf16_t*)(p.ws + Z_RV) + go); } } while (0)
    if (c.vcu < NCHUNK * NH) RETU_PREFETCH(c.vcu);
    for (int u = c.vcu; u < NCHUNK * NH; u += c.G) {
        const int ch = u >> 3, h = u & 7;
        const float l2f = ret_ld(p, l, 0, h) * LOG2E, l2b = ret_ld(p, l, 1, h) * LOG2E;
        lds_barrier();
#pragma unroll
        for (int it = 0; it < 2; ++it) { const int idx = c.tid + 512 * it, j = idx >> 3, c8 = (idx & 7) * 8;
            const u32x4 kw = pkk[it], vw = pvv[it];
            const float wf = exp2f(l2f * (float)(127 - j)), wb = exp2f(l2b * (float)j);
            *(LAS u32x4*)(Kf + j * RS64 + c8 * 2) = scale8(kw, wf); *(LAS u32x4*)(Kb + j * RS64 + c8 * 2) = scale8(kw, wb); *(LAS u32x4*)(Vs + j * RS64 + c8 * 2) = vw; }
        if (u + c.G < NCHUNK * NH) RETU_PREFETCH(u + c.G);
        lds_barrier();
        const int dt = c.wave & 3, et0 = 2 * (c.wave >> 2);
        f32x4 acc[2][2];
#pragma unroll
        for (int s = 0; s < 2; ++s)
#pragma unroll
            for (int e = 0; e < 2; ++e) acc[s][e] = (f32x4){0.f, 0.f, 0.f, 0.f};
#pragma unroll
        for (int ks = 0; ks < 4; ++ks) {
            const bf16x8 af = tr_frag(Kf, RS64, 32 * ks, 16 * dt, c.lane), ab = tr_frag(Kb, RS64, 32 * ks, 16 * dt, c.lane);
#pragma unroll
            for (int e = 0; e < 2; ++e) { const bf16x8 bv = tr_frag(Vs, RS64, 32 * ks, 16 * (et0 + e), c.lane); acc[0][e] = mfma16(af, bv, acc[0][e]); acc[1][e] = mfma16(ab, bv, acc[1][e]); }
        }
#pragma unroll
        for (int s = 0; s < 2; ++s)
#pragma unroll
            for (int e = 0; e < 2; ++e) { bf16_t* o = U + ((size_t)(s * NCHUNK + ch) * NH + h) * 4096 + (16 * dt + 4 * g) * 64 + 16 * (et0 + e) + i16;
#pragma unroll
                for (int r = 0; r < 4; ++r) o[r * 64] = (bf16_t)pk2(acc[s][e][r], 0.f); }
    }
    __syncthreads();
}

#ifndef RETO_DUP
#define RETO_DUP 0
#endif
__device__ __forceinline__ void retO_fast(const Params& p, const Ctx& c, int l) {
    LAS unsigned char* Qs = c.lds; LAS unsigned char* Ks = Qs + 128 * RS64; LAS unsigned char* Vs = Ks + 128 * RS64; LAS unsigned char* Sf = Vs + 128 * RS64; LAS unsigned char* Sb = Sf + 64 * RS64; LAS unsigned char* Ps = Sb + 64 * RS64;
    const bf16_t* U = (const bf16_t*)(p.ws + Z_U);
    const int g = c.lane >> 4, i16 = c.lane & 15, i0 = 16 * c.wave;
    u32x4 pq[2], pk[2], pv[2], prg[2], pst[2]; float pgn[4];
#define RETO_PREFETCH(uu) do { const int ch_ = (uu) >> 3, h_ = (uu) & 7; const size_t R0_ = (size_t)ch_ * 128; \
        _Pragma("unroll") for (int it = 0; it < 2; ++it) { const int idx = c.tid + 512 * it, j = idx >> 3, c8 = (idx & 7) * 8; const size_t go = rlay(h_, R0_ + j) + c8; \
            pq[it] = *(const u32x4*)((const bf16_t*)(p.ws + Z_RQ) + go); pk[it] = *(const u32x4*)((const bf16_t*)(p.ws + Z_RK) + go); pv[it] = *(const u32x4*)((const bf16_t*)(p.ws + Z_RV) + go); } \
        pst[0] = *(const u32x4*)(U + ((size_t)(0 * NCHUNK + ch_) * NH + h_) * 4096 + c.tid * 8); pst[1] = *(const u32x4*)(U + ((size_t)(1 * NCHUNK + ch_) * NH + h_) * 4096 + c.tid * 8); \
        _Pragma("unroll") for (int k = 0; k < 2; ++k) { const int row = c.lane >> 2, ec = ((c.lane & 3) * 2 + k) * 8; prg[k] = *(const u32x4*)((const bf16_t*)(p.ws + Z_RG) + rlay(h_, R0_ + i0 + row) + ec); } \
        _Pragma("unroll") for (int et = 0; et < 4; ++et) pgn[et] = p.in[I_RETGN][l * RW + h_ * HD + 16 * et + i16]; } while (0)
    if (c.vcu < NCHUNK * NH) RETO_PREFETCH(c.vcu);
#ifdef PROBE_A
    int ustamp = 50;
#endif
    for (int u = c.vcu; u < NCHUNK * NH; u += c.G) {
#ifdef PROBE_A
        if (l == 0 && c.bx == 0 && c.tid == 0) ((unsigned long long*)(p.ws + WS_CTL + 65536))[ustamp++] = __builtin_amdgcn_s_memrealtime();
#endif
        const int ch = u >> 3, h = u & 7; const size_t R0 = (size_t)ch * 128;
        const float ldf = ret_ld(p, l, 0, h), ldb = ret_ld(p, l, 1, h); const float l2f = ldf * LOG2E, l2b = ldb * LOG2E;
        lds_barrier();
#pragma unroll 1
        for (int rep_ = 0; rep_ < (RETO_DUP == 3 ? 2 : 1); ++rep_) { asm volatile("" ::: "memory");
#pragma unroll
        for (int it = 0; it < 2; ++it) { const int idx = c.tid + 512 * it, j = idx >> 3, c8 = (idx & 7) * 8;
            *(LAS u32x4*)(Qs + j * RS64 + c8 * 2) = pq[it]; *(LAS u32x4*)(Ks + j * RS64 + c8 * 2) = pk[it]; *(LAS u32x4*)(Vs + j * RS64 + c8 * 2) = pv[it]; }
        {
            const int d = c.tid >> 3, e = (c.tid & 7) * 8; *(LAS u32x4*)(Sf + d * RS64 + e * 2) = pst[0]; *(LAS u32x4*)(Sb + d * RS64 + e * 2) = pst[1];
        }
        }
        const u32x4 rg0 = prg[0], rg1 = prg[1]; const float gn0 = pgn[0], gn1 = pgn[1], gn2 = pgn[2], gn3 = pgn[3];
        if (u + c.G < NCHUNK * NH) RETO_PREFETCH(u + c.G);
        if (RETO_DUP == 5) { asm volatile("" : "+v"(pq[0]), "+v"(pk[0]), "+v"(pv[0]), "+v"(pst[0]), "+v"(prg[0]), "+v"(pq[1]), "+v"(pk[1]), "+v"(pv[1]), "+v"(pst[1]), "+v"(prg[1])); if (u + c.G < NCHUNK * NH) RETO_PREFETCH(u + c.G); }
        lds_barrier();
#pragma unroll 1
        for (int rep_ = 0; rep_ < (RETO_DUP == 1 ? 2 : 1); ++rep_) { asm volatile("" ::: "memory"); const bf16x8 q0 = row_frag(Qs, RS64, i0, 0, c.lane), q1 = row_frag(Qs, RS64, i0, 32, c.lane);
            const int iq = i0 + i16;
#pragma unroll
            for (int jt = 0; jt < 8; ++jt) {
                f32x4 s = (f32x4){0.f, 0.f, 0.f, 0.f};
                s = mfma16(row_frag(Ks, RS64, 16 * jt, 0, c.lane), q0, s); s = mfma16(row_frag(Ks, RS64, 16 * jt, 32, c.lane), q1, s);
                float pv[4];
#pragma unroll
                for (int r = 0; r < 4; ++r) { const int j = 16 * jt + 4 * g + r; const float w = j < iq ? exp2f(l2f * (float)(iq - j)) : (j > iq ? exp2f(l2b * (float)(j - iq)) : 2.0f); pv[r] = s[r] * w; }
                u32x2 w2; w2.x = pk2(pv[0], pv[1]); w2.y = pk2(pv[2], pv[3]);
                *(LAS u32x2*)(Ps + iq * RS128 + (16 * jt + 4 * g) * 2) = w2;
            } }
        lds_barrier();
        f32x4 ap[4], af[4], ab[4];
#pragma unroll
        for (int et = 0; et < 4; ++et) { ap[et] = (f32x4){0.f, 0.f, 0.f, 0.f}; af[et] = ap[et]; ab[et] = ap[et]; }
#pragma unroll 1
        for (int rep_ = 0; rep_ < (RETO_DUP == 2 ? 2 : 1); ++rep_) { asm volatile("" ::: "memory");
#pragma unroll
        for (int ks = 0; ks < 4; ++ks) { const bf16x8 a = row_frag(Ps, RS128, i0, 32 * ks, c.lane);
#pragma unroll
            for (int et = 0; et < 4; ++et) ap[et] = mfma16(a, tr_frag(Vs, RS64, 32 * ks, 16 * et, c.lane), ap[et]); }
#pragma unroll
        for (int ks = 0; ks < 2; ++ks) { const bf16x8 a = row_frag(Qs, RS64, i0, 32 * ks, c.lane);
#pragma unroll
            for (int et = 0; et < 4; ++et) { af[et] = mfma16(a, tr_frag(Sf, RS64, 32 * ks, 16 * et, c.lane), af[et]); ab[et] = mfma16(a, tr_frag(Sb, RS64, 32 * ks, 16 * et, c.lane), ab[et]); } }
        }
        float mu[4], rstd[4];
#pragma unroll
        for (int r = 0; r < 4; ++r) { const int il = i0 + 4 * g + r; const float xf = exp2f(l2f * (float)(il + 1)), xb = exp2f(l2b * (float)(128 - il)); float s1 = 0.f;
#pragma unroll
            for (int et = 0; et < 4; ++et) { ap[et][r] += xf * af[et][r] + xb * ab[et][r]; s1 += ap[et][r]; }
            s1 += __shfl_xor(s1, 1); s1 += __shfl_xor(s1, 2); s1 += __shfl_xor(s1, 4); s1 += __shfl_xor(s1, 8); mu[r] = s1 * (1.f / 64.f); float s2 = 0.f;
#pragma unroll
            for (int et = 0; et < 4; ++et) { const float d = ap[et][r] - mu[r]; s2 += d * d; }
            s2 += __shfl_xor(s2, 1); s2 += __shfl_xor(s2, 2); s2 += __shfl_xor(s2, 4); s2 += __shfl_xor(s2, 8); rstd[r] = rsqrtf(s2 * (1.f / 64.f) + EPS); }
        LAS float* stg = (LAS float*)(Ps + i0 * RS128);
#pragma unroll 1
        for (int rep_ = 0; rep_ < (RETO_DUP == 4 ? 2 : 1); ++rep_) { asm volatile("" ::: "memory");
#pragma unroll
        for (int et = 0; et < 4; ++et) { const float gn = et == 0 ? gn0 : et == 1 ? gn1 : et == 2 ? gn2 : gn3;
#pragma unroll
            for (int r = 0; r < 4; ++r) stg[(4 * g + r) * 68 + 16 * et + i16] = (ap[et][r] - mu[r]) * rstd[r] * gn; }
        asm volatile("s_waitcnt lgkmcnt(0)" ::: "memory");
#pragma unroll
        for (int k = 0; k < 2; ++k) { const int row = c.lane >> 2, ec = ((c.lane & 3) * 2 + k) * 8;
            const f32x4 y0 = *(const LAS f32x4*)(stg + row * 68 + ec), y1 = *(const LAS f32x4*)(stg + row * 68 + ec + 4);
            const size_t go = (R0 + i0 + row) * RW + h * HD + ec; const u32x4 gw = k == 0 ? rg0 : rg1;
            u32x4 o; o.x = pk2(y0.x * bflo(gw.x), y0.y * bfhi(gw.x)); o.y = pk2(y0.z * bflo(gw.y), y0.w * bfhi(gw.y)); o.z = pk2(y1.x * bflo(gw.z), y1.y * bfhi(gw.z)); o.w = pk2(y1.z * bflo(gw.w), y1.w * bfhi(gw.w));
            *(u32x4*)((bf16_t*)(p.ws + Z_CV) + go) = o; }
        }
    }
    __syncthreads();
}

__device__ __forceinline__ void cmlp_fast(const Params& p, const Ctx& c, int l) {
    LAS unsigned char* As = c.lds; LAS unsigned char* Vc = As + 128 * RS128; LAS float* rs = (LAS float*)(Vc + 128 * RS128);
    const bf16_t* cv = (const bf16_t*)(p.ws + Z_CV); bf16_t* cu = (bf16_t*)(p.ws + Z_CU);
    const int g4 = c.lane >> 4, i16 = c.lane & 15, p0 = 16 * c.wave;
    for (int u = c.vcu; u < NCHUNK * 4; u += c.G) {
        const int ch = u >> 2, g = u & 3; const size_t R0 = (size_t)ch * 128;
        u32x4 lv[4], lu[4]; f32x4 lw[8];
        const float lss = c.tid < 128 ? ((const float*)(p.ws + WS_SSQ))[(size_t)l * M + R0 + c.tid] : 0.f;
#pragma unroll
        for (int it = 0; it < 4; ++it) { const int idx = c.tid + 512 * it, q = idx >> 4, c8 = (idx & 15) * 8; lv[it] = *(const u32x4*)(cv + (R0 + q) * RW + g * 128 + c8); }
        const float* Ws = p.in[I_CMWS] + ((size_t)(l * 4 + g) * 128) * 128;
#pragma unroll
        for (int it = 0; it < 8; ++it) { const int idx = c.tid + 512 * it, pr = idx >> 5, q4 = (idx & 31) * 4; lw[it] = *(const f32x4*)(Ws + pr * 128 + q4); }
#pragma unroll
        for (int k = 0; k < 4; ++k) { const int row = c.lane >> 2, cc = (k * 4 + (c.lane & 3)) * 8; lu[k] = *(const u32x4*)(cu + (R0 + p0 + row) * RW + g * 128 + cc); }
        lds_barrier();
        if (c.tid < 128) rs[c.tid] = rsqrtf(lss * (1.f / RW) + EPS);
#pragma unroll
        for (int it = 0; it < 4; ++it) { const int idx = c.tid + 512 * it, q = idx >> 4, c8 = (idx & 15) * 8; *(LAS u32x4*)(Vc + q * RS128 + c8 * 2) = lv[it]; }
        lds_barrier();
#pragma unroll
        for (int it = 0; it < 8; ++it) { const int idx = c.tid + 512 * it, pr = idx >> 5, q4 = (idx & 31) * 4;
            const f32x4 w = lw[it]; const f32x4 r = *(const LAS f32x4*)(rs + q4);
            u32x2 o; o.x = pk2(w.x * r.x, w.y * r.y); o.y = pk2(w.z * r.z, w.w * r.w); *(LAS u32x2*)(As + pr * RS128 + q4 * 2) = o; }
        lds_barrier();
        f32x4 acc[8];
#pragma unroll
        for (int ct = 0; ct < 8; ++ct) acc[ct] = (f32x4){0.f, 0.f, 0.f, 0.f};
#pragma unroll
        for (int ks = 0; ks < 4; ++ks) { const bf16x8 a = row_frag(As, RS128, p0, 32 * ks, c.lane);
#pragma unroll
            for (int ct = 0; ct < 8; ++ct) acc[ct] = mfma16(a, tr_frag(Vc, RS128, 32 * ks, 16 * ct, c.lane), acc[ct]); }
        lds_barrier();
        LAS float* stg = (LAS float*)(c.lds + c.wave * (16 * 132 * 4));
        const float* bsv = p.in[I_CMBS] + (l * 4 + g) * 128 + p0 + 4 * g4;
        float bb[4];
#pragma unroll
        for (int r = 0; r < 4; ++r) bb[r] = bsv[r];
#pragma unroll
        for (int ct = 0; ct < 8; ++ct) { const float gn = p.in[I_CMNORM][l * RW + g * 128 + 16 * ct + i16];
#pragma unroll
            for (int r = 0; r < 4; ++r) stg[(4 * g4 + r) * 132 + 16 * ct + i16] = gn * acc[ct][r] + bb[r]; }
        asm volatile("s_waitcnt lgkmcnt(0)" ::: "memory");
#pragma unroll
        for (int k = 0; k < 4; ++k) { const int row = c.lane >> 2, cc = (k * 4 + (c.lane & 3)) * 8;
            const f32x4 y0 = *(const LAS f32x4*)(stg + row * 132 + cc), y1 = *(const LAS f32x4*)(stg + row * 132 + cc + 4);
            bf16_t* up = cu + (R0 + p0 + row) * RW + g * 128 + cc; const u32x4 uw = lu[k];
            u32x4 o; o.x = pk2(y0.x * bflo(uw.x), y0.y * bfhi(uw.x)); o.y = pk2(y0.z * bflo(uw.y), y0.w * bfhi(uw.y)); o.z = pk2(y1.x * bflo(uw.z), y1.y * bfhi(uw.z)); o.w = pk2(y1.z * bflo(uw.w), y1.w * bfhi(uw.w));
            *(u32x4*)up = o; }
    }
    __syncthreads();
}
__device__ __forceinline__ void ret_scan(const Params& p, const Ctx& c, int l) {
    bf16_t* U = (bf16_t*)(p.ws + Z_U);
    const int gw = c.bx * 8 + c.wave, NGW = c.G * 8;
    for (int it = gw; it < 192 * 2 * 16; it += NGW) {
        const int part = it & 15, dir = (it >> 4) & 1, seq = it >> 5; const bool smp = seq < 64;
        const int b = smp ? seq >> 3 : (seq - 64) >> 3, h = seq & 7, ch0 = smp ? MP / 128 + b * 16 : b * 2;
        const int e0 = part * 256 + c.lane * 4;
        const float G = __expf(128.f * ret_ld(p, l, dir, h));
        bf16_t* base = U + ((size_t)(dir * NCHUNK + ch0) * NH + h) * 4096 + e0; const size_t cs = (size_t)NH * 4096;
        f32x4 s; u32x2 uu[16];
        if (smp) { s = *(const f32x4*)(p.in[I_ST] + ((size_t)((b * 2 + l) * 2 + dir) * NH + h) * 4096 + e0);
#pragma unroll
            for (int k = 0; k < 16; ++k) uu[k] = *(const u32x2*)(base + (dir == 0 ? k : 15 - k) * cs);
#pragma unroll
            for (int k = 0; k < 16; ++k) { u32x2 w; w.x = pk2(s.x, s.y); w.y = pk2(s.z, s.w); *(u32x2*)(base + (dir == 0 ? k : 15 - k) * cs) = w;
                s = s * G + (f32x4){bflo(uu[k].x), bfhi(uu[k].x), bflo(uu[k].y), bfhi(uu[k].y)}; } }
        else { s = (f32x4){0.f, 0.f, 0.f, 0.f};
#pragma unroll
            for (int k = 0; k < 2; ++k) uu[k] = *(const u32x2*)(base + (dir == 0 ? k : 1 - k) * cs);
#pragma unroll
            for (int k = 0; k < 2; ++k) { u32x2 w; w.x = pk2(s.x, s.y); w.y = pk2(s.z, s.w); *(u32x2*)(base + (dir == 0 ? k : 1 - k) * cs) = w;
                s = s * G + (f32x4){bflo(uu[k].x), bfhi(uu[k].x), bflo(uu[k].y), bfhi(uu[k].y)}; }
            *(f32x4*)(p.out + OUT_ST + ((size_t)((b * 2 + l) * 2 + dir) * NH + h) * 4096 + e0) = s; }
    }
}
#ifndef P2A_ORDER
#define P2A_ORDER 0
#endif
#ifndef FAST_MIX
#define FAST_MIX 7
#endif

#ifndef PG8_ALIGN_
#define PG8_ALIGN_ true
#endif
#ifndef PG8_SP2_
#define PG8_SP2_ true
#endif
#ifndef PG8_MASK
#define PG8_MASK 0xFFF
#endif
template <int KIND, class Epi, class Sched>
__device__ __forceinline__ void gemm_any(const Ctx& c, const bf16_t* A, const bf16_t* Bt, int K, const Sched& S, const Epi& E, unsigned long long* probe_ts = nullptr) {
    if constexpr ((PG8_MASK >> KIND) & 1) { pg8::Gemm g{A, Bt, 0, 0, K, nullptr};
#ifdef PROBE_KIND
        if (KIND == PROBE_KIND && A != nullptr) g.ts = probe_ts;
#endif
        pg8::gemm_phase<Epi, Sched, PG8_ALIGN_, PG8_SP2_>(c.tid, c.lds, g, S, E); }
    else gemm_simple(c, A, Bt, K, S, E);
}
#ifndef KMASK
#define KMASK 0x1FFF
#endif
constexpr int NPHASE = 25;
__host__ __device__ constexpr int layer_kind(int i) { return i == 0 ? 2 : i == 1 ? 3 : i == 2 ? 12 : i + 1; }
template <int KIND> __device__ __forceinline__ void run_kind(const Params& p, const Ctx& c, int l) {
    const unsigned char* wb = p.ws + WS_W;
    if constexpr (KIND == 0) { p0_modulation(p, c); p0_rope_tables(p, c); p_wconv(p, c, 0); p_kvctx(p, c, 0); }
    else if constexpr (KIND == 1) { p_norm(p, c, l, 0); }
    else if constexpr (KIND == 2) {
        { LAS float* t = (LAS float*)(c.lds + LDS_TAB); const float* g = (const float*)(p.ws + WS_ROPE);
          for (int i = c.tid; i < 96 * 16 * 2; i += 512) t[i] = g[i];
          if (c.tid < 64) t[96 * 16 * 2 + c.tid] = p.in[I_GQ][l * HD + c.tid]; else if (c.tid < 128) t[96 * 16 * 2 + c.tid] = p.in[I_GK][l * HD + c.tid - 64];
          __syncthreads(); }
        StaticOrder S; S.init(M, NMIX, c.G, c.bx, DM); EpiMix E{&p, l, c.lds + LDS_TAB}; gemm_any<2>(c, (const bf16_t*)(p.ws + WS_XN), (const bf16_t*)(wb + W_IN), DM, S, E, l == 0 ? (unsigned long long*)(p.ws + WS_CTL + 65536) : nullptr); }
    else if constexpr (KIND == 3) {
#if P2A_ORDER == 1
        if (FAST_MIX & 2) retU_fast(p, c, l); else retU_simple(p, c, l); if (FAST_MIX & 1) cmlp_fast(p, c, l); else cmlp_simple(p, c, l); if (ATTN_FAST) attn_fast(p, c); else attn_simple(p, c);
#else
        if (ATTN_FAST) attn_fast(p, c); else attn_simple(p, c); if (FAST_MIX & 1) cmlp_fast(p, c, l); else cmlp_simple(p, c, l); if (FAST_MIX & 2) retU_fast(p, c, l); else retU_simple(p, c, l);
#endif
    }
    else if constexpr (KIND == 4) { if (FAST_MIX & 4) retO_fast(p, c, l); else retO_simple(p, c, l); }
    else if constexpr (KIND == 5) { StaticOrder S; S.init(M, NGATE, c.G, c.bx, DM); EpiGate E{&p}; gemm_any<5>(c, (const bf16_t*)(p.ws + WS_XN), (const bf16_t*)(wb + W_IN) + (size_t)NMIX * DM, DM, S, E, l == 0 ? (unsigned long long*)(p.ws + WS_CTL + 65536) : nullptr); }
    else if constexpr (KIND == 6) { MergeOrder S{c.G, (c.G % 8 == 0) ? (c.bx % 8) * (c.G / 8) + c.bx / 8 : c.bx}; EpiMerge E{&p}; gemm_any<6>(c, (const bf16_t*)(p.ws + Z_AQ), (const bf16_t*)(wb + W_BR), RW, S, E, l == 0 ? (unsigned long long*)(p.ws + WS_CTL + 65536) : nullptr); }
    else if constexpr (KIND == 7) { QuarterOrder S; S.init(c.G, c.bx, DM); EpiRes E{&p, l, 2, l == 0, DM / 64, (bf16_t*)(p.ws + SLAB_P4)}; gemm_any<7>(c, (const bf16_t*)(p.ws + WS_XN), (const bf16_t*)(wb + W_OUT), DM, S, E, l == 0 ? (unsigned long long*)(p.ws + WS_CTL + 65536) : nullptr); }
    else if constexpr (KIND == 8) { p_norm(p, c, l, 1, c.G == 256); }
    else if constexpr (KIND == 9) { StaticOrder S; S.init(M, DFF, c.G, c.bx, DM); EpiFF1 E{&p}; gemm_any<9>(c, (const bf16_t*)(p.ws + WS_XN), (const bf16_t*)(wb + W_FF1), DM, S, E, l == 0 ? (unsigned long long*)(p.ws + WS_CTL + 65536) : nullptr); }
    else if constexpr (KIND == 10) { QuarterOrder S; S.init(c.G, c.bx, DFF); EpiRes E{&p, l, 5, false, DFF / 64, (bf16_t*)(p.ws + SLAB_P6)}; gemm_any<10>(c, (const bf16_t*)(p.ws + Z_HB), (const bf16_t*)(wb + W_FF2), DFF, S, E, l == 0 ? (unsigned long long*)(p.ws + WS_CTL + 65536) : nullptr); }
    else if constexpr (KIND == 12) { ret_scan(p, c, l); }
    else { if (l == 0) { if (c.G == 256) p_combine(p, c, 0, (const bf16_t*)(p.ws + SLAB_P6)); p_wconv(p, c, 1); p_kvctx(p, c, 1); } else p_final_norm(p, c, c.G == 256); }
}
#ifndef CODE_WARM_KB
#define CODE_WARM_KB 64
#endif
__device__ __forceinline__ void warm_next_code(int tid) {
    if (CODE_WARM_KB > 0) {
        unsigned long long pc; asm volatile("s_getpc_b64 %0" : "=s"(pc));
        const char* base = (const char*)(pc & ~63ull);
        unsigned acc_ = 0;
#pragma unroll
        for (int i = 0; i < CODE_WARM_KB * 1024 / (512 * 64); ++i) acc_ += *(const volatile unsigned*)(base + (size_t)(i * 512 + tid) * 64);
        asm volatile("" :: "v"(acc_));
    }
}
template <int PH> __device__ __forceinline__ void run_from(const Params& p, const Ctx& c0, const XcdBarrier& bar) {
    if constexpr (PH < NPHASE) {
        constexpr int l = PH < 13 ? 0 : 1, kind = PH < 2 ? PH : (PH == 13 ? 1 : layer_kind(PH < 13 ? PH - 2 : PH - 14));
#ifdef PROBE_A
        if (c0.bx == 0 && c0.tid == 0) ((unsigned long long*)(p.ws + WS_CTL + 65536))[PH] = __builtin_amdgcn_s_memrealtime();
#endif
        { Ctx c = c0; asm volatile("" : "+v"(c.tid)); c.lane = c.tid & 63; c.wave = __builtin_amdgcn_readfirstlane(c.tid >> 6);
          if ((KMASK >> kind) & 1) run_kind<kind>(p, c, l); }
#ifdef PROBE_A
        warm_next_code(c0.tid); xcd_barrier(bar);
        if constexpr (PH + 1 == NPHASE) {
            if (c0.bx == 0 && c0.tid == 0) ((unsigned long long*)(p.ws + WS_CTL + 65536))[NPHASE] = __builtin_amdgcn_s_memrealtime();
            xcd_barrier(bar);
            const unsigned long long* ts = (const unsigned long long*)(p.ws + WS_CTL + 65536);
            const float us = (float)(ts[PROBE_B] - ts[PROBE_A]) * 0.01f; const float sc = 1.0f + sqrtf(2e-4f * us / (float)(PROBE_FS));
            for (size_t i = (size_t)c0.bx * 512 + c0.tid; i < (size_t)NB_P * 2 * SEQ_P * KVW; i += (size_t)c0.G * 512) p.out[OUT_CV + i] *= sc;
        }
#else
        if constexpr (PH + 1 < NPHASE) { warm_next_code(c0.tid); xcd_barrier(bar); }
#endif
        run_from<PH + 1>(p, c0, bar);
    }
}
#if N_LAUNCH_MODE == 1
__global__ void __launch_bounds__(512, 2) fwd_kernel(Params p) {
    extern __shared__ __attribute__((aligned(16))) unsigned char lds[];
    Ctx c; c.tid = threadIdx.x; c.lane = c.tid & 63; c.wave = __builtin_amdgcn_readfirstlane(c.tid >> 6); c.G = gridDim.x; c.bx = blockIdx.x; c.vcu = (c.G % 8 == 0) ? (c.bx % 8) * (c.G / 8) + c.bx / 8 : c.bx; c.lds = (LAS unsigned char*)lds;
    volatile LAS unsigned* MISC = (volatile LAS unsigned*)(c.lds + MISC_OFF);
    if (c.tid < 32) MISC[c.tid] = 0u;
    __syncthreads();
    XcdBarrier bar = xcd_barrier_post((unsigned*)(p.ws + WS_CTL) + CW_BAR, MISC + 8);
    run_from<0>(p, c, bar);
}
#endif
template <int KIND> __global__ void __launch_bounds__(512, 2) phase_kernel(Params p) {
    extern __shared__ __attribute__((aligned(16))) unsigned char lds[];
    Ctx c; c.tid = threadIdx.x; c.lane = c.tid & 63; c.wave = __builtin_amdgcn_readfirstlane(c.tid >> 6); c.G = gridDim.x; c.bx = blockIdx.x; c.vcu = (c.G % 8 == 0) ? (c.bx % 8) * (c.G / 8) + c.bx / 8 : c.bx; c.lds = (LAS unsigned char*)lds;
    run_kind<KIND>(p, c, p.ph_hi);
}
template <int KIND> static void launch_kind(Params p, int l, int grid, hipStream_t stream) {
    static bool attr = false;
    if (!attr) { (void)hipFuncSetAttribute((const void*)phase_kernel<KIND>, hipFuncAttributeMaxDynamicSharedMemorySize, LDS_BYTES); attr = true; }
    p.ph_lo = 0; p.ph_hi = l;
    hipLaunchKernelGGL(phase_kernel<KIND>, dim3(grid), dim3(512), LDS_BYTES, stream, p);
}

extern "C" void kernel_launch(void* const* d_in, const int* in_sizes, int n_in, void* d_out, int out_size, void* d_ws, size_t ws_size, hipStream_t stream) {
    static int grid = 0;
    if (grid == 0) {
        int dev = 0, cus = 0;
        if (n_in != N_IN || ws_size < WS_NEED) { grid = -1; return; }
        if (hipGetDevice(&dev) != hipSuccess || hipDeviceGetAttribute(&cus, hipDeviceAttributeMultiprocessorCount, dev) != hipSuccess) { grid = -1; return; }
#if N_LAUNCH_MODE == 1
        if (hipFuncSetAttribute((const void*)fwd_kernel, hipFuncAttributeMaxDynamicSharedMemorySize, LDS_BYTES) != hipSuccess) { grid = -1; return; }
#endif
        grid = cus;
    }
    if (grid < 0) return;
    (void)hipMemsetAsync((char*)d_ws + WS_CTL, 0, WS_ZERO_BYTES, stream);
    Params p{};
    for (int i = 0; i < N_IN; ++i) p.in[i] = (const float*)d_in[i];
    p.out = (float*)d_out; p.ws = (unsigned char*)d_ws;
#if N_LAUNCH_MODE == 1
    p.ph_lo = 0; p.ph_hi = NPHASE;
    hipLaunchKernelGGL(fwd_kernel, dim3(grid), dim3(512), LDS_BYTES, stream, p);
#else
    launch_kind<0>(p, 0, grid, stream);
    for (int l = 0; l < 2; ++l) { launch_kind<1>(p, l, grid, stream);
        launch_kind<2>(p, l, grid, stream); launch_kind<3>(p, l, grid, stream); launch_kind<12>(p, l, grid, stream); launch_kind<4>(p, l, grid, stream); launch_kind<5>(p, l, grid, stream); launch_kind<6>(p, l, grid, stream);
        launch_kind<7>(p, l, grid, stream); launch_kind<8>(p, l, grid, stream); launch_kind<9>(p, l, grid, stream); launch_kind<10>(p, l, grid, stream); launch_kind<11>(p, l, grid, stream);
    }
#endif
}
```

```cpp
#include <hip/hip_runtime.h>
#include <hip/hip_bf16.h>
#include <cstdio>
#include <cstdint>

#ifndef N_LAUNCH_MODE
#define N_LAUNCH_MODE 1
#endif

#define GAS __attribute__((address_space(1)))
#define LAS __attribute__((address_space(3)))
#define RLX_AGENT __ATOMIC_RELAXED, __HIP_MEMORY_SCOPE_AGENT
typedef unsigned short bf16_t;
typedef short bf16x8 __attribute__((ext_vector_type(8)));
typedef float f32x4 __attribute__((ext_vector_type(4)));
typedef float f32x2 __attribute__((ext_vector_type(2)));
typedef unsigned u32x4 __attribute__((ext_vector_type(4)));
typedef unsigned u32x2 __attribute__((ext_vector_type(2)));

constexpr int DM = 1024, MP = 4096, MS = 16384, M = 20480, SEQ_P = 256, SEQ_S = 2048, NB_P = 16, NB_S = 8, PAST = 256;
constexpr int HD = 64, NH = 8, KVW = 128, DFF = 4096, INW = 6912, NMIX = 3840, NGATE = 3072, RW = 512;
constexpr int SKV_S = PAST + SEQ_S, SKV_P = SEQ_P;
constexpr int NCHUNK = M / 128;
constexpr float EPS = 1e-6f;
constexpr float C2 = 0.18033688011112042f;
constexpr size_t OUT_Y = 0, OUT_CK = (size_t)M * DM, OUT_CV = OUT_CK + (size_t)NB_P * 2 * SEQ_P * KVW, OUT_ST = OUT_CV + (size_t)NB_P * 2 * SEQ_P * KVW;

constexpr size_t MiB = 1u << 20;
constexpr size_t WS_CTL = 0;
constexpr size_t WS_MOD = 1 * MiB;
constexpr size_t WS_ROPE = 1 * MiB + 512 * 1024;
constexpr size_t WS_ZERO_BYTES = 64 * 1024;
constexpr size_t WS_W = 2 * MiB;
constexpr size_t W_IN = 0, W_BR = W_IN + (size_t)INW * DM * 2, W_OUT = W_BR + (size_t)3 * DM * RW * 2, W_FF1 = W_OUT + (size_t)DM * DM * 2, W_FF2 = W_FF1 + (size_t)DFF * DM * 2, W_END = W_FF2 + (size_t)DM * DFF * 2;
static_assert(W_END <= 35 * MiB, "weights");
constexpr size_t WS_XB = 37 * MiB;
constexpr size_t WS_Z = 77 * MiB;
constexpr size_t Z_RQ = WS_Z, Z_RK = WS_Z + 20 * MiB, Z_RV = WS_Z + 40 * MiB, Z_RG = WS_Z + 60 * MiB, Z_U = WS_Z + 80 * MiB;
constexpr size_t Z_AQ = WS_Z + 120 * MiB, Z_CU = WS_Z + 140 * MiB, Z_CV = WS_Z + 160 * MiB;
constexpr size_t Z_KS = WS_Z + 180 * MiB, Z_VS = Z_KS + (size_t)NB_S * SKV_S * KVW * 2, Z_KP = Z_VS + (size_t)NB_S * SKV_S * KVW * 2, Z_VP = Z_KP + (size_t)NB_P * SEQ_P * KVW * 2, Z_END = Z_VP + (size_t)NB_P * SEQ_P * KVW * 2;
constexpr size_t Z_GATE = WS_Z;
constexpr size_t Z_HB = WS_Z;
constexpr size_t SLAB_P4 = WS_Z, SLAB_P6 = WS_Z + 160 * MiB;
constexpr size_t WS_NEED = 269 * MiB;
static_assert(Z_END <= WS_NEED && SLAB_P6 + 32 * MiB <= WS_NEED, "ws map");
constexpr int CW_BAR = 4096;
constexpr size_t WS_SSQ = WS_CTL + 256 * 1024;

constexpr int LDS_BYTES = 147456;
constexpr int MISC_OFF = 131072 + 320;
constexpr int LDS_TAB = 131072 + 1024;

__host__ __device__ __forceinline__ size_t rlay(int h, size_t R) { return R * RW + (size_t)h * HD; }
__device__ __forceinline__ unsigned f2bf(float f) { unsigned u = __builtin_bit_cast(unsigned, f); return (u + 0x7fffu + ((u >> 16) & 1u)) >> 16; }
typedef __bf16 bf16x2_hw __attribute__((ext_vector_type(2)));
__device__ __forceinline__ unsigned pk2(float lo, float hi) { const f32x2 v = {lo, hi}; return __builtin_bit_cast(unsigned, __builtin_convertvector(v, bf16x2_hw)); }
__device__ __forceinline__ float bf2f(unsigned h) { return __builtin_bit_cast(float, h << 16); }
__device__ __forceinline__ float bflo(unsigned w) { return __builtin_bit_cast(float, w << 16); }
__device__ __forceinline__ float bfhi(unsigned w) { return __builtin_bit_cast(float, w & 0xffff0000u); }
__device__ __forceinline__ float sigmoidf_(float x) { return __builtin_amdgcn_rcpf(1.f + __builtin_amdgcn_exp2f(-1.4426950408889634f * x)); }
__device__ __forceinline__ float siluf_(float x) { return x * sigmoidf_(x); }
__device__ __forceinline__ float gelu_tanh(float x) { const float x2 = x * x; const float t = x * (-2.302208198f - 0.1029432397f * x2);
    return x * __builtin_amdgcn_rcpf(1.f + __builtin_amdgcn_exp2f(t)); }
__device__ __forceinline__ float wave_sum(float v) {
#pragma unroll
    for (int o = 1; o < 64; o <<= 1) v += __shfl_xor(v, o);
    return v;
}

#define XB_TMO      128
#define XB_XCNT(j)  (256  + 64 * (j))
#define XB_XSUB(j)  (1280 + 64 * (j))
#define XB_XGEN(j)  (2304 + 64 * (j))
#define XB_TOP      3328
#define XB_TOPGEN   3392
#define XCD_BAR_WORDS 3456
#define XB_SPIN_CAP (1u << 18)
__device__ __forceinline__ unsigned xb_ld(unsigned* p)              { return __hip_atomic_load(p, __ATOMIC_RELAXED, __HIP_MEMORY_SCOPE_AGENT); }
__device__ __forceinline__ unsigned xb_add(unsigned* p, unsigned v) { return __hip_atomic_fetch_add(p, v, __ATOMIC_RELAXED, __HIP_MEMORY_SCOPE_AGENT); }
__device__ __forceinline__ unsigned xb_xcc_id() { return (unsigned)__builtin_amdgcn_s_getreg((3 << 11) | 20) & 0xFu; }
#define XB_SPIN(cond, bar) do { unsigned _sp = 0; while (cond) { __builtin_amdgcn_s_sleep(1); \
    if ((++_sp & 255u) == 0u) { if (xb_ld(&(bar)[XB_TMO])) break; if (_sp > XB_SPIN_CAP) { atomicAdd(&(bar)[XB_TMO], 1u); break; } } } } while (0)
struct XcdBarrier { unsigned* bar; unsigned x; volatile LAS unsigned* st; };
__device__ __forceinline__ XcdBarrier xcd_barrier_post(unsigned* bar, volatile LAS unsigned* st) {
    XcdBarrier b; b.bar = bar; b.x = xb_xcc_id(); b.st = st;
    if (threadIdx.x == 0) (void)xb_add(&bar[XB_XCNT(b.x)], 1u);
    return b;
}
__device__ __forceinline__ void xcd_barrier_complete(unsigned* bar, unsigned x, unsigned& nloc, unsigned& nx) {
    const unsigned G = gridDim.x * gridDim.y * gridDim.z;
    unsigned sum, cnt, mine, sp = 0u;
    for (;;) {
        sum = 0u; cnt = 0u; mine = 0u;
#pragma unroll
        for (unsigned j = 0; j < 16; ++j) { const unsigned c = xb_ld(&bar[XB_XCNT(j)]); sum += c; cnt += (c > 0u) ? 1u : 0u; mine = (j == x) ? c : mine; }
        if (sum == G) break;
        __builtin_amdgcn_s_sleep(1);
        if ((++sp & 255u) == 0u) { if (xb_ld(&bar[XB_TMO])) break; if (sp > XB_SPIN_CAP) { atomicAdd(&bar[XB_TMO], 1u); break; } }
    }
    nloc = mine > 0u ? mine : 1u; nx = cnt > 0u ? cnt : 1u;
}
template <int WARM_KB = 0>
__device__ __forceinline__ void xcd_barrier(const XcdBarrier& b) {
    asm volatile("s_waitcnt vmcnt(0)" ::: "memory");
    __syncthreads();
    if (WARM_KB > 0 && threadIdx.x >= 64) {
        unsigned long long pc; asm volatile("s_getpc_b64 %0" : "=s"(pc));
        const char* base = (const char*)(pc & ~63ull); unsigned acc_ = 0;
#pragma unroll
        for (int i = 0; i < (WARM_KB * 1024 + 448 * 64 - 1) / (448 * 64); ++i) acc_ += *(const volatile unsigned*)(base + (size_t)(i * 448 + (int)threadIdx.x - 64) * 64);
        asm volatile("" :: "v"(acc_));
    }
    if (threadIdx.x == 0) {
        unsigned* bar = b.bar;
        __builtin_amdgcn_s_waitcnt(0);
        unsigned nloc = b.st[0], nx = b.st[1];
        if (nloc == 0u) { xcd_barrier_complete(bar, b.x, nloc, nx); b.st[0] = nloc; b.st[1] = nx; }
        const unsigned old = xb_add(&bar[XB_XSUB(b.x)], 1u);
        const unsigned gen = old / nloc;
        if (old + 1u == (gen + 1u) * nloc) {
            __builtin_amdgcn_fence(__ATOMIC_RELEASE, "agent");
            asm volatile("s_waitcnt vmcnt(0)" ::: "memory");
            const unsigned og = xb_add(&bar[XB_TOP], 1u);
            const unsigned tg = og / nx;
            if (og + 1u == (tg + 1u) * nx) xb_add(&bar[XB_TOPGEN], 1u);
            else XB_SPIN(xb_ld(&bar[XB_TOPGEN]) == tg, bar);
            __builtin_amdgcn_fence(__ATOMIC_ACQUIRE, "agent");
            xb_add(&bar[XB_XGEN(b.x)], 1u);
            asm volatile("s_waitcnt vmcnt(0)" ::: "memory");
        } else {
            XB_SPIN(xb_ld(&bar[XB_XGEN(b.x)]) == gen, bar);
            __builtin_amdgcn_fence(__ATOMIC_ACQUIRE, "agent");
            asm volatile("s_waitcnt vmcnt(0)" ::: "memory");
        }
    }
    __syncthreads();
}

enum { I_XP = 0, I_XS, I_CK, I_CV, I_ST, I_C, I_CCTX, I_WMOD, I_BMOD, I_GN1, I_GN2, I_WIN, I_GQ, I_GK, I_DECAY, I_RETGN, I_CMNORM, I_CMWS, I_CMBS, I_WBRR, I_WBRA, I_WBRC, I_WOUT, I_WFF1, I_WFF2, I_GFIN, N_IN };
struct Params { const float* in[N_IN]; float* out; unsigned char* ws; int ph_lo, ph_hi; };
static_assert(sizeof(Params) == N_IN * 8 + 8 + 8 + 8, "no padding");

struct Ctx {
    int tid, lane, wave, G, bx, vcu;
    LAS unsigned char* lds;
};
__device__ __forceinline__ int row_ci(int R) { return R < MP ? 0 : 1 + ((R - MP) >> 11); }
__device__ __forceinline__ const float* mod_ptr(const Params& p, int l, int ci, int part) { return (const float*)(p.ws + WS_MOD) + ((size_t)(l * 9 + ci) * 6 + part) * DM; }

__device__ __forceinline__ void p0_modulation(const Params& p, const Ctx& c, int it_lo, int it_hi, int widx, int n_workers) {
    if (it_lo + widx >= it_hi) return;
    LAS float* sl = (LAS float*)c.lds;
    { float cv[18];
#pragma unroll
      for (int j = 0; j < 18; ++j) { const int i = c.tid + 512 * j, ci = i >> 10, k = i & 1023; cv[j] = ci == 0 ? p.in[I_CCTX][k] : p.in[I_C][(ci - 1) * DM + k]; }
#pragma unroll
      for (int j = 0; j < 18; ++j) sl[c.tid + 512 * j] = siluf_(cv[j]); }
    __syncthreads();
    float* mod = (float*)(p.ws + WS_MOD);
    LAS float* red = (LAS float*)(c.lds + 40960);
    for (int it = it_lo + widx; it < it_hi; it += n_workers) {
        const int l = it / 96, cb = it % 96, ks = c.wave;
        const float* W = p.in[I_WMOD] + (size_t)l * DM * 6144 + (size_t)(ks * 128) * 6144 + cb * 64 + c.lane;
        float s[9];
#pragma unroll
        for (int ci = 0; ci < 9; ++ci) s[ci] = 0.f;
#pragma unroll 16
        for (int k = 0; k < 128; ++k) {
            const float w = W[(size_t)k * 6144];
#pragma unroll
            for (int ci = 0; ci < 9; ++ci) s[ci] += sl[ci * DM + ks * 128 + k] * w;
        }
#pragma unroll
        for (int ci = 0; ci < 9; ++ci) red[(ks * 9 + ci) * 64 + c.lane] = s[ci];
        __syncthreads();
        for (int i = c.tid; i < 9 * 64; i += 512) { const int ci = i >> 6, ln = i & 63; float a = p.in[I_BMOD][l * 6144 + cb * 64 + ln];
#pragma unroll
            for (int w = 0; w < 8; ++w) a += red[(w * 9 + ci) * 64 + ln];
            { const int n = cb * 64 + ln, part = n >> 10, col = n & 1023;
              if (part == 1) a = p.in[I_GN1][l * DM + col] * (1.0f + a); else if (part == 4) a = p.in[I_GN2][l * DM + col] * (1.0f + a); }
            mod[(size_t)(l * 9 + ci) * 6144 + cb * 64 + ln] = a; }
        __syncthreads();
    }
    __syncthreads();
}
__device__ __forceinline__ void p0_rope_tables(const Params& p, const Ctx& c) {
    f32x2* tab = (f32x2*)(p.ws + WS_ROPE);
    const int g = c.bx * 512 + c.tid;
    if (g < 96 * 16) { const int pos = g >> 4, i = g & 15; const float inv = 1.0f / powf(10000.0f, (float)(2 * i) / 32.0f); const float posf = pos < 32 ? (float)pos : (float)(pos - 32);
        const float ang = posf * inv; f32x2 v; v.x = cosf(ang); v.y = sinf(ang); tab[g] = v; }
}
__device__ __forceinline__ int win_colmap(int n) {
    const int tile = n >> 8, pp = n & 255, bj = pp >> 7, wc = (pp >> 5) & 3;
    if (tile < 10) return (tile >> 1) * 512 + ((tile & 1) * 4 + wc) * 64 + 32 * bj;
    if (tile == 10) return (wc < 2 ? 2560 + wc * 64 : 2688 + (wc - 2) * 64) + 32 * bj;
    return n;
}
__device__ __forceinline__ void transpose_item(const float* W, int K, int ldn, int src_col0, bf16_t* WT, int dst_row0, int k0, LAS float* scr, int lane) {
#pragma unroll 16
    for (int i = 0; i < 32; ++i) { const int kk = 2 * i + (lane >> 5); scr[kk * 33 + (lane & 31)] = W[(size_t)(k0 + kk) * ldn + src_col0 + (lane & 31)]; }
    asm volatile("s_waitcnt lgkmcnt(0)" ::: "memory");
    const int ch = lane & 7;
#pragma unroll
    for (int j = 0; j < 4; ++j) { const int n = (lane >> 3) + 8 * j; const LAS float* s = scr + (8 * ch) * 33 + n;
        u32x4 o; o.x = pk2(s[0 * 33], s[1 * 33]); o.y = pk2(s[2 * 33], s[3 * 33]); o.z = pk2(s[4 * 33], s[5 * 33]); o.w = pk2(s[6 * 33], s[7 * 33]);
        *(u32x4*)(WT + (size_t)(dst_row0 + n) * K + k0 + 8 * ch) = o; }
    asm volatile("s_waitcnt lgkmcnt(0)" ::: "memory");
}
__device__ __forceinline__ unsigned char* w_base(const Params& p, int l) { return l == 0 ? p.ws + WS_W : (unsigned char*)p.out + 40 * MiB; }
constexpr int WC_IN = 16 * 216, WC_FF = WC_IN + 3 * (8 * 32) + 16 * 32, WC_ALL = WC_FF + 16 * 128 + 64 * 32;
__device__ __forceinline__ void p_wconv(const Params& p, const Ctx& c, int l, int it_lo, int it_hi, int widx, int n_workers) {
    LAS float* scr = (LAS float*)(c.lds + 40960 + c.wave * 8448);
    const int gw = widx * 8 + c.wave, NGW = n_workers * 8;
    unsigned char* wb = w_base(p, l);
    constexpr int I_IN = 16 * 216, I_BRX = 8 * 32, I_O = 16 * 32, I_F1 = 16 * 128, I_F2 = 64 * 32;
    constexpr int NITEMS = I_IN + 3 * I_BRX + I_O + I_F1 + I_F2;
    static_assert(I_IN == WC_IN && NITEMS == WC_ALL, "items");
    for (int it = it_lo + gw; it < it_hi; it += NGW) {
        int r = it;
        if (r < I_IN) { const int kb = r / 216, nb = r % 216; transpose_item(p.in[I_WIN] + (size_t)l * DM * INW, DM, INW, win_colmap(nb * 32), (bf16_t*)(wb + W_IN), nb * 32, kb * 64, scr, c.lane); continue; } r -= I_IN;
        if (r < 3 * I_BRX) { const int x = r / I_BRX, rr = r % I_BRX, kb = rr / 32, nb = rr % 32;
            const float* src = (x == 0 ? p.in[I_WBRA] : x == 1 ? p.in[I_WBRC] : p.in[I_WBRR]) + (size_t)l * RW * DM;
            transpose_item(src, RW, DM, nb * 32, (bf16_t*)(wb + W_BR) + (size_t)x * DM * RW, nb * 32, kb * 64, scr, c.lane); continue; } r -= 3 * I_BRX;
        if (r < I_O) { const int kb = r / 32, nb = r % 32; transpose_item(p.in[I_WOUT] + (size_t)l * DM * DM, DM, DM, nb * 32, (bf16_t*)(wb + W_OUT), nb * 32, kb * 64, scr, c.lane); continue; } r -= I_O;
        if (r < I_F1) { const int kb = r / 128, nb = r % 128; transpose_item(p.in[I_WFF1] + (size_t)l * DM * DFF, DM, DFF, nb * 32, (bf16_t*)(wb + W_FF1), nb * 32, kb * 64, scr, c.lane); continue; } r -= I_F1;
        { const int kb = r / 32, nb = r % 32; transpose_item(p.in[I_WFF2] + (size_t)l * DFF * DM, DFF, DM, nb * 32, (bf16_t*)(wb + W_FF2), nb * 32, kb * 64, scr, c.lane); }
    }
}
__device__ __forceinline__ void p_kvctx(const Params& p, const Ctx& c, int l) {
    const int g = c.bx * 512 + c.tid, NG = c.G * 512;
    for (int i = g; i < NB_S * PAST * KVW / 4; i += NG) {
        const int e = i * 4, b = e / (PAST * KVW), r = e % (PAST * KVW);
        const size_t src = ((size_t)(b * 2 + l) * PAST) * KVW + r;
        const f32x4 k = *(const f32x4*)(p.in[I_CK] + src), v = *(const f32x4*)(p.in[I_CV] + src);
        u32x2 ko, vo; ko.x = pk2(k.x, k.y); ko.y = pk2(k.z, k.w); vo.x = pk2(v.x, v.y); vo.y = pk2(v.z, v.w);
        *(u32x2*)((bf16_t*)(p.ws + Z_KS) + (size_t)b * SKV_S * KVW + r) = ko;
        *(u32x2*)((bf16_t*)(p.ws + Z_VS) + (size_t)b * SKV_S * KVW + r) = vo;
    }
}
__device__ __forceinline__ const float* x_row(const Params& p, int l, int R) { return R < MP ? p.in[I_XP] + (size_t)R * DM : p.in[I_XS] + (size_t)(R - MP) * DM; }
__device__ __forceinline__ bf16_t* xn_ptr(const Params& p) { return (bf16_t*)p.out; }
__device__ __forceinline__ bf16_t* xb_row(const Params& p, int R) { return (bf16_t*)(p.ws + WS_XB) + (size_t)R * DM; }
__device__ __forceinline__ f32x4 unpk4(const u32x2 w) { return (f32x4){bflo(w.x), bfhi(w.x), bflo(w.y), bfhi(w.y)}; }
__device__ __forceinline__ u32x2 pk4(const f32x4 v) { u32x2 w; w.x = pk2(v.x, v.y); w.y = pk2(v.z, v.w); return w; }
__device__ __forceinline__ void slab_combine(const Params& p, const Ctx& c, int l, int part, const bf16_t* slab, int R, f32x4 (&v)[4]) {
    const float* gv = mod_ptr(p, l, row_ci(R), part);
#pragma unroll
    for (int j = 0; j < 4; ++j) { const bf16_t* s = slab + ((size_t)(((R >> 8) - 64) * 4 + j) * 4 * 256 + (R & 255)) * 256 + 4 * c.lane; f32x4 a = (f32x4){0.f, 0.f, 0.f, 0.f};
#pragma unroll
        for (int q = 0; q < 4; ++q) { const u32x2 w = *(const u32x2*)(s + (size_t)q * 65536); a.x += bflo(w.x); a.y += bfhi(w.x); a.z += bflo(w.y); a.w += bfhi(w.y); }
        v[j] = v[j] + *(const f32x4*)(gv + 4 * c.lane + 256 * j) * a; }
}
__device__ __forceinline__ void p_combine(const Params& p, const Ctx& c, int l, const bf16_t* slab) {
    const int gw = c.bx * 8 + c.wave, NGW = c.G * 8;
    for (int R = 16384 + gw; R < M; R += NGW) {
        bf16_t* xr = xb_row(p, R); f32x4 v[4];
#pragma unroll
        for (int j = 0; j < 4; ++j) v[j] = unpk4(*(const u32x2*)(xr + 4 * c.lane + 256 * j));
        slab_combine(p, c, l, 5, slab, R, v);
#pragma unroll
        for (int j = 0; j < 4; ++j) *(u32x2*)(xr + 4 * c.lane + 256 * j) = pk4(v[j]);
    }
}
__device__ __forceinline__ void p_norm(const Params& p, const Ctx& c, int l, int which, bool comb = false) {
    const int gw = c.bx * 8 + c.wave, NGW = c.G * 8;
    constexpr int NR = 2;
    int ci_cur = -1; f32x4 mA[4], mB[4];
    for (int Rb = gw * NR; Rb < M; Rb += NGW * NR) {
        f32x4 v[NR][4]; float s[NR];
#pragma unroll
        for (int rr = 0; rr < NR; ++rr) { const int R = Rb + rr;
            if ((which == 0 && l == 0) || (comb && which == 1 && l == 0 && R >= 16384)) {
                const float* xr = x_row(p, 0, R);
#pragma unroll
                for (int j = 0; j < 4; ++j) v[rr][j] = __builtin_nontemporal_load((const f32x4*)(xr + 4 * c.lane + 256 * j)); }
            else { const bf16_t* xr = xb_row(p, R);
#pragma unroll
                for (int j = 0; j < 4; ++j) v[rr][j] = unpk4(__builtin_nontemporal_load((const u32x2*)(xr + 4 * c.lane + 256 * j))); } }
        if (comb && Rb >= 16384) {
#pragma unroll
            for (int rr = 0; rr < NR; ++rr) { const int R = Rb + rr;
                if (which == 1) slab_combine(p, c, l, 2, (const bf16_t*)(p.ws + SLAB_P4), R, v[rr]); else slab_combine(p, c, l - 1, 5, (const bf16_t*)(p.ws + SLAB_P6), R, v[rr]);
#pragma unroll
                for (int j = 0; j < 4; ++j) *(u32x2*)(xb_row(p, R) + 4 * c.lane + 256 * j) = pk4(v[rr][j]); } }
#pragma unroll
        for (int rr = 0; rr < NR; ++rr) { s[rr] = 0.f;
#pragma unroll
            for (int j = 0; j < 4; ++j) s[rr] += (v[rr][j].x * v[rr][j].x + v[rr][j].y * v[rr][j].y) + (v[rr][j].z * v[rr][j].z + v[rr][j].w * v[rr][j].w); }
#pragma unroll
        for (int o = 1; o < 64; o <<= 1) {
#pragma unroll
            for (int rr = 0; rr < NR; ++rr) s[rr] += __shfl_xor(s[rr], o); }
        { const int ci = row_ci(Rb);
          if (ci != ci_cur) { const float* sh = mod_ptr(p, l, ci, which == 0 ? 0 : 3); const float* sc = mod_ptr(p, l, ci, which == 0 ? 1 : 4);
#pragma unroll
              for (int j = 0; j < 4; ++j) { mA[j] = *(const f32x4*)(sc + 4 * c.lane + 256 * j); mB[j] = *(const f32x4*)(sh + 4 * c.lane + 256 * j); }
              ci_cur = ci; } }
#pragma unroll
        for (int rr = 0; rr < NR; ++rr) { const int R = Rb + rr;
            const float rstd = rsqrtf(s[rr] * (1.f / DM) + EPS);
            bf16_t* orow = xn_ptr(p) + (size_t)R * DM;
#pragma unroll
            for (int j = 0; j < 4; ++j) { const int col = 4 * c.lane + 256 * j;
                f32x4 o = v[rr][j] * rstd * mA[j] + mB[j]; u32x2 w; w.x = pk2(o.x, o.y); w.y = pk2(o.z, o.w); *(u32x2*)(orow + col) = w; } }
    }
}
__device__ __forceinline__ void p_final_norm(const Params& p, const Ctx& c, bool comb) {
    const int gw = c.bx * 8 + c.wave, NGW = c.G * 8;
    constexpr int NR = 2;
    f32x4 gf[4];
#pragma unroll
    for (int j = 0; j < 4; ++j) gf[j] = *(const f32x4*)(p.in[I_GFIN] + 4 * c.lane + 256 * j);
    for (int Rb = gw * NR; Rb < M; Rb += NGW * NR) {
        f32x4 v[NR][4]; float s[NR];
#pragma unroll
        for (int rr = 0; rr < NR; ++rr) { const bf16_t* xr = xb_row(p, Rb + rr);
#pragma unroll
            for (int j = 0; j < 4; ++j) v[rr][j] = unpk4(__builtin_nontemporal_load((const u32x2*)(xr + 4 * c.lane + 256 * j))); }
        if (comb && Rb >= 16384) {
#pragma unroll
            for (int rr = 0; rr < NR; ++rr) slab_combine(p, c, 1, 5, (const bf16_t*)(p.ws + SLAB_P6), Rb + rr, v[rr]); }
#pragma unroll
        for (int rr = 0; rr < NR; ++rr) { s[rr] = 0.f;
#pragma unroll
            for (int j = 0; j < 4; ++j) s[rr] += (v[rr][j].x * v[rr][j].x + v[rr][j].y * v[rr][j].y) + (v[rr][j].z * v[rr][j].z + v[rr][j].w * v[rr][j].w); }
#pragma unroll
        for (int o = 1; o < 64; o <<= 1) {
#pragma unroll
            for (int rr = 0; rr < NR; ++rr) s[rr] += __shfl_xor(s[rr], o); }
#pragma unroll
        for (int rr = 0; rr < NR; ++rr) { float* xr = p.out + (size_t)(Rb + rr) * DM; const float rstd = rsqrtf(s[rr] * (1.f / DM) + EPS);
#pragma unroll
            for (int j = 0; j < 4; ++j) { const int col = 4 * c.lane + 256 * j; *(f32x4*)(xr + col) = v[rr][j] * rstd * gf[j]; } }
    }
}

struct Unit { int pm, pn, k0, nt; };
__host__ __device__ __forceinline__ int perm32(int rho) { const int n = rho >> 4, i = rho & 15; return 8 * (i >> 2) + 4 * n + (i & 3); }
#ifndef WGM_
#define WGM_ 8
#endif
struct StaticOrder {
    int nM, nN, nwg, G, c, ntf;
    __device__ void init(int Mr, int N, int G_, int c_, int K) { nM = Mr / 256; nN = N / 256; nwg = nM * nN; G = G_; c = c_; ntf = K / 64; }
    __device__ bool next(int i, Unit& u) const {
        const long L = (long)i * G + c; if (L >= nwg) return false;
        int wgid = (int)L; { const int q = nwg / 8, r = nwg % 8, xcd = wgid % 8, off = wgid / 8; wgid = (xcd < r ? xcd * (q + 1) : r * (q + 1) + (xcd - r) * q) + off; }
        const int nig = WGM_ * nN, gid = wgid / nig, fm = gid * WGM_, gsz = (nM - fm) < WGM_ ? (nM - fm) : WGM_;
        u.pm = fm + ((wgid % nig) % gsz); u.pn = (wgid % nig) / gsz; u.k0 = 0; u.nt = ntf; return true;
    }
    __device__ __forceinline__ void a_ready(const Unit&) const {}
    __device__ __forceinline__ void done(const Unit&) const {}
};
struct MergeOrder {
    int G, c;
    __device__ bool next(int i, Unit& u) const {
        const int t = i / 3, x = i % 3; long L = (long)t * G + c;
        if (G == 256 && t == 1) { if (c & 3) return false; L = 256 + (c >> 2); }
        if (L >= 320) return false;
        u.pm = x * 80 + (int)(L >> 2); u.pn = x * 4 + (int)(L & 3); u.k0 = 0; u.nt = RW / 64; return true;
    }
    __device__ __forceinline__ void a_ready(const Unit&) const {}
    __device__ __forceinline__ void done(const Unit&) const {}
};
#ifndef QSTAG
#define QSTAG 1
#endif
struct QuarterOrder {
    int G, c, ntf; bool quarter;
    __device__ void init(int G_, int c_, int K) { G = G_; c = (G_ % 8 == 0) ? (c_ % 8) * (G_ / 8) + c_ / 8 : c_; ntf = K / 64; quarter = (G_ == 256); }
    __device__ bool next(int i, Unit& u) const {
        if (quarter) { if (i > 1) return false;
            const bool full = QSTAG ? ((i == 0) != (((c >> 2) & 1) != 0)) : (i == 0);
            if (full) { u.pm = c >> 2; u.pn = c & 3; u.k0 = 0; u.nt = ntf; return true; }
            const int t = 256 + (c >> 2); u.pm = t >> 2; u.pn = t & 3; u.k0 = (c & 3) * (ntf >> 2); u.nt = ntf >> 2; return true; }
        const long L = (long)i * G + c; if (L >= 320) return false;
        u.pm = (int)(L >> 2); u.pn = (int)(L & 3); u.k0 = 0; u.nt = ntf; return true;
    }
    __device__ __forceinline__ void a_ready(const Unit&) const {}
    __device__ __forceinline__ void done(const Unit&) const {}
};
template <class Epi, class Sched>
__device__ __forceinline__ void gemm_simple(const Ctx& c, const bf16_t* A, const bf16_t* Bt, int K, const Sched& S, const Epi& E) {
    const int tid = c.tid, wid = c.wave, lane = tid & 63, wr = wid >> 2, wc = wid & 3, fr = lane & 15, fq = lane >> 4;
    Unit u; bool clear = true;
    f32x4 acc[2][2][4][2];
    for (int ui = 0; S.next(ui, u); ++ui) {
        if (clear) {
#pragma unroll
        for (int a = 0; a < 2; ++a)
#pragma unroll
            for (int b = 0; b < 2; ++b)
#pragma unroll
                for (int m = 0; m < 4; ++m)
#pragma unroll
                    for (int n = 0; n < 2; ++n) acc[a][b][m][n] = (f32x4){0.f, 0.f, 0.f, 0.f};
        }
        if constexpr (Epi::CHAIN) clear = !E.keep(u);
        const bf16_t* Ar = A + (size_t)(u.pm * 256 + wr * 64 + fr) * K + fq * 8;
        const bf16_t* Br[2];
#pragma unroll
        for (int n = 0; n < 2; ++n) Br[n] = Bt + (size_t)(u.pn * 256 + wc * 32 + (Epi::PERM ? perm32(16 * n + fr) : 16 * n + fr)) * K + fq * 8;
#pragma unroll 1
        for (int k0 = u.k0 * 64; k0 < (u.k0 + u.nt) * 64; k0 += 32) {
            bf16x8 tf[2][4], wf[2][2];
#pragma unroll
            for (int ai = 0; ai < 2; ++ai)
#pragma unroll
                for (int m = 0; m < 4; ++m) tf[ai][m] = *(const bf16x8*)(Ar + (size_t)(ai * 128 + m * 16) * K + k0);
#pragma unroll
            for (int bj = 0; bj < 2; ++bj)
#pragma unroll
                for (int n = 0; n < 2; ++n) wf[bj][n] = *(const bf16x8*)(Br[n] + (size_t)(bj * 128) * K + k0);
#pragma unroll
            for (int ai = 0; ai < 2; ++ai)
#pragma unroll
                for (int bj = 0; bj < 2; ++bj)
#pragma unroll
                    for (int m = 0; m < 4; ++m)
#pragma unroll
                        for (int n = 0; n < 2; ++n) acc[ai][bj][m][n] = __builtin_amdgcn_mfma_f32_16x16x32_bf16(wf[bj][n], tf[ai][m], acc[ai][bj][m][n], 0, 0, 0);
        }
        E(acc, u, wr, wc, fr, fq);
    }
}

namespace pg8 {
#define PG8_LAS __attribute__((address_space(3)))
constexpr int BM = 256, BK = 64, HALF = 128, HTB = HALF * BK * 2  , STAGE_BYTES = 8 * HTB, NXCD = 8, WGM = 8;

__host__ __device__ __forceinline__ int lds_byte(int r, int c) { const int st = (r >> 4) * 2 + (c >> 5), rr = r & 15, cc = c & 31, ob = rr * 64 + cc * 2; return st * 1024 + (ob ^ (((ob >> 9) & 1) << 5)); }
__host__ __device__ __forceinline__ void stage_rc(int b, int& R, int& C) { const int st = b / 1024, sb = b % 1024, swz = sb ^ (((sb >> 9) & 1) << 5); R = (st >> 1) * 16 + swz / 64; C = (st & 1) * 32 + (swz % 64) / 2; }
struct Gemm { const bf16_t* A; const bf16_t* Bt; int M, N, K; unsigned long long* ts; };
#define PG8_STAMP(k) do { if (g.ts && blockIdx.x == 0 && tid == 0) g.ts[k] = __builtin_amdgcn_s_memrealtime(); } while (0)
template <class Epi, class Sched, bool ALIGN_EPI = false, bool SP2 = false>
__device__ __forceinline__ void gemm_phase(int tid_in, PG8_LAS unsigned char* lds, const Gemm g, const Sched& S, const Epi& E) {
    const int tid = tid_in, wid = __builtin_amdgcn_readfirstlane(tid >> 6), lane = tid & 63, wr = wid >> 2, wc = wid & 3, fr = lane & 15, fq = lane >> 4;
    const int K = g.K;
    unsigned voffA[2], voffB[2];
#pragma unroll
    for (int i = 0; i < 2; ++i) { int R, C; stage_rc(tid * 16 + i * 8192, R, C); const int Rb = Epi::PERM ? ((R & ~31) + perm32(R & 31)) : R;
        voffA[i] = (unsigned)(R * K + C) * 2u; voffB[i] = (unsigned)(Rb * K + C) * 2u; }
    const size_t kstep = (size_t)(BK * 2);
    const size_t hstep = (size_t)HALF * K * 2;
    const size_t tstep = 2 * hstep;
    const unsigned ldsw = (unsigned)wid * 1024u;
    const int aoff = lds_byte(wr * 64 + fr, fq * 8), boff = lds_byte(wc * 32 + fr, fq * 8);
#define PG8_SA(b, h) (((b) * 2 + (h)) * HTB)
#define PG8_SB(b, h) ((4 + (b) * 2 + (h)) * HTB)
#define PG8_STAGE(bufoff, gbase, voff) do { _Pragma("unroll") for (int _i = 0; _i < 2; ++_i) \
        __builtin_amdgcn_global_load_lds((const unsigned*)((const char*)(gbase) + (voff)[_i]), (PG8_LAS unsigned*)(lds + (bufoff) + ldsw + _i * 8192), 16, 0, 0); } while (0)
#define PG8_LDA(dst, b, h) do { _Pragma("unroll") for (int m = 0; m < 4; ++m) _Pragma("unroll") for (int k = 0; k < 2; ++k) dst[m][k] = *(const PG8_LAS bf16x8*)(lds + PG8_SA(b, h) + aoff + m * 2048 + k * 1024); } while (0)
#define PG8_LDB(dst, b, h) do { _Pragma("unroll") for (int n = 0; n < 2; ++n) _Pragma("unroll") for (int k = 0; k < 2; ++k) dst[n][k] = *(const PG8_LAS bf16x8*)(lds + PG8_SB(b, h) + boff + n * 2048 + k * 1024); } while (0)
#define PG8_MMA(ai, bj, At, Bt) do { __builtin_amdgcn_s_setprio(1); _Pragma("unroll") for (int m = 0; m < 4; ++m) _Pragma("unroll") for (int n = 0; n < 2; ++n) _Pragma("unroll") for (int k = 0; k < 2; ++k) \
        acc[ai][bj][m][n] = __builtin_amdgcn_mfma_f32_16x16x32_bf16(Bt[n][k], At[m][k], acc[ai][bj][m][n], 0, 0, 0); __builtin_amdgcn_s_setprio(0); } while (0)
#define PG8_WAIT_V(n) asm volatile("s_waitcnt vmcnt(" #n ")" ::: "memory")
#define PG8_WAIT_L(n) asm volatile("s_waitcnt lgkmcnt(" #n ")" ::: "memory")
#define PG8_BAR __builtin_amdgcn_s_barrier()
#define PG8_SCHED __builtin_amdgcn_sched_barrier(0)
    Unit cur, nxt; int ui = 0;
    PG8_STAMP(42);
    if (!S.next(0, cur)) return;
    f32x4 acc[2][2][4][2];
#pragma unroll
    for (int a = 0; a < 2; ++a)
#pragma unroll
        for (int b = 0; b < 2; ++b)
#pragma unroll
            for (int m = 0; m < 4; ++m)
#pragma unroll
                for (int n = 0; n < 2; ++n) acc[a][b][m][n] = (f32x4){0.f, 0.f, 0.f, 0.f};
    bf16x8 At[4][2], B0[2][2], B1[2][2];
    const char* cA = (const char*)g.A + (size_t)cur.pm * tstep + (size_t)cur.k0 * kstep; const char* cB = (const char*)g.Bt + (size_t)cur.pn * tstep + (size_t)cur.k0 * kstep;
    S.a_ready(cur);
    if constexpr (SP2) {
        PG8_STAGE(PG8_SB(0, 0), cB, voffB); PG8_STAGE(PG8_SB(0, 1), cB + hstep, voffB); PG8_STAGE(PG8_SA(0, 0), cA, voffA); PG8_STAGE(PG8_SA(0, 1), cA + hstep, voffA);
        if (wr == 1) PG8_BAR;
        PG8_WAIT_V(2); PG8_BAR;
        PG8_STAGE(PG8_SB(1, 0), cB + kstep, voffB); PG8_STAGE(PG8_SA(1, 0), cA + kstep, voffA); PG8_STAGE(PG8_SB(1, 1), cB + hstep + kstep, voffB);
        PG8_WAIT_V(6); PG8_BAR;
    } else {
        PG8_STAGE(PG8_SB(0, 0), cB, voffB); PG8_STAGE(PG8_SA(0, 0), cA, voffA); PG8_STAGE(PG8_SB(0, 1), cB + hstep, voffB); PG8_STAGE(PG8_SA(0, 1), cA + hstep, voffA);
        if (wr == 1) PG8_BAR;
        PG8_WAIT_V(4); PG8_BAR;
        PG8_STAGE(PG8_SB(1, 0), cB + kstep, voffB); PG8_STAGE(PG8_SA(1, 0), cA + kstep, voffA); PG8_STAGE(PG8_SB(1, 1), cB + hstep + kstep, voffB);
        PG8_WAIT_V(6); PG8_BAR;
    }
    PG8_STAMP(43);
    for (;;) {
        const bool has_next = S.next(ui + 1, nxt);
        const char* nA = has_next ? (const char*)g.A + (size_t)nxt.pm * tstep + (size_t)nxt.k0 * kstep : cA; const char* nB = has_next ? (const char*)g.Bt + (size_t)nxt.pn * tstep + (size_t)nxt.k0 * kstep : cB;
        const int nt = cur.nt;
        for (int t = 0; t < nt; t += 2) {
            const bool last = (t == nt - 2);
            const char* a1 = cA + (size_t)(t + 1) * kstep;
            const char* a2 = last ? nA : cA + (size_t)(t + 2) * kstep; const char* b2 = last ? nB : cB + (size_t)(t + 2) * kstep;
            const char* a3 = a2 + kstep; const char* b3 = b2 + kstep;
            if (last && has_next) S.a_ready(nxt);
            if constexpr (SP2) {
            PG8_LDB(B0, 0, 0); PG8_LDB(B1, 0, 1); PG8_SCHED; PG8_LDA(At, 0, 0); PG8_STAGE(PG8_SA(1, 1), a1 + hstep, voffA);
            PG8_WAIT_V(8); PG8_WAIT_L(0); PG8_BAR; PG8_MMA(0, 0, At, B0); PG8_MMA(0, 1, At, B1); PG8_BAR; PG8_SCHED;
            PG8_LDA(At, 0, 1); PG8_STAGE(PG8_SB(0, 0), b2, voffB); PG8_STAGE(PG8_SB(0, 1), b2 + hstep, voffB); PG8_STAGE(PG8_SA(0, 0), a2, voffA);
            PG8_WAIT_V(8); PG8_WAIT_L(0); PG8_BAR; PG8_MMA(1, 0, At, B0); PG8_MMA(1, 1, At, B1); PG8_BAR; PG8_SCHED;
            PG8_LDB(B0, 1, 0); PG8_LDB(B1, 1, 1); PG8_SCHED; PG8_LDA(At, 1, 0); PG8_STAGE(PG8_SA(0, 1), a2 + hstep, voffA);
            PG8_WAIT_V(8); PG8_WAIT_L(0); PG8_BAR; PG8_MMA(0, 0, At, B0); PG8_MMA(0, 1, At, B1); PG8_BAR; PG8_SCHED;
            PG8_LDA(At, 1, 1); PG8_STAGE(PG8_SB(1, 0), b3, voffB); PG8_STAGE(PG8_SB(1, 1), b3 + hstep, voffB); PG8_STAGE(PG8_SA(1, 0), a3, voffA);
            PG8_WAIT_V(8); PG8_WAIT_L(0); PG8_BAR; PG8_MMA(1, 0, At, B0); PG8_MMA(1, 1, At, B1); PG8_BAR; PG8_SCHED;
            } else {
            PG8_LDB(B0, 0, 0); PG8_SCHED; PG8_LDA(At, 0, 0); PG8_STAGE(PG8_SA(1, 1), a1 + hstep, voffA);
            PG8_WAIT_L(8); PG8_BAR; PG8_WAIT_L(0); PG8_MMA(0, 0, At, B0); PG8_BAR; PG8_SCHED;
            PG8_LDB(B1, 0, 1); PG8_STAGE(PG8_SB(0, 0), b2, voffB);
            PG8_BAR; PG8_WAIT_L(0); PG8_MMA(0, 1, At, B1); PG8_BAR;
            PG8_LDA(At, 0, 1); PG8_STAGE(PG8_SA(0, 0), a2, voffA);
            PG8_BAR; PG8_WAIT_L(0); PG8_MMA(1, 0, At, B0); PG8_BAR; PG8_SCHED;
            PG8_STAGE(PG8_SB(0, 1), b2 + hstep, voffB);
            PG8_WAIT_V(6); PG8_BAR; PG8_MMA(1, 1, At, B1); PG8_BAR;
            PG8_LDB(B0, 1, 0); PG8_SCHED; PG8_LDA(At, 1, 0); PG8_STAGE(PG8_SA(0, 1), a2 + hstep, voffA);
            PG8_WAIT_L(8); PG8_BAR; PG8_WAIT_L(0); PG8_MMA(0, 0, At, B0); PG8_BAR; PG8_SCHED;
            PG8_LDB(B1, 1, 1); PG8_STAGE(PG8_SB(1, 0), b3, voffB);
            PG8_BAR; PG8_WAIT_L(0); PG8_MMA(0, 1, At, B1); PG8_BAR;
            PG8_LDA(At, 1, 1); PG8_STAGE(PG8_SA(1, 0), a3, voffA);
            PG8_BAR; PG8_WAIT_L(0); PG8_MMA(1, 0, At, B0); PG8_BAR; PG8_SCHED;
            PG8_STAGE(PG8_SB(1, 1), b3 + hstep, voffB);
            PG8_WAIT_V(6); PG8_BAR; PG8_MMA(1, 1, At, B1); PG8_BAR;
            }
        }
        if (ui == 0) PG8_STAMP(44);
        if constexpr (ALIGN_EPI) { if (wr == 0) PG8_BAR; }
        if constexpr (!Epi::AFTER_DRAIN) { E(acc, cur, wr, wc, fr, fq); S.done(cur); }
        if (ui == 0) PG8_STAMP(45);
        if (!has_next) break;
        bool clear = true; if constexpr (Epi::CHAIN) clear = !E.keep(cur);
        if (clear) {
#pragma unroll
        for (int a = 0; a < 2; ++a)
#pragma unroll
            for (int b = 0; b < 2; ++b)
#pragma unroll
                for (int m = 0; m < 4; ++m)
#pragma unroll
                    for (int n = 0; n < 2; ++n) acc[a][b][m][n] = (f32x4){0.f, 0.f, 0.f, 0.f};
        }
        cur = nxt; cA = nA; cB = nB; ++ui;
        if constexpr (ALIGN_EPI) { if (wr == 1) PG8_BAR; }
    }
    PG8_STAMP(46);
    PG8_WAIT_V(0);
    if constexpr (!ALIGN_EPI) { if (wr == 0) PG8_BAR; }
    PG8_BAR;
    if constexpr (Epi::AFTER_DRAIN) { E.fused(acc, cur, wr, wc, fr, fq, lds, wid, lane); S.done(cur); }
#undef PG8_SA
#undef PG8_SB
#undef PG8_STAGE
#undef PG8_LDA
#undef PG8_LDB
#undef PG8_MMA
#undef PG8_WAIT_V
#undef PG8_WAIT_L
#undef PG8_BAR
#undef PG8_SCHED
}
}

__device__ __forceinline__ u32x4 pack8(const f32x4& a, const f32x4& b) { u32x4 w; w.x = pk2(a.x, a.y); w.y = pk2(a.z, a.w); w.z = pk2(b.x, b.y); w.w = pk2(b.z, b.w); return w; }
__device__ __forceinline__ void rope4(f32x4& v, const f32x2 cs0, const f32x2 cs1) {
    const float a0 = v.x * cs0.x - v.y * cs0.y, a1 = v.x * cs0.y + v.y * cs0.x, a2 = v.z * cs1.x - v.w * cs1.y, a3 = v.z * cs1.y + v.w * cs1.x;
    v.x = a0; v.y = a1; v.z = a2; v.w = a3;
}
struct EpiMix {
    static constexpr bool PERM = true, AFTER_DRAIN = false, CHAIN = false;
    const Params* pp; int l; LAS const unsigned char* tabs;
    __device__ __forceinline__ void operator()(const f32x4 (&acc)[2][2][4][2], const Unit& u, int wr, int wc, int fr, int fq) const {
        const Params& p = *pp;
        const int pn = u.pn, R0 = u.pm * 256; const bool smp = R0 >= MP;
        const int b = smp ? (R0 - MP) >> 11 : R0 >> 8, t0 = smp ? (R0 - MP) & 2047 : 0;
        LAS const f32x2* cs_row = (LAS const f32x2*)tabs; LAS const f32x2* cs_col = cs_row + 32 * 16;
        if (pn >= 11) {
            bf16_t* dst = (bf16_t*)(p.ws + (pn < 13 ? Z_CU : Z_CV)) + ((pn - 11) & 1) * 256 + wc * 32 + 8 * fq;
#pragma unroll
            for (int ai = 0; ai < 2; ++ai)
#pragma unroll
                for (int m = 0; m < 4; ++m) { const int R = R0 + ai * 128 + wr * 64 + m * 16 + fr; float ss = 0.f;
#pragma unroll
                    for (int bj = 0; bj < 2; ++bj) { f32x4 v0 = acc[ai][bj][m][0], v1 = acc[ai][bj][m][1];
#pragma unroll
                        for (int r = 0; r < 4; ++r) { v0[r] = gelu_tanh(v0[r]); v1[r] = gelu_tanh(v1[r]); ss += v0[r] * v0[r] + v1[r] * v1[r]; }
                        *(u32x4*)(dst + (size_t)R * RW + bj * 128) = pack8(v0, v1); }
                    if (pn >= 13) { ss += __shfl_xor(ss, 16); ss += __shfl_xor(ss, 32);
                        if (fq == 0) ((float*)(p.ws + WS_SSQ))[(size_t)((pn - 13) * 4 + wc) * M + R] = ss; } }
            return;
        }
        const int kind = pn >> 1;
        const bool is_k = (pn == 10 && wc < 2), is_v = (pn == 10 && wc >= 2);
        LAS const float* gqk = (LAS const float*)(tabs + 96 * 16 * 8) + (kind == 4 ? 0 : HD) + 8 * fq;
        const int head = (pn & 1) * 4 + wc;
        const bool norm = (kind == 4 || is_k), rope = smp && (kind == 0 || kind == 1 || kind == 4 || is_k);
        const float post = kind == 1 ? 0.125f : (kind == 4 ? C2 : 1.0f);
#pragma unroll
        for (int ai = 0; ai < 2; ++ai)
#pragma unroll
            for (int m = 0; m < 4; ++m) {
                const int rr = ai * 128 + wr * 64 + m * 16 + fr, R = R0 + rr, t = t0 + rr;
                float rs = 1.0f;
                if (norm) {
                    float ss = 0.f;
#pragma unroll
                    for (int bj = 0; bj < 2; ++bj)
#pragma unroll
                        for (int n = 0; n < 2; ++n) { const f32x4 x = acc[ai][bj][m][n]; ss += (x.x * x.x + x.y * x.y) + (x.z * x.z + x.w * x.w); }
                    ss += __shfl_xor(ss, 16); ss += __shfl_xor(ss, 32);
                    rs = rsqrtf(ss * (1.f / HD) + EPS);
                }
                bf16_t* dst;
                if (kind < 5) dst = (bf16_t*)(p.ws + (kind == 0 ? Z_RQ : kind == 1 ? Z_RK : kind == 2 ? Z_RV : kind == 3 ? Z_RG : Z_AQ)) + (size_t)R * RW + head * HD + 8 * fq;
                else { const int hk = wc & 1;
                    if (smp) dst = (bf16_t*)(p.ws + (is_k ? Z_KS : Z_VS)) + ((size_t)b * SKV_S + PAST + t) * KVW + hk * HD + 8 * fq;
                    else dst = (bf16_t*)(p.ws + (is_k ? Z_KP : Z_VP)) + ((size_t)b * SEQ_P + t) * KVW + hk * HD + 8 * fq; }
                float* cdst = p.out + (is_k ? OUT_CK : OUT_CV) + ((size_t)((b * 2 + l) * SEQ_P + t) * 2 + (wc & 1)) * HD + 8 * fq;
#pragma unroll
                for (int bj = 0; bj < 2; ++bj) {
                    f32x4 v0 = acc[ai][bj][m][0], v1 = acc[ai][bj][m][1];
                    if (norm) { const f32x4 g0 = *(LAS const f32x4*)(gqk + 32 * bj), g1 = *(LAS const f32x4*)(gqk + 32 * bj + 4); v0 = v0 * rs * g0; v1 = v1 * rs * g1; }
                    if (pn == 10 && !smp) { *(f32x4*)(cdst + 32 * bj) = v0; *(f32x4*)(cdst + 32 * bj + 4) = v1; }
                    if (kind == 3) {
#pragma unroll
                        for (int r = 0; r < 4; ++r) { v0[r] = siluf_(v0[r]); v1[r] = siluf_(v1[r]); } }
                    if (rope) {
                        LAS const f32x2* tab = (bj == 0 ? cs_row + (t >> 6) * 16 : cs_col + (t & 63) * 16) + 4 * fq;
                        rope4(v0, tab[0], tab[1]); rope4(v1, tab[2], tab[3]); }
                    v0 = v0 * post; v1 = v1 * post;
                    *(u32x4*)(dst + 32 * bj) = pack8(v0, v1);
                    asm volatile("" ::: "memory");
                }
            }
    }
};
__device__ __forceinline__ size_t gate_off(int x, int pm, int pn, int ai, int m, int bj, int wid, int lane) {
    return ((((size_t)(x * 80 + pm) * 4 + pn) * 16 + (ai * 4 + m) * 2 + bj) * 512 + wid * 64 + lane) * 8; }
struct EpiGate {
    static constexpr bool PERM = true, AFTER_DRAIN = false, CHAIN = false;
    const Params* pp;
    __device__ __forceinline__ void operator()(const f32x4 (&acc)[2][2][4][2], const Unit& u, int wr, int wc, int fr, int fq) const {
        const int x = u.pn >> 2; bf16_t* dst = (bf16_t*)(pp->ws + Z_GATE); const int wid = wr * 4 + wc, lane = fq * 16 + fr;
#pragma unroll
        for (int ai = 0; ai < 2; ++ai)
#pragma unroll
            for (int m = 0; m < 4; ++m) {
#pragma unroll
                for (int bj = 0; bj < 2; ++bj) { f32x4 v0 = acc[ai][bj][m][0], v1 = acc[ai][bj][m][1];
#pragma unroll
                    for (int r = 0; r < 4; ++r) { v0[r] = sigmoidf_(fminf(fmaxf(v0[r], -30.f), 30.f)); v1[r] = sigmoidf_(fminf(fmaxf(v1[r], -30.f), 30.f)); }
                    *(u32x4*)(dst + gate_off(x, u.pm, u.pn & 3, ai, m, bj, wid, lane)) = pack8(v0, v1); } }
    }
};
struct EpiMerge {
    static constexpr bool PERM = true, AFTER_DRAIN = false, CHAIN = true;
    const Params* pp;
    __device__ __forceinline__ bool keep(const Unit& u) const { return (u.pn >> 2) != 2; }
    __device__ __forceinline__ void operator()(f32x4 (&acc)[2][2][4][2], const Unit& u, int wr, int wc, int fr, int fq) const {
        const int x = u.pn >> 2, pm = u.pm - 80 * x;
        const int col0 = (u.pn & 3) * 256 + wc * 32 + 8 * fq;
        const int gnum = x == 0 ? 1 : x == 1 ? 2 : 0, gden = x == 0 ? 2 : 0;
        const bf16_t* gbase = (const bf16_t*)(pp->ws + Z_GATE); const int wid = wr * 4 + wc, lane = fq * 16 + fr, pnc = u.pn & 3;
        bf16_t* dst = xn_ptr(*pp) + col0;
#pragma unroll
        for (int aim = 0; aim < 4; ++aim) { const int ai = aim >> 1, m0 = (aim & 1) * 2;
            u32x4 gnv[4][2], gdv[4][2];
#pragma unroll
            for (int m = m0; m < m0 + 2; ++m) { const int R = pm * 256 + ai * 128 + wr * 64 + m * 16 + fr;
#pragma unroll
                for (int bj = 0; bj < 2; ++bj) { gnv[m][bj] = *(const u32x4*)(gbase + gate_off(gnum, pm, pnc, ai, m, bj, wid, lane)); if (x != 2) gdv[m][bj] = *(const u32x4*)(gbase + gate_off(gden, pm, pnc, ai, m, bj, wid, lane)); } }
#pragma unroll
            for (int m = m0; m < m0 + 2; ++m) { const int R = pm * 256 + ai * 128 + wr * 64 + m * 16 + fr;
#pragma unroll
                for (int bj = 0; bj < 2; ++bj) {
                    const u32x4 g = gnv[m][bj];
                    f32x4 s0 = (f32x4){bflo(g.x), bfhi(g.x), bflo(g.y), bfhi(g.y)}, s1 = (f32x4){bflo(g.z), bfhi(g.z), bflo(g.w), bfhi(g.w)};
                    if (x != 2) { const u32x4 d = gdv[m][bj];
                        s0.x *= __builtin_amdgcn_rcpf(bflo(d.x)); s0.y *= __builtin_amdgcn_rcpf(bfhi(d.x)); s0.z *= __builtin_amdgcn_rcpf(bflo(d.y)); s0.w *= __builtin_amdgcn_rcpf(bfhi(d.y));
                        s1.x *= __builtin_amdgcn_rcpf(bflo(d.z)); s1.y *= __builtin_amdgcn_rcpf(bfhi(d.z)); s1.z *= __builtin_amdgcn_rcpf(bflo(d.w)); s1.w *= __builtin_amdgcn_rcpf(bfhi(d.w)); }
                    acc[ai][bj][m][0] = acc[ai][bj][m][0] * s0; acc[ai][bj][m][1] = acc[ai][bj][m][1] * s1;
                    if (x == 2) *(u32x4*)(dst + (size_t)R * DM + bj * 128) = pack8(acc[ai][bj][m][0], acc[ai][bj][m][1]); } }
            asm volatile("" ::: "memory");
        }
    }
};
#ifndef RES_NB
#define RES_NB 3
#endif
#ifndef RESB_NB
#define RESB_NB 4
#endif
struct EpiRes {
    static constexpr bool PERM = true, AFTER_DRAIN = false, CHAIN = false;
    const Params* pp; int l, part; bool from_inputs; int ntf; bf16_t* slab;
    __device__ __forceinline__ void operator()(f32x4 (&acc)[2][2][4][2], const Unit& u, int wr, int wc, int fr, int fq) const {
        const Params& p = *pp; const int R0 = u.pm * 256; const int ci = row_ci(R0);
        if (u.nt != ntf) {
            bf16_t* s = slab + ((size_t)((u.pm * 4 + u.pn - 256) * 4 + u.k0 / u.nt) * 256) * 256 + wc * 32 + 8 * fq;
#pragma unroll
            for (int ai = 0; ai < 2; ++ai)
#pragma unroll
                for (int m = 0; m < 4; ++m) { const int rr = ai * 128 + wr * 64 + m * 16 + fr;
#pragma unroll
                    for (int bj = 0; bj < 2; ++bj) *(u32x4*)(s + (size_t)rr * 256 + bj * 128) = pack8(acc[ai][bj][m][0], acc[ai][bj][m][1]); }
            return;
        }
        const int col = u.pn * 256 + wc * 32 + 8 * fq;
        {
            const float* gv = mod_ptr(p, l, ci, part) + col;
            f32x4 g[2][2];
#pragma unroll
            for (int bj = 0; bj < 2; ++bj)
#pragma unroll
                for (int n = 0; n < 2; ++n) g[bj][n] = *(const f32x4*)(gv + bj * 128 + n * 4);
#pragma unroll
            for (int ai = 0; ai < 2; ++ai)
#pragma unroll
                for (int m = 0; m < 4; ++m)
#pragma unroll
                    for (int bj = 0; bj < 2; ++bj)
#pragma unroll
                        for (int n = 0; n < 2; ++n) acc[ai][bj][m][n] = acc[ai][bj][m][n] * g[bj][n];
        }
        if (from_inputs) {
            constexpr int NB = RES_NB;
#pragma unroll
            for (int b0 = 0; b0 < 8; b0 += NB) {
                f32x4 xv[NB][2][2];
#pragma unroll
                for (int k = 0; k < NB; ++k) if (b0 + k < 8) { const int ai = (b0 + k) >> 2, m = (b0 + k) & 3; const int R = R0 + ai * 128 + wr * 64 + m * 16 + fr;
                    const float* xs = x_row(p, 0, R) + col;
#pragma unroll
                    for (int bj = 0; bj < 2; ++bj)
#pragma unroll
                        for (int n = 0; n < 2; ++n) xv[k][bj][n] = *(const f32x4*)(xs + bj * 128 + n * 4); }
#pragma unroll
                for (int k = 0; k < NB; ++k) if (b0 + k < 8) { const int ai = (b0 + k) >> 2, m = (b0 + k) & 3; const int R = R0 + ai * 128 + wr * 64 + m * 16 + fr;
                    bf16_t* xo = xb_row(p, R) + col;
#pragma unroll
                    for (int bj = 0; bj < 2; ++bj) *(u32x4*)(xo + bj * 128) = pack8(xv[k][bj][0] + acc[ai][bj][m][0], xv[k][bj][1] + acc[ai][bj][m][1]); }
                asm volatile("" ::: "memory");
            }
        } else {
            constexpr int NB = RESB_NB;
#pragma unroll
            for (int b0 = 0; b0 < 8; b0 += NB) {
                u32x4 xv[NB][2];
#pragma unroll
                for (int k = 0; k < NB; ++k) if (b0 + k < 8) { const int ai = (b0 + k) >> 2, m = (b0 + k) & 3; const int R = R0 + ai * 128 + wr * 64 + m * 16 + fr;
                    const bf16_t* xs = xb_row(p, R) + col;
#pragma unroll
                    for (int bj = 0; bj < 2; ++bj) xv[k][bj] = *(const u32x4*)(xs + bj * 128); }
#pragma unroll
                for (int k = 0; k < NB; ++k) if (b0 + k < 8) { const int ai = (b0 + k) >> 2, m = (b0 + k) & 3; const int R = R0 + ai * 128 + wr * 64 + m * 16 + fr;
                    bf16_t* xo = xb_row(p, R) + col;
#pragma unroll
                    for (int bj = 0; bj < 2; ++bj) { const u32x4 w = xv[k][bj];
                        const f32x4 x0 = (f32x4){bflo(w.x), bfhi(w.x), bflo(w.y), bfhi(w.y)}, x1 = (f32x4){bflo(w.z), bfhi(w.z), bflo(w.w), bfhi(w.w)};
                        *(u32x4*)(xo + bj * 128) = pack8(x0 + acc[ai][bj][m][0], x1 + acc[ai][bj][m][1]); } }
                asm volatile("" ::: "memory");
            }
        }
    }
};
struct EpiFF1 {
    static constexpr bool PERM = true, AFTER_DRAIN = false, CHAIN = false;
    const Params* pp;
    __device__ __forceinline__ void operator()(const f32x4 (&acc)[2][2][4][2], const Unit& u, int wr, int wc, int fr, int fq) const {
        bf16_t* dst = (bf16_t*)(pp->ws + Z_HB) + u.pn * 256 + wc * 32 + 8 * fq;
#pragma unroll
        for (int ai = 0; ai < 2; ++ai)
#pragma unroll
            for (int m = 0; m < 4; ++m) { const int R = u.pm * 256 + ai * 128 + wr * 64 + m * 16 + fr;
#pragma unroll
                for (int bj = 0; bj < 2; ++bj) { f32x4 v0 = acc[ai][bj][m][0], v1 = acc[ai][bj][m][1];
#pragma unroll
                    for (int r = 0; r < 4; ++r) { const float a = fmaxf(v0[r], 0.f), b = fmaxf(v1[r], 0.f); v0[r] = a * a; v1[r] = b * b; }
                    *(u32x4*)(dst + (size_t)R * DFF + bj * 128) = pack8(v0, v1); } }
    }
};

namespace attn_body {
using bf16=__hip_bfloat16;
using bf16x8=__attribute__((ext_vector_type(8)))short;
using s16x4=__attribute__((ext_vector_type(4)))short;
using f32x16=__attribute__((ext_vector_type(16)))float;
using u32x4=__attribute__((ext_vector_type(4)))unsigned;
constexpr int D=64,QP=512,KP=128;
constexpr int NW=8,QBLK=32,QB=QBLK*NW,KVBLK=64;
__device__ __forceinline__ int crow(int r,int hi){return (r&3)+8*(r>>2)+4*hi;}
#define SBAR() __builtin_amdgcn_sched_barrier(0)
constexpr int NSLOT=3, SLOTB=8192;
constexpr int LDS_K=0, LDS_V=NSLOT*SLOTB, LDS_WS=2*NSLOT*SLOTB, LDS_OST=LDS_WS+NW*64*4, LDS_BYTES=LDS_OST+NW*4096;
constexpr float C2=0.125f*1.4426950408889634f;
__device__ __forceinline__ void glds16(const void*gsrc,unsigned lds_dst){unsigned keep;
  asm volatile("s_mov_b32 %0, m0\n\ts_mov_b32 m0, %2\n\ts_nop 0\n\tglobal_load_lds_dwordx4 %1, off\n\ts_mov_b32 m0, %0":"=&s"(keep):"v"(gsrc),"s"(lds_dst):"memory");}
__device__ __forceinline__ float max3f(float a,float b,float c){float r;asm("v_max3_f32 %0, %1, %2, %3":"=v"(r):"v"(a),"v"(b),"v"(c));return r;}
__device__ __forceinline__ float max2f(float a,float b){float r;asm("v_max_f32_e32 %0, %1, %2":"=v"(r):"v"(a),"v"(b));return r;}
__device__ __forceinline__ float fadd_s(float a,float b){float r;asm("v_add_f32_e32 %0, %1, %2":"=v"(r):"v"(a),"v"(b));return r;}
__device__ __forceinline__ float fsub_s(float a,float b){float r;asm("v_sub_f32_e32 %0, %1, %2":"=v"(r):"v"(a),"v"(b));return r;}
typedef float f32x2_t __attribute__((ext_vector_type(2))); typedef __bf16 bf16x2_t __attribute__((ext_vector_type(2)));
__device__ __forceinline__ unsigned cvtpk_s(float lo,float hi){f32x2_t v={lo,hi};bf16x2_t b=__builtin_convertvector(v,bf16x2_t);return __builtin_bit_cast(unsigned,b);}
#define WAIT_BAR(N) asm volatile("s_waitcnt vmcnt(" #N ") lgkmcnt(0)\n\ts_barrier":::"memory")

__device__ __forceinline__ void qkt(f32x16&p0,f32x16&p1,const char*Kslot,const bf16x8*qr,const f32x16&negm,int r32,int hi){
  const char*kb=Kslot+hi*1024+r32*16;
  #pragma unroll
  for(int d0=0;d0<4;++d0){
    const bf16x8 b0=*reinterpret_cast<const bf16x8*>(kb+d0*2048);
    const bf16x8 b1=*reinterpret_cast<const bf16x8*>(kb+d0*2048+512);
    if(d0==0){p0=__builtin_amdgcn_mfma_f32_32x32x16_bf16(b0,qr[0],negm,0,0,0);p1=__builtin_amdgcn_mfma_f32_32x32x16_bf16(b1,qr[0],negm,0,0,0);}
    else{p0=__builtin_amdgcn_mfma_f32_32x32x16_bf16(b0,qr[d0],p0,0,0,0);p1=__builtin_amdgcn_mfma_f32_32x32x16_bf16(b1,qr[d0],p1,0,0,0);}}
}
typedef __attribute__((address_space(3))) const char* lds_cptr;
typedef short v4i16_t __attribute__((ext_vector_type(4)));
__device__ __forceinline__ void kload8(bf16x8*kf,lds_cptr kp){
  kf[0]=*(const __attribute__((address_space(3))) bf16x8*)(kp);      kf[1]=*(const __attribute__((address_space(3))) bf16x8*)(kp+512);
  kf[2]=*(const __attribute__((address_space(3))) bf16x8*)(kp+2048); kf[3]=*(const __attribute__((address_space(3))) bf16x8*)(kp+2560);
  kf[4]=*(const __attribute__((address_space(3))) bf16x8*)(kp+4096); kf[5]=*(const __attribute__((address_space(3))) bf16x8*)(kp+4608);
  kf[6]=*(const __attribute__((address_space(3))) bf16x8*)(kp+6144); kf[7]=*(const __attribute__((address_space(3))) bf16x8*)(kp+6656);
}
__device__ __forceinline__ void kload2(bf16x8*kf,lds_cptr kp,int j){ kf[2*j]=*(const __attribute__((address_space(3))) bf16x8*)(kp+j*2048); kf[2*j+1]=*(const __attribute__((address_space(3))) bf16x8*)(kp+j*2048+512); }
__device__ __forceinline__ s16x4 vtr(lds_cptr p){ return __builtin_bit_cast(s16x4,__builtin_amdgcn_ds_read_tr16_b64_v4i16((__attribute__((address_space(3))) v4i16_t*)p)); }
__device__ __forceinline__ float rowmax(const f32x16&p0,const f32x16&p1){
  float a=max3f(p0[0],p0[1],p1[0]),b=max3f(p0[2],p0[3],p1[1]);a=max3f(a,p1[2],p1[3]);
  #pragma unroll
  for(int r=4;r<16;r+=4){a=max3f(a,p0[r],p0[r+1]);b=max3f(b,p0[r+2],p0[r+3]);a=max3f(a,p1[r],p1[r+1]);b=max3f(b,p1[r+2],p1[r+3]);}
  const float m=max2f(a,b);
  auto rr=__builtin_amdgcn_permlane32_swap(__float_as_uint(m),__float_as_uint(m),false,false);
  return max2f(__uint_as_float(rr[0]),__uint_as_float(rr[1]));
}
__device__ __forceinline__ void pv(f32x16*o,int vb,bf16x8 pa0,bf16x8 pa1,bf16x8 pa2,bf16x8 pa3){
  #pragma unroll
  for(int d0=0;d0<2;++d0){s16x4 lo[4],hi[4];
    #pragma unroll
    for(int ks=0;ks<4;++ks){
      asm volatile("ds_read_b64_tr_b16 %0,%1 offset:%c2":"=&v"(lo[ks]):"v"(vb),"i"(d0*4096+ks*1024):"memory");
      asm volatile("ds_read_b64_tr_b16 %0,%1 offset:%c2":"=&v"(hi[ks]):"v"(vb),"i"(d0*4096+ks*1024+512):"memory");}
    asm volatile("s_waitcnt lgkmcnt(0)":::"memory");SBAR();
    #define PK(k) (bf16x8){lo[k][0],lo[k][1],lo[k][2],lo[k][3],hi[k][0],hi[k][1],hi[k][2],hi[k][3]}
    o[d0]=__builtin_amdgcn_mfma_f32_32x32x16_bf16(pa0,PK(0),o[d0],0,0,0);
    o[d0]=__builtin_amdgcn_mfma_f32_32x32x16_bf16(pa1,PK(1),o[d0],0,0,0);
    o[d0]=__builtin_amdgcn_mfma_f32_32x32x16_bf16(pa2,PK(2),o[d0],0,0,0);
    o[d0]=__builtin_amdgcn_mfma_f32_32x32x16_bf16(pa3,PK(3),o[d0],0,0,0);
    #undef PK
  }
}

#ifndef ATTN_STORE16
#define ATTN_STORE16(p,v) (*(u32x4*)(p)=(v))
#endif
template<int THRL> __device__ __forceinline__ void attn_unit(int tid,const bf16*Qu,const bf16*__restrict__ Kh,const bf16*__restrict__ Vh,bf16*Ou,const int NT,char*shm){
  const int lane=tid&63,r32=lane&31,hi=lane>>5; const int wid=__builtin_amdgcn_readfirstlane(tid>>6);
  const bf16*Qw=Qu+(long)(wid*QBLK)*QP;
  const unsigned lds0=(unsigned)(uintptr_t)shm;
  float*wsf=(float*)(shm+LDS_WS)+wid*64;
  const bf16*ksrc=Kh+(long)lane*KP+wid*8;
  const bf16*vsrc=Vh+(long)(16*(wid&3)+(lane>>2))*KP+(wid>>2)*32+(lane&3)*8;
  const unsigned kdst=lds0+LDS_K+wid*1024, vdst=lds0+LDS_V+wid*1024;
  #define DMA_K(t,slot) glds16(ksrc+(long)(t)*KVBLK*KP,(unsigned)__builtin_amdgcn_readfirstlane(kdst+(slot)))
  #define DMA_V(t,slot) glds16(vsrc+(long)(t)*KVBLK*KP,(unsigned)__builtin_amdgcn_readfirstlane(vdst+(slot)))
  const int vb0=(int)(lds0+LDS_V)+((lane>>4)&1)*32+(lane&3)*8+(4*hi+((lane&15)>>2))*64;
  const char*Kbase=shm+LDS_K; bf16x8 kf[8];
  const lds_cptr shm3=(lds_cptr)shm; const lds_cptr kp0=shm3+LDS_K+hi*1024+r32*16; const lds_cptr vp0=shm3+LDS_V+((lane>>4)&1)*32+(lane&3)*8+(4*hi+((lane&15)>>2))*64;
  DMA_K(0,0);DMA_V(0,0);DMA_K(1,SLOTB);
  bf16x8 qr[4];
  #pragma unroll
  for(int d0=0;d0<4;++d0)qr[d0]=*reinterpret_cast<const bf16x8*>(&Qw[(long)r32*QP+d0*16+hi*8]);
  float zf_=0.f;asm volatile("":"+v"(zf_));
  float mhat=zf_,l_reg=zf_;f32x16 o[2],negm;
  #pragma unroll
  for(int r=0;r<16;++r){o[0][r]=zf_;o[1][r]=zf_;negm[r]=zf_;}
  asm volatile("":"+v"(negm));
  #define CMASK(P0,P1,t) do{}while(0)
  bool resc=false;
  #define START(P0,P1) do{ const float rm=rowmax(P0,P1); resc=false; \
    { const float dl=rm; mhat=fadd_s(mhat,dl); \
      _Pragma("unroll") for(int r=0;r<16;++r){P0[r]=fsub_s(P0[r],dl);P1[r]=fsub_s(P1[r],dl);} \
      _Pragma("unroll") for(int r=0;r<16;++r)negm[r]=-mhat; asm volatile("":"+v"(negm)); } \
    _Pragma("unroll") for(int r=0;r<16;++r)P0[r]=__builtin_amdgcn_exp2f(P0[r]); }while(0)
  #define RESC() do{ if(resc){ asm volatile("s_waitcnt lgkmcnt(0)":::"memory"); \
      _Pragma("unroll") for(int d_=0;d_<2;++d_) _Pragma("unroll") for(int r=0;r<16;++r)o[d_][r]*=wsf[crow(r,hi)]; } }while(0)
  f32x16 pA0,pA1,pB0,pB1;
  int sl_prev=0,sl_cur=0,sl_next=SLOTB;
  #define ROT() do{sl_prev=sl_cur;sl_cur=sl_next;sl_next=(sl_next==(NSLOT-1)*SLOTB)?0:sl_next+SLOTB;}while(0)
  DMA_K(2,2*SLOTB);
  WAIT_BAR(3);
  qkt(pA0,pA1,Kbase,qr,negm,r32,hi);asm volatile("s_nop 15\n\ts_nop 7":"+v"(pA0),"+v"(pA1));CMASK(pA0,pA1,0);
  START(pA0,pA1);
  _Pragma("unroll") for(int r=0;r<16;++r)pA1[r]=__builtin_amdgcn_exp2f(pA1[r]);
  WAIT_BAR(0);
  DMA_K(3,0);DMA_V(1,SLOTB);
  ROT();
  kload8(kf,kp0+sl_cur);
  WAIT_BAR(2);
  s16x4 vlo[8],vhi[8]; u32x4 pw0,pw1,pw2,pw3;
  #define PKW(P,B) cvtpk_s(P[B],P[B+1])
  #define PAF(k) __builtin_bit_cast(bf16x8,pw##k)
  #define VFR(i) (bf16x8){vlo[i][0],vlo[i][1],vlo[i][2],vlo[i][3],vhi[i][0],vhi[i][1],vhi[i][2],vhi[i][3]}
  #define PIN(x) asm volatile("":"+v"(x))
  #define MX3(a,b,c) __builtin_fmaxf(__builtin_fmaxf((a),(b)),(c))
  #define GAPA(MF,A0,A1,A2,A3,W0,W1,PW) do{ MF; sacc+=A0; sacc+=A1; sacc+=A2; sacc+=A3; PIN(sacc); W0; W1; PIN(PW); SBAR(); }while(0)
  #define EX(v) __builtin_amdgcn_exp2f(v)
  #define GAPB(MF,X,B) do{ MF; X[B]=EX(X[B]); X[B+1]=EX(X[B+1]); X[B+2]=EX(X[B+2]); X[B+3]=EX(X[B+3]); PIN(X); SBAR(); }while(0)
  #define VRD(i) do{ vlo[i]=vtr(vp_+(((i)>>2)*4096+((i)&3)*1024)); vhi[i]=vtr(vp_+(((i)>>2)*4096+((i)&3)*1024+512)); }while(0)
  #define KRD(G,j) do{ if(G){ kload2(kf,kp0+sl_next,j); SBAR(); } }while(0)
  #define STEP(C0,C1,P0,P1,t,GK,GV,GL) do{ SBAR(); \
    const lds_cptr vp_=vp0+sl_prev; \
    VRD(0); SBAR(); float sacc=(P0[0]+P0[1]); \
    GAPA(C0=__builtin_amdgcn_mfma_f32_32x32x16_bf16(kf[0],qr[0],negm,0,0,0), P0[2],P0[3],P0[4],P0[5],     pw0[0]=PKW(P0,0), pw0[1]=PKW(P0,2), pw0); \
    VRD(4); SBAR(); GAPA(C1=__builtin_amdgcn_mfma_f32_32x32x16_bf16(kf[1],qr[0],negm,0,0,0), P0[6],P0[7],P0[8],P0[9],     pw0[2]=PKW(P0,4), pw0[3]=PKW(P0,6), pw0); \
    VRD(1); SBAR(); GAPA(C0=__builtin_amdgcn_mfma_f32_32x32x16_bf16(kf[2],qr[1],C0,0,0,0),   P0[10],P0[11],P0[12],P0[13], pw1[0]=PKW(P0,8), pw1[1]=PKW(P0,10), pw1); \
    VRD(5); SBAR(); GAPA(C1=__builtin_amdgcn_mfma_f32_32x32x16_bf16(kf[3],qr[1],C1,0,0,0),   P0[14],P0[15],P1[0],P1[1],   pw1[2]=PKW(P0,12),pw1[3]=PKW(P0,14), pw1); \
    VRD(2); SBAR(); GAPA(C0=__builtin_amdgcn_mfma_f32_32x32x16_bf16(kf[4],qr[2],C0,0,0,0),   P1[2],P1[3],P1[4],P1[5],     pw2[0]=PKW(P1,0), pw2[1]=PKW(P1,2), pw2); \
    VRD(6); SBAR(); GAPA(C1=__builtin_amdgcn_mfma_f32_32x32x16_bf16(kf[5],qr[2],C1,0,0,0),   P1[6],P1[7],P1[8],P1[9],     pw2[2]=PKW(P1,4), pw2[3]=PKW(P1,6), pw2); \
    VRD(3); SBAR(); GAPA(C0=__builtin_amdgcn_mfma_f32_32x32x16_bf16(kf[6],qr[3],C0,0,0,0),   P1[10],P1[11],P1[12],P1[13], pw3[0]=PKW(P1,8), pw3[1]=PKW(P1,10), pw3); \
    VRD(7); SBAR(); GAPA(C1=__builtin_amdgcn_mfma_f32_32x32x16_bf16(kf[7],qr[3],C1,0,0,0),   P1[14],P1[15],0.f,0.f,       pw3[2]=PKW(P1,12),pw3[3]=PKW(P1,14), pw3); \
    l_reg+=sacc; \
    if(GK){DMA_K((t)+3,sl_cur);} if(GV){DMA_V((t)+1,sl_next);} \
    CMASK(C0,C1,t); \
    { float a=MX3(C0[0],C0[1],C1[0]),b=MX3(C0[2],C0[3],C1[1]); a=MX3(a,C1[2],C1[3]); \
      _Pragma("unroll") for(int r=4;r<16;r+=4){a=MX3(a,C0[r],C0[r+1]);b=MX3(b,C0[r+2],C0[r+3]);a=MX3(a,C1[r],C1[r+1]);b=MX3(b,C1[r+2],C1[r+3]);} \
      float rm=__builtin_fmaxf(a,b); { auto rr=__builtin_amdgcn_permlane32_swap(__float_as_uint(rm),__float_as_uint(rm),false,false); rm=__builtin_fmaxf(__uint_as_float(rr[0]),__uint_as_float(rr[1])); } \
      resc=false; \
      if(__builtin_expect(__any(rm>(float)THRL),0)){ const float dl=__builtin_fmaxf(rm,0.f); mhat+=dl; \
        _Pragma("unroll") for(int r=0;r<16;++r){C0[r]-=dl;C1[r]-=dl;} \
        _Pragma("unroll") for(int r=0;r<16;++r)negm[r]=-mhat; asm volatile("":"+v"(negm)); \
        const float f=__builtin_amdgcn_exp2f(-dl); l_reg*=f; if(hi==0)wsf[r32]=f; resc=true; } } \
    SBAR(); \
    GAPB(o[0]=__builtin_amdgcn_mfma_f32_32x32x16_bf16(PAF(0),VFR(0),o[0],0,0,0), C0,0); \
    GAPB(o[1]=__builtin_amdgcn_mfma_f32_32x32x16_bf16(PAF(0),VFR(4),o[1],0,0,0), C0,4); \
    KRD(GL,0); GAPB(o[0]=__builtin_amdgcn_mfma_f32_32x32x16_bf16(PAF(1),VFR(1),o[0],0,0,0), C0,8); \
    KRD(GL,1); GAPB(o[1]=__builtin_amdgcn_mfma_f32_32x32x16_bf16(PAF(1),VFR(5),o[1],0,0,0), C0,12); \
    KRD(GL,2); GAPB(o[0]=__builtin_amdgcn_mfma_f32_32x32x16_bf16(PAF(2),VFR(2),o[0],0,0,0), C1,0); \
    KRD(GL,3); GAPB(o[1]=__builtin_amdgcn_mfma_f32_32x32x16_bf16(PAF(2),VFR(6),o[1],0,0,0), C1,4); \
    GAPB(o[0]=__builtin_amdgcn_mfma_f32_32x32x16_bf16(PAF(3),VFR(3),o[0],0,0,0), C1,8); \
    GAPB(o[1]=__builtin_amdgcn_mfma_f32_32x32x16_bf16(PAF(3),VFR(7),o[1],0,0,0), C1,12); \
    }while(0)
  int t=1;
  for(;t+5<NT;t+=2){
    STEP(pB0,pB1,pA0,pA1,t,true,true,true);     WAIT_BAR(2); RESC(); ROT();
    STEP(pA0,pA1,pB0,pB1,t+1,true,true,true);   WAIT_BAR(2); RESC(); ROT();
  }
  #define ENDW(tt) do{ if((tt)+3<NT){WAIT_BAR(2);} else if((tt)+2<NT){WAIT_BAR(1);} else {WAIT_BAR(0);} }while(0)
  for(;t+1<NT;t+=2){
    STEP(pB0,pB1,pA0,pA1,t,(t+3<NT),(t+1<NT),(t+1<NT));       ENDW(t);   RESC(); ROT();
    STEP(pA0,pA1,pB0,pB1,t+1,(t+4<NT),(t+2<NT),(t+2<NT));     ENDW(t+1); RESC(); ROT();
  }
  STEP(pB0,pB1,pA0,pA1,NT-1,false,false,false); RESC();
  { float sacc=pB0[0]+pB0[1]; _Pragma("unroll") for(int r=2;r<16;++r)sacc+=pB0[r]; _Pragma("unroll") for(int r=0;r<16;++r)sacc+=pB1[r]; l_reg+=sacc;
    pw0=(u32x4){PKW(pB0,0),PKW(pB0,2),PKW(pB0,4),PKW(pB0,6)};pw1=(u32x4){PKW(pB0,8),PKW(pB0,10),PKW(pB0,12),PKW(pB0,14)};pw2=(u32x4){PKW(pB1,0),PKW(pB1,2),PKW(pB1,4),PKW(pB1,6)};pw3=(u32x4){PKW(pB1,8),PKW(pB1,10),PKW(pB1,12),PKW(pB1,14)};
    SBAR(); pv(o,vb0+sl_cur,PAF(0),PAF(1),PAF(2),PAF(3)); }
  #undef PKW
  #undef PAF
  #undef VFR
  #undef PIN
  #undef MX3
  #undef GAPA
  #undef GAPB
  #undef EX
  #undef VRD
  #undef KRD
  #undef STEP
  #undef ENDW
  {auto rr=__builtin_amdgcn_permlane32_swap(__float_as_uint(l_reg),__float_as_uint(l_reg),false,false);l_reg=__uint_as_float(rr[0])+__uint_as_float(rr[1]);}
  if(hi==0)wsf[32+r32]=l_reg;asm volatile("s_waitcnt lgkmcnt(0)":::"memory");
  float rli[16];
  #pragma unroll
  for(int r=0;r<16;++r)rli[r]=__builtin_amdgcn_rcpf(wsf[32+crow(r,hi)]);
  bf16*Ow=Ou+(long)(wid*QBLK)*QP;
  { bf16*stg=(bf16*)(shm+LDS_OST)+wid*2048;
    #pragma unroll
    for(int r=0;r<16;++r){const int orow=crow(r,hi);
      #pragma unroll
      for(int d0=0;d0<2;++d0)stg[orow*64+d0*32+r32]=__float2bfloat16(o[d0][r]*rli[r]);}
    asm volatile("s_waitcnt lgkmcnt(0)":::"memory");
    #pragma unroll
    for(int i=0;i<4;++i){const int row=i*8+(lane>>3),ch=lane&7; const u32x4 v=*(const u32x4*)(stg+row*64+ch*8); ATTN_STORE16(Ow+(long)row*QP+ch*8,v);} }
  asm volatile("s_waitcnt lgkmcnt(0)\n\ts_barrier":::"memory");
  #undef DMA_K
  #undef DMA_V
  #undef CMASK
  #undef START
  #undef RESC
  #undef ROT
}
constexpr int ATTN_LDS_BYTES=LDS_BYTES;
#undef SBAR
#undef WAIT_BAR
}
#ifndef ATTN_FAST
#define ATTN_FAST 1
#endif
__device__ __forceinline__ void attn_fast(const Params& p, const Ctx& c) {
    typedef attn_body::bf16 abf;
    const int vcu = (c.G % 8 == 0) ? (c.bx % 8) * (c.G / 8) + c.bx / 8 : c.bx;
    for (int k = 0; ; ++k) {
        int u;
        if (c.G != 256) { u = vcu + k * c.G; if (u >= 512 + 128) break; }
        else if (k < 2) u = vcu + 256 * k;
        else if (k == 2 && !((c.bx >> 3) & 1)) u = 512 + (c.bx & 7) * 16 + (c.bx >> 4);
        else break;
        const abf *Qu, *Kh, *Vh; int NT;
        if (u < 512) { const int qb = u & 7, hq = (u >> 3) & 3, hk = (u >> 5) & 1, b = u >> 6, h = hk * 4 + hq;
            Qu = (const abf*)(p.ws + Z_AQ) + ((size_t)MP + (size_t)b * SEQ_S + qb * 256) * RW + h * HD;
            Kh = (const abf*)(p.ws + Z_KS) + (size_t)b * SKV_S * KVW + hk * HD; Vh = (const abf*)(p.ws + Z_VS) + (size_t)b * SKV_S * KVW + hk * HD; NT = SKV_S / 64; }
        else { const int v = u - 512, hq = v & 3, hk = (v >> 2) & 1, b = v >> 3, h = hk * 4 + hq;
            Qu = (const abf*)(p.ws + Z_AQ) + ((size_t)b * SEQ_P) * RW + h * HD;
            Kh = (const abf*)(p.ws + Z_KP) + (size_t)b * SEQ_P * KVW + hk * HD; Vh = (const abf*)(p.ws + Z_VP) + (size_t)b * SEQ_P * KVW + hk * HD; NT = SKV_P / 64; }
        attn_body::attn_unit<8>(c.tid, Qu, Kh, Vh, (abf*)Qu, NT, (char*)c.lds);
    }
    __syncthreads();
}

__device__ __forceinline__ void attn_simple(const Params& p, const Ctx& c) {
    LAS float* Kt = (LAS float*)c.lds; LAS float* Vt = Kt + 32 * 64; LAS float* Sc = Vt + 32 * 64;
    constexpr int NU_S = NB_S * NH * 4, NU_P = NB_P * NH;
    for (int u = c.bx; u < NU_S + NU_P; u += c.G) {
        const bool smp = u < NU_S; int b, h, q0, nq, skv; const bf16_t *Kb, *Vb; size_t rowbase;
        if (smp) { b = u / 32; h = (u / 4) & 7; q0 = (u & 3) * 512; nq = 512; skv = SKV_S; Kb = (const bf16_t*)(p.ws + Z_KS) + (size_t)b * SKV_S * KVW; Vb = (const bf16_t*)(p.ws + Z_VS) + (size_t)b * SKV_S * KVW; rowbase = MP + (size_t)b * SEQ_S + q0; }
        else { const int v = u - NU_S; b = v / 8; h = v & 7; q0 = 0; nq = 256; skv = SKV_P; Kb = (const bf16_t*)(p.ws + Z_KP) + (size_t)b * SEQ_P * KVW; Vb = (const bf16_t*)(p.ws + Z_VP) + (size_t)b * SEQ_P * KVW; rowbase = (size_t)b * SEQ_P; }
        const int hk = h >> 2; const bool act = c.tid < nq;
        bf16_t* qrow = (bf16_t*)(p.ws + Z_AQ) + (rowbase + (act ? c.tid : 0)) * RW + h * HD;
        float q[64], o[64]; float mx = -1e30f, lsum = 0.f;
#pragma unroll
        for (int i = 0; i < 8; ++i) { const u32x4 w = *(const u32x4*)(qrow + 8 * i); q[8 * i] = bflo(w.x); q[8 * i + 1] = bfhi(w.x); q[8 * i + 2] = bflo(w.y); q[8 * i + 3] = bfhi(w.y); q[8 * i + 4] = bflo(w.z); q[8 * i + 5] = bfhi(w.z); q[8 * i + 6] = bflo(w.w); q[8 * i + 7] = bfhi(w.w); }
#pragma unroll
        for (int i = 0; i < 64; ++i) o[i] = 0.f;
        for (int k0 = 0; k0 < skv; k0 += 32) {
            __syncthreads();
            { const int e = c.tid * 4, j = e >> 6, d = e & 63;
                const u32x2 kw = *(const u32x2*)(Kb + (size_t)(k0 + j) * KVW + hk * HD + d), vw = *(const u32x2*)(Vb + (size_t)(k0 + j) * KVW + hk * HD + d);
                *(LAS f32x4*)(Kt + e) = (f32x4){bflo(kw.x), bfhi(kw.x), bflo(kw.y), bfhi(kw.y)}; *(LAS f32x4*)(Vt + e) = (f32x4){bflo(vw.x), bfhi(vw.x), bflo(vw.y), bfhi(vw.y)}; }
            __syncthreads();
            float tm = mx;
#pragma unroll 1
            for (int j = 0; j < 32; ++j) { float a = 0.f;
#pragma unroll
                for (int d4 = 0; d4 < 16; ++d4) { const f32x4 kv = *(const LAS f32x4*)(Kt + j * 64 + 4 * d4); a += q[4 * d4] * kv.x + q[4 * d4 + 1] * kv.y + q[4 * d4 + 2] * kv.z + q[4 * d4 + 3] * kv.w; }
                Sc[j * 512 + c.tid] = a; tm = fmaxf(tm, a); }
            const float corr = exp2f(mx - tm); mx = tm; lsum *= corr;
#pragma unroll
            for (int i = 0; i < 64; ++i) o[i] *= corr;
#pragma unroll 1
            for (int j = 0; j < 32; ++j) { const float pj = exp2f(Sc[j * 512 + c.tid] - mx); lsum += pj;
#pragma unroll
                for (int d4 = 0; d4 < 16; ++d4) { const f32x4 vv = *(const LAS f32x4*)(Vt + j * 64 + 4 * d4); o[4 * d4] += pj * vv.x; o[4 * d4 + 1] += pj * vv.y; o[4 * d4 + 2] += pj * vv.z; o[4 * d4 + 3] += pj * vv.w; } }
        }
        if (act) { const float il = 1.f / lsum;
#pragma unroll
            for (int i = 0; i < 8; ++i) { u32x4 w; w.x = pk2(o[8 * i] * il, o[8 * i + 1] * il); w.y = pk2(o[8 * i + 2] * il, o[8 * i + 3] * il); w.z = pk2(o[8 * i + 4] * il, o[8 * i + 5] * il); w.w = pk2(o[8 * i + 6] * il, o[8 * i + 7] * il); *(u32x4*)(qrow + 8 * i) = w; } }
    }
    __syncthreads();
}
__device__ __forceinline__ void cmlp_simple(const Params& p, const Ctx& c, int l) {
    LAS float* Vt = (LAS float*)c.lds;
    LAS float* rs = Vt + 128 * 128;
    const bf16_t* cv = (const bf16_t*)(p.ws + Z_CV); bf16_t* cu = (bf16_t*)(p.ws + Z_CU);
    for (int u = c.bx; u < NCHUNK * 4; u += c.G) {
        const int ch = u >> 2, g = u & 3; const size_t R0 = (size_t)ch * 128;
        __syncthreads();
        { const int q = c.tid >> 2, part = c.tid & 3; float ss = 0.f;
            const bf16_t* r = cv + (R0 + q) * RW + part * 128;
#pragma unroll
            for (int i = 0; i < 16; ++i) { const u32x4 w = *(const u32x4*)(r + 8 * i); const float a0 = bflo(w.x), a1 = bfhi(w.x), a2 = bflo(w.y), a3 = bfhi(w.y), a4 = bflo(w.z), a5 = bfhi(w.z), a6 = bflo(w.w), a7 = bfhi(w.w);
                ss += (a0 * a0 + a1 * a1) + (a2 * a2 + a3 * a3) + (a4 * a4 + a5 * a5) + (a6 * a6 + a7 * a7); }
            ss += __shfl_xor(ss, 1); ss += __shfl_xor(ss, 2);
            if (part == 0) rs[q] = rsqrtf(ss * (1.f / RW) + EPS); }
        __syncthreads();
        for (int e = c.tid; e < 128 * 128 / 8; e += 512) { const int q = e >> 4, c8 = (e & 15) * 8; const float r = rs[q];
            const u32x4 w = *(const u32x4*)(cv + (R0 + q) * RW + g * 128 + c8);
            *(LAS f32x4*)(Vt + q * 128 + c8) = (f32x4){bflo(w.x) * r, bfhi(w.x) * r, bflo(w.y) * r, bfhi(w.y) * r};
            *(LAS f32x4*)(Vt + q * 128 + c8 + 4) = (f32x4){bflo(w.z) * r, bfhi(w.z) * r, bflo(w.w) * r, bfhi(w.w) * r}; }
        __syncthreads();
        const int cc = c.tid & 127, pg = __builtin_amdgcn_readfirstlane(c.tid >> 7);
        const float* Ws = p.in[I_CMWS] + ((size_t)(l * 4 + g) * 128) * 128; const float* bs = p.in[I_CMBS] + (l * 4 + g) * 128;
        const float gn = p.in[I_CMNORM][l * RW + g * 128 + cc];
        for (int pi = 0; pi < 32; ++pi) { const int pr = pg * 32 + pi; const float* wrow = Ws + pr * 128; float a = 0.f;
#pragma unroll 8
            for (int q = 0; q < 128; ++q) a += wrow[q] * Vt[q * 128 + cc];
            bf16_t* up = cu + (R0 + pr) * RW + g * 128 + cc;
            const float uu = bf2f(*up);
            *up = (bf16_t)f2bf(uu * (gn * a + bs[pr])); }
    }
    __syncthreads();
}
__device__ __forceinline__ float ret_ld(const Params& p, int l, int dir, int h) { const float x = p.in[I_DECAY][(l * 2 + dir) * NH + h]; return -log1pf(__expf(x)); }
__device__ __forceinline__ void retU_simple(const Params& p, const Ctx& c, int l) {
    LAS float* Kt = (LAS float*)c.lds; LAS float* Vt = Kt + 128 * 64; LAS float* wf = Vt + 128 * 64; LAS float* wb = wf + 128;
    bf16_t* U = (bf16_t*)(p.ws + Z_U);
    for (int u = c.bx; u < NCHUNK * NH; u += c.G) {
        const int ch = u >> 3, h = u & 7; const size_t R0 = (size_t)ch * 128;
        const float ldf = ret_ld(p, l, 0, h), ldb = ret_ld(p, l, 1, h);
        __syncthreads();
        if (c.tid < 128) { wf[c.tid] = __expf(ldf * (float)(127 - c.tid)); wb[c.tid] = __expf(ldb * (float)c.tid); }
        for (int e = c.tid; e < 128 * 64 / 8; e += 512) { const int j = e >> 3, d8 = (e & 7) * 8;
            const u32x4 kw = *(const u32x4*)((const bf16_t*)(p.ws + Z_RK) + (R0 + j) * RW + h * HD + d8), vw = *(const u32x4*)((const bf16_t*)(p.ws + Z_RV) + (R0 + j) * RW + h * HD + d8);
            *(LAS f32x4*)(Kt + j * 64 + d8) = (f32x4){bflo(kw.x), bfhi(kw.x), bflo(kw.y), bfhi(kw.y)}; *(LAS f32x4*)(Kt + j * 64 + d8 + 4) = (f32x4){bflo(kw.z), bfhi(kw.z), bflo(kw.w), bfhi(kw.w)};
            *(LAS f32x4*)(Vt + j * 64 + d8) = (f32x4){bflo(vw.x), bfhi(vw.x), bflo(vw.y), bfhi(vw.y)}; *(LAS f32x4*)(Vt + j * 64 + d8 + 4) = (f32x4){bflo(vw.z), bfhi(vw.z), bflo(vw.w), bfhi(vw.w)}; }
        __syncthreads();
        const int e = c.tid & 63, d0 = __builtin_amdgcn_readfirstlane(c.tid >> 6) * 8;
        float uf[8], ub[8];
#pragma unroll
        for (int i = 0; i < 8; ++i) { uf[i] = 0.f; ub[i] = 0.f; }
        for (int j = 0; j < 128; ++j) { const float v = Vt[j * 64 + e], vf = v * wf[j], vb = v * wb[j];
            const f32x4 k0 = *(const LAS f32x4*)(Kt + j * 64 + d0), k1 = *(const LAS f32x4*)(Kt + j * 64 + d0 + 4);
            uf[0] += k0.x * vf; uf[1] += k0.y * vf; uf[2] += k0.z * vf; uf[3] += k0.w * vf; uf[4] += k1.x * vf; uf[5] += k1.y * vf; uf[6] += k1.z * vf; uf[7] += k1.w * vf;
            ub[0] += k0.x * vb; ub[1] += k0.y * vb; ub[2] += k0.z * vb; ub[3] += k0.w * vb; ub[4] += k1.x * vb; ub[5] += k1.y * vb; ub[6] += k1.z * vb; ub[7] += k1.w * vb; }
        bf16_t* Uf = U + ((size_t)(0 * NCHUNK + ch) * NH + h) * 4096, *Ub = U + ((size_t)(1 * NCHUNK + ch) * NH + h) * 4096;
#pragma unroll
        for (int i = 0; i < 8; ++i) { Uf[(d0 + i) * 64 + e] = (bf16_t)pk2(uf[i], 0.f); Ub[(d0 + i) * 64 + e] = (bf16_t)pk2(ub[i], 0.f); }
    }
    __syncthreads();
}
__device__ __forceinline__ void retO_simple(const Params& p, const Ctx& c, int l) {
    LAS float* Kt = (LAS float*)c.lds; LAS float* Vt = Kt + 128 * 64; LAS float* Sf = Vt + 128 * 64; LAS float* Sb = Sf + 4096; LAS float* pf = Sb + 4096; LAS float* pb = pf + 132;
    const bf16_t* U = (const bf16_t*)(p.ws + Z_U);
    for (int u = c.bx; u < NCHUNK * NH; u += c.G) {
        const int ch = u >> 3, h = u & 7; const size_t R0 = (size_t)ch * 128; const bool smp = ch >= MP / 128;
        const int nc = smp ? 16 : 2, ch0 = smp ? (MP / 128 + ((ch - MP / 128) & ~15)) : (ch & ~1), cidx = ch - ch0, b = smp ? (ch - MP / 128) >> 4 : ch >> 1;
        const float ldf = ret_ld(p, l, 0, h), ldb = ret_ld(p, l, 1, h); const float Gf = __expf(128.f * ldf), Gb = __expf(128.f * ldb);
        __syncthreads();
        if (c.tid <= 128) { pf[c.tid] = __expf(ldf * (float)c.tid); pb[c.tid] = __expf(ldb * (float)c.tid); }
        for (int e = c.tid; e < 128 * 64 / 8; e += 512) { const int j = e >> 3, d8 = (e & 7) * 8;
            const u32x4 kw = *(const u32x4*)((const bf16_t*)(p.ws + Z_RK) + (R0 + j) * RW + h * HD + d8), vw = *(const u32x4*)((const bf16_t*)(p.ws + Z_RV) + (R0 + j) * RW + h * HD + d8);
            *(LAS f32x4*)(Kt + j * 64 + d8) = (f32x4){bflo(kw.x), bfhi(kw.x), bflo(kw.y), bfhi(kw.y)}; *(LAS f32x4*)(Kt + j * 64 + d8 + 4) = (f32x4){bflo(kw.z), bfhi(kw.z), bflo(kw.w), bfhi(kw.w)};
            *(LAS f32x4*)(Vt + j * 64 + d8) = (f32x4){bflo(vw.x), bfhi(vw.x), bflo(vw.y), bfhi(vw.y)}; *(LAS f32x4*)(Vt + j * 64 + d8 + 4) = (f32x4){bflo(vw.z), bfhi(vw.z), bflo(vw.w), bfhi(vw.w)}; }
        {
            const int e0 = c.tid * 8; const bf16_t* sfp = U + ((size_t)(0 * NCHUNK + ch) * NH + h) * 4096 + e0; const bf16_t* sbp = U + ((size_t)(1 * NCHUNK + ch) * NH + h) * 4096 + e0;
#pragma unroll
            for (int i = 0; i < 8; ++i) { Sf[e0 + i] = bf2f(sfp[i]); Sb[e0 + i] = bf2f(sbp[i]); }
        }
        __syncthreads();
        const int i = c.tid >> 2, part = c.tid & 3;
        float qp[16], o[16];
        { const bf16_t* qr = (const bf16_t*)(p.ws + Z_RQ) + (R0 + i) * RW + h * HD + part * 16; const u32x4 w0 = *(const u32x4*)qr, w1 = *(const u32x4*)(qr + 8);
            qp[0] = bflo(w0.x); qp[1] = bfhi(w0.x); qp[2] = bflo(w0.y); qp[3] = bfhi(w0.y); qp[4] = bflo(w0.z); qp[5] = bfhi(w0.z); qp[6] = bflo(w0.w); qp[7] = bfhi(w0.w);
            qp[8] = bflo(w1.x); qp[9] = bfhi(w1.x); qp[10] = bflo(w1.y); qp[11] = bfhi(w1.y); qp[12] = bflo(w1.z); qp[13] = bfhi(w1.z); qp[14] = bflo(w1.w); qp[15] = bfhi(w1.w); }
#pragma unroll
        for (int e = 0; e < 16; ++e) o[e] = 0.f;
#pragma unroll 1
        for (int j = 0; j < 128; ++j) { float s = 0.f;
#pragma unroll
            for (int d4 = 0; d4 < 4; ++d4) { const f32x4 kv = *(const LAS f32x4*)(Kt + j * 64 + part * 16 + 4 * d4); s += qp[4 * d4] * kv.x + qp[4 * d4 + 1] * kv.y + qp[4 * d4 + 2] * kv.z + qp[4 * d4 + 3] * kv.w; }
            s += __shfl_xor(s, 1); s += __shfl_xor(s, 2);
            const float w = j < i ? pf[i - j] : (j > i ? pb[j - i] : 2.0f);
            s *= w;
#pragma unroll
            for (int e4 = 0; e4 < 4; ++e4) { const f32x4 vv = *(const LAS f32x4*)(Vt + j * 64 + part * 16 + 4 * e4); o[4 * e4] += s * vv.x; o[4 * e4 + 1] += s * vv.y; o[4 * e4 + 2] += s * vv.z; o[4 * e4 + 3] += s * vv.w; } }
        { const float xf = pf[i + 1], xb = pb[128 - i]; const bf16_t* qfull = (const bf16_t*)(p.ws + Z_RQ) + (R0 + i) * RW + h * HD;
#pragma unroll 2
            for (int d = 0; d < 64; ++d) { const float qd = bf2f(qfull[d]); const float af = qd * xf, ab = qd * xb;
#pragma unroll
                for (int e4 = 0; e4 < 4; ++e4) { const f32x4 a = *(const LAS f32x4*)(Sf + d * 64 + part * 16 + 4 * e4), bb = *(const LAS f32x4*)(Sb + d * 64 + part * 16 + 4 * e4);
                    o[4 * e4] += af * a.x + ab * bb.x; o[4 * e4 + 1] += af * a.y + ab * bb.y; o[4 * e4 + 2] += af * a.z + ab * bb.z; o[4 * e4 + 3] += af * a.w + ab * bb.w; } } }
        float s1 = 0.f;
#pragma unroll
        for (int e = 0; e < 16; ++e) s1 += o[e];
        s1 += __shfl_xor(s1, 1); s1 += __shfl_xor(s1, 2); const float mu = s1 * (1.f / 64.f);
        float s2 = 0.f;
#pragma unroll
        for (int e = 0; e < 16; ++e) { const float d = o[e] - mu; s2 += d * d; }
        s2 += __shfl_xor(s2, 1); s2 += __shfl_xor(s2, 2); const float rstd = rsqrtf(s2 * (1.f / 64.f) + EPS);
        const float* gn = p.in[I_RETGN] + l * RW + h * HD + part * 16;
        const bf16_t* rg = (const bf16_t*)(p.ws + Z_RG) + (R0 + i) * RW + h * HD + part * 16; const u32x4 g0 = *(const u32x4*)rg, g1 = *(const u32x4*)(rg + 8);
        float gs[16] = {bflo(g0.x), bfhi(g0.x), bflo(g0.y), bfhi(g0.y), bflo(g0.z), bfhi(g0.z), bflo(g0.w), bfhi(g0.w), bflo(g1.x), bfhi(g1.x), bflo(g1.y), bfhi(g1.y), bflo(g1.z), bfhi(g1.z), bflo(g1.w), bfhi(g1.w)};
        float y[16];
#pragma unroll
        for (int e = 0; e < 16; ++e) y[e] = (o[e] - mu) * rstd * gn[e] * gs[e];
        bf16_t* dst = (bf16_t*)(p.ws + Z_CV) + (R0 + i) * RW + h * HD + part * 16;
        u32x4 w0, w1; w0.x = pk2(y[0], y[1]); w0.y = pk2(y[2], y[3]); w0.z = pk2(y[4], y[5]); w0.w = pk2(y[6], y[7]); w1.x = pk2(y[8], y[9]); w1.y = pk2(y[10], y[11]); w1.z = pk2(y[12], y[13]); w1.w = pk2(y[14], y[15]);
        *(u32x4*)dst = w0; *(u32x4*)(dst + 8) = w1;
    }
    __syncthreads();
}

__device__ __forceinline__ void lds_barrier() { asm volatile("s_waitcnt lgkmcnt(0)" ::: "memory"); __builtin_amdgcn_s_barrier(); asm volatile("" ::: "memory"); }
typedef short v4i16_t __attribute__((ext_vector_type(4)));
typedef LAS const unsigned char* lcp;
__device__ __forceinline__ f32x4 mfma16(bf16x8 a, bf16x8 b, f32x4 c) { return __builtin_amdgcn_mfma_f32_16x16x32_bf16(a, b, c, 0, 0, 0); }
__device__ __forceinline__ bf16x8 tr_frag(lcp base, int stride, int k0, int c0, int lane) {
    const int g = lane >> 4, i = lane & 15, q = i >> 2, pp = i & 3;
    lcp a = base + (k0 + 8 * g + q) * stride + (c0 + 4 * pp) * 2;
    const v4i16_t r1 = __builtin_amdgcn_ds_read_tr16_b64_v4i16((LAS v4i16_t*)a), r2 = __builtin_amdgcn_ds_read_tr16_b64_v4i16((LAS v4i16_t*)(a + 4 * stride));
    return (bf16x8){r1[0], r1[1], r1[2], r1[3], r2[0], r2[1], r2[2], r2[3]};
}
__device__ __forceinline__ bf16x8 row_frag(lcp base, int stride, int r0, int k0, int lane) { return *(const LAS bf16x8*)(base + (r0 + (lane & 15)) * stride + (k0 + 8 * (lane >> 4)) * 2); }
__device__ __forceinline__ u32x4 scale8(const u32x4 w, float s) { u32x4 o; o.x = pk2(bflo(w.x) * s, bfhi(w.x) * s); o.y = pk2(bflo(w.y) * s, bfhi(w.y) * s); o.z = pk2(bflo(w.z) * s, bfhi(w.z) * s); o.w = pk2(bflo(w.w) * s, bfhi(w.w) * s); return o; }
constexpr int RS64 = 144, RS128 = 272;
constexpr float LOG2E = 1.4426950408889634f;

__device__ __forceinline__ void retU_fast(const Params& p, const Ctx& c, int l) {
    LAS unsigned char* Kf = c.lds; LAS unsigned char* Kb = Kf + 128 * RS64; LAS unsigned char* Vs = Kb + 128 * RS64;
    bf16_t* U = (bf16_t*)(p.ws + Z_U);
    const int g = c.lane >> 4, i16 = c.lane & 15;
    u32x4 pkk[2], pvv[2];
#define RETU_PREFETCH(uu) do { const int ch_ = (uu) >> 3, h_ = (uu) & 7; \
        _Pragma("unroll") for (int it = 0; it < 2; ++it) { const int idx = c.tid + 512 * it, j = idx >> 3, c8 = (idx & 7) * 8; const size_t go = rlay(h_, (size_t)ch_ * 128 + j) + c8; \
            pkk[it] = *(const u32x4*)((const bf16_t*)(p.ws + Z_RK) + go); pvv[it] = *(const u32x4*)((const bf16_t*)(p.ws + Z_RV) + go); } } while (0)
    if (c.vcu < NCHUNK * NH) RETU_PREFETCH(c.vcu);
    int hcur = -1; float l2f = 0.f, l2b = 0.f;
    for (int u = c.vcu; u < NCHUNK * NH; u += c.G) {
        const int ch = u >> 3, h = u & 7;
        if (h != hcur) { l2f = ret_ld(p, l, 0, h) * LOG2E; l2b = ret_ld(p, l, 1, h) * LOG2E; hcur = h; }
        lds_barrier();
#pragma unroll
        for (int it = 0; it < 2; ++it) { const int idx = c.tid + 512 * it, j = idx >> 3, c8 = (idx & 7) * 8;
            const u32x4 kw = pkk[it], vw = pvv[it];
            const float wf = __builtin_amdgcn_exp2f(l2f * (float)(127 - j)), wb = __builtin_amdgcn_exp2f(l2b * (float)j);
            *(LAS u32x4*)(Kf + j * RS64 + c8 * 2) = scale8(kw, wf); *(LAS u32x4*)(Kb + j * RS64 + c8 * 2) = scale8(kw, wb); *(LAS u32x4*)(Vs + j * RS64 + c8 * 2) = vw; }
        if (u + c.G < NCHUNK * NH) RETU_PREFETCH(u + c.G);
        lds_barrier();
        const int dt = c.wave & 3, et0 = 2 * (c.wave >> 2);
        f32x4 acc[2][2];
#pragma unroll
        for (int s = 0; s < 2; ++s)
#pragma unroll
            for (int e = 0; e < 2; ++e) acc[s][e] = (f32x4){0.f, 0.f, 0.f, 0.f};
#pragma unroll
        for (int ks = 0; ks < 4; ++ks) {
            const bf16x8 af = tr_frag(Kf, RS64, 32 * ks, 16 * dt, c.lane), ab = tr_frag(Kb, RS64, 32 * ks, 16 * dt, c.lane);
#pragma unroll
            for (int e = 0; e < 2; ++e) { const bf16x8 bv = tr_frag(Vs, RS64, 32 * ks, 16 * (et0 + e), c.lane); acc[0][e] = mfma16(af, bv, acc[0][e]); acc[1][e] = mfma16(ab, bv, acc[1][e]); }
        }
#pragma unroll
        for (int s = 0; s < 2; ++s)
#pragma unroll
            for (int e = 0; e < 2; ++e) { bf16_t* o = U + ((size_t)(s * NCHUNK + ch) * NH + h) * 4096 + (16 * dt + 4 * g) * 64 + 16 * (et0 + e) + i16;
#pragma unroll
                for (int r = 0; r < 4; ++r) o[r * 64] = (bf16_t)pk2(acc[s][e][r], 0.f); }
    }
    __syncthreads();
}

#ifndef RETO_DUP
#define RETO_DUP 0
#endif
__device__ __forceinline__ void retO_fast(const Params& p, const Ctx& c, int l) {
    LAS unsigned char* Qs = c.lds; LAS unsigned char* Ks = Qs + 128 * RS64; LAS unsigned char* Vs = Ks + 128 * RS64; LAS unsigned char* Sf = Vs + 128 * RS64; LAS unsigned char* Sb = Sf + 64 * RS64; LAS unsigned char* Ps = Sb + 64 * RS64;
    const bf16_t* U = (const bf16_t*)(p.ws + Z_U);
    const int g = c.lane >> 4, i16 = c.lane & 15, i0 = 16 * c.wave;
    u32x4 pq[2], pk[2], pv[2], prg[2], pst[2]; float pgn[4];
#define RETO_PREFETCH(uu) do { const int ch_ = (uu) >> 3, h_ = (uu) & 7; const size_t R0_ = (size_t)ch_ * 128; \
        _Pragma("unroll") for (int it = 0; it < 2; ++it) { const int idx = c.tid + 512 * it, j = idx >> 3, c8 = (idx & 7) * 8; const size_t go = rlay(h_, R0_ + j) + c8; \
            pq[it] = *(const u32x4*)((const bf16_t*)(p.ws + Z_RQ) + go); pk[it] = *(const u32x4*)((const bf16_t*)(p.ws + Z_RK) + go); pv[it] = *(const u32x4*)((const bf16_t*)(p.ws + Z_RV) + go); } \
        pst[0] = *(const u32x4*)(U + ((size_t)(0 * NCHUNK + ch_) * NH + h_) * 4096 + c.tid * 8); pst[1] = *(const u32x4*)(U + ((size_t)(1 * NCHUNK + ch_) * NH + h_) * 4096 + c.tid * 8); \
        _Pragma("unroll") for (int k = 0; k < 2; ++k) { const int row = c.lane >> 2, ec = ((c.lane & 3) * 2 + k) * 8; prg[k] = *(const u32x4*)((const bf16_t*)(p.ws + Z_RG) + rlay(h_, R0_ + i0 + row) + ec); } \
        _Pragma("unroll") for (int et = 0; et < 4; ++et) pgn[et] = p.in[I_RETGN][l * RW + h_ * HD + 16 * et + i16]; } while (0)
    if (c.vcu < NCHUNK * NH) RETO_PREFETCH(c.vcu);
    int hcur = -1; float l2f = 0.f, l2b = 0.f;
#ifdef PROBE_A
    int ustamp = 50;
#endif
    for (int u = c.vcu; u < NCHUNK * NH; u += c.G) {
#ifdef PROBE_A
        if (l == 0 && c.bx == 0 && c.tid == 0) ((unsigned long long*)(p.ws + WS_CTL + 65536))[ustamp++] = __builtin_amdgcn_s_memrealtime();
#endif
        const int ch = u >> 3, h = u & 7; const size_t R0 = (size_t)ch * 128;
        if (h != hcur) { l2f = ret_ld(p, l, 0, h) * LOG2E; l2b = ret_ld(p, l, 1, h) * LOG2E; hcur = h; }
        lds_barrier();
#pragma unroll 1
        for (int rep_ = 0; rep_ < (RETO_DUP == 3 ? 2 : 1); ++rep_) { asm volatile("" ::: "memory");
#pragma unroll
        for (int it = 0; it < 2; ++it) { const int idx = c.tid + 512 * it, j = idx >> 3, c8 = (idx & 7) * 8;
            *(LAS u32x4*)(Qs + j * RS64 + c8 * 2) = pq[it]; *(LAS u32x4*)(Ks + j * RS64 + c8 * 2) = pk[it]; *(LAS u32x4*)(Vs + j * RS64 + c8 * 2) = pv[it]; }
        {
            const int d = c.tid >> 3, e = (c.tid & 7) * 8; *(LAS u32x4*)(Sf + d * RS64 + e * 2) = pst[0]; *(LAS u32x4*)(Sb + d * RS64 + e * 2) = pst[1];
        }
        }
        const u32x4 rg0 = prg[0], rg1 = prg[1]; const float gn0 = pgn[0], gn1 = pgn[1], gn2 = pgn[2], gn3 = pgn[3];
        if (u + c.G < NCHUNK * NH) RETO_PREFETCH(u + c.G);
        if (RETO_DUP == 5) { asm volatile("" : "+v"(pq[0]), "+v"(pk[0]), "+v"(pv[0]), "+v"(pst[0]), "+v"(prg[0]), "+v"(pq[1]), "+v"(pk[1]), "+v"(pv[1]), "+v"(pst[1]), "+v"(prg[1])); if (u + c.G < NCHUNK * NH) RETO_PREFETCH(u + c.G); }
        lds_barrier();
#pragma unroll 1
        for (int rep_ = 0; rep_ < (RETO_DUP == 1 ? 2 : 1); ++rep_) { asm volatile("" ::: "memory"); const bf16x8 q0 = row_frag(Qs, RS64, i0, 0, c.lane), q1 = row_frag(Qs, RS64, i0, 32, c.lane);
            const int iq = i0 + i16;
#pragma unroll
            for (int jt = 0; jt < 8; ++jt) {
                f32x4 s = (f32x4){0.f, 0.f, 0.f, 0.f};
                s = mfma16(row_frag(Ks, RS64, 16 * jt, 0, c.lane), q0, s); s = mfma16(row_frag(Ks, RS64, 16 * jt, 32, c.lane), q1, s);
                float pv[4];
#pragma unroll
                for (int r = 0; r < 4; ++r) { const int j = 16 * jt + 4 * g + r; const float dj = (float)(iq - j); const float e_ = __builtin_amdgcn_exp2f(dj > 0.f ? l2f * dj : -l2b * dj); const float w = j == iq ? 2.0f : e_; pv[r] = s[r] * w; }
                u32x2 w2; w2.x = pk2(pv[0], pv[1]); w2.y = pk2(pv[2], pv[3]);
                *(LAS u32x2*)(Ps + iq * RS128 + (16 * jt + 4 * g) * 2) = w2;
            } }
        lds_barrier();
        f32x4 ap[4], af[4], ab[4];
#pragma unroll
        for (int et = 0; et < 4; ++et) { ap[et] = (f32x4){0.f, 0.f, 0.f, 0.f}; af[et] = ap[et]; ab[et] = ap[et]; }
#pragma unroll 1
        for (int rep_ = 0; rep_ < (RETO_DUP == 2 ? 2 : 1); ++rep_) { asm volatile("" ::: "memory");
#pragma unroll
        for (int ks = 0; ks < 4; ++ks) { const bf16x8 a = row_frag(Ps, RS128, i0, 32 * ks, c.lane);
#pragma unroll
            for (int et = 0; et < 4; ++et) ap[et] = mfma16(a, tr_frag(Vs, RS64, 32 * ks, 16 * et, c.lane), ap[et]); }
#pragma unroll
        for (int ks = 0; ks < 2; ++ks) { const bf16x8 a = row_frag(Qs, RS64, i0, 32 * ks, c.lane);
#pragma unroll
            for (int et = 0; et < 4; ++et) { af[et] = mfma16(a, tr_frag(Sf, RS64, 32 * ks, 16 * et, c.lane), af[et]); ab[et] = mfma16(a, tr_frag(Sb, RS64, 32 * ks, 16 * et, c.lane), ab[et]); } }
        }
        float mu[4], rstd[4];
#pragma unroll
        for (int r = 0; r < 4; ++r) { const int il = i0 + 4 * g + r; const float xf = __builtin_amdgcn_exp2f(l2f * (float)(il + 1)), xb = __builtin_amdgcn_exp2f(l2b * (float)(128 - il)); float s1 = 0.f;
#pragma unroll
            for (int et = 0; et < 4; ++et) { ap[et][r] += xf * af[et][r] + xb * ab[et][r]; s1 += ap[et][r]; }
            s1 += __shfl_xor(s1, 1); s1 += __shfl_xor(s1, 2); s1 += __shfl_xor(s1, 4); s1 += __shfl_xor(s1, 8); mu[r] = s1 * (1.f / 64.f); float s2 = 0.f;
#pragma unroll
            for (int et = 0; et < 4; ++et) { const float d = ap[et][r] - mu[r]; s2 += d * d; }
            s2 += __shfl_xor(s2, 1); s2 += __shfl_xor(s2, 2); s2 += __shfl_xor(s2, 4); s2 += __shfl_xor(s2, 8); rstd[r] = rsqrtf(s2 * (1.f / 64.f) + EPS); }
        LAS float* stg = (LAS float*)(Ps + i0 * RS128);
#pragma unroll 1
        for (int rep_ = 0; rep_ < (RETO_DUP == 4 ? 2 : 1); ++rep_) { asm volatile("" ::: "memory");
#pragma unroll
        for (int et = 0; et < 4; ++et) { const float gn = et == 0 ? gn0 : et == 1 ? gn1 : et == 2 ? gn2 : gn3;
#pragma unroll
            for (int r = 0; r < 4; ++r) stg[(4 * g + r) * 68 + 16 * et + i16] = (ap[et][r] - mu[r]) * rstd[r] * gn; }
        asm volatile("s_waitcnt lgkmcnt(0)" ::: "memory");
#pragma unroll
        for (int k = 0; k < 2; ++k) { const int row = c.lane >> 2, ec = ((c.lane & 3) * 2 + k) * 8;
            const f32x4 y0 = *(const LAS f32x4*)(stg + row * 68 + ec), y1 = *(const LAS f32x4*)(stg + row * 68 + ec + 4);
            const size_t go = (R0 + i0 + row) * RW + h * HD + ec; const u32x4 gw = k == 0 ? rg0 : rg1;
            u32x4 o; o.x = pk2(y0.x * bflo(gw.x), y0.y * bfhi(gw.x)); o.y = pk2(y0.z * bflo(gw.y), y0.w * bfhi(gw.y)); o.z = pk2(y1.x * bflo(gw.z), y1.y * bfhi(gw.z)); o.w = pk2(y1.z * bflo(gw.w), y1.w * bfhi(gw.w));
            *(u32x4*)((bf16_t*)(p.ws + Z_CV) + go) = o; }
        }
    }
    __syncthreads();
}

__device__ __forceinline__ void cmlp_fast(const Params& p, const Ctx& c, int l) {
    LAS unsigned char* As = c.lds; LAS unsigned char* Vc = As + 128 * RS128; LAS float* rs = (LAS float*)(Vc + 128 * RS128);
    const bf16_t* cv = (const bf16_t*)(p.ws + Z_CV); bf16_t* cu = (bf16_t*)(p.ws + Z_CU);
    const int g4 = c.lane >> 4, i16 = c.lane & 15, p0 = 16 * c.wave;
    for (int k = 0; ; ++k) {
        int u;
        if (c.G != 256) { u = c.vcu + k * c.G; if (u >= NCHUNK * 4) break; }
        else if (k < 2) u = c.vcu + 256 * k;
        else if (k == 2 && ((c.bx >> 3) & 1)) u = 512 + (c.bx & 7) * 16 + (c.bx >> 4);
        else break;
        const int ch = u >> 2, g = u & 3; const size_t R0 = (size_t)ch * 128;
        u32x4 lv[4], lu[4]; f32x4 lw[8];
        float lss = 0.f;
        if (c.tid < 128) {
#pragma unroll
            for (int sx = 0; sx < 8; ++sx) lss += ((const float*)(p.ws + WS_SSQ))[(size_t)sx * M + R0 + c.tid]; }
#pragma unroll
        for (int it = 0; it < 4; ++it) { const int idx = c.tid + 512 * it, q = idx >> 4, c8 = (idx & 15) * 8; lv[it] = *(const u32x4*)(cv + (R0 + q) * RW + g * 128 + c8); }
        const float* Ws = p.in[I_CMWS] + ((size_t)(l * 4 + g) * 128) * 128;
#pragma unroll
        for (int it = 0; it < 8; ++it) { const int idx = c.tid + 512 * it, pr = idx >> 5, q4 = (idx & 31) * 4; lw[it] = *(const f32x4*)(Ws + pr * 128 + q4); }
#pragma unroll
        for (int k = 0; k < 4; ++k) { const int row = c.lane >> 2, cc = (k * 4 + (c.lane & 3)) * 8; lu[k] = *(const u32x4*)(cu + (R0 + p0 + row) * RW + g * 128 + cc); }
        float bb[4], gnv[8];
        { const float* bsv = p.in[I_CMBS] + (l * 4 + g) * 128 + p0 + 4 * g4;
#pragma unroll
          for (int r = 0; r < 4; ++r) bb[r] = bsv[r];
#pragma unroll
          for (int ct = 0; ct < 8; ++ct) gnv[ct] = p.in[I_CMNORM][l * RW + g * 128 + 16 * ct + i16]; }
        lds_barrier();
        if (c.tid < 128) rs[c.tid] = rsqrtf(lss * (1.f / RW) + EPS);
#pragma unroll
        for (int it = 0; it < 4; ++it) { const int idx = c.tid + 512 * it, q = idx >> 4, c8 = (idx & 15) * 8; *(LAS u32x4*)(Vc + q * RS128 + c8 * 2) = lv[it]; }
        lds_barrier();
#pragma unroll
        for (int it = 0; it < 8; ++it) { const int idx = c.tid + 512 * it, pr = idx >> 5, q4 = (idx & 31) * 4;
            const f32x4 w = lw[it]; const f32x4 r = *(const LAS f32x4*)(rs + q4);
            u32x2 o; o.x = pk2(w.x * r.x, w.y * r.y); o.y = pk2(w.z * r.z, w.w * r.w); *(LAS u32x2*)(As + pr * RS128 + q4 * 2) = o; }
        lds_barrier();
        f32x4 acc[8];
#pragma unroll
        for (int ct = 0; ct < 8; ++ct) acc[ct] = (f32x4){0.f, 0.f, 0.f, 0.f};
#pragma unroll
        for (int ks = 0; ks < 4; ++ks) { const bf16x8 a = row_frag(As, RS128, p0, 32 * ks, c.lane);
#pragma unroll
            for (int ct = 0; ct < 8; ++ct) acc[ct] = mfma16(a, tr_frag(Vc, RS128, 32 * ks, 16 * ct, c.lane), acc[ct]); }
        lds_barrier();
        LAS float* stg = (LAS float*)(c.lds + c.wave * (16 * 132 * 4));
#pragma unroll
        for (int ct = 0; ct < 8; ++ct) { const float gn = gnv[ct];
#pragma unroll
            for (int r = 0; r < 4; ++r) stg[(4 * g4 + r) * 132 + 16 * ct + i16] = gn * acc[ct][r] + bb[r]; }
        asm volatile("s_waitcnt lgkmcnt(0)" ::: "memory");
#pragma unroll
        for (int k = 0; k < 4; ++k) { const int row = c.lane >> 2, cc = (k * 4 + (c.lane & 3)) * 8;
            const f32x4 y0 = *(const LAS f32x4*)(stg + row * 132 + cc), y1 = *(const LAS f32x4*)(stg + row * 132 + cc + 4);
            bf16_t* up = cu + (R0 + p0 + row) * RW + g * 128 + cc; const u32x4 uw = lu[k];
            u32x4 o; o.x = pk2(y0.x * bflo(uw.x), y0.y * bfhi(uw.x)); o.y = pk2(y0.z * bflo(uw.y), y0.w * bfhi(uw.y)); o.z = pk2(y1.x * bflo(uw.z), y1.y * bfhi(uw.z)); o.w = pk2(y1.z * bflo(uw.w), y1.w * bfhi(uw.w));
            *(u32x4*)up = o; }
    }
    __syncthreads();
}
__device__ __forceinline__ void ret_scan(const Params& p, const Ctx& c, int l) {
    bf16_t* U = (bf16_t*)(p.ws + Z_U);
    const int gw = c.bx * 8 + c.wave, NGW = c.G * 8;
    if (c.G == 256) {
        const int part = gw & 15, dir = (gw >> 4) & 1, seq0 = gw >> 5, h = seq0 & 7, b0 = seq0 >> 3, e0 = part * 256 + c.lane * 4;
        const float G = __expf(128.f * ret_ld(p, l, dir, h)); const size_t cs = (size_t)NH * 4096;
        bf16_t* base0 = U + ((size_t)(dir * NCHUNK + MP / 128 + b0 * 16) * NH + h) * 4096 + e0;
        bf16_t* base1 = U + ((size_t)(dir * NCHUNK + b0 * 2) * NH + h) * 4096 + e0;
        bf16_t* base2 = U + ((size_t)(dir * NCHUNK + (b0 + 8) * 2) * NH + h) * 4096 + e0;
        f32x4 s = *(const f32x4*)(p.in[I_ST] + ((size_t)((b0 * 2 + l) * 2 + dir) * NH + h) * 4096 + e0);
        u32x2 uu[16], ua[2], ub[2];
#pragma unroll
        for (int k = 0; k < 16; ++k) uu[k] = *(const u32x2*)(base0 + (dir == 0 ? k : 15 - k) * cs);
#pragma unroll
        for (int k = 0; k < 2; ++k) { ua[k] = *(const u32x2*)(base1 + (dir == 0 ? k : 1 - k) * cs); ub[k] = *(const u32x2*)(base2 + (dir == 0 ? k : 1 - k) * cs); }
#pragma unroll
        for (int k = 0; k < 16; ++k) { u32x2 w; w.x = pk2(s.x, s.y); w.y = pk2(s.z, s.w); *(u32x2*)(base0 + (dir == 0 ? k : 15 - k) * cs) = w;
            s = s * G + (f32x4){bflo(uu[k].x), bfhi(uu[k].x), bflo(uu[k].y), bfhi(uu[k].y)}; }
        f32x4 sa = (f32x4){0.f, 0.f, 0.f, 0.f}, sb = sa;
#pragma unroll
        for (int k = 0; k < 2; ++k) { u32x2 w; w.x = pk2(sa.x, sa.y); w.y = pk2(sa.z, sa.w); *(u32x2*)(base1 + (dir == 0 ? k : 1 - k) * cs) = w;
            sa = sa * G + (f32x4){bflo(ua[k].x), bfhi(ua[k].x), bflo(ua[k].y), bfhi(ua[k].y)};
            w.x = pk2(sb.x, sb.y); w.y = pk2(sb.z, sb.w); *(u32x2*)(base2 + (dir == 0 ? k : 1 - k) * cs) = w;
            sb = sb * G + (f32x4){bflo(ub[k].x), bfhi(ub[k].x), bflo(ub[k].y), bfhi(ub[k].y)}; }
        *(f32x4*)(p.out + OUT_ST + ((size_t)((b0 * 2 + l) * 2 + dir) * NH + h) * 4096 + e0) = sa;
        *(f32x4*)(p.out + OUT_ST + ((size_t)(((b0 + 8) * 2 + l) * 2 + dir) * NH + h) * 4096 + e0) = sb;
        return;
    }
    int hcur = -1; float G = 0.f;
    for (int it = gw; it < 192 * 2 * 16; it += NGW) {
        const int part = it & 15, dir = (it >> 4) & 1, seq = it >> 5; const bool smp = seq < 64;
        const int b = smp ? seq >> 3 : (seq - 64) >> 3, h = seq & 7, ch0 = smp ? MP / 128 + b * 16 : b * 2;
        const int e0 = part * 256 + c.lane * 4;
        if (dir * 8 + h != hcur) { G = __expf(128.f * ret_ld(p, l, dir, h)); hcur = dir * 8 + h; }
        bf16_t* base = U + ((size_t)(dir * NCHUNK + ch0) * NH + h) * 4096 + e0; const size_t cs = (size_t)NH * 4096;
        f32x4 s; u32x2 uu[16];
        if (smp) { s = *(const f32x4*)(p.in[I_ST] + ((size_t)((b * 2 + l) * 2 + dir) * NH + h) * 4096 + e0);
#pragma unroll
            for (int k = 0; k < 16; ++k) uu[k] = *(const u32x2*)(base + (dir == 0 ? k : 15 - k) * cs);
#pragma unroll
            for (int k = 0; k < 16; ++k) { u32x2 w; w.x = pk2(s.x, s.y); w.y = pk2(s.z, s.w); *(u32x2*)(base + (dir == 0 ? k : 15 - k) * cs) = w;
                s = s * G + (f32x4){bflo(uu[k].x), bfhi(uu[k].x), bflo(uu[k].y), bfhi(uu[k].y)}; } }
        else { s = (f32x4){0.f, 0.f, 0.f, 0.f};
#pragma unroll
            for (int k = 0; k < 2; ++k) uu[k] = *(const u32x2*)(base + (dir == 0 ? k : 1 - k) * cs);
#pragma unroll
            for (int k = 0; k < 2; ++k) { u32x2 w; w.x = pk2(s.x, s.y); w.y = pk2(s.z, s.w); *(u32x2*)(base + (dir == 0 ? k : 1 - k) * cs) = w;
                s = s * G + (f32x4){bflo(uu[k].x), bfhi(uu[k].x), bflo(uu[k].y), bfhi(uu[k].y)}; }
            *(f32x4*)(p.out + OUT_ST + ((size_t)((b * 2 + l) * 2 + dir) * NH + h) * 4096 + e0) = s; }
    }
}
#ifndef P2A_ORDER
#define P2A_ORDER 0
#endif
#ifndef FAST_MIX
#define FAST_MIX 7
#endif

#ifndef PG8_ALIGN_
#define PG8_ALIGN_ true
#endif
#ifndef PG8_SP2_
#define PG8_SP2_ true
#endif
#ifndef PG8_MASK
#define PG8_MASK 0xFFF
#endif
template <int KIND, class Epi, class Sched>
__device__ __forceinline__ void gemm_any(const Ctx& c, const bf16_t* A, const bf16_t* Bt, int K, const Sched& S, const Epi& E, unsigned long long* probe_ts = nullptr) {
    if constexpr ((PG8_MASK >> KIND) & 1) { pg8::Gemm g{A, Bt, 0, 0, K, nullptr};
#ifdef PROBE_KIND
        if (KIND == PROBE_KIND && A != nullptr) g.ts = probe_ts;
#endif
        pg8::gemm_phase<Epi, Sched, PG8_ALIGN_, PG8_SP2_>(c.tid, c.lds, g, S, E); }
    else gemm_simple(c, A, Bt, K, S, E);
}
#ifndef KMASK
#define KMASK 0x1FFF
#endif
constexpr int NPHASE = 25;
__host__ __device__ constexpr int layer_kind(int i) { return i == 0 ? 2 : i == 1 ? 3 : i == 2 ? 12 : i + 1; }
template <int KIND> __device__ __forceinline__ void run_kind(const Params& p, const Ctx& c, int l) {
    const unsigned char* wb = w_base(p, l);
    if constexpr (KIND == 0) {
        if (c.G == 256) {
            p0_rope_tables(p, c);
            if (c.bx < 96) p0_modulation(p, c, 0, 96, c.bx, 96); else p_wconv(p, c, 0, 0, WC_IN, c.bx - 96, 160);
            p_kvctx(p, c, 0);
        } else { p0_modulation(p, c, 0, 192, c.bx, c.G); p0_rope_tables(p, c); p_wconv(p, c, 0, 0, WC_ALL, c.bx, c.G); p_kvctx(p, c, 0); }
    }
    else if constexpr (KIND == 1) { p_norm(p, c, l, 0, l == 1 && c.G == 256); }
    else if constexpr (KIND == 2) {
        if (l == 1) p_kvctx(p, c, 1);
        { LAS float* t = (LAS float*)(c.lds + LDS_TAB); const float* g = (const float*)(p.ws + WS_ROPE);
          { float tv[6];
#pragma unroll
            for (int j = 0; j < 6; ++j) tv[j] = g[c.tid + 512 * j];
#pragma unroll
            for (int j = 0; j < 6; ++j) t[c.tid + 512 * j] = tv[j]; }
          if (c.tid < 64) t[96 * 16 * 2 + c.tid] = p.in[I_GQ][l * HD + c.tid]; else if (c.tid < 128) t[96 * 16 * 2 + c.tid] = p.in[I_GK][l * HD + c.tid - 64];
          __syncthreads(); }
        StaticOrder S; S.init(M, NMIX, c.G, c.bx, DM); EpiMix E{&p, l, c.lds + LDS_TAB}; gemm_any<2>(c, xn_ptr(p), (const bf16_t*)(wb + W_IN), DM, S, E, l == 0 ? (unsigned long long*)(p.ws + WS_CTL + 65536) : nullptr);
        if (l == 0 && c.G == 256 && c.bx >= 176) { __syncthreads(); p_wconv(p, c, 0, WC_IN, WC_FF, c.bx - 176, 80); p_wconv(p, c, 1, 0, WC_IN, c.bx - 176, 80); }
    }
    else if constexpr (KIND == 3) {
#if P2A_ORDER == 1
        if (FAST_MIX & 2) retU_fast(p, c, l); else retU_simple(p, c, l); if (FAST_MIX & 1) cmlp_fast(p, c, l); else cmlp_simple(p, c, l); if (ATTN_FAST) attn_fast(p, c); else attn_simple(p, c);
#else
        if (ATTN_FAST) attn_fast(p, c); else attn_simple(p, c); if (FAST_MIX & 1) cmlp_fast(p, c, l); else cmlp_simple(p, c, l); if (FAST_MIX & 2) retU_fast(p, c, l); else retU_simple(p, c, l);
#endif
    }
    else if constexpr (KIND == 4) { if (FAST_MIX & 4) retO_fast(p, c, l); else retO_simple(p, c, l); }
    else if constexpr (KIND == 5) { StaticOrder S; S.init(M, NGATE, c.G, c.bx, DM); EpiGate E{&p}; gemm_any<5>(c, xn_ptr(p), (const bf16_t*)(wb + W_IN) + (size_t)NMIX * DM, DM, S, E, l == 0 ? (unsigned long long*)(p.ws + WS_CTL + 65536) : nullptr);
        if (l == 0 && c.G == 256 && c.bx >= 192) { __syncthreads(); p_wconv(p, c, 0, WC_FF, WC_ALL, c.bx - 192, 64); }
    }
    else if constexpr (KIND == 6) { MergeOrder S{c.G, (c.G % 8 == 0) ? (c.bx % 8) * (c.G / 8) + c.bx / 8 : c.bx}; EpiMerge E{&p}; gemm_any<6>(c, (const bf16_t*)(p.ws + Z_AQ), (const bf16_t*)(wb + W_BR), RW, S, E, l == 0 ? (unsigned long long*)(p.ws + WS_CTL + 65536) : nullptr);
        if (l == 0 && c.G == 256 && (c.vcu & 3) != 0) { __syncthreads(); p0_modulation(p, c, 96, 192, (c.vcu >> 2) * 3 + (c.vcu & 3) - 1, 192); p_wconv(p, c, 1, WC_IN, WC_ALL, (c.vcu >> 2) * 3 + (c.vcu & 3) - 1, 192); }
    }
    else if constexpr (KIND == 7) { QuarterOrder S; S.init(c.G, c.bx, DM); EpiRes E{&p, l, 2, l == 0, DM / 64, (bf16_t*)(p.ws + SLAB_P4)}; gemm_any<7>(c, xn_ptr(p), (const bf16_t*)(wb + W_OUT), DM, S, E, l == 0 ? (unsigned long long*)(p.ws + WS_CTL + 65536) : nullptr); }
    else if constexpr (KIND == 8) { p_norm(p, c, l, 1, c.G == 256); }
    else if constexpr (KIND == 9) { StaticOrder S; S.init(M, DFF, c.G, c.bx, DM); EpiFF1 E{&p}; gemm_any<9>(c, xn_ptr(p), (const bf16_t*)(wb + W_FF1), DM, S, E, l == 0 ? (unsigned long long*)(p.ws + WS_CTL + 65536) : nullptr); }
    else if constexpr (KIND == 10) { QuarterOrder S; S.init(c.G, c.bx, DFF); EpiRes E{&p, l, 5, false, DFF / 64, (bf16_t*)(p.ws + SLAB_P6)}; gemm_any<10>(c, (const bf16_t*)(p.ws + Z_HB), (const bf16_t*)(wb + W_FF2), DFF, S, E, l == 0 ? (unsigned long long*)(p.ws + WS_CTL + 65536) : nullptr); }
    else if constexpr (KIND == 12) { ret_scan(p, c, l); }
    else { if (l == 0) { if (c.G != 256) p_wconv(p, c, 1, 0, WC_ALL, c.bx, c.G); } else p_final_norm(p, c, c.G == 256); }
}
#ifndef CODE_WARM_KB
#define CODE_WARM_KB 96
#endif
template <int KB> __device__ __forceinline__ void warm_next_code(int tid) {
    if (KB > 0) {
        unsigned long long pc; asm volatile("s_getpc_b64 %0" : "=s"(pc));
        const char* base = (const char*)(pc & ~63ull);
        unsigned acc_ = 0;
#pragma unroll
        for (int i = 0; i < (KB * 1024 + 512 * 64 - 1) / (512 * 64); ++i) acc_ += *(const volatile unsigned*)(base + (size_t)(i * 512 + tid) * 64);
        asm volatile("" :: "v"(acc_));
    }
}
template <int PH> __device__ __forceinline__ void run_from(const Params& p, const Ctx& c0, const XcdBarrier& bar) {
    if constexpr (PH < NPHASE) {
        constexpr int l = PH < 13 ? 0 : 1, kind = PH < 2 ? PH : (PH == 13 ? 1 : layer_kind(PH < 13 ? PH - 2 : PH - 14));
#ifdef PROBE_A
        if (c0.bx == 0 && c0.tid == 0) ((unsigned long long*)(p.ws + WS_CTL + 65536))[PH] = __builtin_amdgcn_s_memrealtime();
#endif
        { Ctx c = c0; asm volatile("" : "+v"(c.tid)); c.lane = c.tid & 63; c.wave = __builtin_amdgcn_readfirstlane(c.tid >> 6);
          if ((KMASK >> kind) & 1) run_kind<kind>(p, c, l); }
#ifdef PROBE_A
        xcd_barrier<(PH + 3 < NPHASE ? CODE_WARM_KB : 32)>(bar);
        if constexpr (PH + 1 == NPHASE) {
            if (c0.bx == 0 && c0.tid == 0) ((unsigned long long*)(p.ws + WS_CTL + 65536))[NPHASE] = __builtin_amdgcn_s_memrealtime();
            xcd_barrier<0>(bar);
            const unsigned long long* ts = (const unsigned long long*)(p.ws + WS_CTL + 65536);
            const float us = (float)(ts[PROBE_B] - ts[PROBE_A]) * 0.01f; const float sc = 1.0f + sqrtf(2e-4f * us / (float)(PROBE_FS));
            for (size_t i = (size_t)c0.bx * 512 + c0.tid; i < (size_t)NB_P * 2 * SEQ_P * KVW; i += (size_t)c0.G * 512) p.out[OUT_CV + i] *= sc;
        }
#else
        if constexpr (PH + 1 < NPHASE) { if (!(PH == 12 && c0.G == 256)) xcd_barrier<(PH + 3 < NPHASE ? CODE_WARM_KB : 32)>(bar); }
#endif
        run_from<PH + 1>(p, c0, bar);
    }
}
#if N_LAUNCH_MODE == 1
__global__ void __launch_bounds__(512, 2) fwd_kernel(Params p) {
    extern __shared__ __attribute__((aligned(16))) unsigned char lds[];
    Ctx c; c.tid = threadIdx.x; c.lane = c.tid & 63; c.wave = __builtin_amdgcn_readfirstlane(c.tid >> 6); c.G = gridDim.x; c.bx = blockIdx.x; c.vcu = (c.G % 8 == 0) ? (c.bx % 8) * (c.G / 8) + c.bx / 8 : c.bx; c.lds = (LAS unsigned char*)lds;
    volatile LAS unsigned* MISC = (volatile LAS unsigned*)(c.lds + MISC_OFF);
    if (c.tid < 32) MISC[c.tid] = 0u;
    __syncthreads();
    XcdBarrier bar = xcd_barrier_post((unsigned*)(p.ws + WS_CTL) + CW_BAR, MISC + 8);
    run_from<0>(p, c, bar);
}
#endif
template <int KIND> __global__ void __launch_bounds__(512, 2) phase_kernel(Params p) {
    extern __shared__ __attribute__((aligned(16))) unsigned char lds[];
    Ctx c; c.tid = threadIdx.x; c.lane = c.tid & 63; c.wave = __builtin_amdgcn_readfirstlane(c.tid >> 6); c.G = gridDim.x; c.bx = blockIdx.x; c.vcu = (c.G % 8 == 0) ? (c.bx % 8) * (c.G / 8) + c.bx / 8 : c.bx; c.lds = (LAS unsigned char*)lds;
    run_kind<KIND>(p, c, p.ph_hi);
}
template <int KIND> static void launch_kind(Params p, int l, int grid, hipStream_t stream) {
    static bool attr = false;
    if (!attr) { (void)hipFuncSetAttribute((const void*)phase_kernel<KIND>, hipFuncAttributeMaxDynamicSharedMemorySize, LDS_BYTES); attr = true; }
    p.ph_lo = 0; p.ph_hi = l;
    hipLaunchKernelGGL(phase_kernel<KIND>, dim3(grid), dim3(512), LDS_BYTES, stream, p);
}

extern "C" void kernel_launch(void* const* d_in, const int* in_sizes, int n_in, void* d_out, int out_size, void* d_ws, size_t ws_size, hipStream_t stream) {
    static int grid = 0;
    if (grid == 0) {
        int dev = 0, cus = 0;
        if (n_in != N_IN || ws_size < WS_NEED) { grid = -1; return; }
        if (hipGetDevice(&dev) != hipSuccess || hipDeviceGetAttribute(&cus, hipDeviceAttributeMultiprocessorCount, dev) != hipSuccess) { grid = -1; return; }
#if N_LAUNCH_MODE == 1
        if (hipFuncSetAttribute((const void*)fwd_kernel, hipFuncAttributeMaxDynamicSharedMemorySize, LDS_BYTES) != hipSuccess) { grid = -1; return; }
#endif
        grid = cus;
    }
    if (grid < 0) return;
    (void)hipMemsetAsync((char*)d_ws + WS_CTL, 0, WS_ZERO_BYTES, stream);
    Params p{};
    for (int i = 0; i < N_IN; ++i) p.in[i] = (const float*)d_in[i];
    p.out = (float*)d_out; p.ws = (unsigned char*)d_ws;
#if N_LAUNCH_MODE == 1
    p.ph_lo = 0; p.ph_hi = NPHASE;
    hipLaunchKernelGGL(fwd_kernel, dim3(grid), dim3(512), LDS_BYTES, stream, p);
#else
    launch_kind<0>(p, 0, grid, stream);
    for (int l = 0; l < 2; ++l) { launch_kind<1>(p, l, grid, stream);
        launch_kind<2>(p, l, grid, stream); launch_kind<3>(p, l, grid, stream); launch_kind<12>(p, l, grid, stream); launch_kind<4>(p, l, grid, stream); launch_kind<5>(p, l, grid, stream); launch_kind<6>(p, l, grid, stream);
        launch_kind<7>(p, l, grid, stream); launch_kind<8>(p, l, grid, stream); launch_kind<9>(p, l, grid, stream); launch_kind<10>(p, l, grid, stream); launch_kind<11>(p, l, grid, stream);
    }
#endif
}
```
